# Optimizing an MI355X kernel written in HIP

```python
import math
import jax, jax.numpy as jnp
from jax import lax
import numpy as np

D_MODEL = 1024
BATCH = 8
SEQ = 8192
DEPTH = 2

CHUNK = 64
N_MEM = 256
D_MIX = D_MODEL
D_GLA = D_MIX // 2
D_SGU = D_MIX - D_GLA
GLA_HEADS = 4
D_QK = D_GLA // 2
GLA_DK = D_QK // GLA_HEADS
GLA_DV = D_GLA // GLA_HEADS
GATE_RANK = 16
GATE_TEMP = 16.0
SGU_GROUPS = 4
SGU_BLOCK = 128
SGU_CH = D_SGU // SGU_GROUPS
XATTN_HEADS = 4
XATTN_DH = D_MODEL // XATTN_HEADS
N_EXPERTS = 16
N_EXPERT_GROUPS = 4
EXPERTS_PER_GROUP = N_EXPERTS // N_EXPERT_GROUPS
TOP_K = 2
D_EXPERT = D_MODEL // 2
DN_ALPHA = (2.0 * DEPTH) ** 0.25
DN_BETA = (8.0 * DEPTH) ** -0.25
LN_EPS = 1e-5
RMS_EPS = 1e-6
D_IN = 2 * D_QK + 2 * D_GLA + GATE_RANK + 2 * D_SGU

kernel_name = "hybrid_gla_gmlp_memxattn_groupmoe_deepnorm"


def layer_norm(x, g, b):
    xf = x.astype(jnp.float32)
    mu = jnp.mean(xf, axis=-1, keepdims=True)
    var = jnp.mean(jnp.square(xf - mu), axis=-1, keepdims=True)
    y = (xf - mu) * lax.rsqrt(var + LN_EPS)
    return (y * g.astype(jnp.float32) + b.astype(jnp.float32)).astype(x.dtype)


def split_proj(p):
    sizes = (D_QK, D_QK, D_GLA, D_GLA, GATE_RANK, D_SGU, D_SGU)
    outs, start = [], 0
    for s in sizes:
        outs.append(p[..., start:start + s])
        start += s
    return outs


def gla_group(q, k, v, r, a_low, w_a2, b_a, gn_g):
    B, S, _ = q.shape
    nc = S // CHUNK
    log_a = jax.nn.log_sigmoid((a_low @ w_a2 + b_a).astype(jnp.float32)) / GATE_TEMP

    def to_chunks(t, d):
        return t.astype(jnp.float32).reshape(B, nc, CHUNK, GLA_HEADS, d).transpose(1, 0, 3, 2, 4)

    qc = to_chunks(q, GLA_DK) * (GLA_DK ** -0.5)
    kc = to_chunks(k, GLA_DK)
    vc = to_chunks(v, GLA_DV)
    gc = to_chunks(log_a, GLA_DK)

    def step(state, inp):
        q_c, k_c, v_c, g_c = inp
        bcum = jnp.cumsum(g_c, axis=2)
        b_last = bcum[:, :, -1:, :]
        k_dec = k_c * jnp.exp(b_last - bcum)
        state = jnp.exp(b_last[:, :, 0, :])[..., None] * state + jnp.einsum('bhck,bhcv->bhkv', k_dec, v_c)
        o = jnp.einsum('bhck,bhkv->bhcv', q_c, state)
        return state, o

    s0 = jnp.zeros((B, GLA_HEADS, GLA_DK, GLA_DV), jnp.float32)
    _, o = lax.scan(step, s0, (qc, kc, vc, gc))
    o = o.transpose(1, 0, 3, 2, 4).reshape(B, S, GLA_HEADS, GLA_DV)
    o = o * lax.rsqrt(jnp.mean(jnp.square(o), axis=-1, keepdims=True) + RMS_EPS)
    o = o.reshape(B, S, D_GLA) * gn_g.astype(jnp.float32)
    out = o * jax.nn.silu(r.astype(jnp.float32))
    return out.astype(q.dtype)


def sgu_group(u, v, w_s, b_s, ln_g, ln_b):
    B, S, _ = u.shape
    nb = S // SGU_BLOCK
    u = jax.nn.gelu(u)
    v = jax.nn.gelu(v).reshape(B, S, SGU_GROUPS, SGU_CH)
    v = layer_norm(v, ln_g.reshape(SGU_GROUPS, SGU_CH), ln_b.reshape(SGU_GROUPS, SGU_CH))
    v = v.reshape(B, nb, SGU_BLOCK, SGU_GROUPS, SGU_CH)
    pos = jnp.arange(SGU_BLOCK)
    mask = (pos[None, :] // CHUNK) <= (pos[:, None] // CHUNK)
    w_m = jnp.where(mask[None], w_s, jnp.zeros_like(w_s))
    mixed = jnp.einsum('gts,bnsgc->bntgc', w_m, v) + b_s.T[None, None, :, :, None]
    out = u.reshape(B, nb, SGU_BLOCK, SGU_GROUPS, SGU_CH) * mixed
    return out.reshape(B, S, D_SGU)


def mem_xattn(x, mem, wq, wk, wv, wo):
    B, S, _ = x.shape
    M = mem.shape[1]
    q = (x @ wq).reshape(B, S, XATTN_HEADS, XATTN_DH)
    k = (mem @ wk).reshape(B, M, XATTN_HEADS, XATTN_DH)
    v = (mem @ wv).reshape(B, M, XATTN_HEADS, XATTN_DH)
    s = jnp.einsum('bshd,bmhd->bhsm', q, k).astype(jnp.float32) * (XATTN_DH ** -0.5)
    p = jax.nn.softmax(s, axis=-1).astype(v.dtype)
    o = jnp.einsum('bhsm,bmhd->bshd', p, v).reshape(B, S, D_MODEL)
    return o @ wo


def grouped_moe(x, w_router, b_router, w_gate, w_up, w_down):
    B, S, D = x.shape
    xt = x.reshape(B * S, D)
    scores = jax.nn.softmax((xt @ w_router + b_router).astype(jnp.float32), axis=-1)
    grp = scores.reshape(-1, N_EXPERT_GROUPS, EXPERTS_PER_GROUP)
    group_score = jnp.sum(lax.top_k(grp, TOP_K)[0], axis=-1)
    g_sel = jnp.argmax(group_score, axis=-1)
    in_grp = jnp.sum(grp * jax.nn.one_hot(g_sel, N_EXPERT_GROUPS, dtype=jnp.float32)[:, :, None], axis=1)
    top_w, top_i = lax.top_k(in_grp, TOP_K)
    top_w = top_w / jnp.sum(top_w, axis=-1, keepdims=True)
    eid = g_sel[:, None] * EXPERTS_PER_GROUP + top_i
    gate = jnp.sum(jax.nn.one_hot(eid, N_EXPERTS, dtype=jnp.float32) * top_w[..., None], axis=1)
    gate = gate.astype(x.dtype)
    y = jnp.zeros_like(xt)
    for e in range(N_EXPERTS):
        h = jax.nn.silu(xt @ w_gate[e]) * (xt @ w_up[e])
        y = y + gate[:, e:e + 1] * (h @ w_down[e])
    return y.reshape(B, S, D)


def setup_inputs(seed: int = 0) -> dict:
    key = jax.random.key(seed)
    ks = jax.random.split(key, 24)
    f32 = jnp.float32

    def nrm(k, shape, fan_in, scale=1.0):
        return jax.random.normal(k, shape, f32) * (scale * fan_in ** -0.5)

    def gain(k, shape):
        return 1.0 + 0.02 * jax.random.normal(k, shape, f32)

    return {
        "x": jax.random.normal(ks[0], (BATCH, SEQ, D_MODEL), f32),
        "mem": jax.random.normal(ks[1], (BATCH, N_MEM, D_MODEL), f32),
        "w_in": nrm(ks[2], (DEPTH, D_MODEL, D_IN), D_MODEL),
        "w_a2": nrm(ks[3], (DEPTH, GATE_RANK, D_QK), GATE_RANK),
        "b_a": 1.0 + 0.5 * jax.random.normal(ks[4], (DEPTH, D_QK), f32),
        "gla_norm_g": gain(ks[5], (DEPTH, D_GLA)),
        "w_s": nrm(ks[6], (DEPTH, SGU_GROUPS, SGU_BLOCK, SGU_BLOCK), SGU_BLOCK),
        "b_s": gain(ks[7], (DEPTH, SGU_GROUPS, SGU_BLOCK)),
        "sgu_ln_g": gain(ks[8], (DEPTH, D_SGU)),
        "sgu_ln_b": 0.02 * jax.random.normal(ks[9], (DEPTH, D_SGU), f32),
        "w_out": nrm(ks[10], (DEPTH, D_MIX, D_MODEL), D_MIX, DN_BETA),
        "wq_x": nrm(ks[11], (DEPTH, D_MODEL, D_MODEL), D_MODEL),
        "wk_x": nrm(ks[12], (DEPTH, D_MODEL, D_MODEL), D_MODEL),
        "wv_x": nrm(ks[13], (DEPTH, D_MODEL, D_MODEL), D_MODEL),
        "wo_x": nrm(ks[14], (DEPTH, D_MODEL, D_MODEL), D_MODEL, DN_BETA),
        "w_router": nrm(ks[15], (D_MODEL, N_EXPERTS), D_MODEL),
        "b_router": 0.01 * jax.random.normal(ks[16], (N_EXPERTS,), f32),
        "w_gate": nrm(ks[17], (DEPTH, N_EXPERTS, D_MODEL, D_EXPERT), D_MODEL),
        "w_up": nrm(ks[18], (DEPTH, N_EXPERTS, D_MODEL, D_EXPERT), D_MODEL),
        "w_down": nrm(ks[19], (DEPTH, N_EXPERTS, D_EXPERT, D_MODEL), D_EXPERT, DN_BETA),
        "ln_g": gain(ks[20], (DEPTH, 3, D_MODEL)),
        "ln_b": 0.02 * jax.random.normal(ks[21], (DEPTH, 3, D_MODEL), f32),
    }


def reference(x, mem, w_in, w_a2, b_a, gla_norm_g, w_s, b_s, sgu_ln_g, sgu_ln_b, w_out,
              wq_x, wk_x, wv_x, wo_x, w_router, b_router, w_gate, w_up, w_down, ln_g, ln_b):
    for l in range(DEPTH):
        q, k, v, r, a_low, u, v_sgu = split_proj(x @ w_in[l])
        y_gla = gla_group(q, k, v, r, a_low, w_a2[l], b_a[l], gla_norm_g[l])
        y_sgu = sgu_group(u, v_sgu, w_s[l], b_s[l], sgu_ln_g[l], sgu_ln_b[l])
        h = jnp.concatenate([y_gla, y_sgu], axis=-1) @ w_out[l]
        x = layer_norm(DN_ALPHA * x + h, ln_g[l, 0], ln_b[l, 0])
        h = mem_xattn(x, mem, wq_x[l], wk_x[l], wv_x[l], wo_x[l])
        x = layer_norm(DN_ALPHA * x + h, ln_g[l, 1], ln_b[l, 1])
        h = grouped_moe(x, w_router, b_router, w_gate[l], w_up[l], w_down[l])
        x = layer_norm(DN_ALPHA * x + h, ln_g[l, 2], ln_b[l, 2])
    return x
```

```cpp
#include <hip/hip_runtime.h>
#include <cstdio>
#include <cstdint>

namespace pg8 {
#define PG8_LAS __attribute__((address_space(3)))
typedef unsigned short bf16_t;
typedef short bf16x8 __attribute__((ext_vector_type(8)));
typedef float f32x4 __attribute__((ext_vector_type(4)));
typedef unsigned u32x4 __attribute__((ext_vector_type(4)));
typedef unsigned u32x2 __attribute__((ext_vector_type(2)));
constexpr int BM = 256, BK = 64, HALF = 128, HTB = HALF * BK * 2  , STAGE_BYTES = 8 * HTB, NXCD = 8, WGM = 8;

__host__ __device__ __forceinline__ int lds_byte(int r, int c) { const int st = (r >> 4) * 2 + (c >> 5), rr = r & 15, cc = c & 31, ob = rr * 64 + cc * 2; return st * 1024 + (ob ^ (((ob >> 9) & 1) << 5)); }
__host__ __device__ __forceinline__ void stage_rc(int b, int& R, int& C) { const int st = b / 1024, sb = b % 1024, swz = sb ^ (((sb >> 9) & 1) << 5); R = (st >> 1) * 16 + swz / 64; C = (st & 1) * 32 + (swz % 64) / 2; }
__host__ __device__ __forceinline__ int perm32(int rho) { const int n = rho >> 4, i = rho & 15; return 8 * (i >> 2) + 4 * n + (i & 3); }

struct Unit { int pm, pn; };
struct Gemm { const bf16_t* A; const bf16_t* Bt; int M, N, K; int wv; };
__device__ __forceinline__ int lane_id() { int l; asm volatile("v_mbcnt_lo_u32_b32 %0, -1, 0\n\tv_mbcnt_hi_u32_b32 %0, -1, %0" : "=v"(l)); return l; }

struct StaticOrder {
    static constexpr bool GATHER = false;
    int nM, nN, nwg, G, c; const int* src = nullptr;
    __host__ __device__ void init(int M, int N, int G_, int c_) { nM = M / BM; nN = N / BM; nwg = nM * nN; G = G_; c = c_; }
    __host__ __device__ bool next(int i, Unit& u) const {
        const long L = (long)i * G + c; if (L >= nwg) return false;
        int wgid = (int)L; { const int q = nwg / NXCD, r = nwg % NXCD, xcd = wgid % NXCD, off = wgid / NXCD; wgid = (xcd < r ? xcd * (q + 1) : r * (q + 1) + (xcd - r) * q) + off; }
        const int nig = WGM * nN, gid = wgid / nig, fm = gid * WGM, gsz = (nM - fm) < WGM ? (nM - fm) : WGM;
        u.pm = fm + ((wgid % nig) % gsz); u.pn = (wgid % nig) / gsz; return true;
    }
    __device__ __forceinline__ void a_ready(const Unit&) const {}
    __device__ __forceinline__ void done(const Unit&) const {}
};
struct PanelOrder {
    static constexpr bool GATHER = false;
    int nN, npan, G, c; const int* src = nullptr;
    __device__ __forceinline__ bool next(int i, Unit& u) const { const int p = c + (i / nN) * G; if (p >= npan) return false; u.pm = p; u.pn = (i + (c >> 3)) % nN; return true; }
    __device__ __forceinline__ void a_ready(const Unit&) const {}
    __device__ __forceinline__ void done(const Unit&) const {}
};
template <bool GATH_> struct MoeOrderT {
    static constexpr bool GATHER = GATH_;
    const PG8_LAS int* tile_e; int nunits, G, c; const int* src = nullptr;
    __device__ __forceinline__ bool next(int i, Unit& u) const {
        const int cc = ((G & 7) == 0) ? (c & 7) * (G >> 3) + (c >> 3) : c;
        const int L = i * G + cc; if (L >= nunits) return false;
        u.pm = L >> 2; u.pn = tile_e[L >> 2] * 4 + (L & 3); return true;
    }
    __device__ __forceinline__ void a_ready(const Unit&) const {}
    __device__ __forceinline__ void done(const Unit&) const {}
};
typedef MoeOrderT<false> MoeOrder; typedef MoeOrderT<true> MoeGatherOrder;

typedef float f32x2_t __attribute__((ext_vector_type(2))); typedef __bf16 bf16x2_t __attribute__((ext_vector_type(2)));
typedef __amdgpu_buffer_rsrc_t rsrc_t;
__device__ __forceinline__ rsrc_t mk_rsrc(const void* p) { return __builtin_amdgcn_make_buffer_rsrc((void*)p, 0, 0x7fffffff, 0x00020000); }
__device__ __forceinline__ u32x4 bld4(rsrc_t r, unsigned voff, unsigned soff) { return __builtin_bit_cast(u32x4, __builtin_amdgcn_raw_buffer_load_b128(r, voff, soff, 0)); }
__device__ __forceinline__ f32x2_t bld2f(rsrc_t r, unsigned voff, unsigned soff) { return __builtin_bit_cast(f32x2_t, __builtin_amdgcn_raw_buffer_load_b64(r, voff, soff, 0)); }
#define GST4(p) (*(__attribute__((address_space(1))) u32x4*)(p))
__device__ __forceinline__ unsigned pk2(float lo, float hi) { f32x2_t v = {lo, hi}; bf16x2_t b = __builtin_convertvector(v, bf16x2_t); return __builtin_bit_cast(unsigned, b); }
__device__ __forceinline__ float bflo(unsigned w) { return __builtin_bit_cast(float, w << 16); }
__device__ __forceinline__ float bfhi(unsigned w) { return __builtin_bit_cast(float, w & 0xffff0000u); }
__device__ __forceinline__ float f_silu(float x) { return x * __builtin_amdgcn_rcpf(1.0f + __builtin_amdgcn_exp2f(-1.4426950408889634f * x)); }
__device__ __forceinline__ float f_gelu_tanh(float x) { return x * __builtin_amdgcn_rcpf(1.0f + __builtin_amdgcn_exp2f(x * (-2.3022082f - 0.10294324f * x * x))); }
__device__ __forceinline__ float f_logsig16(float z) { const float t = __builtin_amdgcn_exp2f(-1.4426950408889634f * __builtin_fabsf(z)); return (__builtin_fminf(z, 0.0f) - 0.6931471805599453f * __builtin_amdgcn_logf(1.0f + t)) * 0.0625f; }

struct EpiPlain {
    static constexpr bool PERM = true, AFTER_DRAIN = false;
    bf16_t* O; int ldc; int cmask;
    __device__ __forceinline__ void operator()(const f32x4 (&acc)[2][2][4][2], const Unit& u, int wr, int wc, int fr, int fq) const {
        const int row0 = u.pm * BM + wr * 64 + fr, col0 = (u.pn & cmask) * BM + wc * 32 + 8 * fq;
#pragma unroll
        for (int ai = 0; ai < 2; ++ai)
#pragma unroll
            for (int m = 0; m < 4; ++m) { bf16_t* rowp = O + (size_t)(row0 + ai * HALF + m * 16) * ldc + col0;
#pragma unroll
                for (int bj = 0; bj < 2; ++bj) { const f32x4 v0 = acc[ai][bj][m][0], v1 = acc[ai][bj][m][1];
                    u32x4 w; w.x = pk2(v0[0], v0[1]); w.y = pk2(v0[2], v0[3]); w.z = pk2(v1[0], v1[1]); w.w = pk2(v1[2], v1[3]);
                    *(u32x4*)(rowp + bj * HALF) = w; } }
    }
};
struct EpiQFrag {
    static constexpr bool PERM = true, AFTER_DRAIN = false;
    bf16_t* O;
    __device__ __forceinline__ void operator()(const f32x4 (&acc)[2][2][4][2], const Unit& u, int wr, int wc, int fr, int fq) const {
        unsigned lo = (unsigned)(((fq >> 1) * 64 + fr + 32 * (fq & 1)) * 16); asm volatile("" : "+v"(lo));
        char* tile = (char*)(O + (size_t)(u.pm * 4 + u.pn) * 65536) + (size_t)(wr * 2 * 16 + wc * 2) * 1024 + lo;
#pragma unroll
        for (int ai = 0; ai < 2; ++ai)
#pragma unroll
            for (int m = 0; m < 4; ++m)
#pragma unroll
                for (int bj = 0; bj < 2; ++bj) { const f32x4 v0 = acc[ai][bj][m][0], v1 = acc[ai][bj][m][1];
                    u32x4 w; w.x = pk2(v0[0], v0[1]); w.y = pk2(v0[2], v0[3]); w.z = pk2(v1[0], v1[1]); w.w = pk2(v1[2], v1[3]);
                    *(u32x4*)(tile + ((4 * ai + (m >> 1)) * 16 + 8 * bj) * 1024 + (m & 1) * 256) = w; }
    }
};
struct EpiInProj {
    static constexpr bool PERM = true, AFTER_DRAIN = false;
    bf16_t* O; const float* b_a;
    template <int MODE> __device__ __forceinline__ void tile(const f32x4 (&acc)[2][2][4][2], const Unit& u, int wr, int wc, int fr, int fq) const {
        const int row0 = u.pm * BM + wr * 64 + fr, col0 = u.pn * BM + wc * 32 + 8 * fq;
        f32x4 bv[2][2];
#pragma unroll
        for (int bj = 0; bj < 2; ++bj)
#pragma unroll
            for (int n = 0; n < 2; ++n) bv[bj][n] = (MODE == 2) ? *(const f32x4*)(b_a + (col0 - 1536) + bj * HALF + 4 * n) : (f32x4){0.f, 0.f, 0.f, 0.f};
#pragma unroll
        for (int ai = 0; ai < 2; ++ai)
#pragma unroll
            for (int m = 0; m < 4; ++m) { bf16_t* rowp = O + (size_t)(row0 + ai * HALF + m * 16) * 2816 + col0;
#pragma unroll
                for (int bj = 0; bj < 2; ++bj) { f32x4 v0 = acc[ai][bj][m][0], v1 = acc[ai][bj][m][1];
#pragma unroll
                    for (int j = 0; j < 4; ++j) {
                        if (MODE == 1) { v0[j] = f_silu(v0[j]); v1[j] = f_silu(v1[j]); }
                        if (MODE == 2) { v0[j] = f_logsig16(v0[j] + bv[bj][0][j]); v1[j] = f_logsig16(v1[j] + bv[bj][1][j]); }
                        if (MODE == 3) { v0[j] = f_gelu_tanh(v0[j]); v1[j] = f_gelu_tanh(v1[j]); } }
                    u32x4 w; w.x = pk2(v0[0], v0[1]); w.y = pk2(v0[2], v0[3]); w.z = pk2(v1[0], v1[1]); w.w = pk2(v1[2], v1[3]);
                    *(u32x4*)(rowp + bj * HALF) = w; } }
    }
    __device__ __forceinline__ void operator()(const f32x4 (&acc)[2][2][4][2], const Unit& u, int wr, int wc, int fr, int fq) const {
        const int pn = u.pn;
        if (pn < 4) tile<0>(acc, u, wr, wc, fr, fq); else if (pn < 6) tile<1>(acc, u, wr, wc, fr, fq); else if (pn == 6) tile<2>(acc, u, wr, wc, fr, fq); else tile<3>(acc, u, wr, wc, fr, fq);
    }
};
struct EpiResid {
    static constexpr bool PERM = true, AFTER_DRAIN = false;
    const bf16_t* X; bf16_t* Z; float alpha;
    __device__ __forceinline__ void operator()(const f32x4 (&acc)[2][2][4][2], const Unit& u, int wr, int wc, int fr, int fq) const {
        const int row0 = u.pm * BM + wr * 64 + fr, col0 = u.pn * BM + wc * 32 + 8 * fq;
#pragma unroll
        for (int ai = 0; ai < 2; ++ai)
#pragma unroll
            for (int m = 0; m < 4; ++m) { const size_t off = (size_t)(row0 + ai * HALF + m * 16) * 1024 + col0;
#pragma unroll
                for (int bj = 0; bj < 2; ++bj) { const f32x4 v0 = acc[ai][bj][m][0], v1 = acc[ai][bj][m][1];
                    const u32x4 xr = *(const u32x4*)(X + off + bj * HALF);
                    u32x4 w; w.x = pk2(alpha * bflo(xr.x) + v0[0], alpha * bfhi(xr.x) + v0[1]); w.y = pk2(alpha * bflo(xr.y) + v0[2], alpha * bfhi(xr.y) + v0[3]);
                    w.z = pk2(alpha * bflo(xr.z) + v1[0], alpha * bfhi(xr.z) + v1[1]); w.w = pk2(alpha * bflo(xr.w) + v1[2], alpha * bfhi(xr.w) + v1[3]);
                    *(u32x4*)(Z + off + bj * HALF) = w; } }
    }
};
struct EpiResidStats {
    static constexpr bool PERM = true, AFTER_DRAIN = false;
    const bf16_t* X; bf16_t* Z; f32x2_t* part; static constexpr float alpha = 1.4142135623730951f;
    __device__ __forceinline__ void operator()(const f32x4 (&acc)[2][2][4][2], const Unit& u, int wr, int wc, int fr, int fq) const {
        const int row0 = u.pm * BM + wr * 64 + fr, col0 = u.pn * BM + wc * 32 + 8 * fq;
        int ln = 16 * fq + fr; asm volatile("" : "+v"(ln));
        float s1[8], s2[8];
        const rsrc_t rx = mk_rsrc(X); const unsigned voff = ((unsigned)row0 * 1024u + (unsigned)col0) * 2u;
        u32x4 xres[2][4][2];
#pragma unroll
        for (int ai = 0; ai < 2; ++ai)
#pragma unroll
            for (int m = 0; m < 4; ++m)
#pragma unroll
                for (int bj = 0; bj < 2; ++bj) xres[ai][m][bj] = bld4(rx, voff, (unsigned)(((ai * HALF + m * 16) * 1024 + bj * HALF) * 2));
        __builtin_amdgcn_sched_barrier(0);
#pragma unroll
        for (int ai = 0; ai < 2; ++ai)
#pragma unroll
            for (int m = 0; m < 4; ++m) { const size_t off = (size_t)(row0 + ai * HALF + m * 16) * 1024 + col0; float a1 = 0.f, a2 = 0.f;
#pragma unroll
                for (int bj = 0; bj < 2; ++bj) { const f32x4 v0 = acc[ai][bj][m][0], v1 = acc[ai][bj][m][1];
                    const u32x4 xr = xres[ai][m][bj];
                    u32x4 w; w.x = pk2(alpha * bflo(xr.x) + v0[0], alpha * bfhi(xr.x) + v0[1]); w.y = pk2(alpha * bflo(xr.y) + v0[2], alpha * bfhi(xr.y) + v0[3]);
                    w.z = pk2(alpha * bflo(xr.z) + v1[0], alpha * bfhi(xr.z) + v1[1]); w.w = pk2(alpha * bflo(xr.w) + v1[2], alpha * bfhi(xr.w) + v1[3]);
                    GST4(Z + off + bj * HALF) = w;
                    const float z0 = bflo(w.x), z1 = bfhi(w.x), z2 = bflo(w.y), z3 = bfhi(w.y), z4 = bflo(w.z), z5 = bfhi(w.z), z6 = bflo(w.w), z7 = bfhi(w.w);
                    a1 += ((z0 + z1) + (z2 + z3)) + ((z4 + z5) + (z6 + z7)); a2 += ((z0 * z0 + z1 * z1) + (z2 * z2 + z3 * z3)) + ((z4 * z4 + z5 * z5) + (z6 * z6 + z7 * z7)); }
                s1[ai * 4 + m] = a1; s2[ai * 4 + m] = a2; }
        const bool h5 = (ln & 32) != 0, h4 = (ln & 16) != 0;
        float t1[4], t2[4];
#pragma unroll
        for (int i = 0; i < 4; ++i) { const float m1 = h5 ? s1[4 + i] : s1[i], g1 = h5 ? s1[i] : s1[4 + i], m2 = h5 ? s2[4 + i] : s2[i], g2 = h5 ? s2[i] : s2[4 + i];
            t1[i] = m1 + __builtin_bit_cast(float, __builtin_amdgcn_ds_bpermute((ln ^ 32) << 2, __builtin_bit_cast(int, g1)));
            t2[i] = m2 + __builtin_bit_cast(float, __builtin_amdgcn_ds_bpermute((ln ^ 32) << 2, __builtin_bit_cast(int, g2))); }
        float r1[2], r2[2];
#pragma unroll
        for (int i = 0; i < 2; ++i) { const float m1 = h4 ? t1[2 + i] : t1[i], g1 = h4 ? t1[i] : t1[2 + i], m2 = h4 ? t2[2 + i] : t2[i], g2 = h4 ? t2[i] : t2[2 + i];
            r1[i] = m1 + __builtin_bit_cast(float, __builtin_amdgcn_ds_bpermute((ln ^ 16) << 2, __builtin_bit_cast(int, g1)));
            r2[i] = m2 + __builtin_bit_cast(float, __builtin_amdgcn_ds_bpermute((ln ^ 16) << 2, __builtin_bit_cast(int, g2))); }
#pragma unroll
        for (int i = 0; i < 2; ++i) { const int gi = (h5 ? 4 : 0) + (h4 ? 2 : 0) + i, row = row0 + (gi >> 2) * HALF + (gi & 3) * 16;
            part[(size_t)row * 16 + u.pn * 4 + wc] = (f32x2_t){r1[i], r2[i]}; }
    }
};
struct EpiQFragLN {
    static constexpr bool PERM = true, AFTER_DRAIN = false;
    bf16_t* O; const f32x2_t* stats; const float* csum; const float* bq;
    __device__ __forceinline__ void operator()(const f32x4 (&acc)[2][2][4][2], const Unit& u, int wr, int wc, int fr, int fq) const {
        unsigned lo = (unsigned)(((fq >> 1) * 64 + fr + 32 * (fq & 1)) * 16); asm volatile("" : "+v"(lo));
        char* tile = (char*)(O + (size_t)(u.pm * 4 + u.pn) * 65536) + (size_t)(wr * 2 * 16 + wc * 2) * 1024 + lo;
        const int row0 = u.pm * BM + wr * 64 + fr, col0 = u.pn * BM + wc * 32 + 8 * fq;
#pragma unroll
        for (int bj = 0; bj < 2; ++bj) { const f32x4 c0 = *(const f32x4*)(csum + col0 + bj * HALF), c1 = *(const f32x4*)(csum + col0 + bj * HALF + 4), b0 = *(const f32x4*)(bq + col0 + bj * HALF), b1 = *(const f32x4*)(bq + col0 + bj * HALF + 4);
#pragma unroll
            for (int ai = 0; ai < 2; ++ai)
#pragma unroll
                for (int m = 0; m < 4; ++m) { const f32x2_t st = stats[row0 + ai * HALF + m * 16]; const float mu = st[0], rs = st[1];
                    const f32x4 v0 = (acc[ai][bj][m][0] - mu * c0) * rs + b0, v1 = (acc[ai][bj][m][1] - mu * c1) * rs + b1;
                    u32x4 w; w.x = pk2(v0[0], v0[1]); w.y = pk2(v0[2], v0[3]); w.z = pk2(v1[0], v1[1]); w.w = pk2(v1[2], v1[3]);
                    *(u32x4*)(tile + ((4 * ai + (m >> 1)) * 16 + 8 * bj) * 1024 + (m & 1) * 256) = w; } }
    }
};
struct EpiResidLN {
    static constexpr bool PERM = true, AFTER_DRAIN = false;
    bf16_t* Z; const f32x2_t* stats; const float* gain; const float* bias; static constexpr float alpha = 1.4142135623730951f;
    __device__ __forceinline__ void operator()(const f32x4 (&acc)[2][2][4][2], const Unit& u, int wr, int wc, int fr, int fq) const {
        const int row0 = u.pm * BM + wr * 64 + fr, col0 = u.pn * BM + wc * 32 + 8 * fq;
        const rsrc_t rz = mk_rsrc(Z), rs = mk_rsrc(stats); const unsigned voff = ((unsigned)row0 * 1024u + (unsigned)col0) * 2u;
        f32x2_t st[2][4];
#pragma unroll
        for (int ai = 0; ai < 2; ++ai)
#pragma unroll
            for (int m = 0; m < 4; ++m) st[ai][m] = bld2f(rs, (unsigned)row0 * 8u, (unsigned)((ai * HALF + m * 16) * 8));
#pragma unroll
        for (int bj = 0; bj < 2; ++bj) {
            u32x4 zres[2][4];
#pragma unroll
            for (int ai = 0; ai < 2; ++ai)
#pragma unroll
                for (int m = 0; m < 4; ++m) zres[ai][m] = bld4(rz, voff, (unsigned)(((ai * HALF + m * 16) * 1024 + bj * HALF) * 2));
            const f32x4 g0 = *(const f32x4*)(gain + col0 + bj * HALF) * alpha, g1 = *(const f32x4*)(gain + col0 + bj * HALF + 4) * alpha, b0 = *(const f32x4*)(bias + col0 + bj * HALF) * alpha, b1 = *(const f32x4*)(bias + col0 + bj * HALF + 4) * alpha;
            __builtin_amdgcn_sched_barrier(0);
#pragma unroll
            for (int ai = 0; ai < 2; ++ai)
#pragma unroll
                for (int m = 0; m < 4; ++m) { const int row = row0 + ai * HALF + m * 16; const float mu = st[ai][m][0], rsd = st[ai][m][1];
                    const u32x4 zr = zres[ai][m];
                    const f32x4 z0 = (f32x4){bflo(zr.x), bfhi(zr.x), bflo(zr.y), bfhi(zr.y)}, z1 = (f32x4){bflo(zr.z), bfhi(zr.z), bflo(zr.w), bfhi(zr.w)};
                    const f32x4 v0 = (z0 - mu) * rsd * g0 + b0 + acc[ai][bj][m][0], v1 = (z1 - mu) * rsd * g1 + b1 + acc[ai][bj][m][1];
                    u32x4 w; w.x = pk2(v0[0], v0[1]); w.y = pk2(v0[2], v0[3]); w.z = pk2(v1[0], v1[1]); w.w = pk2(v1[2], v1[3]);
                    GST4(Z + (size_t)row * 1024 + col0 + bj * HALF) = w; } }
    }
};
struct EpiGU {
    static constexpr bool PERM = true, AFTER_DRAIN = false;
    bf16_t* H;
    __device__ __forceinline__ void operator()(const f32x4 (&acc)[2][2][4][2], const Unit& u, int wr, int wc, int fr, int fq) const {
        const int row0 = u.pm * BM + wr * 64 + fr, col0 = (u.pn & 3) * 128 + wc * 16 + 4 * fq;
#pragma unroll
        for (int ai = 0; ai < 2; ++ai)
#pragma unroll
            for (int m = 0; m < 4; ++m) { bf16_t* rowp = H + (size_t)(row0 + ai * HALF + m * 16) * 512 + col0;
#pragma unroll
                for (int bj = 0; bj < 2; ++bj) { const f32x4 g = acc[ai][bj][m][0], up = acc[ai][bj][m][1];
                    u32x2 w; w.x = pk2(f_silu(g[0]) * up[0], f_silu(g[1]) * up[1]); w.y = pk2(f_silu(g[2]) * up[2], f_silu(g[3]) * up[3]);
                    *(u32x2*)(rowp + bj * 64) = w; } }
    }
};

template <class Epi, class Sched, bool ALIGN_EPI = false, bool SP2 = false>
__device__ __forceinline__ void gemm_phase(PG8_LAS unsigned char* lds, const Gemm g, const Sched& S, const Epi& E) {
    int tid_ = g.wv * 64 + lane_id(); asm volatile("" : "+v"(tid_));
    const int tid = tid_, wid = __builtin_amdgcn_readfirstlane(tid >> 6), lane = tid & 63, wr = wid >> 2, wc = wid & 3, fr = lane & 15, fq = lane >> 4;
    const int K = g.K, nt = K / BK;
    unsigned voffA[2], voffB[2];
#pragma unroll
    for (int i = 0; i < 2; ++i) { int R, C; stage_rc(tid * 16 + i * 8192, R, C); const int Rb = Epi::PERM ? ((R & ~31) + perm32(R & 31)) : R;
        voffA[i] = (unsigned)(R * K + C) * 2u;
        voffB[i] = (unsigned)(((Rb >> 4) * (K >> 5) + (C >> 5)) * 1024 + (Rb & 15) * 64 + (C & 31) * 2); }
    constexpr bool GATH = Sched::GATHER; static_assert(!GATH || SP2, "gather mode is written for the SP2 loop");
    int Rg[2] = {0, 0}; unsigned Cb[2] = {0u, 0u}; unsigned goc[2][2] = {{0u, 0u}, {0u, 0u}}, gon[2][2] = {{0u, 0u}, {0u, 0u}}, go2[2][2] = {{0u, 0u}, {0u, 0u}};
    if constexpr (GATH) {
#pragma unroll
        for (int i = 0; i < 2; ++i) { int R, C; stage_rc(tid * 16 + i * 8192, R, C); Rg[i] = R; Cb[i] = (unsigned)C * 2u; } }
#define PG8_GOFF(dst, U) do { _Pragma("unroll") for (int h_ = 0; h_ < 2; ++h_) _Pragma("unroll") for (int i_ = 0; i_ < 2; ++i_) \
        dst[h_][i_] = (unsigned)S.src[(U).pm * BM + h_ * HALF + Rg[i_]] * (unsigned)(K * 2) + Cb[i_]; } while (0)
    const size_t kstep = (size_t)(BK * 2);
    const size_t kstepB = 2048;
    const size_t hstep = (size_t)HALF * K * 2;
    const size_t tstep = 2 * hstep;
    const unsigned ldsw = (unsigned)wid * 1024u;
    const int aoff = lds_byte(wr * 64 + fr, fq * 8), boff = lds_byte(wc * 32 + fr, fq * 8);
#define PG8_SA(b, h) (((b) * 2 + (h)) * HTB)
#define PG8_SB(b, h) ((4 + (b) * 2 + (h)) * HTB)
#define PG8_STAGE(bufoff, gbase, voff) do { _Pragma("unroll") for (int _i = 0; _i < 2; ++_i) \
        __builtin_amdgcn_global_load_lds((const unsigned*)((const char*)(gbase) + (voff)[_i]), (PG8_LAS unsigned*)(lds + (bufoff) + ldsw + _i * 8192), 16, 0, 0); } while (0)
#define PG8_STAGE_A(b, h, PTR, KPTR, GO) do { if constexpr (GATH) { PG8_STAGE(PG8_SA(b, h), KPTR, GO); } else { PG8_STAGE(PG8_SA(b, h), PTR, voffA); } } while (0)
#define PG8_LDA(dst, b, h) do { _Pragma("unroll") for (int m = 0; m < 4; ++m) _Pragma("unroll") for (int k = 0; k < 2; ++k) dst[m][k] = *(const PG8_LAS bf16x8*)(lds + PG8_SA(b, h) + aoff + m * 2048 + k * 1024); } while (0)
#define PG8_LDB(dst, b, h) do { _Pragma("unroll") for (int n = 0; n < 2; ++n) _Pragma("unroll") for (int k = 0; k < 2; ++k) dst[n][k] = *(const PG8_LAS bf16x8*)(lds + PG8_SB(b, h) + boff + n * 2048 + k * 1024); } while (0)
#define PG8_MMA(ai, bj, At, Bt) do { __builtin_amdgcn_s_setprio(1); _Pragma("unroll") for (int m = 0; m < 4; ++m) _Pragma("unroll") for (int n = 0; n < 2; ++n) _Pragma("unroll") for (int k = 0; k < 2; ++k) \
        acc[ai][bj][m][n] = __builtin_amdgcn_mfma_f32_16x16x32_bf16(Bt[n][k], At[m][k], acc[ai][bj][m][n], 0, 0, 0); __builtin_amdgcn_s_setprio(0); } while (0)
#define PG8_WAIT_V(n) asm volatile("s_waitcnt vmcnt(" #n ")" ::: "memory")
#define PG8_WAIT_L(n) asm volatile("s_waitcnt lgkmcnt(" #n ")" ::: "memory")
#define PG8_BAR __builtin_amdgcn_s_barrier()
#define PG8_SCHED __builtin_amdgcn_sched_barrier(0)
    Unit cur, nxt; int ui = 0;
    if (!S.next(0, cur)) return;
    f32x4 acc[2][2][4][2];
#pragma unroll
    for (int a = 0; a < 2; ++a)
#pragma unroll
        for (int b = 0; b < 2; ++b)
#pragma unroll
            for (int m = 0; m < 4; ++m)
#pragma unroll
                for (int n = 0; n < 2; ++n) acc[a][b][m][n] = (f32x4){0.f, 0.f, 0.f, 0.f};
    bf16x8 At[4][2], B0[2][2], B1[2][2];
    const char* cA = (const char*)g.A + (size_t)cur.pm * tstep; const char* cB = (const char*)g.Bt + (size_t)cur.pn * tstep;
    S.a_ready(cur);
    const char* gA = (const char*)g.A;
    if constexpr (GATH) PG8_GOFF(goc, cur);
    if constexpr (SP2) {
        PG8_STAGE(PG8_SB(0, 0), cB, voffB); PG8_STAGE(PG8_SB(0, 1), cB + hstep, voffB); PG8_STAGE_A(0, 0, cA, gA, goc[0]); PG8_STAGE_A(0, 1, cA + hstep, gA, goc[1]);
        if (wr == 1) PG8_BAR;
        PG8_WAIT_V(2); PG8_BAR;
        PG8_STAGE(PG8_SB(1, 0), cB + kstepB, voffB); PG8_STAGE_A(1, 0, cA + kstep, gA + kstep, goc[0]); PG8_STAGE(PG8_SB(1, 1), cB + hstep + kstepB, voffB);
        PG8_WAIT_V(6); PG8_BAR;
    } else {
        PG8_STAGE(PG8_SB(0, 0), cB, voffB); PG8_STAGE(PG8_SA(0, 0), cA, voffA); PG8_STAGE(PG8_SB(0, 1), cB + hstep, voffB); PG8_STAGE(PG8_SA(0, 1), cA + hstep, voffA);
        if (wr == 1) PG8_BAR;
        PG8_WAIT_V(4); PG8_BAR;
        PG8_STAGE(PG8_SB(1, 0), cB + kstepB, voffB); PG8_STAGE(PG8_SA(1, 0), cA + kstep, voffA); PG8_STAGE(PG8_SB(1, 1), cB + hstep + kstepB, voffB);
        PG8_WAIT_V(6); PG8_BAR;
    }
    for (;;) {
        const bool has_next = S.next(ui + 1, nxt);
        if constexpr (GATH) { if (has_next) PG8_GOFF(gon, nxt); else { _Pragma("unroll") for (int h_ = 0; h_ < 2; ++h_) _Pragma("unroll") for (int i_ = 0; i_ < 2; ++i_) gon[h_][i_] = goc[h_][i_]; } }
        const char* nA = has_next ? (const char*)g.A + (size_t)nxt.pm * tstep : cA; const char* nB = has_next ? (const char*)g.Bt + (size_t)nxt.pn * tstep : cB;
        for (int t = 0; t < nt; t += 2) {
            const bool last = (t == nt - 2);
            const char* a1 = cA + (size_t)(t + 1) * kstep;
            const char* a2 = last ? nA : cA + (size_t)(t + 2) * kstep; const char* b2 = last ? nB : cB + (size_t)(t + 2) * kstepB;
            const char* a3 = a2 + kstep; const char* b3 = b2 + kstepB;
            if (last && has_next) S.a_ready(nxt);
            const char* ga1 = gA + (size_t)(t + 1) * kstep; const char* ga2 = last ? gA : gA + (size_t)(t + 2) * kstep; const char* ga3 = ga2 + kstep;
            if constexpr (GATH) { _Pragma("unroll") for (int h_ = 0; h_ < 2; ++h_) _Pragma("unroll") for (int i_ = 0; i_ < 2; ++i_) go2[h_][i_] = last ? gon[h_][i_] : goc[h_][i_]; }
            if constexpr (SP2) {
            PG8_LDB(B0, 0, 0); PG8_LDB(B1, 0, 1); PG8_SCHED; PG8_LDA(At, 0, 0); PG8_STAGE_A(1, 1, a1 + hstep, ga1, goc[1]);
            PG8_WAIT_V(8); PG8_WAIT_L(0); PG8_BAR; PG8_MMA(0, 0, At, B0); PG8_MMA(0, 1, At, B1); PG8_BAR; PG8_SCHED;
            PG8_LDA(At, 0, 1); PG8_STAGE(PG8_SB(0, 0), b2, voffB); PG8_STAGE(PG8_SB(0, 1), b2 + hstep, voffB); PG8_STAGE_A(0, 0, a2, ga2, go2[0]);
            PG8_WAIT_V(8); PG8_WAIT_L(0); PG8_BAR; PG8_MMA(1, 0, At, B0); PG8_MMA(1, 1, At, B1); PG8_BAR; PG8_SCHED;
            PG8_LDB(B0, 1, 0); PG8_LDB(B1, 1, 1); PG8_SCHED; PG8_LDA(At, 1, 0); PG8_STAGE_A(0, 1, a2 + hstep, ga2, go2[1]);
            PG8_WAIT_V(8); PG8_WAIT_L(0); PG8_BAR; PG8_MMA(0, 0, At, B0); PG8_MMA(0, 1, At, B1); PG8_BAR; PG8_SCHED;
            PG8_LDA(At, 1, 1); PG8_STAGE(PG8_SB(1, 0), b3, voffB); PG8_STAGE(PG8_SB(1, 1), b3 + hstep, voffB); PG8_STAGE_A(1, 0, a3, ga3, go2[0]);
            PG8_WAIT_V(8); PG8_WAIT_L(0); PG8_BAR; PG8_MMA(1, 0, At, B0); PG8_MMA(1, 1, At, B1); PG8_BAR; PG8_SCHED;
            } else {
            PG8_LDB(B0, 0, 0); PG8_SCHED; PG8_LDA(At, 0, 0); PG8_STAGE(PG8_SA(1, 1), a1 + hstep, voffA);
            PG8_WAIT_L(8); PG8_BAR; PG8_WAIT_L(0); PG8_MMA(0, 0, At, B0); PG8_BAR; PG8_SCHED;
            PG8_LDB(B1, 0, 1); PG8_STAGE(PG8_SB(0, 0), b2, voffB);
            PG8_BAR; PG8_WAIT_L(0); PG8_MMA(0, 1, At, B1); PG8_BAR;
            PG8_LDA(At, 0, 1); PG8_STAGE(PG8_SA(0, 0), a2, voffA);
            PG8_BAR; PG8_WAIT_L(0); PG8_MMA(1, 0, At, B0); PG8_BAR; PG8_SCHED;
            PG8_STAGE(PG8_SB(0, 1), b2 + hstep, voffB);
            PG8_WAIT_V(6); PG8_BAR; PG8_MMA(1, 1, At, B1); PG8_BAR;
            PG8_LDB(B0, 1, 0); PG8_SCHED; PG8_LDA(At, 1, 0); PG8_STAGE(PG8_SA(0, 1), a2 + hstep, voffA);
            PG8_WAIT_L(8); PG8_BAR; PG8_WAIT_L(0); PG8_MMA(0, 0, At, B0); PG8_BAR; PG8_SCHED;
            PG8_LDB(B1, 1, 1); PG8_STAGE(PG8_SB(1, 0), b3, voffB);
            PG8_BAR; PG8_WAIT_L(0); PG8_MMA(0, 1, At, B1); PG8_BAR;
            PG8_LDA(At, 1, 1); PG8_STAGE(PG8_SA(1, 0), a3, voffA);
            PG8_BAR; PG8_WAIT_L(0); PG8_MMA(1, 0, At, B0); PG8_BAR; PG8_SCHED;
            PG8_STAGE(PG8_SB(1, 1), b3 + hstep, voffB);
            PG8_WAIT_V(6); PG8_BAR; PG8_MMA(1, 1, At, B1); PG8_BAR;
            }
        }
        if constexpr (ALIGN_EPI) { if (wr == 0) PG8_BAR; }
        if constexpr (!Epi::AFTER_DRAIN) { E(acc, cur, wr, wc, fr, fq); S.done(cur); }
        if (!has_next) break;
#pragma unroll
        for (int a = 0; a < 2; ++a)
#pragma unroll
            for (int b = 0; b < 2; ++b)
#pragma unroll
                for (int m = 0; m < 4; ++m)
#pragma unroll
                    for (int n = 0; n < 2; ++n) acc[a][b][m][n] = (f32x4){0.f, 0.f, 0.f, 0.f};
        cur = nxt; cA = nA; cB = nB; ++ui;
        if constexpr (GATH) { _Pragma("unroll") for (int h_ = 0; h_ < 2; ++h_) _Pragma("unroll") for (int i_ = 0; i_ < 2; ++i_) goc[h_][i_] = gon[h_][i_]; }
        if constexpr (ALIGN_EPI) { if (wr == 1) PG8_BAR; }
    }
    PG8_WAIT_V(0);
    if constexpr (!ALIGN_EPI) { if (wr == 0) PG8_BAR; }
    PG8_BAR;
    if constexpr (Epi::AFTER_DRAIN) { E.fused(acc, cur, wr, wc, fr, fq, lds, wid, lane); S.done(cur); }
#undef PG8_SA
#undef PG8_SB
#undef PG8_STAGE
#undef PG8_STAGE_A
#undef PG8_GOFF
#undef PG8_LDA
#undef PG8_LDB
#undef PG8_MMA
#undef PG8_WAIT_V
#undef PG8_WAIT_L
#undef PG8_BAR
#undef PG8_SCHED
}}

namespace mk {
using pg8::bf16_t; using pg8::bf16x8; using pg8::f32x4; using pg8::u32x4; using pg8::u32x2; using pg8::pk2; using pg8::bflo; using pg8::bfhi;
typedef float f32x16 __attribute__((ext_vector_type(16)));
typedef short s16x4 __attribute__((ext_vector_type(4)));
typedef short v4i16_t __attribute__((ext_vector_type(4)));
#define LAS __attribute__((address_space(3)))
#define GAS __attribute__((address_space(1)))
typedef GAS unsigned gu32;
#define RLX_AGENT __ATOMIC_RELAXED, __HIP_MEMORY_SCOPE_AGENT
#define LDS_WAIT() asm volatile("s_waitcnt lgkmcnt(0)" ::: "memory")

constexpr int NB = 8, SEQ = 8192, M = NB * SEQ, D = 1024, NP = 2816, NMEM = 256, MKV = NB * NMEM;
constexpr int PQ = 0, PK = 256, PV = 512, PR = 1024, PG = 1536, PU = 1792, PVS = 2304;
constexpr int DIN = 2576;
constexpr int MOE_ROWS = 135168;
constexpr float ALPHA = 1.4142135623730951f, LN_EPS = 1e-5f, LOG2E = 1.4426950408889634f;
constexpr int NWAVES = 8, NTHR = 512;

constexpr size_t MiB = 1u << 20;
constexpr size_t WS_CTL = 0, CTL_ZERO_BYTES = 1 * MiB;
constexpr size_t WS_WM = 1 * MiB;
constexpr size_t WS_WGCNT = 1 * MiB + 512 * 1024;
constexpr size_t WS_LTOT = 1 * MiB + 768 * 1024;
constexpr size_t WS_TINFO = 2 * MiB;
constexpr size_t WS_TRANK = 3 * MiB;
constexpr size_t WS_TSLOT = 3 * MiB + 512 * 1024;
constexpr size_t WS_SEND = 4 * MiB;
constexpr size_t WS_WKV = 12 * MiB;
constexpr size_t WS_MEMB = 20 * MiB;
constexpr size_t WS_KV = 24 * MiB;
constexpr size_t WS_W = 40 * MiB, W_LAYER = 60 * MiB;
constexpr size_t W_IN = 0, W_OUT = (size_t)NP * D * 2, W_Q = W_OUT + 2 * MiB, W_O = W_Q + 2 * MiB, W_GU = W_O + 2 * MiB, W_D = W_GU + 32 * MiB;
static_assert(W_D + 16 * MiB <= W_LAYER, "weights per layer");
constexpr size_t WS_X = 160 * MiB;
constexpr size_t WS_R = 288 * MiB;
constexpr size_t R_P = 0, R_Y = 352 * MiB, R_Z = 480 * MiB, R_Q = 0, R_O = 128 * MiB, R_XS = 352 * MiB, R_H = 0;
constexpr size_t WS_SRCROW = WS_R + 616 * MiB;
constexpr size_t WS_PART = WS_SRCROW + 1 * MiB;
constexpr size_t WS_STATS = WS_PART + 8 * MiB;
constexpr size_t WS_CS = WS_STATS + 1 * MiB;
constexpr size_t WS_END = WS_CS + 1 * MiB;
static_assert(R_XS + (size_t)MOE_ROWS * D * 2 <= 616 * MiB && R_H + (size_t)MOE_ROWS * 512 * 2 <= R_XS, "moe buffers");
constexpr int CW_BAR = 4096;

constexpr int LDS_BYTES = 159744, LDSCTL_OFF = 155648;
constexpr int MISC_OFF = LDSCTL_OFF;
constexpr int TILEE_OFF = LDSCTL_OFF + 512;
static_assert(TILEE_OFF + 528 * 4 <= LDS_BYTES, "LDS map");

#define XB_TMO      128
#define XB_XCNT(j)  (256  + 64 * (j))
#define XB_XSUB(j)  (1280 + 64 * (j))
#define XB_XGEN(j)  (2304 + 64 * (j))
#define XB_TOP      3328
#define XB_TOPGEN   3392
#define XCD_BAR_WORDS 3456
#define XB_SPIN_CAP (1u << 18)

__device__ __forceinline__ unsigned xb_ld(unsigned* p)              { return __hip_atomic_load(p, __ATOMIC_RELAXED, __HIP_MEMORY_SCOPE_AGENT); }
__device__ __forceinline__ unsigned xb_add(unsigned* p, unsigned v) { return __hip_atomic_fetch_add(p, v, __ATOMIC_RELAXED, __HIP_MEMORY_SCOPE_AGENT); }
__device__ __forceinline__ unsigned xb_xcc_id() { return (unsigned)__builtin_amdgcn_s_getreg((3 << 11) | 20) & 0xFu; }
#define XB_SPIN(cond, bar) do { unsigned _sp = 0; while (cond) { __builtin_amdgcn_s_sleep(1); \
    if ((++_sp & 255u) == 0u) { if (xb_ld(&(bar)[XB_TMO])) break; if (_sp > XB_SPIN_CAP) { atomicAdd(&(bar)[XB_TMO], 1u); break; } } } } while (0)

struct XcdBarrier {
    unsigned* bar; unsigned x;
    volatile LAS unsigned* st;
    int wv;
};

__device__ __forceinline__ XcdBarrier xcd_barrier_post(unsigned* bar, volatile LAS unsigned* st) {
    XcdBarrier b; b.bar = bar; b.x = xb_xcc_id(); b.st = st; b.wv = 0;
    if (threadIdx.x == 0) (void)xb_add(&bar[XB_XCNT(b.x)], 1u);
    return b;
}
__device__ __forceinline__ void xcd_barrier_complete(unsigned* bar, unsigned x, unsigned& nloc, unsigned& nx) {
    const unsigned G = gridDim.x * gridDim.y * gridDim.z;
    unsigned sum, cnt, mine, sp = 0u;
    for (;;) {
        sum = 0u; cnt = 0u; mine = 0u;
#pragma unroll
        for (unsigned j = 0; j < 16; ++j) { const unsigned c = xb_ld(&bar[XB_XCNT(j)]); sum += c; cnt += (c > 0u) ? 1u : 0u; mine = (j == x) ? c : mine; }
        if (sum == G) break;
        __builtin_amdgcn_s_sleep(1);
        if ((++sp & 255u) == 0u) { if (xb_ld(&bar[XB_TMO])) break; if (sp > XB_SPIN_CAP) { atomicAdd(&bar[XB_TMO], 1u); break; } }
    }
    nloc = mine > 0u ? mine : 1u; nx = cnt > 0u ? cnt : 1u;
}

__device__ __forceinline__ void xcd_barrier(const XcdBarrier& b) {
    asm volatile("s_waitcnt vmcnt(0)" ::: "memory");
    __syncthreads();
    if (b.wv == 0 && pg8::lane_id() == 0) {
        unsigned* bar = b.bar;
        __builtin_amdgcn_s_waitcnt(0);
        unsigned nloc = b.st[0], nx = b.st[1];
        if (nloc == 0u) { xcd_barrier_complete(bar, b.x, nloc, nx); b.st[0] = nloc; b.st[1] = nx; }
        const unsigned old = xb_add(&bar[XB_XSUB(b.x)], 1u);
        const unsigned gen = old / nloc;
        if (old + 1u == (gen + 1u) * nloc) {
            __builtin_amdgcn_fence(__ATOMIC_RELEASE, "agent");
            asm volatile("s_waitcnt vmcnt(0)" ::: "memory");
            const unsigned og = xb_add(&bar[XB_TOP], 1u);
            const unsigned tg = og / nx;
            if (og + 1u == (tg + 1u) * nx) xb_add(&bar[XB_TOPGEN], 1u);
            else XB_SPIN(xb_ld(&bar[XB_TOPGEN]) == tg, bar);
            __builtin_amdgcn_fence(__ATOMIC_ACQUIRE, "agent");
            xb_add(&bar[XB_XGEN(b.x)], 1u);
            asm volatile("s_waitcnt vmcnt(0)" ::: "memory");
        } else {
            XB_SPIN(xb_ld(&bar[XB_XGEN(b.x)]) == gen, bar);
            __builtin_amdgcn_fence(__ATOMIC_ACQUIRE, "agent");
            asm volatile("s_waitcnt vmcnt(0)" ::: "memory");
        }
    }
    __syncthreads();
}
__device__ __forceinline__ float shx(float v, int m, int lane) { return __builtin_bit_cast(float, __builtin_amdgcn_ds_bpermute((lane ^ m) << 2, __builtin_bit_cast(int, v))); }
__device__ __forceinline__ int shxi(int v, int m, int lane) { return __builtin_amdgcn_ds_bpermute((lane ^ m) << 2, v); }
__device__ __forceinline__ s16x4 vtr(unsigned lds_addr) { return __builtin_bit_cast(s16x4, __builtin_amdgcn_ds_read_tr16_b64_v4i16((LAS v4i16_t*)(size_t)lds_addr)); }
__device__ __forceinline__ bf16x8 cat8(s16x4 lo, s16x4 hi) { return __builtin_shufflevector(lo, hi, 0, 1, 2, 3, 4, 5, 6, 7); }
__device__ __forceinline__ void unpack8(const u32x4 w, float (&f)[8]) { f[0] = bflo(w.x); f[1] = bfhi(w.x); f[2] = bflo(w.y); f[3] = bfhi(w.y); f[4] = bflo(w.z); f[5] = bfhi(w.z); f[6] = bflo(w.w); f[7] = bfhi(w.w); }
__device__ __forceinline__ u32x4 pack8(const float (&f)[8]) { u32x4 w; w.x = pk2(f[0], f[1]); w.y = pk2(f[2], f[3]); w.z = pk2(f[4], f[5]); w.w = pk2(f[6], f[7]); return w; }

struct Args {
    const float* in[22]; float* out; unsigned char* ws;
};

__device__ __forceinline__ void transpose_item(const float* p0, const float* p1, int ld, int mode, float scale, int K, int nblk, bf16_t* dst, int row0, LAS float* scr, int item, int lane, const float* kscale = nullptr) {
    const int kb = item / nblk, nb = item % nblk, k0 = 64 * kb, n0 = 32 * nb;
    const int np = n0 + (lane & 31);
    const float* sp; int col;
    if (mode == 0) { sp = p0; col = np; } else { sp = (np & 4) ? p1 : p0; col = (np >> 3) * 4 + (np & 3); }
    sp += (size_t)k0 * ld + col;
#pragma unroll 8
    for (int i = 0; i < 32; ++i) { const int kk = 2 * i + (lane >> 5); scr[kk * 33 + (lane & 31)] = sp[(size_t)kk * ld] * scale * (kscale ? kscale[k0 + kk] : 1.0f); }
    LDS_WAIT(); asm volatile("" ::: "memory");
    const int c = lane & 7;
#pragma unroll
    for (int j = 0; j < 4; ++j) { const int n = (lane >> 3) + 8 * j; const LAS float* s = scr + (8 * c) * 33 + n;
        u32x4 o; o.x = pk2(s[0 * 33], s[1 * 33]); o.y = pk2(s[2 * 33], s[3 * 33]); o.z = pk2(s[4 * 33], s[5 * 33]); o.w = pk2(s[6 * 33], s[7 * 33]);
        const int ng = row0 + n0 + n, kk = k0 + 8 * c;
        *(u32x4*)(dst + ((size_t)(ng >> 4) * (K >> 5) + (kk >> 5)) * 512 + (ng & 15) * 32 + (kk & 31)) = o; }
    LDS_WAIT(); asm volatile("" ::: "memory");
}
__device__ __forceinline__ void p0_convert(const Args& a, LAS unsigned char* lds, int bid, int G, int wave_s) {
    int tid_ = wave_s * 64 + pg8::lane_id(); asm volatile("" : "+v"(tid_)); const int tid = tid_, lane = tid & 63, wave = __builtin_amdgcn_readfirstlane(tid >> 6);
    unsigned char* ws = a.ws;
    LAS float* scr = (LAS float*)(lds + wave * 16384);
    const int gw = bid * NWAVES + wave, NGW = G * NWAVES;
    constexpr int I_INQ = 16 * 8, I_INB = 16 * 40, I_INC = 16 * 32, I_SQ = 16 * 32, I_GU = 16 * 16 * 32, I_DN = 16 * 8 * 32;
    constexpr int I_LAYER = I_INQ + I_INB + I_INC + 5 * I_SQ + I_GU + I_DN;
    for (int it = gw; it < 2 * I_LAYER; it += NGW) {
        const int l = it / I_LAYER; int r = it % I_LAYER;
        unsigned char* wl = ws + WS_W + (size_t)l * W_LAYER;
        const float* w_in = a.in[2] + (size_t)l * D * DIN;
        if (r < I_INQ) { transpose_item(w_in, nullptr, DIN, 0, 0.125f, D, 8, (bf16_t*)(wl + W_IN), 0, scr, r, lane); continue; } r -= I_INQ;
        if (r < I_INB) { transpose_item(w_in + 256, nullptr, DIN, 0, 1.0f, D, 40, (bf16_t*)(wl + W_IN), 256, scr, r, lane); continue; } r -= I_INB;
        if (r < I_INC) { transpose_item(w_in + 1552, nullptr, DIN, 0, 1.0f, D, 32, (bf16_t*)(wl + W_IN), 1792, scr, r, lane); continue; } r -= I_INC;
        if (r < I_SQ) { transpose_item(a.in[10] + (size_t)l * D * D, nullptr, D, 0, 1.0f, D, 32, (bf16_t*)(wl + W_OUT), 0, scr, r, lane); continue; } r -= I_SQ;
        if (r < I_SQ) { transpose_item(a.in[11] + (size_t)l * D * D, nullptr, D, 0, 0.0625f, D, 32, (bf16_t*)(wl + W_Q), 0, scr, r, lane, a.in[20] + (size_t)(l * 3 + 0) * D); continue; } r -= I_SQ;
        if (r < I_SQ) { transpose_item(a.in[14] + (size_t)l * D * D, nullptr, D, 0, 1.0f, D, 32, (bf16_t*)(wl + W_O), 0, scr, r, lane); continue; } r -= I_SQ;
        if (r < I_SQ) { transpose_item(a.in[12] + (size_t)l * D * D, nullptr, D, 0, 1.0f, D, 32, (bf16_t*)(ws + WS_WKV), l * 2048, scr, r, lane); continue; } r -= I_SQ;
        if (r < I_SQ) { transpose_item(a.in[13] + (size_t)l * D * D, nullptr, D, 0, 1.0f, D, 32, (bf16_t*)(ws + WS_WKV), l * 2048 + 1024, scr, r, lane); continue; } r -= I_SQ;
        if (r < I_GU) { const int e = r / 512, rr = r % 512; const size_t eo = ((size_t)l * 16 + e) * D * 512;
            transpose_item(a.in[17] + eo, a.in[18] + eo, 512, 1, 1.0f, D, 32, (bf16_t*)(wl + W_GU), e * 1024, scr, rr, lane); continue; } r -= I_GU;
        { const int e = r / 256, rr = r % 256; const size_t eo = ((size_t)l * 16 + e) * 512 * D;
            transpose_item(a.in[19] + eo, nullptr, D, 0, 1.0f, 512, 32, (bf16_t*)(wl + W_D), e * 1024, scr, rr, lane); }
    }
    const size_t gt = (size_t)bid * NTHR + tid, NT = (size_t)G * NTHR;
    for (int it = gw; it < 2 * 16 * 16; it += NGW) { const int l = it >> 8, kc = (it >> 4) & 15, n = (it & 15) * 64 + lane;
        const float* wq = a.in[11] + (size_t)l * D * D; const float* gg = a.in[20] + (size_t)(l * 3) * D; const float* bb = a.in[21] + (size_t)(l * 3) * D; float cs = 0.f, bq = 0.f;
#pragma unroll 8
        for (int k = 64 * kc; k < 64 * kc + 64; ++k) { const float w = wq[(size_t)k * D + n] * 0.0625f; cs += bflo(pk2(w * gg[k], 0.f) & 0xffffu); bq += w * bb[k]; }
        float* tb = (float*)(ws + WS_CS) + (size_t)l * 2 * 16 * 1024; tb[kc * 1024 + n] = cs; tb[16 * 1024 + kc * 1024 + n] = bq; }
    for (size_t i = gt; i < (size_t)2 * 256 * 128; i += NT) {
        const int l = (int)(i / (256 * 128)), r = (int)(i % (256 * 128)), j = r / 128, k8 = r % 128;
        const float* w_in = a.in[2] + (size_t)l * D * DIN; const float* w_a2 = a.in[3] + (size_t)l * 16 * 256;
        float wa[16];
#pragma unroll
        for (int q = 0; q < 16; ++q) wa[q] = w_a2[q * 256 + j];
        float o[8];
#pragma unroll
        for (int kk = 0; kk < 8; ++kk) { const float* wr = w_in + (size_t)(8 * k8 + kk) * DIN + 1536; float s = 0.f;
#pragma unroll
            for (int q = 0; q < 16; q += 4) { const f32x4 v = *(const f32x4*)(wr + q); s += v[0] * wa[q] + v[1] * wa[q + 1] + v[2] * wa[q + 2] + v[3] * wa[q + 3]; }
            o[kk] = s; }
        { const int ng = 1536 + j, kk = 8 * k8; *(u32x4*)((bf16_t*)(ws + WS_W + (size_t)l * W_LAYER + W_IN) + ((size_t)(ng >> 4) * (D >> 5) + (kk >> 5)) * 512 + (ng & 15) * 32 + (kk & 31)) = pack8(o); }
    }
    for (size_t i = gt; i < (size_t)2 * 4 * 128 * 16; i += NT) {
        const int s8 = (int)(i & 15), t = (int)((i >> 4) & 127);
        const float* src = a.in[6] + i * 8; float o[8];
#pragma unroll
        for (int q = 0; q < 8; ++q) o[q] = ((8 * s8 + q) / 64 <= t / 64) ? src[q] : 0.f;
        *(u32x4*)((bf16_t*)(ws + WS_WM) + i * 8) = pack8(o);
    }
    for (size_t i = gt; i < (size_t)M * D / 8; i += NT) {
        const f32x4 v0 = *(const f32x4*)(a.in[0] + i * 8), v1 = *(const f32x4*)(a.in[0] + i * 8 + 4);
        u32x4 w; w.x = pk2(v0[0], v0[1]); w.y = pk2(v0[2], v0[3]); w.z = pk2(v1[0], v1[1]); w.w = pk2(v1[2], v1[3]);
        *(u32x4*)((bf16_t*)(ws + WS_X) + i * 8) = w;
    }
    for (size_t i = gt; i < (size_t)MKV * D / 8; i += NT) {
        const f32x4 v0 = *(const f32x4*)(a.in[1] + i * 8), v1 = *(const f32x4*)(a.in[1] + i * 8 + 4);
        u32x4 w; w.x = pk2(v0[0], v0[1]); w.y = pk2(v0[2], v0[3]); w.z = pk2(v1[0], v1[1]); w.w = pk2(v1[2], v1[3]);
        *(u32x4*)((bf16_t*)(ws + WS_MEMB) + i * 8) = w;
    }
}

constexpr int GL_KD = 0, GL_QS = 9216, GL_VS = 18432, GL_PSUM = 35840, GL_DL = 37888, GL_SSQ = 38144;
template <bool FINAL>
__device__ __forceinline__ void gla_phase(LAS unsigned char* lds, const bf16_t* P, float* Send, float* Ltot, bf16_t* Y, const float* gn_g, int bid, int G, int wave_s) {
    int tid_ = wave_s * 64 + pg8::lane_id(); asm volatile("" : "+v"(tid_)); const int tid = tid_, lane = tid & 63, wave = __builtin_amdgcn_readfirstlane(tid >> 6);
    const unsigned lb = (unsigned)(size_t)lds;
    const int g = lane >> 4, l15 = lane & 15, q4 = l15 >> 2, p4 = lane & 3;
    const int kq = tid & 63, part = wave;
    for (int item = bid; item < 256; item += G) {
        const int b = item >> 5, h = (item >> 3) & 3, run = item & 7, bh = item >> 3;
        f32x4 sacc[4];
#pragma unroll
        for (int kt = 0; kt < 4; ++kt) sacc[kt] = (f32x4){0.f, 0.f, 0.f, 0.f};
        if (FINAL) {
            for (int i = 0; i < run; ++i) {
                const float* se = Send + ((size_t)(bh * 8 + i) * 64) * 128; const float* lt = Ltot + (size_t)(bh * 8 + i) * 64;
#pragma unroll
                for (int kt = 0; kt < 4; ++kt)
#pragma unroll
                    for (int r = 0; r < 4; ++r) { const int k = 16 * kt + 4 * g + r; sacc[kt][r] = __expf(lt[k]) * sacc[kt][r] + se[(size_t)k * 128 + 16 * wave + l15]; }
            }
        }
        float ltot_acc = 0.f;
        unsigned short graw[8], kraw[8]; u32x4 vraw[2], qraw; u32x2 rraw[4];
        const int v_row = tid >> 4, v_c16 = tid & 15, q_row = tid >> 3, q_c16 = tid & 7;
        const int ycol = h * 128 + 16 * wave + 4 * g;
#define GLA_FETCH(CC) do { const size_t tf_ = (size_t)b * SEQ + (size_t)(run * 16 + (CC)) * 64; \
            _Pragma("unroll") for (int i = 0; i < 8; ++i) { const bf16_t* rp = P + (tf_ + 8 * part + i) * NP + h * 64 + kq; graw[i] = rp[PG]; kraw[i] = rp[PK]; } \
            _Pragma("unroll") for (int i = 0; i < 2; ++i) vraw[i] = *(const u32x4*)(P + (tf_ + v_row + 32 * i) * NP + PV + h * 128 + v_c16 * 8); \
            if (FINAL) { qraw = *(const u32x4*)(P + (tf_ + q_row) * NP + PQ + h * 64 + q_c16 * 8); \
                _Pragma("unroll") for (int tt = 0; tt < 4; ++tt) rraw[tt] = *(const u32x2*)(P + (tf_ + 16 * tt + l15) * NP + PR + ycol); } } while (0)
        GLA_FETCH(0);
        for (int c = 0; c < 16; ++c) {
            const size_t t0 = (size_t)b * SEQ + (size_t)(run * 16 + c) * 64;
            __syncthreads();
            float gv[8], kv[8];
#pragma unroll
            for (int i = 0; i < 8; ++i) { gv[i] = __builtin_bit_cast(float, (unsigned)graw[i] << 16); kv[i] = __builtin_bit_cast(float, (unsigned)kraw[i] << 16); }
#pragma unroll
            for (int i = 1; i < 8; ++i) gv[i] += gv[i - 1];
            ((LAS float*)(lds + GL_PSUM))[part * 64 + kq] = gv[7];
#pragma unroll
            for (int i = 0; i < 2; ++i) *(LAS u32x4*)(lds + GL_VS + (v_row + 32 * i) * 272 + v_c16 * 16) = vraw[i];
            u32x2 rcur[4];
            if (FINAL) { *(LAS u32x4*)(lds + GL_QS + q_row * 144 + q_c16 * 16) = qraw;
#pragma unroll
                for (int tt = 0; tt < 4; ++tt) rcur[tt] = rraw[tt]; }
            if (c + 1 < 16) GLA_FETCH(c + 1);
            __syncthreads();
            float offs = 0.f, bl = 0.f;
#pragma unroll
            for (int p = 0; p < 8; ++p) { const float v = ((LAS float*)(lds + GL_PSUM))[p * 64 + kq]; offs += (p < part) ? v : 0.f; bl += v; }
#pragma unroll
            for (int i = 0; i < 8; ++i) { const float kd = kv[i] * __expf(bl - (offs + gv[i]));
                *(LAS unsigned short*)(lds + GL_KD + (8 * part + i) * 144 + kq * 2) = (unsigned short)(pk2(kd, 0.f) & 0xffffu); }
            if (part == 0) ((LAS float*)(lds + GL_DL))[kq] = __expf(bl);
            ltot_acc += bl;
            __syncthreads();
#pragma unroll
            for (int kt = 0; kt < 4; ++kt) { const f32x4 dl = *(LAS f32x4*)(lds + GL_DL + (16 * kt + 4 * g) * 4); sacc[kt] = sacc[kt] * dl; }
#pragma unroll
            for (int ks = 0; ks < 2; ++ks) {
                const unsigned vrow = lb + GL_VS + (unsigned)(32 * ks + 8 * g + q4) * 272u + (unsigned)(16 * wave + 4 * p4) * 2u;
                const bf16x8 vb = cat8(vtr(vrow), vtr(vrow + 4u * 272u));
#pragma unroll
                for (int kt = 0; kt < 4; ++kt) {
                    const unsigned krow = lb + GL_KD + (unsigned)(32 * ks + 8 * g + q4) * 144u + (unsigned)(16 * kt + 4 * p4) * 2u;
                    const bf16x8 ka = cat8(vtr(krow), vtr(krow + 4u * 144u));
                    sacc[kt] = __builtin_amdgcn_mfma_f32_16x16x32_bf16(ka, vb, sacc[kt], 0, 0, 0);
                }
            }
            if (FINAL) {
                f32x4 oacc[4];
#pragma unroll
                for (int tt = 0; tt < 4; ++tt) oacc[tt] = (f32x4){0.f, 0.f, 0.f, 0.f};
#pragma unroll
                for (int ks2 = 0; ks2 < 2; ++ks2) {
                    u32x4 spw; spw.x = pk2(sacc[2 * ks2][0], sacc[2 * ks2][1]); spw.y = pk2(sacc[2 * ks2][2], sacc[2 * ks2][3]);
                    spw.z = pk2(sacc[2 * ks2 + 1][0], sacc[2 * ks2 + 1][1]); spw.w = pk2(sacc[2 * ks2 + 1][2], sacc[2 * ks2 + 1][3]);
                    const bf16x8 sp = __builtin_bit_cast(bf16x8, spw);
#pragma unroll
                    for (int tt = 0; tt < 4; ++tt) {
                        const LAS unsigned char* qp = lds + GL_QS + (16 * tt + l15) * 144 + (32 * ks2 + 4 * g) * 2;
                        const u32x2 qlo = *(const LAS u32x2*)qp, qhi = *(const LAS u32x2*)(qp + 32);
                        u32x4 qw; qw.x = qlo.x; qw.y = qlo.y; qw.z = qhi.x; qw.w = qhi.y;
                        oacc[tt] = __builtin_amdgcn_mfma_f32_16x16x32_bf16(sp, __builtin_bit_cast(bf16x8, qw), oacc[tt], 0, 0, 0);
                    }
                }
#pragma unroll
                for (int tt = 0; tt < 4; ++tt) { float s = oacc[tt][0] * oacc[tt][0] + oacc[tt][1] * oacc[tt][1] + oacc[tt][2] * oacc[tt][2] + oacc[tt][3] * oacc[tt][3];
                    s += shx(s, 16, lane); s += shx(s, 32, lane);
                    if (g == 0) ((LAS float*)(lds + GL_SSQ))[wave * 64 + 16 * tt + l15] = s; }
                __syncthreads();
                const int col = h * 128 + 16 * wave + 4 * g;
                const f32x4 gn = *(const f32x4*)(gn_g + col);
#pragma unroll
                for (int tt = 0; tt < 4; ++tt) { float tot = 0.f;
#pragma unroll
                    for (int w2 = 0; w2 < 8; ++w2) tot += ((LAS float*)(lds + GL_SSQ))[w2 * 64 + 16 * tt + l15];
                    const float rs = __builtin_amdgcn_rsqf(tot * (1.0f / 128.0f) + 1e-6f);
                    const size_t tok = t0 + 16 * tt + l15;
                    const u32x2 rr = rcur[tt];
                    u32x2 w; w.x = pk2(oacc[tt][0] * rs * gn[0] * bflo(rr.x), oacc[tt][1] * rs * gn[1] * bfhi(rr.x));
                    w.y = pk2(oacc[tt][2] * rs * gn[2] * bflo(rr.y), oacc[tt][3] * rs * gn[3] * bfhi(rr.y));
                    *(u32x2*)(Y + tok * D + col) = w; }
            }
        }
        if (!FINAL) {
            float* se = Send + ((size_t)(bh * 8 + run) * 64) * 128;
#pragma unroll
            for (int kt = 0; kt < 4; ++kt)
#pragma unroll
                for (int r = 0; r < 4; ++r) se[(size_t)(16 * kt + 4 * g + r) * 128 + 16 * wave + l15] = sacc[kt][r];
            if (part == 0) Ltot[(size_t)(bh * 8 + run) * 64 + kq] = ltot_acc;
        }
    }
}

#undef GLA_FETCH
constexpr int SG_VN = 0;
__device__ __forceinline__ void sgu_phase(LAS unsigned char* lds, const bf16_t* P, const bf16_t* Wm, const float* b_s, const float* lg, const float* lb_, bf16_t* Y, int bid, int G, int wave_s) {
    int tid_ = wave_s * 64 + pg8::lane_id(); asm volatile("" : "+v"(tid_)); const int tid = tid_, lane = tid & 63, wave = __builtin_amdgcn_readfirstlane(tid >> 6);
    const unsigned lb = (unsigned)(size_t)lds;
    const int g = lane >> 4, l15 = lane & 15, q4 = l15 >> 2, p4 = lane & 3;
    const int row = tid >> 2, qu = tid & 3;
    u32x4 vraw[4]; u32x2 uraw[8];
#define SGU_FETCH(IT) do { const int blk_ = (IT) >> 2, gr_ = (IT) & 3; const size_t tf_ = (size_t)blk_ * 128; \
        const bf16_t* src_ = P + (tf_ + row) * NP + PVS + gr_ * 128 + 32 * qu; \
        _Pragma("unroll") for (int i = 0; i < 4; ++i) vraw[i] = *(const u32x4*)(src_ + 8 * i); \
        const bf16_t* us_ = P + (tf_ + 16 * wave + l15) * NP + PU + gr_ * 128 + 4 * g; \
        _Pragma("unroll") for (int ct = 0; ct < 8; ++ct) uraw[ct] = *(const u32x2*)(us_ + 16 * ct); } while (0)
    if (bid < 2048) SGU_FETCH(bid);
    for (int item = bid; item < 2048; item += G) {
        const int blk = item >> 2, gr = item & 3; const size_t t0 = (size_t)blk * 128;
        __syncthreads();
        u32x2 ucur[8];
        { float v[32];
#pragma unroll
          for (int i = 0; i < 4; ++i) { float f[8]; unpack8(vraw[i], f);
#pragma unroll
              for (int j = 0; j < 8; ++j) v[8 * i + j] = f[j]; }
#pragma unroll
          for (int ct = 0; ct < 8; ++ct) ucur[ct] = uraw[ct];
          if (item + G < 2048) SGU_FETCH(item + G);
          float s = 0.f;
#pragma unroll
          for (int i = 0; i < 32; ++i) s += v[i];
          s += shx(s, 1, lane); s += shx(s, 2, lane);
          const float mu = s * (1.0f / 128.0f); float qq = 0.f;
#pragma unroll
          for (int i = 0; i < 32; ++i) { v[i] -= mu; qq += v[i] * v[i]; }
          qq += shx(qq, 1, lane); qq += shx(qq, 2, lane);
          const float rs = __builtin_amdgcn_rsqf(qq * (1.0f / 128.0f) + LN_EPS);
          const float* gp = lg + gr * 128 + 32 * qu; const float* bp = lb_ + gr * 128 + 32 * qu;
#pragma unroll
          for (int i = 0; i < 4; ++i) { float f[8];
#pragma unroll
              for (int j = 0; j < 8; ++j) f[j] = v[8 * i + j] * rs * gp[8 * i + j] + bp[8 * i + j];
              *(LAS u32x4*)(lds + SG_VN + row * 272 + (32 * qu + 8 * i) * 2) = pack8(f); }
        }
        __syncthreads();
        const int nks = (wave < 4) ? 2 : 4;
        bf16x8 wf[4];
#pragma unroll
        for (int ks = 0; ks < 4; ++ks) wf[ks] = *(const bf16x8*)(Wm + ((size_t)(gr * 128 + 16 * wave + l15)) * 128 + 32 * ks + 8 * g);
        const size_t tok = t0 + 16 * wave + l15; const float bs = b_s[gr * 128 + 16 * wave + l15];
        unsigned vb0 = lb + SG_VN + (unsigned)(8 * g + q4) * 272u + (unsigned)(4 * p4) * 2u; asm volatile("" : "+v"(vb0));
#pragma unroll
        for (int ct = 0; ct < 8; ++ct) {
            f32x4 acc = (f32x4){0.f, 0.f, 0.f, 0.f};
#pragma unroll
            for (int ks = 0; ks < 4; ++ks) {
                if (ks < nks) {
                    const unsigned vrow = vb0 + (unsigned)(32 * ks * 272 + 32 * ct);
                    const bf16x8 va = cat8(vtr(vrow), vtr(vrow + 4u * 272u));
                    acc = __builtin_amdgcn_mfma_f32_16x16x32_bf16(va, wf[ks], acc, 0, 0, 0);
                }
            }
            const int col = gr * 128 + 16 * ct + 4 * g;
            const u32x2 uu = ucur[ct];
            u32x2 w; w.x = pk2(bflo(uu.x) * (acc[0] + bs), bfhi(uu.x) * (acc[1] + bs)); w.y = pk2(bflo(uu.y) * (acc[2] + bs), bfhi(uu.y) * (acc[3] + bs));
            *(u32x2*)(Y + tok * D + 512 + col) = w;
        }
    }
}
#undef SGU_FETCH

constexpr int AT_KPS = 1040, AT_VPS = 1088, AT_SLOT = 34816, AT_NSLOT = 3;
static_assert(AT_NSLOT * AT_SLOT <= LDSCTL_OFF, "attention LDS");
__device__ __forceinline__ void glds16(const void* gsrc, unsigned lds_dst) { unsigned keep;
    asm volatile("s_mov_b32 %0, m0\n\ts_mov_b32 m0, %2\n\ts_nop 0\n\tglobal_load_lds_dwordx4 %1, off\n\ts_mov_b32 m0, %0" : "=&s"(keep) : "v"(gsrc), "s"(lds_dst) : "memory"); }
__device__ __forceinline__ void attn_dma(unsigned lb, const char* kvb, int so, unsigned lane_off, int slot, int ps, int wave) {
#pragma unroll
    for (int j = 0; j < 4; ++j) { const int pi = 4 * wave + j, rlo = 32 * (pi >> 4) + (pi & 15);
        glds16(kvb + (size_t)(so + rlo * 8192) + lane_off, (unsigned)__builtin_amdgcn_readfirstlane((int)(lb + (unsigned)(slot * AT_SLOT + pi * ps)))); }
}
#define AT_WAITBAR(N) do { asm volatile("s_waitcnt vmcnt(" #N ") lgkmcnt(0)" ::: "memory"); __builtin_amdgcn_s_barrier(); asm volatile("" ::: "memory"); } while (0)
__device__ __forceinline__ void attn_phase(LAS unsigned char* lds, const bf16_t* Q, const bf16_t* KV, bf16_t* O, int layer, int bid, int G, int wave_s) {
    int tid_ = wave_s * 64 + pg8::lane_id(); asm volatile("" : "+v"(tid_)); const int tid = tid_, lane = tid & 63, wave = __builtin_amdgcn_readfirstlane(tid >> 6);
    const unsigned lb = (unsigned)(size_t)lds;
    const int r32 = lane & 31, hh = lane >> 5, q4 = (lane & 15) >> 2, p4 = lane & 3, blk = (lane >> 4) & 1;
    LAS unsigned char* kbase = lds + (r32 & 15) * AT_KPS + ((r32 >> 4) & 1) * 512 + hh * 16;
    unsigned vbase = lb + (unsigned)(4 * hh + q4) * (unsigned)AT_VPS + (unsigned)(16 * blk + 4 * p4) * 2u;
    unsigned lane_off = (unsigned)((lane >> 5) * 16 * 8192 + (lane & 31) * 16);
    asm volatile("" : "+v"(kbase), "+v"(vbase), "+v"(lane_off));
    const char* kvb = (const char*)KV;
    const int nun = (bid < 256) ? 4 * ((256 - bid + G - 1) / G) : 0;
#define AT_SRC(N, ST) ((int)((((size_t)(((bid + ((N) >> 2) * G) >> 5) * NMEM) * 4096 + layer * 2048 + ((N) & 3) * 256 + (((ST) >> 2) * 1024)) * 2) + ((ST) & 3) * 64 * 8192))
    __syncthreads();
    if (nun > 0) { attn_dma(lb, kvb, AT_SRC(0, 0), lane_off, 0, AT_KPS, wave); attn_dma(lb, kvb, AT_SRC(0, 1), lane_off, 1, AT_KPS, wave); AT_WAITBAR(4); }
    int sl = 0;
    for (int n = 0; n < nun; ++n) {
        const int pan = bid + (n >> 2) * G, h = n & 3, b = pan >> 5, qt = pan & 31;
        int ln_ = pg8::lane_id(); asm volatile("" : "+v"(ln_));
        const unsigned qoff = (unsigned)((wave * 16 * 64 + ln_) * 16);
        const char* qbase = (const char*)(Q + (size_t)(pan * 4 + h) * 65536);
        char* obase = (char*)(O + ((size_t)b * SEQ + qt * 256) * D + h * 256);
        const bool more = (n + 1 < nun);
        bf16x8 qf[16];
#pragma unroll
        for (int s = 0; s < 16; ++s) qf[s] = *(const GAS bf16x8*)(qbase + qoff + 1024 * s);
        float ml = 0.f, lsum = 0.f;
        bf16x8 pk[8][2];
#pragma unroll
        for (int st = 0; st < 4; ++st) {
            const int sl2 = (sl >= 1) ? sl - 1 : 2;
            if (st > 0) attn_dma(lb, kvb, AT_SRC(n, st + 2), lane_off, sl2, (st + 2 < 4) ? AT_KPS : AT_VPS, wave);
            LAS unsigned char* kb = kbase + sl * AT_SLOT;
            f32x16 sa[2];
#pragma unroll
            for (int kt = 0; kt < 2; ++kt)
#pragma unroll
                for (int r = 0; r < 16; ++r) sa[kt][r] = 0.f;
            bf16x8 kfa[2], kfb[2];
#define AT_KLD(dst, S0) do { _Pragma("unroll") for (int kt = 0; kt < 2; ++kt) dst[kt] = *(const LAS bf16x8*)(kb + kt * 16 * AT_KPS + 32 * (S0)); } while (0)
#define AT_KMM(src, S0) do { _Pragma("unroll") for (int kt = 0; kt < 2; ++kt) sa[kt] = __builtin_amdgcn_mfma_f32_32x32x16_bf16(src[kt], qf[(S0)], sa[kt], 0, 0, 0); } while (0)
            AT_KLD(kfa, 0); __builtin_amdgcn_sched_barrier(0);
#pragma unroll
            for (int bq = 0; bq < 8; ++bq) {
                AT_KLD(kfb, 2 * bq + 1); __builtin_amdgcn_sched_barrier(0);
                AT_KMM(kfa, 2 * bq); __builtin_amdgcn_sched_barrier(0);
                if (bq < 7) { AT_KLD(kfa, 2 * bq + 2); __builtin_amdgcn_sched_barrier(0); }
                AT_KMM(kfb, 2 * bq + 1); __builtin_amdgcn_sched_barrier(0);
            }
#undef AT_KLD
#undef AT_KMM
            if (st == 0) attn_dma(lb, kvb, AT_SRC(n, 2), lane_off, sl2, AT_KPS, wave);
            if (st == 0) { float mx = -3.0e38f;
#pragma unroll
                for (int kt = 0; kt < 2; ++kt)
#pragma unroll
                    for (int r = 0; r < 16; ++r) mx = __builtin_fmaxf(mx, sa[kt][r]);
                mx = __builtin_fmaxf(mx, shx(mx, 32, lane)); ml = mx * LOG2E; }
#pragma unroll
            for (int kt = 0; kt < 2; ++kt) {
                float p[16];
#pragma unroll
                for (int r = 0; r < 16; ++r) { p[r] = __builtin_amdgcn_exp2f(sa[kt][r] * LOG2E - ml); lsum += p[r]; }
#pragma unroll
                for (int s2 = 0; s2 < 2; ++s2) { u32x4 w; w.x = pk2(p[8 * s2 + 0], p[8 * s2 + 1]); w.y = pk2(p[8 * s2 + 2], p[8 * s2 + 3]); w.z = pk2(p[8 * s2 + 4], p[8 * s2 + 5]); w.w = pk2(p[8 * s2 + 6], p[8 * s2 + 7]);
                    pk[2 * st + kt][s2] = __builtin_bit_cast(bf16x8, w); }
            }
            AT_WAITBAR(4);
            sl = (sl == 2) ? 0 : sl + 1;
        }
        lsum += shx(lsum, 32, lane);
        f32x16 oacc[8];
#pragma unroll
        for (int dt = 0; dt < 8; ++dt)
#pragma unroll
            for (int r = 0; r < 16; ++r) oacc[dt][r] = 0.f;
#pragma unroll
        for (int st = 4; st < 8; ++st) {
            const bool issue = (st < 6) || more;
            if (issue) { const int s2 = (sl >= 1) ? sl - 1 : 2;
                if (st < 6) attn_dma(lb, kvb, AT_SRC(n, st + 2), lane_off, s2, AT_VPS, wave); else attn_dma(lb, kvb, AT_SRC(n + 1, st - 6), lane_off, s2, AT_KPS, wave); }
            const unsigned vb = vbase + (unsigned)(sl * AT_SLOT);
            bf16x8 vfa[2], vfb[2];
#define AT_VLD(dst, BT) do { const unsigned va_ = vb + (unsigned)((((BT) >> 3) & 1) * 16 * AT_VPS + (((BT) >> 2) & 1) * 512 + ((BT) & 3) * 128); \
                _Pragma("unroll") for (int d_ = 0; d_ < 2; ++d_) dst[d_] = cat8(vtr(va_ + 64u * d_), vtr(va_ + 64u * d_ + 8u * AT_VPS)); } while (0)
#define AT_VMM(src, BT) do { _Pragma("unroll") for (int d_ = 0; d_ < 2; ++d_) oacc[2 * ((BT) & 3) + d_] = __builtin_amdgcn_mfma_f32_32x32x16_bf16(src[d_], pk[2 * (st - 4) + (((BT) >> 3) & 1)][((BT) >> 2) & 1], oacc[2 * ((BT) & 3) + d_], 0, 0, 0); } while (0)
            AT_VLD(vfa, 0); __builtin_amdgcn_sched_barrier(0);
#pragma unroll
            for (int bq = 0; bq < 8; ++bq) {
                AT_VLD(vfb, 2 * bq + 1); __builtin_amdgcn_sched_barrier(0);
                AT_VMM(vfa, 2 * bq); __builtin_amdgcn_sched_barrier(0);
                if (bq < 7) { AT_VLD(vfa, 2 * bq + 2); __builtin_amdgcn_sched_barrier(0); }
                AT_VMM(vfb, 2 * bq + 1); __builtin_amdgcn_sched_barrier(0);
            }
#undef AT_VLD
#undef AT_VMM
            if (issue) AT_WAITBAR(4); else AT_WAITBAR(0);
            sl = (sl == 2) ? 0 : sl + 1;
        }
        const float inv = 1.0f / lsum;
        int ln2 = pg8::lane_id(); asm volatile("" : "+v"(ln2));
        GAS char* op = (GAS char*)obase + ((unsigned)((wave * 32 + (ln2 & 31)) * D) * 2u) + ((ln2 >> 5) ? 16 : 0);
#pragma unroll
        for (int dt = 0; dt < 8; ++dt)
#pragma unroll
            for (int gp = 0; gp < 2; ++gp) {
                u32x2 a, b;
                a.x = pk2(oacc[dt][8 * gp + 0] * inv, oacc[dt][8 * gp + 1] * inv); a.y = pk2(oacc[dt][8 * gp + 2] * inv, oacc[dt][8 * gp + 3] * inv);
                b.x = pk2(oacc[dt][8 * gp + 4] * inv, oacc[dt][8 * gp + 5] * inv); b.y = pk2(oacc[dt][8 * gp + 6] * inv, oacc[dt][8 * gp + 7] * inv);
                { const auto r = __builtin_amdgcn_permlane32_swap(a.x, b.x, false, false); a.x = r[0]; b.x = r[1]; }
                { const auto r = __builtin_amdgcn_permlane32_swap(a.y, b.y, false, false); a.y = r[0]; b.y = r[1]; }
                u32x4 w; w.x = a.x; w.y = a.y; w.z = b.x; w.w = b.y;
                *(GAS u32x4*)(op + (32 * dt + 16 * gp) * 2) = w; }
    }
    asm volatile("s_waitcnt vmcnt(0)" ::: "memory");
    __syncthreads();
}
#undef AT_SRC
#undef AT_WAITBAR

constexpr int RT_WH = 0, RT_WL = 32768, RT_SEL = 65536, RT_RK = 66048, RT_CNTW = 67072, RT_WBASE = 67584;
template <int MODE>
__device__ __forceinline__ void ln_phase(LAS unsigned char* lds, const Args& a, int l, int lnidx, bool last, bf16_t* Xout, int bid, int G, int wave_s) {
    int tid_ = wave_s * 64 + pg8::lane_id(); asm volatile("" : "+v"(tid_)); const int tid = tid_, lane = tid & 63, wave = __builtin_amdgcn_readfirstlane(tid >> 6);
    constexpr int R = (MODE == 2) ? 2 : 4;
    unsigned char* ws = a.ws;
    const bf16_t* Z = (const bf16_t*)(ws + WS_R + R_Z); const bf16_t* X = (const bf16_t*)(ws + WS_X); const bf16_t* Ys = (const bf16_t*)(ws + WS_R + R_XS);
    const float* gp = a.in[20] + (size_t)(l * 3 + lnidx) * D; const float* bp = a.in[21] + (size_t)(l * 3 + lnidx) * D;
    float gg[16], bb[16];
#pragma unroll
    for (int j = 0; j < 2; ++j)
#pragma unroll
        for (int i = 0; i < 8; ++i) { gg[8 * j + i] = gp[8 * lane + 512 * j + i]; bb[8 * j + i] = bp[8 * lane + 512 * j + i]; }
    if (MODE == 1) {
        __syncthreads();
        for (int idx = tid; idx < 2048; idx += NTHR) { const int s = idx >> 6, ln = idx & 63, e = ln & 15, g = ln >> 4; float hi[8], lo[8];
#pragma unroll
            for (int j = 0; j < 8; ++j) { const float w = a.in[15][(32 * s + 8 * g + j) * 16 + e]; const float h = bflo(pk2(w, 0.f) & 0xffffu); hi[j] = h; lo[j] = w - h; }
            *(LAS u32x4*)(lds + RT_WH + idx * 16) = pack8(hi); *(LAS u32x4*)(lds + RT_WL + idx * 16) = pack8(lo); }
        __syncthreads();
    }
    for (int blk = bid; blk < 256; blk += G) {
        int run[16];
#pragma unroll
        for (int e = 0; e < 16; ++e) run[e] = 0;
        u32x4 pa_[R][2], pb_[R][2], pc_[R][2]; float pw0[R], pw1[R];
#define LN_LOAD(ROW0) do { _Pragma("unroll") for (int r = 0; r < R; ++r) { const size_t row = (ROW0) + r; \
            if (MODE == 2) { const int* ts = (const int*)(ws + WS_TSLOT) + row * 2; const float* ti = (const float*)(ws + WS_TINFO) + row * 4; const int s0 = ts[0], s1 = ts[1]; pw0[r] = ti[2]; pw1[r] = ti[3]; \
                _Pragma("unroll") for (int j = 0; j < 2; ++j) { pa_[r][j] = *(const u32x4*)(X + row * D + 8 * lane + 512 * j); pb_[r][j] = *(const u32x4*)(Ys + (size_t)s0 * D + 8 * lane + 512 * j); pc_[r][j] = *(const u32x4*)(Ys + (size_t)s1 * D + 8 * lane + 512 * j); } } \
            else { _Pragma("unroll") for (int j = 0; j < 2; ++j) pa_[r][j] = *(const u32x4*)(Z + row * D + 8 * lane + 512 * j); } } } while (0)
        LN_LOAD((size_t)blk * 256 + wave * 32);
        for (int ri = 0; ri < 32; ri += R) {
            const int rl0 = wave * 32 + ri; const size_t row0 = (size_t)blk * 256 + rl0;
            float v[R][16];
#pragma unroll
            for (int r = 0; r < R; ++r)
#pragma unroll
                for (int j = 0; j < 2; ++j) { float x[8]; unpack8(pa_[r][j], x);
                    if (MODE == 2) { float y0[8], y1[8]; unpack8(pb_[r][j], y0); unpack8(pc_[r][j], y1);
#pragma unroll
                        for (int i = 0; i < 8; ++i) v[r][8 * j + i] = ALPHA * x[i] + pw0[r] * y0[i] + pw1[r] * y1[i]; }
                    else {
#pragma unroll
                        for (int i = 0; i < 8; ++i) v[r][8 * j + i] = x[i]; } }
            if (ri + R < 32) LN_LOAD(row0 + R);
            float s[R];
#pragma unroll
            for (int r = 0; r < R; ++r) { s[r] = 0.f;
#pragma unroll
                for (int i = 0; i < 16; ++i) s[r] += v[r][i]; }
#pragma unroll
            for (int o = 1; o < 64; o <<= 1)
#pragma unroll
                for (int r = 0; r < R; ++r) s[r] += shx(s[r], o, lane);
            float qq[R];
#pragma unroll
            for (int r = 0; r < R; ++r) { const float mu = s[r] * (1.0f / D); qq[r] = 0.f;
#pragma unroll
                for (int i = 0; i < 16; ++i) { v[r][i] -= mu; qq[r] += v[r][i] * v[r][i]; } }
#pragma unroll
            for (int o = 1; o < 64; o <<= 1)
#pragma unroll
                for (int r = 0; r < R; ++r) qq[r] += shx(qq[r], o, lane);
#pragma unroll
            for (int r = 0; r < R; ++r) { const float rs = __builtin_amdgcn_rsqf(qq[r] * (1.0f / D) + LN_EPS);
#pragma unroll
                for (int i = 0; i < 16; ++i) v[r][i] = v[r][i] * rs * gg[i] + bb[i]; }
#pragma unroll
            for (int r = 0; r < R; ++r) { const size_t row = row0 + r;
                if (MODE == 2 && last) {
#pragma unroll
                    for (int j = 0; j < 2; ++j) { float* op = a.out + row * D + 8 * lane + 512 * j;
                        *(f32x4*)op = (f32x4){v[r][8 * j], v[r][8 * j + 1], v[r][8 * j + 2], v[r][8 * j + 3]}; *(f32x4*)(op + 4) = (f32x4){v[r][8 * j + 4], v[r][8 * j + 5], v[r][8 * j + 6], v[r][8 * j + 7]}; }
                } else {
#pragma unroll
                    for (int j = 0; j < 2; ++j) { float f[8];
#pragma unroll
                        for (int i = 0; i < 8; ++i) f[i] = v[r][8 * j + i];
                        *(u32x4*)(Xout + row * D + 8 * lane + 512 * j) = pack8(f); }
                } }
            if (MODE == 1 && ((ri + R) & 15) == 0) {
                asm volatile("s_waitcnt vmcnt(0)" ::: "memory");
                const int tok = lane & 15, g = lane >> 4, tl = rl0 + R - 16 + tok; const size_t token = (size_t)blk * 256 + tl;
                const bf16_t* xr = Xout + token * D + 8 * g;
                f32x4 acc = (f32x4){0.f, 0.f, 0.f, 0.f};
#pragma unroll 8
                for (int ks = 0; ks < 32; ++ks) { const bf16x8 xb = *(const bf16x8*)(xr + 32 * ks);
                    const bf16x8 wh = *(const LAS bf16x8*)(lds + RT_WH + (ks * 64 + lane) * 16), wl = *(const LAS bf16x8*)(lds + RT_WL + (ks * 64 + lane) * 16);
                    acc = __builtin_amdgcn_mfma_f32_16x16x32_bf16(wh, xb, acc, 0, 0, 0); acc = __builtin_amdgcn_mfma_f32_16x16x32_bf16(wl, xb, acc, 0, 0, 0); }
                const f32x4 brv = *(const f32x4*)(a.in[16] + 4 * g);
                float lg[4] = {acc[0] + brv[0], acc[1] + brv[1], acc[2] + brv[2], acc[3] + brv[3]};
                float m = __builtin_fmaxf(__builtin_fmaxf(lg[0], lg[1]), __builtin_fmaxf(lg[2], lg[3]));
                m = __builtin_fmaxf(m, shx(m, 16, lane)); m = __builtin_fmaxf(m, shx(m, 32, lane));
                float t1 = -1.f, t2 = -1.f; int i1 = 0, i2 = 0;
#pragma unroll
                for (int r = 0; r < 4; ++r) { const float p = __expf(lg[r] - m); if (p > t1) { t2 = t1; i2 = i1; t1 = p; i1 = r; } else if (p > t2) { t2 = p; i2 = r; } }
                const float gs = t1 + t2; float bgs = gs; int bg = g;
                { const float o = shx(bgs, 16, lane); const int og = shxi(bg, 16, lane); if (o > bgs || (o == bgs && og < bg)) { bgs = o; bg = og; } }
                { const float o = shx(bgs, 32, lane); const int og = shxi(bg, 32, lane); if (o > bgs || (o == bgs && og < bg)) { bgs = o; bg = og; } }
                const bool mine = (bg == g); const int e0 = 4 * g + i1, e1 = 4 * g + i2;
                if (mine) { u32x4 info; info.x = (unsigned)e0; info.y = (unsigned)e1; info.z = __builtin_bit_cast(unsigned, t1 / gs); info.w = __builtin_bit_cast(unsigned, t2 / gs);
                    *(u32x4*)(ws + WS_TINFO + token * 16) = info; ((LAS unsigned short*)(lds + RT_SEL))[tl] = (unsigned short)(e0 | (e1 << 8)); }
                const unsigned long long below = (1ull << lane) - 1ull; int r0 = 0, r1 = 0;
#pragma unroll
                for (int e = 0; e < 16; ++e) { const bool hit = mine && (e0 == e || e1 == e); const unsigned long long mb = __ballot(hit); const int cb = __popcll(mb & below);
                    r0 = (e0 == e) ? run[e] + cb : r0; r1 = (e1 == e) ? run[e] + cb : r1; run[e] += __popcll(mb); }
                if (mine) { ((LAS unsigned short*)(lds + RT_RK))[2 * tl] = (unsigned short)r0; ((LAS unsigned short*)(lds + RT_RK))[2 * tl + 1] = (unsigned short)r1; }
            }
        }
        if (MODE == 1) {
            { int vsel = 0;
#pragma unroll
              for (int e = 0; e < 16; ++e) vsel = (lane == e) ? run[e] : vsel;
              if (lane < 16) ((LAS int*)(lds + RT_CNTW))[wave * 16 + lane] = vsel; }
            __syncthreads();
            if (tid < 16) { int base = 0;
#pragma unroll
                for (int w = 0; w < 8; ++w) { const int t = ((LAS int*)(lds + RT_CNTW))[w * 16 + tid]; ((LAS int*)(lds + RT_WBASE))[w * 16 + tid] = base; base += t; }
                ((int*)(ws + WS_WGCNT))[blk * 16 + tid] = base; }
            __syncthreads();
            { const int t = tid >> 1, k = tid & 1; const int e = (((LAS unsigned short*)(lds + RT_SEL))[t] >> (8 * k)) & 255;
              ((int*)(ws + WS_TRANK))[(size_t)blk * 512 + tid] = (int)((LAS unsigned short*)(lds + RT_RK))[tid] + ((LAS int*)(lds + RT_WBASE))[(t >> 5) * 16 + e]; }
            __syncthreads();
        }
    }
}

#undef LN_LOAD
constexpr int MG_TBL = 0, MG_TOT = 16384, MG_PRE = 16448, MG_BASE = 16512;
__device__ __forceinline__ void moe_gather_phase(LAS unsigned char* lds, unsigned char* ws, int bid, int G, int wave_s) {
    int tid_ = wave_s * 64 + pg8::lane_id(); asm volatile("" : "+v"(tid_)); const int tid = tid_, lane = tid & 63, wave = __builtin_amdgcn_readfirstlane(tid >> 6);
    LAS int* tbl = (LAS int*)(lds + MG_TBL); LAS int* tot = (LAS int*)(lds + MG_TOT); LAS int* pre = (LAS int*)(lds + MG_PRE); LAS int* base = (LAS int*)(lds + MG_BASE);
    LAS int* offs = (LAS int*)(lds + MISC_OFF) + 16; LAS int* tile_e = (LAS int*)(lds + TILEE_OFF);
    const bf16_t* X = (const bf16_t*)(ws + WS_X); bf16_t* Xs = (bf16_t*)(ws + WS_R + R_XS);
    for (int blk = bid; blk < 256; blk += G) {
        __syncthreads();
        for (int i = tid; i < 4096; i += NTHR) tbl[i] = ((const int*)(ws + WS_WGCNT))[i];
        __syncthreads();
        if (tid < 16) { int t = 0, p = 0; for (int c = 0; c < 256; ++c) { const int v = tbl[c * 16 + tid]; p += (c < blk) ? v : 0; t += v; } tot[tid] = t; pre[tid] = p; }
        __syncthreads();
        if (tid == 0) { int o = 0; for (int e = 0; e < 16; ++e) { offs[e] = o; base[e] = o + pre[e]; o += (tot[e] + 255) & ~255; } offs[16] = o; offs[17] = o >> 8; }
        __syncthreads();
        for (int rt = tid; rt < 528; rt += NTHR) { int e = 0;
#pragma unroll
            for (int q = 1; q < 16; ++q) e = (rt * 256 >= offs[q]) ? q : e;
            tile_e[rt] = e; }
        { const size_t tok = (size_t)blk * 256 + (tid >> 1); const int k = tid & 1;
          const int e = ((const int*)(ws + WS_TINFO))[tok * 4 + k]; const int rk = ((const int*)(ws + WS_TRANK))[tok * 2 + k];
          const int slot = base[e] + rk;
          ((int*)(ws + WS_TSLOT))[tok * 2 + k] = slot; ((int*)(ws + WS_SRCROW))[slot] = (int)tok; }
        for (int e = wave; e < 16; e += NWAVES) { const int npad = offs[e + 1] - offs[e] - tot[e];
            if (blk < npad && lane == 0) ((int*)(ws + WS_SRCROW))[offs[e] + tot[e] + blk] = 0; }
    }
}

#define GEMM_ALIGN true
#define GEMM_SP2 true
__global__ void __launch_bounds__(NTHR, 2) mk_fwd(Args args) {
    extern __shared__ __attribute__((aligned(16))) unsigned char lds_raw[];
    LAS unsigned char* lds = (LAS unsigned char*)lds_raw;
    const int tid = threadIdx.x; const int wave_s = __builtin_amdgcn_readfirstlane(tid >> 6);
    const int G = gridDim.x, bid = blockIdx.x;
    unsigned char* ws = args.ws;
    volatile LAS unsigned* MISC = (volatile LAS unsigned*)(lds + MISC_OFF);
    for (int u = tid; u < (LDS_BYTES - LDSCTL_OFF) / 4; u += NTHR) ((LAS unsigned*)(lds + LDSCTL_OFF))[u] = 0u;
    __syncthreads();
    XcdBarrier bar = xcd_barrier_post((unsigned*)(ws + WS_CTL) + CW_BAR, MISC + 8);
    bar.wv = wave_s;
#define GRID_BAR() xcd_barrier(bar)
#ifndef REP_MASK
#define REP_MASK 0
#endif
#define LOCAL_SYNC() do { asm volatile("s_waitcnt vmcnt(0)" ::: "memory"); __syncthreads(); } while (0)
#define PHASE(grp, ...) do { __VA_ARGS__; if (REP_MASK & (1 << (grp))) { GRID_BAR(); __VA_ARGS__; } } while (0)

#define WSQ ({ unsigned char* w_ = args.ws; asm volatile("" : "+s"(w_)); w_; })
#define X ((bf16_t*)(WSQ + WS_X))
#define P ((bf16_t*)(WSQ + WS_R + R_P))
#define Y ((bf16_t*)(WSQ + WS_R + R_Y))
#define Z ((bf16_t*)(WSQ + WS_R + R_Z))
#define Qb ((bf16_t*)(WSQ + WS_R + R_Q))
#define Ob ((bf16_t*)(WSQ + WS_R + R_O))
#define Xs ((bf16_t*)(WSQ + WS_R + R_XS))
#define Hb ((bf16_t*)(WSQ + WS_R + R_H))
#define KV ((bf16_t*)(WSQ + WS_KV))
#define wl (WSQ + WS_W + (size_t)l * W_LAYER)

    PHASE(0, p0_convert(args, lds, bid, G, wave_s));
    GRID_BAR();
    { const int tid_r = wave_s * 64 + pg8::lane_id();
      for (int i = bid * NTHR + tid_r; i < 2 * 2 * 1024; i += G * NTHR) { const int l = i >> 11, w = (i >> 10) & 1, n = i & 1023; const float* tb = (const float*)(WSQ + WS_CS) + (size_t)l * 2 * 16 * 1024 + w * 16 * 1024; float s = 0.f;
#pragma unroll
          for (int kc = 0; kc < 16; ++kc) s += tb[kc * 1024 + n];
          ((float*)(WSQ + WS_CS) + 65536)[i] = s; } }
    PHASE(1, { pg8::Gemm g{(const bf16_t*)(WSQ + WS_MEMB), (const bf16_t*)(WSQ + WS_WKV), MKV, 4096, D, wave_s}; pg8::StaticOrder S; S.init(MKV, 4096, G, bid);
      pg8::EpiPlain E{KV, 4096, 0xffff};
      pg8::gemm_phase<pg8::EpiPlain, pg8::StaticOrder, GEMM_ALIGN, GEMM_SP2>(lds, g, S, E); });

#pragma unroll 1
    for (int l = 0; l < 2; ++l) {
        PHASE(1, { pg8::Gemm g{X, (const bf16_t*)(wl + W_IN), M, NP, D, wave_s}; pg8::StaticOrder S; S.init(M, NP, G, bid);
          pg8::EpiInProj E{P, args.in[4] + l * 256};
          pg8::gemm_phase<pg8::EpiInProj, pg8::StaticOrder, GEMM_ALIGN, GEMM_SP2>(lds, g, S, E); });
        GRID_BAR();
        PHASE(3, gla_phase<false>(lds, P, (float*)(WSQ + WS_SEND), (float*)(WSQ + WS_LTOT), Y, args.in[5] + l * 512, bid, G, wave_s));
        PHASE(4, sgu_phase(lds, P, (const bf16_t*)(WSQ + WS_WM) + (size_t)l * 4 * 128 * 128, args.in[7] + l * 512, args.in[8] + l * 512, args.in[9] + l * 512, Y, bid, G, wave_s));
        GRID_BAR();
        PHASE(3, gla_phase<true>(lds, P, (float*)(WSQ + WS_SEND), (float*)(WSQ + WS_LTOT), Y, args.in[5] + l * 512, bid, G, wave_s));
        GRID_BAR();
        PHASE(10, { pg8::Gemm g{Y, (const bf16_t*)(wl + W_OUT), M, D, D, wave_s}; pg8::PanelOrder S{4, M / 256, G, bid};
          pg8::EpiResidStats E{X, Z, (pg8::f32x2_t*)(WSQ + WS_PART)};
          pg8::gemm_phase<pg8::EpiResidStats, pg8::PanelOrder, GEMM_ALIGN, GEMM_SP2>(lds, g, S, E); });
        { const int tid_r = wave_s * 64 + pg8::lane_id();
          for (int pan = bid; pan < 256; pan += G) if (tid_r < 256) { const size_t row = (size_t)pan * 256 + tid_r; const pg8::f32x2_t* pp = (const pg8::f32x2_t*)(WSQ + WS_PART) + row * 16; float s1 = 0.f, s2 = 0.f;
#pragma unroll
              for (int q = 0; q < 16; ++q) { const pg8::f32x2_t v = pp[q]; s1 += v[0]; s2 += v[1]; }
              const float mu = s1 * (1.0f / D), var = s2 * (1.0f / D) - mu * mu; ((pg8::f32x2_t*)(WSQ + WS_STATS))[row] = (pg8::f32x2_t){mu, __builtin_amdgcn_rsqf(var + LN_EPS)}; } }
        LOCAL_SYNC();
        PHASE(10, { pg8::Gemm g{Z, (const bf16_t*)(wl + W_Q), M, D, D, wave_s}; pg8::PanelOrder S{4, M / 256, G, bid};
          pg8::EpiQFragLN E{Qb, (const pg8::f32x2_t*)(WSQ + WS_STATS), (const float*)(WSQ + WS_CS) + 65536 + l * 2048, (const float*)(WSQ + WS_CS) + 65536 + l * 2048 + 1024};
          pg8::gemm_phase<pg8::EpiQFragLN, pg8::PanelOrder, GEMM_ALIGN, GEMM_SP2>(lds, g, S, E); });
        PHASE(5, attn_phase(lds, Qb, KV, Ob, l, bid, G, wave_s));
        LOCAL_SYNC();
        PHASE(10, { pg8::Gemm g{Ob, (const bf16_t*)(wl + W_O), M, D, D, wave_s}; pg8::PanelOrder S{4, M / 256, G, bid};
          pg8::EpiResidLN E{Z, (const pg8::f32x2_t*)(WSQ + WS_STATS), args.in[20] + (size_t)(l * 3) * D, args.in[21] + (size_t)(l * 3) * D};
          pg8::gemm_phase<pg8::EpiResidLN, pg8::PanelOrder, GEMM_ALIGN, GEMM_SP2>(lds, g, S, E); });
        PHASE(9, ln_phase<1>(lds, args, l, 1, false, X, bid, G, wave_s));
        GRID_BAR();
        PHASE(7, moe_gather_phase(lds, WSQ, bid, G, wave_s));
        GRID_BAR();
        PHASE(2, { pg8::Gemm g{X, (const bf16_t*)(wl + W_GU), MOE_ROWS, 16384, D, wave_s}; pg8::MoeGatherOrder S{(const LAS int*)(lds + TILEE_OFF), (int)MISC[33] * 4, G, bid, (const int*)(WSQ + WS_SRCROW)};
          pg8::EpiGU E{Hb};
          pg8::gemm_phase<pg8::EpiGU, pg8::MoeGatherOrder, GEMM_ALIGN, GEMM_SP2>(lds, g, S, E); });
        GRID_BAR();
        PHASE(2, { pg8::Gemm g{Hb, (const bf16_t*)(wl + W_D), MOE_ROWS, 16384, 512, wave_s}; pg8::MoeOrder S{(const LAS int*)(lds + TILEE_OFF), (int)MISC[33] * 4, G, bid};
          pg8::EpiPlain E{Xs, D, 3};
          pg8::gemm_phase<pg8::EpiPlain, pg8::MoeOrder, GEMM_ALIGN, GEMM_SP2>(lds, g, S, E); });
        GRID_BAR();
        if (REP_MASK & (1 << 8)) { ln_phase<2>(lds, args, l, 2, l == 1, Z, bid, G, wave_s); GRID_BAR(); }
        ln_phase<2>(lds, args, l, 2, l == 1, X, bid, G, wave_s);
        if (l == 0) GRID_BAR();
    }
}
#undef X
#undef P
#undef Y
#undef Z
#undef Qb
#undef Ob
#undef Xs
#undef Hb
#undef KV
#undef wl
}

extern "C" void kernel_launch(void* const* d_in, const int* in_sizes, int n_in, void* d_out, int out_size, void* d_ws, size_t ws_size, hipStream_t stream) {
    using namespace mk;
    static int grid = 0;
    if (grid == 0) {
        if (n_in != 22 || in_sizes[0] != M * D || out_size != M * D || ws_size < WS_END) { fprintf(stderr, "kernel_launch: unexpected shapes (n_in %d, in0 %d, out %d, ws %zu, need %zu)\n", n_in, n_in > 0 ? in_sizes[0] : -1, out_size, ws_size, (size_t)WS_END); grid = -1; return; }
        int dev = 0, cus = 0;
        if (hipGetDevice(&dev) != hipSuccess || hipDeviceGetAttribute(&cus, hipDeviceAttributeMultiprocessorCount, dev) != hipSuccess) { grid = -1; return; }
        if (hipFuncSetAttribute((const void*)mk_fwd, hipFuncAttributeMaxDynamicSharedMemorySize, LDS_BYTES) != hipSuccess) { fprintf(stderr, "kernel_launch: hipFuncSetAttribute failed\n"); grid = -1; return; }
        int per_cu = 0;
        if (hipOccupancyMaxActiveBlocksPerMultiprocessor(&per_cu, (const void*)mk_fwd, NTHR, LDS_BYTES) != hipSuccess || per_cu < 1) fprintf(stderr, "kernel_launch: occupancy query says %d\n", per_cu);
        (void)hipGetLastError();
        grid = cus;
    }
    if (grid < 0) return;
    if (hipMemsetAsync((char*)d_ws + WS_CTL, 0, CTL_ZERO_BYTES, stream) != hipSuccess) return;
    Args a{};
    for (int i = 0; i < 22; ++i) a.in[i] = (const float*)d_in[i];
    a.out = (float*)d_out; a.ws = (unsigned char*)d_ws;
    hipLaunchKernelGGL(mk_fwd, dim3(grid), dim3(NTHR), LDS_BYTES, stream, a);
}
```

```cpp
#include <hip/hip_runtime.h>
#include <cstdio>
#include <cstdint>

namespace pg8 {
#define PG8_LAS __attribute__((address_space(3)))
typedef unsigned short bf16_t;
typedef short bf16x8 __attribute__((ext_vector_type(8)));
typedef float f32x4 __attribute__((ext_vector_type(4)));
typedef unsigned u32x4 __attribute__((ext_vector_type(4)));
typedef unsigned u32x2 __attribute__((ext_vector_type(2)));
constexpr int BM = 256, BK = 64, HALF = 128, HTB = HALF * BK * 2  , STAGE_BYTES = 8 * HTB, NXCD = 8, WGM = 8;

__host__ __device__ __forceinline__ int lds_byte(int r, int c) { const int st = (r >> 4) * 2 + (c >> 5), rr = r & 15, cc = c & 31, ob = rr * 64 + cc * 2; return st * 1024 + (ob ^ (((ob >> 9) & 1) << 5)); }
__host__ __device__ __forceinline__ void stage_rc(int b, int& R, int& C) { const int st = b / 1024, sb = b % 1024, swz = sb ^ (((sb >> 9) & 1) << 5); R = (st >> 1) * 16 + swz / 64; C = (st & 1) * 32 + (swz % 64) / 2; }
__host__ __device__ __forceinline__ int perm32(int rho) { const int n = rho >> 4, i = rho & 15; return 8 * (i >> 2) + 4 * n + (i & 3); }

struct Unit { int pm, pn; };
struct Gemm { const bf16_t* A; const bf16_t* Bt; int M, N, K; int wv; };
__device__ __forceinline__ int lane_id() { int l; asm volatile("v_mbcnt_lo_u32_b32 %0, -1, 0\n\tv_mbcnt_hi_u32_b32 %0, -1, %0" : "=v"(l)); return l; }

struct StaticOrder {
    static constexpr bool GATHER = false;
    int nM, nN, nwg, G, c; const int* src = nullptr;
    __host__ __device__ void init(int M, int N, int G_, int c_) { nM = M / BM; nN = N / BM; nwg = nM * nN; G = G_; c = c_; }
    __host__ __device__ bool next(int i, Unit& u) const {
        const long L = (long)i * G + c; if (L >= nwg) return false;
        int wgid = (int)L; { const int q = nwg / NXCD, r = nwg % NXCD, xcd = wgid % NXCD, off = wgid / NXCD; wgid = (xcd < r ? xcd * (q + 1) : r * (q + 1) + (xcd - r) * q) + off; }
        const int nig = WGM * nN, gid = wgid / nig, fm = gid * WGM, gsz = (nM - fm) < WGM ? (nM - fm) : WGM;
        u.pm = fm + ((wgid % nig) % gsz); u.pn = (wgid % nig) / gsz; return true;
    }
    __device__ __forceinline__ void a_ready(const Unit&) const {}
    __device__ __forceinline__ void done(const Unit&) const {}
};
struct PanelOrder {
    static constexpr bool GATHER = false;
    int nN, npan, G, c; const int* src = nullptr;
    __device__ __forceinline__ bool next(int i, Unit& u) const { const int p = c + (i / nN) * G; if (p >= npan) return false; u.pm = p; u.pn = i % nN; return true; }
    __device__ __forceinline__ void a_ready(const Unit&) const {}
    __device__ __forceinline__ void done(const Unit&) const {}
};
template <bool GATH_> struct MoeOrderT {
    static constexpr bool GATHER = GATH_;
    const PG8_LAS int* tile_e; int nunits, G, c; const int* src = nullptr;
    __device__ __forceinline__ bool next(int i, Unit& u) const {
        const int cc = ((G & 7) == 0) ? (c & 7) * (G >> 3) + (c >> 3) : c;
        const int L = i * G + cc; if (L >= nunits) return false;
        u.pm = L >> 2; u.pn = tile_e[L >> 2] * 4 + (L & 3); return true;
    }
    __device__ __forceinline__ void a_ready(const Unit&) const {}
    __device__ __forceinline__ void done(const Unit&) const {}
};
typedef MoeOrderT<false> MoeOrder; typedef MoeOrderT<true> MoeGatherOrder;

typedef float f32x2_t __attribute__((ext_vector_type(2))); typedef __bf16 bf16x2_t __attribute__((ext_vector_type(2)));
typedef __amdgpu_buffer_rsrc_t rsrc_t;
__device__ __forceinline__ rsrc_t mk_rsrc(const void* p) { return __builtin_amdgcn_make_buffer_rsrc((void*)p, 0, 0x7fffffff, 0x00020000); }
__device__ __forceinline__ u32x4 bld4(rsrc_t r, unsigned voff, unsigned soff) { return __builtin_bit_cast(u32x4, __builtin_amdgcn_raw_buffer_load_b128(r, voff, soff, 0)); }
__device__ __forceinline__ f32x2_t bld2f(rsrc_t r, unsigned voff, unsigned soff) { return __builtin_bit_cast(f32x2_t, __builtin_amdgcn_raw_buffer_load_b64(r, voff, soff, 0)); }
#define GST4(p) (*(__attribute__((address_space(1))) u32x4*)(p))
__device__ __forceinline__ float f8clamp(float x) { return __builtin_fminf(__builtin_fmaxf(x, -448.0f), 448.0f); }
__device__ __forceinline__ unsigned pk4f8(float a, float b, float c, float d) { int w = 0; w = __builtin_amdgcn_cvt_pk_fp8_f32(f8clamp(a), f8clamp(b), w, false); w = __builtin_amdgcn_cvt_pk_fp8_f32(f8clamp(c), f8clamp(d), w, true); return (unsigned)w; }
constexpr float F8_SX = 4.0f, F8_SW = 64.0f, F8_SH = 8.0f;
__device__ __forceinline__ unsigned pk2(float lo, float hi) { f32x2_t v = {lo, hi}; bf16x2_t b = __builtin_convertvector(v, bf16x2_t); return __builtin_bit_cast(unsigned, b); }
__device__ __forceinline__ float bflo(unsigned w) { return __builtin_bit_cast(float, w << 16); }
__device__ __forceinline__ float bfhi(unsigned w) { return __builtin_bit_cast(float, w & 0xffff0000u); }
__device__ __forceinline__ float f_silu(float x) { return x * __builtin_amdgcn_rcpf(1.0f + __builtin_amdgcn_exp2f(-1.4426950408889634f * x)); }
__device__ __forceinline__ float f_gelu_tanh(float x) { return x * __builtin_amdgcn_rcpf(1.0f + __builtin_amdgcn_exp2f(x * (-2.3022082f - 0.10294324f * x * x))); }
__device__ __forceinline__ float f_logsig16(float z) { const float t = __builtin_amdgcn_exp2f(-1.4426950408889634f * __builtin_fabsf(z)); return (__builtin_fminf(z, 0.0f) - 0.6931471805599453f * __builtin_amdgcn_logf(1.0f + t)) * 0.0625f; }

struct EpiPlain {
    static constexpr bool PERM = true, AFTER_DRAIN = false;
    bf16_t* O; int ldc; int cmask;
    __device__ __forceinline__ void operator()(const f32x4 (&acc)[2][2][4][2], const Unit& u, int wr, int wc, int fr, int fq) const {
        const int row0 = u.pm * BM + wr * 64 + fr, col0 = (u.pn & cmask) * BM + wc * 32 + 8 * fq;
#pragma unroll
        for (int ai = 0; ai < 2; ++ai)
#pragma unroll
            for (int m = 0; m < 4; ++m) { bf16_t* rowp = O + (size_t)(row0 + ai * HALF + m * 16) * ldc + col0;
#pragma unroll
                for (int bj = 0; bj < 2; ++bj) { const f32x4 v0 = acc[ai][bj][m][0], v1 = acc[ai][bj][m][1];
                    u32x4 w; w.x = pk2(v0[0], v0[1]); w.y = pk2(v0[2], v0[3]); w.z = pk2(v1[0], v1[1]); w.w = pk2(v1[2], v1[3]);
                    *(u32x4*)(rowp + bj * HALF) = w; } }
    }
};
struct EpiQFrag {
    static constexpr bool PERM = true, AFTER_DRAIN = false;
    bf16_t* O;
    __device__ __forceinline__ void operator()(const f32x4 (&acc)[2][2][4][2], const Unit& u, int wr, int wc, int fr, int fq) const {
        unsigned lo = (unsigned)(((fq >> 1) * 64 + fr + 32 * (fq & 1)) * 16); asm volatile("" : "+v"(lo));
        char* tile = (char*)(O + (size_t)(u.pm * 4 + u.pn) * 65536) + (size_t)(wr * 2 * 16 + wc * 2) * 1024 + lo;
#pragma unroll
        for (int ai = 0; ai < 2; ++ai)
#pragma unroll
            for (int m = 0; m < 4; ++m)
#pragma unroll
                for (int bj = 0; bj < 2; ++bj) { const f32x4 v0 = acc[ai][bj][m][0], v1 = acc[ai][bj][m][1];
                    u32x4 w; w.x = pk2(v0[0], v0[1]); w.y = pk2(v0[2], v0[3]); w.z = pk2(v1[0], v1[1]); w.w = pk2(v1[2], v1[3]);
                    *(u32x4*)(tile + ((4 * ai + (m >> 1)) * 16 + 8 * bj) * 1024 + (m & 1) * 256) = w; }
    }
};
struct EpiInProj {
    static constexpr bool PERM = true, AFTER_DRAIN = false;
    bf16_t* O; const float* b_a;
    template <int MODE> __device__ __forceinline__ void tile(const f32x4 (&acc)[2][2][4][2], const Unit& u, int wr, int wc, int fr, int fq) const {
        const int row0 = u.pm * BM + wr * 64 + fr, col0 = u.pn * BM + wc * 32 + 8 * fq;
        f32x4 bv[2][2];
#pragma unroll
        for (int bj = 0; bj < 2; ++bj)
#pragma unroll
            for (int n = 0; n < 2; ++n) bv[bj][n] = (MODE == 2) ? *(const f32x4*)(b_a + (col0 - 1536) + bj * HALF + 4 * n) : (f32x4){0.f, 0.f, 0.f, 0.f};
#pragma unroll
        for (int ai = 0; ai < 2; ++ai)
#pragma unroll
            for (int m = 0; m < 4; ++m) { bf16_t* rowp = O + (size_t)(row0 + ai * HALF + m * 16) * 2816 + col0;
#pragma unroll
                for (int bj = 0; bj < 2; ++bj) { f32x4 v0 = acc[ai][bj][m][0], v1 = acc[ai][bj][m][1];
#pragma unroll
                    for (int j = 0; j < 4; ++j) {
                        if (MODE == 1) { v0[j] = f_silu(v0[j]); v1[j] = f_silu(v1[j]); }
                        if (MODE == 2) { v0[j] = f_logsig16(v0[j] + bv[bj][0][j]); v1[j] = f_logsig16(v1[j] + bv[bj][1][j]); }
                        if (MODE == 3) { v0[j] = f_gelu_tanh(v0[j]); v1[j] = f_gelu_tanh(v1[j]); } }
                    u32x4 w; w.x = pk2(v0[0], v0[1]); w.y = pk2(v0[2], v0[3]); w.z = pk2(v1[0], v1[1]); w.w = pk2(v1[2], v1[3]);
                    *(u32x4*)(rowp + bj * HALF) = w; } }
    }
    __device__ __forceinline__ void operator()(const f32x4 (&acc)[2][2][4][2], const Unit& u, int wr, int wc, int fr, int fq) const {
        const int pn = u.pn;
        if (pn < 4) tile<0>(acc, u, wr, wc, fr, fq); else if (pn < 6) tile<1>(acc, u, wr, wc, fr, fq); else if (pn == 6) tile<2>(acc, u, wr, wc, fr, fq); else tile<3>(acc, u, wr, wc, fr, fq);
    }
};
struct EpiResid {
    static constexpr bool PERM = true, AFTER_DRAIN = false;
    const bf16_t* X; bf16_t* Z; float alpha;
    __device__ __forceinline__ void operator()(const f32x4 (&acc)[2][2][4][2], const Unit& u, int wr, int wc, int fr, int fq) const {
        const int row0 = u.pm * BM + wr * 64 + fr, col0 = u.pn * BM + wc * 32 + 8 * fq;
#pragma unroll
        for (int ai = 0; ai < 2; ++ai)
#pragma unroll
            for (int m = 0; m < 4; ++m) { const size_t off = (size_t)(row0 + ai * HALF + m * 16) * 1024 + col0;
#pragma unroll
                for (int bj = 0; bj < 2; ++bj) { const f32x4 v0 = acc[ai][bj][m][0], v1 = acc[ai][bj][m][1];
                    const u32x4 xr = *(const u32x4*)(X + off + bj * HALF);
                    u32x4 w; w.x = pk2(alpha * bflo(xr.x) + v0[0], alpha * bfhi(xr.x) + v0[1]); w.y = pk2(alpha * bflo(xr.y) + v0[2], alpha * bfhi(xr.y) + v0[3]);
                    w.z = pk2(alpha * bflo(xr.z) + v1[0], alpha * bfhi(xr.z) + v1[1]); w.w = pk2(alpha * bflo(xr.w) + v1[2], alpha * bfhi(xr.w) + v1[3]);
                    *(u32x4*)(Z + off + bj * HALF) = w; } }
    }
};
struct EpiResidStats {
    static constexpr bool PERM = true, AFTER_DRAIN = false;
    const bf16_t* X; bf16_t* Z; f32x2_t* part; static constexpr float alpha = 1.4142135623730951f;
    __device__ __forceinline__ void operator()(const f32x4 (&acc)[2][2][4][2], const Unit& u, int wr, int wc, int fr, int fq) const {
        const int row0 = u.pm * BM + wr * 64 + fr, col0 = u.pn * BM + wc * 32 + 8 * fq;
        int ln = 16 * fq + fr; asm volatile("" : "+v"(ln));
        float s1[8], s2[8];
        const rsrc_t rx = mk_rsrc(X); const unsigned voff = ((unsigned)row0 * 1024u + (unsigned)col0) * 2u;
        u32x4 xres[2][4][2];
#pragma unroll
        for (int ai = 0; ai < 2; ++ai)
#pragma unroll
            for (int m = 0; m < 4; ++m)
#pragma unroll
                for (int bj = 0; bj < 2; ++bj) xres[ai][m][bj] = bld4(rx, voff, (unsigned)(((ai * HALF + m * 16) * 1024 + bj * HALF) * 2));
        __builtin_amdgcn_sched_barrier(0);
#pragma unroll
        for (int ai = 0; ai < 2; ++ai)
#pragma unroll
            for (int m = 0; m < 4; ++m) { const size_t off = (size_t)(row0 + ai * HALF + m * 16) * 1024 + col0; float a1 = 0.f, a2 = 0.f;
#pragma unroll
                for (int bj = 0; bj < 2; ++bj) { const f32x4 v0 = acc[ai][bj][m][0], v1 = acc[ai][bj][m][1];
                    const u32x4 xr = xres[ai][m][bj];
                    u32x4 w; w.x = pk2(alpha * bflo(xr.x) + v0[0], alpha * bfhi(xr.x) + v0[1]); w.y = pk2(alpha * bflo(xr.y) + v0[2], alpha * bfhi(xr.y) + v0[3]);
                    w.z = pk2(alpha * bflo(xr.z) + v1[0], alpha * bfhi(xr.z) + v1[1]); w.w = pk2(alpha * bflo(xr.w) + v1[2], alpha * bfhi(xr.w) + v1[3]);
                    GST4(Z + off + bj * HALF) = w;
                    const float z0 = bflo(w.x), z1 = bfhi(w.x), z2 = bflo(w.y), z3 = bfhi(w.y), z4 = bflo(w.z), z5 = bfhi(w.z), z6 = bflo(w.w), z7 = bfhi(w.w);
                    a1 += ((z0 + z1) + (z2 + z3)) + ((z4 + z5) + (z6 + z7)); a2 += ((z0 * z0 + z1 * z1) + (z2 * z2 + z3 * z3)) + ((z4 * z4 + z5 * z5) + (z6 * z6 + z7 * z7)); }
                s1[ai * 4 + m] = a1; s2[ai * 4 + m] = a2; }
        const bool h5 = (ln & 32) != 0, h4 = (ln & 16) != 0;
        float t1[4], t2[4];
#pragma unroll
        for (int i = 0; i < 4; ++i) { const float m1 = h5 ? s1[4 + i] : s1[i], g1 = h5 ? s1[i] : s1[4 + i], m2 = h5 ? s2[4 + i] : s2[i], g2 = h5 ? s2[i] : s2[4 + i];
            t1[i] = m1 + __builtin_bit_cast(float, __builtin_amdgcn_ds_bpermute((ln ^ 32) << 2, __builtin_bit_cast(int, g1)));
            t2[i] = m2 + __builtin_bit_cast(float, __builtin_amdgcn_ds_bpermute((ln ^ 32) << 2, __builtin_bit_cast(int, g2))); }
        float r1[2], r2[2];
#pragma unroll
        for (int i = 0; i < 2; ++i) { const float m1 = h4 ? t1[2 + i] : t1[i], g1 = h4 ? t1[i] : t1[2 + i], m2 = h4 ? t2[2 + i] : t2[i], g2 = h4 ? t2[i] : t2[2 + i];
            r1[i] = m1 + __builtin_bit_cast(float, __builtin_amdgcn_ds_bpermute((ln ^ 16) << 2, __builtin_bit_cast(int, g1)));
            r2[i] = m2 + __builtin_bit_cast(float, __builtin_amdgcn_ds_bpermute((ln ^ 16) << 2, __builtin_bit_cast(int, g2))); }
#pragma unroll
        for (int i = 0; i < 2; ++i) { const int gi = (h5 ? 4 : 0) + (h4 ? 2 : 0) + i, row = row0 + (gi >> 2) * HALF + (gi & 3) * 16;
            part[(size_t)row * 16 + u.pn * 4 + wc] = (f32x2_t){r1[i], r2[i]}; }
    }
};
struct EpiQFragLN {
    static constexpr bool PERM = true, AFTER_DRAIN = false;
    bf16_t* O; const f32x2_t* stats; const float* csum; const float* bq;
    __device__ __forceinline__ void operator()(const f32x4 (&acc)[2][2][4][2], const Unit& u, int wr, int wc, int fr, int fq) const {
        unsigned lo = (unsigned)(((fq >> 1) * 64 + fr + 32 * (fq & 1)) * 16); asm volatile("" : "+v"(lo));
        char* tile = (char*)(O + (size_t)(u.pm * 4 + u.pn) * 65536) + (size_t)(wr * 2 * 16 + wc * 2) * 1024 + lo;
        const int row0 = u.pm * BM + wr * 64 + fr, col0 = u.pn * BM + wc * 32 + 8 * fq;
#pragma unroll
        for (int bj = 0; bj < 2; ++bj) { const f32x4 c0 = *(const f32x4*)(csum + col0 + bj * HALF), c1 = *(const f32x4*)(csum + col0 + bj * HALF + 4), b0 = *(const f32x4*)(bq + col0 + bj * HALF), b1 = *(const f32x4*)(bq + col0 + bj * HALF + 4);
#pragma unroll
            for (int ai = 0; ai < 2; ++ai)
#pragma unroll
                for (int m = 0; m < 4; ++m) { const f32x2_t st = stats[row0 + ai * HALF + m * 16]; const float mu = st[0], rs = st[1];
                    const f32x4 v0 = (acc[ai][bj][m][0] - mu * c0) * rs + b0, v1 = (acc[ai][bj][m][1] - mu * c1) * rs + b1;
                    u32x4 w; w.x = pk2(v0[0], v0[1]); w.y = pk2(v0[2], v0[3]); w.z = pk2(v1[0], v1[1]); w.w = pk2(v1[2], v1[3]);
                    *(u32x4*)(tile + ((4 * ai + (m >> 1)) * 16 + 8 * bj) * 1024 + (m & 1) * 256) = w; } }
    }
};
struct EpiResidLN {
    static constexpr bool PERM = true, AFTER_DRAIN = false;
    bf16_t* Z; const f32x2_t* stats; const float* gain; const float* bias; static constexpr float alpha = 1.4142135623730951f;
    __device__ __forceinline__ void operator()(const f32x4 (&acc)[2][2][4][2], const Unit& u, int wr, int wc, int fr, int fq) const {
        const int row0 = u.pm * BM + wr * 64 + fr, col0 = u.pn * BM + wc * 32 + 8 * fq;
        const rsrc_t rz = mk_rsrc(Z), rs = mk_rsrc(stats); const unsigned voff = ((unsigned)row0 * 1024u + (unsigned)col0) * 2u;
        f32x2_t st[2][4];
#pragma unroll
        for (int ai = 0; ai < 2; ++ai)
#pragma unroll
            for (int m = 0; m < 4; ++m) st[ai][m] = bld2f(rs, (unsigned)row0 * 8u, (unsigned)((ai * HALF + m * 16) * 8));
#pragma unroll
        for (int bj = 0; bj < 2; ++bj) {
            u32x4 zres[2][4];
#pragma unroll
            for (int ai = 0; ai < 2; ++ai)
#pragma unroll
                for (int m = 0; m < 4; ++m) zres[ai][m] = bld4(rz, voff, (unsigned)(((ai * HALF + m * 16) * 1024 + bj * HALF) * 2));
            const f32x4 g0 = *(const f32x4*)(gain + col0 + bj * HALF) * alpha, g1 = *(const f32x4*)(gain + col0 + bj * HALF + 4) * alpha, b0 = *(const f32x4*)(bias + col0 + bj * HALF) * alpha, b1 = *(const f32x4*)(bias + col0 + bj * HALF + 4) * alpha;
            __builtin_amdgcn_sched_barrier(0);
#pragma unroll
            for (int ai = 0; ai < 2; ++ai)
#pragma unroll
                for (int m = 0; m < 4; ++m) { const int row = row0 + ai * HALF + m * 16; const float mu = st[ai][m][0], rsd = st[ai][m][1];
                    const u32x4 zr = zres[ai][m];
                    const f32x4 z0 = (f32x4){bflo(zr.x), bfhi(zr.x), bflo(zr.y), bfhi(zr.y)}, z1 = (f32x4){bflo(zr.z), bfhi(zr.z), bflo(zr.w), bfhi(zr.w)};
                    const f32x4 v0 = (z0 - mu) * rsd * g0 + b0 + acc[ai][bj][m][0], v1 = (z1 - mu) * rsd * g1 + b1 + acc[ai][bj][m][1];
                    u32x4 w; w.x = pk2(v0[0], v0[1]); w.y = pk2(v0[2], v0[3]); w.z = pk2(v1[0], v1[1]); w.w = pk2(v1[2], v1[3]);
                    GST4(Z + (size_t)row * 1024 + col0 + bj * HALF) = w; } }
    }
};
struct EpiGU {
    static constexpr bool PERM = true, AFTER_DRAIN = false;
    bf16_t* H;
    __device__ __forceinline__ void operator()(const f32x4 (&acc)[2][2][4][2], const Unit& u, int wr, int wc, int fr, int fq) const {
        const int row0 = u.pm * BM + wr * 64 + fr, col0 = (u.pn & 3) * 128 + wc * 16 + 4 * fq;
#pragma unroll
        for (int ai = 0; ai < 2; ++ai)
#pragma unroll
            for (int m = 0; m < 4; ++m) { bf16_t* rowp = H + (size_t)(row0 + ai * HALF + m * 16) * 512 + col0;
#pragma unroll
                for (int bj = 0; bj < 2; ++bj) { const f32x4 g = acc[ai][bj][m][0], up = acc[ai][bj][m][1];
                    u32x2 w; w.x = pk2(f_silu(g[0]) * up[0], f_silu(g[1]) * up[1]); w.y = pk2(f_silu(g[2]) * up[2], f_silu(g[3]) * up[3]);
                    *(u32x2*)(rowp + bj * 64) = w; } }
    }
};
struct EpiGU8 {
    static constexpr bool PERM = true, AFTER_DRAIN = false, F8 = true;
    unsigned char* H;
    __device__ __forceinline__ void operator()(const f32x4 (&acc)[2][2][4][2], const Unit& u, int wr, int wc, int fr, int fq) const {
        const int row0 = u.pm * BM + wr * 64 + fr, col0 = (u.pn & 3) * 128 + wc * 32 + 8 * fq;
        constexpr float dq = 1.0f / (F8_SX * F8_SW);
#pragma unroll
        for (int ai = 0; ai < 2; ++ai)
#pragma unroll
            for (int m = 0; m < 4; ++m) { float h[8];
#pragma unroll
                for (int n = 0; n < 2; ++n) { const f32x4 g = acc[ai][0][m][n] * dq, up = acc[ai][1][m][n] * (dq * F8_SH);
#pragma unroll
                    for (int i = 0; i < 4; ++i) h[4 * n + i] = f_silu(g[i]) * up[i]; }
                u32x2 w; w.x = pk4f8(h[0], h[1], h[2], h[3]); w.y = pk4f8(h[4], h[5], h[6], h[7]);
                *(u32x2*)(H + (size_t)(row0 + ai * HALF + m * 16) * 512 + col0) = w; }
    }
};
struct EpiPlain8 {
    static constexpr bool PERM = true, AFTER_DRAIN = false, F8 = true;
    bf16_t* O; int ldc; int cmask;
    __device__ __forceinline__ void operator()(const f32x4 (&acc)[2][2][4][2], const Unit& u, int wr, int wc, int fr, int fq) const {
        const int row0 = u.pm * BM + wr * 64 + fr, col0 = (u.pn & cmask) * BM + wc * 32 + 8 * fq;
        constexpr float dq = 1.0f / (F8_SH * F8_SW);
#pragma unroll
        for (int ai = 0; ai < 2; ++ai)
#pragma unroll
            for (int m = 0; m < 4; ++m) { bf16_t* rowp = O + (size_t)(row0 + ai * HALF + m * 16) * ldc + col0;
#pragma unroll
                for (int bj = 0; bj < 2; ++bj) { const f32x4 v0 = acc[ai][bj][m][0] * dq, v1 = acc[ai][bj][m][1] * dq;
                    u32x4 w; w.x = pk2(v0[0], v0[1]); w.y = pk2(v0[2], v0[3]); w.z = pk2(v1[0], v1[1]); w.w = pk2(v1[2], v1[3]);
                    *(u32x4*)(rowp + bj * HALF) = w; } }
    }
};

typedef int i32x4_t __attribute__((ext_vector_type(4)));
template <class T, class = void> struct epi_f8 { static constexpr bool value = false; };
template <class T> struct epi_f8<T, decltype((void)T::F8)> { static constexpr bool value = true; };
template <class Epi, class Sched, bool ALIGN_EPI = false, bool SP2 = false>
__device__ __forceinline__ void gemm_phase(PG8_LAS unsigned char* lds, const Gemm g, const Sched& S, const Epi& E) {
    int tid_ = g.wv * 64 + lane_id(); asm volatile("" : "+v"(tid_));
    const int tid = tid_, wid = __builtin_amdgcn_readfirstlane(tid >> 6), lane = tid & 63, wr = wid >> 2, wc = wid & 3, fr = lane & 15, fq = lane >> 4;
    const int K = g.K, nt = K / BK; constexpr bool F8 = epi_f8<Epi>::value;
    unsigned voffA[2], voffB[2];
#pragma unroll
    for (int i = 0; i < 2; ++i) { int R, C; stage_rc(tid * 16 + i * 8192, R, C); const int Rb = Epi::PERM ? ((R & ~31) + perm32(R & 31)) : R;
        voffA[i] = (unsigned)(R * K + C) * 2u;
        voffB[i] = (unsigned)(((Rb >> 4) * (K >> 5) + (C >> 5)) * 1024 + (Rb & 15) * 64 + (C & 31) * 2); }
    constexpr bool GATH = Sched::GATHER; static_assert(!GATH || SP2, "gather mode is written for the SP2 loop");
    unsigned goc[2][2] = {{0u, 0u}, {0u, 0u}}, gon[2][2] = {{0u, 0u}, {0u, 0u}}, go2[2][2] = {{0u, 0u}, {0u, 0u}};
#define PG8_GOFF(dst, U) do { int tg_ = tid; asm volatile("" : "+v"(tg_)); _Pragma("unroll") for (int i_ = 0; i_ < 2; ++i_) { int R_, C_; stage_rc(tg_ * 16 + i_ * 8192, R_, C_); \
        _Pragma("unroll") for (int h_ = 0; h_ < 2; ++h_) dst[h_][i_] = (unsigned)S.src[(U).pm * BM + h_ * HALF + R_] * (unsigned)(K * 2) + (unsigned)C_ * 2u; } } while (0)
    const size_t kstep = (size_t)(BK * 2);
    const size_t kstepB = 2048;
    const size_t hstep = (size_t)HALF * K * 2;
    const size_t tstep = 2 * hstep;
    const unsigned ldsw = (unsigned)wid * 1024u;
    const int aoff = lds_byte(wr * 64 + fr, fq * 8), boff = lds_byte(wc * 32 + fr, fq * 8);
#define PG8_SA(b, h) (((b) * 2 + (h)) * HTB)
#define PG8_SB(b, h) ((4 + (b) * 2 + (h)) * HTB)
#define PG8_STAGE(bufoff, gbase, voff) do { _Pragma("unroll") for (int _i = 0; _i < 2; ++_i) \
        __builtin_amdgcn_global_load_lds((const unsigned*)((const char*)(gbase) + (voff)[_i]), (PG8_LAS unsigned*)(lds + (bufoff) + ldsw + _i * 8192), 16, 0, 0); } while (0)
#define PG8_STAGE_A(b, h, PTR, KPTR, GO) do { if constexpr (GATH) { PG8_STAGE(PG8_SA(b, h), KPTR, GO); } else { PG8_STAGE(PG8_SA(b, h), PTR, voffA); } } while (0)
#define PG8_LDA(dst, b, h) do { _Pragma("unroll") for (int m = 0; m < 4; ++m) _Pragma("unroll") for (int k = 0; k < 2; ++k) dst[m][k] = *(const PG8_LAS bf16x8*)(lds + PG8_SA(b, h) + aoff + m * 2048 + k * 1024); } while (0)
#define PG8_LDB(dst, b, h) do { _Pragma("unroll") for (int n = 0; n < 2; ++n) _Pragma("unroll") for (int k = 0; k < 2; ++k) dst[n][k] = *(const PG8_LAS bf16x8*)(lds + PG8_SB(b, h) + boff + n * 2048 + k * 1024); } while (0)
#define PG8_CAT8(x, y) __builtin_shufflevector(__builtin_bit_cast(i32x4_t, x), __builtin_bit_cast(i32x4_t, y), 0, 1, 2, 3, 4, 5, 6, 7)
#define PG8_MMA(ai, bj, At, Bt) do { __builtin_amdgcn_s_setprio(1); \
        if constexpr (F8) { _Pragma("unroll") for (int m = 0; m < 4; ++m) _Pragma("unroll") for (int n = 0; n < 2; ++n) \
            asm volatile("v_mfma_f32_16x16x128_f8f6f4 %0, %1, %2, %0" : "+v"(acc[ai][bj][m][n]) : "v"(PG8_CAT8(Bt[n][0], Bt[n][1])), "v"(PG8_CAT8(At[m][0], At[m][1]))); } \
        else { _Pragma("unroll") for (int m = 0; m < 4; ++m) _Pragma("unroll") for (int n = 0; n < 2; ++n) _Pragma("unroll") for (int k = 0; k < 2; ++k) \
            acc[ai][bj][m][n] = __builtin_amdgcn_mfma_f32_16x16x32_bf16(Bt[n][k], At[m][k], acc[ai][bj][m][n], 0, 0, 0); } \
        __builtin_amdgcn_s_setprio(0); } while (0)
#define PG8_WAIT_V(n) asm volatile("s_waitcnt vmcnt(" #n ")" ::: "memory")
#define PG8_WAIT_L(n) asm volatile("s_waitcnt lgkmcnt(" #n ")" ::: "memory")
#define PG8_BAR __builtin_amdgcn_s_barrier()
#define PG8_SCHED __builtin_amdgcn_sched_barrier(0)
    Unit cur, nxt; int ui = 0;
    if (!S.next(0, cur)) return;
    f32x4 acc[2][2][4][2];
#pragma unroll
    for (int a = 0; a < 2; ++a)
#pragma unroll
        for (int b = 0; b < 2; ++b)
#pragma unroll
            for (int m = 0; m < 4; ++m)
#pragma unroll
                for (int n = 0; n < 2; ++n) { acc[a][b][m][n] = (f32x4){0.f, 0.f, 0.f, 0.f}; if constexpr (F8) asm volatile("" : "+v"(acc[a][b][m][n])); }
    bf16x8 At[4][2], B0[2][2], B1[2][2];
    const char* cA = (const char*)g.A + (size_t)cur.pm * tstep; const char* cB = (const char*)g.Bt + (size_t)cur.pn * tstep;
    S.a_ready(cur);
    const char* gA = (const char*)g.A;
    if constexpr (GATH) PG8_GOFF(goc, cur);
    if constexpr (SP2) {
        PG8_STAGE(PG8_SB(0, 0), cB, voffB); PG8_STAGE(PG8_SB(0, 1), cB + hstep, voffB); PG8_STAGE_A(0, 0, cA, gA, goc[0]); PG8_STAGE_A(0, 1, cA + hstep, gA, goc[1]);
        if (wr == 1) PG8_BAR;
        PG8_WAIT_V(2); PG8_BAR;
        PG8_STAGE(PG8_SB(1, 0), cB + kstepB, voffB); PG8_STAGE_A(1, 0, cA + kstep, gA + kstep, goc[0]); PG8_STAGE(PG8_SB(1, 1), cB + hstep + kstepB, voffB);
        PG8_WAIT_V(6); PG8_BAR;
    } else {
        PG8_STAGE(PG8_SB(0, 0), cB, voffB); PG8_STAGE(PG8_SA(0, 0), cA, voffA); PG8_STAGE(PG8_SB(0, 1), cB + hstep, voffB); PG8_STAGE(PG8_SA(0, 1), cA + hstep, voffA);
        if (wr == 1) PG8_BAR;
        PG8_WAIT_V(4); PG8_BAR;
        PG8_STAGE(PG8_SB(1, 0), cB + kstepB, voffB); PG8_STAGE(PG8_SA(1, 0), cA + kstep, voffA); PG8_STAGE(PG8_SB(1, 1), cB + hstep + kstepB, voffB);
        PG8_WAIT_V(6); PG8_BAR;
    }
    for (;;) {
        const bool has_next = S.next(ui + 1, nxt);
        if constexpr (GATH) { if (has_next) PG8_GOFF(gon, nxt); else { _Pragma("unroll") for (int h_ = 0; h_ < 2; ++h_) _Pragma("unroll") for (int i_ = 0; i_ < 2; ++i_) gon[h_][i_] = goc[h_][i_]; } }
        const char* nA = has_next ? (const char*)g.A + (size_t)nxt.pm * tstep : cA; const char* nB = has_next ? (const char*)g.Bt + (size_t)nxt.pn * tstep : cB;
        for (int t = 0; t < nt; t += 2) {
            const bool last = (t == nt - 2);
            const char* a1 = cA + (size_t)(t + 1) * kstep;
            const char* a2 = last ? nA : cA + (size_t)(t + 2) * kstep; const char* b2 = last ? nB : cB + (size_t)(t + 2) * kstepB;
            const char* a3 = a2 + kstep; const char* b3 = b2 + kstepB;
            if (last && has_next) S.a_ready(nxt);
            const char* ga1 = gA + (size_t)(t + 1) * kstep; const char* ga2 = last ? gA : gA + (size_t)(t + 2) * kstep; const char* ga3 = ga2 + kstep;
            if constexpr (GATH) { _Pragma("unroll") for (int h_ = 0; h_ < 2; ++h_) _Pragma("unroll") for (int i_ = 0; i_ < 2; ++i_) go2[h_][i_] = last ? gon[h_][i_] : goc[h_][i_]; }
            if constexpr (SP2) {
            PG8_LDB(B0, 0, 0); PG8_LDB(B1, 0, 1); PG8_SCHED; PG8_LDA(At, 0, 0); PG8_STAGE_A(1, 1, a1 + hstep, ga1, goc[1]);
            PG8_WAIT_V(8); PG8_WAIT_L(0); PG8_BAR; PG8_MMA(0, 0, At, B0); PG8_MMA(0, 1, At, B1); PG8_BAR; PG8_SCHED;
            PG8_LDA(At, 0, 1); PG8_STAGE(PG8_SB(0, 0), b2, voffB); PG8_STAGE(PG8_SB(0, 1), b2 + hstep, voffB); PG8_STAGE_A(0, 0, a2, ga2, go2[0]);
            PG8_WAIT_V(8); PG8_WAIT_L(0); PG8_BAR; PG8_MMA(1, 0, At, B0); PG8_MMA(1, 1, At, B1); PG8_BAR; PG8_SCHED;
            PG8_LDB(B0, 1, 0); PG8_LDB(B1, 1, 1); PG8_SCHED; PG8_LDA(At, 1, 0); PG8_STAGE_A(0, 1, a2 + hstep, ga2, go2[1]);
            PG8_WAIT_V(8); PG8_WAIT_L(0); PG8_BAR; PG8_MMA(0, 0, At, B0); PG8_MMA(0, 1, At, B1); PG8_BAR; PG8_SCHED;
            PG8_LDA(At, 1, 1); PG8_STAGE(PG8_SB(1, 0), b3, voffB); PG8_STAGE(PG8_SB(1, 1), b3 + hstep, voffB); PG8_STAGE_A(1, 0, a3, ga3, go2[0]);
            PG8_WAIT_V(8); PG8_WAIT_L(0); PG8_BAR; PG8_MMA(1, 0, At, B0); PG8_MMA(1, 1, At, B1); PG8_BAR; PG8_SCHED;
            } else {
            PG8_LDB(B0, 0, 0); PG8_SCHED; PG8_LDA(At, 0, 0); PG8_STAGE(PG8_SA(1, 1), a1 + hstep, voffA);
            PG8_WAIT_L(8); PG8_BAR; PG8_WAIT_L(0); PG8_MMA(0, 0, At, B0); PG8_BAR; PG8_SCHED;
            PG8_LDB(B1, 0, 1); PG8_STAGE(PG8_SB(0, 0), b2, voffB);
            PG8_BAR; PG8_WAIT_L(0); PG8_MMA(0, 1, At, B1); PG8_BAR;
            PG8_LDA(At, 0, 1); PG8_STAGE(PG8_SA(0, 0), a2, voffA);
            PG8_BAR; PG8_WAIT_L(0); PG8_MMA(1, 0, At, B0); PG8_BAR; PG8_SCHED;
            PG8_STAGE(PG8_SB(0, 1), b2 + hstep, voffB);
            PG8_WAIT_V(6); PG8_BAR; PG8_MMA(1, 1, At, B1); PG8_BAR;
            PG8_LDB(B0, 1, 0); PG8_SCHED; PG8_LDA(At, 1, 0); PG8_STAGE(PG8_SA(0, 1), a2 + hstep, voffA);
            PG8_WAIT_L(8); PG8_BAR; PG8_WAIT_L(0); PG8_MMA(0, 0, At, B0); PG8_BAR; PG8_SCHED;
            PG8_LDB(B1, 1, 1); PG8_STAGE(PG8_SB(1, 0), b3, voffB);
            PG8_BAR; PG8_WAIT_L(0); PG8_MMA(0, 1, At, B1); PG8_BAR;
            PG8_LDA(At, 1, 1); PG8_STAGE(PG8_SA(1, 0), a3, voffA);
            PG8_BAR; PG8_WAIT_L(0); PG8_MMA(1, 0, At, B0); PG8_BAR; PG8_SCHED;
            PG8_STAGE(PG8_SB(1, 1), b3 + hstep, voffB);
            PG8_WAIT_V(6); PG8_BAR; PG8_MMA(1, 1, At, B1); PG8_BAR;
            }
        }
        if constexpr (F8) asm volatile("s_nop 15\n\ts_nop 15" ::: "memory");
        if constexpr (ALIGN_EPI) { if (wr == 0) PG8_BAR; }
        if constexpr (!Epi::AFTER_DRAIN) { E(acc, cur, wr, wc, fr, fq); S.done(cur); }
        if (!has_next) break;
#pragma unroll
        for (int a = 0; a < 2; ++a)
#pragma unroll
            for (int b = 0; b < 2; ++b)
#pragma unroll
                for (int m = 0; m < 4; ++m)
#pragma unroll
                    for (int n = 0; n < 2; ++n) { acc[a][b][m][n] = (f32x4){0.f, 0.f, 0.f, 0.f}; if constexpr (F8) asm volatile("" : "+v"(acc[a][b][m][n])); }
        cur = nxt; cA = nA; cB = nB; ++ui;
        if constexpr (GATH) { _Pragma("unroll") for (int h_ = 0; h_ < 2; ++h_) _Pragma("unroll") for (int i_ = 0; i_ < 2; ++i_) goc[h_][i_] = gon[h_][i_]; }
        if constexpr (ALIGN_EPI) { if (wr == 1) PG8_BAR; }
    }
    PG8_WAIT_V(0);
    if constexpr (!ALIGN_EPI) { if (wr == 0) PG8_BAR; }
    PG8_BAR;
    if constexpr (Epi::AFTER_DRAIN) { E.fused(acc, cur, wr, wc, fr, fq, lds, wid, lane); S.done(cur); }
#undef PG8_SA
#undef PG8_SB
#undef PG8_STAGE
#undef PG8_STAGE_A
#undef PG8_GOFF
#undef PG8_LDA
#undef PG8_LDB
#undef PG8_MMA
#undef PG8_WAIT_V
#undef PG8_WAIT_L
#undef PG8_BAR
#undef PG8_SCHED
}}

namespace mk {
using pg8::bf16_t; using pg8::bf16x8; using pg8::f32x4; using pg8::u32x4; using pg8::u32x2; using pg8::pk2; using pg8::bflo; using pg8::bfhi;
typedef float f32x16 __attribute__((ext_vector_type(16)));
typedef short s16x4 __attribute__((ext_vector_type(4)));
typedef short v4i16_t __attribute__((ext_vector_type(4)));
#define LAS __attribute__((address_space(3)))
#define GAS __attribute__((address_space(1)))
typedef GAS unsigned gu32;
#define RLX_AGENT __ATOMIC_RELAXED, __HIP_MEMORY_SCOPE_AGENT
#define LDS_WAIT() asm volatile("s_waitcnt lgkmcnt(0)" ::: "memory")

constexpr int NB = 8, SEQ = 8192, M = NB * SEQ, D = 1024, NP = 2816, NMEM = 256, MKV = NB * NMEM;
constexpr int PQ = 0, PK = 256, PV = 512, PR = 1024, PG = 1536, PU = 1792, PVS = 2304;
constexpr int DIN = 2576;
constexpr int MOE_ROWS = 135168;
constexpr float ALPHA = 1.4142135623730951f, LN_EPS = 1e-5f, LOG2E = 1.4426950408889634f;
constexpr int NWAVES = 8, NTHR = 512;

constexpr size_t MiB = 1u << 20;
constexpr size_t WS_CTL = 0, CTL_ZERO_BYTES = 1 * MiB;
constexpr size_t WS_WM = 1 * MiB;
constexpr size_t WS_WGCNT = 1 * MiB + 512 * 1024;
constexpr size_t WS_LTOT = 1 * MiB + 768 * 1024;
constexpr size_t WS_TINFO = 2 * MiB;
constexpr size_t WS_TRANK = 3 * MiB;
constexpr size_t WS_TSLOT = 3 * MiB + 512 * 1024;
constexpr size_t WS_SEND = 4 * MiB;
constexpr size_t WS_WKV = 12 * MiB;
constexpr size_t WS_MEMB = 20 * MiB;
constexpr size_t WS_KV = 24 * MiB;
constexpr size_t WS_W = 40 * MiB, W_LAYER = 60 * MiB;
constexpr size_t W_IN = 0, W_OUT = (size_t)NP * D * 2, W_Q = W_OUT + 2 * MiB, W_O = W_Q + 2 * MiB, W_GU = W_O + 2 * MiB, W_D = W_GU + 32 * MiB;
static_assert(W_D + 16 * MiB <= W_LAYER, "weights per layer");
constexpr size_t WS_X = 160 * MiB;
constexpr size_t WS_R = 288 * MiB;
constexpr size_t R_P = 0, R_Y = 352 * MiB, R_Z = 480 * MiB, R_Q = 0, R_O = 128 * MiB, R_XS = 352 * MiB, R_H = 0;
constexpr size_t R_X8 = 256 * MiB;
constexpr size_t WS_SRCROW = WS_R + 616 * MiB;
constexpr size_t WS_PART = WS_SRCROW + 1 * MiB;
constexpr size_t WS_STATS = WS_PART + 8 * MiB;
constexpr size_t WS_CS = WS_STATS + 1 * MiB;
constexpr size_t WS_END = WS_CS + 1 * MiB;
static_assert(R_XS + (size_t)MOE_ROWS * D * 2 <= 616 * MiB && R_H + (size_t)MOE_ROWS * 512 * 2 <= R_XS, "moe buffers");
constexpr int CW_BAR = 4096;

constexpr int LDS_BYTES = 159744, LDSCTL_OFF = 155648;
constexpr int MISC_OFF = LDSCTL_OFF;
constexpr int TILEE_OFF = LDSCTL_OFF + 512;
static_assert(TILEE_OFF + 528 * 4 <= LDS_BYTES, "LDS map");

#define XB_TMO      128
#define XB_XCNT(j)  (256  + 64 * (j))
#define XB_XSUB(j)  (1280 + 64 * (j))
#define XB_XGEN(j)  (2304 + 64 * (j))
#define XB_TOP      3328
#define XB_TOPGEN   3392
#define XCD_BAR_WORDS 3456
#define XB_SPIN_CAP (1u << 18)

__device__ __forceinline__ unsigned xb_ld(unsigned* p)              { return __hip_atomic_load(p, __ATOMIC_RELAXED, __HIP_MEMORY_SCOPE_AGENT); }
__device__ __forceinline__ unsigned xb_add(unsigned* p, unsigned v) { return __hip_atomic_fetch_add(p, v, __ATOMIC_RELAXED, __HIP_MEMORY_SCOPE_AGENT); }
__device__ __forceinline__ unsigned xb_xcc_id() { return (unsigned)__builtin_amdgcn_s_getreg((3 << 11) | 20) & 0xFu; }
#define XB_SPIN(cond, bar) do { unsigned _sp = 0; while (cond) { __builtin_amdgcn_s_sleep(1); \
    if ((++_sp & 255u) == 0u) { if (xb_ld(&(bar)[XB_TMO])) break; if (_sp > XB_SPIN_CAP) { atomicAdd(&(bar)[XB_TMO], 1u); break; } } } } while (0)

struct XcdBarrier {
    unsigned* bar; unsigned x;
    volatile LAS unsigned* st;
    int wv;
};

__device__ __forceinline__ XcdBarrier xcd_barrier_post(unsigned* bar, volatile LAS unsigned* st) {
    XcdBarrier b; b.bar = bar; b.x = xb_xcc_id(); b.st = st; b.wv = 0;
    if (threadIdx.x == 0) (void)xb_add(&bar[XB_XCNT(b.x)], 1u);
    return b;
}
__device__ __forceinline__ void xcd_barrier_complete(unsigned* bar, unsigned x, unsigned& nloc, unsigned& nx) {
    const unsigned G = gridDim.x * gridDim.y * gridDim.z;
    unsigned sum, cnt, mine, sp = 0u;
    for (;;) {
        sum = 0u; cnt = 0u; mine = 0u;
#pragma unroll
        for (unsigned j = 0; j < 16; ++j) { const unsigned c = xb_ld(&bar[XB_XCNT(j)]); sum += c; cnt += (c > 0u) ? 1u : 0u; mine = (j == x) ? c : mine; }
        if (sum == G) break;
        __builtin_amdgcn_s_sleep(1);
        if ((++sp & 255u) == 0u) { if (xb_ld(&bar[XB_TMO])) break; if (sp > XB_SPIN_CAP) { atomicAdd(&bar[XB_TMO], 1u); break; } }
    }
    nloc = mine > 0u ? mine : 1u; nx = cnt > 0u ? cnt : 1u;
}

__device__ __forceinline__ void xcd_barrier(const XcdBarrier& b) {
    asm volatile("s_waitcnt vmcnt(0)" ::: "memory");
    __syncthreads();
    if (b.wv == 0 && pg8::lane_id() == 0) {
        unsigned* bar = b.bar;
        __builtin_amdgcn_s_waitcnt(0);
        unsigned nloc = b.st[0], nx = b.st[1];
        if (nloc == 0u) { xcd_barrier_complete(bar, b.x, nloc, nx); b.st[0] = nloc; b.st[1] = nx; }
        const unsigned old = xb_add(&bar[XB_XSUB(b.x)], 1u);
        const unsigned gen = old / nloc;
        if (old + 1u == (gen + 1u) * nloc) {
            __builtin_amdgcn_fence(__ATOMIC_RELEASE, "agent");
            asm volatile("s_waitcnt vmcnt(0)" ::: "memory");
            const unsigned og = xb_add(&bar[XB_TOP], 1u);
            const unsigned tg = og / nx;
            if (og + 1u == (tg + 1u) * nx) xb_add(&bar[XB_TOPGEN], 1u);
            else XB_SPIN(xb_ld(&bar[XB_TOPGEN]) == tg, bar);
            __builtin_amdgcn_fence(__ATOMIC_ACQUIRE, "agent");
            xb_add(&bar[XB_XGEN(b.x)], 1u);
            asm volatile("s_waitcnt vmcnt(0)" ::: "memory");
        } else {
            XB_SPIN(xb_ld(&bar[XB_XGEN(b.x)]) == gen, bar);
            __builtin_amdgcn_fence(__ATOMIC_ACQUIRE, "agent");
            asm volatile("s_waitcnt vmcnt(0)" ::: "memory");
        }
    }
    __syncthreads();
}
__device__ __forceinline__ float shx(float v, int m, int lane) { return __builtin_bit_cast(float, __builtin_amdgcn_ds_bpermute((lane ^ m) << 2, __builtin_bit_cast(int, v))); }
__device__ __forceinline__ int shxi(int v, int m, int lane) { return __builtin_amdgcn_ds_bpermute((lane ^ m) << 2, v); }
__device__ __forceinline__ s16x4 vtr(unsigned lds_addr) { return __builtin_bit_cast(s16x4, __builtin_amdgcn_ds_read_tr16_b64_v4i16((LAS v4i16_t*)(size_t)lds_addr)); }
__device__ __forceinline__ bf16x8 cat8(s16x4 lo, s16x4 hi) { return __builtin_shufflevector(lo, hi, 0, 1, 2, 3, 4, 5, 6, 7); }
__device__ __forceinline__ void unpack8(const u32x4 w, float (&f)[8]) { f[0] = bflo(w.x); f[1] = bfhi(w.x); f[2] = bflo(w.y); f[3] = bfhi(w.y); f[4] = bflo(w.z); f[5] = bfhi(w.z); f[6] = bflo(w.w); f[7] = bfhi(w.w); }
__device__ __forceinline__ u32x4 pack8(const float (&f)[8]) { u32x4 w; w.x = pk2(f[0], f[1]); w.y = pk2(f[2], f[3]); w.z = pk2(f[4], f[5]); w.w = pk2(f[6], f[7]); return w; }

struct Args {
    const float* in[22]; float* out; unsigned char* ws;
};

__device__ __forceinline__ void transpose_item(const float* p0, const float* p1, int ld, int mode, float scale, int K, int nblk, bf16_t* dst, int row0, LAS float* scr, int item, int lane, const float* kscale = nullptr) {
    const int kb = item / nblk, nb = item % nblk, k0 = 64 * kb, n0 = 32 * nb;
    const int np = n0 + (lane & 31);
    const float* sp; int col;
    if (mode == 0) { sp = p0; col = np; } else { sp = (np & 4) ? p1 : p0; col = (np >> 3) * 4 + (np & 3); }
    sp += (size_t)k0 * ld + col;
#pragma unroll 8
    for (int i = 0; i < 32; ++i) { const int kk = 2 * i + (lane >> 5); scr[kk * 33 + (lane & 31)] = sp[(size_t)kk * ld] * scale * (kscale ? kscale[k0 + kk] : 1.0f); }
    LDS_WAIT(); asm volatile("" ::: "memory");
    const int c = lane & 7;
#pragma unroll
    for (int j = 0; j < 4; ++j) { const int n = (lane >> 3) + 8 * j; const LAS float* s = scr + (8 * c) * 33 + n;
        u32x4 o; o.x = pk2(s[0 * 33], s[1 * 33]); o.y = pk2(s[2 * 33], s[3 * 33]); o.z = pk2(s[4 * 33], s[5 * 33]); o.w = pk2(s[6 * 33], s[7 * 33]);
        const int ng = row0 + n0 + n, kk = k0 + 8 * c;
        *(u32x4*)(dst + ((size_t)(ng >> 4) * (K >> 5) + (kk >> 5)) * 512 + (ng & 15) * 32 + (kk & 31)) = o; }
    LDS_WAIT(); asm volatile("" ::: "memory");
}
__device__ __forceinline__ void transpose_item8(const float* p0, const float* p1, int ld, int mode, float scale, int K, int nblk, unsigned char* dst, int row0, LAS float* scr, int item, int lane) {
    const int kb = item / nblk, nb = item % nblk, k0 = 64 * kb, n0 = 32 * nb;
    const int np = n0 + (lane & 31);
    const float* sp; int col;
    if (mode == 0) { sp = p0; col = np; } else { sp = ((np >> 7) & 1) ? p1 : p0; col = (np >> 8) * 128 + (np & 127); }
    sp += (size_t)k0 * ld + col;
#pragma unroll 8
    for (int i = 0; i < 32; ++i) { const int kk = 2 * i + (lane >> 5); scr[kk * 33 + (lane & 31)] = sp[(size_t)kk * ld] * scale; }
    LDS_WAIT(); asm volatile("" ::: "memory");
    const int c = lane & 7;
#pragma unroll
    for (int j = 0; j < 4; ++j) { const int n = (lane >> 3) + 8 * j; const LAS float* s = scr + (8 * c) * 33 + n;
        u32x2 o; o.x = pg8::pk4f8(s[0 * 33], s[1 * 33], s[2 * 33], s[3 * 33]); o.y = pg8::pk4f8(s[4 * 33], s[5 * 33], s[6 * 33], s[7 * 33]);
        const int ng = row0 + n0 + n;
        *(u32x2*)(dst + ((size_t)(ng >> 4) * (K >> 6) + (k0 >> 6)) * 1024 + (ng & 15) * 64 + 8 * c) = o; }
    LDS_WAIT(); asm volatile("" ::: "memory");
}
__device__ __forceinline__ void p0_convert(const Args& a, LAS unsigned char* lds, int bid, int G, int wave_s) {
    int tid_ = wave_s * 64 + pg8::lane_id(); asm volatile("" : "+v"(tid_)); const int tid = tid_, lane = tid & 63, wave = __builtin_amdgcn_readfirstlane(tid >> 6);
    unsigned char* ws = a.ws;
    LAS float* scr = (LAS float*)(lds + wave * 16384);
    const int gw = bid * NWAVES + wave, NGW = G * NWAVES;
    constexpr int I_INQ = 16 * 8, I_INB = 16 * 40, I_INC = 16 * 32, I_SQ = 16 * 32, I_GU = 16 * 16 * 32, I_DN = 16 * 8 * 32;
    constexpr int I_LAYER = I_INQ + I_INB + I_INC + 5 * I_SQ + I_GU + I_DN;
    for (int it = gw; it < 2 * I_LAYER; it += NGW) {
        const int l = it / I_LAYER; int r = it % I_LAYER;
        unsigned char* wl = ws + WS_W + (size_t)l * W_LAYER;
        const float* w_in = a.in[2] + (size_t)l * D * DIN;
        if (r < I_INQ) { transpose_item(w_in, nullptr, DIN, 0, 0.125f, D, 8, (bf16_t*)(wl + W_IN), 0, scr, r, lane); continue; } r -= I_INQ;
        if (r < I_INB) { transpose_item(w_in + 256, nullptr, DIN, 0, 1.0f, D, 40, (bf16_t*)(wl + W_IN), 256, scr, r, lane); continue; } r -= I_INB;
        if (r < I_INC) { transpose_item(w_in + 1552, nullptr, DIN, 0, 1.0f, D, 32, (bf16_t*)(wl + W_IN), 1792, scr, r, lane); continue; } r -= I_INC;
        if (r < I_SQ) { transpose_item(a.in[10] + (size_t)l * D * D, nullptr, D, 0, 1.0f, D, 32, (bf16_t*)(wl + W_OUT), 0, scr, r, lane); continue; } r -= I_SQ;
        if (r < I_SQ) { transpose_item(a.in[11] + (size_t)l * D * D, nullptr, D, 0, 0.0625f, D, 32, (bf16_t*)(wl + W_Q), 0, scr, r, lane, a.in[20] + (size_t)(l * 3 + 0) * D); continue; } r -= I_SQ;
        if (r < I_SQ) { transpose_item(a.in[14] + (size_t)l * D * D, nullptr, D, 0, 1.0f, D, 32, (bf16_t*)(wl + W_O), 0, scr, r, lane); continue; } r -= I_SQ;
        if (r < I_SQ) { transpose_item(a.in[12] + (size_t)l * D * D, nullptr, D, 0, 1.0f, D, 32, (bf16_t*)(ws + WS_WKV), l * 2048, scr, r, lane); continue; } r -= I_SQ;
        if (r < I_SQ) { transpose_item(a.in[13] + (size_t)l * D * D, nullptr, D, 0, 1.0f, D, 32, (bf16_t*)(ws + WS_WKV), l * 2048 + 1024, scr, r, lane); continue; } r -= I_SQ;
        if (r < I_GU) { const int e = r / 512, rr = r % 512; const size_t eo = ((size_t)l * 16 + e) * D * 512;
            transpose_item8(a.in[17] + eo, a.in[18] + eo, 512, 2, pg8::F8_SW, D, 32, wl + W_GU, e * 1024, scr, rr, lane); continue; } r -= I_GU;
        { const int e = r / 256, rr = r % 256; const size_t eo = ((size_t)l * 16 + e) * 512 * D;
            transpose_item8(a.in[19] + eo, nullptr, D, 0, pg8::F8_SW, 512, 32, wl + W_D, e * 1024, scr, rr, lane); }
    }
    const size_t gt = (size_t)bid * NTHR + tid, NT = (size_t)G * NTHR;
    for (int it = gw; it < 2 * 16 * 16; it += NGW) { const int l = it >> 8, kc = (it >> 4) & 15, n = (it & 15) * 64 + lane;
        const float* wq = a.in[11] + (size_t)l * D * D; const float* gg = a.in[20] + (size_t)(l * 3) * D; const float* bb = a.in[21] + (size_t)(l * 3) * D; float cs = 0.f, bq = 0.f;
#pragma unroll 8
        for (int k = 64 * kc; k < 64 * kc + 64; ++k) { const float w = wq[(size_t)k * D + n] * 0.0625f; cs += bflo(pk2(w * gg[k], 0.f) & 0xffffu); bq += w * bb[k]; }
        float* tb = (float*)(ws + WS_CS) + (size_t)l * 2 * 16 * 1024; tb[kc * 1024 + n] = cs; tb[16 * 1024 + kc * 1024 + n] = bq; }
    for (size_t i = gt; i < (size_t)2 * 256 * 128; i += NT) {
        const int l = (int)(i / (256 * 128)), r = (int)(i % (256 * 128)), j = r / 128, k8 = r % 128;
        const float* w_in = a.in[2] + (size_t)l * D * DIN; const float* w_a2 = a.in[3] + (size_t)l * 16 * 256;
        float wa[16];
#pragma unroll
        for (int q = 0; q < 16; ++q) wa[q] = w_a2[q * 256 + j];
        float o[8];
#pragma unroll
        for (int kk = 0; kk < 8; ++kk) { const float* wr = w_in + (size_t)(8 * k8 + kk) * DIN + 1536; float s = 0.f;
#pragma unroll
            for (int q = 0; q < 16; q += 4) { const f32x4 v = *(const f32x4*)(wr + q); s += v[0] * wa[q] + v[1] * wa[q + 1] + v[2] * wa[q + 2] + v[3] * wa[q + 3]; }
            o[kk] = s; }
        { const int ng = 1536 + j, kk = 8 * k8; *(u32x4*)((bf16_t*)(ws + WS_W + (size_t)l * W_LAYER + W_IN) + ((size_t)(ng >> 4) * (D >> 5) + (kk >> 5)) * 512 + (ng & 15) * 32 + (kk & 31)) = pack8(o); }
    }
    for (size_t i = gt; i < (size_t)2 * 4 * 128 * 16; i += NT) {
        const int s8 = (int)(i & 15), t = (int)((i >> 4) & 127);
        const float* src = a.in[6] + i * 8; float o[8];
#pragma unroll
        for (int q = 0; q < 8; ++q) o[q] = ((8 * s8 + q) / 64 <= t / 64) ? src[q] : 0.f;
        *(u32x4*)((bf16_t*)(ws + WS_WM) + i * 8) = pack8(o);
    }
    for (size_t i = gt; i < (size_t)M * D / 8; i += NT) {
        const f32x4 v0 = *(const f32x4*)(a.in[0] + i * 8), v1 = *(const f32x4*)(a.in[0] + i * 8 + 4);
        u32x4 w; w.x = pk2(v0[0], v0[1]); w.y = pk2(v0[2], v0[3]); w.z = pk2(v1[0], v1[1]); w.w = pk2(v1[2], v1[3]);
        *(u32x4*)((bf16_t*)(ws + WS_X) + i * 8) = w;
    }
    for (size_t i = gt; i < (size_t)MKV * D / 8; i += NT) {
        const f32x4 v0 = *(const f32x4*)(a.in[1] + i * 8), v1 = *(const f32x4*)(a.in[1] + i * 8 + 4);
        u32x4 w; w.x = pk2(v0[0], v0[1]); w.y = pk2(v0[2], v0[3]); w.z = pk2(v1[0], v1[1]); w.w = pk2(v1[2], v1[3]);
        *(u32x4*)((bf16_t*)(ws + WS_MEMB) + i * 8) = w;
    }
}

constexpr int GL_KD = 0, GL_QS = 9216, GL_VS = 18432, GL_PSUM = 35840, GL_DL = 37888, GL_SSQ = 38144;
template <bool FINAL>
__device__ __forceinline__ void gla_phase(LAS unsigned char* lds, const bf16_t* P, float* Send, float* Ltot, bf16_t* Y, const float* gn_g, int bid, int G, int wave_s) {
    int tid_ = wave_s * 64 + pg8::lane_id(); asm volatile("" : "+v"(tid_)); const int tid = tid_, lane = tid & 63, wave = __builtin_amdgcn_readfirstlane(tid >> 6);
    const unsigned lb = (unsigned)(size_t)lds;
    const int g = lane >> 4, l15 = lane & 15, q4 = l15 >> 2, p4 = lane & 3;
    const int kq = tid & 63, part = wave;
    for (int item = bid; item < 256; item += G) {
        const int b = item >> 5, h = (item >> 3) & 3, run = item & 7, bh = item >> 3;
        f32x4 sacc[4];
#pragma unroll
        for (int kt = 0; kt < 4; ++kt) sacc[kt] = (f32x4){0.f, 0.f, 0.f, 0.f};
        if (FINAL) {
            for (int i = 0; i < run; ++i) {
                const float* se = Send + ((size_t)(bh * 8 + i) * 64) * 128; const float* lt = Ltot + (size_t)(bh * 8 + i) * 64;
#pragma unroll
                for (int kt = 0; kt < 4; ++kt)
#pragma unroll
                    for (int r = 0; r < 4; ++r) { const int k = 16 * kt + 4 * g + r; sacc[kt][r] = __expf(lt[k]) * sacc[kt][r] + se[(size_t)k * 128 + 16 * wave + l15]; }
            }
        }
        float ltot_acc = 0.f;
        unsigned short graw[8], kraw[8]; u32x4 vraw[2], qraw; u32x2 rraw[4];
        const int v_row = tid >> 4, v_c16 = tid & 15, q_row = tid >> 3, q_c16 = tid & 7;
        const int ycol = h * 128 + 16 * wave + 4 * g;
#define GLA_FETCH(CC) do { const size_t tf_ = (size_t)b * SEQ + (size_t)(run * 16 + (CC)) * 64; \
            _Pragma("unroll") for (int i = 0; i < 8; ++i) { const bf16_t* rp = P + (tf_ + 8 * part + i) * NP + h * 64 + kq; graw[i] = rp[PG]; kraw[i] = rp[PK]; } \
            _Pragma("unroll") for (int i = 0; i < 2; ++i) vraw[i] = *(const u32x4*)(P + (tf_ + v_row + 32 * i) * NP + PV + h * 128 + v_c16 * 8); \
            if (FINAL) { qraw = *(const u32x4*)(P + (tf_ + q_row) * NP + PQ + h * 64 + q_c16 * 8); \
                _Pragma("unroll") for (int tt = 0; tt < 4; ++tt) rraw[tt] = *(const u32x2*)(P + (tf_ + 16 * tt + l15) * NP + PR + ycol); } } while (0)
        GLA_FETCH(0);
        for (int c = 0; c < 16; ++c) {
            const size_t t0 = (size_t)b * SEQ + (size_t)(run * 16 + c) * 64;
            __syncthreads();
            float gv[8], kv[8];
#pragma unroll
            for (int i = 0; i < 8; ++i) { gv[i] = __builtin_bit_cast(float, (unsigned)graw[i] << 16); kv[i] = __builtin_bit_cast(float, (unsigned)kraw[i] << 16); }
#pragma unroll
            for (int i = 1; i < 8; ++i) gv[i] += gv[i - 1];
            ((LAS float*)(lds + GL_PSUM))[part * 64 + kq] = gv[7];
#pragma unroll
            for (int i = 0; i < 2; ++i) *(LAS u32x4*)(lds + GL_VS + (v_row + 32 * i) * 272 + v_c16 * 16) = vraw[i];
            u32x2 rcur[4];
            if (FINAL) { *(LAS u32x4*)(lds + GL_QS + q_row * 144 + q_c16 * 16) = qraw;
#pragma unroll
                for (int tt = 0; tt < 4; ++tt) rcur[tt] = rraw[tt]; }
            if (c + 1 < 16) GLA_FETCH(c + 1);
            __syncthreads();
            float offs = 0.f, bl = 0.f;
#pragma unroll
            for (int p = 0; p < 8; ++p) { const float v = ((LAS float*)(lds + GL_PSUM))[p * 64 + kq]; offs += (p < part) ? v : 0.f; bl += v; }
#pragma unroll
            for (int i = 0; i < 8; ++i) { const float kd = kv[i] * __expf(bl - (offs + gv[i]));
                *(LAS unsigned short*)(lds + GL_KD + (8 * part + i) * 144 + kq * 2) = (unsigned short)(pk2(kd, 0.f) & 0xffffu); }
            if (part == 0) ((LAS float*)(lds + GL_DL))[kq] = __expf(bl);
            ltot_acc += bl;
            __syncthreads();
#pragma unroll
            for (int kt = 0; kt < 4; ++kt) { const f32x4 dl = *(LAS f32x4*)(lds + GL_DL + (16 * kt + 4 * g) * 4); sacc[kt] = sacc[kt] * dl; }
#pragma unroll
            for (int ks = 0; ks < 2; ++ks) {
                const unsigned vrow = lb + GL_VS + (unsigned)(32 * ks + 8 * g + q4) * 272u + (unsigned)(16 * wave + 4 * p4) * 2u;
                const bf16x8 vb = cat8(vtr(vrow), vtr(vrow + 4u * 272u));
#pragma unroll
                for (int kt = 0; kt < 4; ++kt) {
                    const unsigned krow = lb + GL_KD + (unsigned)(32 * ks + 8 * g + q4) * 144u + (unsigned)(16 * kt + 4 * p4) * 2u;
                    const bf16x8 ka = cat8(vtr(krow), vtr(krow + 4u * 144u));
                    sacc[kt] = __builtin_amdgcn_mfma_f32_16x16x32_bf16(ka, vb, sacc[kt], 0, 0, 0);
                }
            }
            if (FINAL) {
                f32x4 oacc[4];
#pragma unroll
                for (int tt = 0; tt < 4; ++tt) oacc[tt] = (f32x4){0.f, 0.f, 0.f, 0.f};
#pragma unroll
                for (int ks2 = 0; ks2 < 2; ++ks2) {
                    u32x4 spw; spw.x = pk2(sacc[2 * ks2][0], sacc[2 * ks2][1]); spw.y = pk2(sacc[2 * ks2][2], sacc[2 * ks2][3]);
                    spw.z = pk2(sacc[2 * ks2 + 1][0], sacc[2 * ks2 + 1][1]); spw.w = pk2(sacc[2 * ks2 + 1][2], sacc[2 * ks2 + 1][3]);
                    const bf16x8 sp = __builtin_bit_cast(bf16x8, spw);
#pragma unroll
                    for (int tt = 0; tt < 4; ++tt) {
                        const LAS unsigned char* qp = lds + GL_QS + (16 * tt + l15) * 144 + (32 * ks2 + 4 * g) * 2;
                        const u32x2 qlo = *(const LAS u32x2*)qp, qhi = *(const LAS u32x2*)(qp + 32);
                        u32x4 qw; qw.x = qlo.x; qw.y = qlo.y; qw.z = qhi.x; qw.w = qhi.y;
                        oacc[tt] = __builtin_amdgcn_mfma_f32_16x16x32_bf16(sp, __builtin_bit_cast(bf16x8, qw), oacc[tt], 0, 0, 0);
                    }
                }
#pragma unroll
                for (int tt = 0; tt < 4; ++tt) { float s = oacc[tt][0] * oacc[tt][0] + oacc[tt][1] * oacc[tt][1] + oacc[tt][2] * oacc[tt][2] + oacc[tt][3] * oacc[tt][3];
                    s += shx(s, 16, lane); s += shx(s, 32, lane);
                    if (g == 0) ((LAS float*)(lds + GL_SSQ))[wave * 64 + 16 * tt + l15] = s; }
                __syncthreads();
                const int col = h * 128 + 16 * wave + 4 * g;
                const f32x4 gn = *(const f32x4*)(gn_g + col);
#pragma unroll
                for (int tt = 0; tt < 4; ++tt) { float tot = 0.f;
#pragma unroll
                    for (int w2 = 0; w2 < 8; ++w2) tot += ((LAS float*)(lds + GL_SSQ))[w2 * 64 + 16 * tt + l15];
                    const float rs = __builtin_amdgcn_rsqf(tot * (1.0f / 128.0f) + 1e-6f);
                    const size_t tok = t0 + 16 * tt + l15;
                    const u32x2 rr = rcur[tt];
                    u32x2 w; w.x = pk2(oacc[tt][0] * rs * gn[0] * bflo(rr.x), oacc[tt][1] * rs * gn[1] * bfhi(rr.x));
                    w.y = pk2(oacc[tt][2] * rs * gn[2] * bflo(rr.y), oacc[tt][3] * rs * gn[3] * bfhi(rr.y));
                    *(u32x2*)(Y + tok * D + col) = w; }
            }
        }
        if (!FINAL) {
            float* se = Send + ((size_t)(bh * 8 + run) * 64) * 128;
#pragma unroll
            for (int kt = 0; kt < 4; ++kt)
#pragma unroll
                for (int r = 0; r < 4; ++r) se[(size_t)(16 * kt + 4 * g + r) * 128 + 16 * wave + l15] = sacc[kt][r];
            if (part == 0) Ltot[(size_t)(bh * 8 + run) * 64 + kq] = ltot_acc;
        }
    }
}

#undef GLA_FETCH
constexpr int SG_VN = 0;
__device__ __forceinline__ void sgu_phase(LAS unsigned char* lds, const bf16_t* P, const bf16_t* Wm, const float* b_s, const float* lg, const float* lb_, bf16_t* Y, int bid, int G, int wave_s) {
    int tid_ = wave_s * 64 + pg8::lane_id(); asm volatile("" : "+v"(tid_)); const int tid = tid_, lane = tid & 63, wave = __builtin_amdgcn_readfirstlane(tid >> 6);
    const unsigned lb = (unsigned)(size_t)lds;
    const int g = lane >> 4, l15 = lane & 15, q4 = l15 >> 2, p4 = lane & 3;
    const int row = tid >> 2, qu = tid & 3;
    u32x4 vraw[4]; u32x2 uraw[8];
#define SGU_FETCH(IT) do { const int blk_ = (IT) >> 2, gr_ = (IT) & 3; const size_t tf_ = (size_t)blk_ * 128; \
        const bf16_t* src_ = P + (tf_ + row) * NP + PVS + gr_ * 128 + 32 * qu; \
        _Pragma("unroll") for (int i = 0; i < 4; ++i) vraw[i] = *(const u32x4*)(src_ + 8 * i); \
        const bf16_t* us_ = P + (tf_ + 16 * wave + l15) * NP + PU + gr_ * 128 + 4 * g; \
        _Pragma("unroll") for (int ct = 0; ct < 8; ++ct) uraw[ct] = *(const u32x2*)(us_ + 16 * ct); } while (0)
    if (bid < 2048) SGU_FETCH(bid);
    for (int item = bid; item < 2048; item += G) {
        const int blk = item >> 2, gr = item & 3; const size_t t0 = (size_t)blk * 128;
        __syncthreads();
        u32x2 ucur[8];
        { float v[32];
#pragma unroll
          for (int i = 0; i < 4; ++i) { float f[8]; unpack8(vraw[i], f);
#pragma unroll
              for (int j = 0; j < 8; ++j) v[8 * i + j] = f[j]; }
#pragma unroll
          for (int ct = 0; ct < 8; ++ct) ucur[ct] = uraw[ct];
          if (item + G < 2048) SGU_FETCH(item + G);
          float s = 0.f;
#pragma unroll
          for (int i = 0; i < 32; ++i) s += v[i];
          s += shx(s, 1, lane); s += shx(s, 2, lane);
          const float mu = s * (1.0f / 128.0f); float qq = 0.f;
#pragma unroll
          for (int i = 0; i < 32; ++i) { v[i] -= mu; qq += v[i] * v[i]; }
          qq += shx(qq, 1, lane); qq += shx(qq, 2, lane);
          const float rs = __builtin_amdgcn_rsqf(qq * (1.0f / 128.0f) + LN_EPS);
          const float* gp = lg + gr * 128 + 32 * qu; const float* bp = lb_ + gr * 128 + 32 * qu;
#pragma unroll
          for (int i = 0; i < 4; ++i) { float f[8];
#pragma unroll
              for (int j = 0; j < 8; ++j) f[j] = v[8 * i + j] * rs * gp[8 * i + j] + bp[8 * i + j];
              *(LAS u32x4*)(lds + SG_VN + row * 272 + (32 * qu + 8 * i) * 2) = pack8(f); }
        }
        __syncthreads();
        const int nks = (wave < 4) ? 2 : 4;
        bf16x8 wf[4];
#pragma unroll
        for (int ks = 0; ks < 4; ++ks) wf[ks] = *(const bf16x8*)(Wm + ((size_t)(gr * 128 + 16 * wave + l15)) * 128 + 32 * ks + 8 * g);
        const size_t tok = t0 + 16 * wave + l15; const float bs = b_s[gr * 128 + 16 * wave + l15];
        unsigned vb0 = lb + SG_VN + (unsigned)(8 * g + q4) * 272u + (unsigned)(4 * p4) * 2u; asm volatile("" : "+v"(vb0));
#pragma unroll
        for (int ct = 0; ct < 8; ++ct) {
            f32x4 acc = (f32x4){0.f, 0.f, 0.f, 0.f};
#pragma unroll
            for (int ks = 0; ks < 4; ++ks) {
                if (ks < nks) {
                    const unsigned vrow = vb0 + (unsigned)(32 * ks * 272 + 32 * ct);
                    const bf16x8 va = cat8(vtr(vrow), vtr(vrow + 4u * 272u));
                    acc = __builtin_amdgcn_mfma_f32_16x16x32_bf16(va, wf[ks], acc, 0, 0, 0);
                }
            }
            const int col = gr * 128 + 16 * ct + 4 * g;
            const u32x2 uu = ucur[ct];
            u32x2 w; w.x = pk2(bflo(uu.x) * (acc[0] + bs), bfhi(uu.x) * (acc[1] + bs)); w.y = pk2(bflo(uu.y) * (acc[2] + bs), bfhi(uu.y) * (acc[3] + bs));
            *(u32x2*)(Y + tok * D + 512 + col) = w;
        }
    }
}
#undef SGU_FETCH

constexpr int AT_KPS = 1040, AT_VPS = 1088, AT_SLOT = 34816, AT_NSLOT = 3;
static_assert(AT_NSLOT * AT_SLOT <= LDSCTL_OFF, "attention LDS");
__device__ __forceinline__ void glds16(const void* gsrc, unsigned lds_dst) { unsigned keep;
    asm volatile("s_mov_b32 %0, m0\n\ts_mov_b32 m0, %2\n\ts_nop 0\n\tglobal_load_lds_dwordx4 %1, off\n\ts_mov_b32 m0, %0" : "=&s"(keep) : "v"(gsrc), "s"(lds_dst) : "memory"); }
__device__ __forceinline__ void attn_dma(unsigned lb, const char* kvb, int so, unsigned lane_off, int slot, int ps, int wave) {
#pragma unroll
    for (int j = 0; j < 4; ++j) { const int pi = 4 * wave + j, rlo = 32 * (pi >> 4) + (pi & 15);
        glds16(kvb + (size_t)(so + rlo * 8192) + lane_off, (unsigned)__builtin_amdgcn_readfirstlane((int)(lb + (unsigned)(slot * AT_SLOT + pi * ps)))); }
}
#define AT_WAITBAR(N) do { asm volatile("s_waitcnt vmcnt(" #N ") lgkmcnt(0)" ::: "memory"); __builtin_amdgcn_s_barrier(); asm volatile("" ::: "memory"); } while (0)
__device__ __forceinline__ void attn_phase(LAS unsigned char* lds, const bf16_t* Q, const bf16_t* KV, bf16_t* O, int layer, int bid, int G, int wave_s) {
    int tid_ = wave_s * 64 + pg8::lane_id(); asm volatile("" : "+v"(tid_)); const int tid = tid_, lane = tid & 63, wave = __builtin_amdgcn_readfirstlane(tid >> 6);
    const unsigned lb = (unsigned)(size_t)lds;
    const int r32 = lane & 31, hh = lane >> 5, q4 = (lane & 15) >> 2, p4 = lane & 3, blk = (lane >> 4) & 1;
    LAS unsigned char* kbase = lds + (r32 & 15) * AT_KPS + ((r32 >> 4) & 1) * 512 + hh * 16;
    unsigned vbase = lb + (unsigned)(4 * hh + q4) * (unsigned)AT_VPS + (unsigned)(16 * blk + 4 * p4) * 2u;
    unsigned lane_off = (unsigned)((lane >> 5) * 16 * 8192 + (lane & 31) * 16);
    asm volatile("" : "+v"(kbase), "+v"(vbase), "+v"(lane_off));
    const char* kvb = (const char*)KV;
    const int nun = (bid < 256) ? 4 * ((256 - bid + G - 1) / G) : 0;
#define AT_SRC(N, ST) ((int)((((size_t)(((bid + ((N) >> 2) * G) >> 5) * NMEM) * 4096 + layer * 2048 + ((N) & 3) * 256 + (((ST) >> 2) * 1024)) * 2) + ((ST) & 3) * 64 * 8192))
    __syncthreads();
    if (nun > 0) { attn_dma(lb, kvb, AT_SRC(0, 0), lane_off, 0, AT_KPS, wave); attn_dma(lb, kvb, AT_SRC(0, 1), lane_off, 1, AT_KPS, wave); AT_WAITBAR(4); }
    int sl = 0;
    for (int n = 0; n < nun; ++n) {
        const int pan = bid + (n >> 2) * G, h = n & 3, b = pan >> 5, qt = pan & 31;
        int ln_ = pg8::lane_id(); asm volatile("" : "+v"(ln_));
        const unsigned qoff = (unsigned)((wave * 16 * 64 + ln_) * 16);
        const char* qbase = (const char*)(Q + (size_t)(pan * 4 + h) * 65536);
        char* obase = (char*)(O + ((size_t)b * SEQ + qt * 256) * D + h * 256);
        const bool more = (n + 1 < nun);
        bf16x8 qf[16];
#pragma unroll
        for (int s = 0; s < 16; ++s) qf[s] = *(const GAS bf16x8*)(qbase + qoff + 1024 * s);
        float ml = 0.f, lsum = 0.f;
        bf16x8 pk[8][2];
#pragma unroll
        for (int st = 0; st < 4; ++st) {
            const int sl2 = (sl >= 1) ? sl - 1 : 2;
            if (st > 0) attn_dma(lb, kvb, AT_SRC(n, st + 2), lane_off, sl2, (st + 2 < 4) ? AT_KPS : AT_VPS, wave);
            LAS unsigned char* kb = kbase + sl * AT_SLOT;
            f32x16 sa[2];
#pragma unroll
            for (int kt = 0; kt < 2; ++kt)
#pragma unroll
                for (int r = 0; r < 16; ++r) sa[kt][r] = 0.f;
            bf16x8 kfa[2], kfb[2];
#define AT_KLD(dst, S0) do { _Pragma("unroll") for (int kt = 0; kt < 2; ++kt) dst[kt] = *(const LAS bf16x8*)(kb + kt * 16 * AT_KPS + 32 * (S0)); } while (0)
#define AT_KMM(src, S0) do { _Pragma("unroll") for (int kt = 0; kt < 2; ++kt) sa[kt] = __builtin_amdgcn_mfma_f32_32x32x16_bf16(src[kt], qf[(S0)], sa[kt], 0, 0, 0); } while (0)
            AT_KLD(kfa, 0); __builtin_amdgcn_sched_barrier(0);
#pragma unroll
            for (int bq = 0; bq < 8; ++bq) {
                AT_KLD(kfb, 2 * bq + 1); __builtin_amdgcn_sched_barrier(0);
                AT_KMM(kfa, 2 * bq); __builtin_amdgcn_sched_barrier(0);
                if (bq < 7) { AT_KLD(kfa, 2 * bq + 2); __builtin_amdgcn_sched_barrier(0); }
                AT_KMM(kfb, 2 * bq + 1); __builtin_amdgcn_sched_barrier(0);
            }
#undef AT_KLD
#undef AT_KMM
            if (st == 0) attn_dma(lb, kvb, AT_SRC(n, 2), lane_off, sl2, AT_KPS, wave);
            if (st == 0) { float mx = -3.0e38f;
#pragma unroll
                for (int kt = 0; kt < 2; ++kt)
#pragma unroll
                    for (int r = 0; r < 16; ++r) mx = __builtin_fmaxf(mx, sa[kt][r]);
                mx = __builtin_fmaxf(mx, shx(mx, 32, lane)); ml = mx * LOG2E; }
#pragma unroll
            for (int kt = 0; kt < 2; ++kt) {
                float p[16];
#pragma unroll
                for (int r = 0; r < 16; ++r) { p[r] = __builtin_amdgcn_exp2f(sa[kt][r] * LOG2E - ml); lsum += p[r]; }
#pragma unroll
                for (int s2 = 0; s2 < 2; ++s2) { u32x4 w; w.x = pk2(p[8 * s2 + 0], p[8 * s2 + 1]); w.y = pk2(p[8 * s2 + 2], p[8 * s2 + 3]); w.z = pk2(p[8 * s2 + 4], p[8 * s2 + 5]); w.w = pk2(p[8 * s2 + 6], p[8 * s2 + 7]);
                    pk[2 * st + kt][s2] = __builtin_bit_cast(bf16x8, w); }
            }
            AT_WAITBAR(4);
            sl = (sl == 2) ? 0 : sl + 1;
        }
        lsum += shx(lsum, 32, lane);
        f32x16 oacc[8];
#pragma unroll
        for (int dt = 0; dt < 8; ++dt)
#pragma unroll
            for (int r = 0; r < 16; ++r) oacc[dt][r] = 0.f;
#pragma unroll
        for (int st = 4; st < 8; ++st) {
            const bool issue = (st < 6) || more;
            if (issue) { const int s2 = (sl >= 1) ? sl - 1 : 2;
                if (st < 6) attn_dma(lb, kvb, AT_SRC(n, st + 2), lane_off, s2, AT_VPS, wave); else attn_dma(lb, kvb, AT_SRC(n + 1, st - 6), lane_off, s2, AT_KPS, wave); }
            const unsigned vb = vbase + (unsigned)(sl * AT_SLOT);
            bf16x8 vfa[2], vfb[2];
#define AT_VLD(dst, BT) do { const unsigned va_ = vb + (unsigned)((((BT) >> 3) & 1) * 16 * AT_VPS + (((BT) >> 2) & 1) * 512 + ((BT) & 3) * 128); \
                _Pragma("unroll") for (int d_ = 0; d_ < 2; ++d_) dst[d_] = cat8(vtr(va_ + 64u * d_), vtr(va_ + 64u * d_ + 8u * AT_VPS)); } while (0)
#define AT_VMM(src, BT) do { _Pragma("unroll") for (int d_ = 0; d_ < 2; ++d_) oacc[2 * ((BT) & 3) + d_] = __builtin_amdgcn_mfma_f32_32x32x16_bf16(src[d_], pk[2 * (st - 4) + (((BT) >> 3) & 1)][((BT) >> 2) & 1], oacc[2 * ((BT) & 3) + d_], 0, 0, 0); } while (0)
            AT_VLD(vfa, 0); __builtin_amdgcn_sched_barrier(0);
#pragma unroll
            for (int bq = 0; bq < 8; ++bq) {
                AT_VLD(vfb, 2 * bq + 1); __builtin_amdgcn_sched_barrier(0);
                AT_VMM(vfa, 2 * bq); __builtin_amdgcn_sched_barrier(0);
                if (bq < 7) { AT_VLD(vfa, 2 * bq + 2); __builtin_amdgcn_sched_barrier(0); }
                AT_VMM(vfb, 2 * bq + 1); __builtin_amdgcn_sched_barrier(0);
            }
#undef AT_VLD
#undef AT_VMM
            if (issue) AT_WAITBAR(4); else AT_WAITBAR(0);
            sl = (sl == 2) ? 0 : sl + 1;
        }
        const float inv = 1.0f / lsum;
        int ln2 = pg8::lane_id(); asm volatile("" : "+v"(ln2));
        GAS char* op = (GAS char*)obase + ((unsigned)((wave * 32 + (ln2 & 31)) * D) * 2u) + ((ln2 >> 5) ? 16 : 0);
#pragma unroll
        for (int dt = 0; dt < 8; ++dt)
#pragma unroll
            for (int gp = 0; gp < 2; ++gp) {
                u32x2 a, b;
                a.x = pk2(oacc[dt][8 * gp + 0] * inv, oacc[dt][8 * gp + 1] * inv); a.y = pk2(oacc[dt][8 * gp + 2] * inv, oacc[dt][8 * gp + 3] * inv);
                b.x = pk2(oacc[dt][8 * gp + 4] * inv, oacc[dt][8 * gp + 5] * inv); b.y = pk2(oacc[dt][8 * gp + 6] * inv, oacc[dt][8 * gp + 7] * inv);
                { const auto r = __builtin_amdgcn_permlane32_swap(a.x, b.x, false, false); a.x = r[0]; b.x = r[1]; }
                { const auto r = __builtin_amdgcn_permlane32_swap(a.y, b.y, false, false); a.y = r[0]; b.y = r[1]; }
                u32x4 w; w.x = a.x; w.y = a.y; w.z = b.x; w.w = b.y;
                *(GAS u32x4*)(op + (32 * dt + 16 * gp) * 2) = w; }
    }
    asm volatile("s_waitcnt vmcnt(0)" ::: "memory");
    __syncthreads();
}
#undef AT_SRC
#undef AT_WAITBAR

constexpr int RT_WH = 0, RT_WL = 32768, RT_SEL = 65536, RT_RK = 66048, RT_CNTW = 67072, RT_WBASE = 67584;
template <int MODE>
__device__ __forceinline__ void ln_phase(LAS unsigned char* lds, const Args& a, int l, int lnidx, bool last, bf16_t* Xout, int bid, int G, int wave_s) {
    int tid_ = wave_s * 64 + pg8::lane_id(); asm volatile("" : "+v"(tid_)); const int tid = tid_, lane = tid & 63, wave = __builtin_amdgcn_readfirstlane(tid >> 6);
    constexpr int R = (MODE == 2) ? 2 : 4;
    unsigned char* ws = a.ws;
    const bf16_t* Z = (const bf16_t*)(ws + WS_R + R_Z); const bf16_t* X = (const bf16_t*)(ws + WS_X); const bf16_t* Ys = (const bf16_t*)(ws + WS_R + R_XS);
    const float* gp = a.in[20] + (size_t)(l * 3 + lnidx) * D; const float* bp = a.in[21] + (size_t)(l * 3 + lnidx) * D;
    float gg[16], bb[16];
#pragma unroll
    for (int j = 0; j < 2; ++j)
#pragma unroll
        for (int i = 0; i < 8; ++i) { gg[8 * j + i] = gp[8 * lane + 512 * j + i]; bb[8 * j + i] = bp[8 * lane + 512 * j + i]; }
    if (MODE == 1) {
        __syncthreads();
        for (int idx = tid; idx < 2048; idx += NTHR) { const int s = idx >> 6, ln = idx & 63, e = ln & 15, g = ln >> 4; float hi[8], lo[8];
#pragma unroll
            for (int j = 0; j < 8; ++j) { const float w = a.in[15][(32 * s + 8 * g + j) * 16 + e]; const float h = bflo(pk2(w, 0.f) & 0xffffu); hi[j] = h; lo[j] = w - h; }
            *(LAS u32x4*)(lds + RT_WH + idx * 16) = pack8(hi); *(LAS u32x4*)(lds + RT_WL + idx * 16) = pack8(lo); }
        __syncthreads();
    }
    for (int blk = bid; blk < 256; blk += G) {
        int run[16];
#pragma unroll
        for (int e = 0; e < 16; ++e) run[e] = 0;
        u32x4 pa_[R][2], pb_[R][2], pc_[R][2]; float pw0[R], pw1[R];
#define LN_LOAD(ROW0) do { _Pragma("unroll") for (int r = 0; r < R; ++r) { const size_t row = (ROW0) + r; \
            if (MODE == 2) { const int* ts = (const int*)(ws + WS_TSLOT) + row * 2; const float* ti = (const float*)(ws + WS_TINFO) + row * 4; const int s0 = ts[0], s1 = ts[1]; pw0[r] = ti[2]; pw1[r] = ti[3]; \
                _Pragma("unroll") for (int j = 0; j < 2; ++j) { pa_[r][j] = *(const u32x4*)(X + row * D + 8 * lane + 512 * j); pb_[r][j] = *(const u32x4*)(Ys + (size_t)s0 * D + 8 * lane + 512 * j); pc_[r][j] = *(const u32x4*)(Ys + (size_t)s1 * D + 8 * lane + 512 * j); } } \
            else { _Pragma("unroll") for (int j = 0; j < 2; ++j) pa_[r][j] = *(const u32x4*)(Z + row * D + 8 * lane + 512 * j); } } } while (0)
        LN_LOAD((size_t)blk * 256 + wave * 32);
        for (int ri = 0; ri < 32; ri += R) {
            const int rl0 = wave * 32 + ri; const size_t row0 = (size_t)blk * 256 + rl0;
            float v[R][16];
#pragma unroll
            for (int r = 0; r < R; ++r)
#pragma unroll
                for (int j = 0; j < 2; ++j) { float x[8]; unpack8(pa_[r][j], x);
                    if (MODE == 2) { float y0[8], y1[8]; unpack8(pb_[r][j], y0); unpack8(pc_[r][j], y1);
#pragma unroll
                        for (int i = 0; i < 8; ++i) v[r][8 * j + i] = ALPHA * x[i] + pw0[r] * y0[i] + pw1[r] * y1[i]; }
                    else {
#pragma unroll
                        for (int i = 0; i < 8; ++i) v[r][8 * j + i] = x[i]; } }
            if (ri + R < 32) LN_LOAD(row0 + R);
            float s[R];
#pragma unroll
            for (int r = 0; r < R; ++r) { s[r] = 0.f;
#pragma unroll
                for (int i = 0; i < 16; ++i) s[r] += v[r][i]; }
#pragma unroll
            for (int o = 1; o < 64; o <<= 1)
#pragma unroll
                for (int r = 0; r < R; ++r) s[r] += shx(s[r], o, lane);
            float qq[R];
#pragma unroll
            for (int r = 0; r < R; ++r) { const float mu = s[r] * (1.0f / D); qq[r] = 0.f;
#pragma unroll
                for (int i = 0; i < 16; ++i) { v[r][i] -= mu; qq[r] += v[r][i] * v[r][i]; } }
#pragma unroll
            for (int o = 1; o < 64; o <<= 1)
#pragma unroll
                for (int r = 0; r < R; ++r) qq[r] += shx(qq[r], o, lane);
#pragma unroll
            for (int r = 0; r < R; ++r) { const float rs = __builtin_amdgcn_rsqf(qq[r] * (1.0f / D) + LN_EPS);
#pragma unroll
                for (int i = 0; i < 16; ++i) v[r][i] = v[r][i] * rs * gg[i] + bb[i]; }
#pragma unroll
            for (int r = 0; r < R; ++r) { const size_t row = row0 + r;
                if (MODE == 2 && last) {
#pragma unroll
                    for (int j = 0; j < 2; ++j) { float* op = a.out + row * D + 8 * lane + 512 * j;
                        *(f32x4*)op = (f32x4){v[r][8 * j], v[r][8 * j + 1], v[r][8 * j + 2], v[r][8 * j + 3]}; *(f32x4*)(op + 4) = (f32x4){v[r][8 * j + 4], v[r][8 * j + 5], v[r][8 * j + 6], v[r][8 * j + 7]}; }
                } else {
#pragma unroll
                    for (int j = 0; j < 2; ++j) { float f[8];
#pragma unroll
                        for (int i = 0; i < 8; ++i) f[i] = v[r][8 * j + i];
                        *(u32x4*)(Xout + row * D + 8 * lane + 512 * j) = pack8(f);
                        if (MODE == 1) { u32x2 q8; q8.x = pg8::pk4f8(f[0] * pg8::F8_SX, f[1] * pg8::F8_SX, f[2] * pg8::F8_SX, f[3] * pg8::F8_SX); q8.y = pg8::pk4f8(f[4] * pg8::F8_SX, f[5] * pg8::F8_SX, f[6] * pg8::F8_SX, f[7] * pg8::F8_SX);
                            *(u32x2*)(ws + WS_R + R_X8 + row * D + 8 * lane + 512 * j) = q8; } }
                } }
            if (MODE == 1 && ((ri + R) & 15) == 0) {
                asm volatile("s_waitcnt vmcnt(0)" ::: "memory");
                const int tok = lane & 15, g = lane >> 4, tl = rl0 + R - 16 + tok; const size_t token = (size_t)blk * 256 + tl;
                const bf16_t* xr = Xout + token * D + 8 * g;
                f32x4 acc = (f32x4){0.f, 0.f, 0.f, 0.f};
#pragma unroll 8
                for (int ks = 0; ks < 32; ++ks) { const bf16x8 xb = *(const bf16x8*)(xr + 32 * ks);
                    const bf16x8 wh = *(const LAS bf16x8*)(lds + RT_WH + (ks * 64 + lane) * 16), wl = *(const LAS bf16x8*)(lds + RT_WL + (ks * 64 + lane) * 16);
                    acc = __builtin_amdgcn_mfma_f32_16x16x32_bf16(wh, xb, acc, 0, 0, 0); acc = __builtin_amdgcn_mfma_f32_16x16x32_bf16(wl, xb, acc, 0, 0, 0); }
                const f32x4 brv = *(const f32x4*)(a.in[16] + 4 * g);
                float lg[4] = {acc[0] + brv[0], acc[1] + brv[1], acc[2] + brv[2], acc[3] + brv[3]};
                float m = __builtin_fmaxf(__builtin_fmaxf(lg[0], lg[1]), __builtin_fmaxf(lg[2], lg[3]));
                m = __builtin_fmaxf(m, shx(m, 16, lane)); m = __builtin_fmaxf(m, shx(m, 32, lane));
                float t1 = -1.f, t2 = -1.f; int i1 = 0, i2 = 0;
#pragma unroll
                for (int r = 0; r < 4; ++r) { const float p = __expf(lg[r] - m); if (p > t1) { t2 = t1; i2 = i1; t1 = p; i1 = r; } else if (p > t2) { t2 = p; i2 = r; } }
                const float gs = t1 + t2; float bgs = gs; int bg = g;
                { const float o = shx(bgs, 16, lane); const int og = shxi(bg, 16, lane); if (o > bgs || (o == bgs && og < bg)) { bgs = o; bg = og; } }
                { const float o = shx(bgs, 32, lane); const int og = shxi(bg, 32, lane); if (o > bgs || (o == bgs && og < bg)) { bgs = o; bg = og; } }
                const bool mine = (bg == g); const int e0 = 4 * g + i1, e1 = 4 * g + i2;
                if (mine) { u32x4 info; info.x = (unsigned)e0; info.y = (unsigned)e1; info.z = __builtin_bit_cast(unsigned, t1 / gs); info.w = __builtin_bit_cast(unsigned, t2 / gs);
                    *(u32x4*)(ws + WS_TINFO + token * 16) = info; ((LAS unsigned short*)(lds + RT_SEL))[tl] = (unsigned short)(e0 | (e1 << 8)); }
                const unsigned long long below = (1ull << lane) - 1ull; int r0 = 0, r1 = 0;
#pragma unroll
                for (int e = 0; e < 16; ++e) { const bool hit = mine && (e0 == e || e1 == e); const unsigned long long mb = __ballot(hit); const int cb = __popcll(mb & below);
                    r0 = (e0 == e) ? run[e] + cb : r0; r1 = (e1 == e) ? run[e] + cb : r1; run[e] += __popcll(mb); }
                if (mine) { ((LAS unsigned short*)(lds + RT_RK))[2 * tl] = (unsigned short)r0; ((LAS unsigned short*)(lds + RT_RK))[2 * tl + 1] = (unsigned short)r1; }
            }
        }
        if (MODE == 1) {
            { int vsel = 0;
#pragma unroll
              for (int e = 0; e < 16; ++e) vsel = (lane == e) ? run[e] : vsel;
              if (lane < 16) ((LAS int*)(lds + RT_CNTW))[wave * 16 + lane] = vsel; }
            __syncthreads();
            if (tid < 16) { int base = 0;
#pragma unroll
                for (int w = 0; w < 8; ++w) { const int t = ((LAS int*)(lds + RT_CNTW))[w * 16 + tid]; ((LAS int*)(lds + RT_WBASE))[w * 16 + tid] = base; base += t; }
                ((int*)(ws + WS_WGCNT))[blk * 16 + tid] = base; }
            __syncthreads();
            { const int t = tid >> 1, k = tid & 1; const int e = (((LAS unsigned short*)(lds + RT_SEL))[t] >> (8 * k)) & 255;
              ((int*)(ws + WS_TRANK))[(size_t)blk * 512 + tid] = (int)((LAS unsigned short*)(lds + RT_RK))[tid] + ((LAS int*)(lds + RT_WBASE))[(t >> 5) * 16 + e]; }
            __syncthreads();
        }
    }
}

#undef LN_LOAD
constexpr int MG_TBL = 0, MG_TOT = 16384, MG_PRE = 16448, MG_BASE = 16512;
__device__ __forceinline__ void moe_gather_phase(LAS unsigned char* lds, unsigned char* ws, int bid, int G, int wave_s) {
    int tid_ = wave_s * 64 + pg8::lane_id(); asm volatile("" : "+v"(tid_)); const int tid = tid_, lane = tid & 63, wave = __builtin_amdgcn_readfirstlane(tid >> 6);
    LAS int* tbl = (LAS int*)(lds + MG_TBL); LAS int* tot = (LAS int*)(lds + MG_TOT); LAS int* pre = (LAS int*)(lds + MG_PRE); LAS int* base = (LAS int*)(lds + MG_BASE);
    LAS int* offs = (LAS int*)(lds + MISC_OFF) + 16; LAS int* tile_e = (LAS int*)(lds + TILEE_OFF);
    const bf16_t* X = (const bf16_t*)(ws + WS_X); bf16_t* Xs = (bf16_t*)(ws + WS_R + R_XS);
    for (int blk = bid; blk < 256; blk += G) {
        __syncthreads();
        for (int i = tid; i < 4096; i += NTHR) tbl[i] = ((const int*)(ws + WS_WGCNT))[i];
        __syncthreads();
        if (tid < 16) { int t = 0, p = 0; for (int c = 0; c < 256; ++c) { const int v = tbl[c * 16 + tid]; p += (c < blk) ? v : 0; t += v; } tot[tid] = t; pre[tid] = p; }
        __syncthreads();
        if (tid == 0) { int o = 0; for (int e = 0; e < 16; ++e) { offs[e] = o; base[e] = o + pre[e]; o += (tot[e] + 255) & ~255; } offs[16] = o; offs[17] = o >> 8; }
        __syncthreads();
        for (int rt = tid; rt < 528; rt += NTHR) { int e = 0;
#pragma unroll
            for (int q = 1; q < 16; ++q) e = (rt * 256 >= offs[q]) ? q : e;
            tile_e[rt] = e; }
        { const size_t tok = (size_t)blk * 256 + (tid >> 1); const int k = tid & 1;
          const int e = ((const int*)(ws + WS_TINFO))[tok * 4 + k]; const int rk = ((const int*)(ws + WS_TRANK))[tok * 2 + k];
          const int slot = base[e] + rk;
          ((int*)(ws + WS_TSLOT))[tok * 2 + k] = slot; ((int*)(ws + WS_SRCROW))[slot] = (int)tok; }
        for (int e = wave; e < 16; e += NWAVES) { const int npad = offs[e + 1] - offs[e] - tot[e];
            if (blk < npad && lane == 0) ((int*)(ws + WS_SRCROW))[offs[e] + tot[e] + blk] = 0; }
    }
}

#define GEMM_ALIGN true
#define GEMM_SP2 true
__global__ void __launch_bounds__(NTHR, 2) mk_fwd(Args args) {
    extern __shared__ __attribute__((aligned(16))) unsigned char lds_raw[];
    LAS unsigned char* lds = (LAS unsigned char*)lds_raw;
    const int tid = threadIdx.x; const int wave_s = __builtin_amdgcn_readfirstlane(tid >> 6);
    const int G = gridDim.x, bid = blockIdx.x;
    unsigned char* ws = args.ws;
    volatile LAS unsigned* MISC = (volatile LAS unsigned*)(lds + MISC_OFF);
    for (int u = tid; u < (LDS_BYTES - LDSCTL_OFF) / 4; u += NTHR) ((LAS unsigned*)(lds + LDSCTL_OFF))[u] = 0u;
    __syncthreads();
    XcdBarrier bar = xcd_barrier_post((unsigned*)(ws + WS_CTL) + CW_BAR, MISC + 8);
    bar.wv = wave_s;
#define GRID_BAR() xcd_barrier(bar)
#ifndef REP_MASK
#define REP_MASK 0
#endif
#define LOCAL_SYNC() do { asm volatile("s_waitcnt vmcnt(0)" ::: "memory"); __syncthreads(); } while (0)
#define PHASE(grp, ...) do { __VA_ARGS__; if (REP_MASK & (1 << (grp))) { GRID_BAR(); __VA_ARGS__; } } while (0)

#define WSQ ({ unsigned char* w_ = args.ws; asm volatile("" : "+s"(w_)); w_; })
#define X ((bf16_t*)(WSQ + WS_X))
#define P ((bf16_t*)(WSQ + WS_R + R_P))
#define Y ((bf16_t*)(WSQ + WS_R + R_Y))
#define Z ((bf16_t*)(WSQ + WS_R + R_Z))
#define Qb ((bf16_t*)(WSQ + WS_R + R_Q))
#define Ob ((bf16_t*)(WSQ + WS_R + R_O))
#define Xs ((bf16_t*)(WSQ + WS_R + R_XS))
#define Hb ((bf16_t*)(WSQ + WS_R + R_H))
#define KV ((bf16_t*)(WSQ + WS_KV))
#define wl (WSQ + WS_W + (size_t)l * W_LAYER)

    PHASE(0, p0_convert(args, lds, bid, G, wave_s));
    GRID_BAR();
    { const int tid_r = wave_s * 64 + pg8::lane_id();
      for (int i = bid * NTHR + tid_r; i < 2 * 2 * 1024; i += G * NTHR) { const int l = i >> 11, w = (i >> 10) & 1, n = i & 1023; const float* tb = (const float*)(WSQ + WS_CS) + (size_t)l * 2 * 16 * 1024 + w * 16 * 1024; float s = 0.f;
#pragma unroll
          for (int kc = 0; kc < 16; ++kc) s += tb[kc * 1024 + n];
          ((float*)(WSQ + WS_CS) + 65536)[i] = s; } }
    PHASE(1, { pg8::Gemm g{(const bf16_t*)(WSQ + WS_MEMB), (const bf16_t*)(WSQ + WS_WKV), MKV, 4096, D, wave_s}; pg8::StaticOrder S; S.init(MKV, 4096, G, bid);
      pg8::EpiPlain E{KV, 4096, 0xffff};
      pg8::gemm_phase<pg8::EpiPlain, pg8::StaticOrder, GEMM_ALIGN, GEMM_SP2>(lds, g, S, E); });

#pragma unroll 1
    for (int l = 0; l < 2; ++l) {
        PHASE(1, { pg8::Gemm g{X, (const bf16_t*)(wl + W_IN), M, NP, D, wave_s}; pg8::StaticOrder S; S.init(M, NP, G, bid);
          pg8::EpiInProj E{P, args.in[4] + l * 256};
          pg8::gemm_phase<pg8::EpiInProj, pg8::StaticOrder, GEMM_ALIGN, GEMM_SP2>(lds, g, S, E); });
        GRID_BAR();
        PHASE(3, gla_phase<false>(lds, P, (float*)(WSQ + WS_SEND), (float*)(WSQ + WS_LTOT), Y, args.in[5] + l * 512, bid, G, wave_s));
        PHASE(4, sgu_phase(lds, P, (const bf16_t*)(WSQ + WS_WM) + (size_t)l * 4 * 128 * 128, args.in[7] + l * 512, args.in[8] + l * 512, args.in[9] + l * 512, Y, bid, G, wave_s));
        GRID_BAR();
        PHASE(3, gla_phase<true>(lds, P, (float*)(WSQ + WS_SEND), (float*)(WSQ + WS_LTOT), Y, args.in[5] + l * 512, bid, G, wave_s));
        GRID_BAR();
        PHASE(10, { pg8::Gemm g{Y, (const bf16_t*)(wl + W_OUT), M, D, D, wave_s}; pg8::PanelOrder S{4, M / 256, G, bid};
          pg8::EpiResidStats E{X, Z, (pg8::f32x2_t*)(WSQ + WS_PART)};
          pg8::gemm_phase<pg8::EpiResidStats, pg8::PanelOrder, GEMM_ALIGN, GEMM_SP2>(lds, g, S, E); });
        { const int tid_r = wave_s * 64 + pg8::lane_id();
          for (int pan = bid; pan < 256; pan += G) if (tid_r < 256) { const size_t row = (size_t)pan * 256 + tid_r; const pg8::f32x2_t* pp = (const pg8::f32x2_t*)(WSQ + WS_PART) + row * 16; float s1 = 0.f, s2 = 0.f;
#pragma unroll
              for (int q = 0; q < 16; ++q) { const pg8::f32x2_t v = pp[q]; s1 += v[0]; s2 += v[1]; }
              const float mu = s1 * (1.0f / D), var = s2 * (1.0f / D) - mu * mu; ((pg8::f32x2_t*)(WSQ + WS_STATS))[row] = (pg8::f32x2_t){mu, __builtin_amdgcn_rsqf(var + LN_EPS)}; } }
        LOCAL_SYNC();
        PHASE(10, { pg8::Gemm g{Z, (const bf16_t*)(wl + W_Q), M, D, D, wave_s}; pg8::PanelOrder S{4, M / 256, G, bid};
          pg8::EpiQFragLN E{Qb, (const pg8::f32x2_t*)(WSQ + WS_STATS), (const float*)(WSQ + WS_CS) + 65536 + l * 2048, (const float*)(WSQ + WS_CS) + 65536 + l * 2048 + 1024};
          pg8::gemm_phase<pg8::EpiQFragLN, pg8::PanelOrder, GEMM_ALIGN, GEMM_SP2>(lds, g, S, E); });
        PHASE(5, attn_phase(lds, Qb, KV, Ob, l, bid, G, wave_s));
        LOCAL_SYNC();
        PHASE(10, { pg8::Gemm g{Ob, (const bf16_t*)(wl + W_O), M, D, D, wave_s}; pg8::PanelOrder S{4, M / 256, G, bid};
          pg8::EpiResidLN E{Z, (const pg8::f32x2_t*)(WSQ + WS_STATS), args.in[20] + (size_t)(l * 3) * D, args.in[21] + (size_t)(l * 3) * D};
          pg8::gemm_phase<pg8::EpiResidLN, pg8::PanelOrder, GEMM_ALIGN, GEMM_SP2>(lds, g, S, E); });
        PHASE(9, ln_phase<1>(lds, args, l, 1, false, X, bid, G, wave_s));
        GRID_BAR();
        PHASE(7, moe_gather_phase(lds, WSQ, bid, G, wave_s));
        GRID_BAR();
        PHASE(2, { pg8::Gemm g{(const bf16_t*)(WSQ + WS_R + R_X8), (const bf16_t*)(wl + W_GU), MOE_ROWS, 16384, D / 2, wave_s}; pg8::MoeGatherOrder S{(const LAS int*)(lds + TILEE_OFF), (int)MISC[33] * 4, G, bid, (const int*)(WSQ + WS_SRCROW)};
          pg8::EpiGU8 E{(unsigned char*)Hb};
          pg8::gemm_phase<pg8::EpiGU8, pg8::MoeGatherOrder, GEMM_ALIGN, GEMM_SP2>(lds, g, S, E); });
        GRID_BAR();
        PHASE(2, { pg8::Gemm g{Hb, (const bf16_t*)(wl + W_D), MOE_ROWS, 16384, 256, wave_s}; pg8::MoeOrder S{(const LAS int*)(lds + TILEE_OFF), (int)MISC[33] * 4, G, bid};
          pg8::EpiPlain8 E{Xs, D, 3};
          pg8::gemm_phase<pg8::EpiPlain8, pg8::MoeOrder, GEMM_ALIGN, GEMM_SP2>(lds, g, S, E); });
        GRID_BAR();
        if (REP_MASK & (1 << 8)) { ln_phase<2>(lds, args, l, 2, l == 1, Z, bid, G, wave_s); GRID_BAR(); }
        ln_phase<2>(lds, args, l, 2, l == 1, X, bid, G, wave_s);
        if (l == 0) GRID_BAR();
    }
}
#undef X
#undef P
#undef Y
#undef Z
#undef Qb
#undef Ob
#undef Xs
#undef Hb
#undef KV
#undef wl
}

extern "C" void kernel_launch(void* const* d_in, const int* in_sizes, int n_in, void* d_out, int out_size, void* d_ws, size_t ws_size, hipStream_t stream) {
    using namespace mk;
    static int grid = 0;
    if (grid == 0) {
        if (n_in != 22 || in_sizes[0] != M * D || out_size != M * D || ws_size < WS_END) { fprintf(stderr, "kernel_launch: unexpected shapes (n_in %d, in0 %d, out %d, ws %zu, need %zu)\n", n_in, n_in > 0 ? in_sizes[0] : -1, out_size, ws_size, (size_t)WS_END); grid = -1; return; }
        int dev = 0, cus = 0;
        if (hipGetDevice(&dev) != hipSuccess || hipDeviceGetAttribute(&cus, hipDeviceAttributeMultiprocessorCount, dev) != hipSuccess) { grid = -1; return; }
        if (hipFuncSetAttribute((const void*)mk_fwd, hipFuncAttributeMaxDynamicSharedMemorySize, LDS_BYTES) != hipSuccess) { fprintf(stderr, "kernel_launch: hipFuncSetAttribute failed\n"); grid = -1; return; }
        int per_cu = 0;
        if (hipOccupancyMaxActiveBlocksPerMultiprocessor(&per_cu, (const void*)mk_fwd, NTHR, LDS_BYTES) != hipSuccess || per_cu < 1) fprintf(stderr, "kernel_launch: occupancy query says %d\n", per_cu);
        (void)hipGetLastError();
        grid = cus;
    }
    if (grid < 0) return;
    if (hipMemsetAsync((char*)d_ws + WS_CTL, 0, CTL_ZERO_BYTES, stream) != hipSuccess) return;
    Args a{};
    for (int i = 0; i < 22; ++i) a.in[i] = (const float*)d_in[i];
    a.out = (float*)d_out; a.ws = (unsigned char*)d_ws;
    hipLaunchKernelGGL(mk_fwd, dim3(grid), dim3(NTHR), LDS_BYTES, stream, a);
}
```

```cpp
#include <hip/hip_runtime.h>
#include <cstdio>
#include <cstdint>

namespace pg8 {
#define PG8_LAS __attribute__((address_space(3)))
typedef unsigned short bf16_t;
typedef short bf16x8 __attribute__((ext_vector_type(8)));
typedef float f32x4 __attribute__((ext_vector_type(4)));
typedef unsigned u32x4 __attribute__((ext_vector_type(4)));
typedef unsigned u32x2 __attribute__((ext_vector_type(2)));
constexpr int BM = 256, BK = 64, HALF = 128, HTB = HALF * BK * 2  , STAGE_BYTES = 8 * HTB, NXCD = 8, WGM = 8;

__host__ __device__ __forceinline__ int lds_byte(int r, int c) { const int st = (r >> 4) * 2 + (c >> 5), rr = r & 15, cc = c & 31, ob = rr * 64 + cc * 2; return st * 1024 + (ob ^ (((ob >> 9) & 1) << 5)); }
__host__ __device__ __forceinline__ void stage_rc(int b, int& R, int& C) { const int st = b / 1024, sb = b % 1024, swz = sb ^ (((sb >> 9) & 1) << 5); R = (st >> 1) * 16 + swz / 64; C = (st & 1) * 32 + (swz % 64) / 2; }
__host__ __device__ __forceinline__ int perm32(int rho) { const int n = rho >> 4, i = rho & 15; return 8 * (i >> 2) + 4 * n + (i & 3); }

struct Unit { int pm, pn; };
struct Gemm { const bf16_t* A; const bf16_t* Bt; int M, N, K; int wv; };
__device__ __forceinline__ int lane_id() { int l; asm volatile("v_mbcnt_lo_u32_b32 %0, -1, 0\n\tv_mbcnt_hi_u32_b32 %0, -1, %0" : "=v"(l)); return l; }

struct StaticOrder {
    static constexpr bool GATHER = false;
    int nM, nN, nwg, G, c; const int* src = nullptr;
    __host__ __device__ void init(int M, int N, int G_, int c_) { nM = M / BM; nN = N / BM; nwg = nM * nN; G = G_; c = c_; }
    __host__ __device__ bool next(int i, Unit& u) const {
        const long L = (long)i * G + c; if (L >= nwg) return false;
        int wgid = (int)L; { const int q = nwg / NXCD, r = nwg % NXCD, xcd = wgid % NXCD, off = wgid / NXCD; wgid = (xcd < r ? xcd * (q + 1) : r * (q + 1) + (xcd - r) * q) + off; }
        const int nig = WGM * nN, gid = wgid / nig, fm = gid * WGM, gsz = (nM - fm) < WGM ? (nM - fm) : WGM;
        u.pm = fm + ((wgid % nig) % gsz); u.pn = (wgid % nig) / gsz; return true;
    }
    __device__ __forceinline__ void a_ready(const Unit&) const {}
    __device__ __forceinline__ void done(const Unit&) const {}
};
struct PanelOrder {
    static constexpr bool GATHER = false;
    int nN, npan, G, c; const int* src = nullptr;
    __device__ __forceinline__ bool next(int i, Unit& u) const { const int p = c + (i / nN) * G; if (p >= npan) return false; u.pm = p; u.pn = i % nN; return true; }
    __device__ __forceinline__ void a_ready(const Unit&) const {}
    __device__ __forceinline__ void done(const Unit&) const {}
};
template <bool GATH_> struct MoeOrderT {
    static constexpr bool GATHER = GATH_;
    const PG8_LAS int* tile_e; int nunits, G, c; const int* src = nullptr;
    __device__ __forceinline__ bool next(int i, Unit& u) const {
        const int cc = ((G & 7) == 0) ? (c & 7) * (G >> 3) + (c >> 3) : c;
        const int L = i * G + cc; if (L >= nunits) return false;
        u.pm = L >> 2; u.pn = tile_e[L >> 2] * 4 + (L & 3); return true;
    }
    __device__ __forceinline__ void a_ready(const Unit&) const {}
    __device__ __forceinline__ void done(const Unit&) const {}
};
typedef MoeOrderT<false> MoeOrder; typedef MoeOrderT<true> MoeGatherOrder;

typedef float f32x2_t __attribute__((ext_vector_type(2))); typedef __bf16 bf16x2_t __attribute__((ext_vector_type(2)));
typedef __amdgpu_buffer_rsrc_t rsrc_t;
__device__ __forceinline__ rsrc_t mk_rsrc(const void* p) { return __builtin_amdgcn_make_buffer_rsrc((void*)p, 0, 0x7fffffff, 0x00020000); }
__device__ __forceinline__ u32x4 bld4(rsrc_t r, unsigned voff, unsigned soff) { return __builtin_bit_cast(u32x4, __builtin_amdgcn_raw_buffer_load_b128(r, voff, soff, 0)); }
__device__ __forceinline__ f32x2_t bld2f(rsrc_t r, unsigned voff, unsigned soff) { return __builtin_bit_cast(f32x2_t, __builtin_amdgcn_raw_buffer_load_b64(r, voff, soff, 0)); }
#define GST4(p) (*(__attribute__((address_space(1))) u32x4*)(p))
__device__ __forceinline__ float f8clamp(float x) { return __builtin_fminf(__builtin_fmaxf(x, -448.0f), 448.0f); }
__device__ __forceinline__ unsigned pk4f8(float a, float b, float c, float d) { int w = 0; w = __builtin_amdgcn_cvt_pk_fp8_f32(f8clamp(a), f8clamp(b), w, false); w = __builtin_amdgcn_cvt_pk_fp8_f32(f8clamp(c), f8clamp(d), w, true); return (unsigned)w; }
constexpr float F8_SX = 4.0f, F8_SW = 64.0f, F8_SH = 8.0f, F8_SO = 64.0f;
__device__ __forceinline__ unsigned pk2(float lo, float hi) { f32x2_t v = {lo, hi}; bf16x2_t b = __builtin_convertvector(v, bf16x2_t); return __builtin_bit_cast(unsigned, b); }
__device__ __forceinline__ float bflo(unsigned w) { return __builtin_bit_cast(float, w << 16); }
__device__ __forceinline__ float bfhi(unsigned w) { return __builtin_bit_cast(float, w & 0xffff0000u); }
__device__ __forceinline__ float f_silu(float x) { return x * __builtin_amdgcn_rcpf(1.0f + __builtin_amdgcn_exp2f(-1.4426950408889634f * x)); }
__device__ __forceinline__ float f_gelu_tanh(float x) { return x * __builtin_amdgcn_rcpf(1.0f + __builtin_amdgcn_exp2f(x * (-2.3022082f - 0.10294324f * x * x))); }
__device__ __forceinline__ float f_logsig16(float z) { const float t = __builtin_amdgcn_exp2f(-1.4426950408889634f * __builtin_fabsf(z)); return (__builtin_fminf(z, 0.0f) - 0.6931471805599453f * __builtin_amdgcn_logf(1.0f + t)) * 0.0625f; }

struct EpiPlain {
    static constexpr bool PERM = true, AFTER_DRAIN = false;
    bf16_t* O; int ldc; int cmask;
    __device__ __forceinline__ void operator()(const f32x4 (&acc)[2][2][4][2], const Unit& u, int wr, int wc, int fr, int fq) const {
        const int row0 = u.pm * BM + wr * 64 + fr, col0 = (u.pn & cmask) * BM + wc * 32 + 8 * fq;
#pragma unroll
        for (int ai = 0; ai < 2; ++ai)
#pragma unroll
            for (int m = 0; m < 4; ++m) { bf16_t* rowp = O + (size_t)(row0 + ai * HALF + m * 16) * ldc + col0;
#pragma unroll
                for (int bj = 0; bj < 2; ++bj) { const f32x4 v0 = acc[ai][bj][m][0], v1 = acc[ai][bj][m][1];
                    u32x4 w; w.x = pk2(v0[0], v0[1]); w.y = pk2(v0[2], v0[3]); w.z = pk2(v1[0], v1[1]); w.w = pk2(v1[2], v1[3]);
                    *(u32x4*)(rowp + bj * HALF) = w; } }
    }
};
struct EpiQFrag {
    static constexpr bool PERM = true, AFTER_DRAIN = false;
    bf16_t* O;
    __device__ __forceinline__ void operator()(const f32x4 (&acc)[2][2][4][2], const Unit& u, int wr, int wc, int fr, int fq) const {
        unsigned lo = (unsigned)(((fq >> 1) * 64 + fr + 32 * (fq & 1)) * 16); asm volatile("" : "+v"(lo));
        char* tile = (char*)(O + (size_t)(u.pm * 4 + u.pn) * 65536) + (size_t)(wr * 2 * 16 + wc * 2) * 1024 + lo;
#pragma unroll
        for (int ai = 0; ai < 2; ++ai)
#pragma unroll
            for (int m = 0; m < 4; ++m)
#pragma unroll
                for (int bj = 0; bj < 2; ++bj) { const f32x4 v0 = acc[ai][bj][m][0], v1 = acc[ai][bj][m][1];
                    u32x4 w; w.x = pk2(v0[0], v0[1]); w.y = pk2(v0[2], v0[3]); w.z = pk2(v1[0], v1[1]); w.w = pk2(v1[2], v1[3]);
                    *(u32x4*)(tile + ((4 * ai + (m >> 1)) * 16 + 8 * bj) * 1024 + (m & 1) * 256) = w; }
    }
};
struct EpiInProj {
    static constexpr bool PERM = true, AFTER_DRAIN = false;
    bf16_t* O; const float* b_a;
    template <int MODE> __device__ __forceinline__ void tile(const f32x4 (&acc)[2][2][4][2], const Unit& u, int wr, int wc, int fr, int fq) const {
        const int row0 = u.pm * BM + wr * 64 + fr, col0 = u.pn * BM + wc * 32 + 8 * fq;
        f32x4 bv[2][2];
#pragma unroll
        for (int bj = 0; bj < 2; ++bj)
#pragma unroll
            for (int n = 0; n < 2; ++n) bv[bj][n] = (MODE == 2) ? *(const f32x4*)(b_a + (col0 - 1536) + bj * HALF + 4 * n) : (f32x4){0.f, 0.f, 0.f, 0.f};
#pragma unroll
        for (int ai = 0; ai < 2; ++ai)
#pragma unroll
            for (int m = 0; m < 4; ++m) { bf16_t* rowp = O + (size_t)(row0 + ai * HALF + m * 16) * 2816 + col0;
#pragma unroll
                for (int bj = 0; bj < 2; ++bj) { f32x4 v0 = acc[ai][bj][m][0], v1 = acc[ai][bj][m][1];
#pragma unroll
                    for (int j = 0; j < 4; ++j) {
                        if (MODE == 1) { v0[j] = f_silu(v0[j]); v1[j] = f_silu(v1[j]); }
                        if (MODE == 2) { v0[j] = f_logsig16(v0[j] + bv[bj][0][j]); v1[j] = f_logsig16(v1[j] + bv[bj][1][j]); }
                        if (MODE == 3) { v0[j] = f_gelu_tanh(v0[j]); v1[j] = f_gelu_tanh(v1[j]); } }
                    u32x4 w; w.x = pk2(v0[0], v0[1]); w.y = pk2(v0[2], v0[3]); w.z = pk2(v1[0], v1[1]); w.w = pk2(v1[2], v1[3]);
                    *(u32x4*)(rowp + bj * HALF) = w; } }
    }
    __device__ __forceinline__ void operator()(const f32x4 (&acc)[2][2][4][2], const Unit& u, int wr, int wc, int fr, int fq) const {
        const int pn = u.pn;
        if (pn < 4) tile<0>(acc, u, wr, wc, fr, fq); else if (pn < 6) tile<1>(acc, u, wr, wc, fr, fq); else if (pn == 6) tile<2>(acc, u, wr, wc, fr, fq); else tile<3>(acc, u, wr, wc, fr, fq);
    }
};
struct EpiResid {
    static constexpr bool PERM = true, AFTER_DRAIN = false;
    const bf16_t* X; bf16_t* Z; float alpha;
    __device__ __forceinline__ void operator()(const f32x4 (&acc)[2][2][4][2], const Unit& u, int wr, int wc, int fr, int fq) const {
        const int row0 = u.pm * BM + wr * 64 + fr, col0 = u.pn * BM + wc * 32 + 8 * fq;
#pragma unroll
        for (int ai = 0; ai < 2; ++ai)
#pragma unroll
            for (int m = 0; m < 4; ++m) { const size_t off = (size_t)(row0 + ai * HALF + m * 16) * 1024 + col0;
#pragma unroll
                for (int bj = 0; bj < 2; ++bj) { const f32x4 v0 = acc[ai][bj][m][0], v1 = acc[ai][bj][m][1];
                    const u32x4 xr = *(const u32x4*)(X + off + bj * HALF);
                    u32x4 w; w.x = pk2(alpha * bflo(xr.x) + v0[0], alpha * bfhi(xr.x) + v0[1]); w.y = pk2(alpha * bflo(xr.y) + v0[2], alpha * bfhi(xr.y) + v0[3]);
                    w.z = pk2(alpha * bflo(xr.z) + v1[0], alpha * bfhi(xr.z) + v1[1]); w.w = pk2(alpha * bflo(xr.w) + v1[2], alpha * bfhi(xr.w) + v1[3]);
                    *(u32x4*)(Z + off + bj * HALF) = w; } }
    }
};
struct EpiResidStats {
    static constexpr bool PERM = true, AFTER_DRAIN = false;
    const bf16_t* X; bf16_t* Z; f32x2_t* part; static constexpr float alpha = 1.4142135623730951f;
    __device__ __forceinline__ void operator()(const f32x4 (&acc)[2][2][4][2], const Unit& u, int wr, int wc, int fr, int fq) const {
        const int row0 = u.pm * BM + wr * 64 + fr, col0 = u.pn * BM + wc * 32 + 8 * fq;
        int ln = 16 * fq + fr; asm volatile("" : "+v"(ln));
        float s1[8], s2[8];
        const rsrc_t rx = mk_rsrc(X); const unsigned voff = ((unsigned)row0 * 1024u + (unsigned)col0) * 2u;
        u32x4 xres[2][4][2];
#pragma unroll
        for (int ai = 0; ai < 2; ++ai)
#pragma unroll
            for (int m = 0; m < 4; ++m)
#pragma unroll
                for (int bj = 0; bj < 2; ++bj) xres[ai][m][bj] = bld4(rx, voff, (unsigned)(((ai * HALF + m * 16) * 1024 + bj * HALF) * 2));
        __builtin_amdgcn_sched_barrier(0);
#pragma unroll
        for (int ai = 0; ai < 2; ++ai)
#pragma unroll
            for (int m = 0; m < 4; ++m) { const size_t off = (size_t)(row0 + ai * HALF + m * 16) * 1024 + col0; float a1 = 0.f, a2 = 0.f;
#pragma unroll
                for (int bj = 0; bj < 2; ++bj) { const f32x4 v0 = acc[ai][bj][m][0], v1 = acc[ai][bj][m][1];
                    const u32x4 xr = xres[ai][m][bj];
                    u32x4 w; w.x = pk2(alpha * bflo(xr.x) + v0[0], alpha * bfhi(xr.x) + v0[1]); w.y = pk2(alpha * bflo(xr.y) + v0[2], alpha * bfhi(xr.y) + v0[3]);
                    w.z = pk2(alpha * bflo(xr.z) + v1[0], alpha * bfhi(xr.z) + v1[1]); w.w = pk2(alpha * bflo(xr.w) + v1[2], alpha * bfhi(xr.w) + v1[3]);
                    GST4(Z + off + bj * HALF) = w;
                    const float z0 = bflo(w.x), z1 = bfhi(w.x), z2 = bflo(w.y), z3 = bfhi(w.y), z4 = bflo(w.z), z5 = bfhi(w.z), z6 = bflo(w.w), z7 = bfhi(w.w);
                    a1 += ((z0 + z1) + (z2 + z3)) + ((z4 + z5) + (z6 + z7)); a2 += ((z0 * z0 + z1 * z1) + (z2 * z2 + z3 * z3)) + ((z4 * z4 + z5 * z5) + (z6 * z6 + z7 * z7)); }
                s1[ai * 4 + m] = a1; s2[ai * 4 + m] = a2; }
        const bool h5 = (ln & 32) != 0, h4 = (ln & 16) != 0;
        float t1[4], t2[4];
#pragma unroll
        for (int i = 0; i < 4; ++i) { const float m1 = h5 ? s1[4 + i] : s1[i], g1 = h5 ? s1[i] : s1[4 + i], m2 = h5 ? s2[4 + i] : s2[i], g2 = h5 ? s2[i] : s2[4 + i];
            t1[i] = m1 + __builtin_bit_cast(float, __builtin_amdgcn_ds_bpermute((ln ^ 32) << 2, __builtin_bit_cast(int, g1)));
            t2[i] = m2 + __builtin_bit_cast(float, __builtin_amdgcn_ds_bpermute((ln ^ 32) << 2, __builtin_bit_cast(int, g2))); }
        float r1[2], r2[2];
#pragma unroll
        for (int i = 0; i < 2; ++i) { const float m1 = h4 ? t1[2 + i] : t1[i], g1 = h4 ? t1[i] : t1[2 + i], m2 = h4 ? t2[2 + i] : t2[i], g2 = h4 ? t2[i] : t2[2 + i];
            r1[i] = m1 + __builtin_bit_cast(float, __builtin_amdgcn_ds_bpermute((ln ^ 16) << 2, __builtin_bit_cast(int, g1)));
            r2[i] = m2 + __builtin_bit_cast(float, __builtin_amdgcn_ds_bpermute((ln ^ 16) << 2, __builtin_bit_cast(int, g2))); }
#pragma unroll
        for (int i = 0; i < 2; ++i) { const int gi = (h5 ? 4 : 0) + (h4 ? 2 : 0) + i, row = row0 + (gi >> 2) * HALF + (gi & 3) * 16;
            part[(size_t)row * 16 + u.pn * 4 + wc] = (f32x2_t){r1[i], r2[i]}; }
    }
};
struct EpiQFragLN {
    static constexpr bool PERM = true, AFTER_DRAIN = false;
    bf16_t* O; const f32x2_t* stats; const float* csum; const float* bq;
    __device__ __forceinline__ void operator()(const f32x4 (&acc)[2][2][4][2], const Unit& u, int wr, int wc, int fr, int fq) const {
        unsigned lo = (unsigned)(((fq >> 1) * 64 + fr + 32 * (fq & 1)) * 16); asm volatile("" : "+v"(lo));
        char* tile = (char*)(O + (size_t)(u.pm * 4 + u.pn) * 65536) + (size_t)(wr * 2 * 16 + wc * 2) * 1024 + lo;
        const int row0 = u.pm * BM + wr * 64 + fr, col0 = u.pn * BM + wc * 32 + 8 * fq;
#pragma unroll
        for (int bj = 0; bj < 2; ++bj) { const f32x4 c0 = *(const f32x4*)(csum + col0 + bj * HALF), c1 = *(const f32x4*)(csum + col0 + bj * HALF + 4), b0 = *(const f32x4*)(bq + col0 + bj * HALF), b1 = *(const f32x4*)(bq + col0 + bj * HALF + 4);
#pragma unroll
            for (int ai = 0; ai < 2; ++ai)
#pragma unroll
                for (int m = 0; m < 4; ++m) { const f32x2_t st = stats[row0 + ai * HALF + m * 16]; const float mu = st[0], rs = st[1];
                    const f32x4 v0 = (acc[ai][bj][m][0] - mu * c0) * rs + b0, v1 = (acc[ai][bj][m][1] - mu * c1) * rs + b1;
                    u32x4 w; w.x = pk2(v0[0], v0[1]); w.y = pk2(v0[2], v0[3]); w.z = pk2(v1[0], v1[1]); w.w = pk2(v1[2], v1[3]);
                    *(u32x4*)(tile + ((4 * ai + (m >> 1)) * 16 + 8 * bj) * 1024 + (m & 1) * 256) = w; } }
    }
};
struct EpiResidLN {
    static constexpr bool PERM = true, AFTER_DRAIN = false;
    bf16_t* Z; const f32x2_t* stats; const float* gain; const float* bias; static constexpr float alpha = 1.4142135623730951f;
    __device__ __forceinline__ void operator()(const f32x4 (&acc)[2][2][4][2], const Unit& u, int wr, int wc, int fr, int fq) const {
        const int row0 = u.pm * BM + wr * 64 + fr, col0 = u.pn * BM + wc * 32 + 8 * fq;
        const rsrc_t rz = mk_rsrc(Z), rs = mk_rsrc(stats); const unsigned voff = ((unsigned)row0 * 1024u + (unsigned)col0) * 2u;
        f32x2_t st[2][4];
#pragma unroll
        for (int ai = 0; ai < 2; ++ai)
#pragma unroll
            for (int m = 0; m < 4; ++m) st[ai][m] = bld2f(rs, (unsigned)row0 * 8u, (unsigned)((ai * HALF + m * 16) * 8));
#pragma unroll
        for (int bj = 0; bj < 2; ++bj) {
            u32x4 zres[2][4];
#pragma unroll
            for (int ai = 0; ai < 2; ++ai)
#pragma unroll
                for (int m = 0; m < 4; ++m) zres[ai][m] = bld4(rz, voff, (unsigned)(((ai * HALF + m * 16) * 1024 + bj * HALF) * 2));
            const f32x4 g0 = *(const f32x4*)(gain + col0 + bj * HALF) * alpha, g1 = *(const f32x4*)(gain + col0 + bj * HALF + 4) * alpha, b0 = *(const f32x4*)(bias + col0 + bj * HALF) * alpha, b1 = *(const f32x4*)(bias + col0 + bj * HALF + 4) * alpha;
            __builtin_amdgcn_sched_barrier(0);
#pragma unroll
            for (int ai = 0; ai < 2; ++ai)
#pragma unroll
                for (int m = 0; m < 4; ++m) { const int row = row0 + ai * HALF + m * 16; const float mu = st[ai][m][0], rsd = st[ai][m][1];
                    const u32x4 zr = zres[ai][m];
                    const f32x4 z0 = (f32x4){bflo(zr.x), bfhi(zr.x), bflo(zr.y), bfhi(zr.y)}, z1 = (f32x4){bflo(zr.z), bfhi(zr.z), bflo(zr.w), bfhi(zr.w)};
                    const f32x4 v0 = (z0 - mu) * rsd * g0 + b0 + acc[ai][bj][m][0], v1 = (z1 - mu) * rsd * g1 + b1 + acc[ai][bj][m][1];
                    u32x4 w; w.x = pk2(v0[0], v0[1]); w.y = pk2(v0[2], v0[3]); w.z = pk2(v1[0], v1[1]); w.w = pk2(v1[2], v1[3]);
                    GST4(Z + (size_t)row * 1024 + col0 + bj * HALF) = w; } }
    }
};
struct EpiResidLN8 {
    static constexpr bool PERM = true, AFTER_DRAIN = false, F8 = true; static constexpr float dq = 1.0f / (F8_SO * F8_SW);
    bf16_t* Z; const f32x2_t* stats; const float* gain; const float* bias; static constexpr float alpha = 1.4142135623730951f;
    __device__ __forceinline__ void operator()(const f32x4 (&acc)[2][2][4][2], const Unit& u, int wr, int wc, int fr, int fq) const {
        const int row0 = u.pm * BM + wr * 64 + fr, col0 = u.pn * BM + wc * 32 + 8 * fq;
        const rsrc_t rz = mk_rsrc(Z), rs = mk_rsrc(stats); const unsigned voff = ((unsigned)row0 * 1024u + (unsigned)col0) * 2u;
        f32x2_t st[2][4];
#pragma unroll
        for (int ai = 0; ai < 2; ++ai)
#pragma unroll
            for (int m = 0; m < 4; ++m) st[ai][m] = bld2f(rs, (unsigned)row0 * 8u, (unsigned)((ai * HALF + m * 16) * 8));
#pragma unroll
        for (int bj = 0; bj < 2; ++bj) {
            u32x4 zres[2][4];
#pragma unroll
            for (int ai = 0; ai < 2; ++ai)
#pragma unroll
                for (int m = 0; m < 4; ++m) zres[ai][m] = bld4(rz, voff, (unsigned)(((ai * HALF + m * 16) * 1024 + bj * HALF) * 2));
            const f32x4 g0 = *(const f32x4*)(gain + col0 + bj * HALF) * alpha, g1 = *(const f32x4*)(gain + col0 + bj * HALF + 4) * alpha, b0 = *(const f32x4*)(bias + col0 + bj * HALF) * alpha, b1 = *(const f32x4*)(bias + col0 + bj * HALF + 4) * alpha;
            __builtin_amdgcn_sched_barrier(0);
#pragma unroll
            for (int ai = 0; ai < 2; ++ai)
#pragma unroll
                for (int m = 0; m < 4; ++m) { const int row = row0 + ai * HALF + m * 16; const float mu = st[ai][m][0], rsd = st[ai][m][1];
                    const u32x4 zr = zres[ai][m];
                    const f32x4 z0 = (f32x4){bflo(zr.x), bfhi(zr.x), bflo(zr.y), bfhi(zr.y)}, z1 = (f32x4){bflo(zr.z), bfhi(zr.z), bflo(zr.w), bfhi(zr.w)};
                    const f32x4 v0 = (z0 - mu) * rsd * g0 + b0 + acc[ai][bj][m][0] * dq, v1 = (z1 - mu) * rsd * g1 + b1 + acc[ai][bj][m][1] * dq;
                    u32x4 w; w.x = pk2(v0[0], v0[1]); w.y = pk2(v0[2], v0[3]); w.z = pk2(v1[0], v1[1]); w.w = pk2(v1[2], v1[3]);
                    GST4(Z + (size_t)row * 1024 + col0 + bj * HALF) = w; } }
    }
};
struct EpiGU {
    static constexpr bool PERM = true, AFTER_DRAIN = false;
    bf16_t* H;
    __device__ __forceinline__ void operator()(const f32x4 (&acc)[2][2][4][2], const Unit& u, int wr, int wc, int fr, int fq) const {
        const int row0 = u.pm * BM + wr * 64 + fr, col0 = (u.pn & 3) * 128 + wc * 16 + 4 * fq;
#pragma unroll
        for (int ai = 0; ai < 2; ++ai)
#pragma unroll
            for (int m = 0; m < 4; ++m) { bf16_t* rowp = H + (size_t)(row0 + ai * HALF + m * 16) * 512 + col0;
#pragma unroll
                for (int bj = 0; bj < 2; ++bj) { const f32x4 g = acc[ai][bj][m][0], up = acc[ai][bj][m][1];
                    u32x2 w; w.x = pk2(f_silu(g[0]) * up[0], f_silu(g[1]) * up[1]); w.y = pk2(f_silu(g[2]) * up[2], f_silu(g[3]) * up[3]);
                    *(u32x2*)(rowp + bj * 64) = w; } }
    }
};
struct EpiGU8 {
    static constexpr bool PERM = true, AFTER_DRAIN = false, F8 = true;
    unsigned char* H;
    __device__ __forceinline__ void operator()(const f32x4 (&acc)[2][2][4][2], const Unit& u, int wr, int wc, int fr, int fq) const {
        const int row0 = u.pm * BM + wr * 64 + fr, col0 = (u.pn & 3) * 128 + wc * 32 + 8 * fq;
        constexpr float dq = 1.0f / (F8_SX * F8_SW);
#pragma unroll
        for (int ai = 0; ai < 2; ++ai)
#pragma unroll
            for (int m = 0; m < 4; ++m) { float h[8];
#pragma unroll
                for (int n = 0; n < 2; ++n) { const f32x4 g = acc[ai][0][m][n] * dq, up = acc[ai][1][m][n] * (dq * F8_SH);
#pragma unroll
                    for (int i = 0; i < 4; ++i) h[4 * n + i] = f_silu(g[i]) * up[i]; }
                u32x2 w; w.x = pk4f8(h[0], h[1], h[2], h[3]); w.y = pk4f8(h[4], h[5], h[6], h[7]);
                *(u32x2*)(H + (size_t)(row0 + ai * HALF + m * 16) * 512 + col0) = w; }
    }
};
struct EpiPlain8 {
    static constexpr bool PERM = true, AFTER_DRAIN = false, F8 = true;
    bf16_t* O; int ldc; int cmask;
    __device__ __forceinline__ void operator()(const f32x4 (&acc)[2][2][4][2], const Unit& u, int wr, int wc, int fr, int fq) const {
        const int row0 = u.pm * BM + wr * 64 + fr, col0 = (u.pn & cmask) * BM + wc * 32 + 8 * fq;
        constexpr float dq = 1.0f / (F8_SH * F8_SW);
#pragma unroll
        for (int ai = 0; ai < 2; ++ai)
#pragma unroll
            for (int m = 0; m < 4; ++m) { bf16_t* rowp = O + (size_t)(row0 + ai * HALF + m * 16) * ldc + col0;
#pragma unroll
                for (int bj = 0; bj < 2; ++bj) { const f32x4 v0 = acc[ai][bj][m][0] * dq, v1 = acc[ai][bj][m][1] * dq;
                    u32x4 w; w.x = pk2(v0[0], v0[1]); w.y = pk2(v0[2], v0[3]); w.z = pk2(v1[0], v1[1]); w.w = pk2(v1[2], v1[3]);
                    *(u32x4*)(rowp + bj * HALF) = w; } }
    }
};

typedef int i32x4_t __attribute__((ext_vector_type(4)));
template <class T, class = void> struct epi_f8 { static constexpr bool value = false; };
template <class T> struct epi_f8<T, decltype((void)T::F8)> { static constexpr bool value = true; };
template <class Epi, class Sched, bool ALIGN_EPI = false, bool SP2 = false>
__device__ __forceinline__ void gemm_phase(PG8_LAS unsigned char* lds, const Gemm g, const Sched& S, const Epi& E) {
    int tid_ = g.wv * 64 + lane_id(); asm volatile("" : "+v"(tid_));
    const int tid = tid_, wid = __builtin_amdgcn_readfirstlane(tid >> 6), lane = tid & 63, wr = wid >> 2, wc = wid & 3, fr = lane & 15, fq = lane >> 4;
    const int K = g.K, nt = K / BK; constexpr bool F8 = epi_f8<Epi>::value;
    unsigned voffA[2], voffB[2];
#pragma unroll
    for (int i = 0; i < 2; ++i) { int R, C; stage_rc(tid * 16 + i * 8192, R, C); const int Rb = Epi::PERM ? ((R & ~31) + perm32(R & 31)) : R;
        voffA[i] = (unsigned)(R * K + C) * 2u;
        voffB[i] = (unsigned)(((Rb >> 4) * (K >> 5) + (C >> 5)) * 1024 + (Rb & 15) * 64 + (C & 31) * 2); }
    constexpr bool GATH = Sched::GATHER; static_assert(!GATH || SP2, "gather mode is written for the SP2 loop");
    unsigned goc[2][2] = {{0u, 0u}, {0u, 0u}}, gon[2][2] = {{0u, 0u}, {0u, 0u}}, go2[2][2] = {{0u, 0u}, {0u, 0u}};
#define PG8_GOFF(dst, U) do { int tg_ = tid; asm volatile("" : "+v"(tg_)); _Pragma("unroll") for (int i_ = 0; i_ < 2; ++i_) { int R_, C_; stage_rc(tg_ * 16 + i_ * 8192, R_, C_); \
        _Pragma("unroll") for (int h_ = 0; h_ < 2; ++h_) dst[h_][i_] = (unsigned)S.src[(U).pm * BM + h_ * HALF + R_] * (unsigned)(K * 2) + (unsigned)C_ * 2u; } } while (0)
    const size_t kstep = (size_t)(BK * 2);
    const size_t kstepB = 2048;
    const size_t hstep = (size_t)HALF * K * 2;
    const size_t tstep = 2 * hstep;
    const unsigned ldsw = (unsigned)wid * 1024u;
    const int aoff = lds_byte(wr * 64 + fr, fq * 8), boff = lds_byte(wc * 32 + fr, fq * 8);
#define PG8_SA(b, h) (((b) * 2 + (h)) * HTB)
#define PG8_SB(b, h) ((4 + (b) * 2 + (h)) * HTB)
#define PG8_STAGE(bufoff, gbase, voff) do { _Pragma("unroll") for (int _i = 0; _i < 2; ++_i) \
        __builtin_amdgcn_global_load_lds((const unsigned*)((const char*)(gbase) + (voff)[_i]), (PG8_LAS unsigned*)(lds + (bufoff) + ldsw + _i * 8192), 16, 0, 0); } while (0)
#define PG8_STAGE_A(b, h, PTR, KPTR, GO) do { if constexpr (GATH) { PG8_STAGE(PG8_SA(b, h), KPTR, GO); } else { PG8_STAGE(PG8_SA(b, h), PTR, voffA); } } while (0)
#define PG8_LDA(dst, b, h) do { _Pragma("unroll") for (int m = 0; m < 4; ++m) _Pragma("unroll") for (int k = 0; k < 2; ++k) dst[m][k] = *(const PG8_LAS bf16x8*)(lds + PG8_SA(b, h) + aoff + m * 2048 + k * 1024); } while (0)
#define PG8_LDB(dst, b, h) do { _Pragma("unroll") for (int n = 0; n < 2; ++n) _Pragma("unroll") for (int k = 0; k < 2; ++k) dst[n][k] = *(const PG8_LAS bf16x8*)(lds + PG8_SB(b, h) + boff + n * 2048 + k * 1024); } while (0)
#define PG8_CAT8(x, y) __builtin_shufflevector(__builtin_bit_cast(i32x4_t, x), __builtin_bit_cast(i32x4_t, y), 0, 1, 2, 3, 4, 5, 6, 7)
#define PG8_MMA(ai, bj, At, Bt) do { __builtin_amdgcn_s_setprio(1); \
        if constexpr (F8) { _Pragma("unroll") for (int m = 0; m < 4; ++m) _Pragma("unroll") for (int n = 0; n < 2; ++n) \
            asm volatile("v_mfma_f32_16x16x128_f8f6f4 %0, %1, %2, %0" : "+v"(acc[ai][bj][m][n]) : "v"(PG8_CAT8(Bt[n][0], Bt[n][1])), "v"(PG8_CAT8(At[m][0], At[m][1]))); } \
        else { _Pragma("unroll") for (int m = 0; m < 4; ++m) _Pragma("unroll") for (int n = 0; n < 2; ++n) _Pragma("unroll") for (int k = 0; k < 2; ++k) \
            acc[ai][bj][m][n] = __builtin_amdgcn_mfma_f32_16x16x32_bf16(Bt[n][k], At[m][k], acc[ai][bj][m][n], 0, 0, 0); } \
        __builtin_amdgcn_s_setprio(0); } while (0)
#define PG8_WAIT_V(n) asm volatile("s_waitcnt vmcnt(" #n ")" ::: "memory")
#define PG8_WAIT_L(n) asm volatile("s_waitcnt lgkmcnt(" #n ")" ::: "memory")
#define PG8_BAR __builtin_amdgcn_s_barrier()
#define PG8_SCHED __builtin_amdgcn_sched_barrier(0)
    Unit cur, nxt; int ui = 0;
    if (!S.next(0, cur)) return;
    f32x4 acc[2][2][4][2];
#pragma unroll
    for (int a = 0; a < 2; ++a)
#pragma unroll
        for (int b = 0; b < 2; ++b)
#pragma unroll
            for (int m = 0; m < 4; ++m)
#pragma unroll
                for (int n = 0; n < 2; ++n) { acc[a][b][m][n] = (f32x4){0.f, 0.f, 0.f, 0.f}; if constexpr (F8) asm volatile("" : "+v"(acc[a][b][m][n])); }
    bf16x8 At[4][2], B0[2][2], B1[2][2];
    const char* cA = (const char*)g.A + (size_t)cur.pm * tstep; const char* cB = (const char*)g.Bt + (size_t)cur.pn * tstep;
    S.a_ready(cur);
    const char* gA = (const char*)g.A;
    if constexpr (GATH) PG8_GOFF(goc, cur);
    if constexpr (SP2) {
        PG8_STAGE(PG8_SB(0, 0), cB, voffB); PG8_STAGE(PG8_SB(0, 1), cB + hstep, voffB); PG8_STAGE_A(0, 0, cA, gA, goc[0]); PG8_STAGE_A(0, 1, cA + hstep, gA, goc[1]);
        if (wr == 1) PG8_BAR;
        PG8_WAIT_V(2); PG8_BAR;
        PG8_STAGE(PG8_SB(1, 0), cB + kstepB, voffB); PG8_STAGE_A(1, 0, cA + kstep, gA + kstep, goc[0]); PG8_STAGE(PG8_SB(1, 1), cB + hstep + kstepB, voffB);
        PG8_WAIT_V(6); PG8_BAR;
    } else {
        PG8_STAGE(PG8_SB(0, 0), cB, voffB); PG8_STAGE(PG8_SA(0, 0), cA, voffA); PG8_STAGE(PG8_SB(0, 1), cB + hstep, voffB); PG8_STAGE(PG8_SA(0, 1), cA + hstep, voffA);
        if (wr == 1) PG8_BAR;
        PG8_WAIT_V(4); PG8_BAR;
        PG8_STAGE(PG8_SB(1, 0), cB + kstepB, voffB); PG8_STAGE(PG8_SA(1, 0), cA + kstep, voffA); PG8_STAGE(PG8_SB(1, 1), cB + hstep + kstepB, voffB);
        PG8_WAIT_V(6); PG8_BAR;
    }
    for (;;) {
        const bool has_next = S.next(ui + 1, nxt);
        if constexpr (GATH) { if (has_next) PG8_GOFF(gon, nxt); else { _Pragma("unroll") for (int h_ = 0; h_ < 2; ++h_) _Pragma("unroll") for (int i_ = 0; i_ < 2; ++i_) gon[h_][i_] = goc[h_][i_]; } }
        const char* nA = has_next ? (const char*)g.A + (size_t)nxt.pm * tstep : cA; const char* nB = has_next ? (const char*)g.Bt + (size_t)nxt.pn * tstep : cB;
        for (int t = 0; t < nt; t += 2) {
            const bool last = (t == nt - 2);
            const char* a1 = cA + (size_t)(t + 1) * kstep;
            const char* a2 = last ? nA : cA + (size_t)(t + 2) * kstep; const char* b2 = last ? nB : cB + (size_t)(t + 2) * kstepB;
            const char* a3 = a2 + kstep; const char* b3 = b2 + kstepB;
            if (last && has_next) S.a_ready(nxt);
            const char* ga1 = gA + (size_t)(t + 1) * kstep; const char* ga2 = last ? gA : gA + (size_t)(t + 2) * kstep; const char* ga3 = ga2 + kstep;
            if constexpr (GATH) { _Pragma("unroll") for (int h_ = 0; h_ < 2; ++h_) _Pragma("unroll") for (int i_ = 0; i_ < 2; ++i_) go2[h_][i_] = last ? gon[h_][i_] : goc[h_][i_]; }
            if constexpr (SP2) {
            PG8_LDB(B0, 0, 0); PG8_LDB(B1, 0, 1); PG8_SCHED; PG8_LDA(At, 0, 0); PG8_STAGE_A(1, 1, a1 + hstep, ga1, goc[1]);
            PG8_WAIT_V(8); PG8_WAIT_L(0); PG8_BAR; PG8_MMA(0, 0, At, B0); PG8_MMA(0, 1, At, B1); PG8_BAR; PG8_SCHED;
            PG8_LDA(At, 0, 1); PG8_STAGE(PG8_SB(0, 0), b2, voffB); PG8_STAGE(PG8_SB(0, 1), b2 + hstep, voffB); PG8_STAGE_A(0, 0, a2, ga2, go2[0]);
            PG8_WAIT_V(8); PG8_WAIT_L(0); PG8_BAR; PG8_MMA(1, 0, At, B0); PG8_MMA(1, 1, At, B1); PG8_BAR; PG8_SCHED;
            PG8_LDB(B0, 1, 0); PG8_LDB(B1, 1, 1); PG8_SCHED; PG8_LDA(At, 1, 0); PG8_STAGE_A(0, 1, a2 + hstep, ga2, go2[1]);
            PG8_WAIT_V(8); PG8_WAIT_L(0); PG8_BAR; PG8_MMA(0, 0, At, B0); PG8_MMA(0, 1, At, B1); PG8_BAR; PG8_SCHED;
            PG8_LDA(At, 1, 1); PG8_STAGE(PG8_SB(1, 0), b3, voffB); PG8_STAGE(PG8_SB(1, 1), b3 + hstep, voffB); PG8_STAGE_A(1, 0, a3, ga3, go2[0]);
            PG8_WAIT_V(8); PG8_WAIT_L(0); PG8_BAR; PG8_MMA(1, 0, At, B0); PG8_MMA(1, 1, At, B1); PG8_BAR; PG8_SCHED;
            } else {
            PG8_LDB(B0, 0, 0); PG8_SCHED; PG8_LDA(At, 0, 0); PG8_STAGE(PG8_SA(1, 1), a1 + hstep, voffA);
            PG8_WAIT_L(8); PG8_BAR; PG8_WAIT_L(0); PG8_MMA(0, 0, At, B0); PG8_BAR; PG8_SCHED;
            PG8_LDB(B1, 0, 1); PG8_STAGE(PG8_SB(0, 0), b2, voffB);
            PG8_BAR; PG8_WAIT_L(0); PG8_MMA(0, 1, At, B1); PG8_BAR;
            PG8_LDA(At, 0, 1); PG8_STAGE(PG8_SA(0, 0), a2, voffA);
            PG8_BAR; PG8_WAIT_L(0); PG8_MMA(1, 0, At, B0); PG8_BAR; PG8_SCHED;
            PG8_STAGE(PG8_SB(0, 1), b2 + hstep, voffB);
            PG8_WAIT_V(6); PG8_BAR; PG8_MMA(1, 1, At, B1); PG8_BAR;
            PG8_LDB(B0, 1, 0); PG8_SCHED; PG8_LDA(At, 1, 0); PG8_STAGE(PG8_SA(0, 1), a2 + hstep, voffA);
            PG8_WAIT_L(8); PG8_BAR; PG8_WAIT_L(0); PG8_MMA(0, 0, At, B0); PG8_BAR; PG8_SCHED;
            PG8_LDB(B1, 1, 1); PG8_STAGE(PG8_SB(1, 0), b3, voffB);
            PG8_BAR; PG8_WAIT_L(0); PG8_MMA(0, 1, At, B1); PG8_BAR;
            PG8_LDA(At, 1, 1); PG8_STAGE(PG8_SA(1, 0), a3, voffA);
            PG8_BAR; PG8_WAIT_L(0); PG8_MMA(1, 0, At, B0); PG8_BAR; PG8_SCHED;
            PG8_STAGE(PG8_SB(1, 1), b3 + hstep, voffB);
            PG8_WAIT_V(6); PG8_BAR; PG8_MMA(1, 1, At, B1); PG8_BAR;
            }
        }
        if constexpr (F8) asm volatile("s_nop 15\n\ts_nop 15" ::: "memory");
        if constexpr (ALIGN_EPI) { if (wr == 0) PG8_BAR; }
        if constexpr (!Epi::AFTER_DRAIN) { E(acc, cur, wr, wc, fr, fq); S.done(cur); }
        if (!has_next) break;
#pragma unroll
        for (int a = 0; a < 2; ++a)
#pragma unroll
            for (int b = 0; b < 2; ++b)
#pragma unroll
                for (int m = 0; m < 4; ++m)
#pragma unroll
                    for (int n = 0; n < 2; ++n) { acc[a][b][m][n] = (f32x4){0.f, 0.f, 0.f, 0.f}; if constexpr (F8) asm volatile("" : "+v"(acc[a][b][m][n])); }
        cur = nxt; cA = nA; cB = nB; ++ui;
        if constexpr (GATH) { _Pragma("unroll") for (int h_ = 0; h_ < 2; ++h_) _Pragma("unroll") for (int i_ = 0; i_ < 2; ++i_) goc[h_][i_] = gon[h_][i_]; }
        if constexpr (ALIGN_EPI) { if (wr == 1) PG8_BAR; }
    }
    PG8_WAIT_V(0);
    if constexpr (!ALIGN_EPI) { if (wr == 0) PG8_BAR; }
    PG8_BAR;
    if constexpr (Epi::AFTER_DRAIN) { E.fused(acc, cur, wr, wc, fr, fq, lds, wid, lane); S.done(cur); }
#undef PG8_SA
#undef PG8_SB
#undef PG8_STAGE
#undef PG8_STAGE_A
#undef PG8_GOFF
#undef PG8_LDA
#undef PG8_LDB
#undef PG8_MMA
#undef PG8_WAIT_V
#undef PG8_WAIT_L
#undef PG8_BAR
#undef PG8_SCHED
}}

namespace mk {
using pg8::bf16_t; using pg8::bf16x8; using pg8::f32x4; using pg8::u32x4; using pg8::u32x2; using pg8::pk2; using pg8::bflo; using pg8::bfhi;
typedef float f32x16 __attribute__((ext_vector_type(16)));
typedef short s16x4 __attribute__((ext_vector_type(4)));
typedef short v4i16_t __attribute__((ext_vector_type(4)));
#define LAS __attribute__((address_space(3)))
#define GAS __attribute__((address_space(1)))
typedef GAS unsigned gu32;
#define RLX_AGENT __ATOMIC_RELAXED, __HIP_MEMORY_SCOPE_AGENT
#define LDS_WAIT() asm volatile("s_waitcnt lgkmcnt(0)" ::: "memory")

constexpr int NB = 8, SEQ = 8192, M = NB * SEQ, D = 1024, NP = 2816, NMEM = 256, MKV = NB * NMEM;
constexpr int PQ = 0, PK = 256, PV = 512, PR = 1024, PG = 1536, PU = 1792, PVS = 2304;
constexpr int DIN = 2576;
constexpr int MOE_ROWS = 135168;
constexpr float ALPHA = 1.4142135623730951f, LN_EPS = 1e-5f, LOG2E = 1.4426950408889634f;
constexpr int NWAVES = 8, NTHR = 512;

constexpr size_t MiB = 1u << 20;
constexpr size_t WS_CTL = 0, CTL_ZERO_BYTES = 1 * MiB;
constexpr size_t WS_WM = 1 * MiB;
constexpr size_t WS_WGCNT = 1 * MiB + 512 * 1024;
constexpr size_t WS_LTOT = 1 * MiB + 768 * 1024;
constexpr size_t WS_TINFO = 2 * MiB;
constexpr size_t WS_TRANK = 3 * MiB;
constexpr size_t WS_TSLOT = 3 * MiB + 512 * 1024;
constexpr size_t WS_SEND = 4 * MiB;
constexpr size_t WS_WKV = 12 * MiB;
constexpr size_t WS_MEMB = 20 * MiB;
constexpr size_t WS_KV = 24 * MiB;
constexpr size_t WS_W = 40 * MiB, W_LAYER = 60 * MiB;
constexpr size_t W_IN = 0, W_OUT = (size_t)NP * D * 2, W_Q = W_OUT + 2 * MiB, W_O = W_Q + 2 * MiB, W_GU = W_O + 2 * MiB, W_D = W_GU + 32 * MiB;
static_assert(W_D + 16 * MiB <= W_LAYER, "weights per layer");
constexpr size_t WS_X = 160 * MiB;
constexpr size_t WS_R = 288 * MiB;
constexpr size_t R_P = 0, R_Y = 352 * MiB, R_Z = 480 * MiB, R_Q = 0, R_O = 128 * MiB, R_XS = 352 * MiB, R_H = 0;
constexpr size_t R_X8 = 256 * MiB;
constexpr size_t WS_SRCROW = WS_R + 616 * MiB;
constexpr size_t WS_PART = WS_SRCROW + 1 * MiB;
constexpr size_t WS_STATS = WS_PART + 8 * MiB;
constexpr size_t WS_CS = WS_STATS + 1 * MiB;
constexpr size_t WS_END = WS_CS + 1 * MiB;
static_assert(R_XS + (size_t)MOE_ROWS * D * 2 <= 616 * MiB && R_H + (size_t)MOE_ROWS * 512 * 2 <= R_XS, "moe buffers");
constexpr int CW_BAR = 4096;

constexpr int LDS_BYTES = 159744, LDSCTL_OFF = 155648;
constexpr int MISC_OFF = LDSCTL_OFF;
constexpr int TILEE_OFF = LDSCTL_OFF + 512;
static_assert(TILEE_OFF + 528 * 4 <= LDS_BYTES, "LDS map");

#define XB_TMO      128
#define XB_XCNT(j)  (256  + 64 * (j))
#define XB_XSUB(j)  (1280 + 64 * (j))
#define XB_XGEN(j)  (2304 + 64 * (j))
#define XB_TOP      3328
#define XB_TOPGEN   3392
#define XCD_BAR_WORDS 3456
#define XB_SPIN_CAP (1u << 18)

__device__ __forceinline__ unsigned xb_ld(unsigned* p)              { return __hip_atomic_load(p, __ATOMIC_RELAXED, __HIP_MEMORY_SCOPE_AGENT); }
__device__ __forceinline__ unsigned xb_add(unsigned* p, unsigned v) { return __hip_atomic_fetch_add(p, v, __ATOMIC_RELAXED, __HIP_MEMORY_SCOPE_AGENT); }
__device__ __forceinline__ unsigned xb_xcc_id() { return (unsigned)__builtin_amdgcn_s_getreg((3 << 11) | 20) & 0xFu; }
#define XB_SPIN(cond, bar) do { unsigned _sp = 0; while (cond) { __builtin_amdgcn_s_sleep(1); \
    if ((++_sp & 255u) == 0u) { if (xb_ld(&(bar)[XB_TMO])) break; if (_sp > XB_SPIN_CAP) { atomicAdd(&(bar)[XB_TMO], 1u); break; } } } } while (0)

struct XcdBarrier {
    unsigned* bar; unsigned x;
    volatile LAS unsigned* st;
    int wv;
};

__device__ __forceinline__ XcdBarrier xcd_barrier_post(unsigned* bar, volatile LAS unsigned* st) {
    XcdBarrier b; b.bar = bar; b.x = xb_xcc_id(); b.st = st; b.wv = 0;
    if (threadIdx.x == 0) (void)xb_add(&bar[XB_XCNT(b.x)], 1u);
    return b;
}
__device__ __forceinline__ void xcd_barrier_complete(unsigned* bar, unsigned x, unsigned& nloc, unsigned& nx) {
    const unsigned G = gridDim.x * gridDim.y * gridDim.z;
    unsigned sum, cnt, mine, sp = 0u;
    for (;;) {
        sum = 0u; cnt = 0u; mine = 0u;
#pragma unroll
        for (unsigned j = 0; j < 16; ++j) { const unsigned c = xb_ld(&bar[XB_XCNT(j)]); sum += c; cnt += (c > 0u) ? 1u : 0u; mine = (j == x) ? c : mine; }
        if (sum == G) break;
        __builtin_amdgcn_s_sleep(1);
        if ((++sp & 255u) == 0u) { if (xb_ld(&bar[XB_TMO])) break; if (sp > XB_SPIN_CAP) { atomicAdd(&bar[XB_TMO], 1u); break; } }
    }
    nloc = mine > 0u ? mine : 1u; nx = cnt > 0u ? cnt : 1u;
}

__device__ __forceinline__ void xcd_barrier(const XcdBarrier& b) {
    asm volatile("s_waitcnt vmcnt(0)" ::: "memory");
    __syncthreads();
    if (b.wv == 0 && pg8::lane_id() == 0) {
        unsigned* bar = b.bar;
        __builtin_amdgcn_s_waitcnt(0);
        unsigned nloc = b.st[0], nx = b.st[1];
        if (nloc == 0u) { xcd_barrier_complete(bar, b.x, nloc, nx); b.st[0] = nloc; b.st[1] = nx; }
        const unsigned old = xb_add(&bar[XB_XSUB(b.x)], 1u);
        const unsigned gen = old / nloc;
        if (old + 1u == (gen + 1u) * nloc) {
            __builtin_amdgcn_fence(__ATOMIC_RELEASE, "agent");
            asm volatile("s_waitcnt vmcnt(0)" ::: "memory");
            const unsigned og = xb_add(&bar[XB_TOP], 1u);
            const unsigned tg = og / nx;
            if (og + 1u == (tg + 1u) * nx) xb_add(&bar[XB_TOPGEN], 1u);
            else XB_SPIN(xb_ld(&bar[XB_TOPGEN]) == tg, bar);
            __builtin_amdgcn_fence(__ATOMIC_ACQUIRE, "agent");
            xb_add(&bar[XB_XGEN(b.x)], 1u);
            asm volatile("s_waitcnt vmcnt(0)" ::: "memory");
        } else {
            XB_SPIN(xb_ld(&bar[XB_XGEN(b.x)]) == gen, bar);
            __builtin_amdgcn_fence(__ATOMIC_ACQUIRE, "agent");
            asm volatile("s_waitcnt vmcnt(0)" ::: "memory");
        }
    }
    __syncthreads();
}
__device__ __forceinline__ float shx(float v, int m, int lane) { return __builtin_bit_cast(float, __builtin_amdgcn_ds_bpermute((lane ^ m) << 2, __builtin_bit_cast(int, v))); }
__device__ __forceinline__ int shxi(int v, int m, int lane) { return __builtin_amdgcn_ds_bpermute((lane ^ m) << 2, v); }
__device__ __forceinline__ s16x4 vtr(unsigned lds_addr) { return __builtin_bit_cast(s16x4, __builtin_amdgcn_ds_read_tr16_b64_v4i16((LAS v4i16_t*)(size_t)lds_addr)); }
__device__ __forceinline__ bf16x8 cat8(s16x4 lo, s16x4 hi) { return __builtin_shufflevector(lo, hi, 0, 1, 2, 3, 4, 5, 6, 7); }
__device__ __forceinline__ void unpack8(const u32x4 w, float (&f)[8]) { f[0] = bflo(w.x); f[1] = bfhi(w.x); f[2] = bflo(w.y); f[3] = bfhi(w.y); f[4] = bflo(w.z); f[5] = bfhi(w.z); f[6] = bflo(w.w); f[7] = bfhi(w.w); }
__device__ __forceinline__ u32x4 pack8(const float (&f)[8]) { u32x4 w; w.x = pk2(f[0], f[1]); w.y = pk2(f[2], f[3]); w.z = pk2(f[4], f[5]); w.w = pk2(f[6], f[7]); return w; }

struct Args {
    const float* in[22]; float* out; unsigned char* ws;
};

__device__ __forceinline__ void transpose_item(const float* p0, const float* p1, int ld, int mode, float scale, int K, int nblk, bf16_t* dst, int row0, LAS float* scr, int item, int lane, const float* kscale = nullptr) {
    const int kb = item / nblk, nb = item % nblk, k0 = 64 * kb, n0 = 32 * nb;
    const int np = n0 + (lane & 31);
    const float* sp; int col;
    if (mode == 0) { sp = p0; col = np; } else { sp = (np & 4) ? p1 : p0; col = (np >> 3) * 4 + (np & 3); }
    sp += (size_t)k0 * ld + col;
#pragma unroll 8
    for (int i = 0; i < 32; ++i) { const int kk = 2 * i + (lane >> 5); scr[kk * 33 + (lane & 31)] = sp[(size_t)kk * ld] * scale * (kscale ? kscale[k0 + kk] : 1.0f); }
    LDS_WAIT(); asm volatile("" ::: "memory");
    const int c = lane & 7;
#pragma unroll
    for (int j = 0; j < 4; ++j) { const int n = (lane >> 3) + 8 * j; const LAS float* s = scr + (8 * c) * 33 + n;
        u32x4 o; o.x = pk2(s[0 * 33], s[1 * 33]); o.y = pk2(s[2 * 33], s[3 * 33]); o.z = pk2(s[4 * 33], s[5 * 33]); o.w = pk2(s[6 * 33], s[7 * 33]);
        const int ng = row0 + n0 + n, kk = k0 + 8 * c;
        *(u32x4*)(dst + ((size_t)(ng >> 4) * (K >> 5) + (kk >> 5)) * 512 + (ng & 15) * 32 + (kk & 31)) = o; }
    LDS_WAIT(); asm volatile("" ::: "memory");
}
__device__ __forceinline__ void transpose_item8(const float* p0, const float* p1, int ld, int mode, float scale, int K, int nblk, unsigned char* dst, int row0, LAS float* scr, int item, int lane) {
    const int kb = item / nblk, nb = item % nblk, k0 = 64 * kb, n0 = 32 * nb;
    const int np = n0 + (lane & 31);
    const float* sp; int col;
    if (mode == 0) { sp = p0; col = np; } else { sp = ((np >> 7) & 1) ? p1 : p0; col = (np >> 8) * 128 + (np & 127); }
    sp += (size_t)k0 * ld + col;
#pragma unroll 8
    for (int i = 0; i < 32; ++i) { const int kk = 2 * i + (lane >> 5); scr[kk * 33 + (lane & 31)] = sp[(size_t)kk * ld] * scale; }
    LDS_WAIT(); asm volatile("" ::: "memory");
    const int c = lane & 7;
#pragma unroll
    for (int j = 0; j < 4; ++j) { const int n = (lane >> 3) + 8 * j; const LAS float* s = scr + (8 * c) * 33 + n;
        u32x2 o; o.x = pg8::pk4f8(s[0 * 33], s[1 * 33], s[2 * 33], s[3 * 33]); o.y = pg8::pk4f8(s[4 * 33], s[5 * 33], s[6 * 33], s[7 * 33]);
        const int ng = row0 + n0 + n;
        *(u32x2*)(dst + ((size_t)(ng >> 4) * (K >> 6) + (k0 >> 6)) * 1024 + (ng & 15) * 64 + 8 * c) = o; }
    LDS_WAIT(); asm volatile("" ::: "memory");
}
__device__ __forceinline__ void p0_convert(const Args& a, LAS unsigned char* lds, int bid, int G, int wave_s) {
    int tid_ = wave_s * 64 + pg8::lane_id(); asm volatile("" : "+v"(tid_)); const int tid = tid_, lane = tid & 63, wave = __builtin_amdgcn_readfirstlane(tid >> 6);
    unsigned char* ws = a.ws;
    LAS float* scr = (LAS float*)(lds + wave * 16384);
    const int gw = bid * NWAVES + wave, NGW = G * NWAVES;
    constexpr int I_INQ = 16 * 8, I_INB = 16 * 40, I_INC = 16 * 32, I_SQ = 16 * 32, I_GU = 16 * 16 * 32, I_DN = 16 * 8 * 32;
    constexpr int I_LAYER = I_INQ + I_INB + I_INC + 5 * I_SQ + I_GU + I_DN;
    for (int it = gw; it < 2 * I_LAYER; it += NGW) {
        const int l = it / I_LAYER; int r = it % I_LAYER;
        unsigned char* wl = ws + WS_W + (size_t)l * W_LAYER;
        const float* w_in = a.in[2] + (size_t)l * D * DIN;
        if (r < I_INQ) { transpose_item(w_in, nullptr, DIN, 0, 0.125f, D, 8, (bf16_t*)(wl + W_IN), 0, scr, r, lane); continue; } r -= I_INQ;
        if (r < I_INB) { transpose_item(w_in + 256, nullptr, DIN, 0, 1.0f, D, 40, (bf16_t*)(wl + W_IN), 256, scr, r, lane); continue; } r -= I_INB;
        if (r < I_INC) { transpose_item(w_in + 1552, nullptr, DIN, 0, 1.0f, D, 32, (bf16_t*)(wl + W_IN), 1792, scr, r, lane); continue; } r -= I_INC;
        if (r < I_SQ) { transpose_item(a.in[10] + (size_t)l * D * D, nullptr, D, 0, 1.0f, D, 32, (bf16_t*)(wl + W_OUT), 0, scr, r, lane); continue; } r -= I_SQ;
        if (r < I_SQ) { transpose_item(a.in[11] + (size_t)l * D * D, nullptr, D, 0, 0.0625f, D, 32, (bf16_t*)(wl + W_Q), 0, scr, r, lane, a.in[20] + (size_t)(l * 3 + 0) * D); continue; } r -= I_SQ;
        if (r < I_SQ) { transpose_item8(a.in[14] + (size_t)l * D * D, nullptr, D, 0, pg8::F8_SW, D, 32, wl + W_O, 0, scr, r, lane); continue; } r -= I_SQ;
        if (r < I_SQ) { transpose_item(a.in[12] + (size_t)l * D * D, nullptr, D, 0, 1.0f, D, 32, (bf16_t*)(ws + WS_WKV), l * 2048, scr, r, lane); continue; } r -= I_SQ;
        if (r < I_SQ) { transpose_item(a.in[13] + (size_t)l * D * D, nullptr, D, 0, 1.0f, D, 32, (bf16_t*)(ws + WS_WKV), l * 2048 + 1024, scr, r, lane); continue; } r -= I_SQ;
        if (r < I_GU) { const int e = r / 512, rr = r % 512; const size_t eo = ((size_t)l * 16 + e) * D * 512;
            transpose_item8(a.in[17] + eo, a.in[18] + eo, 512, 2, pg8::F8_SW, D, 32, wl + W_GU, e * 1024, scr, rr, lane); continue; } r -= I_GU;
        { const int e = r / 256, rr = r % 256; const size_t eo = ((size_t)l * 16 + e) * 512 * D;
            transpose_item8(a.in[19] + eo, nullptr, D, 0, pg8::F8_SW, 512, 32, wl + W_D, e * 1024, scr, rr, lane); }
    }
    const size_t gt = (size_t)bid * NTHR + tid, NT = (size_t)G * NTHR;
    for (int it = gw; it < 2 * 16 * 16; it += NGW) { const int l = it >> 8, kc = (it >> 4) & 15, n = (it & 15) * 64 + lane;
        const float* wq = a.in[11] + (size_t)l * D * D; const float* gg = a.in[20] + (size_t)(l * 3) * D; const float* bb = a.in[21] + (size_t)(l * 3) * D; float cs = 0.f, bq = 0.f;
#pragma unroll 8
        for (int k = 64 * kc; k < 64 * kc + 64; ++k) { const float w = wq[(size_t)k * D + n] * 0.0625f; cs += bflo(pk2(w * gg[k], 0.f) & 0xffffu); bq += w * bb[k]; }
        float* tb = (float*)(ws + WS_CS) + (size_t)l * 2 * 16 * 1024; tb[kc * 1024 + n] = cs; tb[16 * 1024 + kc * 1024 + n] = bq; }
    for (size_t i = gt; i < (size_t)2 * 256 * 128; i += NT) {
        const int l = (int)(i / (256 * 128)), r = (int)(i % (256 * 128)), j = r / 128, k8 = r % 128;
        const float* w_in = a.in[2] + (size_t)l * D * DIN; const float* w_a2 = a.in[3] + (size_t)l * 16 * 256;
        float wa[16];
#pragma unroll
        for (int q = 0; q < 16; ++q) wa[q] = w_a2[q * 256 + j];
        float o[8];
#pragma unroll
        for (int kk = 0; kk < 8; ++kk) { const float* wr = w_in + (size_t)(8 * k8 + kk) * DIN + 1536; float s = 0.f;
#pragma unroll
            for (int q = 0; q < 16; q += 4) { const f32x4 v = *(const f32x4*)(wr + q); s += v[0] * wa[q] + v[1] * wa[q + 1] + v[2] * wa[q + 2] + v[3] * wa[q + 3]; }
            o[kk] = s; }
        { const int ng = 1536 + j, kk = 8 * k8; *(u32x4*)((bf16_t*)(ws + WS_W + (size_t)l * W_LAYER + W_IN) + ((size_t)(ng >> 4) * (D >> 5) + (kk >> 5)) * 512 + (ng & 15) * 32 + (kk & 31)) = pack8(o); }
    }
    for (size_t i = gt; i < (size_t)2 * 4 * 128 * 16; i += NT) {
        const int s8 = (int)(i & 15), t = (int)((i >> 4) & 127);
        const float* src = a.in[6] + i * 8; float o[8];
#pragma unroll
        for (int q = 0; q < 8; ++q) o[q] = ((8 * s8 + q) / 64 <= t / 64) ? src[q] : 0.f;
        *(u32x4*)((bf16_t*)(ws + WS_WM) + i * 8) = pack8(o);
    }
    for (size_t i = gt; i < (size_t)M * D / 8; i += NT) {
        const f32x4 v0 = *(const f32x4*)(a.in[0] + i * 8), v1 = *(const f32x4*)(a.in[0] + i * 8 + 4);
        u32x4 w; w.x = pk2(v0[0], v0[1]); w.y = pk2(v0[2], v0[3]); w.z = pk2(v1[0], v1[1]); w.w = pk2(v1[2], v1[3]);
        *(u32x4*)((bf16_t*)(ws + WS_X) + i * 8) = w;
    }
    for (size_t i = gt; i < (size_t)MKV * D / 8; i += NT) {
        const f32x4 v0 = *(const f32x4*)(a.in[1] + i * 8), v1 = *(const f32x4*)(a.in[1] + i * 8 + 4);
        u32x4 w; w.x = pk2(v0[0], v0[1]); w.y = pk2(v0[2], v0[3]); w.z = pk2(v1[0], v1[1]); w.w = pk2(v1[2], v1[3]);
        *(u32x4*)((bf16_t*)(ws + WS_MEMB) + i * 8) = w;
    }
}

constexpr int GL_KD = 0, GL_QS = 9216, GL_VS = 18432, GL_PSUM = 35840, GL_DL = 37888, GL_SSQ = 38144;
template <bool FINAL>
__device__ __forceinline__ void gla_phase(LAS unsigned char* lds, const bf16_t* P, float* Send, float* Ltot, bf16_t* Y, const float* gn_g, int bid, int G, int wave_s) {
    int tid_ = wave_s * 64 + pg8::lane_id(); asm volatile("" : "+v"(tid_)); const int tid = tid_, lane = tid & 63, wave = __builtin_amdgcn_readfirstlane(tid >> 6);
    const unsigned lb = (unsigned)(size_t)lds;
    const int g = lane >> 4, l15 = lane & 15, q4 = l15 >> 2, p4 = lane & 3;
    const int kq = tid & 63, part = wave;
    for (int item = bid; item < 256; item += G) {
        const int b = item >> 5, h = (item >> 3) & 3, run = item & 7, bh = item >> 3;
        f32x4 sacc[4];
#pragma unroll
        for (int kt = 0; kt < 4; ++kt) sacc[kt] = (f32x4){0.f, 0.f, 0.f, 0.f};
        if (FINAL) {
            for (int i = 0; i < run; ++i) {
                const float* se = Send + ((size_t)(bh * 8 + i) * 64) * 128; const float* lt = Ltot + (size_t)(bh * 8 + i) * 64;
#pragma unroll
                for (int kt = 0; kt < 4; ++kt)
#pragma unroll
                    for (int r = 0; r < 4; ++r) { const int k = 16 * kt + 4 * g + r; sacc[kt][r] = __expf(lt[k]) * sacc[kt][r] + se[(size_t)k * 128 + 16 * wave + l15]; }
            }
        }
        float ltot_acc = 0.f;
        unsigned short graw[8], kraw[8]; u32x4 vraw[2], qraw; u32x2 rraw[4];
        const int v_row = tid >> 4, v_c16 = tid & 15, q_row = tid >> 3, q_c16 = tid & 7;
        const int ycol = h * 128 + 16 * wave + 4 * g;
#define GLA_FETCH(CC) do { const size_t tf_ = (size_t)b * SEQ + (size_t)(run * 16 + (CC)) * 64; \
            _Pragma("unroll") for (int i = 0; i < 8; ++i) { const bf16_t* rp = P + (tf_ + 8 * part + i) * NP + h * 64 + kq; graw[i] = rp[PG]; kraw[i] = rp[PK]; } \
            _Pragma("unroll") for (int i = 0; i < 2; ++i) vraw[i] = *(const u32x4*)(P + (tf_ + v_row + 32 * i) * NP + PV + h * 128 + v_c16 * 8); \
            if (FINAL) { qraw = *(const u32x4*)(P + (tf_ + q_row) * NP + PQ + h * 64 + q_c16 * 8); \
                _Pragma("unroll") for (int tt = 0; tt < 4; ++tt) rraw[tt] = *(const u32x2*)(P + (tf_ + 16 * tt + l15) * NP + PR + ycol); } } while (0)
        GLA_FETCH(0);
        for (int c = 0; c < 16; ++c) {
            const size_t t0 = (size_t)b * SEQ + (size_t)(run * 16 + c) * 64;
            __syncthreads();
            float gv[8], kv[8];
#pragma unroll
            for (int i = 0; i < 8; ++i) { gv[i] = __builtin_bit_cast(float, (unsigned)graw[i] << 16); kv[i] = __builtin_bit_cast(float, (unsigned)kraw[i] << 16); }
#pragma unroll
            for (int i = 1; i < 8; ++i) gv[i] += gv[i - 1];
            ((LAS float*)(lds + GL_PSUM))[part * 64 + kq] = gv[7];
#pragma unroll
            for (int i = 0; i < 2; ++i) *(LAS u32x4*)(lds + GL_VS + (v_row + 32 * i) * 272 + v_c16 * 16) = vraw[i];
            u32x2 rcur[4];
            if (FINAL) { *(LAS u32x4*)(lds + GL_QS + q_row * 144 + q_c16 * 16) = qraw;
#pragma unroll
                for (int tt = 0; tt < 4; ++tt) rcur[tt] = rraw[tt]; }
            if (c + 1 < 16) GLA_FETCH(c + 1);
            __syncthreads();
            float offs = 0.f, bl = 0.f;
#pragma unroll
            for (int p = 0; p < 8; ++p) { const float v = ((LAS float*)(lds + GL_PSUM))[p * 64 + kq]; offs += (p < part) ? v : 0.f; bl += v; }
#pragma unroll
            for (int i = 0; i < 8; ++i) { const float kd = kv[i] * __expf(bl - (offs + gv[i]));
                *(LAS unsigned short*)(lds + GL_KD + (8 * part + i) * 144 + kq * 2) = (unsigned short)(pk2(kd, 0.f) & 0xffffu); }
            if (part == 0) ((LAS float*)(lds + GL_DL))[kq] = __expf(bl);
            ltot_acc += bl;
            __syncthreads();
#pragma unroll
            for (int kt = 0; kt < 4; ++kt) { const f32x4 dl = *(LAS f32x4*)(lds + GL_DL + (16 * kt + 4 * g) * 4); sacc[kt] = sacc[kt] * dl; }
#pragma unroll
            for (int ks = 0; ks < 2; ++ks) {
                const unsigned vrow = lb + GL_VS + (unsigned)(32 * ks + 8 * g + q4) * 272u + (unsigned)(16 * wave + 4 * p4) * 2u;
                const bf16x8 vb = cat8(vtr(vrow), vtr(vrow + 4u * 272u));
#pragma unroll
                for (int kt = 0; kt < 4; ++kt) {
                    const unsigned krow = lb + GL_KD + (unsigned)(32 * ks + 8 * g + q4) * 144u + (unsigned)(16 * kt + 4 * p4) * 2u;
                    const bf16x8 ka = cat8(vtr(krow), vtr(krow + 4u * 144u));
                    sacc[kt] = __builtin_amdgcn_mfma_f32_16x16x32_bf16(ka, vb, sacc[kt], 0, 0, 0);
                }
            }
            if (FINAL) {
                f32x4 oacc[4];
#pragma unroll
                for (int tt = 0; tt < 4; ++tt) oacc[tt] = (f32x4){0.f, 0.f, 0.f, 0.f};
#pragma unroll
                for (int ks2 = 0; ks2 < 2; ++ks2) {
                    u32x4 spw; spw.x = pk2(sacc[2 * ks2][0], sacc[2 * ks2][1]); spw.y = pk2(sacc[2 * ks2][2], sacc[2 * ks2][3]);
                    spw.z = pk2(sacc[2 * ks2 + 1][0], sacc[2 * ks2 + 1][1]); spw.w = pk2(sacc[2 * ks2 + 1][2], sacc[2 * ks2 + 1][3]);
                    const bf16x8 sp = __builtin_bit_cast(bf16x8, spw);
#pragma unroll
                    for (int tt = 0; tt < 4; ++tt) {
                        const LAS unsigned char* qp = lds + GL_QS + (16 * tt + l15) * 144 + (32 * ks2 + 4 * g) * 2;
                        const u32x2 qlo = *(const LAS u32x2*)qp, qhi = *(const LAS u32x2*)(qp + 32);
                        u32x4 qw; qw.x = qlo.x; qw.y = qlo.y; qw.z = qhi.x; qw.w = qhi.y;
                        oacc[tt] = __builtin_amdgcn_mfma_f32_16x16x32_bf16(sp, __builtin_bit_cast(bf16x8, qw), oacc[tt], 0, 0, 0);
                    }
                }
#pragma unroll
                for (int tt = 0; tt < 4; ++tt) { float s = oacc[tt][0] * oacc[tt][0] + oacc[tt][1] * oacc[tt][1] + oacc[tt][2] * oacc[tt][2] + oacc[tt][3] * oacc[tt][3];
                    s += shx(s, 16, lane); s += shx(s, 32, lane);
                    if (g == 0) ((LAS float*)(lds + GL_SSQ))[wave * 64 + 16 * tt + l15] = s; }
                __syncthreads();
                const int col = h * 128 + 16 * wave + 4 * g;
                const f32x4 gn = *(const f32x4*)(gn_g + col);
#pragma unroll
                for (int tt = 0; tt < 4; ++tt) { float tot = 0.f;
#pragma unroll
                    for (int w2 = 0; w2 < 8; ++w2) tot += ((LAS float*)(lds + GL_SSQ))[w2 * 64 + 16 * tt + l15];
                    const float rs = __builtin_amdgcn_rsqf(tot * (1.0f / 128.0f) + 1e-6f);
                    const size_t tok = t0 + 16 * tt + l15;
                    const u32x2 rr = rcur[tt];
                    u32x2 w; w.x = pk2(oacc[tt][0] * rs * gn[0] * bflo(rr.x), oacc[tt][1] * rs * gn[1] * bfhi(rr.x));
                    w.y = pk2(oacc[tt][2] * rs * gn[2] * bflo(rr.y), oacc[tt][3] * rs * gn[3] * bfhi(rr.y));
                    *(u32x2*)(Y + tok * D + col) = w; }
            }
        }
        if (!FINAL) {
            float* se = Send + ((size_t)(bh * 8 + run) * 64) * 128;
#pragma unroll
            for (int kt = 0; kt < 4; ++kt)
#pragma unroll
                for (int r = 0; r < 4; ++r) se[(size_t)(16 * kt + 4 * g + r) * 128 + 16 * wave + l15] = sacc[kt][r];
            if (part == 0) Ltot[(size_t)(bh * 8 + run) * 64 + kq] = ltot_acc;
        }
    }
}

#undef GLA_FETCH
constexpr int SG_VN = 0;
__device__ __forceinline__ void sgu_phase(LAS unsigned char* lds, const bf16_t* P, const bf16_t* Wm, const float* b_s, const float* lg, const float* lb_, bf16_t* Y, int bid, int G, int wave_s) {
    int tid_ = wave_s * 64 + pg8::lane_id(); asm volatile("" : "+v"(tid_)); const int tid = tid_, lane = tid & 63, wave = __builtin_amdgcn_readfirstlane(tid >> 6);
    const unsigned lb = (unsigned)(size_t)lds;
    const int g = lane >> 4, l15 = lane & 15, q4 = l15 >> 2, p4 = lane & 3;
    const int row = tid >> 2, qu = tid & 3;
    u32x4 vraw[4]; u32x2 uraw[8];
#define SGU_FETCH(IT) do { const int blk_ = (IT) >> 2, gr_ = (IT) & 3; const size_t tf_ = (size_t)blk_ * 128; \
        const bf16_t* src_ = P + (tf_ + row) * NP + PVS + gr_ * 128 + 32 * qu; \
        _Pragma("unroll") for (int i = 0; i < 4; ++i) vraw[i] = *(const u32x4*)(src_ + 8 * i); \
        const bf16_t* us_ = P + (tf_ + 16 * wave + l15) * NP + PU + gr_ * 128 + 4 * g; \
        _Pragma("unroll") for (int ct = 0; ct < 8; ++ct) uraw[ct] = *(const u32x2*)(us_ + 16 * ct); } while (0)
    if (bid < 2048) SGU_FETCH(bid);
    for (int item = bid; item < 2048; item += G) {
        const int blk = item >> 2, gr = item & 3; const size_t t0 = (size_t)blk * 128;
        __syncthreads();
        u32x2 ucur[8];
        { float v[32];
#pragma unroll
          for (int i = 0; i < 4; ++i) { float f[8]; unpack8(vraw[i], f);
#pragma unroll
              for (int j = 0; j < 8; ++j) v[8 * i + j] = f[j]; }
#pragma unroll
          for (int ct = 0; ct < 8; ++ct) ucur[ct] = uraw[ct];
          if (item + G < 2048) SGU_FETCH(item + G);
          float s = 0.f;
#pragma unroll
          for (int i = 0; i < 32; ++i) s += v[i];
          s += shx(s, 1, lane); s += shx(s, 2, lane);
          const float mu = s * (1.0f / 128.0f); float qq = 0.f;
#pragma unroll
          for (int i = 0; i < 32; ++i) { v[i] -= mu; qq += v[i] * v[i]; }
          qq += shx(qq, 1, lane); qq += shx(qq, 2, lane);
          const float rs = __builtin_amdgcn_rsqf(qq * (1.0f / 128.0f) + LN_EPS);
          const float* gp = lg + gr * 128 + 32 * qu; const float* bp = lb_ + gr * 128 + 32 * qu;
#pragma unroll
          for (int i = 0; i < 4; ++i) { float f[8];
#pragma unroll
              for (int j = 0; j < 8; ++j) f[j] = v[8 * i + j] * rs * gp[8 * i + j] + bp[8 * i + j];
              *(LAS u32x4*)(lds + SG_VN + row * 272 + (32 * qu + 8 * i) * 2) = pack8(f); }
        }
        __syncthreads();
        const int nks = (wave < 4) ? 2 : 4;
        bf16x8 wf[4];
#pragma unroll
        for (int ks = 0; ks < 4; ++ks) wf[ks] = *(const bf16x8*)(Wm + ((size_t)(gr * 128 + 16 * wave + l15)) * 128 + 32 * ks + 8 * g);
        const size_t tok = t0 + 16 * wave + l15; const float bs = b_s[gr * 128 + 16 * wave + l15];
        unsigned vb0 = lb + SG_VN + (unsigned)(8 * g + q4) * 272u + (unsigned)(4 * p4) * 2u; asm volatile("" : "+v"(vb0));
#pragma unroll
        for (int ct = 0; ct < 8; ++ct) {
            f32x4 acc = (f32x4){0.f, 0.f, 0.f, 0.f};
#pragma unroll
            for (int ks = 0; ks < 4; ++ks) {
                if (ks < nks) {
                    const unsigned vrow = vb0 + (unsigned)(32 * ks * 272 + 32 * ct);
                    const bf16x8 va = cat8(vtr(vrow), vtr(vrow + 4u * 272u));
                    acc = __builtin_amdgcn_mfma_f32_16x16x32_bf16(va, wf[ks], acc, 0, 0, 0);
                }
            }
            const int col = gr * 128 + 16 * ct + 4 * g;
            const u32x2 uu = ucur[ct];
            u32x2 w; w.x = pk2(bflo(uu.x) * (acc[0] + bs), bfhi(uu.x) * (acc[1] + bs)); w.y = pk2(bflo(uu.y) * (acc[2] + bs), bfhi(uu.y) * (acc[3] + bs));
            *(u32x2*)(Y + tok * D + 512 + col) = w;
        }
    }
}
#undef SGU_FETCH

constexpr int AT_KPS = 1040, AT_VPS = 1088, AT_SLOT = 34816, AT_NSLOT = 3;
static_assert(AT_NSLOT * AT_SLOT <= LDSCTL_OFF, "attention LDS");
__device__ __forceinline__ void glds16(const void* gsrc, unsigned lds_dst) { unsigned keep;
    asm volatile("s_mov_b32 %0, m0\n\ts_mov_b32 m0, %2\n\ts_nop 0\n\tglobal_load_lds_dwordx4 %1, off\n\ts_mov_b32 m0, %0" : "=&s"(keep) : "v"(gsrc), "s"(lds_dst) : "memory"); }
__device__ __forceinline__ void attn_dma(unsigned lb, const char* kvb, int so, unsigned lane_off, int slot, int ps, int wave) {
#pragma unroll
    for (int j = 0; j < 4; ++j) { const int pi = 4 * wave + j, rlo = 32 * (pi >> 4) + (pi & 15);
        glds16(kvb + (size_t)(so + rlo * 8192) + lane_off, (unsigned)__builtin_amdgcn_readfirstlane((int)(lb + (unsigned)(slot * AT_SLOT + pi * ps)))); }
}
#define AT_WAITBAR(N) do { asm volatile("s_waitcnt vmcnt(" #N ") lgkmcnt(0)" ::: "memory"); __builtin_amdgcn_s_barrier(); asm volatile("" ::: "memory"); } while (0)
__device__ __forceinline__ void attn_phase(LAS unsigned char* lds, const bf16_t* Q, const bf16_t* KV, bf16_t* O, int layer, int bid, int G, int wave_s) {
    int tid_ = wave_s * 64 + pg8::lane_id(); asm volatile("" : "+v"(tid_)); const int tid = tid_, lane = tid & 63, wave = __builtin_amdgcn_readfirstlane(tid >> 6);
    const unsigned lb = (unsigned)(size_t)lds;
    const int r32 = lane & 31, hh = lane >> 5, q4 = (lane & 15) >> 2, p4 = lane & 3, blk = (lane >> 4) & 1;
    LAS unsigned char* kbase = lds + (r32 & 15) * AT_KPS + ((r32 >> 4) & 1) * 512 + hh * 16;
    unsigned vbase = lb + (unsigned)(4 * hh + q4) * (unsigned)AT_VPS + (unsigned)(16 * blk + 4 * p4) * 2u;
    unsigned lane_off = (unsigned)((lane >> 5) * 16 * 8192 + (lane & 31) * 16);
    asm volatile("" : "+v"(kbase), "+v"(vbase), "+v"(lane_off));
    const char* kvb = (const char*)KV;
    const int nun = (bid < 256) ? 4 * ((256 - bid + G - 1) / G) : 0;
#define AT_SRC(N, ST) ((int)((((size_t)(((bid + ((N) >> 2) * G) >> 5) * NMEM) * 4096 + layer * 2048 + ((N) & 3) * 256 + (((ST) >> 2) * 1024)) * 2) + ((ST) & 3) * 64 * 8192))
    __syncthreads();
    if (nun > 0) { attn_dma(lb, kvb, AT_SRC(0, 0), lane_off, 0, AT_KPS, wave); attn_dma(lb, kvb, AT_SRC(0, 1), lane_off, 1, AT_KPS, wave); AT_WAITBAR(4); }
    int sl = 0;
    for (int n = 0; n < nun; ++n) {
        const int pan = bid + (n >> 2) * G, h = n & 3, b = pan >> 5, qt = pan & 31;
        int ln_ = pg8::lane_id(); asm volatile("" : "+v"(ln_));
        const unsigned qoff = (unsigned)((wave * 16 * 64 + ln_) * 16);
        const char* qbase = (const char*)(Q + (size_t)(pan * 4 + h) * 65536);
        char* obase = (char*)O + ((size_t)b * SEQ + qt * 256) * D + h * 256;
        const bool more = (n + 1 < nun);
        bf16x8 qf[16];
#pragma unroll
        for (int s = 0; s < 16; ++s) qf[s] = *(const GAS bf16x8*)(qbase + qoff + 1024 * s);
        float ml = 0.f, lsum = 0.f;
        bf16x8 pk[8][2];
#pragma unroll
        for (int st = 0; st < 4; ++st) {
            const int sl2 = (sl >= 1) ? sl - 1 : 2;
            if (st > 0) attn_dma(lb, kvb, AT_SRC(n, st + 2), lane_off, sl2, (st + 2 < 4) ? AT_KPS : AT_VPS, wave);
            LAS unsigned char* kb = kbase + sl * AT_SLOT;
            f32x16 sa[2];
#pragma unroll
            for (int kt = 0; kt < 2; ++kt)
#pragma unroll
                for (int r = 0; r < 16; ++r) sa[kt][r] = 0.f;
            bf16x8 kfa[2], kfb[2];
#define AT_KLD(dst, S0) do { _Pragma("unroll") for (int kt = 0; kt < 2; ++kt) dst[kt] = *(const LAS bf16x8*)(kb + kt * 16 * AT_KPS + 32 * (S0)); } while (0)
#define AT_KMM(src, S0) do { _Pragma("unroll") for (int kt = 0; kt < 2; ++kt) sa[kt] = __builtin_amdgcn_mfma_f32_32x32x16_bf16(src[kt], qf[(S0)], sa[kt], 0, 0, 0); } while (0)
            AT_KLD(kfa, 0); __builtin_amdgcn_sched_barrier(0);
#pragma unroll
            for (int bq = 0; bq < 8; ++bq) {
                AT_KLD(kfb, 2 * bq + 1); __builtin_amdgcn_sched_barrier(0);
                AT_KMM(kfa, 2 * bq); __builtin_amdgcn_sched_barrier(0);
                if (bq < 7) { AT_KLD(kfa, 2 * bq + 2); __builtin_amdgcn_sched_barrier(0); }
                AT_KMM(kfb, 2 * bq + 1); __builtin_amdgcn_sched_barrier(0);
            }
#undef AT_KLD
#undef AT_KMM
            if (st == 0) attn_dma(lb, kvb, AT_SRC(n, 2), lane_off, sl2, AT_KPS, wave);
            if (st == 0) { float mx = -3.0e38f;
#pragma unroll
                for (int kt = 0; kt < 2; ++kt)
#pragma unroll
                    for (int r = 0; r < 16; ++r) mx = __builtin_fmaxf(mx, sa[kt][r]);
                mx = __builtin_fmaxf(mx, shx(mx, 32, lane)); ml = mx * LOG2E; }
#pragma unroll
            for (int kt = 0; kt < 2; ++kt) {
                float p[16];
#pragma unroll
                for (int r = 0; r < 16; ++r) { p[r] = __builtin_amdgcn_exp2f(sa[kt][r] * LOG2E - ml); lsum += p[r]; }
#pragma unroll
                for (int s2 = 0; s2 < 2; ++s2) { u32x4 w; w.x = pk2(p[8 * s2 + 0], p[8 * s2 + 1]); w.y = pk2(p[8 * s2 + 2], p[8 * s2 + 3]); w.z = pk2(p[8 * s2 + 4], p[8 * s2 + 5]); w.w = pk2(p[8 * s2 + 6], p[8 * s2 + 7]);
                    pk[2 * st + kt][s2] = __builtin_bit_cast(bf16x8, w); }
            }
            AT_WAITBAR(4);
            sl = (sl == 2) ? 0 : sl + 1;
        }
        lsum += shx(lsum, 32, lane);
        f32x16 oacc[8];
#pragma unroll
        for (int dt = 0; dt < 8; ++dt)
#pragma unroll
            for (int r = 0; r < 16; ++r) oacc[dt][r] = 0.f;
#pragma unroll
        for (int st = 4; st < 8; ++st) {
            const bool issue = (st < 6) || more;
            if (issue) { const int s2 = (sl >= 1) ? sl - 1 : 2;
                if (st < 6) attn_dma(lb, kvb, AT_SRC(n, st + 2), lane_off, s2, AT_VPS, wave); else attn_dma(lb, kvb, AT_SRC(n + 1, st - 6), lane_off, s2, AT_KPS, wave); }
            const unsigned vb = vbase + (unsigned)(sl * AT_SLOT);
            bf16x8 vfa[2], vfb[2];
#define AT_VLD(dst, BT) do { const unsigned va_ = vb + (unsigned)((((BT) >> 3) & 1) * 16 * AT_VPS + (((BT) >> 2) & 1) * 512 + ((BT) & 3) * 128); \
                _Pragma("unroll") for (int d_ = 0; d_ < 2; ++d_) dst[d_] = cat8(vtr(va_ + 64u * d_), vtr(va_ + 64u * d_ + 8u * AT_VPS)); } while (0)
#define AT_VMM(src, BT) do { _Pragma("unroll") for (int d_ = 0; d_ < 2; ++d_) oacc[2 * ((BT) & 3) + d_] = __builtin_amdgcn_mfma_f32_32x32x16_bf16(src[d_], pk[2 * (st - 4) + (((BT) >> 3) & 1)][((BT) >> 2) & 1], oacc[2 * ((BT) & 3) + d_], 0, 0, 0); } while (0)
            AT_VLD(vfa, 0); __builtin_amdgcn_sched_barrier(0);
#pragma unroll
            for (int bq = 0; bq < 8; ++bq) {
                AT_VLD(vfb, 2 * bq + 1); __builtin_amdgcn_sched_barrier(0);
                AT_VMM(vfa, 2 * bq); __builtin_amdgcn_sched_barrier(0);
                if (bq < 7) { AT_VLD(vfa, 2 * bq + 2); __builtin_amdgcn_sched_barrier(0); }
                AT_VMM(vfb, 2 * bq + 1); __builtin_amdgcn_sched_barrier(0);
            }
#undef AT_VLD
#undef AT_VMM
            if (issue) AT_WAITBAR(4); else AT_WAITBAR(0);
            sl = (sl == 2) ? 0 : sl + 1;
        }
        const float inv = 1.0f / lsum;
        int ln2 = pg8::lane_id(); asm volatile("" : "+v"(ln2));
        GAS char* op = (GAS char*)obase + (unsigned)((wave * 32 + (ln2 & 31)) * D) + ((ln2 >> 5) ? 16 : 0);
        const float sc = inv * pg8::F8_SO;
#pragma unroll
        for (int dt = 0; dt < 8; ++dt) {
            unsigned dw[4];
#pragma unroll
            for (int g4 = 0; g4 < 4; ++g4) dw[g4] = pg8::pk4f8(oacc[dt][4 * g4 + 0] * sc, oacc[dt][4 * g4 + 1] * sc, oacc[dt][4 * g4 + 2] * sc, oacc[dt][4 * g4 + 3] * sc);
            { const auto r = __builtin_amdgcn_permlane32_swap(dw[0], dw[2], false, false); dw[0] = r[0]; dw[2] = r[1]; }
            { const auto r = __builtin_amdgcn_permlane32_swap(dw[1], dw[3], false, false); dw[1] = r[0]; dw[3] = r[1]; }
            u32x4 w; w.x = dw[0]; w.y = dw[2]; w.z = dw[1]; w.w = dw[3];
            *(GAS u32x4*)(op + 32 * dt) = w; }
    }
    asm volatile("s_waitcnt vmcnt(0)" ::: "memory");
    __syncthreads();
}
#undef AT_SRC
#undef AT_WAITBAR

constexpr int RT_WH = 0, RT_WL = 32768, RT_SEL = 65536, RT_RK = 66048, RT_CNTW = 67072, RT_WBASE = 67584;
template <int MODE>
__device__ __forceinline__ void ln_phase(LAS unsigned char* lds, const Args& a, int l, int lnidx, bool last, bf16_t* Xout, int bid, int G, int wave_s) {
    int tid_ = wave_s * 64 + pg8::lane_id(); asm volatile("" : "+v"(tid_)); const int tid = tid_, lane = tid & 63, wave = __builtin_amdgcn_readfirstlane(tid >> 6);
    constexpr int R = (MODE == 2) ? 2 : 4;
    unsigned char* ws = a.ws;
    const bf16_t* Z = (const bf16_t*)(ws + WS_R + R_Z); const bf16_t* X = (const bf16_t*)(ws + WS_X); const bf16_t* Ys = (const bf16_t*)(ws + WS_R + R_XS);
    const float* gp = a.in[20] + (size_t)(l * 3 + lnidx) * D; const float* bp = a.in[21] + (size_t)(l * 3 + lnidx) * D;
    float gg[16], bb[16];
#pragma unroll
    for (int j = 0; j < 2; ++j)
#pragma unroll
        for (int i = 0; i < 8; ++i) { gg[8 * j + i] = gp[8 * lane + 512 * j + i]; bb[8 * j + i] = bp[8 * lane + 512 * j + i]; }
    if (MODE == 1) {
        __syncthreads();
        for (int idx = tid; idx < 2048; idx += NTHR) { const int s = idx >> 6, ln = idx & 63, e = ln & 15, g = ln >> 4; float hi[8], lo[8];
#pragma unroll
            for (int j = 0; j < 8; ++j) { const float w = a.in[15][(32 * s + 8 * g + j) * 16 + e]; const float h = bflo(pk2(w, 0.f) & 0xffffu); hi[j] = h; lo[j] = w - h; }
            *(LAS u32x4*)(lds + RT_WH + idx * 16) = pack8(hi); *(LAS u32x4*)(lds + RT_WL + idx * 16) = pack8(lo); }
        __syncthreads();
    }
    for (int blk = bid; blk < 256; blk += G) {
        int run[16];
#pragma unroll
        for (int e = 0; e < 16; ++e) run[e] = 0;
        u32x4 pa_[R][2], pb_[R][2], pc_[R][2]; float pw0[R], pw1[R];
#define LN_LOAD(ROW0) do { _Pragma("unroll") for (int r = 0; r < R; ++r) { const size_t row = (ROW0) + r; \
            if (MODE == 2) { const int* ts = (const int*)(ws + WS_TSLOT) + row * 2; const float* ti = (const float*)(ws + WS_TINFO) + row * 4; const int s0 = ts[0], s1 = ts[1]; pw0[r] = ti[2]; pw1[r] = ti[3]; \
                _Pragma("unroll") for (int j = 0; j < 2; ++j) { pa_[r][j] = *(const u32x4*)(X + row * D + 8 * lane + 512 * j); pb_[r][j] = *(const u32x4*)(Ys + (size_t)s0 * D + 8 * lane + 512 * j); pc_[r][j] = *(const u32x4*)(Ys + (size_t)s1 * D + 8 * lane + 512 * j); } } \
            else { _Pragma("unroll") for (int j = 0; j < 2; ++j) pa_[r][j] = *(const u32x4*)(Z + row * D + 8 * lane + 512 * j); } } } while (0)
        LN_LOAD((size_t)blk * 256 + wave * 32);
        for (int ri = 0; ri < 32; ri += R) {
            const int rl0 = wave * 32 + ri; const size_t row0 = (size_t)blk * 256 + rl0;
            float v[R][16];
#pragma unroll
            for (int r = 0; r < R; ++r)
#pragma unroll
                for (int j = 0; j < 2; ++j) { float x[8]; unpack8(pa_[r][j], x);
                    if (MODE == 2) { float y0[8], y1[8]; unpack8(pb_[r][j], y0); unpack8(pc_[r][j], y1);
#pragma unroll
                        for (int i = 0; i < 8; ++i) v[r][8 * j + i] = ALPHA * x[i] + pw0[r] * y0[i] + pw1[r] * y1[i]; }
                    else {
#pragma unroll
                        for (int i = 0; i < 8; ++i) v[r][8 * j + i] = x[i]; } }
            if (ri + R < 32) LN_LOAD(row0 + R);
            float s[R];
#pragma unroll
            for (int r = 0; r < R; ++r) { s[r] = 0.f;
#pragma unroll
                for (int i = 0; i < 16; ++i) s[r] += v[r][i]; }
#pragma unroll
            for (int o = 1; o < 64; o <<= 1)
#pragma unroll
                for (int r = 0; r < R; ++r) s[r] += shx(s[r], o, lane);
            float qq[R];
#pragma unroll
            for (int r = 0; r < R; ++r) { const float mu = s[r] * (1.0f / D); qq[r] = 0.f;
#pragma unroll
                for (int i = 0; i < 16; ++i) { v[r][i] -= mu; qq[r] += v[r][i] * v[r][i]; } }
#pragma unroll
            for (int o = 1; o < 64; o <<= 1)
#pragma unroll
                for (int r = 0; r < R; ++r) qq[r] += shx(qq[r], o, lane);
#pragma unroll
            for (int r = 0; r < R; ++r) { const float rs = __builtin_amdgcn_rsqf(qq[r] * (1.0f / D) + LN_EPS);
#pragma unroll
                for (int i = 0; i < 16; ++i) v[r][i] = v[r][i] * rs * gg[i] + bb[i]; }
#pragma unroll
            for (int r = 0; r < R; ++r) { const size_t row = row0 + r;
                if (MODE == 2 && last) {
#pragma unroll
                    for (int j = 0; j < 2; ++j) { float* op = a.out + row * D + 8 * lane + 512 * j;
                        *(f32x4*)op = (f32x4){v[r][8 * j], v[r][8 * j + 1], v[r][8 * j + 2], v[r][8 * j + 3]}; *(f32x4*)(op + 4) = (f32x4){v[r][8 * j + 4], v[r][8 * j + 5], v[r][8 * j + 6], v[r][8 * j + 7]}; }
                } else {
#pragma unroll
                    for (int j = 0; j < 2; ++j) { float f[8];
#pragma unroll
                        for (int i = 0; i < 8; ++i) f[i] = v[r][8 * j + i];
                        *(u32x4*)(Xout + row * D + 8 * lane + 512 * j) = pack8(f);
                        if (MODE == 1) { u32x2 q8; q8.x = pg8::pk4f8(f[0] * pg8::F8_SX, f[1] * pg8::F8_SX, f[2] * pg8::F8_SX, f[3] * pg8::F8_SX); q8.y = pg8::pk4f8(f[4] * pg8::F8_SX, f[5] * pg8::F8_SX, f[6] * pg8::F8_SX, f[7] * pg8::F8_SX);
                            *(u32x2*)(ws + WS_R + R_X8 + row * D + 8 * lane + 512 * j) = q8; } }
                } }
            if (MODE == 1 && ((ri + R) & 15) == 0) {
                asm volatile("s_waitcnt vmcnt(0)" ::: "memory");
                const int tok = lane & 15, g = lane >> 4, tl = rl0 + R - 16 + tok; const size_t token = (size_t)blk * 256 + tl;
                const bf16_t* xr = Xout + token * D + 8 * g;
                f32x4 acc = (f32x4){0.f, 0.f, 0.f, 0.f};
#pragma unroll 8
                for (int ks = 0; ks < 32; ++ks) { const bf16x8 xb = *(const bf16x8*)(xr + 32 * ks);
                    const bf16x8 wh = *(const LAS bf16x8*)(lds + RT_WH + (ks * 64 + lane) * 16), wl = *(const LAS bf16x8*)(lds + RT_WL + (ks * 64 + lane) * 16);
                    acc = __builtin_amdgcn_mfma_f32_16x16x32_bf16(wh, xb, acc, 0, 0, 0); acc = __builtin_amdgcn_mfma_f32_16x16x32_bf16(wl, xb, acc, 0, 0, 0); }
                const f32x4 brv = *(const f32x4*)(a.in[16] + 4 * g);
                float lg[4] = {acc[0] + brv[0], acc[1] + brv[1], acc[2] + brv[2], acc[3] + brv[3]};
                float m = __builtin_fmaxf(__builtin_fmaxf(lg[0], lg[1]), __builtin_fmaxf(lg[2], lg[3]));
                m = __builtin_fmaxf(m, shx(m, 16, lane)); m = __builtin_fmaxf(m, shx(m, 32, lane));
                float t1 = -1.f, t2 = -1.f; int i1 = 0, i2 = 0;
#pragma unroll
                for (int r = 0; r < 4; ++r) { const float p = __expf(lg[r] - m); if (p > t1) { t2 = t1; i2 = i1; t1 = p; i1 = r; } else if (p > t2) { t2 = p; i2 = r; } }
                const float gs = t1 + t2; float bgs = gs; int bg = g;
                { const float o = shx(bgs, 16, lane); const int og = shxi(bg, 16, lane); if (o > bgs || (o == bgs && og < bg)) { bgs = o; bg = og; } }
                { const float o = shx(bgs, 32, lane); const int og = shxi(bg, 32, lane); if (o > bgs || (o == bgs && og < bg)) { bgs = o; bg = og; } }
                const bool mine = (bg == g); const int e0 = 4 * g + i1, e1 = 4 * g + i2;
                if (mine) { u32x4 info; info.x = (unsigned)e0; info.y = (unsigned)e1; info.z = __builtin_bit_cast(unsigned, t1 / gs); info.w = __builtin_bit_cast(unsigned, t2 / gs);
                    *(u32x4*)(ws + WS_TINFO + token * 16) = info; ((LAS unsigned short*)(lds + RT_SEL))[tl] = (unsigned short)(e0 | (e1 << 8)); }
                const unsigned long long below = (1ull << lane) - 1ull; int r0 = 0, r1 = 0;
#pragma unroll
                for (int e = 0; e < 16; ++e) { const bool hit = mine && (e0 == e || e1 == e); const unsigned long long mb = __ballot(hit); const int cb = __popcll(mb & below);
                    r0 = (e0 == e) ? run[e] + cb : r0; r1 = (e1 == e) ? run[e] + cb : r1; run[e] += __popcll(mb); }
                if (mine) { ((LAS unsigned short*)(lds + RT_RK))[2 * tl] = (unsigned short)r0; ((LAS unsigned short*)(lds + RT_RK))[2 * tl + 1] = (unsigned short)r1; }
            }
        }
        if (MODE == 1) {
            { int vsel = 0;
#pragma unroll
              for (int e = 0; e < 16; ++e) vsel = (lane == e) ? run[e] : vsel;
              if (lane < 16) ((LAS int*)(lds + RT_CNTW))[wave * 16 + lane] = vsel; }
            __syncthreads();
            if (tid < 16) { int base = 0;
#pragma unroll
                for (int w = 0; w < 8; ++w) { const int t = ((LAS int*)(lds + RT_CNTW))[w * 16 + tid]; ((LAS int*)(lds + RT_WBASE))[w * 16 + tid] = base; base += t; }
                ((int*)(ws + WS_WGCNT))[blk * 16 + tid] = base; }
            __syncthreads();
            { const int t = tid >> 1, k = tid & 1; const int e = (((LAS unsigned short*)(lds + RT_SEL))[t] >> (8 * k)) & 255;
              ((int*)(ws + WS_TRANK))[(size_t)blk * 512 + tid] = (int)((LAS unsigned short*)(lds + RT_RK))[tid] + ((LAS int*)(lds + RT_WBASE))[(t >> 5) * 16 + e]; }
            __syncthreads();
        }
    }
}

#undef LN_LOAD
constexpr int MG_TBL = 0, MG_TOT = 16384, MG_PRE = 16448, MG_BASE = 16512;
__device__ __forceinline__ void moe_gather_phase(LAS unsigned char* lds, unsigned char* ws, int bid, int G, int wave_s) {
    int tid_ = wave_s * 64 + pg8::lane_id(); asm volatile("" : "+v"(tid_)); const int tid = tid_, lane = tid & 63, wave = __builtin_amdgcn_readfirstlane(tid >> 6);
    LAS int* tbl = (LAS int*)(lds + MG_TBL); LAS int* tot = (LAS int*)(lds + MG_TOT); LAS int* pre = (LAS int*)(lds + MG_PRE); LAS int* base = (LAS int*)(lds + MG_BASE);
    LAS int* offs = (LAS int*)(lds + MISC_OFF) + 16; LAS int* tile_e = (LAS int*)(lds + TILEE_OFF);
    const bf16_t* X = (const bf16_t*)(ws + WS_X); bf16_t* Xs = (bf16_t*)(ws + WS_R + R_XS);
    for (int blk = bid; blk < 256; blk += G) {
        __syncthreads();
        for (int i = tid; i < 4096; i += NTHR) tbl[i] = ((const int*)(ws + WS_WGCNT))[i];
        __syncthreads();
        if (tid < 16) { int t = 0, p = 0; for (int c = 0; c < 256; ++c) { const int v = tbl[c * 16 + tid]; p += (c < blk) ? v : 0; t += v; } tot[tid] = t; pre[tid] = p; }
        __syncthreads();
        if (tid == 0) { int o = 0; for (int e = 0; e < 16; ++e) { offs[e] = o; base[e] = o + pre[e]; o += (tot[e] + 255) & ~255; } offs[16] = o; offs[17] = o >> 8; }
        __syncthreads();
        for (int rt = tid; rt < 528; rt += NTHR) { int e = 0;
#pragma unroll
            for (int q = 1; q < 16; ++q) e = (rt * 256 >= offs[q]) ? q : e;
            tile_e[rt] = e; }
        { const size_t tok = (size_t)blk * 256 + (tid >> 1); const int k = tid & 1;
          const int e = ((const int*)(ws + WS_TINFO))[tok * 4 + k]; const int rk = ((const int*)(ws + WS_TRANK))[tok * 2 + k];
          const int slot = base[e] + rk;
          ((int*)(ws + WS_TSLOT))[tok * 2 + k] = slot; ((int*)(ws + WS_SRCROW))[slot] = (int)tok; }
        for (int e = wave; e < 16; e += NWAVES) { const int npad = offs[e + 1] - offs[e] - tot[e];
            if (blk < npad && lane == 0) ((int*)(ws + WS_SRCROW))[offs[e] + tot[e] + blk] = 0; }
    }
}

#define GEMM_ALIGN true
#define GEMM_SP2 true
__global__ void __launch_bounds__(NTHR, 2) mk_fwd(Args args) {
    extern __shared__ __attribute__((aligned(16))) unsigned char lds_raw[];
    LAS unsigned char* lds = (LAS unsigned char*)lds_raw;
    const int tid = threadIdx.x; const int wave_s = __builtin_amdgcn_readfirstlane(tid >> 6);
    const int G = gridDim.x, bid = blockIdx.x;
    unsigned char* ws = args.ws;
    volatile LAS unsigned* MISC = (volatile LAS unsigned*)(lds + MISC_OFF);
    for (int u = tid; u < (LDS_BYTES - LDSCTL_OFF) / 4; u += NTHR) ((LAS unsigned*)(lds + LDSCTL_OFF))[u] = 0u;
    __syncthreads();
    XcdBarrier bar = xcd_barrier_post((unsigned*)(ws + WS_CTL) + CW_BAR, MISC + 8);
    bar.wv = wave_s;
#define GRID_BAR() xcd_barrier(bar)
#ifndef REP_MASK
#define REP_MASK 0
#endif
#define LOCAL_SYNC() do { asm volatile("s_waitcnt vmcnt(0)" ::: "memory"); __syncthreads(); } while (0)
#define PHASE(grp, ...) do { __VA_ARGS__; if (REP_MASK & (1 << (grp))) { GRID_BAR(); __VA_ARGS__; } } while (0)

#define WSQ ({ unsigned char* w_ = args.ws; asm volatile("" : "+s"(w_)); w_; })
#define X ((bf16_t*)(WSQ + WS_X))
#define P ((bf16_t*)(WSQ + WS_R + R_P))
#define Y ((bf16_t*)(WSQ + WS_R + R_Y))
#define Z ((bf16_t*)(WSQ + WS_R + R_Z))
#define Qb ((bf16_t*)(WSQ + WS_R + R_Q))
#define Ob ((bf16_t*)(WSQ + WS_R + R_O))
#define Xs ((bf16_t*)(WSQ + WS_R + R_XS))
#define Hb ((bf16_t*)(WSQ + WS_R + R_H))
#define KV ((bf16_t*)(WSQ + WS_KV))
#define wl (WSQ + WS_W + (size_t)l * W_LAYER)

    PHASE(0, p0_convert(args, lds, bid, G, wave_s));
    GRID_BAR();
    { const int tid_r = wave_s * 64 + pg8::lane_id();
      for (int i = bid * NTHR + tid_r; i < 2 * 2 * 1024; i += G * NTHR) { const int l = i >> 11, w = (i >> 10) & 1, n = i & 1023; const float* tb = (const float*)(WSQ + WS_CS) + (size_t)l * 2 * 16 * 1024 + w * 16 * 1024; float s = 0.f;
#pragma unroll
          for (int kc = 0; kc < 16; ++kc) s += tb[kc * 1024 + n];
          ((float*)(WSQ + WS_CS) + 65536)[i] = s; } }
    PHASE(1, { pg8::Gemm g{(const bf16_t*)(WSQ + WS_MEMB), (const bf16_t*)(WSQ + WS_WKV), MKV, 4096, D, wave_s}; pg8::StaticOrder S; S.init(MKV, 4096, G, bid);
      pg8::EpiPlain E{KV, 4096, 0xffff};
      pg8::gemm_phase<pg8::EpiPlain, pg8::StaticOrder, GEMM_ALIGN, GEMM_SP2>(lds, g, S, E); });

#pragma unroll 1
    for (int l = 0; l < 2; ++l) {
        PHASE(1, { pg8::Gemm g{X, (const bf16_t*)(wl + W_IN), M, NP, D, wave_s}; pg8::StaticOrder S; S.init(M, NP, G, bid);
          pg8::EpiInProj E{P, args.in[4] + l * 256};
          pg8::gemm_phase<pg8::EpiInProj, pg8::StaticOrder, GEMM_ALIGN, GEMM_SP2>(lds, g, S, E); });
        GRID_BAR();
        PHASE(3, gla_phase<false>(lds, P, (float*)(WSQ + WS_SEND), (float*)(WSQ + WS_LTOT), Y, args.in[5] + l * 512, bid, G, wave_s));
        PHASE(4, sgu_phase(lds, P, (const bf16_t*)(WSQ + WS_WM) + (size_t)l * 4 * 128 * 128, args.in[7] + l * 512, args.in[8] + l * 512, args.in[9] + l * 512, Y, bid, G, wave_s));
        GRID_BAR();
        PHASE(3, gla_phase<true>(lds, P, (float*)(WSQ + WS_SEND), (float*)(WSQ + WS_LTOT), Y, args.in[5] + l * 512, bid, G, wave_s));
        GRID_BAR();
        PHASE(10, { pg8::Gemm g{Y, (const bf16_t*)(wl + W_OUT), M, D, D, wave_s}; pg8::PanelOrder S{4, M / 256, G, bid};
          pg8::EpiResidStats E{X, Z, (pg8::f32x2_t*)(WSQ + WS_PART)};
          pg8::gemm_phase<pg8::EpiResidStats, pg8::PanelOrder, GEMM_ALIGN, GEMM_SP2>(lds, g, S, E); });
        { const int tid_r = wave_s * 64 + pg8::lane_id();
          for (int pan = bid; pan < 256; pan += G) if (tid_r < 256) { const size_t row = (size_t)pan * 256 + tid_r; const pg8::f32x2_t* pp = (const pg8::f32x2_t*)(WSQ + WS_PART) + row * 16; float s1 = 0.f, s2 = 0.f;
#pragma unroll
              for (int q = 0; q < 16; ++q) { const pg8::f32x2_t v = pp[q]; s1 += v[0]; s2 += v[1]; }
              const float mu = s1 * (1.0f / D), var = s2 * (1.0f / D) - mu * mu; ((pg8::f32x2_t*)(WSQ + WS_STATS))[row] = (pg8::f32x2_t){mu, __builtin_amdgcn_rsqf(var + LN_EPS)}; } }
        LOCAL_SYNC();
        PHASE(10, { pg8::Gemm g{Z, (const bf16_t*)(wl + W_Q), M, D, D, wave_s}; pg8::PanelOrder S{4, M / 256, G, bid};
          pg8::EpiQFragLN E{Qb, (const pg8::f32x2_t*)(WSQ + WS_STATS), (const float*)(WSQ + WS_CS) + 65536 + l * 2048, (const float*)(WSQ + WS_CS) + 65536 + l * 2048 + 1024};
          pg8::gemm_phase<pg8::EpiQFragLN, pg8::PanelOrder, GEMM_ALIGN, GEMM_SP2>(lds, g, S, E); });
        PHASE(5, attn_phase(lds, Qb, KV, Ob, l, bid, G, wave_s));
        LOCAL_SYNC();
        PHASE(10, { pg8::Gemm g{Ob, (const bf16_t*)(wl + W_O), M, D, D / 2, wave_s}; pg8::PanelOrder S{4, M / 256, G, bid};
          pg8::EpiResidLN8 E{Z, (const pg8::f32x2_t*)(WSQ + WS_STATS), args.in[20] + (size_t)(l * 3) * D, args.in[21] + (size_t)(l * 3) * D};
          pg8::gemm_phase<pg8::EpiResidLN8, pg8::PanelOrder, GEMM_ALIGN, GEMM_SP2>(lds, g, S, E); });
        PHASE(9, ln_phase<1>(lds, args, l, 1, false, X, bid, G, wave_s));
        GRID_BAR();
        PHASE(7, moe_gather_phase(lds, WSQ, bid, G, wave_s));
        GRID_BAR();
        PHASE(2, { pg8::Gemm g{(const bf16_t*)(WSQ + WS_R + R_X8), (const bf16_t*)(wl + W_GU), MOE_ROWS, 16384, D / 2, wave_s}; pg8::MoeGatherOrder S{(const LAS int*)(lds + TILEE_OFF), (int)MISC[33] * 4, G, bid, (const int*)(WSQ + WS_SRCROW)};
          pg8::EpiGU8 E{(unsigned char*)Hb};
          pg8::gemm_phase<pg8::EpiGU8, pg8::MoeGatherOrder, GEMM_ALIGN, GEMM_SP2>(lds, g, S, E); });
        GRID_BAR();
        PHASE(2, { pg8::Gemm g{Hb, (const bf16_t*)(wl + W_D), MOE_ROWS, 16384, 256, wave_s}; pg8::MoeOrder S{(const LAS int*)(lds + TILEE_OFF), (int)MISC[33] * 4, G, bid};
          pg8::EpiPlain8 E{Xs, D, 3};
          pg8::gemm_phase<pg8::EpiPlain8, pg8::MoeOrder, GEMM_ALIGN, GEMM_SP2>(lds, g, S, E); });
        GRID_BAR();
        if (REP_MASK & (1 << 8)) { ln_phase<2>(lds, args, l, 2, l == 1, Z, bid, G, wave_s); GRID_BAR(); }
        ln_phase<2>(lds, args, l, 2, l == 1, X, bid, G, wave_s);
        if (l == 0) GRID_BAR();
    }
}
#undef X
#undef P
#undef Y
#undef Z
#undef Qb
#undef Ob
#undef Xs
#undef Hb
#undef KV
#undef wl
}

extern "C" void kernel_launch(void* const* d_in, const int* in_sizes, int n_in, void* d_out, int out_size, void* d_ws, size_t ws_size, hipStream_t stream) {
    using namespace mk;
    static int grid = 0;
    if (grid == 0) {
        if (n_in != 22 || in_sizes[0] != M * D || out_size != M * D || ws_size < WS_END) { fprintf(stderr, "kernel_launch: unexpected shapes (n_in %d, in0 %d, out %d, ws %zu, need %zu)\n", n_in, n_in > 0 ? in_sizes[0] : -1, out_size, ws_size, (size_t)WS_END); grid = -1; return; }
        int dev = 0, cus = 0;
        if (hipGetDevice(&dev) != hipSuccess || hipDeviceGetAttribute(&cus, hipDeviceAttributeMultiprocessorCount, dev) != hipSuccess) { grid = -1; return; }
        if (hipFuncSetAttribute((const void*)mk_fwd, hipFuncAttributeMaxDynamicSharedMemorySize, LDS_BYTES) != hipSuccess) { fprintf(stderr, "kernel_launch: hipFuncSetAttribute failed\n"); grid = -1; return; }
        int per_cu = 0;
        if (hipOccupancyMaxActiveBlocksPerMultiprocessor(&per_cu, (const void*)mk_fwd, NTHR, LDS_BYTES) != hipSuccess || per_cu < 1) fprintf(stderr, "kernel_launch: occupancy query says %d\n", per_cu);
        (void)hipGetLastError();
        grid = cus;
    }
    if (grid < 0) return;
    if (hipMemsetAsync((char*)d_ws + WS_CTL, 0, CTL_ZERO_BYTES, stream) != hipSuccess) return;
    Args a{};
    for (int i = 0; i < 22; ++i) a.in[i] = (const float*)d_in[i];
    a.out = (float*)d_out; a.ws = (unsigned char*)d_ws;
    hipLaunchKernelGGL(mk_fwd, dim3(grid), dim3(NTHR), LDS_BYTES, stream, a);
}
```

```cpp
#include <hip/hip_runtime.h>
#include <cstdio>
#include <cstdint>

namespace pg8 {
#define PG8_LAS __attribute__((address_space(3)))
typedef unsigned short bf16_t;
typedef short bf16x8 __attribute__((ext_vector_type(8)));
typedef float f32x4 __attribute__((ext_vector_type(4)));
typedef unsigned u32x4 __attribute__((ext_vector_type(4)));
typedef unsigned u32x2 __attribute__((ext_vector_type(2)));
constexpr int BM = 256, BK = 64, HALF = 128, HTB = HALF * BK * 2  , STAGE_BYTES = 8 * HTB, NXCD = 8, WGM = 8;

__host__ __device__ __forceinline__ int lds_byte(int r, int c) { const int st = (r >> 4) * 2 + (c >> 5), rr = r & 15, cc = c & 31, ob = rr * 64 + cc * 2; return st * 1024 + (ob ^ (((ob >> 9) & 1) << 5)); }
__host__ __device__ __forceinline__ void stage_rc(int b, int& R, int& C) { const int st = b / 1024, sb = b % 1024, swz = sb ^ (((sb >> 9) & 1) << 5); R = (st >> 1) * 16 + swz / 64; C = (st & 1) * 32 + (swz % 64) / 2; }
__host__ __device__ __forceinline__ int perm32(int rho) { const int n = rho >> 4, i = rho & 15; return 8 * (i >> 2) + 4 * n + (i & 3); }

struct Unit { int pm, pn; };
struct Gemm { const bf16_t* A; const bf16_t* Bt; int M, N, K; int wv; };
__device__ __forceinline__ int lane_id() { int l; asm volatile("v_mbcnt_lo_u32_b32 %0, -1, 0\n\tv_mbcnt_hi_u32_b32 %0, -1, %0" : "=v"(l)); return l; }

struct StaticOrder {
    static constexpr bool GATHER = false;
    int nM, nN, nwg, G, c; const int* src = nullptr;
    __host__ __device__ void init(int M, int N, int G_, int c_) { nM = M / BM; nN = N / BM; nwg = nM * nN; G = G_; c = c_; }
    __host__ __device__ bool next(int i, Unit& u) const {
        const long L = (long)i * G + c; if (L >= nwg) return false;
        int wgid = (int)L; { const int q = nwg / NXCD, r = nwg % NXCD, xcd = wgid % NXCD, off = wgid / NXCD; wgid = (xcd < r ? xcd * (q + 1) : r * (q + 1) + (xcd - r) * q) + off; }
        const int nig = WGM * nN, gid = wgid / nig, fm = gid * WGM, gsz = (nM - fm) < WGM ? (nM - fm) : WGM;
        u.pm = fm + ((wgid % nig) % gsz); u.pn = (wgid % nig) / gsz; return true;
    }
    __device__ __forceinline__ void a_ready(const Unit&) const {}
    __device__ __forceinline__ void done(const Unit&) const {}
};
struct PanelOrder {
    static constexpr bool GATHER = false;
    int nN, npan, G, c; const int* src = nullptr;
    __device__ __forceinline__ bool next(int i, Unit& u) const { const int p = c + (i / nN) * G; if (p >= npan) return false; u.pm = p; u.pn = i % nN; return true; }
    __device__ __forceinline__ void a_ready(const Unit&) const {}
    __device__ __forceinline__ void done(const Unit&) const {}
};
template <bool GATH_> struct MoeOrderT {
    static constexpr bool GATHER = GATH_;
    const PG8_LAS int* tile_e; int nunits, G, c; const int* src = nullptr;
    __device__ __forceinline__ bool next(int i, Unit& u) const {
        const int cc = ((G & 7) == 0) ? (c & 7) * (G >> 3) + (c >> 3) : c;
        const int L = i * G + cc; if (L >= nunits) return false;
        u.pm = L >> 2; u.pn = tile_e[L >> 2] * 4 + (L & 3); return true;
    }
    __device__ __forceinline__ void a_ready(const Unit&) const {}
    __device__ __forceinline__ void done(const Unit&) const {}
};
typedef MoeOrderT<false> MoeOrder; typedef MoeOrderT<true> MoeGatherOrder;

typedef float f32x2_t __attribute__((ext_vector_type(2))); typedef __bf16 bf16x2_t __attribute__((ext_vector_type(2)));
typedef __amdgpu_buffer_rsrc_t rsrc_t;
__device__ __forceinline__ rsrc_t mk_rsrc(const void* p) { return __builtin_amdgcn_make_buffer_rsrc((void*)p, 0, 0x7fffffff, 0x00020000); }
__device__ __forceinline__ u32x4 bld4(rsrc_t r, unsigned voff, unsigned soff) { return __builtin_bit_cast(u32x4, __builtin_amdgcn_raw_buffer_load_b128(r, voff, soff, 0)); }
__device__ __forceinline__ f32x2_t bld2f(rsrc_t r, unsigned voff, unsigned soff) { return __builtin_bit_cast(f32x2_t, __builtin_amdgcn_raw_buffer_load_b64(r, voff, soff, 0)); }
#define GST4(p) (*(__attribute__((address_space(1))) u32x4*)(p))
__device__ __forceinline__ float f8clamp(float x) { return __builtin_fminf(__builtin_fmaxf(x, -448.0f), 448.0f); }
__device__ __forceinline__ unsigned pk4f8(float a, float b, float c, float d) { int w = 0; w = __builtin_amdgcn_cvt_pk_fp8_f32(f8clamp(a), f8clamp(b), w, false); w = __builtin_amdgcn_cvt_pk_fp8_f32(f8clamp(c), f8clamp(d), w, true); return (unsigned)w; }
constexpr float F8_SX = 4.0f, F8_SW = 64.0f, F8_SH = 8.0f, F8_SO = 64.0f;
__device__ __forceinline__ unsigned pk2(float lo, float hi) { f32x2_t v = {lo, hi}; bf16x2_t b = __builtin_convertvector(v, bf16x2_t); return __builtin_bit_cast(unsigned, b); }
__device__ __forceinline__ float bflo(unsigned w) { return __builtin_bit_cast(float, w << 16); }
__device__ __forceinline__ float bfhi(unsigned w) { return __builtin_bit_cast(float, w & 0xffff0000u); }
__device__ __forceinline__ float f_silu(float x) { return x * __builtin_amdgcn_rcpf(1.0f + __builtin_amdgcn_exp2f(-1.4426950408889634f * x)); }
__device__ __forceinline__ float f_gelu_tanh(float x) { return x * __builtin_amdgcn_rcpf(1.0f + __builtin_amdgcn_exp2f(x * (-2.3022082f - 0.10294324f * x * x))); }
__device__ __forceinline__ float f_logsig16(float z) { const float t = __builtin_amdgcn_exp2f(-1.4426950408889634f * __builtin_fabsf(z)); return (__builtin_fminf(z, 0.0f) - 0.6931471805599453f * __builtin_amdgcn_logf(1.0f + t)) * 0.0625f; }

struct EpiPlain {
    static constexpr bool PERM = true, AFTER_DRAIN = false;
    bf16_t* O; int ldc; int cmask;
    __device__ __forceinline__ void operator()(const f32x4 (&acc)[2][2][4][2], const Unit& u, int wr, int wc, int fr, int fq) const {
        const int row0 = u.pm * BM + wr * 64 + fr, col0 = (u.pn & cmask) * BM + wc * 32 + 8 * fq;
#pragma unroll
        for (int ai = 0; ai < 2; ++ai)
#pragma unroll
            for (int m = 0; m < 4; ++m) { bf16_t* rowp = O + (size_t)(row0 + ai * HALF + m * 16) * ldc + col0;
#pragma unroll
                for (int bj = 0; bj < 2; ++bj) { const f32x4 v0 = acc[ai][bj][m][0], v1 = acc[ai][bj][m][1];
                    u32x4 w; w.x = pk2(v0[0], v0[1]); w.y = pk2(v0[2], v0[3]); w.z = pk2(v1[0], v1[1]); w.w = pk2(v1[2], v1[3]);
                    *(u32x4*)(rowp + bj * HALF) = w; } }
    }
};
struct EpiQFrag {
    static constexpr bool PERM = true, AFTER_DRAIN = false;
    bf16_t* O;
    __device__ __forceinline__ void operator()(const f32x4 (&acc)[2][2][4][2], const Unit& u, int wr, int wc, int fr, int fq) const {
        unsigned lo = (unsigned)(((fq >> 1) * 64 + fr + 32 * (fq & 1)) * 16); asm volatile("" : "+v"(lo));
        char* tile = (char*)(O + (size_t)(u.pm * 4 + u.pn) * 65536) + (size_t)(wr * 2 * 16 + wc * 2) * 1024 + lo;
#pragma unroll
        for (int ai = 0; ai < 2; ++ai)
#pragma unroll
            for (int m = 0; m < 4; ++m)
#pragma unroll
                for (int bj = 0; bj < 2; ++bj) { const f32x4 v0 = acc[ai][bj][m][0], v1 = acc[ai][bj][m][1];
                    u32x4 w; w.x = pk2(v0[0], v0[1]); w.y = pk2(v0[2], v0[3]); w.z = pk2(v1[0], v1[1]); w.w = pk2(v1[2], v1[3]);
                    *(u32x4*)(tile + ((4 * ai + (m >> 1)) * 16 + 8 * bj) * 1024 + (m & 1) * 256) = w; }
    }
};
struct EpiInProj {
    static constexpr bool PERM = true, AFTER_DRAIN = false;
    bf16_t* O; const float* b_a;
    template <int MODE> __device__ __forceinline__ void tile(const f32x4 (&acc)[2][2][4][2], const Unit& u, int wr, int wc, int fr, int fq) const {
        const int row0 = u.pm * BM + wr * 64 + fr, col0 = u.pn * BM + wc * 32 + 8 * fq;
        f32x4 bv[2][2];
#pragma unroll
        for (int bj = 0; bj < 2; ++bj)
#pragma unroll
            for (int n = 0; n < 2; ++n) bv[bj][n] = (MODE == 2) ? *(const f32x4*)(b_a + (col0 - 1536) + bj * HALF + 4 * n) : (f32x4){0.f, 0.f, 0.f, 0.f};
#pragma unroll
        for (int ai = 0; ai < 2; ++ai)
#pragma unroll
            for (int m = 0; m < 4; ++m) { bf16_t* rowp = O + (size_t)(row0 + ai * HALF + m * 16) * 2816 + col0;
#pragma unroll
                for (int bj = 0; bj < 2; ++bj) { f32x4 v0 = acc[ai][bj][m][0], v1 = acc[ai][bj][m][1];
#pragma unroll
                    for (int j = 0; j < 4; ++j) {
                        if (MODE == 1) { v0[j] = f_silu(v0[j]); v1[j] = f_silu(v1[j]); }
                        if (MODE == 2) { v0[j] = f_logsig16(v0[j] + bv[bj][0][j]); v1[j] = f_logsig16(v1[j] + bv[bj][1][j]); }
                        if (MODE == 3) { v0[j] = f_gelu_tanh(v0[j]); v1[j] = f_gelu_tanh(v1[j]); } }
                    u32x4 w; w.x = pk2(v0[0], v0[1]); w.y = pk2(v0[2], v0[3]); w.z = pk2(v1[0], v1[1]); w.w = pk2(v1[2], v1[3]);
                    *(u32x4*)(rowp + bj * HALF) = w; } }
    }
    __device__ __forceinline__ void operator()(const f32x4 (&acc)[2][2][4][2], const Unit& u, int wr, int wc, int fr, int fq) const {
        const int pn = u.pn;
        if (pn < 4) tile<0>(acc, u, wr, wc, fr, fq); else if (pn < 6) tile<1>(acc, u, wr, wc, fr, fq); else if (pn == 6) tile<2>(acc, u, wr, wc, fr, fq); else tile<3>(acc, u, wr, wc, fr, fq);
    }
};
struct EpiInProj8 {
    static constexpr bool PERM = true, AFTER_DRAIN = false, F8 = true; static constexpr float dq = 1.0f / (F8_SX * F8_SW);
    bf16_t* O; const float* b_a;
    template <int MODE> __device__ __forceinline__ void tile(const f32x4 (&acc)[2][2][4][2], const Unit& u, int wr, int wc, int fr, int fq) const {
        const int row0 = u.pm * BM + wr * 64 + fr, col0 = u.pn * BM + wc * 32 + 8 * fq;
        f32x4 bv[2][2];
#pragma unroll
        for (int bj = 0; bj < 2; ++bj)
#pragma unroll
            for (int n = 0; n < 2; ++n) bv[bj][n] = (MODE == 2) ? *(const f32x4*)(b_a + (col0 - 1536) + bj * HALF + 4 * n) : (f32x4){0.f, 0.f, 0.f, 0.f};
#pragma unroll
        for (int ai = 0; ai < 2; ++ai)
#pragma unroll
            for (int m = 0; m < 4; ++m) { bf16_t* rowp = O + (size_t)(row0 + ai * HALF + m * 16) * 2816 + col0;
#pragma unroll
                for (int bj = 0; bj < 2; ++bj) { f32x4 v0 = acc[ai][bj][m][0] * dq, v1 = acc[ai][bj][m][1] * dq;
#pragma unroll
                    for (int j = 0; j < 4; ++j) {
                        if (MODE == 1) { v0[j] = f_silu(v0[j]); v1[j] = f_silu(v1[j]); }
                        if (MODE == 2) { v0[j] = f_logsig16(v0[j] + bv[bj][0][j]); v1[j] = f_logsig16(v1[j] + bv[bj][1][j]); }
                        if (MODE == 3) { v0[j] = f_gelu_tanh(v0[j]); v1[j] = f_gelu_tanh(v1[j]); } }
                    u32x4 w; w.x = pk2(v0[0], v0[1]); w.y = pk2(v0[2], v0[3]); w.z = pk2(v1[0], v1[1]); w.w = pk2(v1[2], v1[3]);
                    *(u32x4*)(rowp + bj * HALF) = w; } }
    }
    __device__ __forceinline__ void operator()(const f32x4 (&acc)[2][2][4][2], const Unit& u, int wr, int wc, int fr, int fq) const {
        const int pn = u.pn;
        if (pn < 4) tile<0>(acc, u, wr, wc, fr, fq); else if (pn < 6) tile<1>(acc, u, wr, wc, fr, fq); else if (pn == 6) tile<2>(acc, u, wr, wc, fr, fq); else tile<3>(acc, u, wr, wc, fr, fq);
    }
};
struct EpiResid {
    static constexpr bool PERM = true, AFTER_DRAIN = false;
    const bf16_t* X; bf16_t* Z; float alpha;
    __device__ __forceinline__ void operator()(const f32x4 (&acc)[2][2][4][2], const Unit& u, int wr, int wc, int fr, int fq) const {
        const int row0 = u.pm * BM + wr * 64 + fr, col0 = u.pn * BM + wc * 32 + 8 * fq;
#pragma unroll
        for (int ai = 0; ai < 2; ++ai)
#pragma unroll
            for (int m = 0; m < 4; ++m) { const size_t off = (size_t)(row0 + ai * HALF + m * 16) * 1024 + col0;
#pragma unroll
                for (int bj = 0; bj < 2; ++bj) { const f32x4 v0 = acc[ai][bj][m][0], v1 = acc[ai][bj][m][1];
                    const u32x4 xr = *(const u32x4*)(X + off + bj * HALF);
                    u32x4 w; w.x = pk2(alpha * bflo(xr.x) + v0[0], alpha * bfhi(xr.x) + v0[1]); w.y = pk2(alpha * bflo(xr.y) + v0[2], alpha * bfhi(xr.y) + v0[3]);
                    w.z = pk2(alpha * bflo(xr.z) + v1[0], alpha * bfhi(xr.z) + v1[1]); w.w = pk2(alpha * bflo(xr.w) + v1[2], alpha * bfhi(xr.w) + v1[3]);
                    *(u32x4*)(Z + off + bj * HALF) = w; } }
    }
};
struct EpiResidStats {
    static constexpr bool PERM = true, AFTER_DRAIN = false;
    const bf16_t* X; bf16_t* Z; f32x2_t* part; static constexpr float alpha = 1.4142135623730951f;
    __device__ __forceinline__ void operator()(const f32x4 (&acc)[2][2][4][2], const Unit& u, int wr, int wc, int fr, int fq) const {
        const int row0 = u.pm * BM + wr * 64 + fr, col0 = u.pn * BM + wc * 32 + 8 * fq;
        int ln = 16 * fq + fr; asm volatile("" : "+v"(ln));
        float s1[8], s2[8];
        const rsrc_t rx = mk_rsrc(X); const unsigned voff = ((unsigned)row0 * 1024u + (unsigned)col0) * 2u;
        u32x4 xres[2][4][2];
#pragma unroll
        for (int ai = 0; ai < 2; ++ai)
#pragma unroll
            for (int m = 0; m < 4; ++m)
#pragma unroll
                for (int bj = 0; bj < 2; ++bj) xres[ai][m][bj] = bld4(rx, voff, (unsigned)(((ai * HALF + m * 16) * 1024 + bj * HALF) * 2));
        __builtin_amdgcn_sched_barrier(0);
#pragma unroll
        for (int ai = 0; ai < 2; ++ai)
#pragma unroll
            for (int m = 0; m < 4; ++m) { const size_t off = (size_t)(row0 + ai * HALF + m * 16) * 1024 + col0; float a1 = 0.f, a2 = 0.f;
#pragma unroll
                for (int bj = 0; bj < 2; ++bj) { const f32x4 v0 = acc[ai][bj][m][0], v1 = acc[ai][bj][m][1];
                    const u32x4 xr = xres[ai][m][bj];
                    u32x4 w; w.x = pk2(alpha * bflo(xr.x) + v0[0], alpha * bfhi(xr.x) + v0[1]); w.y = pk2(alpha * bflo(xr.y) + v0[2], alpha * bfhi(xr.y) + v0[3]);
                    w.z = pk2(alpha * bflo(xr.z) + v1[0], alpha * bfhi(xr.z) + v1[1]); w.w = pk2(alpha * bflo(xr.w) + v1[2], alpha * bfhi(xr.w) + v1[3]);
                    GST4(Z + off + bj * HALF) = w;
                    const float z0 = bflo(w.x), z1 = bfhi(w.x), z2 = bflo(w.y), z3 = bfhi(w.y), z4 = bflo(w.z), z5 = bfhi(w.z), z6 = bflo(w.w), z7 = bfhi(w.w);
                    a1 += ((z0 + z1) + (z2 + z3)) + ((z4 + z5) + (z6 + z7)); a2 += ((z0 * z0 + z1 * z1) + (z2 * z2 + z3 * z3)) + ((z4 * z4 + z5 * z5) + (z6 * z6 + z7 * z7)); }
                s1[ai * 4 + m] = a1; s2[ai * 4 + m] = a2; }
        const bool h5 = (ln & 32) != 0, h4 = (ln & 16) != 0;
        float t1[4], t2[4];
#pragma unroll
        for (int i = 0; i < 4; ++i) { const float m1 = h5 ? s1[4 + i] : s1[i], g1 = h5 ? s1[i] : s1[4 + i], m2 = h5 ? s2[4 + i] : s2[i], g2 = h5 ? s2[i] : s2[4 + i];
            t1[i] = m1 + __builtin_bit_cast(float, __builtin_amdgcn_ds_bpermute((ln ^ 32) << 2, __builtin_bit_cast(int, g1)));
            t2[i] = m2 + __builtin_bit_cast(float, __builtin_amdgcn_ds_bpermute((ln ^ 32) << 2, __builtin_bit_cast(int, g2))); }
        float r1[2], r2[2];
#pragma unroll
        for (int i = 0; i < 2; ++i) { const float m1 = h4 ? t1[2 + i] : t1[i], g1 = h4 ? t1[i] : t1[2 + i], m2 = h4 ? t2[2 + i] : t2[i], g2 = h4 ? t2[i] : t2[2 + i];
            r1[i] = m1 + __builtin_bit_cast(float, __builtin_amdgcn_ds_bpermute((ln ^ 16) << 2, __builtin_bit_cast(int, g1)));
            r2[i] = m2 + __builtin_bit_cast(float, __builtin_amdgcn_ds_bpermute((ln ^ 16) << 2, __builtin_bit_cast(int, g2))); }
#pragma unroll
        for (int i = 0; i < 2; ++i) { const int gi = (h5 ? 4 : 0) + (h4 ? 2 : 0) + i, row = row0 + (gi >> 2) * HALF + (gi & 3) * 16;
            part[(size_t)row * 16 + u.pn * 4 + wc] = (f32x2_t){r1[i], r2[i]}; }
    }
};
struct EpiQFragLN {
    static constexpr bool PERM = true, AFTER_DRAIN = false;
    bf16_t* O; const f32x2_t* stats; const float* csum; const float* bq;
    __device__ __forceinline__ void operator()(const f32x4 (&acc)[2][2][4][2], const Unit& u, int wr, int wc, int fr, int fq) const {
        unsigned lo = (unsigned)(((fq >> 1) * 64 + fr + 32 * (fq & 1)) * 16); asm volatile("" : "+v"(lo));
        char* tile = (char*)(O + (size_t)(u.pm * 4 + u.pn) * 65536) + (size_t)(wr * 2 * 16 + wc * 2) * 1024 + lo;
        const int row0 = u.pm * BM + wr * 64 + fr, col0 = u.pn * BM + wc * 32 + 8 * fq;
#pragma unroll
        for (int bj = 0; bj < 2; ++bj) { const f32x4 c0 = *(const f32x4*)(csum + col0 + bj * HALF), c1 = *(const f32x4*)(csum + col0 + bj * HALF + 4), b0 = *(const f32x4*)(bq + col0 + bj * HALF), b1 = *(const f32x4*)(bq + col0 + bj * HALF + 4);
#pragma unroll
            for (int ai = 0; ai < 2; ++ai)
#pragma unroll
                for (int m = 0; m < 4; ++m) { const f32x2_t st = stats[row0 + ai * HALF + m * 16]; const float mu = st[0], rs = st[1];
                    const f32x4 v0 = (acc[ai][bj][m][0] - mu * c0) * rs + b0, v1 = (acc[ai][bj][m][1] - mu * c1) * rs + b1;
                    u32x4 w; w.x = pk2(v0[0], v0[1]); w.y = pk2(v0[2], v0[3]); w.z = pk2(v1[0], v1[1]); w.w = pk2(v1[2], v1[3]);
                    *(u32x4*)(tile + ((4 * ai + (m >> 1)) * 16 + 8 * bj) * 1024 + (m & 1) * 256) = w; } }
    }
};
struct EpiResidLN {
    static constexpr bool PERM = true, AFTER_DRAIN = false;
    bf16_t* Z; const f32x2_t* stats; const float* gain; const float* bias; static constexpr float alpha = 1.4142135623730951f;
    __device__ __forceinline__ void operator()(const f32x4 (&acc)[2][2][4][2], const Unit& u, int wr, int wc, int fr, int fq) const {
        const int row0 = u.pm * BM + wr * 64 + fr, col0 = u.pn * BM + wc * 32 + 8 * fq;
        const rsrc_t rz = mk_rsrc(Z), rs = mk_rsrc(stats); const unsigned voff = ((unsigned)row0 * 1024u + (unsigned)col0) * 2u;
        f32x2_t st[2][4];
#pragma unroll
        for (int ai = 0; ai < 2; ++ai)
#pragma unroll
            for (int m = 0; m < 4; ++m) st[ai][m] = bld2f(rs, (unsigned)row0 * 8u, (unsigned)((ai * HALF + m * 16) * 8));
#pragma unroll
        for (int bj = 0; bj < 2; ++bj) {
            u32x4 zres[2][4];
#pragma unroll
            for (int ai = 0; ai < 2; ++ai)
#pragma unroll
                for (int m = 0; m < 4; ++m) zres[ai][m] = bld4(rz, voff, (unsigned)(((ai * HALF + m * 16) * 1024 + bj * HALF) * 2));
            const f32x4 g0 = *(const f32x4*)(gain + col0 + bj * HALF) * alpha, g1 = *(const f32x4*)(gain + col0 + bj * HALF + 4) * alpha, b0 = *(const f32x4*)(bias + col0 + bj * HALF) * alpha, b1 = *(const f32x4*)(bias + col0 + bj * HALF + 4) * alpha;
            __builtin_amdgcn_sched_barrier(0);
#pragma unroll
            for (int ai = 0; ai < 2; ++ai)
#pragma unroll
                for (int m = 0; m < 4; ++m) { const int row = row0 + ai * HALF + m * 16; const float mu = st[ai][m][0], rsd = st[ai][m][1];
                    const u32x4 zr = zres[ai][m];
                    const f32x4 z0 = (f32x4){bflo(zr.x), bfhi(zr.x), bflo(zr.y), bfhi(zr.y)}, z1 = (f32x4){bflo(zr.z), bfhi(zr.z), bflo(zr.w), bfhi(zr.w)};
                    const f32x4 v0 = (z0 - mu) * rsd * g0 + b0 + acc[ai][bj][m][0], v1 = (z1 - mu) * rsd * g1 + b1 + acc[ai][bj][m][1];
                    u32x4 w; w.x = pk2(v0[0], v0[1]); w.y = pk2(v0[2], v0[3]); w.z = pk2(v1[0], v1[1]); w.w = pk2(v1[2], v1[3]);
                    GST4(Z + (size_t)row * 1024 + col0 + bj * HALF) = w; } }
    }
};
struct EpiResidLN8 {
    static constexpr bool PERM = true, AFTER_DRAIN = false, F8 = true; static constexpr float dq = 1.0f / (F8_SO * F8_SW);
    bf16_t* Z; const f32x2_t* stats; const float* gain; const float* bias; static constexpr float alpha = 1.4142135623730951f;
    __device__ __forceinline__ void operator()(const f32x4 (&acc)[2][2][4][2], const Unit& u, int wr, int wc, int fr, int fq) const {
        const int row0 = u.pm * BM + wr * 64 + fr, col0 = u.pn * BM + wc * 32 + 8 * fq;
        const rsrc_t rz = mk_rsrc(Z), rs = mk_rsrc(stats); const unsigned voff = ((unsigned)row0 * 1024u + (unsigned)col0) * 2u;
        f32x2_t st[2][4];
#pragma unroll
        for (int ai = 0; ai < 2; ++ai)
#pragma unroll
            for (int m = 0; m < 4; ++m) st[ai][m] = bld2f(rs, (unsigned)row0 * 8u, (unsigned)((ai * HALF + m * 16) * 8));
#pragma unroll
        for (int bj = 0; bj < 2; ++bj) {
            u32x4 zres[2][4];
#pragma unroll
            for (int ai = 0; ai < 2; ++ai)
#pragma unroll
                for (int m = 0; m < 4; ++m) zres[ai][m] = bld4(rz, voff, (unsigned)(((ai * HALF + m * 16) * 1024 + bj * HALF) * 2));
            const f32x4 g0 = *(const f32x4*)(gain + col0 + bj * HALF) * alpha, g1 = *(const f32x4*)(gain + col0 + bj * HALF + 4) * alpha, b0 = *(const f32x4*)(bias + col0 + bj * HALF) * alpha, b1 = *(const f32x4*)(bias + col0 + bj * HALF + 4) * alpha;
            __builtin_amdgcn_sched_barrier(0);
#pragma unroll
            for (int ai = 0; ai < 2; ++ai)
#pragma unroll
                for (int m = 0; m < 4; ++m) { const int row = row0 + ai * HALF + m * 16; const float mu = st[ai][m][0], rsd = st[ai][m][1];
                    const u32x4 zr = zres[ai][m];
                    const f32x4 z0 = (f32x4){bflo(zr.x), bfhi(zr.x), bflo(zr.y), bfhi(zr.y)}, z1 = (f32x4){bflo(zr.z), bfhi(zr.z), bflo(zr.w), bfhi(zr.w)};
                    const f32x4 v0 = (z0 - mu) * rsd * g0 + b0 + acc[ai][bj][m][0] * dq, v1 = (z1 - mu) * rsd * g1 + b1 + acc[ai][bj][m][1] * dq;
                    u32x4 w; w.x = pk2(v0[0], v0[1]); w.y = pk2(v0[2], v0[3]); w.z = pk2(v1[0], v1[1]); w.w = pk2(v1[2], v1[3]);
                    GST4(Z + (size_t)row * 1024 + col0 + bj * HALF) = w; } }
    }
};
struct EpiGU {
    static constexpr bool PERM = true, AFTER_DRAIN = false;
    bf16_t* H;
    __device__ __forceinline__ void operator()(const f32x4 (&acc)[2][2][4][2], const Unit& u, int wr, int wc, int fr, int fq) const {
        const int row0 = u.pm * BM + wr * 64 + fr, col0 = (u.pn & 3) * 128 + wc * 16 + 4 * fq;
#pragma unroll
        for (int ai = 0; ai < 2; ++ai)
#pragma unroll
            for (int m = 0; m < 4; ++m) { bf16_t* rowp = H + (size_t)(row0 + ai * HALF + m * 16) * 512 + col0;
#pragma unroll
                for (int bj = 0; bj < 2; ++bj) { const f32x4 g = acc[ai][bj][m][0], up = acc[ai][bj][m][1];
                    u32x2 w; w.x = pk2(f_silu(g[0]) * up[0], f_silu(g[1]) * up[1]); w.y = pk2(f_silu(g[2]) * up[2], f_silu(g[3]) * up[3]);
                    *(u32x2*)(rowp + bj * 64) = w; } }
    }
};
struct EpiGU8 {
    static constexpr bool PERM = true, AFTER_DRAIN = false, F8 = true;
    unsigned char* H;
    __device__ __forceinline__ void operator()(const f32x4 (&acc)[2][2][4][2], const Unit& u, int wr, int wc, int fr, int fq) const {
        const int row0 = u.pm * BM + wr * 64 + fr, col0 = (u.pn & 3) * 128 + wc * 32 + 8 * fq;
        constexpr float dq = 1.0f / (F8_SX * F8_SW);
#pragma unroll
        for (int ai = 0; ai < 2; ++ai)
#pragma unroll
            for (int m = 0; m < 4; ++m) { float h[8];
#pragma unroll
                for (int n = 0; n < 2; ++n) { const f32x4 g = acc[ai][0][m][n] * dq, up = acc[ai][1][m][n] * (dq * F8_SH);
#pragma unroll
                    for (int i = 0; i < 4; ++i) h[4 * n + i] = f_silu(g[i]) * up[i]; }
                u32x2 w; w.x = pk4f8(h[0], h[1], h[2], h[3]); w.y = pk4f8(h[4], h[5], h[6], h[7]);
                *(u32x2*)(H + (size_t)(row0 + ai * HALF + m * 16) * 512 + col0) = w; }
    }
};
struct EpiPlain8 {
    static constexpr bool PERM = true, AFTER_DRAIN = false, F8 = true;
    bf16_t* O; int ldc; int cmask;
    __device__ __forceinline__ void operator()(const f32x4 (&acc)[2][2][4][2], const Unit& u, int wr, int wc, int fr, int fq) const {
        const int row0 = u.pm * BM + wr * 64 + fr, col0 = (u.pn & cmask) * BM + wc * 32 + 8 * fq;
        constexpr float dq = 1.0f / (F8_SH * F8_SW);
#pragma unroll
        for (int ai = 0; ai < 2; ++ai)
#pragma unroll
            for (int m = 0; m < 4; ++m) { bf16_t* rowp = O + (size_t)(row0 + ai * HALF + m * 16) * ldc + col0;
#pragma unroll
                for (int bj = 0; bj < 2; ++bj) { const f32x4 v0 = acc[ai][bj][m][0] * dq, v1 = acc[ai][bj][m][1] * dq;
                    u32x4 w; w.x = pk2(v0[0], v0[1]); w.y = pk2(v0[2], v0[3]); w.z = pk2(v1[0], v1[1]); w.w = pk2(v1[2], v1[3]);
                    *(u32x4*)(rowp + bj * HALF) = w; } }
    }
};

typedef int i32x4_t __attribute__((ext_vector_type(4)));
template <class T, class = void> struct epi_f8 { static constexpr bool value = false; };
template <class T> struct epi_f8<T, decltype((void)T::F8)> { static constexpr bool value = true; };
template <class Epi, class Sched, bool ALIGN_EPI = false, bool SP2 = false>
__device__ __forceinline__ void gemm_phase(PG8_LAS unsigned char* lds, const Gemm g, const Sched& S, const Epi& E) {
    int tid_ = g.wv * 64 + lane_id(); asm volatile("" : "+v"(tid_));
    const int tid = tid_, wid = __builtin_amdgcn_readfirstlane(tid >> 6), lane = tid & 63, wr = wid >> 2, wc = wid & 3, fr = lane & 15, fq = lane >> 4;
    const int K = g.K, nt = K / BK; constexpr bool F8 = epi_f8<Epi>::value;
    unsigned voffA[2], voffB[2];
#pragma unroll
    for (int i = 0; i < 2; ++i) { int R, C; stage_rc(tid * 16 + i * 8192, R, C); const int Rb = Epi::PERM ? ((R & ~31) + perm32(R & 31)) : R;
        voffA[i] = (unsigned)(R * K + C) * 2u;
        voffB[i] = (unsigned)(((Rb >> 4) * (K >> 5) + (C >> 5)) * 1024 + (Rb & 15) * 64 + (C & 31) * 2); }
    constexpr bool GATH = Sched::GATHER; static_assert(!GATH || SP2, "gather mode is written for the SP2 loop");
    unsigned goc[2][2] = {{0u, 0u}, {0u, 0u}}, gon[2][2] = {{0u, 0u}, {0u, 0u}}, go2[2][2] = {{0u, 0u}, {0u, 0u}};
#define PG8_GOFF(dst, U) do { int tg_ = tid; asm volatile("" : "+v"(tg_)); _Pragma("unroll") for (int i_ = 0; i_ < 2; ++i_) { int R_, C_; stage_rc(tg_ * 16 + i_ * 8192, R_, C_); \
        _Pragma("unroll") for (int h_ = 0; h_ < 2; ++h_) dst[h_][i_] = (unsigned)S.src[(U).pm * BM + h_ * HALF + R_] * (unsigned)(K * 2) + (unsigned)C_ * 2u; } } while (0)
    const size_t kstep = (size_t)(BK * 2);
    const size_t kstepB = 2048;
    const size_t hstep = (size_t)HALF * K * 2;
    const size_t tstep = 2 * hstep;
    const unsigned ldsw = (unsigned)wid * 1024u;
    const int aoff = lds_byte(wr * 64 + fr, fq * 8), boff = lds_byte(wc * 32 + fr, fq * 8);
#define PG8_SA(b, h) (((b) * 2 + (h)) * HTB)
#define PG8_SB(b, h) ((4 + (b) * 2 + (h)) * HTB)
#define PG8_STAGE(bufoff, gbase, voff) do { _Pragma("unroll") for (int _i = 0; _i < 2; ++_i) \
        __builtin_amdgcn_global_load_lds((const unsigned*)((const char*)(gbase) + (voff)[_i]), (PG8_LAS unsigned*)(lds + (bufoff) + ldsw + _i * 8192), 16, 0, 0); } while (0)
#define PG8_STAGE_A(b, h, PTR, KPTR, GO) do { if constexpr (GATH) { PG8_STAGE(PG8_SA(b, h), KPTR, GO); } else { PG8_STAGE(PG8_SA(b, h), PTR, voffA); } } while (0)
#define PG8_LDA(dst, b, h) do { _Pragma("unroll") for (int m = 0; m < 4; ++m) _Pragma("unroll") for (int k = 0; k < 2; ++k) dst[m][k] = *(const PG8_LAS bf16x8*)(lds + PG8_SA(b, h) + aoff + m * 2048 + k * 1024); } while (0)
#define PG8_LDB(dst, b, h) do { _Pragma("unroll") for (int n = 0; n < 2; ++n) _Pragma("unroll") for (int k = 0; k < 2; ++k) dst[n][k] = *(const PG8_LAS bf16x8*)(lds + PG8_SB(b, h) + boff + n * 2048 + k * 1024); } while (0)
#define PG8_CAT8(x, y) __builtin_shufflevector(__builtin_bit_cast(i32x4_t, x), __builtin_bit_cast(i32x4_t, y), 0, 1, 2, 3, 4, 5, 6, 7)
#define PG8_MMA(ai, bj, At, Bt) do { __builtin_amdgcn_s_setprio(1); \
        if constexpr (F8) { _Pragma("unroll") for (int m = 0; m < 4; ++m) _Pragma("unroll") for (int n = 0; n < 2; ++n) \
            asm volatile("v_mfma_f32_16x16x128_f8f6f4 %0, %1, %2, %0" : "+v"(acc[ai][bj][m][n]) : "v"(PG8_CAT8(Bt[n][0], Bt[n][1])), "v"(PG8_CAT8(At[m][0], At[m][1]))); } \
        else { _Pragma("unroll") for (int m = 0; m < 4; ++m) _Pragma("unroll") for (int n = 0; n < 2; ++n) _Pragma("unroll") for (int k = 0; k < 2; ++k) \
            acc[ai][bj][m][n] = __builtin_amdgcn_mfma_f32_16x16x32_bf16(Bt[n][k], At[m][k], acc[ai][bj][m][n], 0, 0, 0); } \
        __builtin_amdgcn_s_setprio(0); } while (0)
#define PG8_WAIT_V(n) asm volatile("s_waitcnt vmcnt(" #n ")" ::: "memory")
#define PG8_WAIT_L(n) asm volatile("s_waitcnt lgkmcnt(" #n ")" ::: "memory")
#define PG8_BAR __builtin_amdgcn_s_barrier()
#define PG8_SCHED __builtin_amdgcn_sched_barrier(0)
    Unit cur, nxt; int ui = 0;
    if (!S.next(0, cur)) return;
    f32x4 acc[2][2][4][2];
#pragma unroll
    for (int a = 0; a < 2; ++a)
#pragma unroll
        for (int b = 0; b < 2; ++b)
#pragma unroll
            for (int m = 0; m < 4; ++m)
#pragma unroll
                for (int n = 0; n < 2; ++n) { acc[a][b][m][n] = (f32x4){0.f, 0.f, 0.f, 0.f}; if constexpr (F8) asm volatile("" : "+v"(acc[a][b][m][n])); }
    bf16x8 At[4][2], B0[2][2], B1[2][2];
    const char* cA = (const char*)g.A + (size_t)cur.pm * tstep; const char* cB = (const char*)g.Bt + (size_t)cur.pn * tstep;
    S.a_ready(cur);
    const char* gA = (const char*)g.A;
    if constexpr (GATH) PG8_GOFF(goc, cur);
    if constexpr (SP2) {
        PG8_STAGE(PG8_SB(0, 0), cB, voffB); PG8_STAGE(PG8_SB(0, 1), cB + hstep, voffB); PG8_STAGE_A(0, 0, cA, gA, goc[0]); PG8_STAGE_A(0, 1, cA + hstep, gA, goc[1]);
        if (wr == 1) PG8_BAR;
        PG8_WAIT_V(2); PG8_BAR;
        PG8_STAGE(PG8_SB(1, 0), cB + kstepB, voffB); PG8_STAGE_A(1, 0, cA + kstep, gA + kstep, goc[0]); PG8_STAGE(PG8_SB(1, 1), cB + hstep + kstepB, voffB);
        PG8_WAIT_V(6); PG8_BAR;
    } else {
        PG8_STAGE(PG8_SB(0, 0), cB, voffB); PG8_STAGE(PG8_SA(0, 0), cA, voffA); PG8_STAGE(PG8_SB(0, 1), cB + hstep, voffB); PG8_STAGE(PG8_SA(0, 1), cA + hstep, voffA);
        if (wr == 1) PG8_BAR;
        PG8_WAIT_V(4); PG8_BAR;
        PG8_STAGE(PG8_SB(1, 0), cB + kstepB, voffB); PG8_STAGE(PG8_SA(1, 0), cA + kstep, voffA); PG8_STAGE(PG8_SB(1, 1), cB + hstep + kstepB, voffB);
        PG8_WAIT_V(6); PG8_BAR;
    }
    for (;;) {
        const bool has_next = S.next(ui + 1, nxt);
        if constexpr (GATH) { if (has_next) PG8_GOFF(gon, nxt); else { _Pragma("unroll") for (int h_ = 0; h_ < 2; ++h_) _Pragma("unroll") for (int i_ = 0; i_ < 2; ++i_) gon[h_][i_] = goc[h_][i_]; } }
        const char* nA = has_next ? (const char*)g.A + (size_t)nxt.pm * tstep : cA; const char* nB = has_next ? (const char*)g.Bt + (size_t)nxt.pn * tstep : cB;
        for (int t = 0; t < nt; t += 2) {
            const bool last = (t == nt - 2);
            const char* a1 = cA + (size_t)(t + 1) * kstep;
            const char* a2 = last ? nA : cA + (size_t)(t + 2) * kstep; const char* b2 = last ? nB : cB + (size_t)(t + 2) * kstepB;
            const char* a3 = a2 + kstep; const char* b3 = b2 + kstepB;
            if (last && has_next) S.a_ready(nxt);
            const char* ga1 = gA + (size_t)(t + 1) * kstep; const char* ga2 = last ? gA : gA + (size_t)(t + 2) * kstep; const char* ga3 = ga2 + kstep;
            if constexpr (GATH) { _Pragma("unroll") for (int h_ = 0; h_ < 2; ++h_) _Pragma("unroll") for (int i_ = 0; i_ < 2; ++i_) go2[h_][i_] = last ? gon[h_][i_] : goc[h_][i_]; }
            if constexpr (SP2) {
            PG8_LDB(B0, 0, 0); PG8_LDB(B1, 0, 1); PG8_SCHED; PG8_LDA(At, 0, 0); PG8_STAGE_A(1, 1, a1 + hstep, ga1, goc[1]);
            PG8_WAIT_V(8); PG8_WAIT_L(0); PG8_BAR; PG8_MMA(0, 0, At, B0); PG8_MMA(0, 1, At, B1); PG8_BAR; PG8_SCHED;
            PG8_LDA(At, 0, 1); PG8_STAGE(PG8_SB(0, 0), b2, voffB); PG8_STAGE(PG8_SB(0, 1), b2 + hstep, voffB); PG8_STAGE_A(0, 0, a2, ga2, go2[0]);
            PG8_WAIT_V(8); PG8_WAIT_L(0); PG8_BAR; PG8_MMA(1, 0, At, B0); PG8_MMA(1, 1, At, B1); PG8_BAR; PG8_SCHED;
            PG8_LDB(B0, 1, 0); PG8_LDB(B1, 1, 1); PG8_SCHED; PG8_LDA(At, 1, 0); PG8_STAGE_A(0, 1, a2 + hstep, ga2, go2[1]);
            PG8_WAIT_V(8); PG8_WAIT_L(0); PG8_BAR; PG8_MMA(0, 0, At, B0); PG8_MMA(0, 1, At, B1); PG8_BAR; PG8_SCHED;
            PG8_LDA(At, 1, 1); PG8_STAGE(PG8_SB(1, 0), b3, voffB); PG8_STAGE(PG8_SB(1, 1), b3 + hstep, voffB); PG8_STAGE_A(1, 0, a3, ga3, go2[0]);
            PG8_WAIT_V(8); PG8_WAIT_L(0); PG8_BAR; PG8_MMA(1, 0, At, B0); PG8_MMA(1, 1, At, B1); PG8_BAR; PG8_SCHED;
            } else {
            PG8_LDB(B0, 0, 0); PG8_SCHED; PG8_LDA(At, 0, 0); PG8_STAGE(PG8_SA(1, 1), a1 + hstep, voffA);
            PG8_WAIT_L(8); PG8_BAR; PG8_WAIT_L(0); PG8_MMA(0, 0, At, B0); PG8_BAR; PG8_SCHED;
            PG8_LDB(B1, 0, 1); PG8_STAGE(PG8_SB(0, 0), b2, voffB);
            PG8_BAR; PG8_WAIT_L(0); PG8_MMA(0, 1, At, B1); PG8_BAR;
            PG8_LDA(At, 0, 1); PG8_STAGE(PG8_SA(0, 0), a2, voffA);
            PG8_BAR; PG8_WAIT_L(0); PG8_MMA(1, 0, At, B0); PG8_BAR; PG8_SCHED;
            PG8_STAGE(PG8_SB(0, 1), b2 + hstep, voffB);
            PG8_WAIT_V(6); PG8_BAR; PG8_MMA(1, 1, At, B1); PG8_BAR;
            PG8_LDB(B0, 1, 0); PG8_SCHED; PG8_LDA(At, 1, 0); PG8_STAGE(PG8_SA(0, 1), a2 + hstep, voffA);
            PG8_WAIT_L(8); PG8_BAR; PG8_WAIT_L(0); PG8_MMA(0, 0, At, B0); PG8_BAR; PG8_SCHED;
            PG8_LDB(B1, 1, 1); PG8_STAGE(PG8_SB(1, 0), b3, voffB);
            PG8_BAR; PG8_WAIT_L(0); PG8_MMA(0, 1, At, B1); PG8_BAR;
            PG8_LDA(At, 1, 1); PG8_STAGE(PG8_SA(1, 0), a3, voffA);
            PG8_BAR; PG8_WAIT_L(0); PG8_MMA(1, 0, At, B0); PG8_BAR; PG8_SCHED;
            PG8_STAGE(PG8_SB(1, 1), b3 + hstep, voffB);
            PG8_WAIT_V(6); PG8_BAR; PG8_MMA(1, 1, At, B1); PG8_BAR;
            }
        }
        if constexpr (F8) asm volatile("s_nop 15\n\ts_nop 15" ::: "memory");
        if constexpr (ALIGN_EPI) { if (wr == 0) PG8_BAR; }
        if constexpr (!Epi::AFTER_DRAIN) { E(acc, cur, wr, wc, fr, fq); S.done(cur); }
        if (!has_next) break;
#pragma unroll
        for (int a = 0; a < 2; ++a)
#pragma unroll
            for (int b = 0; b < 2; ++b)
#pragma unroll
                for (int m = 0; m < 4; ++m)
#pragma unroll
                    for (int n = 0; n < 2; ++n) { acc[a][b][m][n] = (f32x4){0.f, 0.f, 0.f, 0.f}; if constexpr (F8) asm volatile("" : "+v"(acc[a][b][m][n])); }
        cur = nxt; cA = nA; cB = nB; ++ui;
        if constexpr (GATH) { _Pragma("unroll") for (int h_ = 0; h_ < 2; ++h_) _Pragma("unroll") for (int i_ = 0; i_ < 2; ++i_) goc[h_][i_] = gon[h_][i_]; }
        if constexpr (ALIGN_EPI) { if (wr == 1) PG8_BAR; }
    }
    PG8_WAIT_V(0);
    if constexpr (!ALIGN_EPI) { if (wr == 0) PG8_BAR; }
    PG8_BAR;
    if constexpr (Epi::AFTER_DRAIN) { E.fused(acc, cur, wr, wc, fr, fq, lds, wid, lane); S.done(cur); }
#undef PG8_SA
#undef PG8_SB
#undef PG8_STAGE
#undef PG8_STAGE_A
#undef PG8_GOFF
#undef PG8_LDA
#undef PG8_LDB
#undef PG8_MMA
#undef PG8_WAIT_V
#undef PG8_WAIT_L
#undef PG8_BAR
#undef PG8_SCHED
}}

namespace mk {
using pg8::bf16_t; using pg8::bf16x8; using pg8::f32x4; using pg8::u32x4; using pg8::u32x2; using pg8::pk2; using pg8::bflo; using pg8::bfhi;
typedef float f32x16 __attribute__((ext_vector_type(16)));
typedef short s16x4 __attribute__((ext_vector_type(4)));
typedef short v4i16_t __attribute__((ext_vector_type(4)));
#define LAS __attribute__((address_space(3)))
#define GAS __attribute__((address_space(1)))
typedef GAS unsigned gu32;
#define RLX_AGENT __ATOMIC_RELAXED, __HIP_MEMORY_SCOPE_AGENT
#define LDS_WAIT() asm volatile("s_waitcnt lgkmcnt(0)" ::: "memory")

constexpr int NB = 8, SEQ = 8192, M = NB * SEQ, D = 1024, NP = 2816, NMEM = 256, MKV = NB * NMEM;
constexpr int PQ = 0, PK = 256, PV = 512, PR = 1024, PG = 1536, PU = 1792, PVS = 2304;
constexpr int DIN = 2576;
constexpr int MOE_ROWS = 135168;
constexpr float ALPHA = 1.4142135623730951f, LN_EPS = 1e-5f, LOG2E = 1.4426950408889634f;
constexpr int NWAVES = 8, NTHR = 512;

constexpr size_t MiB = 1u << 20;
constexpr size_t WS_CTL = 0, CTL_ZERO_BYTES = 1 * MiB;
constexpr size_t WS_WM = 1 * MiB;
constexpr size_t WS_WGCNT = 1 * MiB + 512 * 1024;
constexpr size_t WS_LTOT = 1 * MiB + 768 * 1024;
constexpr size_t WS_TINFO = 2 * MiB;
constexpr size_t WS_TRANK = 3 * MiB;
constexpr size_t WS_TSLOT = 3 * MiB + 512 * 1024;
constexpr size_t WS_SEND = 4 * MiB;
constexpr size_t WS_WKV = 12 * MiB;
constexpr size_t WS_MEMB = 20 * MiB;
constexpr size_t WS_KV = 24 * MiB;
constexpr size_t WS_W = 40 * MiB, W_LAYER = 60 * MiB;
constexpr size_t W_IN = 0, W_OUT = (size_t)NP * D * 2, W_Q = W_OUT + 2 * MiB, W_O = W_Q + 2 * MiB, W_GU = W_O + 2 * MiB, W_D = W_GU + 32 * MiB;
static_assert(W_D + 16 * MiB <= W_LAYER, "weights per layer");
constexpr size_t WS_X = 160 * MiB;
constexpr size_t WS_R = 288 * MiB;
constexpr size_t R_P = 0, R_Y = 352 * MiB, R_Z = 480 * MiB, R_Q = 0, R_O = 128 * MiB, R_XS = 352 * MiB, R_H = 0;
constexpr size_t R_X8 = 256 * MiB;
constexpr size_t WS_SRCROW = WS_R + 616 * MiB;
constexpr size_t WS_PART = WS_SRCROW + 1 * MiB;
constexpr size_t WS_STATS = WS_PART + 8 * MiB;
constexpr size_t WS_CS = WS_STATS + 1 * MiB;
constexpr size_t WS_X8IN = WS_CS + 1 * MiB;
constexpr size_t WS_END = WS_X8IN + 64 * MiB;
static_assert(R_XS + (size_t)MOE_ROWS * D * 2 <= 616 * MiB && R_H + (size_t)MOE_ROWS * 512 * 2 <= R_XS, "moe buffers");
constexpr int CW_BAR = 4096;

constexpr int LDS_BYTES = 159744, LDSCTL_OFF = 155648;
constexpr int MISC_OFF = LDSCTL_OFF;
constexpr int TILEE_OFF = LDSCTL_OFF + 512;
static_assert(TILEE_OFF + 528 * 4 <= LDS_BYTES, "LDS map");

#define XB_TMO      128
#define XB_XCNT(j)  (256  + 64 * (j))
#define XB_XSUB(j)  (1280 + 64 * (j))
#define XB_XGEN(j)  (2304 + 64 * (j))
#define XB_TOP      3328
#define XB_TOPGEN   3392
#define XCD_BAR_WORDS 3456
#define XB_SPIN_CAP (1u << 18)

__device__ __forceinline__ unsigned xb_ld(unsigned* p)              { return __hip_atomic_load(p, __ATOMIC_RELAXED, __HIP_MEMORY_SCOPE_AGENT); }
__device__ __forceinline__ unsigned xb_add(unsigned* p, unsigned v) { return __hip_atomic_fetch_add(p, v, __ATOMIC_RELAXED, __HIP_MEMORY_SCOPE_AGENT); }
__device__ __forceinline__ unsigned xb_xcc_id() { return (unsigned)__builtin_amdgcn_s_getreg((3 << 11) | 20) & 0xFu; }
#define XB_SPIN(cond, bar) do { unsigned _sp = 0; while (cond) { __builtin_amdgcn_s_sleep(1); \
    if ((++_sp & 255u) == 0u) { if (xb_ld(&(bar)[XB_TMO])) break; if (_sp > XB_SPIN_CAP) { atomicAdd(&(bar)[XB_TMO], 1u); break; } } } } while (0)

struct XcdBarrier {
    unsigned* bar; unsigned x;
    volatile LAS unsigned* st;
    int wv;
};

__device__ __forceinline__ XcdBarrier xcd_barrier_post(unsigned* bar, volatile LAS unsigned* st) {
    XcdBarrier b; b.bar = bar; b.x = xb_xcc_id(); b.st = st; b.wv = 0;
    if (threadIdx.x == 0) (void)xb_add(&bar[XB_XCNT(b.x)], 1u);
    return b;
}
__device__ __forceinline__ void xcd_barrier_complete(unsigned* bar, unsigned x, unsigned& nloc, unsigned& nx) {
    const unsigned G = gridDim.x * gridDim.y * gridDim.z;
    unsigned sum, cnt, mine, sp = 0u;
    for (;;) {
        sum = 0u; cnt = 0u; mine = 0u;
#pragma unroll
        for (unsigned j = 0; j < 16; ++j) { const unsigned c = xb_ld(&bar[XB_XCNT(j)]); sum += c; cnt += (c > 0u) ? 1u : 0u; mine = (j == x) ? c : mine; }
        if (sum == G) break;
        __builtin_amdgcn_s_sleep(1);
        if ((++sp & 255u) == 0u) { if (xb_ld(&bar[XB_TMO])) break; if (sp > XB_SPIN_CAP) { atomicAdd(&bar[XB_TMO], 1u); break; } }
    }
    nloc = mine > 0u ? mine : 1u; nx = cnt > 0u ? cnt : 1u;
}

__device__ __forceinline__ void xcd_barrier(const XcdBarrier& b) {
    asm volatile("s_waitcnt vmcnt(0)" ::: "memory");
    __syncthreads();
    if (b.wv == 0 && pg8::lane_id() == 0) {
        unsigned* bar = b.bar;
        __builtin_amdgcn_s_waitcnt(0);
        unsigned nloc = b.st[0], nx = b.st[1];
        if (nloc == 0u) { xcd_barrier_complete(bar, b.x, nloc, nx); b.st[0] = nloc; b.st[1] = nx; }
        const unsigned old = xb_add(&bar[XB_XSUB(b.x)], 1u);
        const unsigned gen = old / nloc;
        if (old + 1u == (gen + 1u) * nloc) {
            __builtin_amdgcn_fence(__ATOMIC_RELEASE, "agent");
            asm volatile("s_waitcnt vmcnt(0)" ::: "memory");
            const unsigned og = xb_add(&bar[XB_TOP], 1u);
            const unsigned tg = og / nx;
            if (og + 1u == (tg + 1u) * nx) xb_add(&bar[XB_TOPGEN], 1u);
            else XB_SPIN(xb_ld(&bar[XB_TOPGEN]) == tg, bar);
            __builtin_amdgcn_fence(__ATOMIC_ACQUIRE, "agent");
            xb_add(&bar[XB_XGEN(b.x)], 1u);
            asm volatile("s_waitcnt vmcnt(0)" ::: "memory");
        } else {
            XB_SPIN(xb_ld(&bar[XB_XGEN(b.x)]) == gen, bar);
            __builtin_amdgcn_fence(__ATOMIC_ACQUIRE, "agent");
            asm volatile("s_waitcnt vmcnt(0)" ::: "memory");
        }
    }
    __syncthreads();
}
__device__ __forceinline__ float shx(float v, int m, int lane) { return __builtin_bit_cast(float, __builtin_amdgcn_ds_bpermute((lane ^ m) << 2, __builtin_bit_cast(int, v))); }
__device__ __forceinline__ int shxi(int v, int m, int lane) { return __builtin_amdgcn_ds_bpermute((lane ^ m) << 2, v); }
__device__ __forceinline__ s16x4 vtr(unsigned lds_addr) { return __builtin_bit_cast(s16x4, __builtin_amdgcn_ds_read_tr16_b64_v4i16((LAS v4i16_t*)(size_t)lds_addr)); }
__device__ __forceinline__ bf16x8 cat8(s16x4 lo, s16x4 hi) { return __builtin_shufflevector(lo, hi, 0, 1, 2, 3, 4, 5, 6, 7); }
__device__ __forceinline__ void unpack8(const u32x4 w, float (&f)[8]) { f[0] = bflo(w.x); f[1] = bfhi(w.x); f[2] = bflo(w.y); f[3] = bfhi(w.y); f[4] = bflo(w.z); f[5] = bfhi(w.z); f[6] = bflo(w.w); f[7] = bfhi(w.w); }
__device__ __forceinline__ u32x4 pack8(const float (&f)[8]) { u32x4 w; w.x = pk2(f[0], f[1]); w.y = pk2(f[2], f[3]); w.z = pk2(f[4], f[5]); w.w = pk2(f[6], f[7]); return w; }

struct Args {
    const float* in[22]; float* out; unsigned char* ws;
};

__device__ __forceinline__ void transpose_item(const float* p0, const float* p1, int ld, int mode, float scale, int K, int nblk, bf16_t* dst, int row0, LAS float* scr, int item, int lane, const float* kscale = nullptr) {
    const int kb = item / nblk, nb = item % nblk, k0 = 64 * kb, n0 = 32 * nb;
    const int np = n0 + (lane & 31);
    const float* sp; int col;
    if (mode == 0) { sp = p0; col = np; } else { sp = (np & 4) ? p1 : p0; col = (np >> 3) * 4 + (np & 3); }
    sp += (size_t)k0 * ld + col;
#pragma unroll 8
    for (int i = 0; i < 32; ++i) { const int kk = 2 * i + (lane >> 5); scr[kk * 33 + (lane & 31)] = sp[(size_t)kk * ld] * scale * (kscale ? kscale[k0 + kk] : 1.0f); }
    LDS_WAIT(); asm volatile("" ::: "memory");
    const int c = lane & 7;
#pragma unroll
    for (int j = 0; j < 4; ++j) { const int n = (lane >> 3) + 8 * j; const LAS float* s = scr + (8 * c) * 33 + n;
        u32x4 o; o.x = pk2(s[0 * 33], s[1 * 33]); o.y = pk2(s[2 * 33], s[3 * 33]); o.z = pk2(s[4 * 33], s[5 * 33]); o.w = pk2(s[6 * 33], s[7 * 33]);
        const int ng = row0 + n0 + n, kk = k0 + 8 * c;
        *(u32x4*)(dst + ((size_t)(ng >> 4) * (K >> 5) + (kk >> 5)) * 512 + (ng & 15) * 32 + (kk & 31)) = o; }
    LDS_WAIT(); asm volatile("" ::: "memory");
}
__device__ __forceinline__ void transpose_item8(const float* p0, const float* p1, int ld, int mode, float scale, int K, int nblk, unsigned char* dst, int row0, LAS float* scr, int item, int lane) {
    const int kb = item / nblk, nb = item % nblk, k0 = 64 * kb, n0 = 32 * nb;
    const int np = n0 + (lane & 31);
    const float* sp; int col;
    if (mode == 0) { sp = p0; col = np; } else { sp = ((np >> 7) & 1) ? p1 : p0; col = (np >> 8) * 128 + (np & 127); }
    sp += (size_t)k0 * ld + col;
#pragma unroll 8
    for (int i = 0; i < 32; ++i) { const int kk = 2 * i + (lane >> 5); scr[kk * 33 + (lane & 31)] = sp[(size_t)kk * ld] * scale; }
    LDS_WAIT(); asm volatile("" ::: "memory");
    const int c = lane & 7;
#pragma unroll
    for (int j = 0; j < 4; ++j) { const int n = (lane >> 3) + 8 * j; const LAS float* s = scr + (8 * c) * 33 + n;
        u32x2 o; o.x = pg8::pk4f8(s[0 * 33], s[1 * 33], s[2 * 33], s[3 * 33]); o.y = pg8::pk4f8(s[4 * 33], s[5 * 33], s[6 * 33], s[7 * 33]);
        const int ng = row0 + n0 + n;
        *(u32x2*)(dst + ((size_t)(ng >> 4) * (K >> 6) + (k0 >> 6)) * 1024 + (ng & 15) * 64 + 8 * c) = o; }
    LDS_WAIT(); asm volatile("" ::: "memory");
}
__device__ __forceinline__ void p0_convert(const Args& a, LAS unsigned char* lds, int bid, int G, int wave_s) {
    int tid_ = wave_s * 64 + pg8::lane_id(); asm volatile("" : "+v"(tid_)); const int tid = tid_, lane = tid & 63, wave = __builtin_amdgcn_readfirstlane(tid >> 6);
    unsigned char* ws = a.ws;
    LAS float* scr = (LAS float*)(lds + wave * 16384);
    const int gw = bid * NWAVES + wave, NGW = G * NWAVES;
    constexpr int I_INQ = 16 * 8, I_INB = 16 * 40, I_INC = 16 * 32, I_SQ = 16 * 32, I_GU = 16 * 16 * 32, I_DN = 16 * 8 * 32;
    constexpr int I_LAYER = I_INQ + I_INB + I_INC + 5 * I_SQ + I_GU + I_DN;
    for (int it = gw; it < 2 * I_LAYER; it += NGW) {
        const int l = it / I_LAYER; int r = it % I_LAYER;
        unsigned char* wl = ws + WS_W + (size_t)l * W_LAYER;
        const float* w_in = a.in[2] + (size_t)l * D * DIN;
        if (r < I_INQ) { transpose_item8(w_in, nullptr, DIN, 0, 0.125f * pg8::F8_SW, D, 8, wl + W_IN, 0, scr, r, lane); continue; } r -= I_INQ;
        if (r < I_INB) { transpose_item8(w_in + 256, nullptr, DIN, 0, pg8::F8_SW, D, 40, wl + W_IN, 256, scr, r, lane); continue; } r -= I_INB;
        if (r < I_INC) { transpose_item8(w_in + 1552, nullptr, DIN, 0, pg8::F8_SW, D, 32, wl + W_IN, 1792, scr, r, lane); continue; } r -= I_INC;
        if (r < I_SQ) { transpose_item(a.in[10] + (size_t)l * D * D, nullptr, D, 0, 1.0f, D, 32, (bf16_t*)(wl + W_OUT), 0, scr, r, lane); continue; } r -= I_SQ;
        if (r < I_SQ) { transpose_item(a.in[11] + (size_t)l * D * D, nullptr, D, 0, 0.0625f, D, 32, (bf16_t*)(wl + W_Q), 0, scr, r, lane, a.in[20] + (size_t)(l * 3 + 0) * D); continue; } r -= I_SQ;
        if (r < I_SQ) { transpose_item8(a.in[14] + (size_t)l * D * D, nullptr, D, 0, pg8::F8_SW, D, 32, wl + W_O, 0, scr, r, lane); continue; } r -= I_SQ;
        if (r < I_SQ) { transpose_item(a.in[12] + (size_t)l * D * D, nullptr, D, 0, 1.0f, D, 32, (bf16_t*)(ws + WS_WKV), l * 2048, scr, r, lane); continue; } r -= I_SQ;
        if (r < I_SQ) { transpose_item(a.in[13] + (size_t)l * D * D, nullptr, D, 0, 1.0f, D, 32, (bf16_t*)(ws + WS_WKV), l * 2048 + 1024, scr, r, lane); continue; } r -= I_SQ;
        if (r < I_GU) { const int e = r / 512, rr = r % 512; const size_t eo = ((size_t)l * 16 + e) * D * 512;
            transpose_item8(a.in[17] + eo, a.in[18] + eo, 512, 2, pg8::F8_SW, D, 32, wl + W_GU, e * 1024, scr, rr, lane); continue; } r -= I_GU;
        { const int e = r / 256, rr = r % 256; const size_t eo = ((size_t)l * 16 + e) * 512 * D;
            transpose_item8(a.in[19] + eo, nullptr, D, 0, pg8::F8_SW, 512, 32, wl + W_D, e * 1024, scr, rr, lane); }
    }
    const size_t gt = (size_t)bid * NTHR + tid, NT = (size_t)G * NTHR;
    for (int it = gw; it < 2 * 16 * 16; it += NGW) { const int l = it >> 8, kc = (it >> 4) & 15, n = (it & 15) * 64 + lane;
        const float* wq = a.in[11] + (size_t)l * D * D; const float* gg = a.in[20] + (size_t)(l * 3) * D; const float* bb = a.in[21] + (size_t)(l * 3) * D; float cs = 0.f, bq = 0.f;
#pragma unroll 8
        for (int k = 64 * kc; k < 64 * kc + 64; ++k) { const float w = wq[(size_t)k * D + n] * 0.0625f; cs += bflo(pk2(w * gg[k], 0.f) & 0xffffu); bq += w * bb[k]; }
        float* tb = (float*)(ws + WS_CS) + (size_t)l * 2 * 16 * 1024; tb[kc * 1024 + n] = cs; tb[16 * 1024 + kc * 1024 + n] = bq; }
    for (size_t i = gt; i < (size_t)2 * 256 * 128; i += NT) {
        const int l = (int)(i / (256 * 128)), r = (int)(i % (256 * 128)), j = r / 128, k8 = r % 128;
        const float* w_in = a.in[2] + (size_t)l * D * DIN; const float* w_a2 = a.in[3] + (size_t)l * 16 * 256;
        float wa[16];
#pragma unroll
        for (int q = 0; q < 16; ++q) wa[q] = w_a2[q * 256 + j];
        float o[8];
#pragma unroll
        for (int kk = 0; kk < 8; ++kk) { const float* wr = w_in + (size_t)(8 * k8 + kk) * DIN + 1536; float s = 0.f;
#pragma unroll
            for (int q = 0; q < 16; q += 4) { const f32x4 v = *(const f32x4*)(wr + q); s += v[0] * wa[q] + v[1] * wa[q + 1] + v[2] * wa[q + 2] + v[3] * wa[q + 3]; }
            o[kk] = s; }
        { const int ng = 1536 + j, kk = 8 * k8; u32x2 o8; o8.x = pg8::pk4f8(o[0] * pg8::F8_SW, o[1] * pg8::F8_SW, o[2] * pg8::F8_SW, o[3] * pg8::F8_SW); o8.y = pg8::pk4f8(o[4] * pg8::F8_SW, o[5] * pg8::F8_SW, o[6] * pg8::F8_SW, o[7] * pg8::F8_SW);
          *(u32x2*)(ws + WS_W + (size_t)l * W_LAYER + W_IN + ((size_t)(ng >> 4) * (D >> 6) + (kk >> 6)) * 1024 + (ng & 15) * 64 + (kk & 63)) = o8; }
    }
    for (size_t i = gt; i < (size_t)2 * 4 * 128 * 16; i += NT) {
        const int s8 = (int)(i & 15), t = (int)((i >> 4) & 127);
        const float* src = a.in[6] + i * 8; float o[8];
#pragma unroll
        for (int q = 0; q < 8; ++q) o[q] = ((8 * s8 + q) / 64 <= t / 64) ? src[q] : 0.f;
        *(u32x4*)((bf16_t*)(ws + WS_WM) + i * 8) = pack8(o);
    }
    for (size_t i = gt; i < (size_t)M * D / 8; i += NT) {
        const f32x4 v0 = *(const f32x4*)(a.in[0] + i * 8), v1 = *(const f32x4*)(a.in[0] + i * 8 + 4);
        u32x4 w; w.x = pk2(v0[0], v0[1]); w.y = pk2(v0[2], v0[3]); w.z = pk2(v1[0], v1[1]); w.w = pk2(v1[2], v1[3]);
        *(u32x4*)((bf16_t*)(ws + WS_X) + i * 8) = w;
        u32x2 q8; q8.x = pg8::pk4f8(v0[0] * pg8::F8_SX, v0[1] * pg8::F8_SX, v0[2] * pg8::F8_SX, v0[3] * pg8::F8_SX); q8.y = pg8::pk4f8(v1[0] * pg8::F8_SX, v1[1] * pg8::F8_SX, v1[2] * pg8::F8_SX, v1[3] * pg8::F8_SX);
        *(u32x2*)(ws + WS_X8IN + i * 8) = q8;
    }
    for (size_t i = gt; i < (size_t)MKV * D / 8; i += NT) {
        const f32x4 v0 = *(const f32x4*)(a.in[1] + i * 8), v1 = *(const f32x4*)(a.in[1] + i * 8 + 4);
        u32x4 w; w.x = pk2(v0[0], v0[1]); w.y = pk2(v0[2], v0[3]); w.z = pk2(v1[0], v1[1]); w.w = pk2(v1[2], v1[3]);
        *(u32x4*)((bf16_t*)(ws + WS_MEMB) + i * 8) = w;
    }
}

constexpr int GL_KD = 0, GL_QS = 9216, GL_VS = 18432, GL_PSUM = 35840, GL_DL = 37888, GL_SSQ = 38144;
template <bool FINAL>
__device__ __forceinline__ void gla_phase(LAS unsigned char* lds, const bf16_t* P, float* Send, float* Ltot, bf16_t* Y, const float* gn_g, int bid, int G, int wave_s) {
    int tid_ = wave_s * 64 + pg8::lane_id(); asm volatile("" : "+v"(tid_)); const int tid = tid_, lane = tid & 63, wave = __builtin_amdgcn_readfirstlane(tid >> 6);
    const unsigned lb = (unsigned)(size_t)lds;
    const int g = lane >> 4, l15 = lane & 15, q4 = l15 >> 2, p4 = lane & 3;
    const int kq = tid & 63, part = wave;
    for (int item = bid; item < 256; item += G) {
        const int b = item >> 5, h = (item >> 3) & 3, run = item & 7, bh = item >> 3;
        f32x4 sacc[4];
#pragma unroll
        for (int kt = 0; kt < 4; ++kt) sacc[kt] = (f32x4){0.f, 0.f, 0.f, 0.f};
        if (FINAL) {
            for (int i = 0; i < run; ++i) {
                const float* se = Send + ((size_t)(bh * 8 + i) * 64) * 128; const float* lt = Ltot + (size_t)(bh * 8 + i) * 64;
#pragma unroll
                for (int kt = 0; kt < 4; ++kt)
#pragma unroll
                    for (int r = 0; r < 4; ++r) { const int k = 16 * kt + 4 * g + r; sacc[kt][r] = __expf(lt[k]) * sacc[kt][r] + se[(size_t)k * 128 + 16 * wave + l15]; }
            }
        }
        float ltot_acc = 0.f;
        unsigned short graw[8], kraw[8]; u32x4 vraw[2], qraw; u32x2 rraw[4];
        const int v_row = tid >> 4, v_c16 = tid & 15, q_row = tid >> 3, q_c16 = tid & 7;
        const int ycol = h * 128 + 16 * wave + 4 * g;
#define GLA_FETCH(CC) do { const size_t tf_ = (size_t)b * SEQ + (size_t)(run * 16 + (CC)) * 64; \
            _Pragma("unroll") for (int i = 0; i < 8; ++i) { const bf16_t* rp = P + (tf_ + 8 * part + i) * NP + h * 64 + kq; graw[i] = rp[PG]; kraw[i] = rp[PK]; } \
            _Pragma("unroll") for (int i = 0; i < 2; ++i) vraw[i] = *(const u32x4*)(P + (tf_ + v_row + 32 * i) * NP + PV + h * 128 + v_c16 * 8); \
            if (FINAL) { qraw = *(const u32x4*)(P + (tf_ + q_row) * NP + PQ + h * 64 + q_c16 * 8); \
                _Pragma("unroll") for (int tt = 0; tt < 4; ++tt) rraw[tt] = *(const u32x2*)(P + (tf_ + 16 * tt + l15) * NP + PR + ycol); } } while (0)
        GLA_FETCH(0);
        for (int c = 0; c < 16; ++c) {
            const size_t t0 = (size_t)b * SEQ + (size_t)(run * 16 + c) * 64;
            __syncthreads();
            float gv[8], kv[8];
#pragma unroll
            for (int i = 0; i < 8; ++i) { gv[i] = __builtin_bit_cast(float, (unsigned)graw[i] << 16); kv[i] = __builtin_bit_cast(float, (unsigned)kraw[i] << 16); }
#pragma unroll
            for (int i = 1; i < 8; ++i) gv[i] += gv[i - 1];
            ((LAS float*)(lds + GL_PSUM))[part * 64 + kq] = gv[7];
#pragma unroll
            for (int i = 0; i < 2; ++i) *(LAS u32x4*)(lds + GL_VS + (v_row + 32 * i) * 272 + v_c16 * 16) = vraw[i];
            u32x2 rcur[4];
            if (FINAL) { *(LAS u32x4*)(lds + GL_QS + q_row * 144 + q_c16 * 16) = qraw;
#pragma unroll
                for (int tt = 0; tt < 4; ++tt) rcur[tt] = rraw[tt]; }
            if (c + 1 < 16) GLA_FETCH(c + 1);
            __syncthreads();
            float offs = 0.f, bl = 0.f;
#pragma unroll
            for (int p = 0; p < 8; ++p) { const float v = ((LAS float*)(lds + GL_PSUM))[p * 64 + kq]; offs += (p < part) ? v : 0.f; bl += v; }
#pragma unroll
            for (int i = 0; i < 8; ++i) { const float kd = kv[i] * __expf(bl - (offs + gv[i]));
                *(LAS unsigned short*)(lds + GL_KD + (8 * part + i) * 144 + kq * 2) = (unsigned short)(pk2(kd, 0.f) & 0xffffu); }
            if (part == 0) ((LAS float*)(lds + GL_DL))[kq] = __expf(bl);
            ltot_acc += bl;
            __syncthreads();
#pragma unroll
            for (int kt = 0; kt < 4; ++kt) { const f32x4 dl = *(LAS f32x4*)(lds + GL_DL + (16 * kt + 4 * g) * 4); sacc[kt] = sacc[kt] * dl; }
#pragma unroll
            for (int ks = 0; ks < 2; ++ks) {
                const unsigned vrow = lb + GL_VS + (unsigned)(32 * ks + 8 * g + q4) * 272u + (unsigned)(16 * wave + 4 * p4) * 2u;
                const bf16x8 vb = cat8(vtr(vrow), vtr(vrow + 4u * 272u));
#pragma unroll
                for (int kt = 0; kt < 4; ++kt) {
                    const unsigned krow = lb + GL_KD + (unsigned)(32 * ks + 8 * g + q4) * 144u + (unsigned)(16 * kt + 4 * p4) * 2u;
                    const bf16x8 ka = cat8(vtr(krow), vtr(krow + 4u * 144u));
                    sacc[kt] = __builtin_amdgcn_mfma_f32_16x16x32_bf16(ka, vb, sacc[kt], 0, 0, 0);
                }
            }
            if (FINAL) {
                f32x4 oacc[4];
#pragma unroll
                for (int tt = 0; tt < 4; ++tt) oacc[tt] = (f32x4){0.f, 0.f, 0.f, 0.f};
#pragma unroll
                for (int ks2 = 0; ks2 < 2; ++ks2) {
                    u32x4 spw; spw.x = pk2(sacc[2 * ks2][0], sacc[2 * ks2][1]); spw.y = pk2(sacc[2 * ks2][2], sacc[2 * ks2][3]);
                    spw.z = pk2(sacc[2 * ks2 + 1][0], sacc[2 * ks2 + 1][1]); spw.w = pk2(sacc[2 * ks2 + 1][2], sacc[2 * ks2 + 1][3]);
                    const bf16x8 sp = __builtin_bit_cast(bf16x8, spw);
#pragma unroll
                    for (int tt = 0; tt < 4; ++tt) {
                        const LAS unsigned char* qp = lds + GL_QS + (16 * tt + l15) * 144 + (32 * ks2 + 4 * g) * 2;
                        const u32x2 qlo = *(const LAS u32x2*)qp, qhi = *(const LAS u32x2*)(qp + 32);
                        u32x4 qw; qw.x = qlo.x; qw.y = qlo.y; qw.z = qhi.x; qw.w = qhi.y;
                        oacc[tt] = __builtin_amdgcn_mfma_f32_16x16x32_bf16(sp, __builtin_bit_cast(bf16x8, qw), oacc[tt], 0, 0, 0);
                    }
                }
#pragma unroll
                for (int tt = 0; tt < 4; ++tt) { float s = oacc[tt][0] * oacc[tt][0] + oacc[tt][1] * oacc[tt][1] + oacc[tt][2] * oacc[tt][2] + oacc[tt][3] * oacc[tt][3];
                    s += shx(s, 16, lane); s += shx(s, 32, lane);
                    if (g == 0) ((LAS float*)(lds + GL_SSQ))[wave * 64 + 16 * tt + l15] = s; }
                __syncthreads();
                const int col = h * 128 + 16 * wave + 4 * g;
                const f32x4 gn = *(const f32x4*)(gn_g + col);
#pragma unroll
                for (int tt = 0; tt < 4; ++tt) { float tot = 0.f;
#pragma unroll
                    for (int w2 = 0; w2 < 8; ++w2) tot += ((LAS float*)(lds + GL_SSQ))[w2 * 64 + 16 * tt + l15];
                    const float rs = __builtin_amdgcn_rsqf(tot * (1.0f / 128.0f) + 1e-6f);
                    const size_t tok = t0 + 16 * tt + l15;
                    const u32x2 rr = rcur[tt];
                    u32x2 w; w.x = pk2(oacc[tt][0] * rs * gn[0] * bflo(rr.x), oacc[tt][1] * rs * gn[1] * bfhi(rr.x));
                    w.y = pk2(oacc[tt][2] * rs * gn[2] * bflo(rr.y), oacc[tt][3] * rs * gn[3] * bfhi(rr.y));
                    *(u32x2*)(Y + tok * D + col) = w; }
            }
        }
        if (!FINAL) {
            float* se = Send + ((size_t)(bh * 8 + run) * 64) * 128;
#pragma unroll
            for (int kt = 0; kt < 4; ++kt)
#pragma unroll
                for (int r = 0; r < 4; ++r) se[(size_t)(16 * kt + 4 * g + r) * 128 + 16 * wave + l15] = sacc[kt][r];
            if (part == 0) Ltot[(size_t)(bh * 8 + run) * 64 + kq] = ltot_acc;
        }
    }
}

#undef GLA_FETCH
constexpr int SG_VN = 0;
__device__ __forceinline__ void sgu_phase(LAS unsigned char* lds, const bf16_t* P, const bf16_t* Wm, const float* b_s, const float* lg, const float* lb_, bf16_t* Y, int bid, int G, int wave_s) {
    int tid_ = wave_s * 64 + pg8::lane_id(); asm volatile("" : "+v"(tid_)); const int tid = tid_, lane = tid & 63, wave = __builtin_amdgcn_readfirstlane(tid >> 6);
    const unsigned lb = (unsigned)(size_t)lds;
    const int g = lane >> 4, l15 = lane & 15, q4 = l15 >> 2, p4 = lane & 3;
    const int row = tid >> 2, qu = tid & 3;
    u32x4 vraw[4]; u32x2 uraw[8];
#define SGU_FETCH(IT) do { const int blk_ = (IT) >> 2, gr_ = (IT) & 3; const size_t tf_ = (size_t)blk_ * 128; \
        const bf16_t* src_ = P + (tf_ + row) * NP + PVS + gr_ * 128 + 32 * qu; \
        _Pragma("unroll") for (int i = 0; i < 4; ++i) vraw[i] = *(const u32x4*)(src_ + 8 * i); \
        const bf16_t* us_ = P + (tf_ + 16 * wave + l15) * NP + PU + gr_ * 128 + 4 * g; \
        _Pragma("unroll") for (int ct = 0; ct < 8; ++ct) uraw[ct] = *(const u32x2*)(us_ + 16 * ct); } while (0)
    if (bid < 2048) SGU_FETCH(bid);
    for (int item = bid; item < 2048; item += G) {
        const int blk = item >> 2, gr = item & 3; const size_t t0 = (size_t)blk * 128;
        __syncthreads();
        u32x2 ucur[8];
        { float v[32];
#pragma unroll
          for (int i = 0; i < 4; ++i) { float f[8]; unpack8(vraw[i], f);
#pragma unroll
              for (int j = 0; j < 8; ++j) v[8 * i + j] = f[j]; }
#pragma unroll
          for (int ct = 0; ct < 8; ++ct) ucur[ct] = uraw[ct];
          if (item + G < 2048) SGU_FETCH(item + G);
          float s = 0.f;
#pragma unroll
          for (int i = 0; i < 32; ++i) s += v[i];
          s += shx(s, 1, lane); s += shx(s, 2, lane);
          const float mu = s * (1.0f / 128.0f); float qq = 0.f;
#pragma unroll
          for (int i = 0; i < 32; ++i) { v[i] -= mu; qq += v[i] * v[i]; }
          qq += shx(qq, 1, lane); qq += shx(qq, 2, lane);
          const float rs = __builtin_amdgcn_rsqf(qq * (1.0f / 128.0f) + LN_EPS);
          const float* gp = lg + gr * 128 + 32 * qu; const float* bp = lb_ + gr * 128 + 32 * qu;
#pragma unroll
          for (int i = 0; i < 4; ++i) { float f[8];
#pragma unroll
              for (int j = 0; j < 8; ++j) f[j] = v[8 * i + j] * rs * gp[8 * i + j] + bp[8 * i + j];
              *(LAS u32x4*)(lds + SG_VN + row * 272 + (32 * qu + 8 * i) * 2) = pack8(f); }
        }
        __syncthreads();
        const int nks = (wave < 4) ? 2 : 4;
        bf16x8 wf[4];
#pragma unroll
        for (int ks = 0; ks < 4; ++ks) wf[ks] = *(const bf16x8*)(Wm + ((size_t)(gr * 128 + 16 * wave + l15)) * 128 + 32 * ks + 8 * g);
        const size_t tok = t0 + 16 * wave + l15; const float bs = b_s[gr * 128 + 16 * wave + l15];
        unsigned vb0 = lb + SG_VN + (unsigned)(8 * g + q4) * 272u + (unsigned)(4 * p4) * 2u; asm volatile("" : "+v"(vb0));
#pragma unroll
        for (int ct = 0; ct < 8; ++ct) {
            f32x4 acc = (f32x4){0.f, 0.f, 0.f, 0.f};
#pragma unroll
            for (int ks = 0; ks < 4; ++ks) {
                if (ks < nks) {
                    const unsigned vrow = vb0 + (unsigned)(32 * ks * 272 + 32 * ct);
                    const bf16x8 va = cat8(vtr(vrow), vtr(vrow + 4u * 272u));
                    acc = __builtin_amdgcn_mfma_f32_16x16x32_bf16(va, wf[ks], acc, 0, 0, 0);
                }
            }
            const int col = gr * 128 + 16 * ct + 4 * g;
            const u32x2 uu = ucur[ct];
            u32x2 w; w.x = pk2(bflo(uu.x) * (acc[0] + bs), bfhi(uu.x) * (acc[1] + bs)); w.y = pk2(bflo(uu.y) * (acc[2] + bs), bfhi(uu.y) * (acc[3] + bs));
            *(u32x2*)(Y + tok * D + 512 + col) = w;
        }
    }
}
#undef SGU_FETCH

constexpr int AT_KPS = 1040, AT_VPS = 1088, AT_SLOT = 34816, AT_NSLOT = 3;
static_assert(AT_NSLOT * AT_SLOT <= LDSCTL_OFF, "attention LDS");
__device__ __forceinline__ void glds16(const void* gsrc, unsigned lds_dst) { unsigned keep;
    asm volatile("s_mov_b32 %0, m0\n\ts_mov_b32 m0, %2\n\ts_nop 0\n\tglobal_load_lds_dwordx4 %1, off\n\ts_mov_b32 m0, %0" : "=&s"(keep) : "v"(gsrc), "s"(lds_dst) : "memory"); }
__device__ __forceinline__ void attn_dma(unsigned lb, const char* kvb, int so, unsigned lane_off, int slot, int ps, int wave) {
#pragma unroll
    for (int j = 0; j < 4; ++j) { const int pi = 4 * wave + j, rlo = 32 * (pi >> 4) + (pi & 15);
        glds16(kvb + (size_t)(so + rlo * 8192) + lane_off, (unsigned)__builtin_amdgcn_readfirstlane((int)(lb + (unsigned)(slot * AT_SLOT + pi * ps)))); }
}
#define AT_WAITBAR(N) do { asm volatile("s_waitcnt vmcnt(" #N ") lgkmcnt(0)" ::: "memory"); __builtin_amdgcn_s_barrier(); asm volatile("" ::: "memory"); } while (0)
__device__ __forceinline__ void attn_phase(LAS unsigned char* lds, const bf16_t* Q, const bf16_t* KV, bf16_t* O, int layer, int bid, int G, int wave_s) {
    int tid_ = wave_s * 64 + pg8::lane_id(); asm volatile("" : "+v"(tid_)); const int tid = tid_, lane = tid & 63, wave = __builtin_amdgcn_readfirstlane(tid >> 6);
    const unsigned lb = (unsigned)(size_t)lds;
    const int r32 = lane & 31, hh = lane >> 5, q4 = (lane & 15) >> 2, p4 = lane & 3, blk = (lane >> 4) & 1;
    LAS unsigned char* kbase = lds + (r32 & 15) * AT_KPS + ((r32 >> 4) & 1) * 512 + hh * 16;
    unsigned vbase = lb + (unsigned)(4 * hh + q4) * (unsigned)AT_VPS + (unsigned)(16 * blk + 4 * p4) * 2u;
    unsigned lane_off = (unsigned)((lane >> 5) * 16 * 8192 + (lane & 31) * 16);
    asm volatile("" : "+v"(kbase), "+v"(vbase), "+v"(lane_off));
    const char* kvb = (const char*)KV;
    const int nun = (bid < 256) ? 4 * ((256 - bid + G - 1) / G) : 0;
#define AT_SRC(N, ST) ((int)((((size_t)(((bid + ((N) >> 2) * G) >> 5) * NMEM) * 4096 + layer * 2048 + ((N) & 3) * 256 + (((ST) >> 2) * 1024)) * 2) + ((ST) & 3) * 64 * 8192))
    __syncthreads();
    if (nun > 0) { attn_dma(lb, kvb, AT_SRC(0, 0), lane_off, 0, AT_KPS, wave); attn_dma(lb, kvb, AT_SRC(0, 1), lane_off, 1, AT_KPS, wave); AT_WAITBAR(4); }
    int sl = 0;
    for (int n = 0; n < nun; ++n) {
        const int pan = bid + (n >> 2) * G, h = n & 3, b = pan >> 5, qt = pan & 31;
        int ln_ = pg8::lane_id(); asm volatile("" : "+v"(ln_));
        const unsigned qoff = (unsigned)((wave * 16 * 64 + ln_) * 16);
        const char* qbase = (const char*)(Q + (size_t)(pan * 4 + h) * 65536);
        char* obase = (char*)O + ((size_t)b * SEQ + qt * 256) * D + h * 256;
        const bool more = (n + 1 < nun);
        bf16x8 qf[16];
#pragma unroll
        for (int s = 0; s < 16; ++s) qf[s] = *(const GAS bf16x8*)(qbase + qoff + 1024 * s);
        float ml = 0.f, lsum = 0.f;
        bf16x8 pk[8][2];
#pragma unroll
        for (int st = 0; st < 4; ++st) {
            const int sl2 = (sl >= 1) ? sl - 1 : 2;
            if (st > 0) attn_dma(lb, kvb, AT_SRC(n, st + 2), lane_off, sl2, (st + 2 < 4) ? AT_KPS : AT_VPS, wave);
            LAS unsigned char* kb = kbase + sl * AT_SLOT;
            f32x16 sa[2];
#pragma unroll
            for (int kt = 0; kt < 2; ++kt)
#pragma unroll
                for (int r = 0; r < 16; ++r) sa[kt][r] = 0.f;
            bf16x8 kfa[2], kfb[2];
#define AT_KLD(dst, S0) do { _Pragma("unroll") for (int kt = 0; kt < 2; ++kt) dst[kt] = *(const LAS bf16x8*)(kb + kt * 16 * AT_KPS + 32 * (S0)); } while (0)
#define AT_KMM(src, S0) do { _Pragma("unroll") for (int kt = 0; kt < 2; ++kt) sa[kt] = __builtin_amdgcn_mfma_f32_32x32x16_bf16(src[kt], qf[(S0)], sa[kt], 0, 0, 0); } while (0)
            AT_KLD(kfa, 0); __builtin_amdgcn_sched_barrier(0);
#pragma unroll
            for (int bq = 0; bq < 8; ++bq) {
                AT_KLD(kfb, 2 * bq + 1); __builtin_amdgcn_sched_barrier(0);
                AT_KMM(kfa, 2 * bq); __builtin_amdgcn_sched_barrier(0);
                if (bq < 7) { AT_KLD(kfa, 2 * bq + 2); __builtin_amdgcn_sched_barrier(0); }
                AT_KMM(kfb, 2 * bq + 1); __builtin_amdgcn_sched_barrier(0);
            }
#undef AT_KLD
#undef AT_KMM
            if (st == 0) attn_dma(lb, kvb, AT_SRC(n, 2), lane_off, sl2, AT_KPS, wave);
            if (st == 0) { float mx = -3.0e38f;
#pragma unroll
                for (int kt = 0; kt < 2; ++kt)
#pragma unroll
                    for (int r = 0; r < 16; ++r) mx = __builtin_fmaxf(mx, sa[kt][r]);
                mx = __builtin_fmaxf(mx, shx(mx, 32, lane)); ml = mx * LOG2E; }
#pragma unroll
            for (int kt = 0; kt < 2; ++kt) {
                float p[16];
#pragma unroll
                for (int r = 0; r < 16; ++r) { p[r] = __builtin_amdgcn_exp2f(sa[kt][r] * LOG2E - ml); lsum += p[r]; }
#pragma unroll
                for (int s2 = 0; s2 < 2; ++s2) { u32x4 w; w.x = pk2(p[8 * s2 + 0], p[8 * s2 + 1]); w.y = pk2(p[8 * s2 + 2], p[8 * s2 + 3]); w.z = pk2(p[8 * s2 + 4], p[8 * s2 + 5]); w.w = pk2(p[8 * s2 + 6], p[8 * s2 + 7]);
                    pk[2 * st + kt][s2] = __builtin_bit_cast(bf16x8, w); }
            }
            AT_WAITBAR(4);
            sl = (sl == 2) ? 0 : sl + 1;
        }
        lsum += shx(lsum, 32, lane);
        f32x16 oacc[8];
#pragma unroll
        for (int dt = 0; dt < 8; ++dt)
#pragma unroll
            for (int r = 0; r < 16; ++r) oacc[dt][r] = 0.f;
#pragma unroll
        for (int st = 4; st < 8; ++st) {
            const bool issue = (st < 6) || more;
            if (issue) { const int s2 = (sl >= 1) ? sl - 1 : 2;
                if (st < 6) attn_dma(lb, kvb, AT_SRC(n, st + 2), lane_off, s2, AT_VPS, wave); else attn_dma(lb, kvb, AT_SRC(n + 1, st - 6), lane_off, s2, AT_KPS, wave); }
            const unsigned vb = vbase + (unsigned)(sl * AT_SLOT);
            bf16x8 vfa[2], vfb[2];
#define AT_VLD(dst, BT) do { const unsigned va_ = vb + (unsigned)((((BT) >> 3) & 1) * 16 * AT_VPS + (((BT) >> 2) & 1) * 512 + ((BT) & 3) * 128); \
                _Pragma("unroll") for (int d_ = 0; d_ < 2; ++d_) dst[d_] = cat8(vtr(va_ + 64u * d_), vtr(va_ + 64u * d_ + 8u * AT_VPS)); } while (0)
#define AT_VMM(src, BT) do { _Pragma("unroll") for (int d_ = 0; d_ < 2; ++d_) oacc[2 * ((BT) & 3) + d_] = __builtin_amdgcn_mfma_f32_32x32x16_bf16(src[d_], pk[2 * (st - 4) + (((BT) >> 3) & 1)][((BT) >> 2) & 1], oacc[2 * ((BT) & 3) + d_], 0, 0, 0); } while (0)
            AT_VLD(vfa, 0); __builtin_amdgcn_sched_barrier(0);
#pragma unroll
            for (int bq = 0; bq < 8; ++bq) {
                AT_VLD(vfb, 2 * bq + 1); __builtin_amdgcn_sched_barrier(0);
                AT_VMM(vfa, 2 * bq); __builtin_amdgcn_sched_barrier(0);
                if (bq < 7) { AT_VLD(vfa, 2 * bq + 2); __builtin_amdgcn_sched_barrier(0); }
                AT_VMM(vfb, 2 * bq + 1); __builtin_amdgcn_sched_barrier(0);
            }
#undef AT_VLD
#undef AT_VMM
            if (issue) AT_WAITBAR(4); else AT_WAITBAR(0);
            sl = (sl == 2) ? 0 : sl + 1;
        }
        const float inv = 1.0f / lsum;
        int ln2 = pg8::lane_id(); asm volatile("" : "+v"(ln2));
        GAS char* op = (GAS char*)obase + (unsigned)((wave * 32 + (ln2 & 31)) * D) + ((ln2 >> 5) ? 16 : 0);
        const float sc = inv * pg8::F8_SO;
#pragma unroll
        for (int dt = 0; dt < 8; ++dt) {
            unsigned dw[4];
#pragma unroll
            for (int g4 = 0; g4 < 4; ++g4) dw[g4] = pg8::pk4f8(oacc[dt][4 * g4 + 0] * sc, oacc[dt][4 * g4 + 1] * sc, oacc[dt][4 * g4 + 2] * sc, oacc[dt][4 * g4 + 3] * sc);
            { const auto r = __builtin_amdgcn_permlane32_swap(dw[0], dw[2], false, false); dw[0] = r[0]; dw[2] = r[1]; }
            { const auto r = __builtin_amdgcn_permlane32_swap(dw[1], dw[3], false, false); dw[1] = r[0]; dw[3] = r[1]; }
            u32x4 w; w.x = dw[0]; w.y = dw[2]; w.z = dw[1]; w.w = dw[3];
            *(GAS u32x4*)(op + 32 * dt) = w; }
    }
    asm volatile("s_waitcnt vmcnt(0)" ::: "memory");
    __syncthreads();
}
#undef AT_SRC
#undef AT_WAITBAR

constexpr int RT_WH = 0, RT_WL = 32768, RT_SEL = 65536, RT_RK = 66048, RT_CNTW = 67072, RT_WBASE = 67584;
template <int MODE>
__device__ __forceinline__ void ln_phase(LAS unsigned char* lds, const Args& a, int l, int lnidx, bool last, bf16_t* Xout, int bid, int G, int wave_s) {
    int tid_ = wave_s * 64 + pg8::lane_id(); asm volatile("" : "+v"(tid_)); const int tid = tid_, lane = tid & 63, wave = __builtin_amdgcn_readfirstlane(tid >> 6);
    constexpr int R = (MODE == 2) ? 2 : 4;
    unsigned char* ws = a.ws;
    const bf16_t* Z = (const bf16_t*)(ws + WS_R + R_Z); const bf16_t* X = (const bf16_t*)(ws + WS_X); const bf16_t* Ys = (const bf16_t*)(ws + WS_R + R_XS);
    const float* gp = a.in[20] + (size_t)(l * 3 + lnidx) * D; const float* bp = a.in[21] + (size_t)(l * 3 + lnidx) * D;
    float gg[16], bb[16];
#pragma unroll
    for (int j = 0; j < 2; ++j)
#pragma unroll
        for (int i = 0; i < 8; ++i) { gg[8 * j + i] = gp[8 * lane + 512 * j + i]; bb[8 * j + i] = bp[8 * lane + 512 * j + i]; }
    if (MODE == 1) {
        __syncthreads();
        for (int idx = tid; idx < 2048; idx += NTHR) { const int s = idx >> 6, ln = idx & 63, e = ln & 15, g = ln >> 4; float hi[8], lo[8];
#pragma unroll
            for (int j = 0; j < 8; ++j) { const float w = a.in[15][(32 * s + 8 * g + j) * 16 + e]; const float h = bflo(pk2(w, 0.f) & 0xffffu); hi[j] = h; lo[j] = w - h; }
            *(LAS u32x4*)(lds + RT_WH + idx * 16) = pack8(hi); *(LAS u32x4*)(lds + RT_WL + idx * 16) = pack8(lo); }
        __syncthreads();
    }
    for (int blk = bid; blk < 256; blk += G) {
        int run[16];
#pragma unroll
        for (int e = 0; e < 16; ++e) run[e] = 0;
        u32x4 pa_[R][2], pb_[R][2], pc_[R][2]; float pw0[R], pw1[R];
#define LN_LOAD(ROW0) do { _Pragma("unroll") for (int r = 0; r < R; ++r) { const size_t row = (ROW0) + r; \
            if (MODE == 2) { const int* ts = (const int*)(ws + WS_TSLOT) + row * 2; const float* ti = (const float*)(ws + WS_TINFO) + row * 4; const int s0 = ts[0], s1 = ts[1]; pw0[r] = ti[2]; pw1[r] = ti[3]; \
                _Pragma("unroll") for (int j = 0; j < 2; ++j) { pa_[r][j] = *(const u32x4*)(X + row * D + 8 * lane + 512 * j); pb_[r][j] = *(const u32x4*)(Ys + (size_t)s0 * D + 8 * lane + 512 * j); pc_[r][j] = *(const u32x4*)(Ys + (size_t)s1 * D + 8 * lane + 512 * j); } } \
            else { _Pragma("unroll") for (int j = 0; j < 2; ++j) pa_[r][j] = *(const u32x4*)(Z + row * D + 8 * lane + 512 * j); } } } while (0)
        LN_LOAD((size_t)blk * 256 + wave * 32);
        for (int ri = 0; ri < 32; ri += R) {
            const int rl0 = wave * 32 + ri; const size_t row0 = (size_t)blk * 256 + rl0;
            float v[R][16];
#pragma unroll
            for (int r = 0; r < R; ++r)
#pragma unroll
                for (int j = 0; j < 2; ++j) { float x[8]; unpack8(pa_[r][j], x);
                    if (MODE == 2) { float y0[8], y1[8]; unpack8(pb_[r][j], y0); unpack8(pc_[r][j], y1);
#pragma unroll
                        for (int i = 0; i < 8; ++i) v[r][8 * j + i] = ALPHA * x[i] + pw0[r] * y0[i] + pw1[r] * y1[i]; }
                    else {
#pragma unroll
                        for (int i = 0; i < 8; ++i) v[r][8 * j + i] = x[i]; } }
            if (ri + R < 32) LN_LOAD(row0 + R);
            float s[R];
#pragma unroll
            for (int r = 0; r < R; ++r) { s[r] = 0.f;
#pragma unroll
                for (int i = 0; i < 16; ++i) s[r] += v[r][i]; }
#pragma unroll
            for (int o = 1; o < 64; o <<= 1)
#pragma unroll
                for (int r = 0; r < R; ++r) s[r] += shx(s[r], o, lane);
            float qq[R];
#pragma unroll
            for (int r = 0; r < R; ++r) { const float mu = s[r] * (1.0f / D); qq[r] = 0.f;
#pragma unroll
                for (int i = 0; i < 16; ++i) { v[r][i] -= mu; qq[r] += v[r][i] * v[r][i]; } }
#pragma unroll
            for (int o = 1; o < 64; o <<= 1)
#pragma unroll
                for (int r = 0; r < R; ++r) qq[r] += shx(qq[r], o, lane);
#pragma unroll
            for (int r = 0; r < R; ++r) { const float rs = __builtin_amdgcn_rsqf(qq[r] * (1.0f / D) + LN_EPS);
#pragma unroll
                for (int i = 0; i < 16; ++i) v[r][i] = v[r][i] * rs * gg[i] + bb[i]; }
#pragma unroll
            for (int r = 0; r < R; ++r) { const size_t row = row0 + r;
                if (MODE == 2 && last) {
#pragma unroll
                    for (int j = 0; j < 2; ++j) { float* op = a.out + row * D + 8 * lane + 512 * j;
                        *(f32x4*)op = (f32x4){v[r][8 * j], v[r][8 * j + 1], v[r][8 * j + 2], v[r][8 * j + 3]}; *(f32x4*)(op + 4) = (f32x4){v[r][8 * j + 4], v[r][8 * j + 5], v[r][8 * j + 6], v[r][8 * j + 7]}; }
                } else {
#pragma unroll
                    for (int j = 0; j < 2; ++j) { float f[8];
#pragma unroll
                        for (int i = 0; i < 8; ++i) f[i] = v[r][8 * j + i];
                        *(u32x4*)(Xout + row * D + 8 * lane + 512 * j) = pack8(f);
                        if (MODE == 1 || MODE == 2) { u32x2 q8; q8.x = pg8::pk4f8(f[0] * pg8::F8_SX, f[1] * pg8::F8_SX, f[2] * pg8::F8_SX, f[3] * pg8::F8_SX); q8.y = pg8::pk4f8(f[4] * pg8::F8_SX, f[5] * pg8::F8_SX, f[6] * pg8::F8_SX, f[7] * pg8::F8_SX);
                            *(u32x2*)(ws + (MODE == 1 ? WS_R + R_X8 : WS_X8IN) + row * D + 8 * lane + 512 * j) = q8; } }
                } }
            if (MODE == 1 && ((ri + R) & 15) == 0) {
                asm volatile("s_waitcnt vmcnt(0)" ::: "memory");
                const int tok = lane & 15, g = lane >> 4, tl = rl0 + R - 16 + tok; const size_t token = (size_t)blk * 256 + tl;
                const bf16_t* xr = Xout + token * D + 8 * g;
                f32x4 acc = (f32x4){0.f, 0.f, 0.f, 0.f};
#pragma unroll 8
                for (int ks = 0; ks < 32; ++ks) { const bf16x8 xb = *(const bf16x8*)(xr + 32 * ks);
                    const bf16x8 wh = *(const LAS bf16x8*)(lds + RT_WH + (ks * 64 + lane) * 16), wl = *(const LAS bf16x8*)(lds + RT_WL + (ks * 64 + lane) * 16);
                    acc = __builtin_amdgcn_mfma_f32_16x16x32_bf16(wh, xb, acc, 0, 0, 0); acc = __builtin_amdgcn_mfma_f32_16x16x32_bf16(wl, xb, acc, 0, 0, 0); }
                const f32x4 brv = *(const f32x4*)(a.in[16] + 4 * g);
                float lg[4] = {acc[0] + brv[0], acc[1] + brv[1], acc[2] + brv[2], acc[3] + brv[3]};
                float m = __builtin_fmaxf(__builtin_fmaxf(lg[0], lg[1]), __builtin_fmaxf(lg[2], lg[3]));
                m = __builtin_fmaxf(m, shx(m, 16, lane)); m = __builtin_fmaxf(m, shx(m, 32, lane));
                float t1 = -1.f, t2 = -1.f; int i1 = 0, i2 = 0;
#pragma unroll
                for (int r = 0; r < 4; ++r) { const float p = __expf(lg[r] - m); if (p > t1) { t2 = t1; i2 = i1; t1 = p; i1 = r; } else if (p > t2) { t2 = p; i2 = r; } }
                const float gs = t1 + t2; float bgs = gs; int bg = g;
                { const float o = shx(bgs, 16, lane); const int og = shxi(bg, 16, lane); if (o > bgs || (o == bgs && og < bg)) { bgs = o; bg = og; } }
                { const float o = shx(bgs, 32, lane); const int og = shxi(bg, 32, lane); if (o > bgs || (o == bgs && og < bg)) { bgs = o; bg = og; } }
                const bool mine = (bg == g); const int e0 = 4 * g + i1, e1 = 4 * g + i2;
                if (mine) { u32x4 info; info.x = (unsigned)e0; info.y = (unsigned)e1; info.z = __builtin_bit_cast(unsigned, t1 / gs); info.w = __builtin_bit_cast(unsigned, t2 / gs);
                    *(u32x4*)(ws + WS_TINFO + token * 16) = info; ((LAS unsigned short*)(lds + RT_SEL))[tl] = (unsigned short)(e0 | (e1 << 8)); }
                const unsigned long long below = (1ull << lane) - 1ull; int r0 = 0, r1 = 0;
#pragma unroll
                for (int e = 0; e < 16; ++e) { const bool hit = mine && (e0 == e || e1 == e); const unsigned long long mb = __ballot(hit); const int cb = __popcll(mb & below);
                    r0 = (e0 == e) ? run[e] + cb : r0; r1 = (e1 == e) ? run[e] + cb : r1; run[e] += __popcll(mb); }
                if (mine) { ((LAS unsigned short*)(lds + RT_RK))[2 * tl] = (unsigned short)r0; ((LAS unsigned short*)(lds + RT_RK))[2 * tl + 1] = (unsigned short)r1; }
            }
        }
        if (MODE == 1) {
            { int vsel = 0;
#pragma unroll
              for (int e = 0; e < 16; ++e) vsel = (lane == e) ? run[e] : vsel;
              if (lane < 16) ((LAS int*)(lds + RT_CNTW))[wave * 16 + lane] = vsel; }
            __syncthreads();
            if (tid < 16) { int base = 0;
#pragma unroll
                for (int w = 0; w < 8; ++w) { const int t = ((LAS int*)(lds + RT_CNTW))[w * 16 + tid]; ((LAS int*)(lds + RT_WBASE))[w * 16 + tid] = base; base += t; }
                ((int*)(ws + WS_WGCNT))[blk * 16 + tid] = base; }
            __syncthreads();
            { const int t = tid >> 1, k = tid & 1; const int e = (((LAS unsigned short*)(lds + RT_SEL))[t] >> (8 * k)) & 255;
              ((int*)(ws + WS_TRANK))[(size_t)blk * 512 + tid] = (int)((LAS unsigned short*)(lds + RT_RK))[tid] + ((LAS int*)(lds + RT_WBASE))[(t >> 5) * 16 + e]; }
            __syncthreads();
        }
    }
}

#undef LN_LOAD
constexpr int MG_TBL = 0, MG_TOT = 16384, MG_PRE = 16448, MG_BASE = 16512;
__device__ __forceinline__ void moe_gather_phase(LAS unsigned char* lds, unsigned char* ws, int bid, int G, int wave_s) {
    int tid_ = wave_s * 64 + pg8::lane_id(); asm volatile("" : "+v"(tid_)); const int tid = tid_, lane = tid & 63, wave = __builtin_amdgcn_readfirstlane(tid >> 6);
    LAS int* tbl = (LAS int*)(lds + MG_TBL); LAS int* tot = (LAS int*)(lds + MG_TOT); LAS int* pre = (LAS int*)(lds + MG_PRE); LAS int* base = (LAS int*)(lds + MG_BASE);
    LAS int* offs = (LAS int*)(lds + MISC_OFF) + 16; LAS int* tile_e = (LAS int*)(lds + TILEE_OFF);
    const bf16_t* X = (const bf16_t*)(ws + WS_X); bf16_t* Xs = (bf16_t*)(ws + WS_R + R_XS);
    for (int blk = bid; blk < 256; blk += G) {
        __syncthreads();
        for (int i = tid; i < 4096; i += NTHR) tbl[i] = ((const int*)(ws + WS_WGCNT))[i];
        __syncthreads();
        if (tid < 16) { int t = 0, p = 0; for (int c = 0; c < 256; ++c) { const int v = tbl[c * 16 + tid]; p += (c < blk) ? v : 0; t += v; } tot[tid] = t; pre[tid] = p; }
        __syncthreads();
        if (tid == 0) { int o = 0; for (int e = 0; e < 16; ++e) { offs[e] = o; base[e] = o + pre[e]; o += (tot[e] + 255) & ~255; } offs[16] = o; offs[17] = o >> 8; }
        __syncthreads();
        for (int rt = tid; rt < 528; rt += NTHR) { int e = 0;
#pragma unroll
            for (int q = 1; q < 16; ++q) e = (rt * 256 >= offs[q]) ? q : e;
            tile_e[rt] = e; }
        { const size_t tok = (size_t)blk * 256 + (tid >> 1); const int k = tid & 1;
          const int e = ((const int*)(ws + WS_TINFO))[tok * 4 + k]; const int rk = ((const int*)(ws + WS_TRANK))[tok * 2 + k];
          const int slot = base[e] + rk;
          ((int*)(ws + WS_TSLOT))[tok * 2 + k] = slot; ((int*)(ws + WS_SRCROW))[slot] = (int)tok; }
        for (int e = wave; e < 16; e += NWAVES) { const int npad = offs[e + 1] - offs[e] - tot[e];
            if (blk < npad && lane == 0) ((int*)(ws + WS_SRCROW))[offs[e] + tot[e] + blk] = 0; }
    }
}

#define GEMM_ALIGN true
#define GEMM_SP2 true
__global__ void __launch_bounds__(NTHR, 2) mk_fwd(Args args) {
    extern __shared__ __attribute__((aligned(16))) unsigned char lds_raw[];
    LAS unsigned char* lds = (LAS unsigned char*)lds_raw;
    const int tid = threadIdx.x; const int wave_s = __builtin_amdgcn_readfirstlane(tid >> 6);
    const int G = gridDim.x, bid = blockIdx.x;
    unsigned char* ws = args.ws;
    volatile LAS unsigned* MISC = (volatile LAS unsigned*)(lds + MISC_OFF);
    for (int u = tid; u < (LDS_BYTES - LDSCTL_OFF) / 4; u += NTHR) ((LAS unsigned*)(lds + LDSCTL_OFF))[u] = 0u;
    __syncthreads();
    XcdBarrier bar = xcd_barrier_post((unsigned*)(ws + WS_CTL) + CW_BAR, MISC + 8);
    bar.wv = wave_s;
#define GRID_BAR() xcd_barrier(bar)
#ifndef REP_MASK
#define REP_MASK 0
#endif
#define LOCAL_SYNC() do { asm volatile("s_waitcnt vmcnt(0)" ::: "memory"); __syncthreads(); } while (0)
#define PHASE(grp, ...) do { __VA_ARGS__; if (REP_MASK & (1 << (grp))) { GRID_BAR(); __VA_ARGS__; } } while (0)

#define WSQ ({ unsigned char* w_ = args.ws; asm volatile("" : "+s"(w_)); w_; })
#define X ((bf16_t*)(WSQ + WS_X))
#define P ((bf16_t*)(WSQ + WS_R + R_P))
#define Y ((bf16_t*)(WSQ + WS_R + R_Y))
#define Z ((bf16_t*)(WSQ + WS_R + R_Z))
#define Qb ((bf16_t*)(WSQ + WS_R + R_Q))
#define Ob ((bf16_t*)(WSQ + WS_R + R_O))
#define Xs ((bf16_t*)(WSQ + WS_R + R_XS))
#define Hb ((bf16_t*)(WSQ + WS_R + R_H))
#define KV ((bf16_t*)(WSQ + WS_KV))
#define wl (WSQ + WS_W + (size_t)l * W_LAYER)

    PHASE(0, p0_convert(args, lds, bid, G, wave_s));
    GRID_BAR();
    { const int tid_r = wave_s * 64 + pg8::lane_id();
      for (int i = bid * NTHR + tid_r; i < 2 * 2 * 1024; i += G * NTHR) { const int l = i >> 11, w = (i >> 10) & 1, n = i & 1023; const float* tb = (const float*)(WSQ + WS_CS) + (size_t)l * 2 * 16 * 1024 + w * 16 * 1024; float s = 0.f;
#pragma unroll
          for (int kc = 0; kc < 16; ++kc) s += tb[kc * 1024 + n];
          ((float*)(WSQ + WS_CS) + 65536)[i] = s; } }
    PHASE(1, { pg8::Gemm g{(const bf16_t*)(WSQ + WS_MEMB), (const bf16_t*)(WSQ + WS_WKV), MKV, 4096, D, wave_s}; pg8::StaticOrder S; S.init(MKV, 4096, G, bid);
      pg8::EpiPlain E{KV, 4096, 0xffff};
      pg8::gemm_phase<pg8::EpiPlain, pg8::StaticOrder, GEMM_ALIGN, GEMM_SP2>(lds, g, S, E); });

#pragma unroll 1
    for (int l = 0; l < 2; ++l) {
        PHASE(1, { pg8::Gemm g{(const bf16_t*)(WSQ + WS_X8IN), (const bf16_t*)(wl + W_IN), M, NP, D / 2, wave_s}; pg8::StaticOrder S; S.init(M, NP, G, bid);
          pg8::EpiInProj8 E{P, args.in[4] + l * 256};
          pg8::gemm_phase<pg8::EpiInProj8, pg8::StaticOrder, GEMM_ALIGN, GEMM_SP2>(lds, g, S, E); });
        GRID_BAR();
        PHASE(3, gla_phase<false>(lds, P, (float*)(WSQ + WS_SEND), (float*)(WSQ + WS_LTOT), Y, args.in[5] + l * 512, bid, G, wave_s));
        PHASE(4, sgu_phase(lds, P, (const bf16_t*)(WSQ + WS_WM) + (size_t)l * 4 * 128 * 128, args.in[7] + l * 512, args.in[8] + l * 512, args.in[9] + l * 512, Y, bid, G, wave_s));
        GRID_BAR();
        PHASE(3, gla_phase<true>(lds, P, (float*)(WSQ + WS_SEND), (float*)(WSQ + WS_LTOT), Y, args.in[5] + l * 512, bid, G, wave_s));
        GRID_BAR();
        PHASE(10, { pg8::Gemm g{Y, (const bf16_t*)(wl + W_OUT), M, D, D, wave_s}; pg8::PanelOrder S{4, M / 256, G, bid};
          pg8::EpiResidStats E{X, Z, (pg8::f32x2_t*)(WSQ + WS_PART)};
          pg8::gemm_phase<pg8::EpiResidStats, pg8::PanelOrder, GEMM_ALIGN, GEMM_SP2>(lds, g, S, E); });
        { const int tid_r = wave_s * 64 + pg8::lane_id();
          for (int pan = bid; pan < 256; pan += G) if (tid_r < 256) { const size_t row = (size_t)pan * 256 + tid_r; const pg8::f32x2_t* pp = (const pg8::f32x2_t*)(WSQ + WS_PART) + row * 16; float s1 = 0.f, s2 = 0.f;
#pragma unroll
              for (int q = 0; q < 16; ++q) { const pg8::f32x2_t v = pp[q]; s1 += v[0]; s2 += v[1]; }
              const float mu = s1 * (1.0f / D), var = s2 * (1.0f / D) - mu * mu; ((pg8::f32x2_t*)(WSQ + WS_STATS))[row] = (pg8::f32x2_t){mu, __builtin_amdgcn_rsqf(var + LN_EPS)}; } }
        LOCAL_SYNC();
        PHASE(10, { pg8::Gemm g{Z, (const bf16_t*)(wl + W_Q), M, D, D, wave_s}; pg8::PanelOrder S{4, M / 256, G, bid};
          pg8::EpiQFragLN E{Qb, (const pg8::f32x2_t*)(WSQ + WS_STATS), (const float*)(WSQ + WS_CS) + 65536 + l * 2048, (const float*)(WSQ + WS_CS) + 65536 + l * 2048 + 1024};
          pg8::gemm_phase<pg8::EpiQFragLN, pg8::PanelOrder, GEMM_ALIGN, GEMM_SP2>(lds, g, S, E); });
        PHASE(5, attn_phase(lds, Qb, KV, Ob, l, bid, G, wave_s));
        LOCAL_SYNC();
        PHASE(10, { pg8::Gemm g{Ob, (const bf16_t*)(wl + W_O), M, D, D / 2, wave_s}; pg8::PanelOrder S{4, M / 256, G, bid};
          pg8::EpiResidLN8 E{Z, (const pg8::f32x2_t*)(WSQ + WS_STATS), args.in[20] + (size_t)(l * 3) * D, args.in[21] + (size_t)(l * 3) * D};
          pg8::gemm_phase<pg8::EpiResidLN8, pg8::PanelOrder, GEMM_ALIGN, GEMM_SP2>(lds, g, S, E); });
        PHASE(9, ln_phase<1>(lds, args, l, 1, false, X, bid, G, wave_s));
        GRID_BAR();
        PHASE(7, moe_gather_phase(lds, WSQ, bid, G, wave_s));
        GRID_BAR();
        PHASE(2, { pg8::Gemm g{(const bf16_t*)(WSQ + WS_R + R_X8), (const bf16_t*)(wl + W_GU), MOE_ROWS, 16384, D / 2, wave_s}; pg8::MoeGatherOrder S{(const LAS int*)(lds + TILEE_OFF), (int)MISC[33] * 4, G, bid, (const int*)(WSQ + WS_SRCROW)};
          pg8::EpiGU8 E{(unsigned char*)Hb};
          pg8::gemm_phase<pg8::EpiGU8, pg8::MoeGatherOrder, GEMM_ALIGN, GEMM_SP2>(lds, g, S, E); });
        GRID_BAR();
        PHASE(2, { pg8::Gemm g{Hb, (const bf16_t*)(wl + W_D), MOE_ROWS, 16384, 256, wave_s}; pg8::MoeOrder S{(const LAS int*)(lds + TILEE_OFF), (int)MISC[33] * 4, G, bid};
          pg8::EpiPlain8 E{Xs, D, 3};
          pg8::gemm_phase<pg8::EpiPlain8, pg8::MoeOrder, GEMM_ALIGN, GEMM_SP2>(lds, g, S, E); });
        GRID_BAR();
        if (REP_MASK & (1 << 8)) { ln_phase<2>(lds, args, l, 2, l == 1, Z, bid, G, wave_s); GRID_BAR(); }
        ln_phase<2>(lds, args, l, 2, l == 1, X, bid, G, wave_s);
        if (l == 0) GRID_BAR();
    }
}
#undef X
#undef P
#undef Y
#undef Z
#undef Qb
#undef Ob
#undef Xs
#undef Hb
#undef KV
#undef wl
}

extern "C" void kernel_launch(void* const* d_in, const int* in_sizes, int n_in, void* d_out, int out_size, void* d_ws, size_t ws_size, hipStream_t stream) {
    using namespace mk;
    static int grid = 0;
    if (grid == 0) {
        if (n_in != 22 || in_sizes[0] != M * D || out_size != M * D || ws_size < WS_END) { fprintf(stderr, "kernel_launch: unexpected shapes (n_in %d, in0 %d, out %d, ws %zu, need %zu)\n", n_in, n_in > 0 ? in_sizes[0] : -1, out_size, ws_size, (size_t)WS_END); grid = -1; return; }
        int dev = 0, cus = 0;
        if (hipGetDevice(&dev) != hipSuccess || hipDeviceGetAttribute(&cus, hipDeviceAttributeMultiprocessorCount, dev) != hipSuccess) { grid = -1; return; }
        if (hipFuncSetAttribute((const void*)mk_fwd, hipFuncAttributeMaxDynamicSharedMemorySize, LDS_BYTES) != hipSuccess) { fprintf(stderr, "kernel_launch: hipFuncSetAttribute failed\n"); grid = -1; return; }
        int per_cu = 0;
        if (hipOccupancyMaxActiveBlocksPerMultiprocessor(&per_cu, (const void*)mk_fwd, NTHR, LDS_BYTES) != hipSuccess || per_cu < 1) fprintf(stderr, "kernel_launch: occupancy query says %d\n", per_cu);
        (void)hipGetLastError();
        grid = cus;
    }
    if (grid < 0) return;
    if (hipMemsetAsync((char*)d_ws + WS_CTL, 0, CTL_ZERO_BYTES, stream) != hipSuccess) return;
    Args a{};
    for (int i = 0; i < 22; ++i) a.in[i] = (const float*)d_in[i];
    a.out = (float*)d_out; a.ws = (unsigned char*)d_ws;
    hipLaunchKernelGGL(mk_fwd, dim3(grid), dim3(NTHR), LDS_BYTES, stream, a);
}
```

```cpp
#include <hip/hip_runtime.h>
#include <cstdio>
#include <cstdint>

namespace pg8 {
#define PG8_LAS __attribute__((address_space(3)))
typedef unsigned short bf16_t;
typedef short bf16x8 __attribute__((ext_vector_type(8)));
typedef float f32x4 __attribute__((ext_vector_type(4)));
typedef unsigned u32x4 __attribute__((ext_vector_type(4)));
typedef unsigned u32x2 __attribute__((ext_vector_type(2)));
constexpr int BM = 256, BK = 64, HALF = 128, HTB = HALF * BK * 2  , STAGE_BYTES = 8 * HTB, NXCD = 8, WGM = 8;

__host__ __device__ __forceinline__ int lds_byte(int r, int c) { const int st = (r >> 4) * 2 + (c >> 5), rr = r & 15, cc = c & 31, ob = rr * 64 + cc * 2; return st * 1024 + (ob ^ (((ob >> 9) & 1) << 5)); }
__host__ __device__ __forceinline__ void stage_rc(int b, int& R, int& C) { const int st = b / 1024, sb = b % 1024, swz = sb ^ (((sb >> 9) & 1) << 5); R = (st >> 1) * 16 + swz / 64; C = (st & 1) * 32 + (swz % 64) / 2; }
__host__ __device__ __forceinline__ int perm32(int rho) { const int n = rho >> 4, i = rho & 15; return 8 * (i >> 2) + 4 * n + (i & 3); }

struct Unit { int pm, pn; };
struct Gemm { const bf16_t* A; const bf16_t* Bt; int M, N, K; int wv; };
__device__ __forceinline__ int lane_id() { int l; asm volatile("v_mbcnt_lo_u32_b32 %0, -1, 0\n\tv_mbcnt_hi_u32_b32 %0, -1, %0" : "=v"(l)); return l; }

struct StaticOrder {
    static constexpr bool GATHER = false;
    int nM, nN, nwg, G, c; const int* src = nullptr;
    __host__ __device__ void init(int M, int N, int G_, int c_) { nM = M / BM; nN = N / BM; nwg = nM * nN; G = G_; c = c_; }
    __host__ __device__ bool next(int i, Unit& u) const {
        const long L = (long)i * G + c; if (L >= nwg) return false;
        int wgid = (int)L; { const int q = nwg / NXCD, r = nwg % NXCD, xcd = wgid % NXCD, off = wgid / NXCD; wgid = (xcd < r ? xcd * (q + 1) : r * (q + 1) + (xcd - r) * q) + off; }
        const int nig = WGM * nN, gid = wgid / nig, fm = gid * WGM, gsz = (nM - fm) < WGM ? (nM - fm) : WGM;
        u.pm = fm + ((wgid % nig) % gsz); u.pn = (wgid % nig) / gsz; return true;
    }
    __device__ __forceinline__ void a_ready(const Unit&) const {}
    __device__ __forceinline__ void done(const Unit&) const {}
};
struct PanelOrder {
    static constexpr bool GATHER = false;
    int nN, npan, G, c; const int* src = nullptr;
    __device__ __forceinline__ bool next(int i, Unit& u) const { const int p = c + (i / nN) * G; if (p >= npan) return false; u.pm = p; u.pn = i % nN; return true; }
    __device__ __forceinline__ void a_ready(const Unit&) const {}
    __device__ __forceinline__ void done(const Unit&) const {}
};
template <bool GATH_> struct MoeOrderT {
    static constexpr bool GATHER = GATH_;
    const PG8_LAS int* tile_e; int nunits, G, c; const int* src = nullptr;
    __device__ __forceinline__ bool next(int i, Unit& u) const {
        const int cc = ((G & 7) == 0) ? (c & 7) * (G >> 3) + (c >> 3) : c;
        const int L = i * G + cc; if (L >= nunits) return false;
        u.pm = L >> 2; u.pn = tile_e[L >> 2] * 4 + (L & 3); return true;
    }
    __device__ __forceinline__ void a_ready(const Unit&) const {}
    __device__ __forceinline__ void done(const Unit&) const {}
};
typedef MoeOrderT<false> MoeOrder; typedef MoeOrderT<true> MoeGatherOrder;

typedef float f32x2_t __attribute__((ext_vector_type(2))); typedef __bf16 bf16x2_t __attribute__((ext_vector_type(2)));
typedef __amdgpu_buffer_rsrc_t rsrc_t;
__device__ __forceinline__ rsrc_t mk_rsrc(const void* p) { return __builtin_amdgcn_make_buffer_rsrc((void*)p, 0, 0x7fffffff, 0x00020000); }
__device__ __forceinline__ u32x4 bld4(rsrc_t r, unsigned voff, unsigned soff) { return __builtin_bit_cast(u32x4, __builtin_amdgcn_raw_buffer_load_b128(r, voff, soff, 0)); }
__device__ __forceinline__ f32x2_t bld2f(rsrc_t r, unsigned voff, unsigned soff) { return __builtin_bit_cast(f32x2_t, __builtin_amdgcn_raw_buffer_load_b64(r, voff, soff, 0)); }
#define GST4(p) (*(__attribute__((address_space(1))) u32x4*)(p))
__device__ __forceinline__ float f8clamp(float x) { return __builtin_fminf(__builtin_fmaxf(x, -448.0f), 448.0f); }
__device__ __forceinline__ unsigned pk4f8(float a, float b, float c, float d) { int w = 0; w = __builtin_amdgcn_cvt_pk_fp8_f32(f8clamp(a), f8clamp(b), w, false); w = __builtin_amdgcn_cvt_pk_fp8_f32(f8clamp(c), f8clamp(d), w, true); return (unsigned)w; }
constexpr float F8_SX = 4.0f, F8_SW = 64.0f, F8_SH = 8.0f, F8_SO = 64.0f, F8_SY = 16.0f;
__device__ __forceinline__ unsigned pk2(float lo, float hi) { f32x2_t v = {lo, hi}; bf16x2_t b = __builtin_convertvector(v, bf16x2_t); return __builtin_bit_cast(unsigned, b); }
__device__ __forceinline__ float bflo(unsigned w) { return __builtin_bit_cast(float, w << 16); }
__device__ __forceinline__ float bfhi(unsigned w) { return __builtin_bit_cast(float, w & 0xffff0000u); }
__device__ __forceinline__ float f_silu(float x) { return x * __builtin_amdgcn_rcpf(1.0f + __builtin_amdgcn_exp2f(-1.4426950408889634f * x)); }
__device__ __forceinline__ float f_gelu_tanh(float x) { return x * __builtin_amdgcn_rcpf(1.0f + __builtin_amdgcn_exp2f(x * (-2.3022082f - 0.10294324f * x * x))); }
__device__ __forceinline__ float f_logsig16(float z) { const float t = __builtin_amdgcn_exp2f(-1.4426950408889634f * __builtin_fabsf(z)); return (__builtin_fminf(z, 0.0f) - 0.6931471805599453f * __builtin_amdgcn_logf(1.0f + t)) * 0.0625f; }

struct EpiPlain {
    static constexpr bool PERM = true, AFTER_DRAIN = false;
    bf16_t* O; int ldc; int cmask;
    __device__ __forceinline__ void operator()(const f32x4 (&acc)[2][2][4][2], const Unit& u, int wr, int wc, int fr, int fq) const {
        const int row0 = u.pm * BM + wr * 64 + fr, col0 = (u.pn & cmask) * BM + wc * 32 + 8 * fq;
#pragma unroll
        for (int ai = 0; ai < 2; ++ai)
#pragma unroll
            for (int m = 0; m < 4; ++m) { bf16_t* rowp = O + (size_t)(row0 + ai * HALF + m * 16) * ldc + col0;
#pragma unroll
                for (int bj = 0; bj < 2; ++bj) { const f32x4 v0 = acc[ai][bj][m][0], v1 = acc[ai][bj][m][1];
                    u32x4 w; w.x = pk2(v0[0], v0[1]); w.y = pk2(v0[2], v0[3]); w.z = pk2(v1[0], v1[1]); w.w = pk2(v1[2], v1[3]);
                    *(u32x4*)(rowp + bj * HALF) = w; } }
    }
};
struct EpiQFrag {
    static constexpr bool PERM = true, AFTER_DRAIN = false;
    bf16_t* O;
    __device__ __forceinline__ void operator()(const f32x4 (&acc)[2][2][4][2], const Unit& u, int wr, int wc, int fr, int fq) const {
        unsigned lo = (unsigned)(((fq >> 1) * 64 + fr + 32 * (fq & 1)) * 16); asm volatile("" : "+v"(lo));
        char* tile = (char*)(O + (size_t)(u.pm * 4 + u.pn) * 65536) + (size_t)(wr * 2 * 16 + wc * 2) * 1024 + lo;
#pragma unroll
        for (int ai = 0; ai < 2; ++ai)
#pragma unroll
            for (int m = 0; m < 4; ++m)
#pragma unroll
                for (int bj = 0; bj < 2; ++bj) { const f32x4 v0 = acc[ai][bj][m][0], v1 = acc[ai][bj][m][1];
                    u32x4 w; w.x = pk2(v0[0], v0[1]); w.y = pk2(v0[2], v0[3]); w.z = pk2(v1[0], v1[1]); w.w = pk2(v1[2], v1[3]);
                    *(u32x4*)(tile + ((4 * ai + (m >> 1)) * 16 + 8 * bj) * 1024 + (m & 1) * 256) = w; }
    }
};
struct EpiInProj {
    static constexpr bool PERM = true, AFTER_DRAIN = false;
    bf16_t* O; const float* b_a;
    template <int MODE> __device__ __forceinline__ void tile(const f32x4 (&acc)[2][2][4][2], const Unit& u, int wr, int wc, int fr, int fq) const {
        const int row0 = u.pm * BM + wr * 64 + fr, col0 = u.pn * BM + wc * 32 + 8 * fq;
        f32x4 bv[2][2];
#pragma unroll
        for (int bj = 0; bj < 2; ++bj)
#pragma unroll
            for (int n = 0; n < 2; ++n) bv[bj][n] = (MODE == 2) ? *(const f32x4*)(b_a + (col0 - 1536) + bj * HALF + 4 * n) : (f32x4){0.f, 0.f, 0.f, 0.f};
#pragma unroll
        for (int ai = 0; ai < 2; ++ai)
#pragma unroll
            for (int m = 0; m < 4; ++m) { bf16_t* rowp = O + (size_t)(row0 + ai * HALF + m * 16) * 2816 + col0;
#pragma unroll
                for (int bj = 0; bj < 2; ++bj) { f32x4 v0 = acc[ai][bj][m][0], v1 = acc[ai][bj][m][1];
#pragma unroll
                    for (int j = 0; j < 4; ++j) {
                        if (MODE == 1) { v0[j] = f_silu(v0[j]); v1[j] = f_silu(v1[j]); }
                        if (MODE == 2) { v0[j] = f_logsig16(v0[j] + bv[bj][0][j]); v1[j] = f_logsig16(v1[j] + bv[bj][1][j]); }
                        if (MODE == 3) { v0[j] = f_gelu_tanh(v0[j]); v1[j] = f_gelu_tanh(v1[j]); } }
                    u32x4 w; w.x = pk2(v0[0], v0[1]); w.y = pk2(v0[2], v0[3]); w.z = pk2(v1[0], v1[1]); w.w = pk2(v1[2], v1[3]);
                    *(u32x4*)(rowp + bj * HALF) = w; } }
    }
    __device__ __forceinline__ void operator()(const f32x4 (&acc)[2][2][4][2], const Unit& u, int wr, int wc, int fr, int fq) const {
        const int pn = u.pn;
        if (pn < 4) tile<0>(acc, u, wr, wc, fr, fq); else if (pn < 6) tile<1>(acc, u, wr, wc, fr, fq); else if (pn == 6) tile<2>(acc, u, wr, wc, fr, fq); else tile<3>(acc, u, wr, wc, fr, fq);
    }
};
struct EpiInProj8 {
    static constexpr bool PERM = true, AFTER_DRAIN = false, F8 = true; static constexpr float dq = 1.0f / (F8_SX * F8_SW);
    bf16_t* O; const float* b_a;
    template <int MODE> __device__ __forceinline__ void tile(const f32x4 (&acc)[2][2][4][2], const Unit& u, int wr, int wc, int fr, int fq) const {
        const int row0 = u.pm * BM + wr * 64 + fr, col0 = u.pn * BM + wc * 32 + 8 * fq;
        f32x4 bv[2][2];
#pragma unroll
        for (int bj = 0; bj < 2; ++bj)
#pragma unroll
            for (int n = 0; n < 2; ++n) bv[bj][n] = (MODE == 2) ? *(const f32x4*)(b_a + (col0 - 1536) + bj * HALF + 4 * n) : (f32x4){0.f, 0.f, 0.f, 0.f};
#pragma unroll
        for (int ai = 0; ai < 2; ++ai)
#pragma unroll
            for (int m = 0; m < 4; ++m) { bf16_t* rowp = O + (size_t)(row0 + ai * HALF + m * 16) * 2816 + col0;
#pragma unroll
                for (int bj = 0; bj < 2; ++bj) { f32x4 v0 = acc[ai][bj][m][0] * dq, v1 = acc[ai][bj][m][1] * dq;
#pragma unroll
                    for (int j = 0; j < 4; ++j) {
                        if (MODE == 1) { v0[j] = f_silu(v0[j]); v1[j] = f_silu(v1[j]); }
                        if (MODE == 2) { v0[j] = f_logsig16(v0[j] + bv[bj][0][j]); v1[j] = f_logsig16(v1[j] + bv[bj][1][j]); }
                        if (MODE == 3) { v0[j] = f_gelu_tanh(v0[j]); v1[j] = f_gelu_tanh(v1[j]); } }
                    u32x4 w; w.x = pk2(v0[0], v0[1]); w.y = pk2(v0[2], v0[3]); w.z = pk2(v1[0], v1[1]); w.w = pk2(v1[2], v1[3]);
                    *(u32x4*)(rowp + bj * HALF) = w; } }
    }
    __device__ __forceinline__ void operator()(const f32x4 (&acc)[2][2][4][2], const Unit& u, int wr, int wc, int fr, int fq) const {
        const int pn = u.pn;
        if (pn < 4) tile<0>(acc, u, wr, wc, fr, fq); else if (pn < 6) tile<1>(acc, u, wr, wc, fr, fq); else if (pn == 6) tile<2>(acc, u, wr, wc, fr, fq); else tile<3>(acc, u, wr, wc, fr, fq);
    }
};
struct EpiResid {
    static constexpr bool PERM = true, AFTER_DRAIN = false;
    const bf16_t* X; bf16_t* Z; float alpha;
    __device__ __forceinline__ void operator()(const f32x4 (&acc)[2][2][4][2], const Unit& u, int wr, int wc, int fr, int fq) const {
        const int row0 = u.pm * BM + wr * 64 + fr, col0 = u.pn * BM + wc * 32 + 8 * fq;
#pragma unroll
        for (int ai = 0; ai < 2; ++ai)
#pragma unroll
            for (int m = 0; m < 4; ++m) { const size_t off = (size_t)(row0 + ai * HALF + m * 16) * 1024 + col0;
#pragma unroll
                for (int bj = 0; bj < 2; ++bj) { const f32x4 v0 = acc[ai][bj][m][0], v1 = acc[ai][bj][m][1];
                    const u32x4 xr = *(const u32x4*)(X + off + bj * HALF);
                    u32x4 w; w.x = pk2(alpha * bflo(xr.x) + v0[0], alpha * bfhi(xr.x) + v0[1]); w.y = pk2(alpha * bflo(xr.y) + v0[2], alpha * bfhi(xr.y) + v0[3]);
                    w.z = pk2(alpha * bflo(xr.z) + v1[0], alpha * bfhi(xr.z) + v1[1]); w.w = pk2(alpha * bflo(xr.w) + v1[2], alpha * bfhi(xr.w) + v1[3]);
                    *(u32x4*)(Z + off + bj * HALF) = w; } }
    }
};
struct EpiResidStats {
    static constexpr bool PERM = true, AFTER_DRAIN = false;
    const bf16_t* X; bf16_t* Z; f32x2_t* part; static constexpr float alpha = 1.4142135623730951f;
    __device__ __forceinline__ void operator()(const f32x4 (&acc)[2][2][4][2], const Unit& u, int wr, int wc, int fr, int fq) const {
        const int row0 = u.pm * BM + wr * 64 + fr, col0 = u.pn * BM + wc * 32 + 8 * fq;
        int ln = 16 * fq + fr; asm volatile("" : "+v"(ln));
        float s1[8], s2[8];
        const rsrc_t rx = mk_rsrc(X); const unsigned voff = ((unsigned)row0 * 1024u + (unsigned)col0) * 2u;
        u32x4 xres[2][4][2];
#pragma unroll
        for (int ai = 0; ai < 2; ++ai)
#pragma unroll
            for (int m = 0; m < 4; ++m)
#pragma unroll
                for (int bj = 0; bj < 2; ++bj) xres[ai][m][bj] = bld4(rx, voff, (unsigned)(((ai * HALF + m * 16) * 1024 + bj * HALF) * 2));
        __builtin_amdgcn_sched_barrier(0);
#pragma unroll
        for (int ai = 0; ai < 2; ++ai)
#pragma unroll
            for (int m = 0; m < 4; ++m) { const size_t off = (size_t)(row0 + ai * HALF + m * 16) * 1024 + col0; float a1 = 0.f, a2 = 0.f;
#pragma unroll
                for (int bj = 0; bj < 2; ++bj) { const f32x4 v0 = acc[ai][bj][m][0], v1 = acc[ai][bj][m][1];
                    const u32x4 xr = xres[ai][m][bj];
                    u32x4 w; w.x = pk2(alpha * bflo(xr.x) + v0[0], alpha * bfhi(xr.x) + v0[1]); w.y = pk2(alpha * bflo(xr.y) + v0[2], alpha * bfhi(xr.y) + v0[3]);
                    w.z = pk2(alpha * bflo(xr.z) + v1[0], alpha * bfhi(xr.z) + v1[1]); w.w = pk2(alpha * bflo(xr.w) + v1[2], alpha * bfhi(xr.w) + v1[3]);
                    GST4(Z + off + bj * HALF) = w;
                    const float z0 = bflo(w.x), z1 = bfhi(w.x), z2 = bflo(w.y), z3 = bfhi(w.y), z4 = bflo(w.z), z5 = bfhi(w.z), z6 = bflo(w.w), z7 = bfhi(w.w);
                    a1 += ((z0 + z1) + (z2 + z3)) + ((z4 + z5) + (z6 + z7)); a2 += ((z0 * z0 + z1 * z1) + (z2 * z2 + z3 * z3)) + ((z4 * z4 + z5 * z5) + (z6 * z6 + z7 * z7)); }
                s1[ai * 4 + m] = a1; s2[ai * 4 + m] = a2; }
        const bool h5 = (ln & 32) != 0, h4 = (ln & 16) != 0;
        float t1[4], t2[4];
#pragma unroll
        for (int i = 0; i < 4; ++i) { const float m1 = h5 ? s1[4 + i] : s1[i], g1 = h5 ? s1[i] : s1[4 + i], m2 = h5 ? s2[4 + i] : s2[i], g2 = h5 ? s2[i] : s2[4 + i];
            t1[i] = m1 + __builtin_bit_cast(float, __builtin_amdgcn_ds_bpermute((ln ^ 32) << 2, __builtin_bit_cast(int, g1)));
            t2[i] = m2 + __builtin_bit_cast(float, __builtin_amdgcn_ds_bpermute((ln ^ 32) << 2, __builtin_bit_cast(int, g2))); }
        float r1[2], r2[2];
#pragma unroll
        for (int i = 0; i < 2; ++i) { const float m1 = h4 ? t1[2 + i] : t1[i], g1 = h4 ? t1[i] : t1[2 + i], m2 = h4 ? t2[2 + i] : t2[i], g2 = h4 ? t2[i] : t2[2 + i];
            r1[i] = m1 + __builtin_bit_cast(float, __builtin_amdgcn_ds_bpermute((ln ^ 16) << 2, __builtin_bit_cast(int, g1)));
            r2[i] = m2 + __builtin_bit_cast(float, __builtin_amdgcn_ds_bpermute((ln ^ 16) << 2, __builtin_bit_cast(int, g2))); }
#pragma unroll
        for (int i = 0; i < 2; ++i) { const int gi = (h5 ? 4 : 0) + (h4 ? 2 : 0) + i, row = row0 + (gi >> 2) * HALF + (gi & 3) * 16;
            part[(size_t)row * 16 + u.pn * 4 + wc] = (f32x2_t){r1[i], r2[i]}; }
    }
};
struct EpiQFragLN {
    static constexpr bool PERM = true, AFTER_DRAIN = false;
    bf16_t* O; const f32x2_t* stats; const float* csum; const float* bq;
    __device__ __forceinline__ void operator()(const f32x4 (&acc)[2][2][4][2], const Unit& u, int wr, int wc, int fr, int fq) const {
        unsigned lo = (unsigned)(((fq >> 1) * 64 + fr + 32 * (fq & 1)) * 16); asm volatile("" : "+v"(lo));
        char* tile = (char*)(O + (size_t)(u.pm * 4 + u.pn) * 65536) + (size_t)(wr * 2 * 16 + wc * 2) * 1024 + lo;
        const int row0 = u.pm * BM + wr * 64 + fr, col0 = u.pn * BM + wc * 32 + 8 * fq;
#pragma unroll
        for (int bj = 0; bj < 2; ++bj) { const f32x4 c0 = *(const f32x4*)(csum + col0 + bj * HALF), c1 = *(const f32x4*)(csum + col0 + bj * HALF + 4), b0 = *(const f32x4*)(bq + col0 + bj * HALF), b1 = *(const f32x4*)(bq + col0 + bj * HALF + 4);
#pragma unroll
            for (int ai = 0; ai < 2; ++ai)
#pragma unroll
                for (int m = 0; m < 4; ++m) { const f32x2_t st = stats[row0 + ai * HALF + m * 16]; const float mu = st[0], rs = st[1];
                    const f32x4 v0 = (acc[ai][bj][m][0] - mu * c0) * rs + b0, v1 = (acc[ai][bj][m][1] - mu * c1) * rs + b1;
                    u32x4 w; w.x = pk2(v0[0], v0[1]); w.y = pk2(v0[2], v0[3]); w.z = pk2(v1[0], v1[1]); w.w = pk2(v1[2], v1[3]);
                    *(u32x4*)(tile + ((4 * ai + (m >> 1)) * 16 + 8 * bj) * 1024 + (m & 1) * 256) = w; } }
    }
};
struct EpiResidLN {
    static constexpr bool PERM = true, AFTER_DRAIN = false;
    bf16_t* Z; const f32x2_t* stats; const float* gain; const float* bias; static constexpr float alpha = 1.4142135623730951f;
    __device__ __forceinline__ void operator()(const f32x4 (&acc)[2][2][4][2], const Unit& u, int wr, int wc, int fr, int fq) const {
        const int row0 = u.pm * BM + wr * 64 + fr, col0 = u.pn * BM + wc * 32 + 8 * fq;
        const rsrc_t rz = mk_rsrc(Z), rs = mk_rsrc(stats); const unsigned voff = ((unsigned)row0 * 1024u + (unsigned)col0) * 2u;
        f32x2_t st[2][4];
#pragma unroll
        for (int ai = 0; ai < 2; ++ai)
#pragma unroll
            for (int m = 0; m < 4; ++m) st[ai][m] = bld2f(rs, (unsigned)row0 * 8u, (unsigned)((ai * HALF + m * 16) * 8));
#pragma unroll
        for (int bj = 0; bj < 2; ++bj) {
            u32x4 zres[2][4];
#pragma unroll
            for (int ai = 0; ai < 2; ++ai)
#pragma unroll
                for (int m = 0; m < 4; ++m) zres[ai][m] = bld4(rz, voff, (unsigned)(((ai * HALF + m * 16) * 1024 + bj * HALF) * 2));
            const f32x4 g0 = *(const f32x4*)(gain + col0 + bj * HALF) * alpha, g1 = *(const f32x4*)(gain + col0 + bj * HALF + 4) * alpha, b0 = *(const f32x4*)(bias + col0 + bj * HALF) * alpha, b1 = *(const f32x4*)(bias + col0 + bj * HALF + 4) * alpha;
            __builtin_amdgcn_sched_barrier(0);
#pragma unroll
            for (int ai = 0; ai < 2; ++ai)
#pragma unroll
                for (int m = 0; m < 4; ++m) { const int row = row0 + ai * HALF + m * 16; const float mu = st[ai][m][0], rsd = st[ai][m][1];
                    const u32x4 zr = zres[ai][m];
                    const f32x4 z0 = (f32x4){bflo(zr.x), bfhi(zr.x), bflo(zr.y), bfhi(zr.y)}, z1 = (f32x4){bflo(zr.z), bfhi(zr.z), bflo(zr.w), bfhi(zr.w)};
                    const f32x4 v0 = (z0 - mu) * rsd * g0 + b0 + acc[ai][bj][m][0], v1 = (z1 - mu) * rsd * g1 + b1 + acc[ai][bj][m][1];
                    u32x4 w; w.x = pk2(v0[0], v0[1]); w.y = pk2(v0[2], v0[3]); w.z = pk2(v1[0], v1[1]); w.w = pk2(v1[2], v1[3]);
                    GST4(Z + (size_t)row * 1024 + col0 + bj * HALF) = w; } }
    }
};
struct EpiResidLN8 {
    static constexpr bool PERM = true, AFTER_DRAIN = false, F8 = true; static constexpr float dq = 1.0f / (F8_SO * F8_SW);
    bf16_t* Z; const f32x2_t* stats; const float* gain; const float* bias; static constexpr float alpha = 1.4142135623730951f;
    __device__ __forceinline__ void operator()(const f32x4 (&acc)[2][2][4][2], const Unit& u, int wr, int wc, int fr, int fq) const {
        const int row0 = u.pm * BM + wr * 64 + fr, col0 = u.pn * BM + wc * 32 + 8 * fq;
        const rsrc_t rz = mk_rsrc(Z), rs = mk_rsrc(stats); const unsigned voff = ((unsigned)row0 * 1024u + (unsigned)col0) * 2u;
        f32x2_t st[2][4];
#pragma unroll
        for (int ai = 0; ai < 2; ++ai)
#pragma unroll
            for (int m = 0; m < 4; ++m) st[ai][m] = bld2f(rs, (unsigned)row0 * 8u, (unsigned)((ai * HALF + m * 16) * 8));
#pragma unroll
        for (int bj = 0; bj < 2; ++bj) {
            u32x4 zres[2][4];
#pragma unroll
            for (int ai = 0; ai < 2; ++ai)
#pragma unroll
                for (int m = 0; m < 4; ++m) zres[ai][m] = bld4(rz, voff, (unsigned)(((ai * HALF + m * 16) * 1024 + bj * HALF) * 2));
            const f32x4 g0 = *(const f32x4*)(gain + col0 + bj * HALF) * alpha, g1 = *(const f32x4*)(gain + col0 + bj * HALF + 4) * alpha, b0 = *(const f32x4*)(bias + col0 + bj * HALF) * alpha, b1 = *(const f32x4*)(bias + col0 + bj * HALF + 4) * alpha;
            __builtin_amdgcn_sched_barrier(0);
#pragma unroll
            for (int ai = 0; ai < 2; ++ai)
#pragma unroll
                for (int m = 0; m < 4; ++m) { const int row = row0 + ai * HALF + m * 16; const float mu = st[ai][m][0], rsd = st[ai][m][1];
                    const u32x4 zr = zres[ai][m];
                    const f32x4 z0 = (f32x4){bflo(zr.x), bfhi(zr.x), bflo(zr.y), bfhi(zr.y)}, z1 = (f32x4){bflo(zr.z), bfhi(zr.z), bflo(zr.w), bfhi(zr.w)};
                    const f32x4 v0 = (z0 - mu) * rsd * g0 + b0 + acc[ai][bj][m][0] * dq, v1 = (z1 - mu) * rsd * g1 + b1 + acc[ai][bj][m][1] * dq;
                    u32x4 w; w.x = pk2(v0[0], v0[1]); w.y = pk2(v0[2], v0[3]); w.z = pk2(v1[0], v1[1]); w.w = pk2(v1[2], v1[3]);
                    GST4(Z + (size_t)row * 1024 + col0 + bj * HALF) = w; } }
    }
};
struct EpiGU {
    static constexpr bool PERM = true, AFTER_DRAIN = false;
    bf16_t* H;
    __device__ __forceinline__ void operator()(const f32x4 (&acc)[2][2][4][2], const Unit& u, int wr, int wc, int fr, int fq) const {
        const int row0 = u.pm * BM + wr * 64 + fr, col0 = (u.pn & 3) * 128 + wc * 16 + 4 * fq;
#pragma unroll
        for (int ai = 0; ai < 2; ++ai)
#pragma unroll
            for (int m = 0; m < 4; ++m) { bf16_t* rowp = H + (size_t)(row0 + ai * HALF + m * 16) * 512 + col0;
#pragma unroll
                for (int bj = 0; bj < 2; ++bj) { const f32x4 g = acc[ai][bj][m][0], up = acc[ai][bj][m][1];
                    u32x2 w; w.x = pk2(f_silu(g[0]) * up[0], f_silu(g[1]) * up[1]); w.y = pk2(f_silu(g[2]) * up[2], f_silu(g[3]) * up[3]);
                    *(u32x2*)(rowp + bj * 64) = w; } }
    }
};
struct EpiGU8 {
    static constexpr bool PERM = true, AFTER_DRAIN = false, F8 = true;
    unsigned char* H;
    __device__ __forceinline__ void operator()(const f32x4 (&acc)[2][2][4][2], const Unit& u, int wr, int wc, int fr, int fq) const {
        const int row0 = u.pm * BM + wr * 64 + fr, col0 = (u.pn & 3) * 128 + wc * 32 + 8 * fq;
        constexpr float dq = 1.0f / (F8_SX * F8_SW);
#pragma unroll
        for (int ai = 0; ai < 2; ++ai)
#pragma unroll
            for (int m = 0; m < 4; ++m) { float h[8];
#pragma unroll
                for (int n = 0; n < 2; ++n) { const f32x4 g = acc[ai][0][m][n] * dq, up = acc[ai][1][m][n] * (dq * F8_SH);
#pragma unroll
                    for (int i = 0; i < 4; ++i) h[4 * n + i] = f_silu(g[i]) * up[i]; }
                u32x2 w; w.x = pk4f8(h[0], h[1], h[2], h[3]); w.y = pk4f8(h[4], h[5], h[6], h[7]);
                *(u32x2*)(H + (size_t)(row0 + ai * HALF + m * 16) * 512 + col0) = w; }
    }
};
struct EpiPlain8 {
    static constexpr bool PERM = true, AFTER_DRAIN = false, F8 = true;
    unsigned char* O; int ldc; int cmask;
    __device__ __forceinline__ void operator()(const f32x4 (&acc)[2][2][4][2], const Unit& u, int wr, int wc, int fr, int fq) const {
        const int row0 = u.pm * BM + wr * 64 + fr, col0 = (u.pn & cmask) * BM + wc * 32 + 8 * fq;
        constexpr float dq = F8_SY / (F8_SH * F8_SW);
#pragma unroll
        for (int ai = 0; ai < 2; ++ai)
#pragma unroll
            for (int m = 0; m < 4; ++m) { unsigned char* rowp = O + (size_t)(row0 + ai * HALF + m * 16) * ldc + col0;
#pragma unroll
                for (int bj = 0; bj < 2; ++bj) { const f32x4 v0 = acc[ai][bj][m][0] * dq, v1 = acc[ai][bj][m][1] * dq;
                    u32x2 w; w.x = pk4f8(v0[0], v0[1], v0[2], v0[3]); w.y = pk4f8(v1[0], v1[1], v1[2], v1[3]);
                    *(u32x2*)(rowp + bj * HALF) = w; } }
    }
};

typedef int i32x4_t __attribute__((ext_vector_type(4)));
template <class T, class = void> struct epi_f8 { static constexpr bool value = false; };
template <class T> struct epi_f8<T, decltype((void)T::F8)> { static constexpr bool value = true; };
template <class Epi, class Sched, bool ALIGN_EPI = false, bool SP2 = false>
__device__ __forceinline__ void gemm_phase(PG8_LAS unsigned char* lds, const Gemm g, const Sched& S, const Epi& E) {
    int tid_ = g.wv * 64 + lane_id(); asm volatile("" : "+v"(tid_));
    const int tid = tid_, wid = __builtin_amdgcn_readfirstlane(tid >> 6), lane = tid & 63, wr = wid >> 2, wc = wid & 3, fr = lane & 15, fq = lane >> 4;
    const int K = g.K, nt = K / BK; constexpr bool F8 = epi_f8<Epi>::value;
    unsigned voffA[2], voffB[2];
#pragma unroll
    for (int i = 0; i < 2; ++i) { int R, C; stage_rc(tid * 16 + i * 8192, R, C); const int Rb = Epi::PERM ? ((R & ~31) + perm32(R & 31)) : R;
        voffA[i] = (unsigned)(R * K + C) * 2u;
        voffB[i] = (unsigned)(((Rb >> 4) * (K >> 5) + (C >> 5)) * 1024 + (Rb & 15) * 64 + (C & 31) * 2); }
    constexpr bool GATH = Sched::GATHER; static_assert(!GATH || SP2, "gather mode is written for the SP2 loop");
    unsigned goc[2][2] = {{0u, 0u}, {0u, 0u}}, gon[2][2] = {{0u, 0u}, {0u, 0u}}, go2[2][2] = {{0u, 0u}, {0u, 0u}};
#define PG8_GOFF(dst, U) do { int tg_ = tid; asm volatile("" : "+v"(tg_)); _Pragma("unroll") for (int i_ = 0; i_ < 2; ++i_) { int R_, C_; stage_rc(tg_ * 16 + i_ * 8192, R_, C_); \
        _Pragma("unroll") for (int h_ = 0; h_ < 2; ++h_) dst[h_][i_] = (unsigned)S.src[(U).pm * BM + h_ * HALF + R_] * (unsigned)(K * 2) + (unsigned)C_ * 2u; } } while (0)
    const size_t kstep = (size_t)(BK * 2);
    const size_t kstepB = 2048;
    const size_t hstep = (size_t)HALF * K * 2;
    const size_t tstep = 2 * hstep;
    const unsigned ldsw = (unsigned)wid * 1024u;
    const int aoff = lds_byte(wr * 64 + fr, fq * 8), boff = lds_byte(wc * 32 + fr, fq * 8);
#define PG8_SA(b, h) (((b) * 2 + (h)) * HTB)
#define PG8_SB(b, h) ((4 + (b) * 2 + (h)) * HTB)
#define PG8_STAGE(bufoff, gbase, voff) do { _Pragma("unroll") for (int _i = 0; _i < 2; ++_i) \
        __builtin_amdgcn_global_load_lds((const unsigned*)((const char*)(gbase) + (voff)[_i]), (PG8_LAS unsigned*)(lds + (bufoff) + ldsw + _i * 8192), 16, 0, 0); } while (0)
#define PG8_STAGE_A(b, h, PTR, KPTR, GO) do { if constexpr (GATH) { PG8_STAGE(PG8_SA(b, h), KPTR, GO); } else { PG8_STAGE(PG8_SA(b, h), PTR, voffA); } } while (0)
#define PG8_LDA(dst, b, h) do { _Pragma("unroll") for (int m = 0; m < 4; ++m) _Pragma("unroll") for (int k = 0; k < 2; ++k) dst[m][k] = *(const PG8_LAS bf16x8*)(lds + PG8_SA(b, h) + aoff + m * 2048 + k * 1024); } while (0)
#define PG8_LDB(dst, b, h) do { _Pragma("unroll") for (int n = 0; n < 2; ++n) _Pragma("unroll") for (int k = 0; k < 2; ++k) dst[n][k] = *(const PG8_LAS bf16x8*)(lds + PG8_SB(b, h) + boff + n * 2048 + k * 1024); } while (0)
#define PG8_CAT8(x, y) __builtin_shufflevector(__builtin_bit_cast(i32x4_t, x), __builtin_bit_cast(i32x4_t, y), 0, 1, 2, 3, 4, 5, 6, 7)
#define PG8_MMA(ai, bj, At, Bt) do { __builtin_amdgcn_s_setprio(1); \
        if constexpr (F8) { _Pragma("unroll") for (int m = 0; m < 4; ++m) _Pragma("unroll") for (int n = 0; n < 2; ++n) \
            asm volatile("v_mfma_f32_16x16x128_f8f6f4 %0, %1, %2, %0" : "+v"(acc[ai][bj][m][n]) : "v"(PG8_CAT8(Bt[n][0], Bt[n][1])), "v"(PG8_CAT8(At[m][0], At[m][1]))); } \
        else { _Pragma("unroll") for (int m = 0; m < 4; ++m) _Pragma("unroll") for (int n = 0; n < 2; ++n) _Pragma("unroll") for (int k = 0; k < 2; ++k) \
            acc[ai][bj][m][n] = __builtin_amdgcn_mfma_f32_16x16x32_bf16(Bt[n][k], At[m][k], acc[ai][bj][m][n], 0, 0, 0); } \
        __builtin_amdgcn_s_setprio(0); } while (0)
#define PG8_WAIT_V(n) asm volatile("s_waitcnt vmcnt(" #n ")" ::: "memory")
#define PG8_WAIT_L(n) asm volatile("s_waitcnt lgkmcnt(" #n ")" ::: "memory")
#define PG8_BAR __builtin_amdgcn_s_barrier()
#define PG8_SCHED __builtin_amdgcn_sched_barrier(0)
    Unit cur, nxt; int ui = 0;
    if (!S.next(0, cur)) return;
    f32x4 acc[2][2][4][2];
#pragma unroll
    for (int a = 0; a < 2; ++a)
#pragma unroll
        for (int b = 0; b < 2; ++b)
#pragma unroll
            for (int m = 0; m < 4; ++m)
#pragma unroll
                for (int n = 0; n < 2; ++n) { acc[a][b][m][n] = (f32x4){0.f, 0.f, 0.f, 0.f}; if constexpr (F8) asm volatile("" : "+v"(acc[a][b][m][n])); }
    bf16x8 At[4][2], B0[2][2], B1[2][2];
    const char* cA = (const char*)g.A + (size_t)cur.pm * tstep; const char* cB = (const char*)g.Bt + (size_t)cur.pn * tstep;
    S.a_ready(cur);
    const char* gA = (const char*)g.A;
    if constexpr (GATH) PG8_GOFF(goc, cur);
    if constexpr (SP2) {
        PG8_STAGE(PG8_SB(0, 0), cB, voffB); PG8_STAGE(PG8_SB(0, 1), cB + hstep, voffB); PG8_STAGE_A(0, 0, cA, gA, goc[0]); PG8_STAGE_A(0, 1, cA + hstep, gA, goc[1]);
        if (wr == 1) PG8_BAR;
        PG8_WAIT_V(2); PG8_BAR;
        PG8_STAGE(PG8_SB(1, 0), cB + kstepB, voffB); PG8_STAGE_A(1, 0, cA + kstep, gA + kstep, goc[0]); PG8_STAGE(PG8_SB(1, 1), cB + hstep + kstepB, voffB);
        PG8_WAIT_V(6); PG8_BAR;
    } else {
        PG8_STAGE(PG8_SB(0, 0), cB, voffB); PG8_STAGE(PG8_SA(0, 0), cA, voffA); PG8_STAGE(PG8_SB(0, 1), cB + hstep, voffB); PG8_STAGE(PG8_SA(0, 1), cA + hstep, voffA);
        if (wr == 1) PG8_BAR;
        PG8_WAIT_V(4); PG8_BAR;
        PG8_STAGE(PG8_SB(1, 0), cB + kstepB, voffB); PG8_STAGE(PG8_SA(1, 0), cA + kstep, voffA); PG8_STAGE(PG8_SB(1, 1), cB + hstep + kstepB, voffB);
        PG8_WAIT_V(6); PG8_BAR;
    }
    for (;;) {
        const bool has_next = S.next(ui + 1, nxt);
        if constexpr (GATH) { if (has_next) PG8_GOFF(gon, nxt); else { _Pragma("unroll") for (int h_ = 0; h_ < 2; ++h_) _Pragma("unroll") for (int i_ = 0; i_ < 2; ++i_) gon[h_][i_] = goc[h_][i_]; } }
        const char* nA = has_next ? (const char*)g.A + (size_t)nxt.pm * tstep : cA; const char* nB = has_next ? (const char*)g.Bt + (size_t)nxt.pn * tstep : cB;
        for (int t = 0; t < nt; t += 2) {
            const bool last = (t == nt - 2);
            const char* a1 = cA + (size_t)(t + 1) * kstep;
            const char* a2 = last ? nA : cA + (size_t)(t + 2) * kstep; const char* b2 = last ? nB : cB + (size_t)(t + 2) * kstepB;
            const char* a3 = a2 + kstep; const char* b3 = b2 + kstepB;
            if (last && has_next) S.a_ready(nxt);
            const char* ga1 = gA + (size_t)(t + 1) * kstep; const char* ga2 = last ? gA : gA + (size_t)(t + 2) * kstep; const char* ga3 = ga2 + kstep;
            if constexpr (GATH) { _Pragma("unroll") for (int h_ = 0; h_ < 2; ++h_) _Pragma("unroll") for (int i_ = 0; i_ < 2; ++i_) go2[h_][i_] = last ? gon[h_][i_] : goc[h_][i_]; }
            if constexpr (SP2) {
            PG8_LDB(B0, 0, 0); PG8_LDB(B1, 0, 1); PG8_SCHED; PG8_LDA(At, 0, 0); PG8_STAGE_A(1, 1, a1 + hstep, ga1, goc[1]);
            PG8_WAIT_V(8); PG8_WAIT_L(0); PG8_BAR; PG8_MMA(0, 0, At, B0); PG8_MMA(0, 1, At, B1); PG8_BAR; PG8_SCHED;
            PG8_LDA(At, 0, 1); PG8_STAGE(PG8_SB(0, 0), b2, voffB); PG8_STAGE(PG8_SB(0, 1), b2 + hstep, voffB); PG8_STAGE_A(0, 0, a2, ga2, go2[0]);
            PG8_WAIT_V(8); PG8_WAIT_L(0); PG8_BAR; PG8_MMA(1, 0, At, B0); PG8_MMA(1, 1, At, B1); PG8_BAR; PG8_SCHED;
            PG8_LDB(B0, 1, 0); PG8_LDB(B1, 1, 1); PG8_SCHED; PG8_LDA(At, 1, 0); PG8_STAGE_A(0, 1, a2 + hstep, ga2, go2[1]);
            PG8_WAIT_V(8); PG8_WAIT_L(0); PG8_BAR; PG8_MMA(0, 0, At, B0); PG8_MMA(0, 1, At, B1); PG8_BAR; PG8_SCHED;
            PG8_LDA(At, 1, 1); PG8_STAGE(PG8_SB(1, 0), b3, voffB); PG8_STAGE(PG8_SB(1, 1), b3 + hstep, voffB); PG8_STAGE_A(1, 0, a3, ga3, go2[0]);
            PG8_WAIT_V(8); PG8_WAIT_L(0); PG8_BAR; PG8_MMA(1, 0, At, B0); PG8_MMA(1, 1, At, B1); PG8_BAR; PG8_SCHED;
            } else {
            PG8_LDB(B0, 0, 0); PG8_SCHED; PG8_LDA(At, 0, 0); PG8_STAGE(PG8_SA(1, 1), a1 + hstep, voffA);
            PG8_WAIT_L(8); PG8_BAR; PG8_WAIT_L(0); PG8_MMA(0, 0, At, B0); PG8_BAR; PG8_SCHED;
            PG8_LDB(B1, 0, 1); PG8_STAGE(PG8_SB(0, 0), b2, voffB);
            PG8_BAR; PG8_WAIT_L(0); PG8_MMA(0, 1, At, B1); PG8_BAR;
            PG8_LDA(At, 0, 1); PG8_STAGE(PG8_SA(0, 0), a2, voffA);
            PG8_BAR; PG8_WAIT_L(0); PG8_MMA(1, 0, At, B0); PG8_BAR; PG8_SCHED;
            PG8_STAGE(PG8_SB(0, 1), b2 + hstep, voffB);
            PG8_WAIT_V(6); PG8_BAR; PG8_MMA(1, 1, At, B1); PG8_BAR;
            PG8_LDB(B0, 1, 0); PG8_SCHED; PG8_LDA(At, 1, 0); PG8_STAGE(PG8_SA(0, 1), a2 + hstep, voffA);
            PG8_WAIT_L(8); PG8_BAR; PG8_WAIT_L(0); PG8_MMA(0, 0, At, B0); PG8_BAR; PG8_SCHED;
            PG8_LDB(B1, 1, 1); PG8_STAGE(PG8_SB(1, 0), b3, voffB);
            PG8_BAR; PG8_WAIT_L(0); PG8_MMA(0, 1, At, B1); PG8_BAR;
            PG8_LDA(At, 1, 1); PG8_STAGE(PG8_SA(1, 0), a3, voffA);
            PG8_BAR; PG8_WAIT_L(0); PG8_MMA(1, 0, At, B0); PG8_BAR; PG8_SCHED;
            PG8_STAGE(PG8_SB(1, 1), b3 + hstep, voffB);
            PG8_WAIT_V(6); PG8_BAR; PG8_MMA(1, 1, At, B1); PG8_BAR;
            }
        }
        if constexpr (F8) asm volatile("s_nop 15\n\ts_nop 15" ::: "memory");
        if constexpr (ALIGN_EPI) { if (wr == 0) PG8_BAR; }
        if constexpr (!Epi::AFTER_DRAIN) { E(acc, cur, wr, wc, fr, fq); S.done(cur); }
        if (!has_next) break;
#pragma unroll
        for (int a = 0; a < 2; ++a)
#pragma unroll
            for (int b = 0; b < 2; ++b)
#pragma unroll
                for (int m = 0; m < 4; ++m)
#pragma unroll
                    for (int n = 0; n < 2; ++n) { acc[a][b][m][n] = (f32x4){0.f, 0.f, 0.f, 0.f}; if constexpr (F8) asm volatile("" : "+v"(acc[a][b][m][n])); }
        cur = nxt; cA = nA; cB = nB; ++ui;
        if constexpr (GATH) { _Pragma("unroll") for (int h_ = 0; h_ < 2; ++h_) _Pragma("unroll") for (int i_ = 0; i_ < 2; ++i_) goc[h_][i_] = gon[h_][i_]; }
        if constexpr (ALIGN_EPI) { if (wr == 1) PG8_BAR; }
    }
    PG8_WAIT_V(0);
    if constexpr (!ALIGN_EPI) { if (wr == 0) PG8_BAR; }
    PG8_BAR;
    if constexpr (Epi::AFTER_DRAIN) { E.fused(acc, cur, wr, wc, fr, fq, lds, wid, lane); S.done(cur); }
#undef PG8_SA
#undef PG8_SB
#undef PG8_STAGE
#undef PG8_STAGE_A
#undef PG8_GOFF
#undef PG8_LDA
#undef PG8_LDB
#undef PG8_MMA
#undef PG8_WAIT_V
#undef PG8_WAIT_L
#undef PG8_BAR
#undef PG8_SCHED
}}

namespace mk {
using pg8::bf16_t; using pg8::bf16x8; using pg8::f32x4; using pg8::u32x4; using pg8::u32x2; using pg8::pk2; using pg8::bflo; using pg8::bfhi;
typedef float f32x16 __attribute__((ext_vector_type(16)));
typedef short s16x4 __attribute__((ext_vector_type(4)));
typedef short v4i16_t __attribute__((ext_vector_type(4)));
#define LAS __attribute__((address_space(3)))
#define GAS __attribute__((address_space(1)))
typedef GAS unsigned gu32;
#define RLX_AGENT __ATOMIC_RELAXED, __HIP_MEMORY_SCOPE_AGENT
#define LDS_WAIT() asm volatile("s_waitcnt lgkmcnt(0)" ::: "memory")

constexpr int NB = 8, SEQ = 8192, M = NB * SEQ, D = 1024, NP = 2816, NMEM = 256, MKV = NB * NMEM;
constexpr int PQ = 0, PK = 256, PV = 512, PR = 1024, PG = 1536, PU = 1792, PVS = 2304;
constexpr int DIN = 2576;
constexpr int MOE_ROWS = 135168;
constexpr float ALPHA = 1.4142135623730951f, LN_EPS = 1e-5f, LOG2E = 1.4426950408889634f;
constexpr int NWAVES = 8, NTHR = 512;

constexpr size_t MiB = 1u << 20;
constexpr size_t WS_CTL = 0, CTL_ZERO_BYTES = 1 * MiB;
constexpr size_t WS_WM = 1 * MiB;
constexpr size_t WS_WGCNT = 1 * MiB + 512 * 1024;
constexpr size_t WS_LTOT = 1 * MiB + 768 * 1024;
constexpr size_t WS_TINFO = 2 * MiB;
constexpr size_t WS_TRANK = 3 * MiB;
constexpr size_t WS_TSLOT = 3 * MiB + 512 * 1024;
constexpr size_t WS_SEND = 4 * MiB;
constexpr size_t WS_WKV = 12 * MiB;
constexpr size_t WS_MEMB = 20 * MiB;
constexpr size_t WS_KV = 24 * MiB;
constexpr size_t WS_W = 40 * MiB, W_LAYER = 60 * MiB;
constexpr size_t W_IN = 0, W_OUT = (size_t)NP * D * 2, W_Q = W_OUT + 2 * MiB, W_O = W_Q + 2 * MiB, W_GU = W_O + 2 * MiB, W_D = W_GU + 32 * MiB;
static_assert(W_D + 16 * MiB <= W_LAYER, "weights per layer");
constexpr size_t WS_X = 160 * MiB;
constexpr size_t WS_R = 288 * MiB;
constexpr size_t R_P = 0, R_Y = 352 * MiB, R_Z = 480 * MiB, R_Q = 0, R_O = 128 * MiB, R_XS = 352 * MiB, R_H = 0;
constexpr size_t R_X8 = 256 * MiB;
constexpr size_t WS_SRCROW = WS_R + 616 * MiB;
constexpr size_t WS_PART = WS_SRCROW + 1 * MiB;
constexpr size_t WS_STATS = WS_PART + 8 * MiB;
constexpr size_t WS_CS = WS_STATS + 1 * MiB;
constexpr size_t WS_X8IN = WS_CS + 1 * MiB;
constexpr size_t WS_END = WS_X8IN + 64 * MiB;
static_assert(R_XS + (size_t)MOE_ROWS * D * 2 <= 616 * MiB && R_H + (size_t)MOE_ROWS * 512 * 2 <= R_XS, "moe buffers");
constexpr int CW_BAR = 4096;

constexpr int LDS_BYTES = 159744, LDSCTL_OFF = 155648;
constexpr int MISC_OFF = LDSCTL_OFF;
constexpr int TILEE_OFF = LDSCTL_OFF + 512;
static_assert(TILEE_OFF + 528 * 4 <= LDS_BYTES, "LDS map");

#define XB_TMO      128
#define XB_XCNT(j)  (256  + 64 * (j))
#define XB_XSUB(j)  (1280 + 64 * (j))
#define XB_XGEN(j)  (2304 + 64 * (j))
#define XB_TOP      3328
#define XB_TOPGEN   3392
#define XCD_BAR_WORDS 3456
#define XB_SPIN_CAP (1u << 18)

__device__ __forceinline__ unsigned xb_ld(unsigned* p)              { return __hip_atomic_load(p, __ATOMIC_RELAXED, __HIP_MEMORY_SCOPE_AGENT); }
__device__ __forceinline__ unsigned xb_add(unsigned* p, unsigned v) { return __hip_atomic_fetch_add(p, v, __ATOMIC_RELAXED, __HIP_MEMORY_SCOPE_AGENT); }
__device__ __forceinline__ unsigned xb_xcc_id() { return (unsigned)__builtin_amdgcn_s_getreg((3 << 11) | 20) & 0xFu; }
#define XB_SPIN(cond, bar) do { unsigned _sp = 0; while (cond) { __builtin_amdgcn_s_sleep(1); \
    if ((++_sp & 255u) == 0u) { if (xb_ld(&(bar)[XB_TMO])) break; if (_sp > XB_SPIN_CAP) { atomicAdd(&(bar)[XB_TMO], 1u); break; } } } } while (0)

struct XcdBarrier {
    unsigned* bar; unsigned x;
    volatile LAS unsigned* st;
    int wv;
};

__device__ __forceinline__ XcdBarrier xcd_barrier_post(unsigned* bar, volatile LAS unsigned* st) {
    XcdBarrier b; b.bar = bar; b.x = xb_xcc_id(); b.st = st; b.wv = 0;
    if (threadIdx.x == 0) (void)xb_add(&bar[XB_XCNT(b.x)], 1u);
    return b;
}
__device__ __forceinline__ void xcd_barrier_complete(unsigned* bar, unsigned x, unsigned& nloc, unsigned& nx) {
    const unsigned G = gridDim.x * gridDim.y * gridDim.z;
    unsigned sum, cnt, mine, sp = 0u;
    for (;;) {
        sum = 0u; cnt = 0u; mine = 0u;
#pragma unroll
        for (unsigned j = 0; j < 16; ++j) { const unsigned c = xb_ld(&bar[XB_XCNT(j)]); sum += c; cnt += (c > 0u) ? 1u : 0u; mine = (j == x) ? c : mine; }
        if (sum == G) break;
        __builtin_amdgcn_s_sleep(1);
        if ((++sp & 255u) == 0u) { if (xb_ld(&bar[XB_TMO])) break; if (sp > XB_SPIN_CAP) { atomicAdd(&bar[XB_TMO], 1u); break; } }
    }
    nloc = mine > 0u ? mine : 1u; nx = cnt > 0u ? cnt : 1u;
}

__device__ __forceinline__ void xcd_barrier(const XcdBarrier& b) {
    asm volatile("s_waitcnt vmcnt(0)" ::: "memory");
    __syncthreads();
    if (b.wv == 0 && pg8::lane_id() == 0) {
        unsigned* bar = b.bar;
        __builtin_amdgcn_s_waitcnt(0);
        unsigned nloc = b.st[0], nx = b.st[1];
        if (nloc == 0u) { xcd_barrier_complete(bar, b.x, nloc, nx); b.st[0] = nloc; b.st[1] = nx; }
        const unsigned old = xb_add(&bar[XB_XSUB(b.x)], 1u);
        const unsigned gen = old / nloc;
        if (old + 1u == (gen + 1u) * nloc) {
            __builtin_amdgcn_fence(__ATOMIC_RELEASE, "agent");
            asm volatile("s_waitcnt vmcnt(0)" ::: "memory");
            const unsigned og = xb_add(&bar[XB_TOP], 1u);
            const unsigned tg = og / nx;
            if (og + 1u == (tg + 1u) * nx) xb_add(&bar[XB_TOPGEN], 1u);
            else XB_SPIN(xb_ld(&bar[XB_TOPGEN]) == tg, bar);
            __builtin_amdgcn_fence(__ATOMIC_ACQUIRE, "agent");
            xb_add(&bar[XB_XGEN(b.x)], 1u);
            asm volatile("s_waitcnt vmcnt(0)" ::: "memory");
        } else {
            XB_SPIN(xb_ld(&bar[XB_XGEN(b.x)]) == gen, bar);
            __builtin_amdgcn_fence(__ATOMIC_ACQUIRE, "agent");
            asm volatile("s_waitcnt vmcnt(0)" ::: "memory");
        }
    }
    __syncthreads();
}
__device__ __forceinline__ float shx(float v, int m, int lane) { return __builtin_bit_cast(float, __builtin_amdgcn_ds_bpermute((lane ^ m) << 2, __builtin_bit_cast(int, v))); }
__device__ __forceinline__ int shxi(int v, int m, int lane) { return __builtin_amdgcn_ds_bpermute((lane ^ m) << 2, v); }
__device__ __forceinline__ s16x4 vtr(unsigned lds_addr) { return __builtin_bit_cast(s16x4, __builtin_amdgcn_ds_read_tr16_b64_v4i16((LAS v4i16_t*)(size_t)lds_addr)); }
__device__ __forceinline__ bf16x8 cat8(s16x4 lo, s16x4 hi) { return __builtin_shufflevector(lo, hi, 0, 1, 2, 3, 4, 5, 6, 7); }
__device__ __forceinline__ void unpack8(const u32x4 w, float (&f)[8]) { f[0] = bflo(w.x); f[1] = bfhi(w.x); f[2] = bflo(w.y); f[3] = bfhi(w.y); f[4] = bflo(w.z); f[5] = bfhi(w.z); f[6] = bflo(w.w); f[7] = bfhi(w.w); }
__device__ __forceinline__ void unpack8f8(const u32x2 w, float (&f)[8]) { const auto a0 = __builtin_amdgcn_cvt_pk_f32_fp8((int)w.x, false), a1 = __builtin_amdgcn_cvt_pk_f32_fp8((int)w.x, true), a2 = __builtin_amdgcn_cvt_pk_f32_fp8((int)w.y, false), a3 = __builtin_amdgcn_cvt_pk_f32_fp8((int)w.y, true);
    f[0] = a0[0]; f[1] = a0[1]; f[2] = a1[0]; f[3] = a1[1]; f[4] = a2[0]; f[5] = a2[1]; f[6] = a3[0]; f[7] = a3[1]; }
__device__ __forceinline__ u32x4 pack8(const float (&f)[8]) { u32x4 w; w.x = pk2(f[0], f[1]); w.y = pk2(f[2], f[3]); w.z = pk2(f[4], f[5]); w.w = pk2(f[6], f[7]); return w; }

struct Args {
    const float* in[22]; float* out; unsigned char* ws;
};

__device__ __forceinline__ void transpose_item(const float* p0, const float* p1, int ld, int mode, float scale, int K, int nblk, bf16_t* dst, int row0, LAS float* scr, int item, int lane, const float* kscale = nullptr) {
    const int kb = item / nblk, nb = item % nblk, k0 = 64 * kb, n0 = 32 * nb;
    const int np = n0 + (lane & 31);
    const float* sp; int col;
    if (mode == 0) { sp = p0; col = np; } else { sp = (np & 4) ? p1 : p0; col = (np >> 3) * 4 + (np & 3); }
    sp += (size_t)k0 * ld + col;
#pragma unroll 8
    for (int i = 0; i < 32; ++i) { const int kk = 2 * i + (lane >> 5); scr[kk * 33 + (lane & 31)] = sp[(size_t)kk * ld] * scale * (kscale ? kscale[k0 + kk] : 1.0f); }
    LDS_WAIT(); asm volatile("" ::: "memory");
    const int c = lane & 7;
#pragma unroll
    for (int j = 0; j < 4; ++j) { const int n = (lane >> 3) + 8 * j; const LAS float* s = scr + (8 * c) * 33 + n;
        u32x4 o; o.x = pk2(s[0 * 33], s[1 * 33]); o.y = pk2(s[2 * 33], s[3 * 33]); o.z = pk2(s[4 * 33], s[5 * 33]); o.w = pk2(s[6 * 33], s[7 * 33]);
        const int ng = row0 + n0 + n, kk = k0 + 8 * c;
        *(u32x4*)(dst + ((size_t)(ng >> 4) * (K >> 5) + (kk >> 5)) * 512 + (ng & 15) * 32 + (kk & 31)) = o; }
    LDS_WAIT(); asm volatile("" ::: "memory");
}
__device__ __forceinline__ void transpose_item8(const float* p0, const float* p1, int ld, int mode, float scale, int K, int nblk, unsigned char* dst, int row0, LAS float* scr, int item, int lane) {
    const int kb = item / nblk, nb = item % nblk, k0 = 64 * kb, n0 = 32 * nb;
    const int np = n0 + (lane & 31);
    const float* sp; int col;
    if (mode == 0) { sp = p0; col = np; } else { sp = ((np >> 7) & 1) ? p1 : p0; col = (np >> 8) * 128 + (np & 127); }
    sp += (size_t)k0 * ld + col;
#pragma unroll 8
    for (int i = 0; i < 32; ++i) { const int kk = 2 * i + (lane >> 5); scr[kk * 33 + (lane & 31)] = sp[(size_t)kk * ld] * scale; }
    LDS_WAIT(); asm volatile("" ::: "memory");
    const int c = lane & 7;
#pragma unroll
    for (int j = 0; j < 4; ++j) { const int n = (lane >> 3) + 8 * j; const LAS float* s = scr + (8 * c) * 33 + n;
        u32x2 o; o.x = pg8::pk4f8(s[0 * 33], s[1 * 33], s[2 * 33], s[3 * 33]); o.y = pg8::pk4f8(s[4 * 33], s[5 * 33], s[6 * 33], s[7 * 33]);
        const int ng = row0 + n0 + n;
        *(u32x2*)(dst + ((size_t)(ng >> 4) * (K >> 6) + (k0 >> 6)) * 1024 + (ng & 15) * 64 + 8 * c) = o; }
    LDS_WAIT(); asm volatile("" ::: "memory");
}
__device__ __forceinline__ void p0_convert(const Args& a, LAS unsigned char* lds, int bid, int G, int wave_s) {
    int tid_ = wave_s * 64 + pg8::lane_id(); asm volatile("" : "+v"(tid_)); const int tid = tid_, lane = tid & 63, wave = __builtin_amdgcn_readfirstlane(tid >> 6);
    unsigned char* ws = a.ws;
    LAS float* scr = (LAS float*)(lds + wave * 16384);
    const int gw = bid * NWAVES + wave, NGW = G * NWAVES;
    constexpr int I_INQ = 16 * 8, I_INB = 16 * 40, I_INC = 16 * 32, I_SQ = 16 * 32, I_GU = 16 * 16 * 32, I_DN = 16 * 8 * 32;
    constexpr int I_LAYER = I_INQ + I_INB + I_INC + 5 * I_SQ + I_GU + I_DN;
    for (int it = gw; it < 2 * I_LAYER; it += NGW) {
        const int l = it / I_LAYER; int r = it % I_LAYER;
        unsigned char* wl = ws + WS_W + (size_t)l * W_LAYER;
        const float* w_in = a.in[2] + (size_t)l * D * DIN;
        if (r < I_INQ) { transpose_item8(w_in, nullptr, DIN, 0, 0.125f * pg8::F8_SW, D, 8, wl + W_IN, 0, scr, r, lane); continue; } r -= I_INQ;
        if (r < I_INB) { transpose_item8(w_in + 256, nullptr, DIN, 0, pg8::F8_SW, D, 40, wl + W_IN, 256, scr, r, lane); continue; } r -= I_INB;
        if (r < I_INC) { transpose_item8(w_in + 1552, nullptr, DIN, 0, pg8::F8_SW, D, 32, wl + W_IN, 1792, scr, r, lane); continue; } r -= I_INC;
        if (r < I_SQ) { transpose_item(a.in[10] + (size_t)l * D * D, nullptr, D, 0, 1.0f, D, 32, (bf16_t*)(wl + W_OUT), 0, scr, r, lane); continue; } r -= I_SQ;
        if (r < I_SQ) { transpose_item(a.in[11] + (size_t)l * D * D, nullptr, D, 0, 0.0625f, D, 32, (bf16_t*)(wl + W_Q), 0, scr, r, lane, a.in[20] + (size_t)(l * 3 + 0) * D); continue; } r -= I_SQ;
        if (r < I_SQ) { transpose_item8(a.in[14] + (size_t)l * D * D, nullptr, D, 0, pg8::F8_SW, D, 32, wl + W_O, 0, scr, r, lane); continue; } r -= I_SQ;
        if (r < I_SQ) { transpose_item(a.in[12] + (size_t)l * D * D, nullptr, D, 0, 1.0f, D, 32, (bf16_t*)(ws + WS_WKV), l * 2048, scr, r, lane); continue; } r -= I_SQ;
        if (r < I_SQ) { transpose_item(a.in[13] + (size_t)l * D * D, nullptr, D, 0, 1.0f, D, 32, (bf16_t*)(ws + WS_WKV), l * 2048 + 1024, scr, r, lane); continue; } r -= I_SQ;
        if (r < I_GU) { const int e = r / 512, rr = r % 512; const size_t eo = ((size_t)l * 16 + e) * D * 512;
            transpose_item8(a.in[17] + eo, a.in[18] + eo, 512, 2, pg8::F8_SW, D, 32, wl + W_GU, e * 1024, scr, rr, lane); continue; } r -= I_GU;
        { const int e = r / 256, rr = r % 256; const size_t eo = ((size_t)l * 16 + e) * 512 * D;
            transpose_item8(a.in[19] + eo, nullptr, D, 0, pg8::F8_SW, 512, 32, wl + W_D, e * 1024, scr, rr, lane); }
    }
    const size_t gt = (size_t)bid * NTHR + tid, NT = (size_t)G * NTHR;
    for (int it = gw; it < 2 * 16 * 16; it += NGW) { const int l = it >> 8, kc = (it >> 4) & 15, n = (it & 15) * 64 + lane;
        const float* wq = a.in[11] + (size_t)l * D * D; const float* gg = a.in[20] + (size_t)(l * 3) * D; const float* bb = a.in[21] + (size_t)(l * 3) * D; float cs = 0.f, bq = 0.f;
#pragma unroll 8
        for (int k = 64 * kc; k < 64 * kc + 64; ++k) { const float w = wq[(size_t)k * D + n] * 0.0625f; cs += bflo(pk2(w * gg[k], 0.f) & 0xffffu); bq += w * bb[k]; }
        float* tb = (float*)(ws + WS_CS) + (size_t)l * 2 * 16 * 1024; tb[kc * 1024 + n] = cs; tb[16 * 1024 + kc * 1024 + n] = bq; }
    for (size_t i = gt; i < (size_t)2 * 256 * 128; i += NT) {
        const int l = (int)(i / (256 * 128)), r = (int)(i % (256 * 128)), j = r / 128, k8 = r % 128;
        const float* w_in = a.in[2] + (size_t)l * D * DIN; const float* w_a2 = a.in[3] + (size_t)l * 16 * 256;
        float wa[16];
#pragma unroll
        for (int q = 0; q < 16; ++q) wa[q] = w_a2[q * 256 + j];
        float o[8];
#pragma unroll
        for (int kk = 0; kk < 8; ++kk) { const float* wr = w_in + (size_t)(8 * k8 + kk) * DIN + 1536; float s = 0.f;
#pragma unroll
            for (int q = 0; q < 16; q += 4) { const f32x4 v = *(const f32x4*)(wr + q); s += v[0] * wa[q] + v[1] * wa[q + 1] + v[2] * wa[q + 2] + v[3] * wa[q + 3]; }
            o[kk] = s; }
        { const int ng = 1536 + j, kk = 8 * k8; u32x2 o8; o8.x = pg8::pk4f8(o[0] * pg8::F8_SW, o[1] * pg8::F8_SW, o[2] * pg8::F8_SW, o[3] * pg8::F8_SW); o8.y = pg8::pk4f8(o[4] * pg8::F8_SW, o[5] * pg8::F8_SW, o[6] * pg8::F8_SW, o[7] * pg8::F8_SW);
          *(u32x2*)(ws + WS_W + (size_t)l * W_LAYER + W_IN + ((size_t)(ng >> 4) * (D >> 6) + (kk >> 6)) * 1024 + (ng & 15) * 64 + (kk & 63)) = o8; }
    }
    for (size_t i = gt; i < (size_t)2 * 4 * 128 * 16; i += NT) {
        const int s8 = (int)(i & 15), t = (int)((i >> 4) & 127);
        const float* src = a.in[6] + i * 8; float o[8];
#pragma unroll
        for (int q = 0; q < 8; ++q) o[q] = ((8 * s8 + q) / 64 <= t / 64) ? src[q] : 0.f;
        *(u32x4*)((bf16_t*)(ws + WS_WM) + i * 8) = pack8(o);
    }
    for (size_t i = gt; i < (size_t)M * D / 8; i += NT) {
        const f32x4 v0 = *(const f32x4*)(a.in[0] + i * 8), v1 = *(const f32x4*)(a.in[0] + i * 8 + 4);
        u32x4 w; w.x = pk2(v0[0], v0[1]); w.y = pk2(v0[2], v0[3]); w.z = pk2(v1[0], v1[1]); w.w = pk2(v1[2], v1[3]);
        *(u32x4*)((bf16_t*)(ws + WS_X) + i * 8) = w;
        u32x2 q8; q8.x = pg8::pk4f8(v0[0] * pg8::F8_SX, v0[1] * pg8::F8_SX, v0[2] * pg8::F8_SX, v0[3] * pg8::F8_SX); q8.y = pg8::pk4f8(v1[0] * pg8::F8_SX, v1[1] * pg8::F8_SX, v1[2] * pg8::F8_SX, v1[3] * pg8::F8_SX);
        *(u32x2*)(ws + WS_X8IN + i * 8) = q8;
    }
    for (size_t i = gt; i < (size_t)MKV * D / 8; i += NT) {
        const f32x4 v0 = *(const f32x4*)(a.in[1] + i * 8), v1 = *(const f32x4*)(a.in[1] + i * 8 + 4);
        u32x4 w; w.x = pk2(v0[0], v0[1]); w.y = pk2(v0[2], v0[3]); w.z = pk2(v1[0], v1[1]); w.w = pk2(v1[2], v1[3]);
        *(u32x4*)((bf16_t*)(ws + WS_MEMB) + i * 8) = w;
    }
}

constexpr int GL_KD = 0, GL_QS = 9216, GL_VS = 18432, GL_PSUM = 35840, GL_DL = 37888, GL_SSQ = 38144;
template <bool FINAL>
__device__ __forceinline__ void gla_phase(LAS unsigned char* lds, const bf16_t* P, float* Send, float* Ltot, bf16_t* Y, const float* gn_g, int bid, int G, int wave_s) {
    int tid_ = wave_s * 64 + pg8::lane_id(); asm volatile("" : "+v"(tid_)); const int tid = tid_, lane = tid & 63, wave = __builtin_amdgcn_readfirstlane(tid >> 6);
    const unsigned lb = (unsigned)(size_t)lds;
    const int g = lane >> 4, l15 = lane & 15, q4 = l15 >> 2, p4 = lane & 3;
    const int kq = tid & 63, part = wave;
    for (int item = bid; item < 256; item += G) {
        const int b = item >> 5, h = (item >> 3) & 3, run = item & 7, bh = item >> 3;
        f32x4 sacc[4];
#pragma unroll
        for (int kt = 0; kt < 4; ++kt) sacc[kt] = (f32x4){0.f, 0.f, 0.f, 0.f};
        if (FINAL) {
            for (int i = 0; i < run; ++i) {
                const float* se = Send + ((size_t)(bh * 8 + i) * 64) * 128; const float* lt = Ltot + (size_t)(bh * 8 + i) * 64;
#pragma unroll
                for (int kt = 0; kt < 4; ++kt)
#pragma unroll
                    for (int r = 0; r < 4; ++r) { const int k = 16 * kt + 4 * g + r; sacc[kt][r] = __expf(lt[k]) * sacc[kt][r] + se[(size_t)k * 128 + 16 * wave + l15]; }
            }
        }
        float ltot_acc = 0.f;
        unsigned short graw[8], kraw[8]; u32x4 vraw[2], qraw; u32x2 rraw[4];
        const int v_row = tid >> 4, v_c16 = tid & 15, q_row = tid >> 3, q_c16 = tid & 7;
        const int ycol = h * 128 + 16 * wave + 4 * g;
#define GLA_FETCH(CC) do { const size_t tf_ = (size_t)b * SEQ + (size_t)(run * 16 + (CC)) * 64; \
            _Pragma("unroll") for (int i = 0; i < 8; ++i) { const bf16_t* rp = P + (tf_ + 8 * part + i) * NP + h * 64 + kq; graw[i] = rp[PG]; kraw[i] = rp[PK]; } \
            _Pragma("unroll") for (int i = 0; i < 2; ++i) vraw[i] = *(const u32x4*)(P + (tf_ + v_row + 32 * i) * NP + PV + h * 128 + v_c16 * 8); \
            if (FINAL) { qraw = *(const u32x4*)(P + (tf_ + q_row) * NP + PQ + h * 64 + q_c16 * 8); \
                _Pragma("unroll") for (int tt = 0; tt < 4; ++tt) rraw[tt] = *(const u32x2*)(P + (tf_ + 16 * tt + l15) * NP + PR + ycol); } } while (0)
        GLA_FETCH(0);
        for (int c = 0; c < 16; ++c) {
            const size_t t0 = (size_t)b * SEQ + (size_t)(run * 16 + c) * 64;
            __syncthreads();
            float gv[8], kv[8];
#pragma unroll
            for (int i = 0; i < 8; ++i) { gv[i] = __builtin_bit_cast(float, (unsigned)graw[i] << 16); kv[i] = __builtin_bit_cast(float, (unsigned)kraw[i] << 16); }
#pragma unroll
            for (int i = 1; i < 8; ++i) gv[i] += gv[i - 1];
            ((LAS float*)(lds + GL_PSUM))[part * 64 + kq] = gv[7];
#pragma unroll
            for (int i = 0; i < 2; ++i) *(LAS u32x4*)(lds + GL_VS + (v_row + 32 * i) * 272 + v_c16 * 16) = vraw[i];
            u32x2 rcur[4];
            if (FINAL) { *(LAS u32x4*)(lds + GL_QS + q_row * 144 + q_c16 * 16) = qraw;
#pragma unroll
                for (int tt = 0; tt < 4; ++tt) rcur[tt] = rraw[tt]; }
            if (c + 1 < 16) GLA_FETCH(c + 1);
            __syncthreads();
            float offs = 0.f, bl = 0.f;
#pragma unroll
            for (int p = 0; p < 8; ++p) { const float v = ((LAS float*)(lds + GL_PSUM))[p * 64 + kq]; offs += (p < part) ? v : 0.f; bl += v; }
#pragma unroll
            for (int i = 0; i < 8; ++i) { const float kd = kv[i] * __expf(bl - (offs + gv[i]));
                *(LAS unsigned short*)(lds + GL_KD + (8 * part + i) * 144 + kq * 2) = (unsigned short)(pk2(kd, 0.f) & 0xffffu); }
            if (part == 0) ((LAS float*)(lds + GL_DL))[kq] = __expf(bl);
            ltot_acc += bl;
            __syncthreads();
#pragma unroll
            for (int kt = 0; kt < 4; ++kt) { const f32x4 dl = *(LAS f32x4*)(lds + GL_DL + (16 * kt + 4 * g) * 4); sacc[kt] = sacc[kt] * dl; }
#pragma unroll
            for (int ks = 0; ks < 2; ++ks) {
                const unsigned vrow = lb + GL_VS + (unsigned)(32 * ks + 8 * g + q4) * 272u + (unsigned)(16 * wave + 4 * p4) * 2u;
                const bf16x8 vb = cat8(vtr(vrow), vtr(vrow + 4u * 272u));
#pragma unroll
                for (int kt = 0; kt < 4; ++kt) {
                    const unsigned krow = lb + GL_KD + (unsigned)(32 * ks + 8 * g + q4) * 144u + (unsigned)(16 * kt + 4 * p4) * 2u;
                    const bf16x8 ka = cat8(vtr(krow), vtr(krow + 4u * 144u));
                    sacc[kt] = __builtin_amdgcn_mfma_f32_16x16x32_bf16(ka, vb, sacc[kt], 0, 0, 0);
                }
            }
            if (FINAL) {
                f32x4 oacc[4];
#pragma unroll
                for (int tt = 0; tt < 4; ++tt) oacc[tt] = (f32x4){0.f, 0.f, 0.f, 0.f};
#pragma unroll
                for (int ks2 = 0; ks2 < 2; ++ks2) {
                    u32x4 spw; spw.x = pk2(sacc[2 * ks2][0], sacc[2 * ks2][1]); spw.y = pk2(sacc[2 * ks2][2], sacc[2 * ks2][3]);
                    spw.z = pk2(sacc[2 * ks2 + 1][0], sacc[2 * ks2 + 1][1]); spw.w = pk2(sacc[2 * ks2 + 1][2], sacc[2 * ks2 + 1][3]);
                    const bf16x8 sp = __builtin_bit_cast(bf16x8, spw);
#pragma unroll
                    for (int tt = 0; tt < 4; ++tt) {
                        const LAS unsigned char* qp = lds + GL_QS + (16 * tt + l15) * 144 + (32 * ks2 + 4 * g) * 2;
                        const u32x2 qlo = *(const LAS u32x2*)qp, qhi = *(const LAS u32x2*)(qp + 32);
                        u32x4 qw; qw.x = qlo.x; qw.y = qlo.y; qw.z = qhi.x; qw.w = qhi.y;
                        oacc[tt] = __builtin_amdgcn_mfma_f32_16x16x32_bf16(sp, __builtin_bit_cast(bf16x8, qw), oacc[tt], 0, 0, 0);
                    }
                }
#pragma unroll
                for (int tt = 0; tt < 4; ++tt) { float s = oacc[tt][0] * oacc[tt][0] + oacc[tt][1] * oacc[tt][1] + oacc[tt][2] * oacc[tt][2] + oacc[tt][3] * oacc[tt][3];
                    s += shx(s, 16, lane); s += shx(s, 32, lane);
                    if (g == 0) ((LAS float*)(lds + GL_SSQ))[wave * 64 + 16 * tt + l15] = s; }
                __syncthreads();
                const int col = h * 128 + 16 * wave + 4 * g;
                const f32x4 gn = *(const f32x4*)(gn_g + col);
#pragma unroll
                for (int tt = 0; tt < 4; ++tt) { float tot = 0.f;
#pragma unroll
                    for (int w2 = 0; w2 < 8; ++w2) tot += ((LAS float*)(lds + GL_SSQ))[w2 * 64 + 16 * tt + l15];
                    const float rs = __builtin_amdgcn_rsqf(tot * (1.0f / 128.0f) + 1e-6f);
                    const size_t tok = t0 + 16 * tt + l15;
                    const u32x2 rr = rcur[tt];
                    u32x2 w; w.x = pk2(oacc[tt][0] * rs * gn[0] * bflo(rr.x), oacc[tt][1] * rs * gn[1] * bfhi(rr.x));
                    w.y = pk2(oacc[tt][2] * rs * gn[2] * bflo(rr.y), oacc[tt][3] * rs * gn[3] * bfhi(rr.y));
                    *(u32x2*)(Y + tok * D + col) = w; }
            }
        }
        if (!FINAL) {
            float* se = Send + ((size_t)(bh * 8 + run) * 64) * 128;
#pragma unroll
            for (int kt = 0; kt < 4; ++kt)
#pragma unroll
                for (int r = 0; r < 4; ++r) se[(size_t)(16 * kt + 4 * g + r) * 128 + 16 * wave + l15] = sacc[kt][r];
            if (part == 0) Ltot[(size_t)(bh * 8 + run) * 64 + kq] = ltot_acc;
        }
    }
}

#undef GLA_FETCH
constexpr int SG_VN = 0;
__device__ __forceinline__ void sgu_phase(LAS unsigned char* lds, const bf16_t* P, const bf16_t* Wm, const float* b_s, const float* lg, const float* lb_, bf16_t* Y, int bid, int G, int wave_s) {
    int tid_ = wave_s * 64 + pg8::lane_id(); asm volatile("" : "+v"(tid_)); const int tid = tid_, lane = tid & 63, wave = __builtin_amdgcn_readfirstlane(tid >> 6);
    const unsigned lb = (unsigned)(size_t)lds;
    const int g = lane >> 4, l15 = lane & 15, q4 = l15 >> 2, p4 = lane & 3;
    const int row = tid >> 2, qu = tid & 3;
    u32x4 vraw[4]; u32x2 uraw[8];
#define SGU_FETCH(IT) do { const int blk_ = (IT) >> 2, gr_ = (IT) & 3; const size_t tf_ = (size_t)blk_ * 128; \
        const bf16_t* src_ = P + (tf_ + row) * NP + PVS + gr_ * 128 + 32 * qu; \
        _Pragma("unroll") for (int i = 0; i < 4; ++i) vraw[i] = *(const u32x4*)(src_ + 8 * i); \
        const bf16_t* us_ = P + (tf_ + 16 * wave + l15) * NP + PU + gr_ * 128 + 4 * g; \
        _Pragma("unroll") for (int ct = 0; ct < 8; ++ct) uraw[ct] = *(const u32x2*)(us_ + 16 * ct); } while (0)
    if (bid < 2048) SGU_FETCH(bid);
    for (int item = bid; item < 2048; item += G) {
        const int blk = item >> 2, gr = item & 3; const size_t t0 = (size_t)blk * 128;
        __syncthreads();
        u32x2 ucur[8];
        { float v[32];
#pragma unroll
          for (int i = 0; i < 4; ++i) { float f[8]; unpack8(vraw[i], f);
#pragma unroll
              for (int j = 0; j < 8; ++j) v[8 * i + j] = f[j]; }
#pragma unroll
          for (int ct = 0; ct < 8; ++ct) ucur[ct] = uraw[ct];
          if (item + G < 2048) SGU_FETCH(item + G);
          float s = 0.f;
#pragma unroll
          for (int i = 0; i < 32; ++i) s += v[i];
          s += shx(s, 1, lane); s += shx(s, 2, lane);
          const float mu = s * (1.0f / 128.0f); float qq = 0.f;
#pragma unroll
          for (int i = 0; i < 32; ++i) { v[i] -= mu; qq += v[i] * v[i]; }
          qq += shx(qq, 1, lane); qq += shx(qq, 2, lane);
          const float rs = __builtin_amdgcn_rsqf(qq * (1.0f / 128.0f) + LN_EPS);
          const float* gp = lg + gr * 128 + 32 * qu; const float* bp = lb_ + gr * 128 + 32 * qu;
#pragma unroll
          for (int i = 0; i < 4; ++i) { float f[8];
#pragma unroll
              for (int j = 0; j < 8; ++j) f[j] = v[8 * i + j] * rs * gp[8 * i + j] + bp[8 * i + j];
              *(LAS u32x4*)(lds + SG_VN + row * 272 + (32 * qu + 8 * i) * 2) = pack8(f); }
        }
        __syncthreads();
        const int nks = (wave < 4) ? 2 : 4;
        bf16x8 wf[4];
#pragma unroll
        for (int ks = 0; ks < 4; ++ks) wf[ks] = *(const bf16x8*)(Wm + ((size_t)(gr * 128 + 16 * wave + l15)) * 128 + 32 * ks + 8 * g);
        const size_t tok = t0 + 16 * wave + l15; const float bs = b_s[gr * 128 + 16 * wave + l15];
        unsigned vb0 = lb + SG_VN + (unsigned)(8 * g + q4) * 272u + (unsigned)(4 * p4) * 2u; asm volatile("" : "+v"(vb0));
#pragma unroll
        for (int ct = 0; ct < 8; ++ct) {
            f32x4 acc = (f32x4){0.f, 0.f, 0.f, 0.f};
#pragma unroll
            for (int ks = 0; ks < 4; ++ks) {
                if (ks < nks) {
                    const unsigned vrow = vb0 + (unsigned)(32 * ks * 272 + 32 * ct);
                    const bf16x8 va = cat8(vtr(vrow), vtr(vrow + 4u * 272u));
                    acc = __builtin_amdgcn_mfma_f32_16x16x32_bf16(va, wf[ks], acc, 0, 0, 0);
                }
            }
            const int col = gr * 128 + 16 * ct + 4 * g;
            const u32x2 uu = ucur[ct];
            u32x2 w; w.x = pk2(bflo(uu.x) * (acc[0] + bs), bfhi(uu.x) * (acc[1] + bs)); w.y = pk2(bflo(uu.y) * (acc[2] + bs), bfhi(uu.y) * (acc[3] + bs));
            *(u32x2*)(Y + tok * D + 512 + col) = w;
        }
    }
}
#undef SGU_FETCH

constexpr int AT_KPS = 1040, AT_VPS = 1088, AT_SLOT = 34816, AT_NSLOT = 3;
static_assert(AT_NSLOT * AT_SLOT <= LDSCTL_OFF, "attention LDS");
__device__ __forceinline__ void glds16(const void* gsrc, unsigned lds_dst) { unsigned keep;
    asm volatile("s_mov_b32 %0, m0\n\ts_mov_b32 m0, %2\n\ts_nop 0\n\tglobal_load_lds_dwordx4 %1, off\n\ts_mov_b32 m0, %0" : "=&s"(keep) : "v"(gsrc), "s"(lds_dst) : "memory"); }
__device__ __forceinline__ void attn_dma(unsigned lb, const char* kvb, int so, unsigned lane_off, int slot, int ps, int wave) {
#pragma unroll
    for (int j = 0; j < 4; ++j) { const int pi = 4 * wave + j, rlo = 32 * (pi >> 4) + (pi & 15);
        glds16(kvb + (size_t)(so + rlo * 8192) + lane_off, (unsigned)__builtin_amdgcn_readfirstlane((int)(lb + (unsigned)(slot * AT_SLOT + pi * ps)))); }
}
#define AT_WAITBAR(N) do { asm volatile("s_waitcnt vmcnt(" #N ") lgkmcnt(0)" ::: "memory"); __builtin_amdgcn_s_barrier(); asm volatile("" ::: "memory"); } while (0)
__device__ __forceinline__ void attn_phase(LAS unsigned char* lds, const bf16_t* Q, const bf16_t* KV, bf16_t* O, int layer, int bid, int G, int wave_s) {
    int tid_ = wave_s * 64 + pg8::lane_id(); asm volatile("" : "+v"(tid_)); const int tid = tid_, lane = tid & 63, wave = __builtin_amdgcn_readfirstlane(tid >> 6);
    const unsigned lb = (unsigned)(size_t)lds;
    const int r32 = lane & 31, hh = lane >> 5, q4 = (lane & 15) >> 2, p4 = lane & 3, blk = (lane >> 4) & 1;
    LAS unsigned char* kbase = lds + (r32 & 15) * AT_KPS + ((r32 >> 4) & 1) * 512 + hh * 16;
    unsigned vbase = lb + (unsigned)(4 * hh + q4) * (unsigned)AT_VPS + (unsigned)(16 * blk + 4 * p4) * 2u;
    unsigned lane_off = (unsigned)((lane >> 5) * 16 * 8192 + (lane & 31) * 16);
    asm volatile("" : "+v"(kbase), "+v"(vbase), "+v"(lane_off));
    const char* kvb = (const char*)KV;
    const int nun = (bid < 256) ? 4 * ((256 - bid + G - 1) / G) : 0;
#define AT_SRC(N, ST) ((int)((((size_t)(((bid + ((N) >> 2) * G) >> 5) * NMEM) * 4096 + layer * 2048 + ((N) & 3) * 256 + (((ST) >> 2) * 1024)) * 2) + ((ST) & 3) * 64 * 8192))
    __syncthreads();
    if (nun > 0) { attn_dma(lb, kvb, AT_SRC(0, 0), lane_off, 0, AT_KPS, wave); attn_dma(lb, kvb, AT_SRC(0, 1), lane_off, 1, AT_KPS, wave); AT_WAITBAR(4); }
    int sl = 0;
    for (int n = 0; n < nun; ++n) {
        const int pan = bid + (n >> 2) * G, h = n & 3, b = pan >> 5, qt = pan & 31;
        int ln_ = pg8::lane_id(); asm volatile("" : "+v"(ln_));
        const unsigned qoff = (unsigned)((wave * 16 * 64 + ln_) * 16);
        const char* qbase = (const char*)(Q + (size_t)(pan * 4 + h) * 65536);
        char* obase = (char*)O + ((size_t)b * SEQ + qt * 256) * D + h * 256;
        const bool more = (n + 1 < nun);
        bf16x8 qf[16];
#pragma unroll
        for (int s = 0; s < 16; ++s) qf[s] = *(const GAS bf16x8*)(qbase + qoff + 1024 * s);
        float ml = 0.f, lsum = 0.f;
        bf16x8 pk[8][2];
#pragma unroll
        for (int st = 0; st < 4; ++st) {
            const int sl2 = (sl >= 1) ? sl - 1 : 2;
            if (st > 0) attn_dma(lb, kvb, AT_SRC(n, st + 2), lane_off, sl2, (st + 2 < 4) ? AT_KPS : AT_VPS, wave);
            LAS unsigned char* kb = kbase + sl * AT_SLOT;
            f32x16 sa[2];
#pragma unroll
            for (int kt = 0; kt < 2; ++kt)
#pragma unroll
                for (int r = 0; r < 16; ++r) sa[kt][r] = 0.f;
            bf16x8 kfa[2], kfb[2];
#define AT_KLD(dst, S0) do { _Pragma("unroll") for (int kt = 0; kt < 2; ++kt) dst[kt] = *(const LAS bf16x8*)(kb + kt * 16 * AT_KPS + 32 * (S0)); } while (0)
#define AT_KMM(src, S0) do { _Pragma("unroll") for (int kt = 0; kt < 2; ++kt) sa[kt] = __builtin_amdgcn_mfma_f32_32x32x16_bf16(src[kt], qf[(S0)], sa[kt], 0, 0, 0); } while (0)
            AT_KLD(kfa, 0); __builtin_amdgcn_sched_barrier(0);
#pragma unroll
            for (int bq = 0; bq < 8; ++bq) {
                AT_KLD(kfb, 2 * bq + 1); __builtin_amdgcn_sched_barrier(0);
                AT_KMM(kfa, 2 * bq); __builtin_amdgcn_sched_barrier(0);
                if (bq < 7) { AT_KLD(kfa, 2 * bq + 2); __builtin_amdgcn_sched_barrier(0); }
                AT_KMM(kfb, 2 * bq + 1); __builtin_amdgcn_sched_barrier(0);
            }
#undef AT_KLD
#undef AT_KMM
            if (st == 0) attn_dma(lb, kvb, AT_SRC(n, 2), lane_off, sl2, AT_KPS, wave);
            if (st == 0) { float mx = -3.0e38f;
#pragma unroll
                for (int kt = 0; kt < 2; ++kt)
#pragma unroll
                    for (int r = 0; r < 16; ++r) mx = __builtin_fmaxf(mx, sa[kt][r]);
                mx = __builtin_fmaxf(mx, shx(mx, 32, lane)); ml = mx * LOG2E; }
#pragma unroll
            for (int kt = 0; kt < 2; ++kt) {
                float p[16];
#pragma unroll
                for (int r = 0; r < 16; ++r) { p[r] = __builtin_amdgcn_exp2f(sa[kt][r] * LOG2E - ml); lsum += p[r]; }
#pragma unroll
                for (int s2 = 0; s2 < 2; ++s2) { u32x4 w; w.x = pk2(p[8 * s2 + 0], p[8 * s2 + 1]); w.y = pk2(p[8 * s2 + 2], p[8 * s2 + 3]); w.z = pk2(p[8 * s2 + 4], p[8 * s2 + 5]); w.w = pk2(p[8 * s2 + 6], p[8 * s2 + 7]);
                    pk[2 * st + kt][s2] = __builtin_bit_cast(bf16x8, w); }
            }
            AT_WAITBAR(4);
            sl = (sl == 2) ? 0 : sl + 1;
        }
        lsum += shx(lsum, 32, lane);
        f32x16 oacc[8];
#pragma unroll
        for (int dt = 0; dt < 8; ++dt)
#pragma unroll
            for (int r = 0; r < 16; ++r) oacc[dt][r] = 0.f;
#pragma unroll
        for (int st = 4; st < 8; ++st) {
            const bool issue = (st < 6) || more;
            if (issue) { const int s2 = (sl >= 1) ? sl - 1 : 2;
                if (st < 6) attn_dma(lb, kvb, AT_SRC(n, st + 2), lane_off, s2, AT_VPS, wave); else attn_dma(lb, kvb, AT_SRC(n + 1, st - 6), lane_off, s2, AT_KPS, wave); }
            const unsigned vb = vbase + (unsigned)(sl * AT_SLOT);
            bf16x8 vfa[2], vfb[2];
#define AT_VLD(dst, BT) do { const unsigned va_ = vb + (unsigned)((((BT) >> 3) & 1) * 16 * AT_VPS + (((BT) >> 2) & 1) * 512 + ((BT) & 3) * 128); \
                _Pragma("unroll") for (int d_ = 0; d_ < 2; ++d_) dst[d_] = cat8(vtr(va_ + 64u * d_), vtr(va_ + 64u * d_ + 8u * AT_VPS)); } while (0)
#define AT_VMM(src, BT) do { _Pragma("unroll") for (int d_ = 0; d_ < 2; ++d_) oacc[2 * ((BT) & 3) + d_] = __builtin_amdgcn_mfma_f32_32x32x16_bf16(src[d_], pk[2 * (st - 4) + (((BT) >> 3) & 1)][((BT) >> 2) & 1], oacc[2 * ((BT) & 3) + d_], 0, 0, 0); } while (0)
            AT_VLD(vfa, 0); __builtin_amdgcn_sched_barrier(0);
#pragma unroll
            for (int bq = 0; bq < 8; ++bq) {
                AT_VLD(vfb, 2 * bq + 1); __builtin_amdgcn_sched_barrier(0);
                AT_VMM(vfa, 2 * bq); __builtin_amdgcn_sched_barrier(0);
                if (bq < 7) { AT_VLD(vfa, 2 * bq + 2); __builtin_amdgcn_sched_barrier(0); }
                AT_VMM(vfb, 2 * bq + 1); __builtin_amdgcn_sched_barrier(0);
            }
#undef AT_VLD
#undef AT_VMM
            if (issue) AT_WAITBAR(4); else AT_WAITBAR(0);
            sl = (sl == 2) ? 0 : sl + 1;
        }
        const float inv = 1.0f / lsum;
        int ln2 = pg8::lane_id(); asm volatile("" : "+v"(ln2));
        GAS char* op = (GAS char*)obase + (unsigned)((wave * 32 + (ln2 & 31)) * D) + ((ln2 >> 5) ? 16 : 0);
        const float sc = inv * pg8::F8_SO;
#pragma unroll
        for (int dt = 0; dt < 8; ++dt) {
            unsigned dw[4];
#pragma unroll
            for (int g4 = 0; g4 < 4; ++g4) dw[g4] = pg8::pk4f8(oacc[dt][4 * g4 + 0] * sc, oacc[dt][4 * g4 + 1] * sc, oacc[dt][4 * g4 + 2] * sc, oacc[dt][4 * g4 + 3] * sc);
            { const auto r = __builtin_amdgcn_permlane32_swap(dw[0], dw[2], false, false); dw[0] = r[0]; dw[2] = r[1]; }
            { const auto r = __builtin_amdgcn_permlane32_swap(dw[1], dw[3], false, false); dw[1] = r[0]; dw[3] = r[1]; }
            u32x4 w; w.x = dw[0]; w.y = dw[2]; w.z = dw[1]; w.w = dw[3];
            *(GAS u32x4*)(op + 32 * dt) = w; }
    }
    asm volatile("s_waitcnt vmcnt(0)" ::: "memory");
    __syncthreads();
}
#undef AT_SRC
#undef AT_WAITBAR

constexpr int RT_WH = 0, RT_WL = 32768, RT_SEL = 65536, RT_RK = 66048, RT_CNTW = 67072, RT_WBASE = 67584;
template <int MODE>
__device__ __forceinline__ void ln_phase(LAS unsigned char* lds, const Args& a, int l, int lnidx, bool last, bf16_t* Xout, int bid, int G, int wave_s) {
    int tid_ = wave_s * 64 + pg8::lane_id(); asm volatile("" : "+v"(tid_)); const int tid = tid_, lane = tid & 63, wave = __builtin_amdgcn_readfirstlane(tid >> 6);
    constexpr int R = (MODE == 2) ? 2 : 4;
    unsigned char* ws = a.ws;
    const bf16_t* Z = (const bf16_t*)(ws + WS_R + R_Z); const bf16_t* X = (const bf16_t*)(ws + WS_X); const unsigned char* Ys8 = ws + WS_R + R_XS;
    const float* gp = a.in[20] + (size_t)(l * 3 + lnidx) * D; const float* bp = a.in[21] + (size_t)(l * 3 + lnidx) * D;
    float gg[16], bb[16];
#pragma unroll
    for (int j = 0; j < 2; ++j)
#pragma unroll
        for (int i = 0; i < 8; ++i) { gg[8 * j + i] = gp[8 * lane + 512 * j + i]; bb[8 * j + i] = bp[8 * lane + 512 * j + i]; }
    if (MODE == 1) {
        __syncthreads();
        for (int idx = tid; idx < 2048; idx += NTHR) { const int s = idx >> 6, ln = idx & 63, e = ln & 15, g = ln >> 4; float hi[8], lo[8];
#pragma unroll
            for (int j = 0; j < 8; ++j) { const float w = a.in[15][(32 * s + 8 * g + j) * 16 + e]; const float h = bflo(pk2(w, 0.f) & 0xffffu); hi[j] = h; lo[j] = w - h; }
            *(LAS u32x4*)(lds + RT_WH + idx * 16) = pack8(hi); *(LAS u32x4*)(lds + RT_WL + idx * 16) = pack8(lo); }
        __syncthreads();
    }
    for (int blk = bid; blk < 256; blk += G) {
        int run[16];
#pragma unroll
        for (int e = 0; e < 16; ++e) run[e] = 0;
        u32x4 pa_[R][2]; u32x2 pb_[R][2], pc_[R][2]; float pw0[R], pw1[R];
#define LN_LOAD(ROW0) do { _Pragma("unroll") for (int r = 0; r < R; ++r) { const size_t row = (ROW0) + r; \
            if (MODE == 2) { const int* ts = (const int*)(ws + WS_TSLOT) + row * 2; const float* ti = (const float*)(ws + WS_TINFO) + row * 4; const int s0 = ts[0], s1 = ts[1]; pw0[r] = ti[2]; pw1[r] = ti[3]; \
                _Pragma("unroll") for (int j = 0; j < 2; ++j) { pa_[r][j] = *(const u32x4*)(X + row * D + 8 * lane + 512 * j); pb_[r][j] = *(const u32x2*)(Ys8 + (size_t)s0 * D + 8 * lane + 512 * j); pc_[r][j] = *(const u32x2*)(Ys8 + (size_t)s1 * D + 8 * lane + 512 * j); } } \
            else { _Pragma("unroll") for (int j = 0; j < 2; ++j) pa_[r][j] = *(const u32x4*)(Z + row * D + 8 * lane + 512 * j); } } } while (0)
        LN_LOAD((size_t)blk * 256 + wave * 32);
        for (int ri = 0; ri < 32; ri += R) {
            const int rl0 = wave * 32 + ri; const size_t row0 = (size_t)blk * 256 + rl0;
            float v[R][16];
#pragma unroll
            for (int r = 0; r < R; ++r)
#pragma unroll
                for (int j = 0; j < 2; ++j) { float x[8]; unpack8(pa_[r][j], x);
                    if (MODE == 2) { float y0[8], y1[8]; unpack8f8(pb_[r][j], y0); unpack8f8(pc_[r][j], y1);
#pragma unroll
                        for (int i = 0; i < 8; ++i) v[r][8 * j + i] = ALPHA * x[i] + (pw0[r] * (1.0f / pg8::F8_SY)) * y0[i] + (pw1[r] * (1.0f / pg8::F8_SY)) * y1[i]; }
                    else {
#pragma unroll
                        for (int i = 0; i < 8; ++i) v[r][8 * j + i] = x[i]; } }
            if (ri + R < 32) LN_LOAD(row0 + R);
            float s[R];
#pragma unroll
            for (int r = 0; r < R; ++r) { s[r] = 0.f;
#pragma unroll
                for (int i = 0; i < 16; ++i) s[r] += v[r][i]; }
#pragma unroll
            for (int o = 1; o < 64; o <<= 1)
#pragma unroll
                for (int r = 0; r < R; ++r) s[r] += shx(s[r], o, lane);
            float qq[R];
#pragma unroll
            for (int r = 0; r < R; ++r) { const float mu = s[r] * (1.0f / D); qq[r] = 0.f;
#pragma unroll
                for (int i = 0; i < 16; ++i) { v[r][i] -= mu; qq[r] += v[r][i] * v[r][i]; } }
#pragma unroll
            for (int o = 1; o < 64; o <<= 1)
#pragma unroll
                for (int r = 0; r < R; ++r) qq[r] += shx(qq[r], o, lane);
#pragma unroll
            for (int r = 0; r < R; ++r) { const float rs = __builtin_amdgcn_rsqf(qq[r] * (1.0f / D) + LN_EPS);
#pragma unroll
                for (int i = 0; i < 16; ++i) v[r][i] = v[r][i] * rs * gg[i] + bb[i]; }
#pragma unroll
            for (int r = 0; r < R; ++r) { const size_t row = row0 + r;
                if (MODE == 2 && last) {
#pragma unroll
                    for (int j = 0; j < 2; ++j) { float* op = a.out + row * D + 8 * lane + 512 * j;
                        *(f32x4*)op = (f32x4){v[r][8 * j], v[r][8 * j + 1], v[r][8 * j + 2], v[r][8 * j + 3]}; *(f32x4*)(op + 4) = (f32x4){v[r][8 * j + 4], v[r][8 * j + 5], v[r][8 * j + 6], v[r][8 * j + 7]}; }
                } else {
#pragma unroll
                    for (int j = 0; j < 2; ++j) { float f[8];
#pragma unroll
                        for (int i = 0; i < 8; ++i) f[i] = v[r][8 * j + i];
                        *(u32x4*)(Xout + row * D + 8 * lane + 512 * j) = pack8(f);
                        if (MODE == 1 || MODE == 2) { u32x2 q8; q8.x = pg8::pk4f8(f[0] * pg8::F8_SX, f[1] * pg8::F8_SX, f[2] * pg8::F8_SX, f[3] * pg8::F8_SX); q8.y = pg8::pk4f8(f[4] * pg8::F8_SX, f[5] * pg8::F8_SX, f[6] * pg8::F8_SX, f[7] * pg8::F8_SX);
                            *(u32x2*)(ws + (MODE == 1 ? WS_R + R_X8 : WS_X8IN) + row * D + 8 * lane + 512 * j) = q8; } }
                } }
            if (MODE == 1 && ((ri + R) & 15) == 0) {
                asm volatile("s_waitcnt vmcnt(0)" ::: "memory");
                const int tok = lane & 15, g = lane >> 4, tl = rl0 + R - 16 + tok; const size_t token = (size_t)blk * 256 + tl;
                const bf16_t* xr = Xout + token * D + 8 * g;
                f32x4 acc = (f32x4){0.f, 0.f, 0.f, 0.f};
#pragma unroll 8
                for (int ks = 0; ks < 32; ++ks) { const bf16x8 xb = *(const bf16x8*)(xr + 32 * ks);
                    const bf16x8 wh = *(const LAS bf16x8*)(lds + RT_WH + (ks * 64 + lane) * 16), wl = *(const LAS bf16x8*)(lds + RT_WL + (ks * 64 + lane) * 16);
                    acc = __builtin_amdgcn_mfma_f32_16x16x32_bf16(wh, xb, acc, 0, 0, 0); acc = __builtin_amdgcn_mfma_f32_16x16x32_bf16(wl, xb, acc, 0, 0, 0); }
                const f32x4 brv = *(const f32x4*)(a.in[16] + 4 * g);
                float lg[4] = {acc[0] + brv[0], acc[1] + brv[1], acc[2] + brv[2], acc[3] + brv[3]};
                float m = __builtin_fmaxf(__builtin_fmaxf(lg[0], lg[1]), __builtin_fmaxf(lg[2], lg[3]));
                m = __builtin_fmaxf(m, shx(m, 16, lane)); m = __builtin_fmaxf(m, shx(m, 32, lane));
                float t1 = -1.f, t2 = -1.f; int i1 = 0, i2 = 0;
#pragma unroll
                for (int r = 0; r < 4; ++r) { const float p = __expf(lg[r] - m); if (p > t1) { t2 = t1; i2 = i1; t1 = p; i1 = r; } else if (p > t2) { t2 = p; i2 = r; } }
                const float gs = t1 + t2; float bgs = gs; int bg = g;
                { const float o = shx(bgs, 16, lane); const int og = shxi(bg, 16, lane); if (o > bgs || (o == bgs && og < bg)) { bgs = o; bg = og; } }
                { const float o = shx(bgs, 32, lane); const int og = shxi(bg, 32, lane); if (o > bgs || (o == bgs && og < bg)) { bgs = o; bg = og; } }
                const bool mine = (bg == g); const int e0 = 4 * g + i1, e1 = 4 * g + i2;
                if (mine) { u32x4 info; info.x = (unsigned)e0; info.y = (unsigned)e1; info.z = __builtin_bit_cast(unsigned, t1 / gs); info.w = __builtin_bit_cast(unsigned, t2 / gs);
                    *(u32x4*)(ws + WS_TINFO + token * 16) = info; ((LAS unsigned short*)(lds + RT_SEL))[tl] = (unsigned short)(e0 | (e1 << 8)); }
                const unsigned long long below = (1ull << lane) - 1ull; int r0 = 0, r1 = 0;
#pragma unroll
                for (int e = 0; e < 16; ++e) { const bool hit = mine && (e0 == e || e1 == e); const unsigned long long mb = __ballot(hit); const int cb = __popcll(mb & below);
                    r0 = (e0 == e) ? run[e] + cb : r0; r1 = (e1 == e) ? run[e] + cb : r1; run[e] += __popcll(mb); }
                if (mine) { ((LAS unsigned short*)(lds + RT_RK))[2 * tl] = (unsigned short)r0; ((LAS unsigned short*)(lds + RT_RK))[2 * tl + 1] = (unsigned short)r1; }
            }
        }
        if (MODE == 1) {
            { int vsel = 0;
#pragma unroll
              for (int e = 0; e < 16; ++e) vsel = (lane == e) ? run[e] : vsel;
              if (lane < 16) ((LAS int*)(lds + RT_CNTW))[wave * 16 + lane] = vsel; }
            __syncthreads();
            if (tid < 16) { int base = 0;
#pragma unroll
                for (int w = 0; w < 8; ++w) { const int t = ((LAS int*)(lds + RT_CNTW))[w * 16 + tid]; ((LAS int*)(lds + RT_WBASE))[w * 16 + tid] = base; base += t; }
                ((int*)(ws + WS_WGCNT))[blk * 16 + tid] = base; }
            __syncthreads();
            { const int t = tid >> 1, k = tid & 1; const int e = (((LAS unsigned short*)(lds + RT_SEL))[t] >> (8 * k)) & 255;
              ((int*)(ws + WS_TRANK))[(size_t)blk * 512 + tid] = (int)((LAS unsigned short*)(lds + RT_RK))[tid] + ((LAS int*)(lds + RT_WBASE))[(t >> 5) * 16 + e]; }
            __syncthreads();
        }
    }
}

#undef LN_LOAD
constexpr int MG_TBL = 0, MG_TOT = 16384, MG_PRE = 16448, MG_BASE = 16512;
__device__ __forceinline__ void moe_gather_phase(LAS unsigned char* lds, unsigned char* ws, int bid, int G, int wave_s) {
    int tid_ = wave_s * 64 + pg8::lane_id(); asm volatile("" : "+v"(tid_)); const int tid = tid_, lane = tid & 63, wave = __builtin_amdgcn_readfirstlane(tid >> 6);
    LAS int* tbl = (LAS int*)(lds + MG_TBL); LAS int* tot = (LAS int*)(lds + MG_TOT); LAS int* pre = (LAS int*)(lds + MG_PRE); LAS int* base = (LAS int*)(lds + MG_BASE);
    LAS int* offs = (LAS int*)(lds + MISC_OFF) + 16; LAS int* tile_e = (LAS int*)(lds + TILEE_OFF);
    const bf16_t* X = (const bf16_t*)(ws + WS_X); bf16_t* Xs = (bf16_t*)(ws + WS_R + R_XS);
    for (int blk = bid; blk < 256; blk += G) {
        __syncthreads();
        for (int i = tid; i < 4096; i += NTHR) tbl[i] = ((const int*)(ws + WS_WGCNT))[i];
        __syncthreads();
        if (tid < 16) { int t = 0, p = 0; for (int c = 0; c < 256; ++c) { const int v = tbl[c * 16 + tid]; p += (c < blk) ? v : 0; t += v; } tot[tid] = t; pre[tid] = p; }
        __syncthreads();
        if (tid == 0) { int o = 0; for (int e = 0; e < 16; ++e) { offs[e] = o; base[e] = o + pre[e]; o += (tot[e] + 255) & ~255; } offs[16] = o; offs[17] = o >> 8; }
        __syncthreads();
        for (int rt = tid; rt < 528; rt += NTHR) { int e = 0;
#pragma unroll
            for (int q = 1; q < 16; ++q) e = (rt * 256 >= offs[q]) ? q : e;
            tile_e[rt] = e; }
        { const size_t tok = (size_t)blk * 256 + (tid >> 1); const int k = tid & 1;
          const int e = ((const int*)(ws + WS_TINFO))[tok * 4 + k]; const int rk = ((const int*)(ws + WS_TRANK))[tok * 2 + k];
          const int slot = base[e] + rk;
          ((int*)(ws + WS_TSLOT))[tok * 2 + k] = slot; ((int*)(ws + WS_SRCROW))[slot] = (int)tok; }
        for (int e = wave; e < 16; e += NWAVES) { const int npad = offs[e + 1] - offs[e] - tot[e];
            if (blk < npad && lane == 0) ((int*)(ws + WS_SRCROW))[offs[e] + tot[e] + blk] = 0; }
    }
}

#define GEMM_ALIGN true
#define GEMM_SP2 true
__global__ void __launch_bounds__(NTHR, 2) mk_fwd(Args args) {
    extern __shared__ __attribute__((aligned(16))) unsigned char lds_raw[];
    LAS unsigned char* lds = (LAS unsigned char*)lds_raw;
    const int tid = threadIdx.x; const int wave_s = __builtin_amdgcn_readfirstlane(tid >> 6);
    const int G = gridDim.x, bid = blockIdx.x;
    unsigned char* ws = args.ws;
    volatile LAS unsigned* MISC = (volatile LAS unsigned*)(lds + MISC_OFF);
    for (int u = tid; u < (LDS_BYTES - LDSCTL_OFF) / 4; u += NTHR) ((LAS unsigned*)(lds + LDSCTL_OFF))[u] = 0u;
    __syncthreads();
    XcdBarrier bar = xcd_barrier_post((unsigned*)(ws + WS_CTL) + CW_BAR, MISC + 8);
    bar.wv = wave_s;
#define GRID_BAR() xcd_barrier(bar)
#ifndef REP_MASK
#define REP_MASK 0
#endif
#define LOCAL_SYNC() do { asm volatile("s_waitcnt vmcnt(0)" ::: "memory"); __syncthreads(); } while (0)
#define PHASE(grp, ...) do { __VA_ARGS__; if (REP_MASK & (1 << (grp))) { GRID_BAR(); __VA_ARGS__; } } while (0)

#define WSQ ({ unsigned char* w_ = args.ws; asm volatile("" : "+s"(w_)); w_; })
#define X ((bf16_t*)(WSQ + WS_X))
#define P ((bf16_t*)(WSQ + WS_R + R_P))
#define Y ((bf16_t*)(WSQ + WS_R + R_Y))
#define Z ((bf16_t*)(WSQ + WS_R + R_Z))
#define Qb ((bf16_t*)(WSQ + WS_R + R_Q))
#define Ob ((bf16_t*)(WSQ + WS_R + R_O))
#define Xs ((bf16_t*)(WSQ + WS_R + R_XS))
#define Hb ((bf16_t*)(WSQ + WS_R + R_H))
#define KV ((bf16_t*)(WSQ + WS_KV))
#define wl (WSQ + WS_W + (size_t)l * W_LAYER)

    PHASE(0, p0_convert(args, lds, bid, G, wave_s));
    GRID_BAR();
    { const int tid_r = wave_s * 64 + pg8::lane_id();
      for (int i = bid * NTHR + tid_r; i < 2 * 2 * 1024; i += G * NTHR) { const int l = i >> 11, w = (i >> 10) & 1, n = i & 1023; const float* tb = (const float*)(WSQ + WS_CS) + (size_t)l * 2 * 16 * 1024 + w * 16 * 1024; float s = 0.f;
#pragma unroll
          for (int kc = 0; kc < 16; ++kc) s += tb[kc * 1024 + n];
          ((float*)(WSQ + WS_CS) + 65536)[i] = s; } }
    PHASE(1, { pg8::Gemm g{(const bf16_t*)(WSQ + WS_MEMB), (const bf16_t*)(WSQ + WS_WKV), MKV, 4096, D, wave_s}; pg8::StaticOrder S; S.init(MKV, 4096, G, bid);
      pg8::EpiPlain E{KV, 4096, 0xffff};
      pg8::gemm_phase<pg8::EpiPlain, pg8::StaticOrder, GEMM_ALIGN, GEMM_SP2>(lds, g, S, E); });

#pragma unroll 1
    for (int l = 0; l < 2; ++l) {
        PHASE(1, { pg8::Gemm g{(const bf16_t*)(WSQ + WS_X8IN), (const bf16_t*)(wl + W_IN), M, NP, D / 2, wave_s}; pg8::StaticOrder S; S.init(M, NP, G, bid);
          pg8::EpiInProj8 E{P, args.in[4] + l * 256};
          pg8::gemm_phase<pg8::EpiInProj8, pg8::StaticOrder, GEMM_ALIGN, GEMM_SP2>(lds, g, S, E); });
        GRID_BAR();
        PHASE(3, gla_phase<false>(lds, P, (float*)(WSQ + WS_SEND), (float*)(WSQ + WS_LTOT), Y, args.in[5] + l * 512, bid, G, wave_s));
        PHASE(4, sgu_phase(lds, P, (const bf16_t*)(WSQ + WS_WM) + (size_t)l * 4 * 128 * 128, args.in[7] + l * 512, args.in[8] + l * 512, args.in[9] + l * 512, Y, bid, G, wave_s));
        GRID_BAR();
        PHASE(3, gla_phase<true>(lds, P, (float*)(WSQ + WS_SEND), (float*)(WSQ + WS_LTOT), Y, args.in[5] + l * 512, bid, G, wave_s));
        GRID_BAR();
        PHASE(10, { pg8::Gemm g{Y, (const bf16_t*)(wl + W_OUT), M, D, D, wave_s}; pg8::PanelOrder S{4, M / 256, G, bid};
          pg8::EpiResidStats E{X, Z, (pg8::f32x2_t*)(WSQ + WS_PART)};
          pg8::gemm_phase<pg8::EpiResidStats, pg8::PanelOrder, GEMM_ALIGN, GEMM_SP2>(lds, g, S, E); });
        { const int tid_r = wave_s * 64 + pg8::lane_id();
          for (int pan = bid; pan < 256; pan += G) if (tid_r < 256) { const size_t row = (size_t)pan * 256 + tid_r; const pg8::f32x2_t* pp = (const pg8::f32x2_t*)(WSQ + WS_PART) + row * 16; float s1 = 0.f, s2 = 0.f;
#pragma unroll
              for (int q = 0; q < 16; ++q) { const pg8::f32x2_t v = pp[q]; s1 += v[0]; s2 += v[1]; }
              const float mu = s1 * (1.0f / D), var = s2 * (1.0f / D) - mu * mu; ((pg8::f32x2_t*)(WSQ + WS_STATS))[row] = (pg8::f32x2_t){mu, __builtin_amdgcn_rsqf(var + LN_EPS)}; } }
        LOCAL_SYNC();
        PHASE(10, { pg8::Gemm g{Z, (const bf16_t*)(wl + W_Q), M, D, D, wave_s}; pg8::PanelOrder S{4, M / 256, G, bid};
          pg8::EpiQFragLN E{Qb, (const pg8::f32x2_t*)(WSQ + WS_STATS), (const float*)(WSQ + WS_CS) + 65536 + l * 2048, (const float*)(WSQ + WS_CS) + 65536 + l * 2048 + 1024};
          pg8::gemm_phase<pg8::EpiQFragLN, pg8::PanelOrder, GEMM_ALIGN, GEMM_SP2>(lds, g, S, E); });
        PHASE(5, attn_phase(lds, Qb, KV, Ob, l, bid, G, wave_s));
        LOCAL_SYNC();
        PHASE(10, { pg8::Gemm g{Ob, (const bf16_t*)(wl + W_O), M, D, D / 2, wave_s}; pg8::PanelOrder S{4, M / 256, G, bid};
          pg8::EpiResidLN8 E{Z, (const pg8::f32x2_t*)(WSQ + WS_STATS), args.in[20] + (size_t)(l * 3) * D, args.in[21] + (size_t)(l * 3) * D};
          pg8::gemm_phase<pg8::EpiResidLN8, pg8::PanelOrder, GEMM_ALIGN, GEMM_SP2>(lds, g, S, E); });
        PHASE(9, ln_phase<1>(lds, args, l, 1, false, X, bid, G, wave_s));
        GRID_BAR();
        PHASE(7, moe_gather_phase(lds, WSQ, bid, G, wave_s));
        GRID_BAR();
        PHASE(2, { pg8::Gemm g{(const bf16_t*)(WSQ + WS_R + R_X8), (const bf16_t*)(wl + W_GU), MOE_ROWS, 16384, D / 2, wave_s}; pg8::MoeGatherOrder S{(const LAS int*)(lds + TILEE_OFF), (int)MISC[33] * 4, G, bid, (const int*)(WSQ + WS_SRCROW)};
          pg8::EpiGU8 E{(unsigned char*)Hb};
          pg8::gemm_phase<pg8::EpiGU8, pg8::MoeGatherOrder, GEMM_ALIGN, GEMM_SP2>(lds, g, S, E); });
        GRID_BAR();
        PHASE(2, { pg8::Gemm g{Hb, (const bf16_t*)(wl + W_D), MOE_ROWS, 16384, 256, wave_s}; pg8::MoeOrder S{(const LAS int*)(lds + TILEE_OFF), (int)MISC[33] * 4, G, bid};
          pg8::EpiPlain8 E{(unsigned char*)Xs, D, 3};
          pg8::gemm_phase<pg8::EpiPlain8, pg8::MoeOrder, GEMM_ALIGN, GEMM_SP2>(lds, g, S, E); });
        GRID_BAR();
        if (REP_MASK & (1 << 8)) { ln_phase<2>(lds, args, l, 2, l == 1, Z, bid, G, wave_s); GRID_BAR(); }
        ln_phase<2>(lds, args, l, 2, l == 1, X, bid, G, wave_s);
        if (l == 0) GRID_BAR();
    }
}
#undef X
#undef P
#undef Y
#undef Z
#undef Qb
#undef Ob
#undef Xs
#undef Hb
#undef KV
#undef wl
}

extern "C" void kernel_launch(void* const* d_in, const int* in_sizes, int n_in, void* d_out, int out_size, void* d_ws, size_t ws_size, hipStream_t stream) {
    using namespace mk;
    static int grid = 0;
    if (grid == 0) {
        if (n_in != 22 || in_sizes[0] != M * D || out_size != M * D || ws_size < WS_END) { fprintf(stderr, "kernel_launch: unexpected shapes (n_in %d, in0 %d, out %d, ws %zu, need %zu)\n", n_in, n_in > 0 ? in_sizes[0] : -1, out_size, ws_size, (size_t)WS_END); grid = -1; return; }
        int dev = 0, cus = 0;
        if (hipGetDevice(&dev) != hipSuccess || hipDeviceGetAttribute(&cus, hipDeviceAttributeMultiprocessorCount, dev) != hipSuccess) { grid = -1; return; }
        if (hipFuncSetAttribute((const void*)mk_fwd, hipFuncAttributeMaxDynamicSharedMemorySize, LDS_BYTES) != hipSuccess) { fprintf(stderr, "kernel_launch: hipFuncSetAttribute failed\n"); grid = -1; return; }
        int per_cu = 0;
        if (hipOccupancyMaxActiveBlocksPerMultiprocessor(&per_cu, (const void*)mk_fwd, NTHR, LDS_BYTES) != hipSuccess || per_cu < 1) fprintf(stderr, "kernel_launch: occupancy query says %d\n", per_cu);
        (void)hipGetLastError();
        grid = cus;
    }
    if (grid < 0) return;
    if (hipMemsetAsync((char*)d_ws + WS_CTL, 0, CTL_ZERO_BYTES, stream) != hipSuccess) return;
    Args a{};
    for (int i = 0; i < 22; ++i) a.in[i] = (const float*)d_in[i];
    a.out = (float*)d_out; a.ws = (unsigned char*)d_ws;
    hipLaunchKernelGGL(mk_fwd, dim3(grid), dim3(NTHR), LDS_BYTES, stream, a);
}
```

```cpp
#include <hip/hip_runtime.h>
#include <cstdio>
#include <cstdint>

namespace pg8 {
#define PG8_LAS __attribute__((address_space(3)))
typedef unsigned short bf16_t;
typedef short bf16x8 __attribute__((ext_vector_type(8)));
typedef float f32x4 __attribute__((ext_vector_type(4)));
typedef unsigned u32x4 __attribute__((ext_vector_type(4)));
typedef unsigned u32x2 __attribute__((ext_vector_type(2)));
constexpr int BM = 256, BK = 64, HALF = 128, HTB = HALF * BK * 2  , STAGE_BYTES = 8 * HTB, NXCD = 8, WGM = 8;

__host__ __device__ __forceinline__ int lds_byte(int r, int c) { const int st = (r >> 4) * 2 + (c >> 5), rr = r & 15, cc = c & 31, ob = rr * 64 + cc * 2; return st * 1024 + (ob ^ (((ob >> 9) & 1) << 5)); }
__host__ __device__ __forceinline__ void stage_rc(int b, int& R, int& C) { const int st = b / 1024, sb = b % 1024, swz = sb ^ (((sb >> 9) & 1) << 5); R = (st >> 1) * 16 + swz / 64; C = (st & 1) * 32 + (swz % 64) / 2; }
__host__ __device__ __forceinline__ int perm32(int rho) { const int n = rho >> 4, i = rho & 15; return 8 * (i >> 2) + 4 * n + (i & 3); }

struct Unit { int pm, pn; };
struct Gemm { const bf16_t* A; const bf16_t* Bt; int M, N, K; int wv; };
__device__ __forceinline__ int lane_id() { int l; asm volatile("v_mbcnt_lo_u32_b32 %0, -1, 0\n\tv_mbcnt_hi_u32_b32 %0, -1, %0" : "=v"(l)); return l; }

struct StaticOrder {
    static constexpr bool GATHER = false;
    int nM, nN, nwg, G, c; const int* src = nullptr;
    __host__ __device__ void init(int M, int N, int G_, int c_) { nM = M / BM; nN = N / BM; nwg = nM * nN; G = G_; c = c_; }
    __host__ __device__ bool next(int i, Unit& u) const {
        const long L = (long)i * G + c; if (L >= nwg) return false;
        int wgid = (int)L; { const int q = nwg / NXCD, r = nwg % NXCD, xcd = wgid % NXCD, off = wgid / NXCD; wgid = (xcd < r ? xcd * (q + 1) : r * (q + 1) + (xcd - r) * q) + off; }
        const int nig = WGM * nN, gid = wgid / nig, fm = gid * WGM, gsz = (nM - fm) < WGM ? (nM - fm) : WGM;
        u.pm = fm + ((wgid % nig) % gsz); u.pn = (wgid % nig) / gsz; return true;
    }
    __device__ __forceinline__ void a_ready(const Unit&) const {}
    __device__ __forceinline__ void done(const Unit&) const {}
};
struct PanelOrder {
    static constexpr bool GATHER = false;
    int nN, npan, G, c; const int* src = nullptr;
    __device__ __forceinline__ bool next(int i, Unit& u) const { const int p = c + (i / nN) * G; if (p >= npan) return false; u.pm = p; u.pn = i % nN; return true; }
    __device__ __forceinline__ void a_ready(const Unit&) const {}
    __device__ __forceinline__ void done(const Unit&) const {}
};
template <bool GATH_> struct MoeOrderT {
    static constexpr bool GATHER = GATH_;
    const PG8_LAS int* tile_e; int nunits, G, c; const int* src = nullptr;
    __device__ __forceinline__ bool next(int i, Unit& u) const {
        const int cc = ((G & 7) == 0) ? (c & 7) * (G >> 3) + (c >> 3) : c;
        const int L = i * G + cc; if (L >= nunits) return false;
        u.pm = L >> 2; u.pn = tile_e[L >> 2] * 4 + (L & 3); return true;
    }
    __device__ __forceinline__ void a_ready(const Unit&) const {}
    __device__ __forceinline__ void done(const Unit&) const {}
};
typedef MoeOrderT<false> MoeOrder; typedef MoeOrderT<true> MoeGatherOrder;

typedef float f32x2_t __attribute__((ext_vector_type(2))); typedef __bf16 bf16x2_t __attribute__((ext_vector_type(2)));
typedef __amdgpu_buffer_rsrc_t rsrc_t;
__device__ __forceinline__ rsrc_t mk_rsrc(const void* p) { return __builtin_amdgcn_make_buffer_rsrc((void*)p, 0, 0x7fffffff, 0x00020000); }
__device__ __forceinline__ u32x4 bld4(rsrc_t r, unsigned voff, unsigned soff) { return __builtin_bit_cast(u32x4, __builtin_amdgcn_raw_buffer_load_b128(r, voff, soff, 0)); }
__device__ __forceinline__ f32x2_t bld2f(rsrc_t r, unsigned voff, unsigned soff) { return __builtin_bit_cast(f32x2_t, __builtin_amdgcn_raw_buffer_load_b64(r, voff, soff, 0)); }
#define GST4(p) (*(__attribute__((address_space(1))) u32x4*)(p))
__device__ __forceinline__ float f8clamp(float x) { return __builtin_fminf(__builtin_fmaxf(x, -448.0f), 448.0f); }
__device__ __forceinline__ unsigned pk4f8(float a, float b, float c, float d) { int w = 0; w = __builtin_amdgcn_cvt_pk_fp8_f32(f8clamp(a), f8clamp(b), w, false); w = __builtin_amdgcn_cvt_pk_fp8_f32(f8clamp(c), f8clamp(d), w, true); return (unsigned)w; }
constexpr float F8_SX = 4.0f, F8_SW = 64.0f, F8_SH = 8.0f, F8_SO = 64.0f, F8_SY = 16.0f, F8_SQ = 64.0f;
__device__ __forceinline__ unsigned pk2(float lo, float hi) { f32x2_t v = {lo, hi}; bf16x2_t b = __builtin_convertvector(v, bf16x2_t); return __builtin_bit_cast(unsigned, b); }
__device__ __forceinline__ float bflo(unsigned w) { return __builtin_bit_cast(float, w << 16); }
__device__ __forceinline__ float bfhi(unsigned w) { return __builtin_bit_cast(float, w & 0xffff0000u); }
__device__ __forceinline__ float f_silu(float x) { return x * __builtin_amdgcn_rcpf(1.0f + __builtin_amdgcn_exp2f(-1.4426950408889634f * x)); }
__device__ __forceinline__ float f_gelu_tanh(float x) { return x * __builtin_amdgcn_rcpf(1.0f + __builtin_amdgcn_exp2f(x * (-2.3022082f - 0.10294324f * x * x))); }
__device__ __forceinline__ float f_logsig16(float z) { const float t = __builtin_amdgcn_exp2f(-1.4426950408889634f * __builtin_fabsf(z)); return (__builtin_fminf(z, 0.0f) - 0.6931471805599453f * __builtin_amdgcn_logf(1.0f + t)) * 0.0625f; }

struct EpiPlain {
    static constexpr bool PERM = true, AFTER_DRAIN = false;
    bf16_t* O; int ldc; int cmask;
    __device__ __forceinline__ void operator()(const f32x4 (&acc)[2][2][4][2], const Unit& u, int wr, int wc, int fr, int fq) const {
        const int row0 = u.pm * BM + wr * 64 + fr, col0 = (u.pn & cmask) * BM + wc * 32 + 8 * fq;
#pragma unroll
        for (int ai = 0; ai < 2; ++ai)
#pragma unroll
            for (int m = 0; m < 4; ++m) { bf16_t* rowp = O + (size_t)(row0 + ai * HALF + m * 16) * ldc + col0;
#pragma unroll
                for (int bj = 0; bj < 2; ++bj) { const f32x4 v0 = acc[ai][bj][m][0], v1 = acc[ai][bj][m][1];
                    u32x4 w; w.x = pk2(v0[0], v0[1]); w.y = pk2(v0[2], v0[3]); w.z = pk2(v1[0], v1[1]); w.w = pk2(v1[2], v1[3]);
                    *(u32x4*)(rowp + bj * HALF) = w; } }
    }
};
struct EpiQFrag {
    static constexpr bool PERM = true, AFTER_DRAIN = false;
    bf16_t* O;
    __device__ __forceinline__ void operator()(const f32x4 (&acc)[2][2][4][2], const Unit& u, int wr, int wc, int fr, int fq) const {
        unsigned lo = (unsigned)(((fq >> 1) * 64 + fr + 32 * (fq & 1)) * 16); asm volatile("" : "+v"(lo));
        char* tile = (char*)(O + (size_t)(u.pm * 4 + u.pn) * 65536) + (size_t)(wr * 2 * 16 + wc * 2) * 1024 + lo;
#pragma unroll
        for (int ai = 0; ai < 2; ++ai)
#pragma unroll
            for (int m = 0; m < 4; ++m)
#pragma unroll
                for (int bj = 0; bj < 2; ++bj) { const f32x4 v0 = acc[ai][bj][m][0], v1 = acc[ai][bj][m][1];
                    u32x4 w; w.x = pk2(v0[0], v0[1]); w.y = pk2(v0[2], v0[3]); w.z = pk2(v1[0], v1[1]); w.w = pk2(v1[2], v1[3]);
                    *(u32x4*)(tile + ((4 * ai + (m >> 1)) * 16 + 8 * bj) * 1024 + (m & 1) * 256) = w; }
    }
};
struct EpiInProj {
    static constexpr bool PERM = true, AFTER_DRAIN = false;
    bf16_t* O; const float* b_a;
    template <int MODE> __device__ __forceinline__ void tile(const f32x4 (&acc)[2][2][4][2], const Unit& u, int wr, int wc, int fr, int fq) const {
        const int row0 = u.pm * BM + wr * 64 + fr, col0 = u.pn * BM + wc * 32 + 8 * fq;
        f32x4 bv[2][2];
#pragma unroll
        for (int bj = 0; bj < 2; ++bj)
#pragma unroll
            for (int n = 0; n < 2; ++n) bv[bj][n] = (MODE == 2) ? *(const f32x4*)(b_a + (col0 - 1536) + bj * HALF + 4 * n) : (f32x4){0.f, 0.f, 0.f, 0.f};
#pragma unroll
        for (int ai = 0; ai < 2; ++ai)
#pragma unroll
            for (int m = 0; m < 4; ++m) { bf16_t* rowp = O + (size_t)(row0 + ai * HALF + m * 16) * 2816 + col0;
#pragma unroll
                for (int bj = 0; bj < 2; ++bj) { f32x4 v0 = acc[ai][bj][m][0], v1 = acc[ai][bj][m][1];
#pragma unroll
                    for (int j = 0; j < 4; ++j) {
                        if (MODE == 1) { v0[j] = f_silu(v0[j]); v1[j] = f_silu(v1[j]); }
                        if (MODE == 2) { v0[j] = f_logsig16(v0[j] + bv[bj][0][j]); v1[j] = f_logsig16(v1[j] + bv[bj][1][j]); }
                        if (MODE == 3) { v0[j] = f_gelu_tanh(v0[j]); v1[j] = f_gelu_tanh(v1[j]); } }
                    u32x4 w; w.x = pk2(v0[0], v0[1]); w.y = pk2(v0[2], v0[3]); w.z = pk2(v1[0], v1[1]); w.w = pk2(v1[2], v1[3]);
                    *(u32x4*)(rowp + bj * HALF) = w; } }
    }
    __device__ __forceinline__ void operator()(const f32x4 (&acc)[2][2][4][2], const Unit& u, int wr, int wc, int fr, int fq) const {
        const int pn = u.pn;
        if (pn < 4) tile<0>(acc, u, wr, wc, fr, fq); else if (pn < 6) tile<1>(acc, u, wr, wc, fr, fq); else if (pn == 6) tile<2>(acc, u, wr, wc, fr, fq); else tile<3>(acc, u, wr, wc, fr, fq);
    }
};
struct EpiInProj8 {
    static constexpr bool PERM = true, AFTER_DRAIN = false, F8 = true; static constexpr float dq = 1.0f / (F8_SX * F8_SW);
    bf16_t* O; const float* b_a;
    template <int MODE> __device__ __forceinline__ void tile(const f32x4 (&acc)[2][2][4][2], const Unit& u, int wr, int wc, int fr, int fq) const {
        const int row0 = u.pm * BM + wr * 64 + fr, col0 = u.pn * BM + wc * 32 + 8 * fq;
        f32x4 bv[2][2];
#pragma unroll
        for (int bj = 0; bj < 2; ++bj)
#pragma unroll
            for (int n = 0; n < 2; ++n) bv[bj][n] = (MODE == 2) ? *(const f32x4*)(b_a + (col0 - 1536) + bj * HALF + 4 * n) : (f32x4){0.f, 0.f, 0.f, 0.f};
#pragma unroll
        for (int ai = 0; ai < 2; ++ai)
#pragma unroll
            for (int m = 0; m < 4; ++m) { bf16_t* rowp = O + (size_t)(row0 + ai * HALF + m * 16) * 2816 + col0;
#pragma unroll
                for (int bj = 0; bj < 2; ++bj) { f32x4 v0 = acc[ai][bj][m][0] * dq, v1 = acc[ai][bj][m][1] * dq;
#pragma unroll
                    for (int j = 0; j < 4; ++j) {
                        if (MODE == 1) { v0[j] = f_silu(v0[j]); v1[j] = f_silu(v1[j]); }
                        if (MODE == 2) { v0[j] = f_logsig16(v0[j] + bv[bj][0][j]); v1[j] = f_logsig16(v1[j] + bv[bj][1][j]); }
                        if (MODE == 3) { v0[j] = f_gelu_tanh(v0[j]); v1[j] = f_gelu_tanh(v1[j]); } }
                    u32x4 w; w.x = pk2(v0[0], v0[1]); w.y = pk2(v0[2], v0[3]); w.z = pk2(v1[0], v1[1]); w.w = pk2(v1[2], v1[3]);
                    *(u32x4*)(rowp + bj * HALF) = w; } }
    }
    __device__ __forceinline__ void operator()(const f32x4 (&acc)[2][2][4][2], const Unit& u, int wr, int wc, int fr, int fq) const {
        const int pn = u.pn;
        if (pn < 4) tile<0>(acc, u, wr, wc, fr, fq); else if (pn < 6) tile<1>(acc, u, wr, wc, fr, fq); else if (pn == 6) tile<2>(acc, u, wr, wc, fr, fq); else tile<3>(acc, u, wr, wc, fr, fq);
    }
};
struct EpiResid {
    static constexpr bool PERM = true, AFTER_DRAIN = false;
    const bf16_t* X; bf16_t* Z; float alpha;
    __device__ __forceinline__ void operator()(const f32x4 (&acc)[2][2][4][2], const Unit& u, int wr, int wc, int fr, int fq) const {
        const int row0 = u.pm * BM + wr * 64 + fr, col0 = u.pn * BM + wc * 32 + 8 * fq;
#pragma unroll
        for (int ai = 0; ai < 2; ++ai)
#pragma unroll
            for (int m = 0; m < 4; ++m) { const size_t off = (size_t)(row0 + ai * HALF + m * 16) * 1024 + col0;
#pragma unroll
                for (int bj = 0; bj < 2; ++bj) { const f32x4 v0 = acc[ai][bj][m][0], v1 = acc[ai][bj][m][1];
                    const u32x4 xr = *(const u32x4*)(X + off + bj * HALF);
                    u32x4 w; w.x = pk2(alpha * bflo(xr.x) + v0[0], alpha * bfhi(xr.x) + v0[1]); w.y = pk2(alpha * bflo(xr.y) + v0[2], alpha * bfhi(xr.y) + v0[3]);
                    w.z = pk2(alpha * bflo(xr.z) + v1[0], alpha * bfhi(xr.z) + v1[1]); w.w = pk2(alpha * bflo(xr.w) + v1[2], alpha * bfhi(xr.w) + v1[3]);
                    *(u32x4*)(Z + off + bj * HALF) = w; } }
    }
};
struct EpiResidStats {
    static constexpr bool PERM = true, AFTER_DRAIN = false;
    const bf16_t* X; bf16_t* Z; f32x2_t* part; static constexpr float alpha = 1.4142135623730951f;
    __device__ __forceinline__ void operator()(const f32x4 (&acc)[2][2][4][2], const Unit& u, int wr, int wc, int fr, int fq) const {
        const int row0 = u.pm * BM + wr * 64 + fr, col0 = u.pn * BM + wc * 32 + 8 * fq;
        int ln = 16 * fq + fr; asm volatile("" : "+v"(ln));
        float s1[8], s2[8];
        const rsrc_t rx = mk_rsrc(X); const unsigned voff = ((unsigned)row0 * 1024u + (unsigned)col0) * 2u;
        u32x4 xres[2][4][2];
#pragma unroll
        for (int ai = 0; ai < 2; ++ai)
#pragma unroll
            for (int m = 0; m < 4; ++m)
#pragma unroll
                for (int bj = 0; bj < 2; ++bj) xres[ai][m][bj] = bld4(rx, voff, (unsigned)(((ai * HALF + m * 16) * 1024 + bj * HALF) * 2));
        __builtin_amdgcn_sched_barrier(0);
#pragma unroll
        for (int ai = 0; ai < 2; ++ai)
#pragma unroll
            for (int m = 0; m < 4; ++m) { const size_t off = (size_t)(row0 + ai * HALF + m * 16) * 1024 + col0; float a1 = 0.f, a2 = 0.f;
#pragma unroll
                for (int bj = 0; bj < 2; ++bj) { const f32x4 v0 = acc[ai][bj][m][0], v1 = acc[ai][bj][m][1];
                    const u32x4 xr = xres[ai][m][bj];
                    u32x4 w; w.x = pk2(alpha * bflo(xr.x) + v0[0], alpha * bfhi(xr.x) + v0[1]); w.y = pk2(alpha * bflo(xr.y) + v0[2], alpha * bfhi(xr.y) + v0[3]);
                    w.z = pk2(alpha * bflo(xr.z) + v1[0], alpha * bfhi(xr.z) + v1[1]); w.w = pk2(alpha * bflo(xr.w) + v1[2], alpha * bfhi(xr.w) + v1[3]);
                    GST4(Z + off + bj * HALF) = w;
                    const float z0 = bflo(w.x), z1 = bfhi(w.x), z2 = bflo(w.y), z3 = bfhi(w.y), z4 = bflo(w.z), z5 = bfhi(w.z), z6 = bflo(w.w), z7 = bfhi(w.w);
                    a1 += ((z0 + z1) + (z2 + z3)) + ((z4 + z5) + (z6 + z7)); a2 += ((z0 * z0 + z1 * z1) + (z2 * z2 + z3 * z3)) + ((z4 * z4 + z5 * z5) + (z6 * z6 + z7 * z7)); }
                s1[ai * 4 + m] = a1; s2[ai * 4 + m] = a2; }
        const bool h5 = (ln & 32) != 0, h4 = (ln & 16) != 0;
        float t1[4], t2[4];
#pragma unroll
        for (int i = 0; i < 4; ++i) { const float m1 = h5 ? s1[4 + i] : s1[i], g1 = h5 ? s1[i] : s1[4 + i], m2 = h5 ? s2[4 + i] : s2[i], g2 = h5 ? s2[i] : s2[4 + i];
            t1[i] = m1 + __builtin_bit_cast(float, __builtin_amdgcn_ds_bpermute((ln ^ 32) << 2, __builtin_bit_cast(int, g1)));
            t2[i] = m2 + __builtin_bit_cast(float, __builtin_amdgcn_ds_bpermute((ln ^ 32) << 2, __builtin_bit_cast(int, g2))); }
        float r1[2], r2[2];
#pragma unroll
        for (int i = 0; i < 2; ++i) { const float m1 = h4 ? t1[2 + i] : t1[i], g1 = h4 ? t1[i] : t1[2 + i], m2 = h4 ? t2[2 + i] : t2[i], g2 = h4 ? t2[i] : t2[2 + i];
            r1[i] = m1 + __builtin_bit_cast(float, __builtin_amdgcn_ds_bpermute((ln ^ 16) << 2, __builtin_bit_cast(int, g1)));
            r2[i] = m2 + __builtin_bit_cast(float, __builtin_amdgcn_ds_bpermute((ln ^ 16) << 2, __builtin_bit_cast(int, g2))); }
#pragma unroll
        for (int i = 0; i < 2; ++i) { const int gi = (h5 ? 4 : 0) + (h4 ? 2 : 0) + i, row = row0 + (gi >> 2) * HALF + (gi & 3) * 16;
            part[(size_t)row * 16 + u.pn * 4 + wc] = (f32x2_t){r1[i], r2[i]}; }
    }
};
struct EpiQFragLN {
    static constexpr bool PERM = true, AFTER_DRAIN = false;
    unsigned char* O; const f32x2_t* stats; const float* csum; const float* bq;
    __device__ __forceinline__ void operator()(const f32x4 (&acc)[2][2][4][2], const Unit& u, int wr, int wc, int fr, int fq) const {
        unsigned lo = (unsigned)(((fq >> 1) * 64 + fr + 32 * (fq & 1)) * 16); asm volatile("" : "+v"(lo));
        unsigned char* tile = O + (size_t)(u.pm * 4 + u.pn) * 65536 + (size_t)(wr * 2 * 8 + wc * 2) * 1024 + lo;
        const int row0 = u.pm * BM + wr * 64 + fr, col0 = u.pn * BM + wc * 32 + 8 * fq;
        f32x4 cc[2][2], bb[2][2];
#pragma unroll
        for (int bj = 0; bj < 2; ++bj)
#pragma unroll
            for (int n = 0; n < 2; ++n) { cc[bj][n] = *(const f32x4*)(csum + col0 + bj * HALF + 4 * n); bb[bj][n] = *(const f32x4*)(bq + col0 + bj * HALF + 4 * n); }
#pragma unroll
        for (int ai = 0; ai < 2; ++ai)
#pragma unroll
            for (int m = 0; m < 4; ++m) { const f32x2_t st = stats[row0 + ai * HALF + m * 16]; const float mu = st[0], rs = st[1] * F8_SQ; u32x4 w;
#pragma unroll
                for (int bj = 0; bj < 2; ++bj) { const f32x4 v0 = (acc[ai][bj][m][0] - mu * cc[bj][0]) * rs + bb[bj][0] * F8_SQ, v1 = (acc[ai][bj][m][1] - mu * cc[bj][1]) * rs + bb[bj][1] * F8_SQ;
                    const unsigned lo4 = pk4f8(v0[0], v0[1], v0[2], v0[3]), hi4 = pk4f8(v1[0], v1[1], v1[2], v1[3]);
                    if (bj == 0) { w.x = lo4; w.y = hi4; } else { w.z = lo4; w.w = hi4; } }
                *(u32x4*)(tile + (4 * ai + (m >> 1)) * 8192 + (m & 1) * 256) = w; }
    }
};
struct EpiResidLN {
    static constexpr bool PERM = true, AFTER_DRAIN = false;
    bf16_t* Z; const f32x2_t* stats; const float* gain; const float* bias; static constexpr float alpha = 1.4142135623730951f;
    __device__ __forceinline__ void operator()(const f32x4 (&acc)[2][2][4][2], const Unit& u, int wr, int wc, int fr, int fq) const {
        const int row0 = u.pm * BM + wr * 64 + fr, col0 = u.pn * BM + wc * 32 + 8 * fq;
        const rsrc_t rz = mk_rsrc(Z), rs = mk_rsrc(stats); const unsigned voff = ((unsigned)row0 * 1024u + (unsigned)col0) * 2u;
        f32x2_t st[2][4];
#pragma unroll
        for (int ai = 0; ai < 2; ++ai)
#pragma unroll
            for (int m = 0; m < 4; ++m) st[ai][m] = bld2f(rs, (unsigned)row0 * 8u, (unsigned)((ai * HALF + m * 16) * 8));
#pragma unroll
        for (int bj = 0; bj < 2; ++bj) {
            u32x4 zres[2][4];
#pragma unroll
            for (int ai = 0; ai < 2; ++ai)
#pragma unroll
                for (int m = 0; m < 4; ++m) zres[ai][m] = bld4(rz, voff, (unsigned)(((ai * HALF + m * 16) * 1024 + bj * HALF) * 2));
            const f32x4 g0 = *(const f32x4*)(gain + col0 + bj * HALF) * alpha, g1 = *(const f32x4*)(gain + col0 + bj * HALF + 4) * alpha, b0 = *(const f32x4*)(bias + col0 + bj * HALF) * alpha, b1 = *(const f32x4*)(bias + col0 + bj * HALF + 4) * alpha;
            __builtin_amdgcn_sched_barrier(0);
#pragma unroll
            for (int ai = 0; ai < 2; ++ai)
#pragma unroll
                for (int m = 0; m < 4; ++m) { const int row = row0 + ai * HALF + m * 16; const float mu = st[ai][m][0], rsd = st[ai][m][1];
                    const u32x4 zr = zres[ai][m];
                    const f32x4 z0 = (f32x4){bflo(zr.x), bfhi(zr.x), bflo(zr.y), bfhi(zr.y)}, z1 = (f32x4){bflo(zr.z), bfhi(zr.z), bflo(zr.w), bfhi(zr.w)};
                    const f32x4 v0 = (z0 - mu) * rsd * g0 + b0 + acc[ai][bj][m][0], v1 = (z1 - mu) * rsd * g1 + b1 + acc[ai][bj][m][1];
                    u32x4 w; w.x = pk2(v0[0], v0[1]); w.y = pk2(v0[2], v0[3]); w.z = pk2(v1[0], v1[1]); w.w = pk2(v1[2], v1[3]);
                    GST4(Z + (size_t)row * 1024 + col0 + bj * HALF) = w; } }
    }
};
struct EpiResidLN8 {
    static constexpr bool PERM = true, AFTER_DRAIN = false, F8 = true; static constexpr float dq = 1.0f / (F8_SO * F8_SW);
    bf16_t* Z; const f32x2_t* stats; const float* gain; const float* bias; static constexpr float alpha = 1.4142135623730951f;
    __device__ __forceinline__ void operator()(const f32x4 (&acc)[2][2][4][2], const Unit& u, int wr, int wc, int fr, int fq) const {
        const int row0 = u.pm * BM + wr * 64 + fr, col0 = u.pn * BM + wc * 32 + 8 * fq;
        const rsrc_t rz = mk_rsrc(Z), rs = mk_rsrc(stats); const unsigned voff = ((unsigned)row0 * 1024u + (unsigned)col0) * 2u;
        f32x2_t st[2][4];
#pragma unroll
        for (int ai = 0; ai < 2; ++ai)
#pragma unroll
            for (int m = 0; m < 4; ++m) st[ai][m] = bld2f(rs, (unsigned)row0 * 8u, (unsigned)((ai * HALF + m * 16) * 8));
#pragma unroll
        for (int bj = 0; bj < 2; ++bj) {
            u32x4 zres[2][4];
#pragma unroll
            for (int ai = 0; ai < 2; ++ai)
#pragma unroll
                for (int m = 0; m < 4; ++m) zres[ai][m] = bld4(rz, voff, (unsigned)(((ai * HALF + m * 16) * 1024 + bj * HALF) * 2));
            const f32x4 g0 = *(const f32x4*)(gain + col0 + bj * HALF) * alpha, g1 = *(const f32x4*)(gain + col0 + bj * HALF + 4) * alpha, b0 = *(const f32x4*)(bias + col0 + bj * HALF) * alpha, b1 = *(const f32x4*)(bias + col0 + bj * HALF + 4) * alpha;
            __builtin_amdgcn_sched_barrier(0);
#pragma unroll
            for (int ai = 0; ai < 2; ++ai)
#pragma unroll
                for (int m = 0; m < 4; ++m) { const int row = row0 + ai * HALF + m * 16; const float mu = st[ai][m][0], rsd = st[ai][m][1];
                    const u32x4 zr = zres[ai][m];
                    const f32x4 z0 = (f32x4){bflo(zr.x), bfhi(zr.x), bflo(zr.y), bfhi(zr.y)}, z1 = (f32x4){bflo(zr.z), bfhi(zr.z), bflo(zr.w), bfhi(zr.w)};
                    const f32x4 v0 = (z0 - mu) * rsd * g0 + b0 + acc[ai][bj][m][0] * dq, v1 = (z1 - mu) * rsd * g1 + b1 + acc[ai][bj][m][1] * dq;
                    u32x4 w; w.x = pk2(v0[0], v0[1]); w.y = pk2(v0[2], v0[3]); w.z = pk2(v1[0], v1[1]); w.w = pk2(v1[2], v1[3]);
                    GST4(Z + (size_t)row * 1024 + col0 + bj * HALF) = w; } }
    }
};
struct EpiGU {
    static constexpr bool PERM = true, AFTER_DRAIN = false;
    bf16_t* H;
    __device__ __forceinline__ void operator()(const f32x4 (&acc)[2][2][4][2], const Unit& u, int wr, int wc, int fr, int fq) const {
        const int row0 = u.pm * BM + wr * 64 + fr, col0 = (u.pn & 3) * 128 + wc * 16 + 4 * fq;
#pragma unroll
        for (int ai = 0; ai < 2; ++ai)
#pragma unroll
            for (int m = 0; m < 4; ++m) { bf16_t* rowp = H + (size_t)(row0 + ai * HALF + m * 16) * 512 + col0;
#pragma unroll
                for (int bj = 0; bj < 2; ++bj) { const f32x4 g = acc[ai][bj][m][0], up = acc[ai][bj][m][1];
                    u32x2 w; w.x = pk2(f_silu(g[0]) * up[0], f_silu(g[1]) * up[1]); w.y = pk2(f_silu(g[2]) * up[2], f_silu(g[3]) * up[3]);
                    *(u32x2*)(rowp + bj * 64) = w; } }
    }
};
struct EpiGU8 {
    static constexpr bool PERM = true, AFTER_DRAIN = false, F8 = true;
    unsigned char* H;
    __device__ __forceinline__ void operator()(const f32x4 (&acc)[2][2][4][2], const Unit& u, int wr, int wc, int fr, int fq) const {
        const int row0 = u.pm * BM + wr * 64 + fr, col0 = (u.pn & 3) * 128 + wc * 32 + 8 * fq;
        constexpr float dq = 1.0f / (F8_SX * F8_SW);
#pragma unroll
        for (int ai = 0; ai < 2; ++ai)
#pragma unroll
            for (int m = 0; m < 4; ++m) { float h[8];
#pragma unroll
                for (int n = 0; n < 2; ++n) { const f32x4 g = acc[ai][0][m][n] * dq, up = acc[ai][1][m][n] * (dq * F8_SH);
#pragma unroll
                    for (int i = 0; i < 4; ++i) h[4 * n + i] = f_silu(g[i]) * up[i]; }
                u32x2 w; w.x = pk4f8(h[0], h[1], h[2], h[3]); w.y = pk4f8(h[4], h[5], h[6], h[7]);
                *(u32x2*)(H + (size_t)(row0 + ai * HALF + m * 16) * 512 + col0) = w; }
    }
};
struct EpiPlain8 {
    static constexpr bool PERM = true, AFTER_DRAIN = false, F8 = true;
    unsigned char* O; int ldc; int cmask;
    __device__ __forceinline__ void operator()(const f32x4 (&acc)[2][2][4][2], const Unit& u, int wr, int wc, int fr, int fq) const {
        const int row0 = u.pm * BM + wr * 64 + fr, col0 = (u.pn & cmask) * BM + wc * 32 + 8 * fq;
        constexpr float dq = F8_SY / (F8_SH * F8_SW);
#pragma unroll
        for (int ai = 0; ai < 2; ++ai)
#pragma unroll
            for (int m = 0; m < 4; ++m) { unsigned char* rowp = O + (size_t)(row0 + ai * HALF + m * 16) * ldc + col0;
#pragma unroll
                for (int bj = 0; bj < 2; ++bj) { const f32x4 v0 = acc[ai][bj][m][0] * dq, v1 = acc[ai][bj][m][1] * dq;
                    u32x2 w; w.x = pk4f8(v0[0], v0[1], v0[2], v0[3]); w.y = pk4f8(v1[0], v1[1], v1[2], v1[3]);
                    *(u32x2*)(rowp + bj * HALF) = w; } }
    }
};

typedef int i32x4_t __attribute__((ext_vector_type(4)));
template <class T, class = void> struct epi_f8 { static constexpr bool value = false; };
template <class T> struct epi_f8<T, decltype((void)T::F8)> { static constexpr bool value = true; };
template <class Epi, class Sched, bool ALIGN_EPI = false, bool SP2 = false>
__device__ __forceinline__ void gemm_phase(PG8_LAS unsigned char* lds, const Gemm g, const Sched& S, const Epi& E) {
    int tid_ = g.wv * 64 + lane_id(); asm volatile("" : "+v"(tid_));
    const int tid = tid_, wid = __builtin_amdgcn_readfirstlane(tid >> 6), lane = tid & 63, wr = wid >> 2, wc = wid & 3, fr = lane & 15, fq = lane >> 4;
    const int K = g.K, nt = K / BK; constexpr bool F8 = epi_f8<Epi>::value;
    unsigned voffA[2], voffB[2];
#pragma unroll
    for (int i = 0; i < 2; ++i) { int R, C; stage_rc(tid * 16 + i * 8192, R, C); const int Rb = Epi::PERM ? ((R & ~31) + perm32(R & 31)) : R;
        voffA[i] = (unsigned)(R * K + C) * 2u;
        voffB[i] = (unsigned)(((Rb >> 4) * (K >> 5) + (C >> 5)) * 1024 + (Rb & 15) * 64 + (C & 31) * 2); }
    constexpr bool GATH = Sched::GATHER; static_assert(!GATH || SP2, "gather mode is written for the SP2 loop");
    unsigned goc[2][2] = {{0u, 0u}, {0u, 0u}}, gon[2][2] = {{0u, 0u}, {0u, 0u}}, go2[2][2] = {{0u, 0u}, {0u, 0u}};
#define PG8_GOFF(dst, U) do { int tg_ = tid; asm volatile("" : "+v"(tg_)); _Pragma("unroll") for (int i_ = 0; i_ < 2; ++i_) { int R_, C_; stage_rc(tg_ * 16 + i_ * 8192, R_, C_); \
        _Pragma("unroll") for (int h_ = 0; h_ < 2; ++h_) dst[h_][i_] = (unsigned)S.src[(U).pm * BM + h_ * HALF + R_] * (unsigned)(K * 2) + (unsigned)C_ * 2u; } } while (0)
    const size_t kstep = (size_t)(BK * 2);
    const size_t kstepB = 2048;
    const size_t hstep = (size_t)HALF * K * 2;
    const size_t tstep = 2 * hstep;
    const unsigned ldsw = (unsigned)wid * 1024u;
    const int aoff = lds_byte(wr * 64 + fr, fq * 8), boff = lds_byte(wc * 32 + fr, fq * 8);
#define PG8_SA(b, h) (((b) * 2 + (h)) * HTB)
#define PG8_SB(b, h) ((4 + (b) * 2 + (h)) * HTB)
#define PG8_STAGE(bufoff, gbase, voff) do { _Pragma("unroll") for (int _i = 0; _i < 2; ++_i) \
        __builtin_amdgcn_global_load_lds((const unsigned*)((const char*)(gbase) + (voff)[_i]), (PG8_LAS unsigned*)(lds + (bufoff) + ldsw + _i * 8192), 16, 0, 0); } while (0)
#define PG8_STAGE_A(b, h, PTR, KPTR, GO) do { if constexpr (GATH) { PG8_STAGE(PG8_SA(b, h), KPTR, GO); } else { PG8_STAGE(PG8_SA(b, h), PTR, voffA); } } while (0)
#define PG8_LDA(dst, b, h) do { _Pragma("unroll") for (int m = 0; m < 4; ++m) _Pragma("unroll") for (int k = 0; k < 2; ++k) dst[m][k] = *(const PG8_LAS bf16x8*)(lds + PG8_SA(b, h) + aoff + m * 2048 + k * 1024); } while (0)
#define PG8_LDB(dst, b, h) do { _Pragma("unroll") for (int n = 0; n < 2; ++n) _Pragma("unroll") for (int k = 0; k < 2; ++k) dst[n][k] = *(const PG8_LAS bf16x8*)(lds + PG8_SB(b, h) + boff + n * 2048 + k * 1024); } while (0)
#define PG8_CAT8(x, y) __builtin_shufflevector(__builtin_bit_cast(i32x4_t, x), __builtin_bit_cast(i32x4_t, y), 0, 1, 2, 3, 4, 5, 6, 7)
#define PG8_MMA(ai, bj, At, Bt) do { __builtin_amdgcn_s_setprio(1); \
        if constexpr (F8) { _Pragma("unroll") for (int m = 0; m < 4; ++m) _Pragma("unroll") for (int n = 0; n < 2; ++n) \
            asm volatile("v_mfma_f32_16x16x128_f8f6f4 %0, %1, %2, %0" : "+v"(acc[ai][bj][m][n]) : "v"(PG8_CAT8(Bt[n][0], Bt[n][1])), "v"(PG8_CAT8(At[m][0], At[m][1]))); } \
        else { _Pragma("unroll") for (int m = 0; m < 4; ++m) _Pragma("unroll") for (int n = 0; n < 2; ++n) _Pragma("unroll") for (int k = 0; k < 2; ++k) \
            acc[ai][bj][m][n] = __builtin_amdgcn_mfma_f32_16x16x32_bf16(Bt[n][k], At[m][k], acc[ai][bj][m][n], 0, 0, 0); } \
        __builtin_amdgcn_s_setprio(0); } while (0)
#define PG8_WAIT_V(n) asm volatile("s_waitcnt vmcnt(" #n ")" ::: "memory")
#define PG8_WAIT_L(n) asm volatile("s_waitcnt lgkmcnt(" #n ")" ::: "memory")
#define PG8_BAR __builtin_amdgcn_s_barrier()
#define PG8_SCHED __builtin_amdgcn_sched_barrier(0)
    Unit cur, nxt; int ui = 0;
    if (!S.next(0, cur)) return;
    f32x4 acc[2][2][4][2];
#pragma unroll
    for (int a = 0; a < 2; ++a)
#pragma unroll
        for (int b = 0; b < 2; ++b)
#pragma unroll
            for (int m = 0; m < 4; ++m)
#pragma unroll
                for (int n = 0; n < 2; ++n) { acc[a][b][m][n] = (f32x4){0.f, 0.f, 0.f, 0.f}; if constexpr (F8) asm volatile("" : "+v"(acc[a][b][m][n])); }
    bf16x8 At[4][2], B0[2][2], B1[2][2];
    const char* cA = (const char*)g.A + (size_t)cur.pm * tstep; const char* cB = (const char*)g.Bt + (size_t)cur.pn * tstep;
    S.a_ready(cur);
    const char* gA = (const char*)g.A;
    if constexpr (GATH) PG8_GOFF(goc, cur);
    if constexpr (SP2) {
        PG8_STAGE(PG8_SB(0, 0), cB, voffB); PG8_STAGE(PG8_SB(0, 1), cB + hstep, voffB); PG8_STAGE_A(0, 0, cA, gA, goc[0]); PG8_STAGE_A(0, 1, cA + hstep, gA, goc[1]);
        if (wr == 1) PG8_BAR;
        PG8_WAIT_V(2); PG8_BAR;
        PG8_STAGE(PG8_SB(1, 0), cB + kstepB, voffB); PG8_STAGE_A(1, 0, cA + kstep, gA + kstep, goc[0]); PG8_STAGE(PG8_SB(1, 1), cB + hstep + kstepB, voffB);
        PG8_WAIT_V(6); PG8_BAR;
    } else {
        PG8_STAGE(PG8_SB(0, 0), cB, voffB); PG8_STAGE(PG8_SA(0, 0), cA, voffA); PG8_STAGE(PG8_SB(0, 1), cB + hstep, voffB); PG8_STAGE(PG8_SA(0, 1), cA + hstep, voffA);
        if (wr == 1) PG8_BAR;
        PG8_WAIT_V(4); PG8_BAR;
        PG8_STAGE(PG8_SB(1, 0), cB + kstepB, voffB); PG8_STAGE(PG8_SA(1, 0), cA + kstep, voffA); PG8_STAGE(PG8_SB(1, 1), cB + hstep + kstepB, voffB);
        PG8_WAIT_V(6); PG8_BAR;
    }
    for (;;) {
        const bool has_next = S.next(ui + 1, nxt);
        if constexpr (GATH) { if (has_next) PG8_GOFF(gon, nxt); else { _Pragma("unroll") for (int h_ = 0; h_ < 2; ++h_) _Pragma("unroll") for (int i_ = 0; i_ < 2; ++i_) gon[h_][i_] = goc[h_][i_]; } }
        const char* nA = has_next ? (const char*)g.A + (size_t)nxt.pm * tstep : cA; const char* nB = has_next ? (const char*)g.Bt + (size_t)nxt.pn * tstep : cB;
        for (int t = 0; t < nt; t += 2) {
            const bool last = (t == nt - 2);
            const char* a1 = cA + (size_t)(t + 1) * kstep;
            const char* a2 = last ? nA : cA + (size_t)(t + 2) * kstep; const char* b2 = last ? nB : cB + (size_t)(t + 2) * kstepB;
            const char* a3 = a2 + kstep; const char* b3 = b2 + kstepB;
            if (last && has_next) S.a_ready(nxt);
            const char* ga1 = gA + (size_t)(t + 1) * kstep; const char* ga2 = last ? gA : gA + (size_t)(t + 2) * kstep; const char* ga3 = ga2 + kstep;
            if constexpr (GATH) { _Pragma("unroll") for (int h_ = 0; h_ < 2; ++h_) _Pragma("unroll") for (int i_ = 0; i_ < 2; ++i_) go2[h_][i_] = last ? gon[h_][i_] : goc[h_][i_]; }
            if constexpr (SP2) {
            PG8_LDB(B0, 0, 0); PG8_LDB(B1, 0, 1); PG8_SCHED; PG8_LDA(At, 0, 0); PG8_STAGE_A(1, 1, a1 + hstep, ga1, goc[1]);
            PG8_WAIT_V(8); PG8_WAIT_L(0); PG8_BAR; PG8_MMA(0, 0, At, B0); PG8_MMA(0, 1, At, B1); PG8_BAR; PG8_SCHED;
            PG8_LDA(At, 0, 1); PG8_STAGE(PG8_SB(0, 0), b2, voffB); PG8_STAGE(PG8_SB(0, 1), b2 + hstep, voffB); PG8_STAGE_A(0, 0, a2, ga2, go2[0]);
            PG8_WAIT_V(8); PG8_WAIT_L(0); PG8_BAR; PG8_MMA(1, 0, At, B0); PG8_MMA(1, 1, At, B1); PG8_BAR; PG8_SCHED;
            PG8_LDB(B0, 1, 0); PG8_LDB(B1, 1, 1); PG8_SCHED; PG8_LDA(At, 1, 0); PG8_STAGE_A(0, 1, a2 + hstep, ga2, go2[1]);
            PG8_WAIT_V(8); PG8_WAIT_L(0); PG8_BAR; PG8_MMA(0, 0, At, B0); PG8_MMA(0, 1, At, B1); PG8_BAR; PG8_SCHED;
            PG8_LDA(At, 1, 1); PG8_STAGE(PG8_SB(1, 0), b3, voffB); PG8_STAGE(PG8_SB(1, 1), b3 + hstep, voffB); PG8_STAGE_A(1, 0, a3, ga3, go2[0]);
            PG8_WAIT_V(8); PG8_WAIT_L(0); PG8_BAR; PG8_MMA(1, 0, At, B0); PG8_MMA(1, 1, At, B1); PG8_BAR; PG8_SCHED;
            } else {
            PG8_LDB(B0, 0, 0); PG8_SCHED; PG8_LDA(At, 0, 0); PG8_STAGE(PG8_SA(1, 1), a1 + hstep, voffA);
            PG8_WAIT_L(8); PG8_BAR; PG8_WAIT_L(0); PG8_MMA(0, 0, At, B0); PG8_BAR; PG8_SCHED;
            PG8_LDB(B1, 0, 1); PG8_STAGE(PG8_SB(0, 0), b2, voffB);
            PG8_BAR; PG8_WAIT_L(0); PG8_MMA(0, 1, At, B1); PG8_BAR;
            PG8_LDA(At, 0, 1); PG8_STAGE(PG8_SA(0, 0), a2, voffA);
            PG8_BAR; PG8_WAIT_L(0); PG8_MMA(1, 0, At, B0); PG8_BAR; PG8_SCHED;
            PG8_STAGE(PG8_SB(0, 1), b2 + hstep, voffB);
            PG8_WAIT_V(6); PG8_BAR; PG8_MMA(1, 1, At, B1); PG8_BAR;
            PG8_LDB(B0, 1, 0); PG8_SCHED; PG8_LDA(At, 1, 0); PG8_STAGE(PG8_SA(0, 1), a2 + hstep, voffA);
            PG8_WAIT_L(8); PG8_BAR; PG8_WAIT_L(0); PG8_MMA(0, 0, At, B0); PG8_BAR; PG8_SCHED;
            PG8_LDB(B1, 1, 1); PG8_STAGE(PG8_SB(1, 0), b3, voffB);
            PG8_BAR; PG8_WAIT_L(0); PG8_MMA(0, 1, At, B1); PG8_BAR;
            PG8_LDA(At, 1, 1); PG8_STAGE(PG8_SA(1, 0), a3, voffA);
            PG8_BAR; PG8_WAIT_L(0); PG8_MMA(1, 0, At, B0); PG8_BAR; PG8_SCHED;
            PG8_STAGE(PG8_SB(1, 1), b3 + hstep, voffB);
            PG8_WAIT_V(6); PG8_BAR; PG8_MMA(1, 1, At, B1); PG8_BAR;
            }
        }
        if constexpr (F8) asm volatile("s_nop 15\n\ts_nop 15" ::: "memory");
        if constexpr (ALIGN_EPI) { if (wr == 0) PG8_BAR; }
        if constexpr (!Epi::AFTER_DRAIN) { E(acc, cur, wr, wc, fr, fq); S.done(cur); }
        if (!has_next) break;
#pragma unroll
        for (int a = 0; a < 2; ++a)
#pragma unroll
            for (int b = 0; b < 2; ++b)
#pragma unroll
                for (int m = 0; m < 4; ++m)
#pragma unroll
                    for (int n = 0; n < 2; ++n) { acc[a][b][m][n] = (f32x4){0.f, 0.f, 0.f, 0.f}; if constexpr (F8) asm volatile("" : "+v"(acc[a][b][m][n])); }
        cur = nxt; cA = nA; cB = nB; ++ui;
        if constexpr (GATH) { _Pragma("unroll") for (int h_ = 0; h_ < 2; ++h_) _Pragma("unroll") for (int i_ = 0; i_ < 2; ++i_) goc[h_][i_] = gon[h_][i_]; }
        if constexpr (ALIGN_EPI) { if (wr == 1) PG8_BAR; }
    }
    PG8_WAIT_V(0);
    if constexpr (!ALIGN_EPI) { if (wr == 0) PG8_BAR; }
    PG8_BAR;
    if constexpr (Epi::AFTER_DRAIN) { E.fused(acc, cur, wr, wc, fr, fq, lds, wid, lane); S.done(cur); }
#undef PG8_SA
#undef PG8_SB
#undef PG8_STAGE
#undef PG8_STAGE_A
#undef PG8_GOFF
#undef PG8_LDA
#undef PG8_LDB
#undef PG8_MMA
#undef PG8_WAIT_V
#undef PG8_WAIT_L
#undef PG8_BAR
#undef PG8_SCHED
}}

namespace mk {
using pg8::bf16_t; using pg8::bf16x8; using pg8::f32x4; using pg8::u32x4; using pg8::u32x2; using pg8::pk2; using pg8::bflo; using pg8::bfhi;
typedef float f32x16 __attribute__((ext_vector_type(16)));
typedef short s16x4 __attribute__((ext_vector_type(4)));
typedef short v4i16_t __attribute__((ext_vector_type(4)));
#define LAS __attribute__((address_space(3)))
#define GAS __attribute__((address_space(1)))
typedef GAS unsigned gu32;
#define RLX_AGENT __ATOMIC_RELAXED, __HIP_MEMORY_SCOPE_AGENT
#define LDS_WAIT() asm volatile("s_waitcnt lgkmcnt(0)" ::: "memory")

constexpr int NB = 8, SEQ = 8192, M = NB * SEQ, D = 1024, NP = 2816, NMEM = 256, MKV = NB * NMEM;
constexpr int PQ = 0, PK = 256, PV = 512, PR = 1024, PG = 1536, PU = 1792, PVS = 2304;
constexpr int DIN = 2576;
constexpr int MOE_ROWS = 135168;
constexpr float ALPHA = 1.4142135623730951f, LN_EPS = 1e-5f, LOG2E = 1.4426950408889634f;
constexpr int NWAVES = 8, NTHR = 512;

constexpr size_t MiB = 1u << 20;
constexpr size_t WS_CTL = 0, CTL_ZERO_BYTES = 1 * MiB;
constexpr size_t WS_WM = 1 * MiB;
constexpr size_t WS_WGCNT = 1 * MiB + 512 * 1024;
constexpr size_t WS_LTOT = 1 * MiB + 768 * 1024;
constexpr size_t WS_TINFO = 2 * MiB;
constexpr size_t WS_TRANK = 3 * MiB;
constexpr size_t WS_TSLOT = 3 * MiB + 512 * 1024;
constexpr size_t WS_SEND = 4 * MiB;
constexpr size_t WS_WKV = 12 * MiB;
constexpr size_t WS_MEMB = 20 * MiB;
constexpr size_t WS_KV = 24 * MiB;
constexpr size_t WS_W = 40 * MiB, W_LAYER = 60 * MiB;
constexpr size_t W_IN = 0, W_OUT = (size_t)NP * D * 2, W_Q = W_OUT + 2 * MiB, W_O = W_Q + 2 * MiB, W_GU = W_O + 2 * MiB, W_D = W_GU + 32 * MiB;
static_assert(W_D + 16 * MiB <= W_LAYER, "weights per layer");
constexpr size_t WS_X = 160 * MiB;
constexpr size_t WS_R = 288 * MiB;
constexpr size_t R_P = 0, R_Y = 352 * MiB, R_Z = 480 * MiB, R_Q = 0, R_O = 128 * MiB, R_XS = 352 * MiB, R_H = 0;
constexpr size_t R_X8 = 256 * MiB;
constexpr size_t WS_SRCROW = WS_R + 616 * MiB;
constexpr size_t WS_PART = WS_SRCROW + 1 * MiB;
constexpr size_t WS_STATS = WS_PART + 8 * MiB;
constexpr size_t WS_CS = WS_STATS + 1 * MiB;
constexpr size_t WS_X8IN = WS_CS + 1 * MiB;
constexpr size_t WS_END = WS_X8IN + 64 * MiB;
static_assert(R_XS + (size_t)MOE_ROWS * D * 2 <= 616 * MiB && R_H + (size_t)MOE_ROWS * 512 * 2 <= R_XS, "moe buffers");
constexpr int CW_BAR = 4096;

constexpr int LDS_BYTES = 159744, LDSCTL_OFF = 155648;
constexpr int MISC_OFF = LDSCTL_OFF;
constexpr int TILEE_OFF = LDSCTL_OFF + 512;
static_assert(TILEE_OFF + 528 * 4 <= LDS_BYTES, "LDS map");

#define XB_TMO      128
#define XB_XCNT(j)  (256  + 64 * (j))
#define XB_XSUB(j)  (1280 + 64 * (j))
#define XB_XGEN(j)  (2304 + 64 * (j))
#define XB_TOP      3328
#define XB_TOPGEN   3392
#define XCD_BAR_WORDS 3456
#define XB_SPIN_CAP (1u << 18)

__device__ __forceinline__ unsigned xb_ld(unsigned* p)              { return __hip_atomic_load(p, __ATOMIC_RELAXED, __HIP_MEMORY_SCOPE_AGENT); }
__device__ __forceinline__ unsigned xb_add(unsigned* p, unsigned v) { return __hip_atomic_fetch_add(p, v, __ATOMIC_RELAXED, __HIP_MEMORY_SCOPE_AGENT); }
__device__ __forceinline__ unsigned xb_xcc_id() { return (unsigned)__builtin_amdgcn_s_getreg((3 << 11) | 20) & 0xFu; }
#define XB_SPIN(cond, bar) do { unsigned _sp = 0; while (cond) { __builtin_amdgcn_s_sleep(1); \
    if ((++_sp & 255u) == 0u) { if (xb_ld(&(bar)[XB_TMO])) break; if (_sp > XB_SPIN_CAP) { atomicAdd(&(bar)[XB_TMO], 1u); break; } } } } while (0)

struct XcdBarrier {
    unsigned* bar; unsigned x;
    volatile LAS unsigned* st;
    int wv;
};

__device__ __forceinline__ XcdBarrier xcd_barrier_post(unsigned* bar, volatile LAS unsigned* st) {
    XcdBarrier b; b.bar = bar; b.x = xb_xcc_id(); b.st = st; b.wv = 0;
    if (threadIdx.x == 0) (void)xb_add(&bar[XB_XCNT(b.x)], 1u);
    return b;
}
__device__ __forceinline__ void xcd_barrier_complete(unsigned* bar, unsigned x, unsigned& nloc, unsigned& nx) {
    const unsigned G = gridDim.x * gridDim.y * gridDim.z;
    unsigned sum, cnt, mine, sp = 0u;
    for (;;) {
        sum = 0u; cnt = 0u; mine = 0u;
#pragma unroll
        for (unsigned j = 0; j < 16; ++j) { const unsigned c = xb_ld(&bar[XB_XCNT(j)]); sum += c; cnt += (c > 0u) ? 1u : 0u; mine = (j == x) ? c : mine; }
        if (sum == G) break;
        __builtin_amdgcn_s_sleep(1);
        if ((++sp & 255u) == 0u) { if (xb_ld(&bar[XB_TMO])) break; if (sp > XB_SPIN_CAP) { atomicAdd(&bar[XB_TMO], 1u); break; } }
    }
    nloc = mine > 0u ? mine : 1u; nx = cnt > 0u ? cnt : 1u;
}

__device__ __forceinline__ void xcd_barrier(const XcdBarrier& b) {
    asm volatile("s_waitcnt vmcnt(0)" ::: "memory");
    __syncthreads();
    if (b.wv == 0 && pg8::lane_id() == 0) {
        unsigned* bar = b.bar;
        __builtin_amdgcn_s_waitcnt(0);
        unsigned nloc = b.st[0], nx = b.st[1];
        if (nloc == 0u) { xcd_barrier_complete(bar, b.x, nloc, nx); b.st[0] = nloc; b.st[1] = nx; }
        const unsigned old = xb_add(&bar[XB_XSUB(b.x)], 1u);
        const unsigned gen = old / nloc;
        if (old + 1u == (gen + 1u) * nloc) {
            __builtin_amdgcn_fence(__ATOMIC_RELEASE, "agent");
            asm volatile("s_waitcnt vmcnt(0)" ::: "memory");
            const unsigned og = xb_add(&bar[XB_TOP], 1u);
            const unsigned tg = og / nx;
            if (og + 1u == (tg + 1u) * nx) xb_add(&bar[XB_TOPGEN], 1u);
            else XB_SPIN(xb_ld(&bar[XB_TOPGEN]) == tg, bar);
            __builtin_amdgcn_fence(__ATOMIC_ACQUIRE, "agent");
            xb_add(&bar[XB_XGEN(b.x)], 1u);
            asm volatile("s_waitcnt vmcnt(0)" ::: "memory");
        } else {
            XB_SPIN(xb_ld(&bar[XB_XGEN(b.x)]) == gen, bar);
            __builtin_amdgcn_fence(__ATOMIC_ACQUIRE, "agent");
            asm volatile("s_waitcnt vmcnt(0)" ::: "memory");
        }
    }
    __syncthreads();
}
__device__ __forceinline__ float shx(float v, int m, int lane) { return __builtin_bit_cast(float, __builtin_amdgcn_ds_bpermute((lane ^ m) << 2, __builtin_bit_cast(int, v))); }
__device__ __forceinline__ int shxi(int v, int m, int lane) { return __builtin_amdgcn_ds_bpermute((lane ^ m) << 2, v); }
__device__ __forceinline__ s16x4 vtr(unsigned lds_addr) { return __builtin_bit_cast(s16x4, __builtin_amdgcn_ds_read_tr16_b64_v4i16((LAS v4i16_t*)(size_t)lds_addr)); }
__device__ __forceinline__ bf16x8 cat8(s16x4 lo, s16x4 hi) { return __builtin_shufflevector(lo, hi, 0, 1, 2, 3, 4, 5, 6, 7); }
__device__ __forceinline__ void unpack8(const u32x4 w, float (&f)[8]) { f[0] = bflo(w.x); f[1] = bfhi(w.x); f[2] = bflo(w.y); f[3] = bfhi(w.y); f[4] = bflo(w.z); f[5] = bfhi(w.z); f[6] = bflo(w.w); f[7] = bfhi(w.w); }
__device__ __forceinline__ void unpack8f8(const u32x2 w, float (&f)[8]) { const auto a0 = __builtin_amdgcn_cvt_pk_f32_fp8((int)w.x, false), a1 = __builtin_amdgcn_cvt_pk_f32_fp8((int)w.x, true), a2 = __builtin_amdgcn_cvt_pk_f32_fp8((int)w.y, false), a3 = __builtin_amdgcn_cvt_pk_f32_fp8((int)w.y, true);
    f[0] = a0[0]; f[1] = a0[1]; f[2] = a1[0]; f[3] = a1[1]; f[4] = a2[0]; f[5] = a2[1]; f[6] = a3[0]; f[7] = a3[1]; }
__device__ __forceinline__ u32x4 pack8(const float (&f)[8]) { u32x4 w; w.x = pk2(f[0], f[1]); w.y = pk2(f[2], f[3]); w.z = pk2(f[4], f[5]); w.w = pk2(f[6], f[7]); return w; }

struct Args {
    const float* in[22]; float* out; unsigned char* ws;
};

__device__ __forceinline__ void transpose_item(const float* p0, const float* p1, int ld, int mode, float scale, int K, int nblk, bf16_t* dst, int row0, LAS float* scr, int item, int lane, const float* kscale = nullptr) {
    const int kb = item / nblk, nb = item % nblk, k0 = 64 * kb, n0 = 32 * nb;
    const int np = n0 + (lane & 31);
    const float* sp; int col;
    if (mode == 0) { sp = p0; col = np; } else { sp = (np & 4) ? p1 : p0; col = (np >> 3) * 4 + (np & 3); }
    sp += (size_t)k0 * ld + col;
#pragma unroll 8
    for (int i = 0; i < 32; ++i) { const int kk = 2 * i + (lane >> 5); scr[kk * 33 + (lane & 31)] = sp[(size_t)kk * ld] * scale * (kscale ? kscale[k0 + kk] : 1.0f); }
    LDS_WAIT(); asm volatile("" ::: "memory");
    const int c = lane & 7;
#pragma unroll
    for (int j = 0; j < 4; ++j) { const int n = (lane >> 3) + 8 * j; const LAS float* s = scr + (8 * c) * 33 + n;
        u32x4 o; o.x = pk2(s[0 * 33], s[1 * 33]); o.y = pk2(s[2 * 33], s[3 * 33]); o.z = pk2(s[4 * 33], s[5 * 33]); o.w = pk2(s[6 * 33], s[7 * 33]);
        const int ng = row0 + n0 + n, kk = k0 + 8 * c;
        *(u32x4*)(dst + ((size_t)(ng >> 4) * (K >> 5) + (kk >> 5)) * 512 + (ng & 15) * 32 + (kk & 31)) = o; }
    LDS_WAIT(); asm volatile("" ::: "memory");
}
__device__ __forceinline__ void transpose_item8(const float* p0, const float* p1, int ld, int mode, float scale, int K, int nblk, unsigned char* dst, int row0, LAS float* scr, int item, int lane) {
    const int kb = item / nblk, nb = item % nblk, k0 = 64 * kb, n0 = 32 * nb;
    const int np = n0 + (lane & 31);
    const float* sp; int col;
    if (mode == 0) { sp = p0; col = np; } else { sp = ((np >> 7) & 1) ? p1 : p0; col = (np >> 8) * 128 + (np & 127); }
    sp += (size_t)k0 * ld + col;
#pragma unroll 8
    for (int i = 0; i < 32; ++i) { const int kk = 2 * i + (lane >> 5); scr[kk * 33 + (lane & 31)] = sp[(size_t)kk * ld] * scale; }
    LDS_WAIT(); asm volatile("" ::: "memory");
    const int c = lane & 7;
#pragma unroll
    for (int j = 0; j < 4; ++j) { const int n = (lane >> 3) + 8 * j; const LAS float* s = scr + (8 * c) * 33 + n;
        u32x2 o; o.x = pg8::pk4f8(s[0 * 33], s[1 * 33], s[2 * 33], s[3 * 33]); o.y = pg8::pk4f8(s[4 * 33], s[5 * 33], s[6 * 33], s[7 * 33]);
        const int ng = row0 + n0 + n;
        *(u32x2*)(dst + ((size_t)(ng >> 4) * (K >> 6) + (k0 >> 6)) * 1024 + (ng & 15) * 64 + 8 * c) = o; }
    LDS_WAIT(); asm volatile("" ::: "memory");
}
__device__ __forceinline__ void p0_convert(const Args& a, LAS unsigned char* lds, int bid, int G, int wave_s) {
    int tid_ = wave_s * 64 + pg8::lane_id(); asm volatile("" : "+v"(tid_)); const int tid = tid_, lane = tid & 63, wave = __builtin_amdgcn_readfirstlane(tid >> 6);
    unsigned char* ws = a.ws;
    LAS float* scr = (LAS float*)(lds + wave * 16384);
    const int gw = bid * NWAVES + wave, NGW = G * NWAVES;
    constexpr int I_INQ = 16 * 8, I_INB = 16 * 40, I_INC = 16 * 32, I_SQ = 16 * 32, I_GU = 16 * 16 * 32, I_DN = 16 * 8 * 32;
    constexpr int I_LAYER = I_INQ + I_INB + I_INC + 5 * I_SQ + I_GU + I_DN;
    for (int it = gw; it < 2 * I_LAYER; it += NGW) {
        const int l = it / I_LAYER; int r = it % I_LAYER;
        unsigned char* wl = ws + WS_W + (size_t)l * W_LAYER;
        const float* w_in = a.in[2] + (size_t)l * D * DIN;
        if (r < I_INQ) { transpose_item8(w_in, nullptr, DIN, 0, 0.125f * pg8::F8_SW, D, 8, wl + W_IN, 0, scr, r, lane); continue; } r -= I_INQ;
        if (r < I_INB) { transpose_item8(w_in + 256, nullptr, DIN, 0, pg8::F8_SW, D, 40, wl + W_IN, 256, scr, r, lane); continue; } r -= I_INB;
        if (r < I_INC) { transpose_item8(w_in + 1552, nullptr, DIN, 0, pg8::F8_SW, D, 32, wl + W_IN, 1792, scr, r, lane); continue; } r -= I_INC;
        if (r < I_SQ) { transpose_item(a.in[10] + (size_t)l * D * D, nullptr, D, 0, 1.0f, D, 32, (bf16_t*)(wl + W_OUT), 0, scr, r, lane); continue; } r -= I_SQ;
        if (r < I_SQ) { transpose_item(a.in[11] + (size_t)l * D * D, nullptr, D, 0, 0.0625f, D, 32, (bf16_t*)(wl + W_Q), 0, scr, r, lane, a.in[20] + (size_t)(l * 3 + 0) * D); continue; } r -= I_SQ;
        if (r < I_SQ) { transpose_item8(a.in[14] + (size_t)l * D * D, nullptr, D, 0, pg8::F8_SW, D, 32, wl + W_O, 0, scr, r, lane); continue; } r -= I_SQ;
        if (r < I_SQ) { transpose_item(a.in[12] + (size_t)l * D * D, nullptr, D, 0, 1.0f, D, 32, (bf16_t*)(ws + WS_WKV), l * 2048, scr, r, lane); continue; } r -= I_SQ;
        if (r < I_SQ) { transpose_item(a.in[13] + (size_t)l * D * D, nullptr, D, 0, 1.0f, D, 32, (bf16_t*)(ws + WS_WKV), l * 2048 + 1024, scr, r, lane); continue; } r -= I_SQ;
        if (r < I_GU) { const int e = r / 512, rr = r % 512; const size_t eo = ((size_t)l * 16 + e) * D * 512;
            transpose_item8(a.in[17] + eo, a.in[18] + eo, 512, 2, pg8::F8_SW, D, 32, wl + W_GU, e * 1024, scr, rr, lane); continue; } r -= I_GU;
        { const int e = r / 256, rr = r % 256; const size_t eo = ((size_t)l * 16 + e) * 512 * D;
            transpose_item8(a.in[19] + eo, nullptr, D, 0, pg8::F8_SW, 512, 32, wl + W_D, e * 1024, scr, rr, lane); }
    }
    const size_t gt = (size_t)bid * NTHR + tid, NT = (size_t)G * NTHR;
    for (int it = gw; it < 2 * 16 * 16; it += NGW) { const int l = it >> 8, kc = (it >> 4) & 15, n = (it & 15) * 64 + lane;
        const float* wq = a.in[11] + (size_t)l * D * D; const float* gg = a.in[20] + (size_t)(l * 3) * D; const float* bb = a.in[21] + (size_t)(l * 3) * D; float cs = 0.f, bq = 0.f;
#pragma unroll 8
        for (int k = 64 * kc; k < 64 * kc + 64; ++k) { const float w = wq[(size_t)k * D + n] * 0.0625f; cs += bflo(pk2(w * gg[k], 0.f) & 0xffffu); bq += w * bb[k]; }
        float* tb = (float*)(ws + WS_CS) + (size_t)l * 2 * 16 * 1024; tb[kc * 1024 + n] = cs; tb[16 * 1024 + kc * 1024 + n] = bq; }
    for (size_t i = gt; i < (size_t)2 * 256 * 128; i += NT) {
        const int l = (int)(i / (256 * 128)), r = (int)(i % (256 * 128)), j = r / 128, k8 = r % 128;
        const float* w_in = a.in[2] + (size_t)l * D * DIN; const float* w_a2 = a.in[3] + (size_t)l * 16 * 256;
        float wa[16];
#pragma unroll
        for (int q = 0; q < 16; ++q) wa[q] = w_a2[q * 256 + j];
        float o[8];
#pragma unroll
        for (int kk = 0; kk < 8; ++kk) { const float* wr = w_in + (size_t)(8 * k8 + kk) * DIN + 1536; float s = 0.f;
#pragma unroll
            for (int q = 0; q < 16; q += 4) { const f32x4 v = *(const f32x4*)(wr + q); s += v[0] * wa[q] + v[1] * wa[q + 1] + v[2] * wa[q + 2] + v[3] * wa[q + 3]; }
            o[kk] = s; }
        { const int ng = 1536 + j, kk = 8 * k8; u32x2 o8; o8.x = pg8::pk4f8(o[0] * pg8::F8_SW, o[1] * pg8::F8_SW, o[2] * pg8::F8_SW, o[3] * pg8::F8_SW); o8.y = pg8::pk4f8(o[4] * pg8::F8_SW, o[5] * pg8::F8_SW, o[6] * pg8::F8_SW, o[7] * pg8::F8_SW);
          *(u32x2*)(ws + WS_W + (size_t)l * W_LAYER + W_IN + ((size_t)(ng >> 4) * (D >> 6) + (kk >> 6)) * 1024 + (ng & 15) * 64 + (kk & 63)) = o8; }
    }
    for (size_t i = gt; i < (size_t)2 * 4 * 128 * 16; i += NT) {
        const int s8 = (int)(i & 15), t = (int)((i >> 4) & 127);
        const float* src = a.in[6] + i * 8; float o[8];
#pragma unroll
        for (int q = 0; q < 8; ++q) o[q] = ((8 * s8 + q) / 64 <= t / 64) ? src[q] : 0.f;
        *(u32x4*)((bf16_t*)(ws + WS_WM) + i * 8) = pack8(o);
    }
    for (size_t i = gt; i < (size_t)M * D / 8; i += NT) {
        const f32x4 v0 = *(const f32x4*)(a.in[0] + i * 8), v1 = *(const f32x4*)(a.in[0] + i * 8 + 4);
        u32x4 w; w.x = pk2(v0[0], v0[1]); w.y = pk2(v0[2], v0[3]); w.z = pk2(v1[0], v1[1]); w.w = pk2(v1[2], v1[3]);
        *(u32x4*)((bf16_t*)(ws + WS_X) + i * 8) = w;
        u32x2 q8; q8.x = pg8::pk4f8(v0[0] * pg8::F8_SX, v0[1] * pg8::F8_SX, v0[2] * pg8::F8_SX, v0[3] * pg8::F8_SX); q8.y = pg8::pk4f8(v1[0] * pg8::F8_SX, v1[1] * pg8::F8_SX, v1[2] * pg8::F8_SX, v1[3] * pg8::F8_SX);
        *(u32x2*)(ws + WS_X8IN + i * 8) = q8;
    }
    for (size_t i = gt; i < (size_t)MKV * D / 8; i += NT) {
        const f32x4 v0 = *(const f32x4*)(a.in[1] + i * 8), v1 = *(const f32x4*)(a.in[1] + i * 8 + 4);
        u32x4 w; w.x = pk2(v0[0], v0[1]); w.y = pk2(v0[2], v0[3]); w.z = pk2(v1[0], v1[1]); w.w = pk2(v1[2], v1[3]);
        *(u32x4*)((bf16_t*)(ws + WS_MEMB) + i * 8) = w;
    }
}

constexpr int GL_KD = 0, GL_QS = 9216, GL_VS = 18432, GL_PSUM = 35840, GL_DL = 37888, GL_SSQ = 38144;
template <bool FINAL>
__device__ __forceinline__ void gla_phase(LAS unsigned char* lds, const bf16_t* P, float* Send, float* Ltot, bf16_t* Y, const float* gn_g, int bid, int G, int wave_s) {
    int tid_ = wave_s * 64 + pg8::lane_id(); asm volatile("" : "+v"(tid_)); const int tid = tid_, lane = tid & 63, wave = __builtin_amdgcn_readfirstlane(tid >> 6);
    const unsigned lb = (unsigned)(size_t)lds;
    const int g = lane >> 4, l15 = lane & 15, q4 = l15 >> 2, p4 = lane & 3;
    const int kq = tid & 63, part = wave;
    for (int item = bid; item < 256; item += G) {
        const int b = item >> 5, h = (item >> 3) & 3, run = item & 7, bh = item >> 3;
        f32x4 sacc[4];
#pragma unroll
        for (int kt = 0; kt < 4; ++kt) sacc[kt] = (f32x4){0.f, 0.f, 0.f, 0.f};
        if (FINAL) {
            for (int i = 0; i < run; ++i) {
                const float* se = Send + ((size_t)(bh * 8 + i) * 64) * 128; const float* lt = Ltot + (size_t)(bh * 8 + i) * 64;
#pragma unroll
                for (int kt = 0; kt < 4; ++kt)
#pragma unroll
                    for (int r = 0; r < 4; ++r) { const int k = 16 * kt + 4 * g + r; sacc[kt][r] = __expf(lt[k]) * sacc[kt][r] + se[(size_t)k * 128 + 16 * wave + l15]; }
            }
        }
        float ltot_acc = 0.f;
        unsigned short graw[8], kraw[8]; u32x4 vraw[2], qraw; u32x2 rraw[4];
        const int v_row = tid >> 4, v_c16 = tid & 15, q_row = tid >> 3, q_c16 = tid & 7;
        const int ycol = h * 128 + 16 * wave + 4 * g;
#define GLA_FETCH(CC) do { const size_t tf_ = (size_t)b * SEQ + (size_t)(run * 16 + (CC)) * 64; \
            _Pragma("unroll") for (int i = 0; i < 8; ++i) { const bf16_t* rp = P + (tf_ + 8 * part + i) * NP + h * 64 + kq; graw[i] = rp[PG]; kraw[i] = rp[PK]; } \
            _Pragma("unroll") for (int i = 0; i < 2; ++i) vraw[i] = *(const u32x4*)(P + (tf_ + v_row + 32 * i) * NP + PV + h * 128 + v_c16 * 8); \
            if (FINAL) { qraw = *(const u32x4*)(P + (tf_ + q_row) * NP + PQ + h * 64 + q_c16 * 8); \
                _Pragma("unroll") for (int tt = 0; tt < 4; ++tt) rraw[tt] = *(const u32x2*)(P + (tf_ + 16 * tt + l15) * NP + PR + ycol); } } while (0)
        GLA_FETCH(0);
        for (int c = 0; c < 16; ++c) {
            const size_t t0 = (size_t)b * SEQ + (size_t)(run * 16 + c) * 64;
            __syncthreads();
            float gv[8], kv[8];
#pragma unroll
            for (int i = 0; i < 8; ++i) { gv[i] = __builtin_bit_cast(float, (unsigned)graw[i] << 16); kv[i] = __builtin_bit_cast(float, (unsigned)kraw[i] << 16); }
#pragma unroll
            for (int i = 1; i < 8; ++i) gv[i] += gv[i - 1];
            ((LAS float*)(lds + GL_PSUM))[part * 64 + kq] = gv[7];
#pragma unroll
            for (int i = 0; i < 2; ++i) *(LAS u32x4*)(lds + GL_VS + (v_row + 32 * i) * 272 + v_c16 * 16) = vraw[i];
            u32x2 rcur[4];
            if (FINAL) { *(LAS u32x4*)(lds + GL_QS + q_row * 144 + q_c16 * 16) = qraw;
#pragma unroll
                for (int tt = 0; tt < 4; ++tt) rcur[tt] = rraw[tt]; }
            if (c + 1 < 16) GLA_FETCH(c + 1);
            __syncthreads();
            float offs = 0.f, bl = 0.f;
#pragma unroll
            for (int p = 0; p < 8; ++p) { const float v = ((LAS float*)(lds + GL_PSUM))[p * 64 + kq]; offs += (p < part) ? v : 0.f; bl += v; }
#pragma unroll
            for (int i = 0; i < 8; ++i) { const float kd = kv[i] * __expf(bl - (offs + gv[i]));
                *(LAS unsigned short*)(lds + GL_KD + (8 * part + i) * 144 + kq * 2) = (unsigned short)(pk2(kd, 0.f) & 0xffffu); }
            if (part == 0) ((LAS float*)(lds + GL_DL))[kq] = __expf(bl);
            ltot_acc += bl;
            __syncthreads();
#pragma unroll
            for (int kt = 0; kt < 4; ++kt) { const f32x4 dl = *(LAS f32x4*)(lds + GL_DL + (16 * kt + 4 * g) * 4); sacc[kt] = sacc[kt] * dl; }
#pragma unroll
            for (int ks = 0; ks < 2; ++ks) {
                const unsigned vrow = lb + GL_VS + (unsigned)(32 * ks + 8 * g + q4) * 272u + (unsigned)(16 * wave + 4 * p4) * 2u;
                const bf16x8 vb = cat8(vtr(vrow), vtr(vrow + 4u * 272u));
#pragma unroll
                for (int kt = 0; kt < 4; ++kt) {
                    const unsigned krow = lb + GL_KD + (unsigned)(32 * ks + 8 * g + q4) * 144u + (unsigned)(16 * kt + 4 * p4) * 2u;
                    const bf16x8 ka = cat8(vtr(krow), vtr(krow + 4u * 144u));
                    sacc[kt] = __builtin_amdgcn_mfma_f32_16x16x32_bf16(ka, vb, sacc[kt], 0, 0, 0);
                }
            }
            if (FINAL) {
                f32x4 oacc[4];
#pragma unroll
                for (int tt = 0; tt < 4; ++tt) oacc[tt] = (f32x4){0.f, 0.f, 0.f, 0.f};
#pragma unroll
                for (int ks2 = 0; ks2 < 2; ++ks2) {
                    u32x4 spw; spw.x = pk2(sacc[2 * ks2][0], sacc[2 * ks2][1]); spw.y = pk2(sacc[2 * ks2][2], sacc[2 * ks2][3]);
                    spw.z = pk2(sacc[2 * ks2 + 1][0], sacc[2 * ks2 + 1][1]); spw.w = pk2(sacc[2 * ks2 + 1][2], sacc[2 * ks2 + 1][3]);
                    const bf16x8 sp = __builtin_bit_cast(bf16x8, spw);
#pragma unroll
                    for (int tt = 0; tt < 4; ++tt) {
                        const LAS unsigned char* qp = lds + GL_QS + (16 * tt + l15) * 144 + (32 * ks2 + 4 * g) * 2;
                        const u32x2 qlo = *(const LAS u32x2*)qp, qhi = *(const LAS u32x2*)(qp + 32);
                        u32x4 qw; qw.x = qlo.x; qw.y = qlo.y; qw.z = qhi.x; qw.w = qhi.y;
                        oacc[tt] = __builtin_amdgcn_mfma_f32_16x16x32_bf16(sp, __builtin_bit_cast(bf16x8, qw), oacc[tt], 0, 0, 0);
                    }
                }
#pragma unroll
                for (int tt = 0; tt < 4; ++tt) { float s = oacc[tt][0] * oacc[tt][0] + oacc[tt][1] * oacc[tt][1] + oacc[tt][2] * oacc[tt][2] + oacc[tt][3] * oacc[tt][3];
                    s += shx(s, 16, lane); s += shx(s, 32, lane);
                    if (g == 0) ((LAS float*)(lds + GL_SSQ))[wave * 64 + 16 * tt + l15] = s; }
                __syncthreads();
                const int col = h * 128 + 16 * wave + 4 * g;
                const f32x4 gn = *(const f32x4*)(gn_g + col);
#pragma unroll
                for (int tt = 0; tt < 4; ++tt) { float tot = 0.f;
#pragma unroll
                    for (int w2 = 0; w2 < 8; ++w2) tot += ((LAS float*)(lds + GL_SSQ))[w2 * 64 + 16 * tt + l15];
                    const float rs = __builtin_amdgcn_rsqf(tot * (1.0f / 128.0f) + 1e-6f);
                    const size_t tok = t0 + 16 * tt + l15;
                    const u32x2 rr = rcur[tt];
                    u32x2 w; w.x = pk2(oacc[tt][0] * rs * gn[0] * bflo(rr.x), oacc[tt][1] * rs * gn[1] * bfhi(rr.x));
                    w.y = pk2(oacc[tt][2] * rs * gn[2] * bflo(rr.y), oacc[tt][3] * rs * gn[3] * bfhi(rr.y));
                    *(u32x2*)(Y + tok * D + col) = w; }
            }
        }
        if (!FINAL) {
            float* se = Send + ((size_t)(bh * 8 + run) * 64) * 128;
#pragma unroll
            for (int kt = 0; kt < 4; ++kt)
#pragma unroll
                for (int r = 0; r < 4; ++r) se[(size_t)(16 * kt + 4 * g + r) * 128 + 16 * wave + l15] = sacc[kt][r];
            if (part == 0) Ltot[(size_t)(bh * 8 + run) * 64 + kq] = ltot_acc;
        }
    }
}

#undef GLA_FETCH
constexpr int SG_VN = 0;
__device__ __forceinline__ void sgu_phase(LAS unsigned char* lds, const bf16_t* P, const bf16_t* Wm, const float* b_s, const float* lg, const float* lb_, bf16_t* Y, int bid, int G, int wave_s) {
    int tid_ = wave_s * 64 + pg8::lane_id(); asm volatile("" : "+v"(tid_)); const int tid = tid_, lane = tid & 63, wave = __builtin_amdgcn_readfirstlane(tid >> 6);
    const unsigned lb = (unsigned)(size_t)lds;
    const int g = lane >> 4, l15 = lane & 15, q4 = l15 >> 2, p4 = lane & 3;
    const int row = tid >> 2, qu = tid & 3;
    u32x4 vraw[4]; u32x2 uraw[8];
#define SGU_FETCH(IT) do { const int blk_ = (IT) >> 2, gr_ = (IT) & 3; const size_t tf_ = (size_t)blk_ * 128; \
        const bf16_t* src_ = P + (tf_ + row) * NP + PVS + gr_ * 128 + 32 * qu; \
        _Pragma("unroll") for (int i = 0; i < 4; ++i) vraw[i] = *(const u32x4*)(src_ + 8 * i); \
        const bf16_t* us_ = P + (tf_ + 16 * wave + l15) * NP + PU + gr_ * 128 + 4 * g; \
        _Pragma("unroll") for (int ct = 0; ct < 8; ++ct) uraw[ct] = *(const u32x2*)(us_ + 16 * ct); } while (0)
    if (bid < 2048) SGU_FETCH(bid);
    for (int item = bid; item < 2048; item += G) {
        const int blk = item >> 2, gr = item & 3; const size_t t0 = (size_t)blk * 128;
        __syncthreads();
        u32x2 ucur[8];
        { float v[32];
#pragma unroll
          for (int i = 0; i < 4; ++i) { float f[8]; unpack8(vraw[i], f);
#pragma unroll
              for (int j = 0; j < 8; ++j) v[8 * i + j] = f[j]; }
#pragma unroll
          for (int ct = 0; ct < 8; ++ct) ucur[ct] = uraw[ct];
          if (item + G < 2048) SGU_FETCH(item + G);
          float s = 0.f;
#pragma unroll
          for (int i = 0; i < 32; ++i) s += v[i];
          s += shx(s, 1, lane); s += shx(s, 2, lane);
          const float mu = s * (1.0f / 128.0f); float qq = 0.f;
#pragma unroll
          for (int i = 0; i < 32; ++i) { v[i] -= mu; qq += v[i] * v[i]; }
          qq += shx(qq, 1, lane); qq += shx(qq, 2, lane);
          const float rs = __builtin_amdgcn_rsqf(qq * (1.0f / 128.0f) + LN_EPS);
          const float* gp = lg + gr * 128 + 32 * qu; const float* bp = lb_ + gr * 128 + 32 * qu;
#pragma unroll
          for (int i = 0; i < 4; ++i) { float f[8];
#pragma unroll
              for (int j = 0; j < 8; ++j) f[j] = v[8 * i + j] * rs * gp[8 * i + j] + bp[8 * i + j];
              *(LAS u32x4*)(lds + SG_VN + row * 272 + (32 * qu + 8 * i) * 2) = pack8(f); }
        }
        __syncthreads();
        const int nks = (wave < 4) ? 2 : 4;
        bf16x8 wf[4];
#pragma unroll
        for (int ks = 0; ks < 4; ++ks) wf[ks] = *(const bf16x8*)(Wm + ((size_t)(gr * 128 + 16 * wave + l15)) * 128 + 32 * ks + 8 * g);
        const size_t tok = t0 + 16 * wave + l15; const float bs = b_s[gr * 128 + 16 * wave + l15];
        unsigned vb0 = lb + SG_VN + (unsigned)(8 * g + q4) * 272u + (unsigned)(4 * p4) * 2u; asm volatile("" : "+v"(vb0));
#pragma unroll
        for (int ct = 0; ct < 8; ++ct) {
            f32x4 acc = (f32x4){0.f, 0.f, 0.f, 0.f};
#pragma unroll
            for (int ks = 0; ks < 4; ++ks) {
                if (ks < nks) {
                    const unsigned vrow = vb0 + (unsigned)(32 * ks * 272 + 32 * ct);
                    const bf16x8 va = cat8(vtr(vrow), vtr(vrow + 4u * 272u));
                    acc = __builtin_amdgcn_mfma_f32_16x16x32_bf16(va, wf[ks], acc, 0, 0, 0);
                }
            }
            const int col = gr * 128 + 16 * ct + 4 * g;
            const u32x2 uu = ucur[ct];
            u32x2 w; w.x = pk2(bflo(uu.x) * (acc[0] + bs), bfhi(uu.x) * (acc[1] + bs)); w.y = pk2(bflo(uu.y) * (acc[2] + bs), bfhi(uu.y) * (acc[3] + bs));
            *(u32x2*)(Y + tok * D + 512 + col) = w;
        }
    }
}
#undef SGU_FETCH

constexpr int AT_KPS = 1040, AT_VPS = 1088, AT_SLOT = 34816, AT_NSLOT = 3;
static_assert(AT_NSLOT * AT_SLOT <= LDSCTL_OFF, "attention LDS");
__device__ __forceinline__ void glds16(const void* gsrc, unsigned lds_dst) { unsigned keep;
    asm volatile("s_mov_b32 %0, m0\n\ts_mov_b32 m0, %2\n\ts_nop 0\n\tglobal_load_lds_dwordx4 %1, off\n\ts_mov_b32 m0, %0" : "=&s"(keep) : "v"(gsrc), "s"(lds_dst) : "memory"); }
__device__ __forceinline__ void attn_dma(unsigned lb, const char* kvb, int so, unsigned lane_off, int slot, int ps, int wave) {
#pragma unroll
    for (int j = 0; j < 4; ++j) { const int pi = 4 * wave + j, rlo = 32 * (pi >> 4) + (pi & 15);
        glds16(kvb + (size_t)(so + rlo * 8192) + lane_off, (unsigned)__builtin_amdgcn_readfirstlane((int)(lb + (unsigned)(slot * AT_SLOT + pi * ps)))); }
}
#define AT_WAITBAR(N) do { asm volatile("s_waitcnt vmcnt(" #N ") lgkmcnt(0)" ::: "memory"); __builtin_amdgcn_s_barrier(); asm volatile("" ::: "memory"); } while (0)
__device__ __forceinline__ void attn_phase(LAS unsigned char* lds, const bf16_t* Q, const bf16_t* KV, bf16_t* O, int layer, int bid, int G, int wave_s) {
    int tid_ = wave_s * 64 + pg8::lane_id(); asm volatile("" : "+v"(tid_)); const int tid = tid_, lane = tid & 63, wave = __builtin_amdgcn_readfirstlane(tid >> 6);
    const unsigned lb = (unsigned)(size_t)lds;
    const int r32 = lane & 31, hh = lane >> 5, q4 = (lane & 15) >> 2, p4 = lane & 3, blk = (lane >> 4) & 1;
    LAS unsigned char* kbase = lds + (r32 & 15) * AT_KPS + ((r32 >> 4) & 1) * 512 + hh * 16;
    unsigned vbase = lb + (unsigned)(4 * hh + q4) * (unsigned)AT_VPS + (unsigned)(16 * blk + 4 * p4) * 2u;
    unsigned lane_off = (unsigned)((lane >> 5) * 16 * 8192 + (lane & 31) * 16);
    asm volatile("" : "+v"(kbase), "+v"(vbase), "+v"(lane_off));
    const char* kvb = (const char*)KV;
    const int nun = (bid < 256) ? 4 * ((256 - bid + G - 1) / G) : 0;
#define AT_SRC(N, ST) ((int)((((size_t)(((bid + ((N) >> 2) * G) >> 5) * NMEM) * 4096 + layer * 2048 + ((N) & 3) * 256 + (((ST) >> 2) * 1024)) * 2) + ((ST) & 3) * 64 * 8192))
    __syncthreads();
    if (nun > 0) { attn_dma(lb, kvb, AT_SRC(0, 0), lane_off, 0, AT_KPS, wave); attn_dma(lb, kvb, AT_SRC(0, 1), lane_off, 1, AT_KPS, wave); AT_WAITBAR(4); }
    int sl = 0;
    for (int n = 0; n < nun; ++n) {
        const int pan = bid + (n >> 2) * G, h = n & 3, b = pan >> 5, qt = pan & 31;
        int ln_ = pg8::lane_id(); asm volatile("" : "+v"(ln_));
        const unsigned qoff = (unsigned)((wave * 8 * 64 + ln_) * 16);
        const char* qbase = (const char*)Q + (size_t)(pan * 4 + h) * 65536;
        char* obase = (char*)O + ((size_t)b * SEQ + qt * 256) * D + h * 256;
        const bool more = (n + 1 < nun);
        bf16x8 qf[16];
#pragma unroll
        for (int s = 0; s < 8; ++s) { const u32x4 raw = *(const GAS u32x4*)(qbase + qoff + 1024 * s); float f[8]; u32x2 h8;
            h8.x = raw.x; h8.y = raw.y; unpack8f8(h8, f);
#pragma unroll
            for (int i = 0; i < 8; ++i) f[i] *= (1.0f / pg8::F8_SQ);
            qf[s] = __builtin_bit_cast(bf16x8, pack8(f));
            h8.x = raw.z; h8.y = raw.w; unpack8f8(h8, f);
#pragma unroll
            for (int i = 0; i < 8; ++i) f[i] *= (1.0f / pg8::F8_SQ);
            qf[s + 8] = __builtin_bit_cast(bf16x8, pack8(f)); }
        float ml = 0.f, lsum = 0.f;
        bf16x8 pk[8][2];
#pragma unroll
        for (int st = 0; st < 4; ++st) {
            const int sl2 = (sl >= 1) ? sl - 1 : 2;
            if (st > 0) attn_dma(lb, kvb, AT_SRC(n, st + 2), lane_off, sl2, (st + 2 < 4) ? AT_KPS : AT_VPS, wave);
            LAS unsigned char* kb = kbase + sl * AT_SLOT;
            f32x16 sa[2];
#pragma unroll
            for (int kt = 0; kt < 2; ++kt)
#pragma unroll
                for (int r = 0; r < 16; ++r) sa[kt][r] = 0.f;
            bf16x8 kfa[2], kfb[2];
#define AT_KLD(dst, S0) do { _Pragma("unroll") for (int kt = 0; kt < 2; ++kt) dst[kt] = *(const LAS bf16x8*)(kb + kt * 16 * AT_KPS + 32 * (S0)); } while (0)
#define AT_KMM(src, S0) do { _Pragma("unroll") for (int kt = 0; kt < 2; ++kt) sa[kt] = __builtin_amdgcn_mfma_f32_32x32x16_bf16(src[kt], qf[(S0)], sa[kt], 0, 0, 0); } while (0)
            AT_KLD(kfa, 0); __builtin_amdgcn_sched_barrier(0);
#pragma unroll
            for (int bq = 0; bq < 8; ++bq) {
                AT_KLD(kfb, 2 * bq + 1); __builtin_amdgcn_sched_barrier(0);
                AT_KMM(kfa, 2 * bq); __builtin_amdgcn_sched_barrier(0);
                if (bq < 7) { AT_KLD(kfa, 2 * bq + 2); __builtin_amdgcn_sched_barrier(0); }
                AT_KMM(kfb, 2 * bq + 1); __builtin_amdgcn_sched_barrier(0);
            }
#undef AT_KLD
#undef AT_KMM
            if (st == 0) attn_dma(lb, kvb, AT_SRC(n, 2), lane_off, sl2, AT_KPS, wave);
            if (st == 0) { float mx = -3.0e38f;
#pragma unroll
                for (int kt = 0; kt < 2; ++kt)
#pragma unroll
                    for (int r = 0; r < 16; ++r) mx = __builtin_fmaxf(mx, sa[kt][r]);
                mx = __builtin_fmaxf(mx, shx(mx, 32, lane)); ml = mx * LOG2E; }
#pragma unroll
            for (int kt = 0; kt < 2; ++kt) {
                float p[16];
#pragma unroll
                for (int r = 0; r < 16; ++r) { p[r] = __builtin_amdgcn_exp2f(sa[kt][r] * LOG2E - ml); lsum += p[r]; }
#pragma unroll
                for (int s2 = 0; s2 < 2; ++s2) { u32x4 w; w.x = pk2(p[8 * s2 + 0], p[8 * s2 + 1]); w.y = pk2(p[8 * s2 + 2], p[8 * s2 + 3]); w.z = pk2(p[8 * s2 + 4], p[8 * s2 + 5]); w.w = pk2(p[8 * s2 + 6], p[8 * s2 + 7]);
                    pk[2 * st + kt][s2] = __builtin_bit_cast(bf16x8, w); }
            }
            AT_WAITBAR(4);
            sl = (sl == 2) ? 0 : sl + 1;
        }
        lsum += shx(lsum, 32, lane);
        f32x16 oacc[8];
#pragma unroll
        for (int dt = 0; dt < 8; ++dt)
#pragma unroll
            for (int r = 0; r < 16; ++r) oacc[dt][r] = 0.f;
#pragma unroll
        for (int st = 4; st < 8; ++st) {
            const bool issue = (st < 6) || more;
            if (issue) { const int s2 = (sl >= 1) ? sl - 1 : 2;
                if (st < 6) attn_dma(lb, kvb, AT_SRC(n, st + 2), lane_off, s2, AT_VPS, wave); else attn_dma(lb, kvb, AT_SRC(n + 1, st - 6), lane_off, s2, AT_KPS, wave); }
            const unsigned vb = vbase + (unsigned)(sl * AT_SLOT);
            bf16x8 vfa[2], vfb[2];
#define AT_VLD(dst, BT) do { const unsigned va_ = vb + (unsigned)((((BT) >> 3) & 1) * 16 * AT_VPS + (((BT) >> 2) & 1) * 512 + ((BT) & 3) * 128); \
                _Pragma("unroll") for (int d_ = 0; d_ < 2; ++d_) dst[d_] = cat8(vtr(va_ + 64u * d_), vtr(va_ + 64u * d_ + 8u * AT_VPS)); } while (0)
#define AT_VMM(src, BT) do { _Pragma("unroll") for (int d_ = 0; d_ < 2; ++d_) oacc[2 * ((BT) & 3) + d_] = __builtin_amdgcn_mfma_f32_32x32x16_bf16(src[d_], pk[2 * (st - 4) + (((BT) >> 3) & 1)][((BT) >> 2) & 1], oacc[2 * ((BT) & 3) + d_], 0, 0, 0); } while (0)
            AT_VLD(vfa, 0); __builtin_amdgcn_sched_barrier(0);
#pragma unroll
            for (int bq = 0; bq < 8; ++bq) {
                AT_VLD(vfb, 2 * bq + 1); __builtin_amdgcn_sched_barrier(0);
                AT_VMM(vfa, 2 * bq); __builtin_amdgcn_sched_barrier(0);
                if (bq < 7) { AT_VLD(vfa, 2 * bq + 2); __builtin_amdgcn_sched_barrier(0); }
                AT_VMM(vfb, 2 * bq + 1); __builtin_amdgcn_sched_barrier(0);
            }
#undef AT_VLD
#undef AT_VMM
            if (issue) AT_WAITBAR(4); else AT_WAITBAR(0);
            sl = (sl == 2) ? 0 : sl + 1;
        }
        const float inv = 1.0f / lsum;
        int ln2 = pg8::lane_id(); asm volatile("" : "+v"(ln2));
        GAS char* op = (GAS char*)obase + (unsigned)((wave * 32 + (ln2 & 31)) * D) + ((ln2 >> 5) ? 16 : 0);
        const float sc = inv * pg8::F8_SO;
#pragma unroll
        for (int dt = 0; dt < 8; ++dt) {
            unsigned dw[4];
#pragma unroll
            for (int g4 = 0; g4 < 4; ++g4) dw[g4] = pg8::pk4f8(oacc[dt][4 * g4 + 0] * sc, oacc[dt][4 * g4 + 1] * sc, oacc[dt][4 * g4 + 2] * sc, oacc[dt][4 * g4 + 3] * sc);
            { const auto r = __builtin_amdgcn_permlane32_swap(dw[0], dw[2], false, false); dw[0] = r[0]; dw[2] = r[1]; }
            { const auto r = __builtin_amdgcn_permlane32_swap(dw[1], dw[3], false, false); dw[1] = r[0]; dw[3] = r[1]; }
            u32x4 w; w.x = dw[0]; w.y = dw[2]; w.z = dw[1]; w.w = dw[3];
            *(GAS u32x4*)(op + 32 * dt) = w; }
    }
    asm volatile("s_waitcnt vmcnt(0)" ::: "memory");
    __syncthreads();
}
#undef AT_SRC
#undef AT_WAITBAR

constexpr int RT_WH = 0, RT_WL = 32768, RT_SEL = 65536, RT_RK = 66048, RT_CNTW = 67072, RT_WBASE = 67584;
template <int MODE>
__device__ __forceinline__ void ln_phase(LAS unsigned char* lds, const Args& a, int l, int lnidx, bool last, bf16_t* Xout, int bid, int G, int wave_s) {
    int tid_ = wave_s * 64 + pg8::lane_id(); asm volatile("" : "+v"(tid_)); const int tid = tid_, lane = tid & 63, wave = __builtin_amdgcn_readfirstlane(tid >> 6);
    constexpr int R = (MODE == 2) ? 2 : 4;
    unsigned char* ws = a.ws;
    const bf16_t* Z = (const bf16_t*)(ws + WS_R + R_Z); const bf16_t* X = (const bf16_t*)(ws + WS_X); const unsigned char* Ys8 = ws + WS_R + R_XS;
    const float* gp = a.in[20] + (size_t)(l * 3 + lnidx) * D; const float* bp = a.in[21] + (size_t)(l * 3 + lnidx) * D;
    float gg[16], bb[16];
#pragma unroll
    for (int j = 0; j < 2; ++j)
#pragma unroll
        for (int i = 0; i < 8; ++i) { gg[8 * j + i] = gp[8 * lane + 512 * j + i]; bb[8 * j + i] = bp[8 * lane + 512 * j + i]; }
    if (MODE == 1) {
        __syncthreads();
        for (int idx = tid; idx < 2048; idx += NTHR) { const int s = idx >> 6, ln = idx & 63, e = ln & 15, g = ln >> 4; float hi[8], lo[8];
#pragma unroll
            for (int j = 0; j < 8; ++j) { const float w = a.in[15][(32 * s + 8 * g + j) * 16 + e]; const float h = bflo(pk2(w, 0.f) & 0xffffu); hi[j] = h; lo[j] = w - h; }
            *(LAS u32x4*)(lds + RT_WH + idx * 16) = pack8(hi); *(LAS u32x4*)(lds + RT_WL + idx * 16) = pack8(lo); }
        __syncthreads();
    }
    for (int blk = bid; blk < 256; blk += G) {
        int run[16];
#pragma unroll
        for (int e = 0; e < 16; ++e) run[e] = 0;
        u32x4 pa_[R][2]; u32x2 pb_[R][2], pc_[R][2]; float pw0[R], pw1[R];
#define LN_LOAD(ROW0) do { _Pragma("unroll") for (int r = 0; r < R; ++r) { const size_t row = (ROW0) + r; \
            if (MODE == 2) { const int* ts = (const int*)(ws + WS_TSLOT) + row * 2; const float* ti = (const float*)(ws + WS_TINFO) + row * 4; const int s0 = ts[0], s1 = ts[1]; pw0[r] = ti[2]; pw1[r] = ti[3]; \
                _Pragma("unroll") for (int j = 0; j < 2; ++j) { pa_[r][j] = *(const u32x4*)(X + row * D + 8 * lane + 512 * j); pb_[r][j] = *(const u32x2*)(Ys8 + (size_t)s0 * D + 8 * lane + 512 * j); pc_[r][j] = *(const u32x2*)(Ys8 + (size_t)s1 * D + 8 * lane + 512 * j); } } \
            else { _Pragma("unroll") for (int j = 0; j < 2; ++j) pa_[r][j] = *(const u32x4*)(Z + row * D + 8 * lane + 512 * j); } } } while (0)
        LN_LOAD((size_t)blk * 256 + wave * 32);
        for (int ri = 0; ri < 32; ri += R) {
            const int rl0 = wave * 32 + ri; const size_t row0 = (size_t)blk * 256 + rl0;
            float v[R][16];
#pragma unroll
            for (int r = 0; r < R; ++r)
#pragma unroll
                for (int j = 0; j < 2; ++j) { float x[8]; unpack8(pa_[r][j], x);
                    if (MODE == 2) { float y0[8], y1[8]; unpack8f8(pb_[r][j], y0); unpack8f8(pc_[r][j], y1);
#pragma unroll
                        for (int i = 0; i < 8; ++i) v[r][8 * j + i] = ALPHA * x[i] + (pw0[r] * (1.0f / pg8::F8_SY)) * y0[i] + (pw1[r] * (1.0f / pg8::F8_SY)) * y1[i]; }
                    else {
#pragma unroll
                        for (int i = 0; i < 8; ++i) v[r][8 * j + i] = x[i]; } }
            if (ri + R < 32) LN_LOAD(row0 + R);
            float s[R];
#pragma unroll
            for (int r = 0; r < R; ++r) { s[r] = 0.f;
#pragma unroll
                for (int i = 0; i < 16; ++i) s[r] += v[r][i]; }
#pragma unroll
            for (int o = 1; o < 64; o <<= 1)
#pragma unroll
                for (int r = 0; r < R; ++r) s[r] += shx(s[r], o, lane);
            float qq[R];
#pragma unroll
            for (int r = 0; r < R; ++r) { const float mu = s[r] * (1.0f / D); qq[r] = 0.f;
#pragma unroll
                for (int i = 0; i < 16; ++i) { v[r][i] -= mu; qq[r] += v[r][i] * v[r][i]; } }
#pragma unroll
            for (int o = 1; o < 64; o <<= 1)
#pragma unroll
                for (int r = 0; r < R; ++r) qq[r] += shx(qq[r], o, lane);
#pragma unroll
            for (int r = 0; r < R; ++r) { const float rs = __builtin_amdgcn_rsqf(qq[r] * (1.0f / D) + LN_EPS);
#pragma unroll
                for (int i = 0; i < 16; ++i) v[r][i] = v[r][i] * rs * gg[i] + bb[i]; }
#pragma unroll
            for (int r = 0; r < R; ++r) { const size_t row = row0 + r;
                if (MODE == 2 && last) {
#pragma unroll
                    for (int j = 0; j < 2; ++j) { float* op = a.out + row * D + 8 * lane + 512 * j;
                        *(f32x4*)op = (f32x4){v[r][8 * j], v[r][8 * j + 1], v[r][8 * j + 2], v[r][8 * j + 3]}; *(f32x4*)(op + 4) = (f32x4){v[r][8 * j + 4], v[r][8 * j + 5], v[r][8 * j + 6], v[r][8 * j + 7]}; }
                } else {
#pragma unroll
                    for (int j = 0; j < 2; ++j) { float f[8];
#pragma unroll
                        for (int i = 0; i < 8; ++i) f[i] = v[r][8 * j + i];
                        *(u32x4*)(Xout + row * D + 8 * lane + 512 * j) = pack8(f);
                        if (MODE == 1 || MODE == 2) { u32x2 q8; q8.x = pg8::pk4f8(f[0] * pg8::F8_SX, f[1] * pg8::F8_SX, f[2] * pg8::F8_SX, f[3] * pg8::F8_SX); q8.y = pg8::pk4f8(f[4] * pg8::F8_SX, f[5] * pg8::F8_SX, f[6] * pg8::F8_SX, f[7] * pg8::F8_SX);
                            *(u32x2*)(ws + (MODE == 1 ? WS_R + R_X8 : WS_X8IN) + row * D + 8 * lane + 512 * j) = q8; } }
                } }
            if (MODE == 1 && ((ri + R) & 15) == 0) {
                asm volatile("s_waitcnt vmcnt(0)" ::: "memory");
                const int tok = lane & 15, g = lane >> 4, tl = rl0 + R - 16 + tok; const size_t token = (size_t)blk * 256 + tl;
                const bf16_t* xr = Xout + token * D + 8 * g;
                f32x4 acc = (f32x4){0.f, 0.f, 0.f, 0.f};
#pragma unroll 8
                for (int ks = 0; ks < 32; ++ks) { const bf16x8 xb = *(const bf16x8*)(xr + 32 * ks);
                    const bf16x8 wh = *(const LAS bf16x8*)(lds + RT_WH + (ks * 64 + lane) * 16), wl = *(const LAS bf16x8*)(lds + RT_WL + (ks * 64 + lane) * 16);
                    acc = __builtin_amdgcn_mfma_f32_16x16x32_bf16(wh, xb, acc, 0, 0, 0); acc = __builtin_amdgcn_mfma_f32_16x16x32_bf16(wl, xb, acc, 0, 0, 0); }
                const f32x4 brv = *(const f32x4*)(a.in[16] + 4 * g);
                float lg[4] = {acc[0] + brv[0], acc[1] + brv[1], acc[2] + brv[2], acc[3] + brv[3]};
                float m = __builtin_fmaxf(__builtin_fmaxf(lg[0], lg[1]), __builtin_fmaxf(lg[2], lg[3]));
                m = __builtin_fmaxf(m, shx(m, 16, lane)); m = __builtin_fmaxf(m, shx(m, 32, lane));
                float t1 = -1.f, t2 = -1.f; int i1 = 0, i2 = 0;
#pragma unroll
                for (int r = 0; r < 4; ++r) { const float p = __expf(lg[r] - m); if (p > t1) { t2 = t1; i2 = i1; t1 = p; i1 = r; } else if (p > t2) { t2 = p; i2 = r; } }
                const float gs = t1 + t2; float bgs = gs; int bg = g;
                { const float o = shx(bgs, 16, lane); const int og = shxi(bg, 16, lane); if (o > bgs || (o == bgs && og < bg)) { bgs = o; bg = og; } }
                { const float o = shx(bgs, 32, lane); const int og = shxi(bg, 32, lane); if (o > bgs || (o == bgs && og < bg)) { bgs = o; bg = og; } }
                const bool mine = (bg == g); const int e0 = 4 * g + i1, e1 = 4 * g + i2;
                if (mine) { u32x4 info; info.x = (unsigned)e0; info.y = (unsigned)e1; info.z = __builtin_bit_cast(unsigned, t1 / gs); info.w = __builtin_bit_cast(unsigned, t2 / gs);
                    *(u32x4*)(ws + WS_TINFO + token * 16) = info; ((LAS unsigned short*)(lds + RT_SEL))[tl] = (unsigned short)(e0 | (e1 << 8)); }
                const unsigned long long below = (1ull << lane) - 1ull; int r0 = 0, r1 = 0;
#pragma unroll
                for (int e = 0; e < 16; ++e) { const bool hit = mine && (e0 == e || e1 == e); const unsigned long long mb = __ballot(hit); const int cb = __popcll(mb & below);
                    r0 = (e0 == e) ? run[e] + cb : r0; r1 = (e1 == e) ? run[e] + cb : r1; run[e] += __popcll(mb); }
                if (mine) { ((LAS unsigned short*)(lds + RT_RK))[2 * tl] = (unsigned short)r0; ((LAS unsigned short*)(lds + RT_RK))[2 * tl + 1] = (unsigned short)r1; }
            }
        }
        if (MODE == 1) {
            { int vsel = 0;
#pragma unroll
              for (int e = 0; e < 16; ++e) vsel = (lane == e) ? run[e] : vsel;
              if (lane < 16) ((LAS int*)(lds + RT_CNTW))[wave * 16 + lane] = vsel; }
            __syncthreads();
            if (tid < 16) { int base = 0;
#pragma unroll
                for (int w = 0; w < 8; ++w) { const int t = ((LAS int*)(lds + RT_CNTW))[w * 16 + tid]; ((LAS int*)(lds + RT_WBASE))[w * 16 + tid] = base; base += t; }
                ((int*)(ws + WS_WGCNT))[blk * 16 + tid] = base; }
            __syncthreads();
            { const int t = tid >> 1, k = tid & 1; const int e = (((LAS unsigned short*)(lds + RT_SEL))[t] >> (8 * k)) & 255;
              ((int*)(ws + WS_TRANK))[(size_t)blk * 512 + tid] = (int)((LAS unsigned short*)(lds + RT_RK))[tid] + ((LAS int*)(lds + RT_WBASE))[(t >> 5) * 16 + e]; }
            __syncthreads();
        }
    }
}

#undef LN_LOAD
constexpr int MG_TBL = 0, MG_TOT = 16384, MG_PRE = 16448, MG_BASE = 16512;
__device__ __forceinline__ void moe_gather_phase(LAS unsigned char* lds, unsigned char* ws, int bid, int G, int wave_s) {
    int tid_ = wave_s * 64 + pg8::lane_id(); asm volatile("" : "+v"(tid_)); const int tid = tid_, lane = tid & 63, wave = __builtin_amdgcn_readfirstlane(tid >> 6);
    LAS int* tbl = (LAS int*)(lds + MG_TBL); LAS int* tot = (LAS int*)(lds + MG_TOT); LAS int* pre = (LAS int*)(lds + MG_PRE); LAS int* base = (LAS int*)(lds + MG_BASE);
    LAS int* offs = (LAS int*)(lds + MISC_OFF) + 16; LAS int* tile_e = (LAS int*)(lds + TILEE_OFF);
    const bf16_t* X = (const bf16_t*)(ws + WS_X); bf16_t* Xs = (bf16_t*)(ws + WS_R + R_XS);
    for (int blk = bid; blk < 256; blk += G) {
        __syncthreads();
        for (int i = tid; i < 4096; i += NTHR) tbl[i] = ((const int*)(ws + WS_WGCNT))[i];
        __syncthreads();
        if (tid < 16) { int t = 0, p = 0; for (int c = 0; c < 256; ++c) { const int v = tbl[c * 16 + tid]; p += (c < blk) ? v : 0; t += v; } tot[tid] = t; pre[tid] = p; }
        __syncthreads();
        if (tid == 0) { int o = 0; for (int e = 0; e < 16; ++e) { offs[e] = o; base[e] = o + pre[e]; o += (tot[e] + 255) & ~255; } offs[16] = o; offs[17] = o >> 8; }
        __syncthreads();
        for (int rt = tid; rt < 528; rt += NTHR) { int e = 0;
#pragma unroll
            for (int q = 1; q < 16; ++q) e = (rt * 256 >= offs[q]) ? q : e;
            tile_e[rt] = e; }
        { const size_t tok = (size_t)blk * 256 + (tid >> 1); const int k = tid & 1;
          const int e = ((const int*)(ws + WS_TINFO))[tok * 4 + k]; const int rk = ((const int*)(ws + WS_TRANK))[tok * 2 + k];
          const int slot = base[e] + rk;
          ((int*)(ws + WS_TSLOT))[tok * 2 + k] = slot; ((int*)(ws + WS_SRCROW))[slot] = (int)tok; }
        for (int e = wave; e < 16; e += NWAVES) { const int npad = offs[e + 1] - offs[e] - tot[e];
            if (blk < npad && lane == 0) ((int*)(ws + WS_SRCROW))[offs[e] + tot[e] + blk] = 0; }
    }
}

#define GEMM_ALIGN true
#define GEMM_SP2 true
__global__ void __launch_bounds__(NTHR, 2) mk_fwd(Args args) {
    extern __shared__ __attribute__((aligned(16))) unsigned char lds_raw[];
    LAS unsigned char* lds = (LAS unsigned char*)lds_raw;
    const int tid = threadIdx.x; const int wave_s = __builtin_amdgcn_readfirstlane(tid >> 6);
    const int G = gridDim.x, bid = blockIdx.x;
    unsigned char* ws = args.ws;
    volatile LAS unsigned* MISC = (volatile LAS unsigned*)(lds + MISC_OFF);
    for (int u = tid; u < (LDS_BYTES - LDSCTL_OFF) / 4; u += NTHR) ((LAS unsigned*)(lds + LDSCTL_OFF))[u] = 0u;
    __syncthreads();
    XcdBarrier bar = xcd_barrier_post((unsigned*)(ws + WS_CTL) + CW_BAR, MISC + 8);
    bar.wv = wave_s;
#define GRID_BAR() xcd_barrier(bar)
#ifndef REP_MASK
#define REP_MASK 0
#endif
#define LOCAL_SYNC() do { asm volatile("s_waitcnt vmcnt(0)" ::: "memory"); __syncthreads(); } while (0)
#define PHASE(grp, ...) do { __VA_ARGS__; if (REP_MASK & (1 << (grp))) { GRID_BAR(); __VA_ARGS__; } } while (0)

#define WSQ ({ unsigned char* w_ = args.ws; asm volatile("" : "+s"(w_)); w_; })
#define X ((bf16_t*)(WSQ + WS_X))
#define P ((bf16_t*)(WSQ + WS_R + R_P))
#define Y ((bf16_t*)(WSQ + WS_R + R_Y))
#define Z ((bf16_t*)(WSQ + WS_R + R_Z))
#define Qb ((bf16_t*)(WSQ + WS_R + R_Q))
#define Ob ((bf16_t*)(WSQ + WS_R + R_O))
#define Xs ((bf16_t*)(WSQ + WS_R + R_XS))
#define Hb ((bf16_t*)(WSQ + WS_R + R_H))
#define KV ((bf16_t*)(WSQ + WS_KV))
#define wl (WSQ + WS_W + (size_t)l * W_LAYER)

    PHASE(0, p0_convert(args, lds, bid, G, wave_s));
    GRID_BAR();
    { const int tid_r = wave_s * 64 + pg8::lane_id();
      for (int i = bid * NTHR + tid_r; i < 2 * 2 * 1024; i += G * NTHR) { const int l = i >> 11, w = (i >> 10) & 1, n = i & 1023; const float* tb = (const float*)(WSQ + WS_CS) + (size_t)l * 2 * 16 * 1024 + w * 16 * 1024; float s = 0.f;
#pragma unroll
          for (int kc = 0; kc < 16; ++kc) s += tb[kc * 1024 + n];
          ((float*)(WSQ + WS_CS) + 65536)[i] = s; } }
    PHASE(1, { pg8::Gemm g{(const bf16_t*)(WSQ + WS_MEMB), (const bf16_t*)(WSQ + WS_WKV), MKV, 4096, D, wave_s}; pg8::StaticOrder S; S.init(MKV, 4096, G, bid);
      pg8::EpiPlain E{KV, 4096, 0xffff};
      pg8::gemm_phase<pg8::EpiPlain, pg8::StaticOrder, GEMM_ALIGN, GEMM_SP2>(lds, g, S, E); });

#pragma unroll 1
    for (int l = 0; l < 2; ++l) {
        PHASE(1, { pg8::Gemm g{(const bf16_t*)(WSQ + WS_X8IN), (const bf16_t*)(wl + W_IN), M, NP, D / 2, wave_s}; pg8::StaticOrder S; S.init(M, NP, G, bid);
          pg8::EpiInProj8 E{P, args.in[4] + l * 256};
          pg8::gemm_phase<pg8::EpiInProj8, pg8::StaticOrder, GEMM_ALIGN, GEMM_SP2>(lds, g, S, E); });
        GRID_BAR();
        PHASE(3, gla_phase<false>(lds, P, (float*)(WSQ + WS_SEND), (float*)(WSQ + WS_LTOT), Y, args.in[5] + l * 512, bid, G, wave_s));
        PHASE(4, sgu_phase(lds, P, (const bf16_t*)(WSQ + WS_WM) + (size_t)l * 4 * 128 * 128, args.in[7] + l * 512, args.in[8] + l * 512, args.in[9] + l * 512, Y, bid, G, wave_s));
        GRID_BAR();
        PHASE(3, gla_phase<true>(lds, P, (float*)(WSQ + WS_SEND), (float*)(WSQ + WS_LTOT), Y, args.in[5] + l * 512, bid, G, wave_s));
        GRID_BAR();
        PHASE(10, { pg8::Gemm g{Y, (const bf16_t*)(wl + W_OUT), M, D, D, wave_s}; pg8::PanelOrder S{4, M / 256, G, bid};
          pg8::EpiResidStats E{X, Z, (pg8::f32x2_t*)(WSQ + WS_PART)};
          pg8::gemm_phase<pg8::EpiResidStats, pg8::PanelOrder, GEMM_ALIGN, GEMM_SP2>(lds, g, S, E); });
        { const int tid_r = wave_s * 64 + pg8::lane_id();
          for (int pan = bid; pan < 256; pan += G) if (tid_r < 256) { const size_t row = (size_t)pan * 256 + tid_r; const pg8::f32x2_t* pp = (const pg8::f32x2_t*)(WSQ + WS_PART) + row * 16; float s1 = 0.f, s2 = 0.f;
#pragma unroll
              for (int q = 0; q < 16; ++q) { const pg8::f32x2_t v = pp[q]; s1 += v[0]; s2 += v[1]; }
              const float mu = s1 * (1.0f / D), var = s2 * (1.0f / D) - mu * mu; ((pg8::f32x2_t*)(WSQ + WS_STATS))[row] = (pg8::f32x2_t){mu, __builtin_amdgcn_rsqf(var + LN_EPS)}; } }
        LOCAL_SYNC();
        PHASE(10, { pg8::Gemm g{Z, (const bf16_t*)(wl + W_Q), M, D, D, wave_s}; pg8::PanelOrder S{4, M / 256, G, bid};
          pg8::EpiQFragLN E{(unsigned char*)Qb, (const pg8::f32x2_t*)(WSQ + WS_STATS), (const float*)(WSQ + WS_CS) + 65536 + l * 2048, (const float*)(WSQ + WS_CS) + 65536 + l * 2048 + 1024};
          pg8::gemm_phase<pg8::EpiQFragLN, pg8::PanelOrder, GEMM_ALIGN, GEMM_SP2>(lds, g, S, E); });
        PHASE(5, attn_phase(lds, Qb, KV, Ob, l, bid, G, wave_s));
        LOCAL_SYNC();
        PHASE(10, { pg8::Gemm g{Ob, (const bf16_t*)(wl + W_O), M, D, D / 2, wave_s}; pg8::PanelOrder S{4, M / 256, G, bid};
          pg8::EpiResidLN8 E{Z, (const pg8::f32x2_t*)(WSQ + WS_STATS), args.in[20] + (size_t)(l * 3) * D, args.in[21] + (size_t)(l * 3) * D};
          pg8::gemm_phase<pg8::EpiResidLN8, pg8::PanelOrder, GEMM_ALIGN, GEMM_SP2>(lds, g, S, E); });
        PHASE(9, ln_phase<1>(lds, args, l, 1, false, X, bid, G, wave_s));
        GRID_BAR();
        PHASE(7, moe_gather_phase(lds, WSQ, bid, G, wave_s));
        GRID_BAR();
        PHASE(2, { pg8::Gemm g{(const bf16_t*)(WSQ + WS_R + R_X8), (const bf16_t*)(wl + W_GU), MOE_ROWS, 16384, D / 2, wave_s}; pg8::MoeGatherOrder S{(const LAS int*)(lds + TILEE_OFF), (int)MISC[33] * 4, G, bid, (const int*)(WSQ + WS_SRCROW)};
          pg8::EpiGU8 E{(unsigned char*)Hb};
          pg8::gemm_phase<pg8::EpiGU8, pg8::MoeGatherOrder, GEMM_ALIGN, GEMM_SP2>(lds, g, S, E); });
        GRID_BAR();
        PHASE(2, { pg8::Gemm g{Hb, (const bf16_t*)(wl + W_D), MOE_ROWS, 16384, 256, wave_s}; pg8::MoeOrder S{(const LAS int*)(lds + TILEE_OFF), (int)MISC[33] * 4, G, bid};
          pg8::EpiPlain8 E{(unsigned char*)Xs, D, 3};
          pg8::gemm_phase<pg8::EpiPlain8, pg8::MoeOrder, GEMM_ALIGN, GEMM_SP2>(lds, g, S, E); });
        GRID_BAR();
        if (REP_MASK & (1 << 8)) { ln_phase<2>(lds, args, l, 2, l == 1, Z, bid, G, wave_s); GRID_BAR(); }
        ln_phase<2>(lds, args, l, 2, l == 1, X, bid, G, wave_s);
        if (l == 0) GRID_BAR();
    }
}
#undef X
#undef P
#undef Y
#undef Z
#undef Qb
#undef Ob
#undef Xs
#undef Hb
#undef KV
#undef wl
}

extern "C" void kernel_launch(void* const* d_in, const int* in_sizes, int n_in, void* d_out, int out_size, void* d_ws, size_t ws_size, hipStream_t stream) {
    using namespace mk;
    static int grid = 0;
    if (grid == 0) {
        if (n_in != 22 || in_sizes[0] != M * D || out_size != M * D || ws_size < WS_END) { fprintf(stderr, "kernel_launch: unexpected shapes (n_in %d, in0 %d, out %d, ws %zu, need %zu)\n", n_in, n_in > 0 ? in_sizes[0] : -1, out_size, ws_size, (size_t)WS_END); grid = -1; return; }
        int dev = 0, cus = 0;
        if (hipGetDevice(&dev) != hipSuccess || hipDeviceGetAttribute(&cus, hipDeviceAttributeMultiprocessorCount, dev) != hipSuccess) { grid = -1; return; }
        if (hipFuncSetAttribute((const void*)mk_fwd, hipFuncAttributeMaxDynamicSharedMemorySize, LDS_BYTES) != hipSuccess) { fprintf(stderr, "kernel_launch: hipFuncSetAttribute failed\n"); grid = -1; return; }
        int per_cu = 0;
        if (hipOccupancyMaxActiveBlocksPerMultiprocessor(&per_cu, (const void*)mk_fwd, NTHR, LDS_BYTES) != hipSuccess || per_cu < 1) fprintf(stderr, "kernel_launch: occupancy query says %d\n", per_cu);
        (void)hipGetLastError();
        grid = cus;
    }
    if (grid < 0) return;
    if (hipMemsetAsync((char*)d_ws + WS_CTL, 0, CTL_ZERO_BYTES, stream) != hipSuccess) return;
    Args a{};
    for (int i = 0; i < 22; ++i) a.in[i] = (const float*)d_in[i];
    a.out = (float*)d_out; a.ws = (unsigned char*)d_ws;
    hipLaunchKernelGGL(mk_fwd, dim3(grid), dim3(NTHR), LDS_BYTES, stream, a);
}
```

```cpp
#include <hip/hip_runtime.h>
#include <cstdio>
#include <cstdint>

namespace pg8 {
#define PG8_LAS __attribute__((address_space(3)))
typedef unsigned short bf16_t;
typedef short bf16x8 __attribute__((ext_vector_type(8)));
typedef float f32x4 __attribute__((ext_vector_type(4)));
typedef unsigned u32x4 __attribute__((ext_vector_type(4)));
typedef unsigned u32x2 __attribute__((ext_vector_type(2)));
constexpr int BM = 256, BK = 64, HALF = 128, HTB = HALF * BK * 2  , STAGE_BYTES = 8 * HTB, NXCD = 8, WGM = 8;

__host__ __device__ __forceinline__ int lds_byte(int r, int c) { const int st = (r >> 4) * 2 + (c >> 5), rr = r & 15, cc = c & 31, ob = rr * 64 + cc * 2; return st * 1024 + (ob ^ (((ob >> 9) & 1) << 5)); }
__host__ __device__ __forceinline__ void stage_rc(int b, int& R, int& C) { const int st = b / 1024, sb = b % 1024, swz = sb ^ (((sb >> 9) & 1) << 5); R = (st >> 1) * 16 + swz / 64; C = (st & 1) * 32 + (swz % 64) / 2; }
__host__ __device__ __forceinline__ int perm32(int rho) { const int n = rho >> 4, i = rho & 15; return 8 * (i >> 2) + 4 * n + (i & 3); }

struct Unit { int pm, pn; };
struct Gemm { const bf16_t* A; const bf16_t* Bt; int M, N, K; int wv; };
__device__ __forceinline__ int lane_id() { int l; asm volatile("v_mbcnt_lo_u32_b32 %0, -1, 0\n\tv_mbcnt_hi_u32_b32 %0, -1, %0" : "=v"(l)); return l; }

struct StaticOrder {
    static constexpr bool GATHER = false;
    int nM, nN, nwg, G, c; const int* src = nullptr;
    __host__ __device__ void init(int M, int N, int G_, int c_) { nM = M / BM; nN = N / BM; nwg = nM * nN; G = G_; c = c_; }
    __host__ __device__ bool next(int i, Unit& u) const {
        const long L = (long)i * G + c; if (L >= nwg) return false;
        int wgid = (int)L; { const int q = nwg / NXCD, r = nwg % NXCD, xcd = wgid % NXCD, off = wgid / NXCD; wgid = (xcd < r ? xcd * (q + 1) : r * (q + 1) + (xcd - r) * q) + off; }
        const int nig = WGM * nN, gid = wgid / nig, fm = gid * WGM, gsz = (nM - fm) < WGM ? (nM - fm) : WGM;
        u.pm = fm + ((wgid % nig) % gsz); u.pn = (wgid % nig) / gsz; return true;
    }
    __device__ __forceinline__ void a_ready(const Unit&) const {}
    __device__ __forceinline__ void done(const Unit&) const {}
};
struct PanelOrder {
    static constexpr bool GATHER = false;
    int nN, npan, G, c; const int* src = nullptr;
    __device__ __forceinline__ bool next(int i, Unit& u) const { const int p = c + (i / nN) * G; if (p >= npan) return false; u.pm = p; u.pn = i % nN; return true; }
    __device__ __forceinline__ void a_ready(const Unit&) const {}
    __device__ __forceinline__ void done(const Unit&) const {}
};
template <bool GATH_> struct MoeOrderT {
    static constexpr bool GATHER = GATH_;
    const PG8_LAS int* tile_e; int nunits, G, c; const int* src = nullptr;
    __device__ __forceinline__ bool next(int i, Unit& u) const {
        const int cc = ((G & 7) == 0) ? (c & 7) * (G >> 3) + (c >> 3) : c;
        const int L = i * G + cc; if (L >= nunits) return false;
        u.pm = L >> 2; u.pn = tile_e[L >> 2] * 4 + (L & 3); return true;
    }
    __device__ __forceinline__ void a_ready(const Unit&) const {}
    __device__ __forceinline__ void done(const Unit&) const {}
};
typedef MoeOrderT<false> MoeOrder; typedef MoeOrderT<true> MoeGatherOrder;

typedef float f32x2_t __attribute__((ext_vector_type(2))); typedef __bf16 bf16x2_t __attribute__((ext_vector_type(2)));
typedef __amdgpu_buffer_rsrc_t rsrc_t;
__device__ __forceinline__ rsrc_t mk_rsrc(const void* p) { return __builtin_amdgcn_make_buffer_rsrc((void*)p, 0, 0x7fffffff, 0x00020000); }
__device__ __forceinline__ u32x4 bld4(rsrc_t r, unsigned voff, unsigned soff) { return __builtin_bit_cast(u32x4, __builtin_amdgcn_raw_buffer_load_b128(r, voff, soff, 0)); }
__device__ __forceinline__ f32x2_t bld2f(rsrc_t r, unsigned voff, unsigned soff) { return __builtin_bit_cast(f32x2_t, __builtin_amdgcn_raw_buffer_load_b64(r, voff, soff, 0)); }
#define GST4(p) (*(__attribute__((address_space(1))) u32x4*)(p))
__device__ __forceinline__ float f8clamp(float x) { return __builtin_fminf(__builtin_fmaxf(x, -448.0f), 448.0f); }
__device__ __forceinline__ unsigned pk4f8(float a, float b, float c, float d) { int w = 0; w = __builtin_amdgcn_cvt_pk_fp8_f32(f8clamp(a), f8clamp(b), w, false); w = __builtin_amdgcn_cvt_pk_fp8_f32(f8clamp(c), f8clamp(d), w, true); return (unsigned)w; }
constexpr float F8_SX = 4.0f, F8_SW = 64.0f, F8_SH = 8.0f, F8_SO = 64.0f, F8_SY = 16.0f, F8_SQ = 64.0f;
__device__ __forceinline__ unsigned pk2(float lo, float hi) { f32x2_t v = {lo, hi}; bf16x2_t b = __builtin_convertvector(v, bf16x2_t); return __builtin_bit_cast(unsigned, b); }
__device__ __forceinline__ float bflo(unsigned w) { return __builtin_bit_cast(float, w << 16); }
__device__ __forceinline__ float bfhi(unsigned w) { return __builtin_bit_cast(float, w & 0xffff0000u); }
__device__ __forceinline__ float f_silu(float x) { return x * __builtin_amdgcn_rcpf(1.0f + __builtin_amdgcn_exp2f(-1.4426950408889634f * x)); }
__device__ __forceinline__ float f_gelu_tanh(float x) { return x * __builtin_amdgcn_rcpf(1.0f + __builtin_amdgcn_exp2f(x * (-2.3022082f - 0.10294324f * x * x))); }
__device__ __forceinline__ float f_logsig16(float z) { const float t = __builtin_amdgcn_exp2f(-1.4426950408889634f * __builtin_fabsf(z)); return (__builtin_fminf(z, 0.0f) - 0.6931471805599453f * __builtin_amdgcn_logf(1.0f + t)) * 0.0625f; }

struct EpiPlain {
    static constexpr bool PERM = true, AFTER_DRAIN = false;
    bf16_t* O; int ldc; int cmask;
    __device__ __forceinline__ void operator()(const f32x4 (&acc)[2][2][4][2], const Unit& u, int wr, int wc, int fr, int fq) const {
        const int row0 = u.pm * BM + wr * 64 + fr, col0 = (u.pn & cmask) * BM + wc * 32 + 8 * fq;
#pragma unroll
        for (int ai = 0; ai < 2; ++ai)
#pragma unroll
            for (int m = 0; m < 4; ++m) { bf16_t* rowp = O + (size_t)(row0 + ai * HALF + m * 16) * ldc + col0;
#pragma unroll
                for (int bj = 0; bj < 2; ++bj) { const f32x4 v0 = acc[ai][bj][m][0], v1 = acc[ai][bj][m][1];
                    u32x4 w; w.x = pk2(v0[0], v0[1]); w.y = pk2(v0[2], v0[3]); w.z = pk2(v1[0], v1[1]); w.w = pk2(v1[2], v1[3]);
                    *(u32x4*)(rowp + bj * HALF) = w; } }
    }
};
struct EpiQFrag {
    static constexpr bool PERM = true, AFTER_DRAIN = false;
    bf16_t* O;
    __device__ __forceinline__ void operator()(const f32x4 (&acc)[2][2][4][2], const Unit& u, int wr, int wc, int fr, int fq) const {
        unsigned lo = (unsigned)(((fq >> 1) * 64 + fr + 32 * (fq & 1)) * 16); asm volatile("" : "+v"(lo));
        char* tile = (char*)(O + (size_t)(u.pm * 4 + u.pn) * 65536) + (size_t)(wr * 2 * 16 + wc * 2) * 1024 + lo;
#pragma unroll
        for (int ai = 0; ai < 2; ++ai)
#pragma unroll
            for (int m = 0; m < 4; ++m)
#pragma unroll
                for (int bj = 0; bj < 2; ++bj) { const f32x4 v0 = acc[ai][bj][m][0], v1 = acc[ai][bj][m][1];
                    u32x4 w; w.x = pk2(v0[0], v0[1]); w.y = pk2(v0[2], v0[3]); w.z = pk2(v1[0], v1[1]); w.w = pk2(v1[2], v1[3]);
                    *(u32x4*)(tile + ((4 * ai + (m >> 1)) * 16 + 8 * bj) * 1024 + (m & 1) * 256) = w; }
    }
};
struct EpiInProj {
    static constexpr bool PERM = true, AFTER_DRAIN = false;
    bf16_t* O; const float* b_a;
    template <int MODE> __device__ __forceinline__ void tile(const f32x4 (&acc)[2][2][4][2], const Unit& u, int wr, int wc, int fr, int fq) const {
        const int row0 = u.pm * BM + wr * 64 + fr, col0 = u.pn * BM + wc * 32 + 8 * fq;
        f32x4 bv[2][2];
#pragma unroll
        for (int bj = 0; bj < 2; ++bj)
#pragma unroll
            for (int n = 0; n < 2; ++n) bv[bj][n] = (MODE == 2) ? *(const f32x4*)(b_a + (col0 - 1536) + bj * HALF + 4 * n) : (f32x4){0.f, 0.f, 0.f, 0.f};
#pragma unroll
        for (int ai = 0; ai < 2; ++ai)
#pragma unroll
            for (int m = 0; m < 4; ++m) { bf16_t* rowp = O + (size_t)(row0 + ai * HALF + m * 16) * 2816 + col0;
#pragma unroll
                for (int bj = 0; bj < 2; ++bj) { f32x4 v0 = acc[ai][bj][m][0], v1 = acc[ai][bj][m][1];
#pragma unroll
                    for (int j = 0; j < 4; ++j) {
                        if (MODE == 1) { v0[j] = f_silu(v0[j]); v1[j] = f_silu(v1[j]); }
                        if (MODE == 2) { v0[j] = f_logsig16(v0[j] + bv[bj][0][j]); v1[j] = f_logsig16(v1[j] + bv[bj][1][j]); }
                        if (MODE == 3) { v0[j] = f_gelu_tanh(v0[j]); v1[j] = f_gelu_tanh(v1[j]); } }
                    u32x4 w; w.x = pk2(v0[0], v0[1]); w.y = pk2(v0[2], v0[3]); w.z = pk2(v1[0], v1[1]); w.w = pk2(v1[2], v1[3]);
                    *(u32x4*)(rowp + bj * HALF) = w; } }
    }
    __device__ __forceinline__ void operator()(const f32x4 (&acc)[2][2][4][2], const Unit& u, int wr, int wc, int fr, int fq) const {
        const int pn = u.pn;
        if (pn < 4) tile<0>(acc, u, wr, wc, fr, fq); else if (pn < 6) tile<1>(acc, u, wr, wc, fr, fq); else if (pn == 6) tile<2>(acc, u, wr, wc, fr, fq); else tile<3>(acc, u, wr, wc, fr, fq);
    }
};
struct EpiInProj8 {
    static constexpr bool PERM = true, AFTER_DRAIN = false, F8 = true; static constexpr float dq = 1.0f / (F8_SX * F8_SW);
    bf16_t* O; const float* b_a;
    template <int MODE> __device__ __forceinline__ void tile(const f32x4 (&acc)[2][2][4][2], const Unit& u, int wr, int wc, int fr, int fq) const {
        const int row0 = u.pm * BM + wr * 64 + fr, col0 = u.pn * BM + wc * 32 + 8 * fq;
        f32x4 bv[2][2];
#pragma unroll
        for (int bj = 0; bj < 2; ++bj)
#pragma unroll
            for (int n = 0; n < 2; ++n) bv[bj][n] = (MODE == 2) ? *(const f32x4*)(b_a + (col0 - 1536) + bj * HALF + 4 * n) : (f32x4){0.f, 0.f, 0.f, 0.f};
#pragma unroll
        for (int ai = 0; ai < 2; ++ai)
#pragma unroll
            for (int m = 0; m < 4; ++m) { bf16_t* rowp = O + (size_t)(row0 + ai * HALF + m * 16) * 2816 + col0;
#pragma unroll
                for (int bj = 0; bj < 2; ++bj) { f32x4 v0 = acc[ai][bj][m][0] * dq, v1 = acc[ai][bj][m][1] * dq;
#pragma unroll
                    for (int j = 0; j < 4; ++j) {
                        if (MODE == 1) { v0[j] = f_silu(v0[j]); v1[j] = f_silu(v1[j]); }
                        if (MODE == 2) { v0[j] = f_logsig16(v0[j] + bv[bj][0][j]); v1[j] = f_logsig16(v1[j] + bv[bj][1][j]); }
                        if (MODE == 3) { v0[j] = f_gelu_tanh(v0[j]); v1[j] = f_gelu_tanh(v1[j]); } }
                    u32x4 w; w.x = pk2(v0[0], v0[1]); w.y = pk2(v0[2], v0[3]); w.z = pk2(v1[0], v1[1]); w.w = pk2(v1[2], v1[3]);
                    *(u32x4*)(rowp + bj * HALF) = w; } }
    }
    __device__ __forceinline__ void operator()(const f32x4 (&acc)[2][2][4][2], const Unit& u, int wr, int wc, int fr, int fq) const {
        const int pn = u.pn;
        if (pn < 4) tile<0>(acc, u, wr, wc, fr, fq); else if (pn < 6) tile<1>(acc, u, wr, wc, fr, fq); else if (pn == 6) tile<2>(acc, u, wr, wc, fr, fq); else tile<3>(acc, u, wr, wc, fr, fq);
    }
};
struct EpiResid {
    static constexpr bool PERM = true, AFTER_DRAIN = false;
    const bf16_t* X; bf16_t* Z; float alpha;
    __device__ __forceinline__ void operator()(const f32x4 (&acc)[2][2][4][2], const Unit& u, int wr, int wc, int fr, int fq) const {
        const int row0 = u.pm * BM + wr * 64 + fr, col0 = u.pn * BM + wc * 32 + 8 * fq;
#pragma unroll
        for (int ai = 0; ai < 2; ++ai)
#pragma unroll
            for (int m = 0; m < 4; ++m) { const size_t off = (size_t)(row0 + ai * HALF + m * 16) * 1024 + col0;
#pragma unroll
                for (int bj = 0; bj < 2; ++bj) { const f32x4 v0 = acc[ai][bj][m][0], v1 = acc[ai][bj][m][1];
                    const u32x4 xr = *(const u32x4*)(X + off + bj * HALF);
                    u32x4 w; w.x = pk2(alpha * bflo(xr.x) + v0[0], alpha * bfhi(xr.x) + v0[1]); w.y = pk2(alpha * bflo(xr.y) + v0[2], alpha * bfhi(xr.y) + v0[3]);
                    w.z = pk2(alpha * bflo(xr.z) + v1[0], alpha * bfhi(xr.z) + v1[1]); w.w = pk2(alpha * bflo(xr.w) + v1[2], alpha * bfhi(xr.w) + v1[3]);
                    *(u32x4*)(Z + off + bj * HALF) = w; } }
    }
};
struct EpiResidStats {
    static constexpr bool PERM = true, AFTER_DRAIN = false;
    const bf16_t* X; bf16_t* Z; f32x2_t* part; static constexpr float alpha = 1.4142135623730951f;
    __device__ __forceinline__ void operator()(const f32x4 (&acc)[2][2][4][2], const Unit& u, int wr, int wc, int fr, int fq) const {
        const int row0 = u.pm * BM + wr * 64 + fr, col0 = u.pn * BM + wc * 32 + 8 * fq;
        int ln = 16 * fq + fr; asm volatile("" : "+v"(ln));
        float s1[8], s2[8];
        const rsrc_t rx = mk_rsrc(X); const unsigned voff = ((unsigned)row0 * 1024u + (unsigned)col0) * 2u;
        u32x4 xres[2][4][2];
#pragma unroll
        for (int ai = 0; ai < 2; ++ai)
#pragma unroll
            for (int m = 0; m < 4; ++m)
#pragma unroll
                for (int bj = 0; bj < 2; ++bj) xres[ai][m][bj] = bld4(rx, voff, (unsigned)(((ai * HALF + m * 16) * 1024 + bj * HALF) * 2));
        __builtin_amdgcn_sched_barrier(0);
#pragma unroll
        for (int ai = 0; ai < 2; ++ai)
#pragma unroll
            for (int m = 0; m < 4; ++m) { const size_t off = (size_t)(row0 + ai * HALF + m * 16) * 1024 + col0; float a1 = 0.f, a2 = 0.f;
#pragma unroll
                for (int bj = 0; bj < 2; ++bj) { const f32x4 v0 = acc[ai][bj][m][0], v1 = acc[ai][bj][m][1];
                    const u32x4 xr = xres[ai][m][bj];
                    u32x4 w; w.x = pk2(alpha * bflo(xr.x) + v0[0], alpha * bfhi(xr.x) + v0[1]); w.y = pk2(alpha * bflo(xr.y) + v0[2], alpha * bfhi(xr.y) + v0[3]);
                    w.z = pk2(alpha * bflo(xr.z) + v1[0], alpha * bfhi(xr.z) + v1[1]); w.w = pk2(alpha * bflo(xr.w) + v1[2], alpha * bfhi(xr.w) + v1[3]);
                    GST4(Z + off + bj * HALF) = w;
                    const float z0 = bflo(w.x), z1 = bfhi(w.x), z2 = bflo(w.y), z3 = bfhi(w.y), z4 = bflo(w.z), z5 = bfhi(w.z), z6 = bflo(w.w), z7 = bfhi(w.w);
                    a1 += ((z0 + z1) + (z2 + z3)) + ((z4 + z5) + (z6 + z7)); a2 += ((z0 * z0 + z1 * z1) + (z2 * z2 + z3 * z3)) + ((z4 * z4 + z5 * z5) + (z6 * z6 + z7 * z7)); }
                s1[ai * 4 + m] = a1; s2[ai * 4 + m] = a2; }
        const bool h5 = (ln & 32) != 0, h4 = (ln & 16) != 0;
        float t1[4], t2[4];
#pragma unroll
        for (int i = 0; i < 4; ++i) { const float m1 = h5 ? s1[4 + i] : s1[i], g1 = h5 ? s1[i] : s1[4 + i], m2 = h5 ? s2[4 + i] : s2[i], g2 = h5 ? s2[i] : s2[4 + i];
            t1[i] = m1 + __builtin_bit_cast(float, __builtin_amdgcn_ds_bpermute((ln ^ 32) << 2, __builtin_bit_cast(int, g1)));
            t2[i] = m2 + __builtin_bit_cast(float, __builtin_amdgcn_ds_bpermute((ln ^ 32) << 2, __builtin_bit_cast(int, g2))); }
        float r1[2], r2[2];
#pragma unroll
        for (int i = 0; i < 2; ++i) { const float m1 = h4 ? t1[2 + i] : t1[i], g1 = h4 ? t1[i] : t1[2 + i], m2 = h4 ? t2[2 + i] : t2[i], g2 = h4 ? t2[i] : t2[2 + i];
            r1[i] = m1 + __builtin_bit_cast(float, __builtin_amdgcn_ds_bpermute((ln ^ 16) << 2, __builtin_bit_cast(int, g1)));
            r2[i] = m2 + __builtin_bit_cast(float, __builtin_amdgcn_ds_bpermute((ln ^ 16) << 2, __builtin_bit_cast(int, g2))); }
#pragma unroll
        for (int i = 0; i < 2; ++i) { const int gi = (h5 ? 4 : 0) + (h4 ? 2 : 0) + i, row = row0 + (gi >> 2) * HALF + (gi & 3) * 16;
            part[(size_t)row * 16 + u.pn * 4 + wc] = (f32x2_t){r1[i], r2[i]}; }
    }
};
struct EpiQFragLN {
    static constexpr bool PERM = true, AFTER_DRAIN = false;
    unsigned char* O; const f32x2_t* stats; const float* csum; const float* bq;
    __device__ __forceinline__ void operator()(const f32x4 (&acc)[2][2][4][2], const Unit& u, int wr, int wc, int fr, int fq) const {
        unsigned lo = (unsigned)(((fq >> 1) * 64 + fr + 32 * (fq & 1)) * 16); asm volatile("" : "+v"(lo));
        unsigned char* tile = O + (size_t)(u.pm * 4 + u.pn) * 65536 + (size_t)(wr * 2 * 8 + wc * 2) * 1024 + lo;
        const int row0 = u.pm * BM + wr * 64 + fr, col0 = u.pn * BM + wc * 32 + 8 * fq;
        f32x4 cc[2][2], bb[2][2];
#pragma unroll
        for (int bj = 0; bj < 2; ++bj)
#pragma unroll
            for (int n = 0; n < 2; ++n) { cc[bj][n] = *(const f32x4*)(csum + col0 + bj * HALF + 4 * n); bb[bj][n] = *(const f32x4*)(bq + col0 + bj * HALF + 4 * n); }
#pragma unroll
        for (int ai = 0; ai < 2; ++ai)
#pragma unroll
            for (int m = 0; m < 4; ++m) { const f32x2_t st = stats[row0 + ai * HALF + m * 16]; const float mu = st[0], rs = st[1] * F8_SQ; u32x4 w;
#pragma unroll
                for (int bj = 0; bj < 2; ++bj) { const f32x4 v0 = (acc[ai][bj][m][0] - mu * cc[bj][0]) * rs + bb[bj][0] * F8_SQ, v1 = (acc[ai][bj][m][1] - mu * cc[bj][1]) * rs + bb[bj][1] * F8_SQ;
                    const unsigned lo4 = pk4f8(v0[0], v0[1], v0[2], v0[3]), hi4 = pk4f8(v1[0], v1[1], v1[2], v1[3]);
                    if (bj == 0) { w.x = lo4; w.y = hi4; } else { w.z = lo4; w.w = hi4; } }
                *(u32x4*)(tile + (4 * ai + (m >> 1)) * 8192 + (m & 1) * 256) = w; }
    }
};
struct EpiResidLN {
    static constexpr bool PERM = true, AFTER_DRAIN = false;
    bf16_t* Z; const f32x2_t* stats; const float* gain; const float* bias; static constexpr float alpha = 1.4142135623730951f;
    __device__ __forceinline__ void operator()(const f32x4 (&acc)[2][2][4][2], const Unit& u, int wr, int wc, int fr, int fq) const {
        const int row0 = u.pm * BM + wr * 64 + fr, col0 = u.pn * BM + wc * 32 + 8 * fq;
        const rsrc_t rz = mk_rsrc(Z), rs = mk_rsrc(stats); const unsigned voff = ((unsigned)row0 * 1024u + (unsigned)col0) * 2u;
        f32x2_t st[2][4];
#pragma unroll
        for (int ai = 0; ai < 2; ++ai)
#pragma unroll
            for (int m = 0; m < 4; ++m) st[ai][m] = bld2f(rs, (unsigned)row0 * 8u, (unsigned)((ai * HALF + m * 16) * 8));
#pragma unroll
        for (int bj = 0; bj < 2; ++bj) {
            u32x4 zres[2][4];
#pragma unroll
            for (int ai = 0; ai < 2; ++ai)
#pragma unroll
                for (int m = 0; m < 4; ++m) zres[ai][m] = bld4(rz, voff, (unsigned)(((ai * HALF + m * 16) * 1024 + bj * HALF) * 2));
            const f32x4 g0 = *(const f32x4*)(gain + col0 + bj * HALF) * alpha, g1 = *(const f32x4*)(gain + col0 + bj * HALF + 4) * alpha, b0 = *(const f32x4*)(bias + col0 + bj * HALF) * alpha, b1 = *(const f32x4*)(bias + col0 + bj * HALF + 4) * alpha;
            __builtin_amdgcn_sched_barrier(0);
#pragma unroll
            for (int ai = 0; ai < 2; ++ai)
#pragma unroll
                for (int m = 0; m < 4; ++m) { const int row = row0 + ai * HALF + m * 16; const float mu = st[ai][m][0], rsd = st[ai][m][1];
                    const u32x4 zr = zres[ai][m];
                    const f32x4 z0 = (f32x4){bflo(zr.x), bfhi(zr.x), bflo(zr.y), bfhi(zr.y)}, z1 = (f32x4){bflo(zr.z), bfhi(zr.z), bflo(zr.w), bfhi(zr.w)};
                    const f32x4 v0 = (z0 - mu) * rsd * g0 + b0 + acc[ai][bj][m][0], v1 = (z1 - mu) * rsd * g1 + b1 + acc[ai][bj][m][1];
                    u32x4 w; w.x = pk2(v0[0], v0[1]); w.y = pk2(v0[2], v0[3]); w.z = pk2(v1[0], v1[1]); w.w = pk2(v1[2], v1[3]);
                    GST4(Z + (size_t)row * 1024 + col0 + bj * HALF) = w; } }
    }
};
struct EpiResidLN8 {
    static constexpr bool PERM = true, AFTER_DRAIN = false, F8 = true; static constexpr float dq = 1.0f / (F8_SO * F8_SW);
    bf16_t* Z; const f32x2_t* stats; const float* gain; const float* bias; static constexpr float alpha = 1.4142135623730951f;
    __device__ __forceinline__ void operator()(const f32x4 (&acc)[2][2][4][2], const Unit& u, int wr, int wc, int fr, int fq) const {
        const int row0 = u.pm * BM + wr * 64 + fr, col0 = u.pn * BM + wc * 32 + 8 * fq;
        const rsrc_t rz = mk_rsrc(Z), rs = mk_rsrc(stats); const unsigned voff = ((unsigned)row0 * 1024u + (unsigned)col0) * 2u;
        f32x2_t st[2][4];
#pragma unroll
        for (int ai = 0; ai < 2; ++ai)
#pragma unroll
            for (int m = 0; m < 4; ++m) st[ai][m] = bld2f(rs, (unsigned)row0 * 8u, (unsigned)((ai * HALF + m * 16) * 8));
#pragma unroll
        for (int bj = 0; bj < 2; ++bj) {
            u32x4 zres[2][4];
#pragma unroll
            for (int ai = 0; ai < 2; ++ai)
#pragma unroll
                for (int m = 0; m < 4; ++m) zres[ai][m] = bld4(rz, voff, (unsigned)(((ai * HALF + m * 16) * 1024 + bj * HALF) * 2));
            const f32x4 g0 = *(const f32x4*)(gain + col0 + bj * HALF) * alpha, g1 = *(const f32x4*)(gain + col0 + bj * HALF + 4) * alpha, b0 = *(const f32x4*)(bias + col0 + bj * HALF) * alpha, b1 = *(const f32x4*)(bias + col0 + bj * HALF + 4) * alpha;
            __builtin_amdgcn_sched_barrier(0);
#pragma unroll
            for (int ai = 0; ai < 2; ++ai)
#pragma unroll
                for (int m = 0; m < 4; ++m) { const int row = row0 + ai * HALF + m * 16; const float mu = st[ai][m][0], rsd = st[ai][m][1];
                    const u32x4 zr = zres[ai][m];
                    const f32x4 z0 = (f32x4){bflo(zr.x), bfhi(zr.x), bflo(zr.y), bfhi(zr.y)}, z1 = (f32x4){bflo(zr.z), bfhi(zr.z), bflo(zr.w), bfhi(zr.w)};
                    const f32x4 v0 = (z0 - mu) * rsd * g0 + b0 + acc[ai][bj][m][0] * dq, v1 = (z1 - mu) * rsd * g1 + b1 + acc[ai][bj][m][1] * dq;
                    u32x4 w; w.x = pk2(v0[0], v0[1]); w.y = pk2(v0[2], v0[3]); w.z = pk2(v1[0], v1[1]); w.w = pk2(v1[2], v1[3]);
                    GST4(Z + (size_t)row * 1024 + col0 + bj * HALF) = w; } }
    }
};
struct EpiGU {
    static constexpr bool PERM = true, AFTER_DRAIN = false;
    bf16_t* H;
    __device__ __forceinline__ void operator()(const f32x4 (&acc)[2][2][4][2], const Unit& u, int wr, int wc, int fr, int fq) const {
        const int row0 = u.pm * BM + wr * 64 + fr, col0 = (u.pn & 3) * 128 + wc * 16 + 4 * fq;
#pragma unroll
        for (int ai = 0; ai < 2; ++ai)
#pragma unroll
            for (int m = 0; m < 4; ++m) { bf16_t* rowp = H + (size_t)(row0 + ai * HALF + m * 16) * 512 + col0;
#pragma unroll
                for (int bj = 0; bj < 2; ++bj) { const f32x4 g = acc[ai][bj][m][0], up = acc[ai][bj][m][1];
                    u32x2 w; w.x = pk2(f_silu(g[0]) * up[0], f_silu(g[1]) * up[1]); w.y = pk2(f_silu(g[2]) * up[2], f_silu(g[3]) * up[3]);
                    *(u32x2*)(rowp + bj * 64) = w; } }
    }
};
struct EpiGU8 {
    static constexpr bool PERM = true, AFTER_DRAIN = false, F8 = true;
    unsigned char* H;
    __device__ __forceinline__ void operator()(const f32x4 (&acc)[2][2][4][2], const Unit& u, int wr, int wc, int fr, int fq) const {
        const int row0 = u.pm * BM + wr * 64 + fr, col0 = (u.pn & 3) * 128 + wc * 32 + 8 * fq;
        constexpr float dq = 1.0f / (F8_SX * F8_SW);
#pragma unroll
        for (int ai = 0; ai < 2; ++ai)
#pragma unroll
            for (int m = 0; m < 4; ++m) { float h[8];
#pragma unroll
                for (int n = 0; n < 2; ++n) { const f32x4 g = acc[ai][0][m][n] * dq, up = acc[ai][1][m][n] * (dq * F8_SH);
#pragma unroll
                    for (int i = 0; i < 4; ++i) h[4 * n + i] = f_silu(g[i]) * up[i]; }
                u32x2 w; w.x = pk4f8(h[0], h[1], h[2], h[3]); w.y = pk4f8(h[4], h[5], h[6], h[7]);
                *(u32x2*)(H + (size_t)(row0 + ai * HALF + m * 16) * 512 + col0) = w; }
    }
};
struct EpiPlain8 {
    static constexpr bool PERM = true, AFTER_DRAIN = false, F8 = true;
    unsigned char* O; int ldc; int cmask;
    __device__ __forceinline__ void operator()(const f32x4 (&acc)[2][2][4][2], const Unit& u, int wr, int wc, int fr, int fq) const {
        const int row0 = u.pm * BM + wr * 64 + fr, col0 = (u.pn & cmask) * BM + wc * 32 + 8 * fq;
        constexpr float dq = F8_SY / (F8_SH * F8_SW);
#pragma unroll
        for (int ai = 0; ai < 2; ++ai)
#pragma unroll
            for (int m = 0; m < 4; ++m) { unsigned char* rowp = O + (size_t)(row0 + ai * HALF + m * 16) * ldc + col0;
#pragma unroll
                for (int bj = 0; bj < 2; ++bj) { const f32x4 v0 = acc[ai][bj][m][0] * dq, v1 = acc[ai][bj][m][1] * dq;
                    u32x2 w; w.x = pk4f8(v0[0], v0[1], v0[2], v0[3]); w.y = pk4f8(v1[0], v1[1], v1[2], v1[3]);
                    *(u32x2*)(rowp + bj * HALF) = w; } }
    }
};

typedef int i32x4_t __attribute__((ext_vector_type(4)));
template <class T, class = void> struct epi_f8 { static constexpr bool value = false; };
template <class T> struct epi_f8<T, decltype((void)T::F8)> { static constexpr bool value = true; };
template <class Epi, class Sched, bool ALIGN_EPI = false, bool SP2 = false>
__device__ __forceinline__ void gemm_phase(PG8_LAS unsigned char* lds, const Gemm g, const Sched& S, const Epi& E) {
    int tid_ = g.wv * 64 + lane_id(); asm volatile("" : "+v"(tid_));
    const int tid = tid_, wid = __builtin_amdgcn_readfirstlane(tid >> 6), lane = tid & 63, wr = wid >> 2, wc = wid & 3, fr = lane & 15, fq = lane >> 4;
    const int K = g.K, nt = K / BK; constexpr bool F8 = epi_f8<Epi>::value;
    unsigned voffA[2], voffB[2];
#pragma unroll
    for (int i = 0; i < 2; ++i) { int R, C; stage_rc(tid * 16 + i * 8192, R, C); const int Rb = Epi::PERM ? ((R & ~31) + perm32(R & 31)) : R;
        voffA[i] = (unsigned)(R * K + C) * 2u;
        voffB[i] = (unsigned)(((Rb >> 4) * (K >> 5) + (C >> 5)) * 1024 + (Rb & 15) * 64 + (C & 31) * 2); }
    constexpr bool GATH = Sched::GATHER; static_assert(!GATH || SP2, "gather mode is written for the SP2 loop");
    unsigned goc[2][2] = {{0u, 0u}, {0u, 0u}}, gon[2][2] = {{0u, 0u}, {0u, 0u}}, go2[2][2] = {{0u, 0u}, {0u, 0u}};
#define PG8_GOFF(dst, U) do { int tg_ = tid; asm volatile("" : "+v"(tg_)); _Pragma("unroll") for (int i_ = 0; i_ < 2; ++i_) { int R_, C_; stage_rc(tg_ * 16 + i_ * 8192, R_, C_); \
        _Pragma("unroll") for (int h_ = 0; h_ < 2; ++h_) dst[h_][i_] = (unsigned)S.src[(U).pm * BM + h_ * HALF + R_] * (unsigned)(K * 2) + (unsigned)C_ * 2u; } } while (0)
    const size_t kstep = (size_t)(BK * 2);
    const size_t kstepB = 2048;
    const size_t hstep = (size_t)HALF * K * 2;
    const size_t tstep = 2 * hstep;
    const unsigned ldsw = (unsigned)wid * 1024u;
    const int aoff = lds_byte(wr * 64 + fr, fq * 8), boff = lds_byte(wc * 32 + fr, fq * 8);
#define PG8_SA(b, h) (((b) * 2 + (h)) * HTB)
#define PG8_SB(b, h) ((4 + (b) * 2 + (h)) * HTB)
#define PG8_STAGE(bufoff, gbase, voff) do { _Pragma("unroll") for (int _i = 0; _i < 2; ++_i) \
        __builtin_amdgcn_global_load_lds((const unsigned*)((const char*)(gbase) + (voff)[_i]), (PG8_LAS unsigned*)(lds + (bufoff) + ldsw + _i * 8192), 16, 0, 0); } while (0)
#define PG8_STAGE_A(b, h, PTR, KPTR, GO) do { if constexpr (GATH) { PG8_STAGE(PG8_SA(b, h), KPTR, GO); } else { PG8_STAGE(PG8_SA(b, h), PTR, voffA); } } while (0)
#define PG8_LDA(dst, b, h) do { _Pragma("unroll") for (int m = 0; m < 4; ++m) _Pragma("unroll") for (int k = 0; k < 2; ++k) dst[m][k] = *(const PG8_LAS bf16x8*)(lds + PG8_SA(b, h) + aoff + m * 2048 + k * 1024); } while (0)
#define PG8_LDB(dst, b, h) do { _Pragma("unroll") for (int n = 0; n < 2; ++n) _Pragma("unroll") for (int k = 0; k < 2; ++k) dst[n][k] = *(const PG8_LAS bf16x8*)(lds + PG8_SB(b, h) + boff + n * 2048 + k * 1024); } while (0)
#define PG8_CAT8(x, y) __builtin_shufflevector(__builtin_bit_cast(i32x4_t, x), __builtin_bit_cast(i32x4_t, y), 0, 1, 2, 3, 4, 5, 6, 7)
#define PG8_MMA(ai, bj, At, Bt) do { __builtin_amdgcn_s_setprio(1); \
        if constexpr (F8) { _Pragma("unroll") for (int m = 0; m < 4; ++m) _Pragma("unroll") for (int n = 0; n < 2; ++n) \
            asm volatile("v_mfma_f32_16x16x128_f8f6f4 %0, %1, %2, %0" : "+v"(acc[ai][bj][m][n]) : "v"(PG8_CAT8(Bt[n][0], Bt[n][1])), "v"(PG8_CAT8(At[m][0], At[m][1]))); } \
        else { _Pragma("unroll") for (int m = 0; m < 4; ++m) _Pragma("unroll") for (int n = 0; n < 2; ++n) _Pragma("unroll") for (int k = 0; k < 2; ++k) \
            acc[ai][bj][m][n] = __builtin_amdgcn_mfma_f32_16x16x32_bf16(Bt[n][k], At[m][k], acc[ai][bj][m][n], 0, 0, 0); } \
        __builtin_amdgcn_s_setprio(0); } while (0)
#define PG8_WAIT_V(n) asm volatile("s_waitcnt vmcnt(" #n ")" ::: "memory")
#define PG8_WAIT_L(n) asm volatile("s_waitcnt lgkmcnt(" #n ")" ::: "memory")
#define PG8_BAR __builtin_amdgcn_s_barrier()
#define PG8_SCHED __builtin_amdgcn_sched_barrier(0)
    Unit cur, nxt; int ui = 0;
    if (!S.next(0, cur)) return;
    f32x4 acc[2][2][4][2];
#pragma unroll
    for (int a = 0; a < 2; ++a)
#pragma unroll
        for (int b = 0; b < 2; ++b)
#pragma unroll
            for (int m = 0; m < 4; ++m)
#pragma unroll
                for (int n = 0; n < 2; ++n) { acc[a][b][m][n] = (f32x4){0.f, 0.f, 0.f, 0.f}; if constexpr (F8) asm volatile("" : "+v"(acc[a][b][m][n])); }
    bf16x8 At[4][2], B0[2][2], B1[2][2];
    const char* cA = (const char*)g.A + (size_t)cur.pm * tstep; const char* cB = (const char*)g.Bt + (size_t)cur.pn * tstep;
    S.a_ready(cur);
    const char* gA = (const char*)g.A;
    if constexpr (GATH) PG8_GOFF(goc, cur);
    if constexpr (SP2) {
        PG8_STAGE(PG8_SB(0, 0), cB, voffB); PG8_STAGE(PG8_SB(0, 1), cB + hstep, voffB); PG8_STAGE_A(0, 0, cA, gA, goc[0]); PG8_STAGE_A(0, 1, cA + hstep, gA, goc[1]);
        if (wr == 1) PG8_BAR;
        PG8_WAIT_V(2); PG8_BAR;
        PG8_STAGE(PG8_SB(1, 0), cB + kstepB, voffB); PG8_STAGE_A(1, 0, cA + kstep, gA + kstep, goc[0]); PG8_STAGE(PG8_SB(1, 1), cB + hstep + kstepB, voffB);
        PG8_WAIT_V(6); PG8_BAR;
    } else {
        PG8_STAGE(PG8_SB(0, 0), cB, voffB); PG8_STAGE(PG8_SA(0, 0), cA, voffA); PG8_STAGE(PG8_SB(0, 1), cB + hstep, voffB); PG8_STAGE(PG8_SA(0, 1), cA + hstep, voffA);
        if (wr == 1) PG8_BAR;
        PG8_WAIT_V(4); PG8_BAR;
        PG8_STAGE(PG8_SB(1, 0), cB + kstepB, voffB); PG8_STAGE(PG8_SA(1, 0), cA + kstep, voffA); PG8_STAGE(PG8_SB(1, 1), cB + hstep + kstepB, voffB);
        PG8_WAIT_V(6); PG8_BAR;
    }
    for (;;) {
        const bool has_next = S.next(ui + 1, nxt);
        if constexpr (GATH) { if (has_next) PG8_GOFF(gon, nxt); else { _Pragma("unroll") for (int h_ = 0; h_ < 2; ++h_) _Pragma("unroll") for (int i_ = 0; i_ < 2; ++i_) gon[h_][i_] = goc[h_][i_]; } }
        const char* nA = has_next ? (const char*)g.A + (size_t)nxt.pm * tstep : cA; const char* nB = has_next ? (const char*)g.Bt + (size_t)nxt.pn * tstep : cB;
        for (int t = 0; t < nt; t += 2) {
            const bool last = (t == nt - 2);
            const char* a1 = cA + (size_t)(t + 1) * kstep;
            const char* a2 = last ? nA : cA + (size_t)(t + 2) * kstep; const char* b2 = last ? nB : cB + (size_t)(t + 2) * kstepB;
            const char* a3 = a2 + kstep; const char* b3 = b2 + kstepB;
            if (last && has_next) S.a_ready(nxt);
            const char* ga1 = gA + (size_t)(t + 1) * kstep; const char* ga2 = last ? gA : gA + (size_t)(t + 2) * kstep; const char* ga3 = ga2 + kstep;
            if constexpr (GATH) { _Pragma("unroll") for (int h_ = 0; h_ < 2; ++h_) _Pragma("unroll") for (int i_ = 0; i_ < 2; ++i_) go2[h_][i_] = last ? gon[h_][i_] : goc[h_][i_]; }
            if constexpr (SP2) {
            PG8_LDB(B0, 0, 0); PG8_LDB(B1, 0, 1); PG8_SCHED; PG8_LDA(At, 0, 0); PG8_STAGE_A(1, 1, a1 + hstep, ga1, goc[1]);
            PG8_WAIT_V(8); PG8_WAIT_L(0); PG8_BAR; PG8_MMA(0, 0, At, B0); PG8_MMA(0, 1, At, B1); PG8_BAR; PG8_SCHED;
            PG8_LDA(At, 0, 1); PG8_STAGE(PG8_SB(0, 0), b2, voffB); PG8_STAGE(PG8_SB(0, 1), b2 + hstep, voffB); PG8_STAGE_A(0, 0, a2, ga2, go2[0]);
            PG8_WAIT_V(8); PG8_WAIT_L(0); PG8_BAR; PG8_MMA(1, 0, At, B0); PG8_MMA(1, 1, At, B1); PG8_BAR; PG8_SCHED;
            PG8_LDB(B0, 1, 0); PG8_LDB(B1, 1, 1); PG8_SCHED; PG8_LDA(At, 1, 0); PG8_STAGE_A(0, 1, a2 + hstep, ga2, go2[1]);
            PG8_WAIT_V(8); PG8_WAIT_L(0); PG8_BAR; PG8_MMA(0, 0, At, B0); PG8_MMA(0, 1, At, B1); PG8_BAR; PG8_SCHED;
            PG8_LDA(At, 1, 1); PG8_STAGE(PG8_SB(1, 0), b3, voffB); PG8_STAGE(PG8_SB(1, 1), b3 + hstep, voffB); PG8_STAGE_A(1, 0, a3, ga3, go2[0]);
            PG8_WAIT_V(8); PG8_WAIT_L(0); PG8_BAR; PG8_MMA(1, 0, At, B0); PG8_MMA(1, 1, At, B1); PG8_BAR; PG8_SCHED;
            } else {
            PG8_LDB(B0, 0, 0); PG8_SCHED; PG8_LDA(At, 0, 0); PG8_STAGE(PG8_SA(1, 1), a1 + hstep, voffA);
            PG8_WAIT_L(8); PG8_BAR; PG8_WAIT_L(0); PG8_MMA(0, 0, At, B0); PG8_BAR; PG8_SCHED;
            PG8_LDB(B1, 0, 1); PG8_STAGE(PG8_SB(0, 0), b2, voffB);
            PG8_BAR; PG8_WAIT_L(0); PG8_MMA(0, 1, At, B1); PG8_BAR;
            PG8_LDA(At, 0, 1); PG8_STAGE(PG8_SA(0, 0), a2, voffA);
            PG8_BAR; PG8_WAIT_L(0); PG8_MMA(1, 0, At, B0); PG8_BAR; PG8_SCHED;
            PG8_STAGE(PG8_SB(0, 1), b2 + hstep, voffB);
            PG8_WAIT_V(6); PG8_BAR; PG8_MMA(1, 1, At, B1); PG8_BAR;
            PG8_LDB(B0, 1, 0); PG8_SCHED; PG8_LDA(At, 1, 0); PG8_STAGE(PG8_SA(0, 1), a2 + hstep, voffA);
            PG8_WAIT_L(8); PG8_BAR; PG8_WAIT_L(0); PG8_MMA(0, 0, At, B0); PG8_BAR; PG8_SCHED;
            PG8_LDB(B1, 1, 1); PG8_STAGE(PG8_SB(1, 0), b3, voffB);
            PG8_BAR; PG8_WAIT_L(0); PG8_MMA(0, 1, At, B1); PG8_BAR;
            PG8_LDA(At, 1, 1); PG8_STAGE(PG8_SA(1, 0), a3, voffA);
            PG8_BAR; PG8_WAIT_L(0); PG8_MMA(1, 0, At, B0); PG8_BAR; PG8_SCHED;
            PG8_STAGE(PG8_SB(1, 1), b3 + hstep, voffB);
            PG8_WAIT_V(6); PG8_BAR; PG8_MMA(1, 1, At, B1); PG8_BAR;
            }
        }
        if constexpr (F8) asm volatile("s_nop 15\n\ts_nop 15" ::: "memory");
        if constexpr (ALIGN_EPI) { if (wr == 0) PG8_BAR; }
        if constexpr (!Epi::AFTER_DRAIN) { E(acc, cur, wr, wc, fr, fq); S.done(cur); }
        if (!has_next) break;
#pragma unroll
        for (int a = 0; a < 2; ++a)
#pragma unroll
            for (int b = 0; b < 2; ++b)
#pragma unroll
                for (int m = 0; m < 4; ++m)
#pragma unroll
                    for (int n = 0; n < 2; ++n) { acc[a][b][m][n] = (f32x4){0.f, 0.f, 0.f, 0.f}; if constexpr (F8) asm volatile("" : "+v"(acc[a][b][m][n])); }
        cur = nxt; cA = nA; cB = nB; ++ui;
        if constexpr (GATH) { _Pragma("unroll") for (int h_ = 0; h_ < 2; ++h_) _Pragma("unroll") for (int i_ = 0; i_ < 2; ++i_) goc[h_][i_] = gon[h_][i_]; }
        if constexpr (ALIGN_EPI) { if (wr == 1) PG8_BAR; }
    }
    PG8_WAIT_V(0);
    if constexpr (!ALIGN_EPI) { if (wr == 0) PG8_BAR; }
    PG8_BAR;
    if constexpr (Epi::AFTER_DRAIN) { E.fused(acc, cur, wr, wc, fr, fq, lds, wid, lane); S.done(cur); }
#undef PG8_SA
#undef PG8_SB
#undef PG8_STAGE
#undef PG8_STAGE_A
#undef PG8_GOFF
#undef PG8_LDA
#undef PG8_LDB
#undef PG8_MMA
#undef PG8_WAIT_V
#undef PG8_WAIT_L
#undef PG8_BAR
#undef PG8_SCHED
}}

namespace mk {
using pg8::bf16_t; using pg8::bf16x8; using pg8::f32x4; using pg8::u32x4; using pg8::u32x2; using pg8::pk2; using pg8::bflo; using pg8::bfhi;
typedef float f32x16 __attribute__((ext_vector_type(16)));
typedef short s16x4 __attribute__((ext_vector_type(4)));
typedef short v4i16_t __attribute__((ext_vector_type(4)));
#define LAS __attribute__((address_space(3)))
#define GAS __attribute__((address_space(1)))
typedef GAS unsigned gu32;
#define RLX_AGENT __ATOMIC_RELAXED, __HIP_MEMORY_SCOPE_AGENT
#define LDS_WAIT() asm volatile("s_waitcnt lgkmcnt(0)" ::: "memory")

constexpr int NB = 8, SEQ = 8192, M = NB * SEQ, D = 1024, NP = 2816, NMEM = 256, MKV = NB * NMEM;
constexpr int PQ = 0, PK = 256, PV = 512, PR = 1024, PG = 1536, PU = 1792, PVS = 2304;
constexpr int DIN = 2576;
constexpr int MOE_ROWS = 135168;
constexpr float ALPHA = 1.4142135623730951f, LN_EPS = 1e-5f, LOG2E = 1.4426950408889634f;
constexpr int NWAVES = 8, NTHR = 512;

constexpr size_t MiB = 1u << 20;
constexpr size_t WS_CTL = 0, CTL_ZERO_BYTES = 1 * MiB;
constexpr size_t WS_WM = 1 * MiB;
constexpr size_t WS_WGCNT = 1 * MiB + 512 * 1024;
constexpr size_t WS_LTOT = 1 * MiB + 768 * 1024;
constexpr size_t WS_TINFO = 2 * MiB;
constexpr size_t WS_TRANK = 3 * MiB;
constexpr size_t WS_TSLOT = 3 * MiB + 512 * 1024;
constexpr size_t WS_SEND = 4 * MiB;
constexpr size_t WS_WKV = 12 * MiB;
constexpr size_t WS_MEMB = 20 * MiB;
constexpr size_t WS_KV = 24 * MiB;
constexpr size_t WS_W = 40 * MiB, W_LAYER = 60 * MiB;
constexpr size_t W_IN = 0, W_OUT = (size_t)NP * D * 2, W_Q = W_OUT + 2 * MiB, W_O = W_Q + 2 * MiB, W_GU = W_O + 2 * MiB, W_D = W_GU + 32 * MiB;
static_assert(W_D + 16 * MiB <= W_LAYER, "weights per layer");
constexpr size_t WS_X = 160 * MiB;
constexpr size_t WS_R = 288 * MiB;
constexpr size_t R_P = 0, R_Y = 352 * MiB, R_Z = 480 * MiB, R_Q = 0, R_O = 128 * MiB, R_XS = 344 * MiB, R_H = 0;
constexpr size_t R_X8 = 256 * MiB;
constexpr size_t WS_SRCROW = WS_R + 616 * MiB;
constexpr size_t WS_PART = WS_SRCROW + 1 * MiB;
constexpr size_t WS_STATS = WS_PART + 8 * MiB;
constexpr size_t WS_CS = WS_STATS + 1 * MiB;
constexpr size_t WS_X8IN = WS_CS + 1 * MiB;
constexpr size_t WS_END = WS_X8IN + 64 * MiB;
static_assert(R_XS + (size_t)MOE_ROWS * D * 2 <= 616 * MiB && R_H + (size_t)MOE_ROWS * 512 * 2 <= R_XS, "moe buffers");
constexpr int CW_BAR = 4096;

constexpr int LDS_BYTES = 159744, LDSCTL_OFF = 155648;
constexpr int MISC_OFF = LDSCTL_OFF;
constexpr int TILEE_OFF = LDSCTL_OFF + 512;
static_assert(TILEE_OFF + 528 * 4 <= LDS_BYTES, "LDS map");

#define XB_TMO      128
#define XB_XCNT(j)  (256  + 64 * (j))
#define XB_XSUB(j)  (1280 + 64 * (j))
#define XB_XGEN(j)  (2304 + 64 * (j))
#define XB_TOP      3328
#define XB_TOPGEN   3392
#define XCD_BAR_WORDS 3456
#define XB_SPIN_CAP (1u << 18)

__device__ __forceinline__ unsigned xb_ld(unsigned* p)              { return __hip_atomic_load(p, __ATOMIC_RELAXED, __HIP_MEMORY_SCOPE_AGENT); }
__device__ __forceinline__ unsigned xb_add(unsigned* p, unsigned v) { return __hip_atomic_fetch_add(p, v, __ATOMIC_RELAXED, __HIP_MEMORY_SCOPE_AGENT); }
__device__ __forceinline__ unsigned xb_xcc_id() { return (unsigned)__builtin_amdgcn_s_getreg((3 << 11) | 20) & 0xFu; }
#define XB_SPIN(cond, bar) do { unsigned _sp = 0; while (cond) { __builtin_amdgcn_s_sleep(1); \
    if ((++_sp & 255u) == 0u) { if (xb_ld(&(bar)[XB_TMO])) break; if (_sp > XB_SPIN_CAP) { atomicAdd(&(bar)[XB_TMO], 1u); break; } } } } while (0)

struct XcdBarrier {
    unsigned* bar; unsigned x;
    volatile LAS unsigned* st;
    int wv;
};

__device__ __forceinline__ XcdBarrier xcd_barrier_post(unsigned* bar, volatile LAS unsigned* st) {
    XcdBarrier b; b.bar = bar; b.x = xb_xcc_id(); b.st = st; b.wv = 0;
    if (threadIdx.x == 0) (void)xb_add(&bar[XB_XCNT(b.x)], 1u);
    return b;
}
__device__ __forceinline__ void xcd_barrier_complete(unsigned* bar, unsigned x, unsigned& nloc, unsigned& nx) {
    const unsigned G = gridDim.x * gridDim.y * gridDim.z;
    unsigned sum, cnt, mine, sp = 0u;
    for (;;) {
        sum = 0u; cnt = 0u; mine = 0u;
#pragma unroll
        for (unsigned j = 0; j < 16; ++j) { const unsigned c = xb_ld(&bar[XB_XCNT(j)]); sum += c; cnt += (c > 0u) ? 1u : 0u; mine = (j == x) ? c : mine; }
        if (sum == G) break;
        __builtin_amdgcn_s_sleep(1);
        if ((++sp & 255u) == 0u) { if (xb_ld(&bar[XB_TMO])) break; if (sp > XB_SPIN_CAP) { atomicAdd(&bar[XB_TMO], 1u); break; } }
    }
    nloc = mine > 0u ? mine : 1u; nx = cnt > 0u ? cnt : 1u;
}

__device__ __forceinline__ void xcd_barrier(const XcdBarrier& b) {
    asm volatile("s_waitcnt vmcnt(0)" ::: "memory");
    __syncthreads();
    if (b.wv == 0 && pg8::lane_id() == 0) {
        unsigned* bar = b.bar;
        __builtin_amdgcn_s_waitcnt(0);
        unsigned nloc = b.st[0], nx = b.st[1];
        if (nloc == 0u) { xcd_barrier_complete(bar, b.x, nloc, nx); b.st[0] = nloc; b.st[1] = nx; }
        const unsigned old = xb_add(&bar[XB_XSUB(b.x)], 1u);
        const unsigned gen = old / nloc;
        if (old + 1u == (gen + 1u) * nloc) {
            __builtin_amdgcn_fence(__ATOMIC_RELEASE, "agent");
            asm volatile("s_waitcnt vmcnt(0)" ::: "memory");
            const unsigned og = xb_add(&bar[XB_TOP], 1u);
            const unsigned tg = og / nx;
            if (og + 1u == (tg + 1u) * nx) xb_add(&bar[XB_TOPGEN], 1u);
            else XB_SPIN(xb_ld(&bar[XB_TOPGEN]) == tg, bar);
            __builtin_amdgcn_fence(__ATOMIC_ACQUIRE, "agent");
            xb_add(&bar[XB_XGEN(b.x)], 1u);
            asm volatile("s_waitcnt vmcnt(0)" ::: "memory");
        } else {
            XB_SPIN(xb_ld(&bar[XB_XGEN(b.x)]) == gen, bar);
            __builtin_amdgcn_fence(__ATOMIC_ACQUIRE, "agent");
            asm volatile("s_waitcnt vmcnt(0)" ::: "memory");
        }
    }
    __syncthreads();
}
__device__ __forceinline__ float shx(float v, int m, int lane) { return __builtin_bit_cast(float, __builtin_amdgcn_ds_bpermute((lane ^ m) << 2, __builtin_bit_cast(int, v))); }
__device__ __forceinline__ int shxi(int v, int m, int lane) { return __builtin_amdgcn_ds_bpermute((lane ^ m) << 2, v); }
__device__ __forceinline__ s16x4 vtr(unsigned lds_addr) { return __builtin_bit_cast(s16x4, __builtin_amdgcn_ds_read_tr16_b64_v4i16((LAS v4i16_t*)(size_t)lds_addr)); }
__device__ __forceinline__ bf16x8 cat8(s16x4 lo, s16x4 hi) { return __builtin_shufflevector(lo, hi, 0, 1, 2, 3, 4, 5, 6, 7); }
__device__ __forceinline__ void unpack8(const u32x4 w, float (&f)[8]) { f[0] = bflo(w.x); f[1] = bfhi(w.x); f[2] = bflo(w.y); f[3] = bfhi(w.y); f[4] = bflo(w.z); f[5] = bfhi(w.z); f[6] = bflo(w.w); f[7] = bfhi(w.w); }
__device__ __forceinline__ void unpack8f8(const u32x2 w, float (&f)[8]) { const auto a0 = __builtin_amdgcn_cvt_pk_f32_fp8((int)w.x, false), a1 = __builtin_amdgcn_cvt_pk_f32_fp8((int)w.x, true), a2 = __builtin_amdgcn_cvt_pk_f32_fp8((int)w.y, false), a3 = __builtin_amdgcn_cvt_pk_f32_fp8((int)w.y, true);
    f[0] = a0[0]; f[1] = a0[1]; f[2] = a1[0]; f[3] = a1[1]; f[4] = a2[0]; f[5] = a2[1]; f[6] = a3[0]; f[7] = a3[1]; }
__device__ __forceinline__ u32x4 pack8(const float (&f)[8]) { u32x4 w; w.x = pk2(f[0], f[1]); w.y = pk2(f[2], f[3]); w.z = pk2(f[4], f[5]); w.w = pk2(f[6], f[7]); return w; }

struct Args {
    const float* in[22]; float* out; unsigned char* ws;
};

__device__ __forceinline__ void transpose_item(const float* p0, const float* p1, int ld, int mode, float scale, int K, int nblk, bf16_t* dst, int row0, LAS float* scr, int item, int lane, const float* kscale = nullptr) {
    const int kb = item / nblk, nb = item % nblk, k0 = 64 * kb, n0 = 32 * nb;
    const int np = n0 + (lane & 31);
    const float* sp; int col;
    if (mode == 0) { sp = p0; col = np; } else { sp = (np & 4) ? p1 : p0; col = (np >> 3) * 4 + (np & 3); }
    sp += (size_t)k0 * ld + col;
#pragma unroll 8
    for (int i = 0; i < 32; ++i) { const int kk = 2 * i + (lane >> 5); scr[kk * 33 + (lane & 31)] = sp[(size_t)kk * ld] * scale * (kscale ? kscale[k0 + kk] : 1.0f); }
    LDS_WAIT(); asm volatile("" ::: "memory");
    const int c = lane & 7;
#pragma unroll
    for (int j = 0; j < 4; ++j) { const int n = (lane >> 3) + 8 * j; const LAS float* s = scr + (8 * c) * 33 + n;
        u32x4 o; o.x = pk2(s[0 * 33], s[1 * 33]); o.y = pk2(s[2 * 33], s[3 * 33]); o.z = pk2(s[4 * 33], s[5 * 33]); o.w = pk2(s[6 * 33], s[7 * 33]);
        const int ng = row0 + n0 + n, kk = k0 + 8 * c;
        *(u32x4*)(dst + ((size_t)(ng >> 4) * (K >> 5) + (kk >> 5)) * 512 + (ng & 15) * 32 + (kk & 31)) = o; }
    LDS_WAIT(); asm volatile("" ::: "memory");
}
__device__ __forceinline__ void transpose_item8(const float* p0, const float* p1, int ld, int mode, float scale, int K, int nblk, unsigned char* dst, int row0, LAS float* scr, int item, int lane) {
    const int kb = item / nblk, nb = item % nblk, k0 = 64 * kb, n0 = 32 * nb;
    const int np = n0 + (lane & 31);
    const float* sp; int col;
    if (mode == 0) { sp = p0; col = np; } else { sp = ((np >> 7) & 1) ? p1 : p0; col = (np >> 8) * 128 + (np & 127); }
    sp += (size_t)k0 * ld + col;
#pragma unroll 8
    for (int i = 0; i < 32; ++i) { const int kk = 2 * i + (lane >> 5); scr[kk * 33 + (lane & 31)] = sp[(size_t)kk * ld] * scale; }
    LDS_WAIT(); asm volatile("" ::: "memory");
    const int c = lane & 7;
#pragma unroll
    for (int j = 0; j < 4; ++j) { const int n = (lane >> 3) + 8 * j; const LAS float* s = scr + (8 * c) * 33 + n;
        u32x2 o; o.x = pg8::pk4f8(s[0 * 33], s[1 * 33], s[2 * 33], s[3 * 33]); o.y = pg8::pk4f8(s[4 * 33], s[5 * 33], s[6 * 33], s[7 * 33]);
        const int ng = row0 + n0 + n;
        *(u32x2*)(dst + ((size_t)(ng >> 4) * (K >> 6) + (k0 >> 6)) * 1024 + (ng & 15) * 64 + 8 * c) = o; }
    LDS_WAIT(); asm volatile("" ::: "memory");
}
__device__ __forceinline__ void p0_convert(const Args& a, LAS unsigned char* lds, int bid, int G, int wave_s) {
    int tid_ = wave_s * 64 + pg8::lane_id(); asm volatile("" : "+v"(tid_)); const int tid = tid_, lane = tid & 63, wave = __builtin_amdgcn_readfirstlane(tid >> 6);
    unsigned char* ws = a.ws;
    LAS float* scr = (LAS float*)(lds + wave * 16384);
    const int gw = bid * NWAVES + wave, NGW = G * NWAVES;
    constexpr int I_INQ = 16 * 8, I_INB = 16 * 40, I_INC = 16 * 32, I_SQ = 16 * 32, I_GU = 16 * 16 * 32, I_DN = 16 * 8 * 32;
    constexpr int I_LAYER = I_INQ + I_INB + I_INC + 5 * I_SQ + I_GU + I_DN;
    for (int it = gw; it < 2 * I_LAYER; it += NGW) {
        const int l = it / I_LAYER; int r = it % I_LAYER;
        unsigned char* wl = ws + WS_W + (size_t)l * W_LAYER;
        const float* w_in = a.in[2] + (size_t)l * D * DIN;
        if (r < I_INQ) { transpose_item8(w_in, nullptr, DIN, 0, 0.125f * pg8::F8_SW, D, 8, wl + W_IN, 0, scr, r, lane); continue; } r -= I_INQ;
        if (r < I_INB) { transpose_item8(w_in + 256, nullptr, DIN, 0, pg8::F8_SW, D, 40, wl + W_IN, 256, scr, r, lane); continue; } r -= I_INB;
        if (r < I_INC) { transpose_item8(w_in + 1552, nullptr, DIN, 0, pg8::F8_SW, D, 32, wl + W_IN, 1792, scr, r, lane); continue; } r -= I_INC;
        if (r < I_SQ) { transpose_item(a.in[10] + (size_t)l * D * D, nullptr, D, 0, 1.0f, D, 32, (bf16_t*)(wl + W_OUT), 0, scr, r, lane); continue; } r -= I_SQ;
        if (r < I_SQ) { transpose_item(a.in[11] + (size_t)l * D * D, nullptr, D, 0, 0.0625f, D, 32, (bf16_t*)(wl + W_Q), 0, scr, r, lane, a.in[20] + (size_t)(l * 3 + 0) * D); continue; } r -= I_SQ;
        if (r < I_SQ) { transpose_item8(a.in[14] + (size_t)l * D * D, nullptr, D, 0, pg8::F8_SW, D, 32, wl + W_O, 0, scr, r, lane); continue; } r -= I_SQ;
        if (r < I_SQ) { transpose_item(a.in[12] + (size_t)l * D * D, nullptr, D, 0, 1.0f, D, 32, (bf16_t*)(ws + WS_WKV), l * 2048, scr, r, lane); continue; } r -= I_SQ;
        if (r < I_SQ) { transpose_item(a.in[13] + (size_t)l * D * D, nullptr, D, 0, 1.0f, D, 32, (bf16_t*)(ws + WS_WKV), l * 2048 + 1024, scr, r, lane); continue; } r -= I_SQ;
        if (r < I_GU) { const int e = r / 512, rr = r % 512; const size_t eo = ((size_t)l * 16 + e) * D * 512;
            transpose_item8(a.in[17] + eo, a.in[18] + eo, 512, 2, pg8::F8_SW, D, 32, wl + W_GU, e * 1024, scr, rr, lane); continue; } r -= I_GU;
        { const int e = r / 256, rr = r % 256; const size_t eo = ((size_t)l * 16 + e) * 512 * D;
            transpose_item8(a.in[19] + eo, nullptr, D, 0, pg8::F8_SW, 512, 32, wl + W_D, e * 1024, scr, rr, lane); }
    }
    const size_t gt = (size_t)bid * NTHR + tid, NT = (size_t)G * NTHR;
    for (int it = gw; it < 2 * 16 * 16; it += NGW) { const int l = it >> 8, kc = (it >> 4) & 15, n = (it & 15) * 64 + lane;
        const float* wq = a.in[11] + (size_t)l * D * D; const float* gg = a.in[20] + (size_t)(l * 3) * D; const float* bb = a.in[21] + (size_t)(l * 3) * D; float cs = 0.f, bq = 0.f;
#pragma unroll 8
        for (int k = 64 * kc; k < 64 * kc + 64; ++k) { const float w = wq[(size_t)k * D + n] * 0.0625f; cs += bflo(pk2(w * gg[k], 0.f) & 0xffffu); bq += w * bb[k]; }
        float* tb = (float*)(ws + WS_CS) + (size_t)l * 2 * 16 * 1024; tb[kc * 1024 + n] = cs; tb[16 * 1024 + kc * 1024 + n] = bq; }
    for (size_t i = gt; i < (size_t)2 * 256 * 128; i += NT) {
        const int l = (int)(i / (256 * 128)), r = (int)(i % (256 * 128)), j = r / 128, k8 = r % 128;
        const float* w_in = a.in[2] + (size_t)l * D * DIN; const float* w_a2 = a.in[3] + (size_t)l * 16 * 256;
        float wa[16];
#pragma unroll
        for (int q = 0; q < 16; ++q) wa[q] = w_a2[q * 256 + j];
        float o[8];
#pragma unroll
        for (int kk = 0; kk < 8; ++kk) { const float* wr = w_in + (size_t)(8 * k8 + kk) * DIN + 1536; float s = 0.f;
#pragma unroll
            for (int q = 0; q < 16; q += 4) { const f32x4 v = *(const f32x4*)(wr + q); s += v[0] * wa[q] + v[1] * wa[q + 1] + v[2] * wa[q + 2] + v[3] * wa[q + 3]; }
            o[kk] = s; }
        { const int ng = 1536 + j, kk = 8 * k8; u32x2 o8; o8.x = pg8::pk4f8(o[0] * pg8::F8_SW, o[1] * pg8::F8_SW, o[2] * pg8::F8_SW, o[3] * pg8::F8_SW); o8.y = pg8::pk4f8(o[4] * pg8::F8_SW, o[5] * pg8::F8_SW, o[6] * pg8::F8_SW, o[7] * pg8::F8_SW);
          *(u32x2*)(ws + WS_W + (size_t)l * W_LAYER + W_IN + ((size_t)(ng >> 4) * (D >> 6) + (kk >> 6)) * 1024 + (ng & 15) * 64 + (kk & 63)) = o8; }
    }
    for (size_t i = gt; i < (size_t)2 * 4 * 128 * 16; i += NT) {
        const int s8 = (int)(i & 15), t = (int)((i >> 4) & 127);
        const float* src = a.in[6] + i * 8; float o[8];
#pragma unroll
        for (int q = 0; q < 8; ++q) o[q] = ((8 * s8 + q) / 64 <= t / 64) ? src[q] : 0.f;
        *(u32x4*)((bf16_t*)(ws + WS_WM) + i * 8) = pack8(o);
    }
    for (size_t i = gt; i < (size_t)M * D / 8; i += NT) {
        const f32x4 v0 = *(const f32x4*)(a.in[0] + i * 8), v1 = *(const f32x4*)(a.in[0] + i * 8 + 4);
        u32x4 w; w.x = pk2(v0[0], v0[1]); w.y = pk2(v0[2], v0[3]); w.z = pk2(v1[0], v1[1]); w.w = pk2(v1[2], v1[3]);
        *(u32x4*)((bf16_t*)(ws + WS_X) + i * 8) = w;
        u32x2 q8; q8.x = pg8::pk4f8(v0[0] * pg8::F8_SX, v0[1] * pg8::F8_SX, v0[2] * pg8::F8_SX, v0[3] * pg8::F8_SX); q8.y = pg8::pk4f8(v1[0] * pg8::F8_SX, v1[1] * pg8::F8_SX, v1[2] * pg8::F8_SX, v1[3] * pg8::F8_SX);
        *(u32x2*)(ws + WS_X8IN + i * 8) = q8;
    }
    for (size_t i = gt; i < (size_t)MKV * D / 8; i += NT) {
        const f32x4 v0 = *(const f32x4*)(a.in[1] + i * 8), v1 = *(const f32x4*)(a.in[1] + i * 8 + 4);
        u32x4 w; w.x = pk2(v0[0], v0[1]); w.y = pk2(v0[2], v0[3]); w.z = pk2(v1[0], v1[1]); w.w = pk2(v1[2], v1[3]);
        *(u32x4*)((bf16_t*)(ws + WS_MEMB) + i * 8) = w;
    }
}

constexpr int GL_KD = 0, GL_QS = 9216, GL_VS = 18432, GL_PSUM = 35840, GL_DL = 37888, GL_SSQ = 38144;
template <bool FINAL>
__device__ __forceinline__ void gla_phase(LAS unsigned char* lds, const bf16_t* P, float* Send, float* Ltot, bf16_t* Y, const float* gn_g, int bid, int G, int wave_s) {
    int tid_ = wave_s * 64 + pg8::lane_id(); asm volatile("" : "+v"(tid_)); const int tid = tid_, lane = tid & 63, wave = __builtin_amdgcn_readfirstlane(tid >> 6);
    const unsigned lb = (unsigned)(size_t)lds;
    const int g = lane >> 4, l15 = lane & 15, q4 = l15 >> 2, p4 = lane & 3;
    const int kq = tid & 63, part = wave;
    for (int item = bid; item < 256; item += G) {
        const int b = item >> 5, h = (item >> 3) & 3, run = item & 7, bh = item >> 3;
        f32x4 sacc[4];
#pragma unroll
        for (int kt = 0; kt < 4; ++kt) sacc[kt] = (f32x4){0.f, 0.f, 0.f, 0.f};
        if (FINAL) {
            for (int i = 0; i < run; ++i) {
                const float* se = Send + ((size_t)(bh * 8 + i) * 64) * 128; const float* lt = Ltot + (size_t)(bh * 8 + i) * 64;
#pragma unroll
                for (int kt = 0; kt < 4; ++kt)
#pragma unroll
                    for (int r = 0; r < 4; ++r) { const int k = 16 * kt + 4 * g + r; sacc[kt][r] = __expf(lt[k]) * sacc[kt][r] + se[(size_t)k * 128 + 16 * wave + l15]; }
            }
        }
        float ltot_acc = 0.f;
        unsigned short graw[8], kraw[8]; u32x4 vraw[2], qraw; u32x2 rraw[4];
        const int v_row = tid >> 4, v_c16 = tid & 15, q_row = tid >> 3, q_c16 = tid & 7;
        const int ycol = h * 128 + 16 * wave + 4 * g;
#define GLA_FETCH(CC) do { const size_t tf_ = (size_t)b * SEQ + (size_t)(run * 16 + (CC)) * 64; \
            _Pragma("unroll") for (int i = 0; i < 8; ++i) { const bf16_t* rp = P + (tf_ + 8 * part + i) * NP + h * 64 + kq; graw[i] = rp[PG]; kraw[i] = rp[PK]; } \
            _Pragma("unroll") for (int i = 0; i < 2; ++i) vraw[i] = *(const u32x4*)(P + (tf_ + v_row + 32 * i) * NP + PV + h * 128 + v_c16 * 8); \
            if (FINAL) { qraw = *(const u32x4*)(P + (tf_ + q_row) * NP + PQ + h * 64 + q_c16 * 8); \
                _Pragma("unroll") for (int tt = 0; tt < 4; ++tt) rraw[tt] = *(const u32x2*)(P + (tf_ + 16 * tt + l15) * NP + PR + ycol); } } while (0)
        GLA_FETCH(0);
        for (int c = 0; c < 16; ++c) {
            const size_t t0 = (size_t)b * SEQ + (size_t)(run * 16 + c) * 64;
            __syncthreads();
            float gv[8], kv[8];
#pragma unroll
            for (int i = 0; i < 8; ++i) { gv[i] = __builtin_bit_cast(float, (unsigned)graw[i] << 16); kv[i] = __builtin_bit_cast(float, (unsigned)kraw[i] << 16); }
#pragma unroll
            for (int i = 1; i < 8; ++i) gv[i] += gv[i - 1];
            ((LAS float*)(lds + GL_PSUM))[part * 64 + kq] = gv[7];
#pragma unroll
            for (int i = 0; i < 2; ++i) *(LAS u32x4*)(lds + GL_VS + (v_row + 32 * i) * 272 + v_c16 * 16) = vraw[i];
            u32x2 rcur[4];
            if (FINAL) { *(LAS u32x4*)(lds + GL_QS + q_row * 144 + q_c16 * 16) = qraw;
#pragma unroll
                for (int tt = 0; tt < 4; ++tt) rcur[tt] = rraw[tt]; }
            if (c + 1 < 16) GLA_FETCH(c + 1);
            __syncthreads();
            float offs = 0.f, bl = 0.f;
#pragma unroll
            for (int p = 0; p < 8; ++p) { const float v = ((LAS float*)(lds + GL_PSUM))[p * 64 + kq]; offs += (p < part) ? v : 0.f; bl += v; }
#pragma unroll
            for (int i = 0; i < 8; ++i) { const float kd = kv[i] * __expf(bl - (offs + gv[i]));
                *(LAS unsigned short*)(lds + GL_KD + (8 * part + i) * 144 + kq * 2) = (unsigned short)(pk2(kd, 0.f) & 0xffffu); }
            if (part == 0) ((LAS float*)(lds + GL_DL))[kq] = __expf(bl);
            ltot_acc += bl;
            __syncthreads();
#pragma unroll
            for (int kt = 0; kt < 4; ++kt) { const f32x4 dl = *(LAS f32x4*)(lds + GL_DL + (16 * kt + 4 * g) * 4); sacc[kt] = sacc[kt] * dl; }
#pragma unroll
            for (int ks = 0; ks < 2; ++ks) {
                const unsigned vrow = lb + GL_VS + (unsigned)(32 * ks + 8 * g + q4) * 272u + (unsigned)(16 * wave + 4 * p4) * 2u;
                const bf16x8 vb = cat8(vtr(vrow), vtr(vrow + 4u * 272u));
#pragma unroll
                for (int kt = 0; kt < 4; ++kt) {
                    const unsigned krow = lb + GL_KD + (unsigned)(32 * ks + 8 * g + q4) * 144u + (unsigned)(16 * kt + 4 * p4) * 2u;
                    const bf16x8 ka = cat8(vtr(krow), vtr(krow + 4u * 144u));
                    sacc[kt] = __builtin_amdgcn_mfma_f32_16x16x32_bf16(ka, vb, sacc[kt], 0, 0, 0);
                }
            }
            if (FINAL) {
                f32x4 oacc[4];
#pragma unroll
                for (int tt = 0; tt < 4; ++tt) oacc[tt] = (f32x4){0.f, 0.f, 0.f, 0.f};
#pragma unroll
                for (int ks2 = 0; ks2 < 2; ++ks2) {
                    u32x4 spw; spw.x = pk2(sacc[2 * ks2][0], sacc[2 * ks2][1]); spw.y = pk2(sacc[2 * ks2][2], sacc[2 * ks2][3]);
                    spw.z = pk2(sacc[2 * ks2 + 1][0], sacc[2 * ks2 + 1][1]); spw.w = pk2(sacc[2 * ks2 + 1][2], sacc[2 * ks2 + 1][3]);
                    const bf16x8 sp = __builtin_bit_cast(bf16x8, spw);
#pragma unroll
                    for (int tt = 0; tt < 4; ++tt) {
                        const LAS unsigned char* qp = lds + GL_QS + (16 * tt + l15) * 144 + (32 * ks2 + 4 * g) * 2;
                        const u32x2 qlo = *(const LAS u32x2*)qp, qhi = *(const LAS u32x2*)(qp + 32);
                        u32x4 qw; qw.x = qlo.x; qw.y = qlo.y; qw.z = qhi.x; qw.w = qhi.y;
                        oacc[tt] = __builtin_amdgcn_mfma_f32_16x16x32_bf16(sp, __builtin_bit_cast(bf16x8, qw), oacc[tt], 0, 0, 0);
                    }
                }
#pragma unroll
                for (int tt = 0; tt < 4; ++tt) { float s = oacc[tt][0] * oacc[tt][0] + oacc[tt][1] * oacc[tt][1] + oacc[tt][2] * oacc[tt][2] + oacc[tt][3] * oacc[tt][3];
                    s += shx(s, 16, lane); s += shx(s, 32, lane);
                    if (g == 0) ((LAS float*)(lds + GL_SSQ))[wave * 64 + 16 * tt + l15] = s; }
                __syncthreads();
                const int col = h * 128 + 16 * wave + 4 * g;
                const f32x4 gn = *(const f32x4*)(gn_g + col);
#pragma unroll
                for (int tt = 0; tt < 4; ++tt) { float tot = 0.f;
#pragma unroll
                    for (int w2 = 0; w2 < 8; ++w2) tot += ((LAS float*)(lds + GL_SSQ))[w2 * 64 + 16 * tt + l15];
                    const float rs = __builtin_amdgcn_rsqf(tot * (1.0f / 128.0f) + 1e-6f);
                    const size_t tok = t0 + 16 * tt + l15;
                    const u32x2 rr = rcur[tt];
                    u32x2 w; w.x = pk2(oacc[tt][0] * rs * gn[0] * bflo(rr.x), oacc[tt][1] * rs * gn[1] * bfhi(rr.x));
                    w.y = pk2(oacc[tt][2] * rs * gn[2] * bflo(rr.y), oacc[tt][3] * rs * gn[3] * bfhi(rr.y));
                    *(u32x2*)(Y + tok * D + col) = w; }
            }
        }
        if (!FINAL) {
            float* se = Send + ((size_t)(bh * 8 + run) * 64) * 128;
#pragma unroll
            for (int kt = 0; kt < 4; ++kt)
#pragma unroll
                for (int r = 0; r < 4; ++r) se[(size_t)(16 * kt + 4 * g + r) * 128 + 16 * wave + l15] = sacc[kt][r];
            if (part == 0) Ltot[(size_t)(bh * 8 + run) * 64 + kq] = ltot_acc;
        }
    }
}

#undef GLA_FETCH
constexpr int SG_VN = 0;
__device__ __forceinline__ void sgu_phase(LAS unsigned char* lds, const bf16_t* P, const bf16_t* Wm, const float* b_s, const float* lg, const float* lb_, bf16_t* Y, int bid, int G, int wave_s) {
    int tid_ = wave_s * 64 + pg8::lane_id(); asm volatile("" : "+v"(tid_)); const int tid = tid_, lane = tid & 63, wave = __builtin_amdgcn_readfirstlane(tid >> 6);
    const unsigned lb = (unsigned)(size_t)lds;
    const int g = lane >> 4, l15 = lane & 15, q4 = l15 >> 2, p4 = lane & 3;
    const int row = tid >> 2, qu = tid & 3;
    u32x4 vraw[4]; u32x2 uraw[8];
#define SGU_FETCH(IT) do { const int blk_ = (IT) >> 2, gr_ = (IT) & 3; const size_t tf_ = (size_t)blk_ * 128; \
        const bf16_t* src_ = P + (tf_ + row) * NP + PVS + gr_ * 128 + 32 * qu; \
        _Pragma("unroll") for (int i = 0; i < 4; ++i) vraw[i] = *(const u32x4*)(src_ + 8 * i); \
        const bf16_t* us_ = P + (tf_ + 16 * wave + l15) * NP + PU + gr_ * 128 + 4 * g; \
        _Pragma("unroll") for (int ct = 0; ct < 8; ++ct) uraw[ct] = *(const u32x2*)(us_ + 16 * ct); } while (0)
    if (bid < 2048) SGU_FETCH(bid);
    for (int item = bid; item < 2048; item += G) {
        const int blk = item >> 2, gr = item & 3; const size_t t0 = (size_t)blk * 128;
        __syncthreads();
        u32x2 ucur[8];
        { float v[32];
#pragma unroll
          for (int i = 0; i < 4; ++i) { float f[8]; unpack8(vraw[i], f);
#pragma unroll
              for (int j = 0; j < 8; ++j) v[8 * i + j] = f[j]; }
#pragma unroll
          for (int ct = 0; ct < 8; ++ct) ucur[ct] = uraw[ct];
          if (item + G < 2048) SGU_FETCH(item + G);
          float s = 0.f;
#pragma unroll
          for (int i = 0; i < 32; ++i) s += v[i];
          s += shx(s, 1, lane); s += shx(s, 2, lane);
          const float mu = s * (1.0f / 128.0f); float qq = 0.f;
#pragma unroll
          for (int i = 0; i < 32; ++i) { v[i] -= mu; qq += v[i] * v[i]; }
          qq += shx(qq, 1, lane); qq += shx(qq, 2, lane);
          const float rs = __builtin_amdgcn_rsqf(qq * (1.0f / 128.0f) + LN_EPS);
          const float* gp = lg + gr * 128 + 32 * qu; const float* bp = lb_ + gr * 128 + 32 * qu;
#pragma unroll
          for (int i = 0; i < 4; ++i) { float f[8];
#pragma unroll
              for (int j = 0; j < 8; ++j) f[j] = v[8 * i + j] * rs * gp[8 * i + j] + bp[8 * i + j];
              *(LAS u32x4*)(lds + SG_VN + row * 272 + (32 * qu + 8 * i) * 2) = pack8(f); }
        }
        __syncthreads();
        const int nks = (wave < 4) ? 2 : 4;
        bf16x8 wf[4];
#pragma unroll
        for (int ks = 0; ks < 4; ++ks) wf[ks] = *(const bf16x8*)(Wm + ((size_t)(gr * 128 + 16 * wave + l15)) * 128 + 32 * ks + 8 * g);
        const size_t tok = t0 + 16 * wave + l15; const float bs = b_s[gr * 128 + 16 * wave + l15];
        unsigned vb0 = lb + SG_VN + (unsigned)(8 * g + q4) * 272u + (unsigned)(4 * p4) * 2u; asm volatile("" : "+v"(vb0));
#pragma unroll
        for (int ct = 0; ct < 8; ++ct) {
            f32x4 acc = (f32x4){0.f, 0.f, 0.f, 0.f};
#pragma unroll
            for (int ks = 0; ks < 4; ++ks) {
                if (ks < nks) {
                    const unsigned vrow = vb0 + (unsigned)(32 * ks * 272 + 32 * ct);
                    const bf16x8 va = cat8(vtr(vrow), vtr(vrow + 4u * 272u));
                    acc = __builtin_amdgcn_mfma_f32_16x16x32_bf16(va, wf[ks], acc, 0, 0, 0);
                }
            }
            const int col = gr * 128 + 16 * ct + 4 * g;
            const u32x2 uu = ucur[ct];
            u32x2 w; w.x = pk2(bflo(uu.x) * (acc[0] + bs), bfhi(uu.x) * (acc[1] + bs)); w.y = pk2(bflo(uu.y) * (acc[2] + bs), bfhi(uu.y) * (acc[3] + bs));
            *(u32x2*)(Y + tok * D + 512 + col) = w;
        }
    }
}
#undef SGU_FETCH

constexpr int AT_KPS = 1040, AT_VPS = 1088, AT_SLOT = 34816, AT_NSLOT = 3;
static_assert(AT_NSLOT * AT_SLOT <= LDSCTL_OFF, "attention LDS");
__device__ __forceinline__ void glds16(const void* gsrc, unsigned lds_dst) { unsigned keep;
    asm volatile("s_mov_b32 %0, m0\n\ts_mov_b32 m0, %2\n\ts_nop 0\n\tglobal_load_lds_dwordx4 %1, off\n\ts_mov_b32 m0, %0" : "=&s"(keep) : "v"(gsrc), "s"(lds_dst) : "memory"); }
__device__ __forceinline__ void attn_dma(unsigned lb, const char* kvb, int so, unsigned lane_off, int slot, int ps, int wave) {
#pragma unroll
    for (int j = 0; j < 4; ++j) { const int pi = 4 * wave + j, rlo = 32 * (pi >> 4) + (pi & 15);
        glds16(kvb + (size_t)(so + rlo * 8192) + lane_off, (unsigned)__builtin_amdgcn_readfirstlane((int)(lb + (unsigned)(slot * AT_SLOT + pi * ps)))); }
}
#define AT_WAITBAR(N) do { asm volatile("s_waitcnt vmcnt(" #N ") lgkmcnt(0)" ::: "memory"); __builtin_amdgcn_s_barrier(); asm volatile("" ::: "memory"); } while (0)
__device__ __forceinline__ void attn_phase(LAS unsigned char* lds, const bf16_t* Q, const bf16_t* KV, bf16_t* O, int layer, int bid, int G, int wave_s) {
    int tid_ = wave_s * 64 + pg8::lane_id(); asm volatile("" : "+v"(tid_)); const int tid = tid_, lane = tid & 63, wave = __builtin_amdgcn_readfirstlane(tid >> 6);
    const unsigned lb = (unsigned)(size_t)lds;
    const int r32 = lane & 31, hh = lane >> 5, q4 = (lane & 15) >> 2, p4 = lane & 3, blk = (lane >> 4) & 1;
    LAS unsigned char* kbase = lds + (r32 & 15) * AT_KPS + ((r32 >> 4) & 1) * 512 + hh * 16;
    unsigned vbase = lb + (unsigned)(4 * hh + q4) * (unsigned)AT_VPS + (unsigned)(16 * blk + 4 * p4) * 2u;
    unsigned lane_off = (unsigned)((lane >> 5) * 16 * 8192 + (lane & 31) * 16);
    asm volatile("" : "+v"(kbase), "+v"(vbase), "+v"(lane_off));
    const char* kvb = (const char*)KV;
    const int nun = (bid < 256) ? 4 * ((256 - bid + G - 1) / G) : 0;
#define AT_SRC(N, ST) ((int)((((size_t)(((bid + ((N) >> 2) * G) >> 5) * NMEM) * 4096 + layer * 2048 + ((N) & 3) * 256 + (((ST) >> 2) * 1024)) * 2) + ((ST) & 3) * 64 * 8192))
    __syncthreads();
    if (nun > 0) { attn_dma(lb, kvb, AT_SRC(0, 0), lane_off, 0, AT_KPS, wave); attn_dma(lb, kvb, AT_SRC(0, 1), lane_off, 1, AT_KPS, wave); AT_WAITBAR(4); }
    int sl = 0;
    for (int n = 0; n < nun; ++n) {
        const int pan = bid + (n >> 2) * G, h = n & 3, b = pan >> 5, qt = pan & 31;
        int ln_ = pg8::lane_id(); asm volatile("" : "+v"(ln_));
        const unsigned qoff = (unsigned)((wave * 8 * 64 + ln_) * 16);
        const char* qbase = (const char*)Q + (size_t)(pan * 4 + h) * 65536;
        char* obase = (char*)O + ((size_t)b * SEQ + qt * 256) * D + h * 256;
        const bool more = (n + 1 < nun);
        bf16x8 qf[16];
#pragma unroll
        for (int s = 0; s < 8; ++s) { const u32x4 raw = *(const GAS u32x4*)(qbase + qoff + 1024 * s); float f[8]; u32x2 h8;
            h8.x = raw.x; h8.y = raw.y; unpack8f8(h8, f);
#pragma unroll
            for (int i = 0; i < 8; ++i) f[i] *= (1.0f / pg8::F8_SQ);
            qf[s] = __builtin_bit_cast(bf16x8, pack8(f));
            h8.x = raw.z; h8.y = raw.w; unpack8f8(h8, f);
#pragma unroll
            for (int i = 0; i < 8; ++i) f[i] *= (1.0f / pg8::F8_SQ);
            qf[s + 8] = __builtin_bit_cast(bf16x8, pack8(f)); }
        float ml = 0.f, lsum = 0.f;
        bf16x8 pk[8][2];
#pragma unroll
        for (int st = 0; st < 4; ++st) {
            const int sl2 = (sl >= 1) ? sl - 1 : 2;
            if (st > 0) attn_dma(lb, kvb, AT_SRC(n, st + 2), lane_off, sl2, (st + 2 < 4) ? AT_KPS : AT_VPS, wave);
            LAS unsigned char* kb = kbase + sl * AT_SLOT;
            f32x16 sa[2];
#pragma unroll
            for (int kt = 0; kt < 2; ++kt)
#pragma unroll
                for (int r = 0; r < 16; ++r) sa[kt][r] = 0.f;
            bf16x8 kfa[2], kfb[2];
#define AT_KLD(dst, S0) do { _Pragma("unroll") for (int kt = 0; kt < 2; ++kt) dst[kt] = *(const LAS bf16x8*)(kb + kt * 16 * AT_KPS + 32 * (S0)); } while (0)
#define AT_KMM(src, S0) do { _Pragma("unroll") for (int kt = 0; kt < 2; ++kt) sa[kt] = __builtin_amdgcn_mfma_f32_32x32x16_bf16(src[kt], qf[(S0)], sa[kt], 0, 0, 0); } while (0)
            AT_KLD(kfa, 0); __builtin_amdgcn_sched_barrier(0);
#pragma unroll
            for (int bq = 0; bq < 8; ++bq) {
                AT_KLD(kfb, 2 * bq + 1); __builtin_amdgcn_sched_barrier(0);
                AT_KMM(kfa, 2 * bq); __builtin_amdgcn_sched_barrier(0);
                if (bq < 7) { AT_KLD(kfa, 2 * bq + 2); __builtin_amdgcn_sched_barrier(0); }
                AT_KMM(kfb, 2 * bq + 1); __builtin_amdgcn_sched_barrier(0);
            }
#undef AT_KLD
#undef AT_KMM
            if (st == 0) attn_dma(lb, kvb, AT_SRC(n, 2), lane_off, sl2, AT_KPS, wave);
            if (st == 0) { float mx = -3.0e38f;
#pragma unroll
                for (int kt = 0; kt < 2; ++kt)
#pragma unroll
                    for (int r = 0; r < 16; ++r) mx = __builtin_fmaxf(mx, sa[kt][r]);
                mx = __builtin_fmaxf(mx, shx(mx, 32, lane)); ml = mx * LOG2E; }
#pragma unroll
            for (int kt = 0; kt < 2; ++kt) {
                float p[16];
#pragma unroll
                for (int r = 0; r < 16; ++r) { p[r] = __builtin_amdgcn_exp2f(sa[kt][r] * LOG2E - ml); lsum += p[r]; }
#pragma unroll
                for (int s2 = 0; s2 < 2; ++s2) { u32x4 w; w.x = pk2(p[8 * s2 + 0], p[8 * s2 + 1]); w.y = pk2(p[8 * s2 + 2], p[8 * s2 + 3]); w.z = pk2(p[8 * s2 + 4], p[8 * s2 + 5]); w.w = pk2(p[8 * s2 + 6], p[8 * s2 + 7]);
                    pk[2 * st + kt][s2] = __builtin_bit_cast(bf16x8, w); }
            }
            AT_WAITBAR(4);
            sl = (sl == 2) ? 0 : sl + 1;
        }
        lsum += shx(lsum, 32, lane);
        f32x16 oacc[8];
#pragma unroll
        for (int dt = 0; dt < 8; ++dt)
#pragma unroll
            for (int r = 0; r < 16; ++r) oacc[dt][r] = 0.f;
#pragma unroll
        for (int st = 4; st < 8; ++st) {
            const bool issue = (st < 6) || more;
            if (issue) { const int s2 = (sl >= 1) ? sl - 1 : 2;
                if (st < 6) attn_dma(lb, kvb, AT_SRC(n, st + 2), lane_off, s2, AT_VPS, wave); else attn_dma(lb, kvb, AT_SRC(n + 1, st - 6), lane_off, s2, AT_KPS, wave); }
            const unsigned vb = vbase + (unsigned)(sl * AT_SLOT);
            bf16x8 vfa[2], vfb[2];
#define AT_VLD(dst, BT) do { const unsigned va_ = vb + (unsigned)((((BT) >> 3) & 1) * 16 * AT_VPS + (((BT) >> 2) & 1) * 512 + ((BT) & 3) * 128); \
                _Pragma("unroll") for (int d_ = 0; d_ < 2; ++d_) dst[d_] = cat8(vtr(va_ + 64u * d_), vtr(va_ + 64u * d_ + 8u * AT_VPS)); } while (0)
#define AT_VMM(src, BT) do { _Pragma("unroll") for (int d_ = 0; d_ < 2; ++d_) oacc[2 * ((BT) & 3) + d_] = __builtin_amdgcn_mfma_f32_32x32x16_bf16(src[d_], pk[2 * (st - 4) + (((BT) >> 3) & 1)][((BT) >> 2) & 1], oacc[2 * ((BT) & 3) + d_], 0, 0, 0); } while (0)
            AT_VLD(vfa, 0); __builtin_amdgcn_sched_barrier(0);
#pragma unroll
            for (int bq = 0; bq < 8; ++bq) {
                AT_VLD(vfb, 2 * bq + 1); __builtin_amdgcn_sched_barrier(0);
                AT_VMM(vfa, 2 * bq); __builtin_amdgcn_sched_barrier(0);
                if (bq < 7) { AT_VLD(vfa, 2 * bq + 2); __builtin_amdgcn_sched_barrier(0); }
                AT_VMM(vfb, 2 * bq + 1); __builtin_amdgcn_sched_barrier(0);
            }
#undef AT_VLD
#undef AT_VMM
            if (issue) AT_WAITBAR(4); else AT_WAITBAR(0);
            sl = (sl == 2) ? 0 : sl + 1;
        }
        const float inv = 1.0f / lsum;
        int ln2 = pg8::lane_id(); asm volatile("" : "+v"(ln2));
        GAS char* op = (GAS char*)obase + (unsigned)((wave * 32 + (ln2 & 31)) * D) + ((ln2 >> 5) ? 16 : 0);
        const float sc = inv * pg8::F8_SO;
#pragma unroll
        for (int dt = 0; dt < 8; ++dt) {
            unsigned dw[4];
#pragma unroll
            for (int g4 = 0; g4 < 4; ++g4) dw[g4] = pg8::pk4f8(oacc[dt][4 * g4 + 0] * sc, oacc[dt][4 * g4 + 1] * sc, oacc[dt][4 * g4 + 2] * sc, oacc[dt][4 * g4 + 3] * sc);
            { const auto r = __builtin_amdgcn_permlane32_swap(dw[0], dw[2], false, false); dw[0] = r[0]; dw[2] = r[1]; }
            { const auto r = __builtin_amdgcn_permlane32_swap(dw[1], dw[3], false, false); dw[1] = r[0]; dw[3] = r[1]; }
            u32x4 w; w.x = dw[0]; w.y = dw[2]; w.z = dw[1]; w.w = dw[3];
            *(GAS u32x4*)(op + 32 * dt) = w; }
    }
    asm volatile("s_waitcnt vmcnt(0)" ::: "memory");
    __syncthreads();
}
#undef AT_SRC
#undef AT_WAITBAR

constexpr int RT_WH = 0, RT_WL = 32768, RT_SEL = 65536, RT_RK = 66048, RT_CNTW = 67072, RT_WBASE = 67584, RT_CS = 68608, RT_BB = 68672, RT_PART = 68736;
template <int MODE>
__device__ __forceinline__ void ln_phase(LAS unsigned char* lds, const Args& a, int l, int lnidx, bool last, bf16_t* Xout, int bid, int G, int wave_s) {
    int tid_ = wave_s * 64 + pg8::lane_id(); asm volatile("" : "+v"(tid_)); const int tid = tid_, lane = tid & 63, wave = __builtin_amdgcn_readfirstlane(tid >> 6);
    constexpr int R = (MODE == 2) ? 2 : 4;
    unsigned char* ws = a.ws;
    const bf16_t* Z = (const bf16_t*)(ws + WS_R + R_Z); const unsigned char* Ys8 = ws + WS_R + R_XS;
    pg8::f32x2_t* stats1 = (pg8::f32x2_t*)(ws + WS_STATS);
    const float* gp = a.in[20] + (size_t)(l * 3 + lnidx) * D; const float* bp = a.in[21] + (size_t)(l * 3 + lnidx) * D;
    float gg[16], bb[16];
#pragma unroll
    for (int j = 0; j < 2; ++j)
#pragma unroll
        for (int i = 0; i < 8; ++i) { gg[8 * j + i] = gp[8 * lane + 512 * j + i]; bb[8 * j + i] = bp[8 * lane + 512 * j + i]; }
    float g1v[16], b1v[16];
    if (MODE == 2) { const float* gq = a.in[20] + (size_t)(l * 3 + 1) * D; const float* bq_ = a.in[21] + (size_t)(l * 3 + 1) * D;
#pragma unroll
        for (int j = 0; j < 2; ++j)
#pragma unroll
            for (int i = 0; i < 8; ++i) { g1v[8 * j + i] = gq[8 * lane + 512 * j + i]; b1v[8 * j + i] = bq_[8 * lane + 512 * j + i]; } }
    if (MODE == 1) {
        __syncthreads();
        for (int idx = tid; idx < 2048; idx += NTHR) { const int s = idx >> 6, ln = idx & 63, e = ln & 15, g = ln >> 4; float hi[8], lo[8];
#pragma unroll
            for (int j = 0; j < 8; ++j) { const float w = a.in[15][(32 * s + 8 * g + j) * 16 + e] * gp[32 * s + 8 * g + j]; const float h = bflo(pk2(w, 0.f) & 0xffffu); hi[j] = h; lo[j] = w - h; }
            *(LAS u32x4*)(lds + RT_WH + idx * 16) = pack8(hi); *(LAS u32x4*)(lds + RT_WL + idx * 16) = pack8(lo); }
        { const int e = tid & 15, kp = tid >> 4; float cs = 0.f, bs = 0.f;
          for (int k = 32 * kp; k < 32 * kp + 32; ++k) { const float wr = a.in[15][k * 16 + e]; const float w = wr * gp[k]; const float h = bflo(pk2(w, 0.f) & 0xffffu); const float lo2 = bflo(pk2(w - h, 0.f) & 0xffffu); cs += h + lo2; bs += bp[k] * wr; }
          ((LAS float*)(lds + RT_PART))[kp * 32 + e] = cs; ((LAS float*)(lds + RT_PART))[kp * 32 + 16 + e] = bs; }
        __syncthreads();
        if (tid < 32) { float t = 0.f; for (int kp = 0; kp < 32; ++kp) t += ((LAS float*)(lds + RT_PART))[kp * 32 + tid];
            if (tid < 16) ((LAS float*)(lds + RT_CS))[tid] = t; else ((LAS float*)(lds + RT_BB))[tid - 16] = t + a.in[16][tid - 16]; }
        __syncthreads();
    }
    for (int blk = bid; blk < 256; blk += G) {
        int run[16];
#pragma unroll
        for (int e = 0; e < 16; ++e) run[e] = 0;
        u32x4 pa_[R][2]; u32x2 pb_[R][2], pc_[R][2]; float pw0[R], pw1[R]; pg8::f32x2_t pst[R];
#define LN_LOAD(ROW0) do { _Pragma("unroll") for (int r = 0; r < R; ++r) { const size_t row = (ROW0) + r; \
            if (MODE == 2) { const int* ts = (const int*)(ws + WS_TSLOT) + row * 2; const float* ti = (const float*)(ws + WS_TINFO) + row * 4; const int s0 = ts[0], s1 = ts[1]; pw0[r] = ti[2]; pw1[r] = ti[3]; pst[r] = stats1[row]; \
                _Pragma("unroll") for (int j = 0; j < 2; ++j) { pa_[r][j] = *(const u32x4*)(Z + row * D + 8 * lane + 512 * j); pb_[r][j] = *(const u32x2*)(Ys8 + (size_t)s0 * D + 8 * lane + 512 * j); pc_[r][j] = *(const u32x2*)(Ys8 + (size_t)s1 * D + 8 * lane + 512 * j); } } \
            else { _Pragma("unroll") for (int j = 0; j < 2; ++j) pa_[r][j] = *(const u32x4*)(Z + row * D + 8 * lane + 512 * j); } } } while (0)
        float mu_t = 0.f, rs_t = 0.f;
        LN_LOAD((size_t)blk * 256 + wave * 32);
        for (int ri = 0; ri < 32; ri += R) {
            const int rl0 = wave * 32 + ri; const size_t row0 = (size_t)blk * 256 + rl0;
            float v[R][16];
#pragma unroll
            for (int r = 0; r < R; ++r)
#pragma unroll
                for (int j = 0; j < 2; ++j) { float x[8]; unpack8(pa_[r][j], x);
                    if (MODE == 2) { float y0[8], y1[8]; unpack8f8(pb_[r][j], y0); unpack8f8(pc_[r][j], y1); const float mu1 = pst[r][0], rs1 = pst[r][1];
#pragma unroll
                        for (int i = 0; i < 8; ++i) v[r][8 * j + i] = ALPHA * ((x[i] - mu1) * rs1 * g1v[8 * j + i] + b1v[8 * j + i]) + (pw0[r] * (1.0f / pg8::F8_SY)) * y0[i] + (pw1[r] * (1.0f / pg8::F8_SY)) * y1[i]; }
                    else {
#pragma unroll
                        for (int i = 0; i < 8; ++i) v[r][8 * j + i] = x[i]; } }
            if (ri + R < 32) LN_LOAD(row0 + R);
            float s[R];
#pragma unroll
            for (int r = 0; r < R; ++r) { s[r] = 0.f;
#pragma unroll
                for (int i = 0; i < 16; ++i) s[r] += v[r][i]; }
#pragma unroll
            for (int o = 1; o < 64; o <<= 1)
#pragma unroll
                for (int r = 0; r < R; ++r) s[r] += shx(s[r], o, lane);
            float qq[R], mur[R];
#pragma unroll
            for (int r = 0; r < R; ++r) { const float mu = s[r] * (1.0f / D); mur[r] = mu; qq[r] = 0.f;
#pragma unroll
                for (int i = 0; i < 16; ++i) { v[r][i] -= mu; qq[r] += v[r][i] * v[r][i]; } }
#pragma unroll
            for (int o = 1; o < 64; o <<= 1)
#pragma unroll
                for (int r = 0; r < R; ++r) qq[r] += shx(qq[r], o, lane);
#pragma unroll
            for (int r = 0; r < R; ++r) { const float rs = __builtin_amdgcn_rsqf(qq[r] * (1.0f / D) + LN_EPS);
                if (MODE == 1) { if (lane == 0) stats1[row0 + r] = (pg8::f32x2_t){mur[r], rs};
                    if ((lane & 15) == ((ri + r) & 15)) { mu_t = mur[r]; rs_t = rs; } }
#pragma unroll
                for (int i = 0; i < 16; ++i) v[r][i] = v[r][i] * rs * gg[i] + bb[i]; }
#pragma unroll
            for (int r = 0; r < R; ++r) { const size_t row = row0 + r;
                if (MODE == 2 && last) {
#pragma unroll
                    for (int j = 0; j < 2; ++j) { float* op = a.out + row * D + 8 * lane + 512 * j;
                        *(f32x4*)op = (f32x4){v[r][8 * j], v[r][8 * j + 1], v[r][8 * j + 2], v[r][8 * j + 3]}; *(f32x4*)(op + 4) = (f32x4){v[r][8 * j + 4], v[r][8 * j + 5], v[r][8 * j + 6], v[r][8 * j + 7]}; }
                } else {
#pragma unroll
                    for (int j = 0; j < 2; ++j) { float f[8];
#pragma unroll
                        for (int i = 0; i < 8; ++i) f[i] = v[r][8 * j + i];
                        if (MODE != 1) *(u32x4*)(Xout + row * D + 8 * lane + 512 * j) = pack8(f);
                        if (MODE == 1 || MODE == 2) { u32x2 q8; q8.x = pg8::pk4f8(f[0] * pg8::F8_SX, f[1] * pg8::F8_SX, f[2] * pg8::F8_SX, f[3] * pg8::F8_SX); q8.y = pg8::pk4f8(f[4] * pg8::F8_SX, f[5] * pg8::F8_SX, f[6] * pg8::F8_SX, f[7] * pg8::F8_SX);
                            *(u32x2*)(ws + (MODE == 1 ? WS_R + R_X8 : WS_X8IN) + row * D + 8 * lane + 512 * j) = q8; } }
                } }
            if (MODE == 1 && ((ri + R) & 15) == 0) {
                const int tok = lane & 15, g = lane >> 4, tl = rl0 + R - 16 + tok; const size_t token = (size_t)blk * 256 + tl;
                const bf16_t* xr = Z + token * D + 8 * g;
                f32x4 acc = (f32x4){0.f, 0.f, 0.f, 0.f};
#pragma unroll 8
                for (int ks = 0; ks < 32; ++ks) { const bf16x8 xb = *(const bf16x8*)(xr + 32 * ks);
                    const bf16x8 wh = *(const LAS bf16x8*)(lds + RT_WH + (ks * 64 + lane) * 16), wl = *(const LAS bf16x8*)(lds + RT_WL + (ks * 64 + lane) * 16);
                    acc = __builtin_amdgcn_mfma_f32_16x16x32_bf16(wh, xb, acc, 0, 0, 0); acc = __builtin_amdgcn_mfma_f32_16x16x32_bf16(wl, xb, acc, 0, 0, 0); }
                const f32x4 csv = *(const LAS f32x4*)(lds + RT_CS + 16 * g), bbv = *(const LAS f32x4*)(lds + RT_BB + 16 * g);
                float lg[4] = {rs_t * (acc[0] - mu_t * csv[0]) + bbv[0], rs_t * (acc[1] - mu_t * csv[1]) + bbv[1], rs_t * (acc[2] - mu_t * csv[2]) + bbv[2], rs_t * (acc[3] - mu_t * csv[3]) + bbv[3]};
                float m = __builtin_fmaxf(__builtin_fmaxf(lg[0], lg[1]), __builtin_fmaxf(lg[2], lg[3]));
                m = __builtin_fmaxf(m, shx(m, 16, lane)); m = __builtin_fmaxf(m, shx(m, 32, lane));
                float t1 = -1.f, t2 = -1.f; int i1 = 0, i2 = 0;
#pragma unroll
                for (int r = 0; r < 4; ++r) { const float p = __expf(lg[r] - m); if (p > t1) { t2 = t1; i2 = i1; t1 = p; i1 = r; } else if (p > t2) { t2 = p; i2 = r; } }
                const float gs = t1 + t2; float bgs = gs; int bg = g;
                { const float o = shx(bgs, 16, lane); const int og = shxi(bg, 16, lane); if (o > bgs || (o == bgs && og < bg)) { bgs = o; bg = og; } }
                { const float o = shx(bgs, 32, lane); const int og = shxi(bg, 32, lane); if (o > bgs || (o == bgs && og < bg)) { bgs = o; bg = og; } }
                const bool mine = (bg == g); const int e0 = 4 * g + i1, e1 = 4 * g + i2;
                if (mine) { u32x4 info; info.x = (unsigned)e0; info.y = (unsigned)e1; info.z = __builtin_bit_cast(unsigned, t1 / gs); info.w = __builtin_bit_cast(unsigned, t2 / gs);
                    *(u32x4*)(ws + WS_TINFO + token * 16) = info; ((LAS unsigned short*)(lds + RT_SEL))[tl] = (unsigned short)(e0 | (e1 << 8)); }
                const unsigned long long below = (1ull << lane) - 1ull; int r0 = 0, r1 = 0;
#pragma unroll
                for (int e = 0; e < 16; ++e) { const bool hit = mine && (e0 == e || e1 == e); const unsigned long long mb = __ballot(hit); const int cb = __popcll(mb & below);
                    r0 = (e0 == e) ? run[e] + cb : r0; r1 = (e1 == e) ? run[e] + cb : r1; run[e] += __popcll(mb); }
                if (mine) { ((LAS unsigned short*)(lds + RT_RK))[2 * tl] = (unsigned short)r0; ((LAS unsigned short*)(lds + RT_RK))[2 * tl + 1] = (unsigned short)r1; }
            }
        }
        if (MODE == 1) {
            { int vsel = 0;
#pragma unroll
              for (int e = 0; e < 16; ++e) vsel = (lane == e) ? run[e] : vsel;
              if (lane < 16) ((LAS int*)(lds + RT_CNTW))[wave * 16 + lane] = vsel; }
            __syncthreads();
            if (tid < 16) { int base = 0;
#pragma unroll
                for (int w = 0; w < 8; ++w) { const int t = ((LAS int*)(lds + RT_CNTW))[w * 16 + tid]; ((LAS int*)(lds + RT_WBASE))[w * 16 + tid] = base; base += t; }
                ((int*)(ws + WS_WGCNT))[blk * 16 + tid] = base; }
            __syncthreads();
            { const int t = tid >> 1, k = tid & 1; const int e = (((LAS unsigned short*)(lds + RT_SEL))[t] >> (8 * k)) & 255;
              ((int*)(ws + WS_TRANK))[(size_t)blk * 512 + tid] = (int)((LAS unsigned short*)(lds + RT_RK))[tid] + ((LAS int*)(lds + RT_WBASE))[(t >> 5) * 16 + e]; }
            __syncthreads();
        }
    }
}

#undef LN_LOAD
constexpr int MG_TBL = 0, MG_TOT = 16384, MG_PRE = 16448, MG_BASE = 16512;
__device__ __forceinline__ void moe_gather_phase(LAS unsigned char* lds, unsigned char* ws, int bid, int G, int wave_s) {
    int tid_ = wave_s * 64 + pg8::lane_id(); asm volatile("" : "+v"(tid_)); const int tid = tid_, lane = tid & 63, wave = __builtin_amdgcn_readfirstlane(tid >> 6);
    LAS int* tbl = (LAS int*)(lds + MG_TBL); LAS int* tot = (LAS int*)(lds + MG_TOT); LAS int* pre = (LAS int*)(lds + MG_PRE); LAS int* base = (LAS int*)(lds + MG_BASE);
    LAS int* offs = (LAS int*)(lds + MISC_OFF) + 16; LAS int* tile_e = (LAS int*)(lds + TILEE_OFF);
    const bf16_t* X = (const bf16_t*)(ws + WS_X); bf16_t* Xs = (bf16_t*)(ws + WS_R + R_XS);
    for (int blk = bid; blk < 256; blk += G) {
        __syncthreads();
        for (int i = tid; i < 4096; i += NTHR) tbl[i] = ((const int*)(ws + WS_WGCNT))[i];
        __syncthreads();
        if (tid < 16) { int t = 0, p = 0; for (int c = 0; c < 256; ++c) { const int v = tbl[c * 16 + tid]; p += (c < blk) ? v : 0; t += v; } tot[tid] = t; pre[tid] = p; }
        __syncthreads();
        if (tid == 0) { int o = 0; for (int e = 0; e < 16; ++e) { offs[e] = o; base[e] = o + pre[e]; o += (tot[e] + 255) & ~255; } offs[16] = o; offs[17] = o >> 8; }
        __syncthreads();
        for (int rt = tid; rt < 528; rt += NTHR) { int e = 0;
#pragma unroll
            for (int q = 1; q < 16; ++q) e = (rt * 256 >= offs[q]) ? q : e;
            tile_e[rt] = e; }
        { const size_t tok = (size_t)blk * 256 + (tid >> 1); const int k = tid & 1;
          const int e = ((const int*)(ws + WS_TINFO))[tok * 4 + k]; const int rk = ((const int*)(ws + WS_TRANK))[tok * 2 + k];
          const int slot = base[e] + rk;
          ((int*)(ws + WS_TSLOT))[tok * 2 + k] = slot; ((int*)(ws + WS_SRCROW))[slot] = (int)tok; }
        for (int e = wave; e < 16; e += NWAVES) { const int npad = offs[e + 1] - offs[e] - tot[e];
            if (blk < npad && lane == 0) ((int*)(ws + WS_SRCROW))[offs[e] + tot[e] + blk] = 0; }
    }
}

#define GEMM_ALIGN true
#define GEMM_SP2 true
__global__ void __launch_bounds__(NTHR, 2) mk_fwd(Args args) {
    extern __shared__ __attribute__((aligned(16))) unsigned char lds_raw[];
    LAS unsigned char* lds = (LAS unsigned char*)lds_raw;
    const int tid = threadIdx.x; const int wave_s = __builtin_amdgcn_readfirstlane(tid >> 6);
    const int G = gridDim.x, bid = blockIdx.x;
    unsigned char* ws = args.ws;
    volatile LAS unsigned* MISC = (volatile LAS unsigned*)(lds + MISC_OFF);
    for (int u = tid; u < (LDS_BYTES - LDSCTL_OFF) / 4; u += NTHR) ((LAS unsigned*)(lds + LDSCTL_OFF))[u] = 0u;
    __syncthreads();
    XcdBarrier bar = xcd_barrier_post((unsigned*)(ws + WS_CTL) + CW_BAR, MISC + 8);
    bar.wv = wave_s;
#define GRID_BAR() xcd_barrier(bar)
#ifndef REP_MASK
#define REP_MASK 0
#endif
#define LOCAL_SYNC() do { asm volatile("s_waitcnt vmcnt(0)" ::: "memory"); __syncthreads(); } while (0)
#define PHASE(grp, ...) do { __VA_ARGS__; if (REP_MASK & (1 << (grp))) { GRID_BAR(); __VA_ARGS__; } } while (0)

#define WSQ ({ unsigned char* w_ = args.ws; asm volatile("" : "+s"(w_)); w_; })
#define X ((bf16_t*)(WSQ + WS_X))
#define P ((bf16_t*)(WSQ + WS_R + R_P))
#define Y ((bf16_t*)(WSQ + WS_R + R_Y))
#define Z ((bf16_t*)(WSQ + WS_R + R_Z))
#define Qb ((bf16_t*)(WSQ + WS_R + R_Q))
#define Ob ((bf16_t*)(WSQ + WS_R + R_O))
#define Xs ((bf16_t*)(WSQ + WS_R + R_XS))
#define Hb ((bf16_t*)(WSQ + WS_R + R_H))
#define KV ((bf16_t*)(WSQ + WS_KV))
#define wl (WSQ + WS_W + (size_t)l * W_LAYER)

    PHASE(0, p0_convert(args, lds, bid, G, wave_s));
    GRID_BAR();
    { const int tid_r = wave_s * 64 + pg8::lane_id();
      for (int i = bid * NTHR + tid_r; i < 2 * 2 * 1024; i += G * NTHR) { const int l = i >> 11, w = (i >> 10) & 1, n = i & 1023; const float* tb = (const float*)(WSQ + WS_CS) + (size_t)l * 2 * 16 * 1024 + w * 16 * 1024; float s = 0.f;
#pragma unroll
          for (int kc = 0; kc < 16; ++kc) s += tb[kc * 1024 + n];
          ((float*)(WSQ + WS_CS) + 65536)[i] = s; } }
    PHASE(1, { pg8::Gemm g{(const bf16_t*)(WSQ + WS_MEMB), (const bf16_t*)(WSQ + WS_WKV), MKV, 4096, D, wave_s}; pg8::StaticOrder S; S.init(MKV, 4096, G, bid);
      pg8::EpiPlain E{KV, 4096, 0xffff};
      pg8::gemm_phase<pg8::EpiPlain, pg8::StaticOrder, GEMM_ALIGN, GEMM_SP2>(lds, g, S, E); });

#pragma unroll 1
    for (int l = 0; l < 2; ++l) {
        PHASE(1, { pg8::Gemm g{(const bf16_t*)(WSQ + WS_X8IN), (const bf16_t*)(wl + W_IN), M, NP, D / 2, wave_s}; pg8::StaticOrder S; S.init(M, NP, G, bid);
          pg8::EpiInProj8 E{P, args.in[4] + l * 256};
          pg8::gemm_phase<pg8::EpiInProj8, pg8::StaticOrder, GEMM_ALIGN, GEMM_SP2>(lds, g, S, E); });
        GRID_BAR();
        PHASE(3, gla_phase<false>(lds, P, (float*)(WSQ + WS_SEND), (float*)(WSQ + WS_LTOT), Y, args.in[5] + l * 512, bid, G, wave_s));
        PHASE(4, sgu_phase(lds, P, (const bf16_t*)(WSQ + WS_WM) + (size_t)l * 4 * 128 * 128, args.in[7] + l * 512, args.in[8] + l * 512, args.in[9] + l * 512, Y, bid, G, wave_s));
        GRID_BAR();
        PHASE(3, gla_phase<true>(lds, P, (float*)(WSQ + WS_SEND), (float*)(WSQ + WS_LTOT), Y, args.in[5] + l * 512, bid, G, wave_s));
        GRID_BAR();
        PHASE(10, { pg8::Gemm g{Y, (const bf16_t*)(wl + W_OUT), M, D, D, wave_s}; pg8::PanelOrder S{4, M / 256, G, bid};
          pg8::EpiResidStats E{X, Z, (pg8::f32x2_t*)(WSQ + WS_PART)};
          pg8::gemm_phase<pg8::EpiResidStats, pg8::PanelOrder, GEMM_ALIGN, GEMM_SP2>(lds, g, S, E); });
        { const int tid_r = wave_s * 64 + pg8::lane_id();
          for (int pan = bid; pan < 256; pan += G) if (tid_r < 256) { const size_t row = (size_t)pan * 256 + tid_r; const pg8::f32x2_t* pp = (const pg8::f32x2_t*)(WSQ + WS_PART) + row * 16; float s1 = 0.f, s2 = 0.f;
#pragma unroll
              for (int q = 0; q < 16; ++q) { const pg8::f32x2_t v = pp[q]; s1 += v[0]; s2 += v[1]; }
              const float mu = s1 * (1.0f / D), var = s2 * (1.0f / D) - mu * mu; ((pg8::f32x2_t*)(WSQ + WS_STATS))[row] = (pg8::f32x2_t){mu, __builtin_amdgcn_rsqf(var + LN_EPS)}; } }
        LOCAL_SYNC();
        PHASE(10, { pg8::Gemm g{Z, (const bf16_t*)(wl + W_Q), M, D, D, wave_s}; pg8::PanelOrder S{4, M / 256, G, bid};
          pg8::EpiQFragLN E{(unsigned char*)Qb, (const pg8::f32x2_t*)(WSQ + WS_STATS), (const float*)(WSQ + WS_CS) + 65536 + l * 2048, (const float*)(WSQ + WS_CS) + 65536 + l * 2048 + 1024};
          pg8::gemm_phase<pg8::EpiQFragLN, pg8::PanelOrder, GEMM_ALIGN, GEMM_SP2>(lds, g, S, E); });
        PHASE(5, attn_phase(lds, Qb, KV, Ob, l, bid, G, wave_s));
        LOCAL_SYNC();
        PHASE(10, { pg8::Gemm g{Ob, (const bf16_t*)(wl + W_O), M, D, D / 2, wave_s}; pg8::PanelOrder S{4, M / 256, G, bid};
          pg8::EpiResidLN8 E{Z, (const pg8::f32x2_t*)(WSQ + WS_STATS), args.in[20] + (size_t)(l * 3) * D, args.in[21] + (size_t)(l * 3) * D};
          pg8::gemm_phase<pg8::EpiResidLN8, pg8::PanelOrder, GEMM_ALIGN, GEMM_SP2>(lds, g, S, E); });
        PHASE(9, ln_phase<1>(lds, args, l, 1, false, X, bid, G, wave_s));
        GRID_BAR();
        PHASE(7, moe_gather_phase(lds, WSQ, bid, G, wave_s));
        GRID_BAR();
        PHASE(2, { pg8::Gemm g{(const bf16_t*)(WSQ + WS_R + R_X8), (const bf16_t*)(wl + W_GU), MOE_ROWS, 16384, D / 2, wave_s}; pg8::MoeGatherOrder S{(const LAS int*)(lds + TILEE_OFF), (int)MISC[33] * 4, G, bid, (const int*)(WSQ + WS_SRCROW)};
          pg8::EpiGU8 E{(unsigned char*)Hb};
          pg8::gemm_phase<pg8::EpiGU8, pg8::MoeGatherOrder, GEMM_ALIGN, GEMM_SP2>(lds, g, S, E); });
        GRID_BAR();
        PHASE(2, { pg8::Gemm g{Hb, (const bf16_t*)(wl + W_D), MOE_ROWS, 16384, 256, wave_s}; pg8::MoeOrder S{(const LAS int*)(lds + TILEE_OFF), (int)MISC[33] * 4, G, bid};
          pg8::EpiPlain8 E{(unsigned char*)Xs, D, 3};
          pg8::gemm_phase<pg8::EpiPlain8, pg8::MoeOrder, GEMM_ALIGN, GEMM_SP2>(lds, g, S, E); });
        GRID_BAR();
        if (REP_MASK & (1 << 8)) { ln_phase<2>(lds, args, l, 2, l == 1, Z, bid, G, wave_s); GRID_BAR(); }
        ln_phase<2>(lds, args, l, 2, l == 1, X, bid, G, wave_s);
        if (l == 0) GRID_BAR();
    }
}
#undef X
#undef P
#undef Y
#undef Z
#undef Qb
#undef Ob
#undef Xs
#undef Hb
#undef KV
#undef wl
}

extern "C" void kernel_launch(void* const* d_in, const int* in_sizes, int n_in, void* d_out, int out_size, void* d_ws, size_t ws_size, hipStream_t stream) {
    using namespace mk;
    static int grid = 0;
    if (grid == 0) {
        if (n_in != 22 || in_sizes[0] != M * D || out_size != M * D || ws_size < WS_END) { fprintf(stderr, "kernel_launch: unexpected shapes (n_in %d, in0 %d, out %d, ws %zu, need %zu)\n", n_in, n_in > 0 ? in_sizes[0] : -1, out_size, ws_size, (size_t)WS_END); grid = -1; return; }
        int dev = 0, cus = 0;
        if (hipGetDevice(&dev) != hipSuccess || hipDeviceGetAttribute(&cus, hipDeviceAttributeMultiprocessorCount, dev) != hipSuccess) { grid = -1; return; }
        if (hipFuncSetAttribute((const void*)mk_fwd, hipFuncAttributeMaxDynamicSharedMemorySize, LDS_BYTES) != hipSuccess) { fprintf(stderr, "kernel_launch: hipFuncSetAttribute failed\n"); grid = -1; return; }
        int per_cu = 0;
        if (hipOccupancyMaxActiveBlocksPerMultiprocessor(&per_cu, (const void*)mk_fwd, NTHR, LDS_BYTES) != hipSuccess || per_cu < 1) fprintf(stderr, "kernel_launch: occupancy query says %d\n", per_cu);
        (void)hipGetLastError();
        grid = cus;
    }
    if (grid < 0) return;
    if (hipMemsetAsync((char*)d_ws + WS_CTL, 0, CTL_ZERO_BYTES, stream) != hipSuccess) return;
    Args a{};
    for (int i = 0; i < 22; ++i) a.in[i] = (const float*)d_in[i];
    a.out = (float*)d_out; a.ws = (unsigned char*)d_ws;
    hipLaunchKernelGGL(mk_fwd, dim3(grid), dim3(NTHR), LDS_BYTES, stream, a);
}
```

```cpp
#include <hip/hip_runtime.h>
#include <cstdio>
#include <cstdint>

namespace pg8 {
#define PG8_LAS __attribute__((address_space(3)))
typedef unsigned short bf16_t;
typedef short bf16x8 __attribute__((ext_vector_type(8)));
typedef float f32x4 __attribute__((ext_vector_type(4)));
typedef unsigned u32x4 __attribute__((ext_vector_type(4)));
typedef unsigned u32x2 __attribute__((ext_vector_type(2)));
constexpr int BM = 256, BK = 64, HALF = 128, HTB = HALF * BK * 2  , STAGE_BYTES = 8 * HTB, NXCD = 8, WGM = 8;

__host__ __device__ __forceinline__ int lds_byte(int r, int c) { const int st = (r >> 4) * 2 + (c >> 5), rr = r & 15, cc = c & 31, ob = rr * 64 + cc * 2; return st * 1024 + (ob ^ (((ob >> 9) & 1) << 5)); }
__host__ __device__ __forceinline__ void stage_rc(int b, int& R, int& C) { const int st = b / 1024, sb = b % 1024, swz = sb ^ (((sb >> 9) & 1) << 5); R = (st >> 1) * 16 + swz / 64; C = (st & 1) * 32 + (swz % 64) / 2; }
__host__ __device__ __forceinline__ int perm32(int rho) { const int n = rho >> 4, i = rho & 15; return 8 * (i >> 2) + 4 * n + (i & 3); }

struct Unit { int pm, pn; };
struct Gemm { const bf16_t* A; const bf16_t* Bt; int M, N, K; int wv; };
__device__ __forceinline__ int lane_id() { int l; asm volatile("v_mbcnt_lo_u32_b32 %0, -1, 0\n\tv_mbcnt_hi_u32_b32 %0, -1, %0" : "=v"(l)); return l; }

struct StaticOrder {
    static constexpr bool GATHER = false;
    int nM, nN, nwg, G, c; const int* src = nullptr;
    __host__ __device__ void init(int M, int N, int G_, int c_) { nM = M / BM; nN = N / BM; nwg = nM * nN; G = G_; c = c_; }
    __host__ __device__ bool next(int i, Unit& u) const {
        const long L = (long)i * G + c; if (L >= nwg) return false;
        int wgid = (int)L; { const int q = nwg / NXCD, r = nwg % NXCD, xcd = wgid % NXCD, off = wgid / NXCD; wgid = (xcd < r ? xcd * (q + 1) : r * (q + 1) + (xcd - r) * q) + off; }
        const int nig = WGM * nN, gid = wgid / nig, fm = gid * WGM, gsz = (nM - fm) < WGM ? (nM - fm) : WGM;
        u.pm = fm + ((wgid % nig) % gsz); u.pn = (wgid % nig) / gsz; return true;
    }
    __device__ __forceinline__ void a_ready(const Unit&) const {}
    __device__ __forceinline__ void done(const Unit&) const {}
};
struct PanelOrder {
    static constexpr bool GATHER = false;
    int nN, npan, G, c; const int* src = nullptr;
    __device__ __forceinline__ bool next(int i, Unit& u) const { const int p = c + (i / nN) * G; if (p >= npan) return false; u.pm = p; u.pn = i % nN; return true; }
    __device__ __forceinline__ void a_ready(const Unit&) const {}
    __device__ __forceinline__ void done(const Unit&) const {}
};
template <bool GATH_> struct MoeOrderT {
    static constexpr bool GATHER = GATH_;
    const PG8_LAS int* tile_e; int nunits, G, c; const int* src = nullptr;
    __device__ __forceinline__ bool next(int i, Unit& u) const {
        const int cc = ((G & 7) == 0) ? (c & 7) * (G >> 3) + (c >> 3) : c;
        const int L = i * G + cc; if (L >= nunits) return false;
        u.pm = L >> 2; u.pn = tile_e[L >> 2] * 4 + (L & 3); return true;
    }
    __device__ __forceinline__ void a_ready(const Unit&) const {}
    __device__ __forceinline__ void done(const Unit&) const {}
};
typedef MoeOrderT<false> MoeOrder; typedef MoeOrderT<true> MoeGatherOrder;

typedef float f32x2_t __attribute__((ext_vector_type(2))); typedef __bf16 bf16x2_t __attribute__((ext_vector_type(2)));
typedef __amdgpu_buffer_rsrc_t rsrc_t;
__device__ __forceinline__ rsrc_t mk_rsrc(const void* p) { return __builtin_amdgcn_make_buffer_rsrc((void*)p, 0, 0x7fffffff, 0x00020000); }
__device__ __forceinline__ u32x4 bld4(rsrc_t r, unsigned voff, unsigned soff) { return __builtin_bit_cast(u32x4, __builtin_amdgcn_raw_buffer_load_b128(r, voff, soff, 0)); }
__device__ __forceinline__ f32x2_t bld2f(rsrc_t r, unsigned voff, unsigned soff) { return __builtin_bit_cast(f32x2_t, __builtin_amdgcn_raw_buffer_load_b64(r, voff, soff, 0)); }
#define GST4(p) (*(__attribute__((address_space(1))) u32x4*)(p))
__device__ __forceinline__ float f8clamp(float x) { return __builtin_fminf(__builtin_fmaxf(x, -448.0f), 448.0f); }
__device__ __forceinline__ unsigned pk4f8(float a, float b, float c, float d) { int w = 0; w = __builtin_amdgcn_cvt_pk_fp8_f32(f8clamp(a), f8clamp(b), w, false); w = __builtin_amdgcn_cvt_pk_fp8_f32(f8clamp(c), f8clamp(d), w, true); return (unsigned)w; }
constexpr float F8_SX = 4.0f, F8_SW = 64.0f, F8_SH = 8.0f, F8_SO = 64.0f, F8_SY = 16.0f, F8_SQ = 64.0f, F8_SM = 4.0f;
__device__ __forceinline__ unsigned pk2(float lo, float hi) { f32x2_t v = {lo, hi}; bf16x2_t b = __builtin_convertvector(v, bf16x2_t); return __builtin_bit_cast(unsigned, b); }
__device__ __forceinline__ float bflo(unsigned w) { return __builtin_bit_cast(float, w << 16); }
__device__ __forceinline__ float bfhi(unsigned w) { return __builtin_bit_cast(float, w & 0xffff0000u); }
__device__ __forceinline__ float f_silu(float x) { return x * __builtin_amdgcn_rcpf(1.0f + __builtin_amdgcn_exp2f(-1.4426950408889634f * x)); }
__device__ __forceinline__ float f_gelu_tanh(float x) { return x * __builtin_amdgcn_rcpf(1.0f + __builtin_amdgcn_exp2f(x * (-2.3022082f - 0.10294324f * x * x))); }
__device__ __forceinline__ float f_logsig16(float z) { const float t = __builtin_amdgcn_exp2f(-1.4426950408889634f * __builtin_fabsf(z)); return (__builtin_fminf(z, 0.0f) - 0.6931471805599453f * __builtin_amdgcn_logf(1.0f + t)) * 0.0625f; }

struct EpiPlain {
    static constexpr bool PERM = true, AFTER_DRAIN = false;
    bf16_t* O; int ldc; int cmask;
    __device__ __forceinline__ void operator()(const f32x4 (&acc)[2][2][4][2], const Unit& u, int wr, int wc, int fr, int fq) const {
        const int row0 = u.pm * BM + wr * 64 + fr, col0 = (u.pn & cmask) * BM + wc * 32 + 8 * fq;
#pragma unroll
        for (int ai = 0; ai < 2; ++ai)
#pragma unroll
            for (int m = 0; m < 4; ++m) { bf16_t* rowp = O + (size_t)(row0 + ai * HALF + m * 16) * ldc + col0;
#pragma unroll
                for (int bj = 0; bj < 2; ++bj) { const f32x4 v0 = acc[ai][bj][m][0], v1 = acc[ai][bj][m][1];
                    u32x4 w; w.x = pk2(v0[0], v0[1]); w.y = pk2(v0[2], v0[3]); w.z = pk2(v1[0], v1[1]); w.w = pk2(v1[2], v1[3]);
                    *(u32x4*)(rowp + bj * HALF) = w; } }
    }
};
struct EpiQFrag {
    static constexpr bool PERM = true, AFTER_DRAIN = false;
    bf16_t* O;
    __device__ __forceinline__ void operator()(const f32x4 (&acc)[2][2][4][2], const Unit& u, int wr, int wc, int fr, int fq) const {
        unsigned lo = (unsigned)(((fq >> 1) * 64 + fr + 32 * (fq & 1)) * 16); asm volatile("" : "+v"(lo));
        char* tile = (char*)(O + (size_t)(u.pm * 4 + u.pn) * 65536) + (size_t)(wr * 2 * 16 + wc * 2) * 1024 + lo;
#pragma unroll
        for (int ai = 0; ai < 2; ++ai)
#pragma unroll
            for (int m = 0; m < 4; ++m)
#pragma unroll
                for (int bj = 0; bj < 2; ++bj) { const f32x4 v0 = acc[ai][bj][m][0], v1 = acc[ai][bj][m][1];
                    u32x4 w; w.x = pk2(v0[0], v0[1]); w.y = pk2(v0[2], v0[3]); w.z = pk2(v1[0], v1[1]); w.w = pk2(v1[2], v1[3]);
                    *(u32x4*)(tile + ((4 * ai + (m >> 1)) * 16 + 8 * bj) * 1024 + (m & 1) * 256) = w; }
    }
};
struct EpiInProj {
    static constexpr bool PERM = true, AFTER_DRAIN = false;
    bf16_t* O; const float* b_a;
    template <int MODE> __device__ __forceinline__ void tile(const f32x4 (&acc)[2][2][4][2], const Unit& u, int wr, int wc, int fr, int fq) const {
        const int row0 = u.pm * BM + wr * 64 + fr, col0 = u.pn * BM + wc * 32 + 8 * fq;
        f32x4 bv[2][2];
#pragma unroll
        for (int bj = 0; bj < 2; ++bj)
#pragma unroll
            for (int n = 0; n < 2; ++n) bv[bj][n] = (MODE == 2) ? *(const f32x4*)(b_a + (col0 - 1536) + bj * HALF + 4 * n) : (f32x4){0.f, 0.f, 0.f, 0.f};
#pragma unroll
        for (int ai = 0; ai < 2; ++ai)
#pragma unroll
            for (int m = 0; m < 4; ++m) { bf16_t* rowp = O + (size_t)(row0 + ai * HALF + m * 16) * 2816 + col0;
#pragma unroll
                for (int bj = 0; bj < 2; ++bj) { f32x4 v0 = acc[ai][bj][m][0], v1 = acc[ai][bj][m][1];
#pragma unroll
                    for (int j = 0; j < 4; ++j) {
                        if (MODE == 1) { v0[j] = f_silu(v0[j]); v1[j] = f_silu(v1[j]); }
                        if (MODE == 2) { v0[j] = f_logsig16(v0[j] + bv[bj][0][j]); v1[j] = f_logsig16(v1[j] + bv[bj][1][j]); }
                        if (MODE == 3) { v0[j] = f_gelu_tanh(v0[j]); v1[j] = f_gelu_tanh(v1[j]); } }
                    u32x4 w; w.x = pk2(v0[0], v0[1]); w.y = pk2(v0[2], v0[3]); w.z = pk2(v1[0], v1[1]); w.w = pk2(v1[2], v1[3]);
                    *(u32x4*)(rowp + bj * HALF) = w; } }
    }
    __device__ __forceinline__ void operator()(const f32x4 (&acc)[2][2][4][2], const Unit& u, int wr, int wc, int fr, int fq) const {
        const int pn = u.pn;
        if (pn < 4) tile<0>(acc, u, wr, wc, fr, fq); else if (pn < 6) tile<1>(acc, u, wr, wc, fr, fq); else if (pn == 6) tile<2>(acc, u, wr, wc, fr, fq); else tile<3>(acc, u, wr, wc, fr, fq);
    }
};
struct EpiInProj8 {
    static constexpr bool PERM = true, AFTER_DRAIN = false, F8 = true; static constexpr float dq = 1.0f / (F8_SX * F8_SW);
    bf16_t* O; const float* b_a;
    template <int MODE> __device__ __forceinline__ void tile(const f32x4 (&acc)[2][2][4][2], const Unit& u, int wr, int wc, int fr, int fq) const {
        const int row0 = u.pm * BM + wr * 64 + fr, col0 = u.pn * BM + wc * 32 + 8 * fq;
        f32x4 bv[2][2];
#pragma unroll
        for (int bj = 0; bj < 2; ++bj)
#pragma unroll
            for (int n = 0; n < 2; ++n) bv[bj][n] = (MODE == 2) ? *(const f32x4*)(b_a + (col0 - 1536) + bj * HALF + 4 * n) : (f32x4){0.f, 0.f, 0.f, 0.f};
#pragma unroll
        for (int ai = 0; ai < 2; ++ai)
#pragma unroll
            for (int m = 0; m < 4; ++m) { bf16_t* rowp = O + (size_t)(row0 + ai * HALF + m * 16) * 2816 + col0;
#pragma unroll
                for (int bj = 0; bj < 2; ++bj) { f32x4 v0 = acc[ai][bj][m][0] * dq, v1 = acc[ai][bj][m][1] * dq;
#pragma unroll
                    for (int j = 0; j < 4; ++j) {
                        if (MODE == 1) { v0[j] = f_silu(v0[j]); v1[j] = f_silu(v1[j]); }
                        if (MODE == 2) { v0[j] = f_logsig16(v0[j] + bv[bj][0][j]); v1[j] = f_logsig16(v1[j] + bv[bj][1][j]); }
                        if (MODE == 3) { v0[j] = f_gelu_tanh(v0[j]); v1[j] = f_gelu_tanh(v1[j]); } }
                    u32x4 w; w.x = pk2(v0[0], v0[1]); w.y = pk2(v0[2], v0[3]); w.z = pk2(v1[0], v1[1]); w.w = pk2(v1[2], v1[3]);
                    *(u32x4*)(rowp + bj * HALF) = w; } }
    }
    __device__ __forceinline__ void operator()(const f32x4 (&acc)[2][2][4][2], const Unit& u, int wr, int wc, int fr, int fq) const {
        const int pn = u.pn;
        if (pn < 4) tile<0>(acc, u, wr, wc, fr, fq); else if (pn < 6) tile<1>(acc, u, wr, wc, fr, fq); else if (pn == 6) tile<2>(acc, u, wr, wc, fr, fq); else tile<3>(acc, u, wr, wc, fr, fq);
    }
};
struct EpiResid {
    static constexpr bool PERM = true, AFTER_DRAIN = false;
    const bf16_t* X; bf16_t* Z; float alpha;
    __device__ __forceinline__ void operator()(const f32x4 (&acc)[2][2][4][2], const Unit& u, int wr, int wc, int fr, int fq) const {
        const int row0 = u.pm * BM + wr * 64 + fr, col0 = u.pn * BM + wc * 32 + 8 * fq;
#pragma unroll
        for (int ai = 0; ai < 2; ++ai)
#pragma unroll
            for (int m = 0; m < 4; ++m) { const size_t off = (size_t)(row0 + ai * HALF + m * 16) * 1024 + col0;
#pragma unroll
                for (int bj = 0; bj < 2; ++bj) { const f32x4 v0 = acc[ai][bj][m][0], v1 = acc[ai][bj][m][1];
                    const u32x4 xr = *(const u32x4*)(X + off + bj * HALF);
                    u32x4 w; w.x = pk2(alpha * bflo(xr.x) + v0[0], alpha * bfhi(xr.x) + v0[1]); w.y = pk2(alpha * bflo(xr.y) + v0[2], alpha * bfhi(xr.y) + v0[3]);
                    w.z = pk2(alpha * bflo(xr.z) + v1[0], alpha * bfhi(xr.z) + v1[1]); w.w = pk2(alpha * bflo(xr.w) + v1[2], alpha * bfhi(xr.w) + v1[3]);
                    *(u32x4*)(Z + off + bj * HALF) = w; } }
    }
};
struct EpiResidStats {
    static constexpr bool PERM = true, AFTER_DRAIN = false;
    const bf16_t* X; bf16_t* Z; f32x2_t* part; static constexpr float alpha = 1.4142135623730951f;
    __device__ __forceinline__ void operator()(const f32x4 (&acc)[2][2][4][2], const Unit& u, int wr, int wc, int fr, int fq) const {
        const int row0 = u.pm * BM + wr * 64 + fr, col0 = u.pn * BM + wc * 32 + 8 * fq;
        int ln = 16 * fq + fr; asm volatile("" : "+v"(ln));
        float s1[8], s2[8];
        const rsrc_t rx = mk_rsrc(X); const unsigned voff = ((unsigned)row0 * 1024u + (unsigned)col0) * 2u;
        u32x4 xres[2][4][2];
#pragma unroll
        for (int ai = 0; ai < 2; ++ai)
#pragma unroll
            for (int m = 0; m < 4; ++m)
#pragma unroll
                for (int bj = 0; bj < 2; ++bj) xres[ai][m][bj] = bld4(rx, voff, (unsigned)(((ai * HALF + m * 16) * 1024 + bj * HALF) * 2));
        __builtin_amdgcn_sched_barrier(0);
#pragma unroll
        for (int ai = 0; ai < 2; ++ai)
#pragma unroll
            for (int m = 0; m < 4; ++m) { const size_t off = (size_t)(row0 + ai * HALF + m * 16) * 1024 + col0; float a1 = 0.f, a2 = 0.f;
#pragma unroll
                for (int bj = 0; bj < 2; ++bj) { const f32x4 v0 = acc[ai][bj][m][0], v1 = acc[ai][bj][m][1];
                    const u32x4 xr = xres[ai][m][bj];
                    u32x4 w; w.x = pk2(alpha * bflo(xr.x) + v0[0], alpha * bfhi(xr.x) + v0[1]); w.y = pk2(alpha * bflo(xr.y) + v0[2], alpha * bfhi(xr.y) + v0[3]);
                    w.z = pk2(alpha * bflo(xr.z) + v1[0], alpha * bfhi(xr.z) + v1[1]); w.w = pk2(alpha * bflo(xr.w) + v1[2], alpha * bfhi(xr.w) + v1[3]);
                    GST4(Z + off + bj * HALF) = w;
                    const float z0 = bflo(w.x), z1 = bfhi(w.x), z2 = bflo(w.y), z3 = bfhi(w.y), z4 = bflo(w.z), z5 = bfhi(w.z), z6 = bflo(w.w), z7 = bfhi(w.w);
                    a1 += ((z0 + z1) + (z2 + z3)) + ((z4 + z5) + (z6 + z7)); a2 += ((z0 * z0 + z1 * z1) + (z2 * z2 + z3 * z3)) + ((z4 * z4 + z5 * z5) + (z6 * z6 + z7 * z7)); }
                s1[ai * 4 + m] = a1; s2[ai * 4 + m] = a2; }
        const bool h5 = (ln & 32) != 0, h4 = (ln & 16) != 0;
        float t1[4], t2[4];
#pragma unroll
        for (int i = 0; i < 4; ++i) { const float m1 = h5 ? s1[4 + i] : s1[i], g1 = h5 ? s1[i] : s1[4 + i], m2 = h5 ? s2[4 + i] : s2[i], g2 = h5 ? s2[i] : s2[4 + i];
            t1[i] = m1 + __builtin_bit_cast(float, __builtin_amdgcn_ds_bpermute((ln ^ 32) << 2, __builtin_bit_cast(int, g1)));
            t2[i] = m2 + __builtin_bit_cast(float, __builtin_amdgcn_ds_bpermute((ln ^ 32) << 2, __builtin_bit_cast(int, g2))); }
        float r1[2], r2[2];
#pragma unroll
        for (int i = 0; i < 2; ++i) { const float m1 = h4 ? t1[2 + i] : t1[i], g1 = h4 ? t1[i] : t1[2 + i], m2 = h4 ? t2[2 + i] : t2[i], g2 = h4 ? t2[i] : t2[2 + i];
            r1[i] = m1 + __builtin_bit_cast(float, __builtin_amdgcn_ds_bpermute((ln ^ 16) << 2, __builtin_bit_cast(int, g1)));
            r2[i] = m2 + __builtin_bit_cast(float, __builtin_amdgcn_ds_bpermute((ln ^ 16) << 2, __builtin_bit_cast(int, g2))); }
#pragma unroll
        for (int i = 0; i < 2; ++i) { const int gi = (h5 ? 4 : 0) + (h4 ? 2 : 0) + i, row = row0 + (gi >> 2) * HALF + (gi & 3) * 16;
            part[(size_t)row * 16 + u.pn * 4 + wc] = (f32x2_t){r1[i], r2[i]}; }
    }
};
struct EpiResidStats8 {
    static constexpr bool PERM = true, AFTER_DRAIN = false, F8 = true; static constexpr float dq = 1.0f / (F8_SM * F8_SW);
    const bf16_t* X; bf16_t* Z; f32x2_t* part; static constexpr float alpha = 1.4142135623730951f;
    __device__ __forceinline__ void operator()(const f32x4 (&acc)[2][2][4][2], const Unit& u, int wr, int wc, int fr, int fq) const {
        const int row0 = u.pm * BM + wr * 64 + fr, col0 = u.pn * BM + wc * 32 + 8 * fq;
        int ln = 16 * fq + fr; asm volatile("" : "+v"(ln));
        float s1[8], s2[8];
        const rsrc_t rx = mk_rsrc(X); const unsigned voff = ((unsigned)row0 * 1024u + (unsigned)col0) * 2u;
        u32x4 xres[2][4][2];
#pragma unroll
        for (int ai = 0; ai < 2; ++ai)
#pragma unroll
            for (int m = 0; m < 4; ++m)
#pragma unroll
                for (int bj = 0; bj < 2; ++bj) xres[ai][m][bj] = bld4(rx, voff, (unsigned)(((ai * HALF + m * 16) * 1024 + bj * HALF) * 2));
        __builtin_amdgcn_sched_barrier(0);
#pragma unroll
        for (int ai = 0; ai < 2; ++ai)
#pragma unroll
            for (int m = 0; m < 4; ++m) { const size_t off = (size_t)(row0 + ai * HALF + m * 16) * 1024 + col0; float a1 = 0.f, a2 = 0.f;
#pragma unroll
                for (int bj = 0; bj < 2; ++bj) { const f32x4 v0 = acc[ai][bj][m][0] * dq, v1 = acc[ai][bj][m][1] * dq;
                    const u32x4 xr = xres[ai][m][bj];
                    u32x4 w; w.x = pk2(alpha * bflo(xr.x) + v0[0], alpha * bfhi(xr.x) + v0[1]); w.y = pk2(alpha * bflo(xr.y) + v0[2], alpha * bfhi(xr.y) + v0[3]);
                    w.z = pk2(alpha * bflo(xr.z) + v1[0], alpha * bfhi(xr.z) + v1[1]); w.w = pk2(alpha * bflo(xr.w) + v1[2], alpha * bfhi(xr.w) + v1[3]);
                    GST4(Z + off + bj * HALF) = w;
                    const float z0 = bflo(w.x), z1 = bfhi(w.x), z2 = bflo(w.y), z3 = bfhi(w.y), z4 = bflo(w.z), z5 = bfhi(w.z), z6 = bflo(w.w), z7 = bfhi(w.w);
                    a1 += ((z0 + z1) + (z2 + z3)) + ((z4 + z5) + (z6 + z7)); a2 += ((z0 * z0 + z1 * z1) + (z2 * z2 + z3 * z3)) + ((z4 * z4 + z5 * z5) + (z6 * z6 + z7 * z7)); }
                s1[ai * 4 + m] = a1; s2[ai * 4 + m] = a2; }
        const bool h5 = (ln & 32) != 0, h4 = (ln & 16) != 0;
        float t1[4], t2[4];
#pragma unroll
        for (int i = 0; i < 4; ++i) { const float m1 = h5 ? s1[4 + i] : s1[i], g1 = h5 ? s1[i] : s1[4 + i], m2 = h5 ? s2[4 + i] : s2[i], g2 = h5 ? s2[i] : s2[4 + i];
            t1[i] = m1 + __builtin_bit_cast(float, __builtin_amdgcn_ds_bpermute((ln ^ 32) << 2, __builtin_bit_cast(int, g1)));
            t2[i] = m2 + __builtin_bit_cast(float, __builtin_amdgcn_ds_bpermute((ln ^ 32) << 2, __builtin_bit_cast(int, g2))); }
        float r1[2], r2[2];
#pragma unroll
        for (int i = 0; i < 2; ++i) { const float m1 = h4 ? t1[2 + i] : t1[i], g1 = h4 ? t1[i] : t1[2 + i], m2 = h4 ? t2[2 + i] : t2[i], g2 = h4 ? t2[i] : t2[2 + i];
            r1[i] = m1 + __builtin_bit_cast(float, __builtin_amdgcn_ds_bpermute((ln ^ 16) << 2, __builtin_bit_cast(int, g1)));
            r2[i] = m2 + __builtin_bit_cast(float, __builtin_amdgcn_ds_bpermute((ln ^ 16) << 2, __builtin_bit_cast(int, g2))); }
#pragma unroll
        for (int i = 0; i < 2; ++i) { const int gi = (h5 ? 4 : 0) + (h4 ? 2 : 0) + i, row = row0 + (gi >> 2) * HALF + (gi & 3) * 16;
            part[(size_t)row * 16 + u.pn * 4 + wc] = (f32x2_t){r1[i], r2[i]}; }
    }
};
struct EpiQFragLN {
    static constexpr bool PERM = true, AFTER_DRAIN = false;
    unsigned char* O; const f32x2_t* stats; const float* csum; const float* bq;
    __device__ __forceinline__ void operator()(const f32x4 (&acc)[2][2][4][2], const Unit& u, int wr, int wc, int fr, int fq) const {
        unsigned lo = (unsigned)(((fq >> 1) * 64 + fr + 32 * (fq & 1)) * 16); asm volatile("" : "+v"(lo));
        unsigned char* tile = O + (size_t)(u.pm * 4 + u.pn) * 65536 + (size_t)(wr * 2 * 8 + wc * 2) * 1024 + lo;
        const int row0 = u.pm * BM + wr * 64 + fr, col0 = u.pn * BM + wc * 32 + 8 * fq;
        f32x4 cc[2][2], bb[2][2];
#pragma unroll
        for (int bj = 0; bj < 2; ++bj)
#pragma unroll
            for (int n = 0; n < 2; ++n) { cc[bj][n] = *(const f32x4*)(csum + col0 + bj * HALF + 4 * n); bb[bj][n] = *(const f32x4*)(bq + col0 + bj * HALF + 4 * n); }
#pragma unroll
        for (int ai = 0; ai < 2; ++ai)
#pragma unroll
            for (int m = 0; m < 4; ++m) { const f32x2_t st = stats[row0 + ai * HALF + m * 16]; const float mu = st[0], rs = st[1] * F8_SQ; u32x4 w;
#pragma unroll
                for (int bj = 0; bj < 2; ++bj) { const f32x4 v0 = (acc[ai][bj][m][0] - mu * cc[bj][0]) * rs + bb[bj][0] * F8_SQ, v1 = (acc[ai][bj][m][1] - mu * cc[bj][1]) * rs + bb[bj][1] * F8_SQ;
                    const unsigned lo4 = pk4f8(v0[0], v0[1], v0[2], v0[3]), hi4 = pk4f8(v1[0], v1[1], v1[2], v1[3]);
                    if (bj == 0) { w.x = lo4; w.y = hi4; } else { w.z = lo4; w.w = hi4; } }
                *(u32x4*)(tile + (4 * ai + (m >> 1)) * 8192 + (m & 1) * 256) = w; }
    }
};
struct EpiResidLN {
    static constexpr bool PERM = true, AFTER_DRAIN = false;
    bf16_t* Z; const f32x2_t* stats; const float* gain; const float* bias; static constexpr float alpha = 1.4142135623730951f;
    __device__ __forceinline__ void operator()(const f32x4 (&acc)[2][2][4][2], const Unit& u, int wr, int wc, int fr, int fq) const {
        const int row0 = u.pm * BM + wr * 64 + fr, col0 = u.pn * BM + wc * 32 + 8 * fq;
        const rsrc_t rz = mk_rsrc(Z), rs = mk_rsrc(stats); const unsigned voff = ((unsigned)row0 * 1024u + (unsigned)col0) * 2u;
        f32x2_t st[2][4];
#pragma unroll
        for (int ai = 0; ai < 2; ++ai)
#pragma unroll
            for (int m = 0; m < 4; ++m) st[ai][m] = bld2f(rs, (unsigned)row0 * 8u, (unsigned)((ai * HALF + m * 16) * 8));
#pragma unroll
        for (int bj = 0; bj < 2; ++bj) {
            u32x4 zres[2][4];
#pragma unroll
            for (int ai = 0; ai < 2; ++ai)
#pragma unroll
                for (int m = 0; m < 4; ++m) zres[ai][m] = bld4(rz, voff, (unsigned)(((ai * HALF + m * 16) * 1024 + bj * HALF) * 2));
            const f32x4 g0 = *(const f32x4*)(gain + col0 + bj * HALF) * alpha, g1 = *(const f32x4*)(gain + col0 + bj * HALF + 4) * alpha, b0 = *(const f32x4*)(bias + col0 + bj * HALF) * alpha, b1 = *(const f32x4*)(bias + col0 + bj * HALF + 4) * alpha;
            __builtin_amdgcn_sched_barrier(0);
#pragma unroll
            for (int ai = 0; ai < 2; ++ai)
#pragma unroll
                for (int m = 0; m < 4; ++m) { const int row = row0 + ai * HALF + m * 16; const float mu = st[ai][m][0], rsd = st[ai][m][1];
                    const u32x4 zr = zres[ai][m];
                    const f32x4 z0 = (f32x4){bflo(zr.x), bfhi(zr.x), bflo(zr.y), bfhi(zr.y)}, z1 = (f32x4){bflo(zr.z), bfhi(zr.z), bflo(zr.w), bfhi(zr.w)};
                    const f32x4 v0 = (z0 - mu) * rsd * g0 + b0 + acc[ai][bj][m][0], v1 = (z1 - mu) * rsd * g1 + b1 + acc[ai][bj][m][1];
                    u32x4 w; w.x = pk2(v0[0], v0[1]); w.y = pk2(v0[2], v0[3]); w.z = pk2(v1[0], v1[1]); w.w = pk2(v1[2], v1[3]);
                    GST4(Z + (size_t)row * 1024 + col0 + bj * HALF) = w; } }
    }
};
struct EpiResidLN8 {
    static constexpr bool PERM = true, AFTER_DRAIN = false, F8 = true; static constexpr float dq = 1.0f / (F8_SO * F8_SW);
    bf16_t* Z; const f32x2_t* stats; const float* gain; const float* bias; static constexpr float alpha = 1.4142135623730951f;
    __device__ __forceinline__ void operator()(const f32x4 (&acc)[2][2][4][2], const Unit& u, int wr, int wc, int fr, int fq) const {
        const int row0 = u.pm * BM + wr * 64 + fr, col0 = u.pn * BM + wc * 32 + 8 * fq;
        const rsrc_t rz = mk_rsrc(Z), rs = mk_rsrc(stats); const unsigned voff = ((unsigned)row0 * 1024u + (unsigned)col0) * 2u;
        f32x2_t st[2][4];
#pragma unroll
        for (int ai = 0; ai < 2; ++ai)
#pragma unroll
            for (int m = 0; m < 4; ++m) st[ai][m] = bld2f(rs, (unsigned)row0 * 8u, (unsigned)((ai * HALF + m * 16) * 8));
#pragma unroll
        for (int bj = 0; bj < 2; ++bj) {
            u32x4 zres[2][4];
#pragma unroll
            for (int ai = 0; ai < 2; ++ai)
#pragma unroll
                for (int m = 0; m < 4; ++m) zres[ai][m] = bld4(rz, voff, (unsigned)(((ai * HALF + m * 16) * 1024 + bj * HALF) * 2));
            const f32x4 g0 = *(const f32x4*)(gain + col0 + bj * HALF) * alpha, g1 = *(const f32x4*)(gain + col0 + bj * HALF + 4) * alpha, b0 = *(const f32x4*)(bias + col0 + bj * HALF) * alpha, b1 = *(const f32x4*)(bias + col0 + bj * HALF + 4) * alpha;
            __builtin_amdgcn_sched_barrier(0);
#pragma unroll
            for (int ai = 0; ai < 2; ++ai)
#pragma unroll
                for (int m = 0; m < 4; ++m) { const int row = row0 + ai * HALF + m * 16; const float mu = st[ai][m][0], rsd = st[ai][m][1];
                    const u32x4 zr = zres[ai][m];
                    const f32x4 z0 = (f32x4){bflo(zr.x), bfhi(zr.x), bflo(zr.y), bfhi(zr.y)}, z1 = (f32x4){bflo(zr.z), bfhi(zr.z), bflo(zr.w), bfhi(zr.w)};
                    const f32x4 v0 = (z0 - mu) * rsd * g0 + b0 + acc[ai][bj][m][0] * dq, v1 = (z1 - mu) * rsd * g1 + b1 + acc[ai][bj][m][1] * dq;
                    u32x4 w; w.x = pk2(v0[0], v0[1]); w.y = pk2(v0[2], v0[3]); w.z = pk2(v1[0], v1[1]); w.w = pk2(v1[2], v1[3]);
                    GST4(Z + (size_t)row * 1024 + col0 + bj * HALF) = w; } }
    }
};
struct EpiGU {
    static constexpr bool PERM = true, AFTER_DRAIN = false;
    bf16_t* H;
    __device__ __forceinline__ void operator()(const f32x4 (&acc)[2][2][4][2], const Unit& u, int wr, int wc, int fr, int fq) const {
        const int row0 = u.pm * BM + wr * 64 + fr, col0 = (u.pn & 3) * 128 + wc * 16 + 4 * fq;
#pragma unroll
        for (int ai = 0; ai < 2; ++ai)
#pragma unroll
            for (int m = 0; m < 4; ++m) { bf16_t* rowp = H + (size_t)(row0 + ai * HALF + m * 16) * 512 + col0;
#pragma unroll
                for (int bj = 0; bj < 2; ++bj) { const f32x4 g = acc[ai][bj][m][0], up = acc[ai][bj][m][1];
                    u32x2 w; w.x = pk2(f_silu(g[0]) * up[0], f_silu(g[1]) * up[1]); w.y = pk2(f_silu(g[2]) * up[2], f_silu(g[3]) * up[3]);
                    *(u32x2*)(rowp + bj * 64) = w; } }
    }
};
struct EpiGU8 {
    static constexpr bool PERM = true, AFTER_DRAIN = false, F8 = true;
    unsigned char* H;
    __device__ __forceinline__ void operator()(const f32x4 (&acc)[2][2][4][2], const Unit& u, int wr, int wc, int fr, int fq) const {
        const int row0 = u.pm * BM + wr * 64 + fr, col0 = (u.pn & 3) * 128 + wc * 32 + 8 * fq;
        constexpr float dq = 1.0f / (F8_SX * F8_SW);
#pragma unroll
        for (int ai = 0; ai < 2; ++ai)
#pragma unroll
            for (int m = 0; m < 4; ++m) { float h[8];
#pragma unroll
                for (int n = 0; n < 2; ++n) { const f32x4 g = acc[ai][0][m][n] * dq, up = acc[ai][1][m][n] * (dq * F8_SH);
#pragma unroll
                    for (int i = 0; i < 4; ++i) h[4 * n + i] = f_silu(g[i]) * up[i]; }
                u32x2 w; w.x = pk4f8(h[0], h[1], h[2], h[3]); w.y = pk4f8(h[4], h[5], h[6], h[7]);
                *(u32x2*)(H + (size_t)(row0 + ai * HALF + m * 16) * 512 + col0) = w; }
    }
};
struct EpiPlain8 {
    static constexpr bool PERM = true, AFTER_DRAIN = false, F8 = true;
    unsigned char* O; int ldc; int cmask;
    __device__ __forceinline__ void operator()(const f32x4 (&acc)[2][2][4][2], const Unit& u, int wr, int wc, int fr, int fq) const {
        const int row0 = u.pm * BM + wr * 64 + fr, col0 = (u.pn & cmask) * BM + wc * 32 + 8 * fq;
        constexpr float dq = F8_SY / (F8_SH * F8_SW);
#pragma unroll
        for (int ai = 0; ai < 2; ++ai)
#pragma unroll
            for (int m = 0; m < 4; ++m) { unsigned char* rowp = O + (size_t)(row0 + ai * HALF + m * 16) * ldc + col0;
#pragma unroll
                for (int bj = 0; bj < 2; ++bj) { const f32x4 v0 = acc[ai][bj][m][0] * dq, v1 = acc[ai][bj][m][1] * dq;
                    u32x2 w; w.x = pk4f8(v0[0], v0[1], v0[2], v0[3]); w.y = pk4f8(v1[0], v1[1], v1[2], v1[3]);
                    *(u32x2*)(rowp + bj * HALF) = w; } }
    }
};

typedef int i32x4_t __attribute__((ext_vector_type(4)));
template <class T, class = void> struct epi_f8 { static constexpr bool value = false; };
template <class T> struct epi_f8<T, decltype((void)T::F8)> { static constexpr bool value = true; };
template <class Epi, class Sched, bool ALIGN_EPI = false, bool SP2 = false>
__device__ __forceinline__ void gemm_phase(PG8_LAS unsigned char* lds, const Gemm g, const Sched& S, const Epi& E) {
    int tid_ = g.wv * 64 + lane_id(); asm volatile("" : "+v"(tid_));
    const int tid = tid_, wid = __builtin_amdgcn_readfirstlane(tid >> 6), lane = tid & 63, wr = wid >> 2, wc = wid & 3, fr = lane & 15, fq = lane >> 4;
    const int K = g.K, nt = K / BK; constexpr bool F8 = epi_f8<Epi>::value;
    unsigned voffA[2], voffB[2];
#pragma unroll
    for (int i = 0; i < 2; ++i) { int R, C; stage_rc(tid * 16 + i * 8192, R, C); const int Rb = Epi::PERM ? ((R & ~31) + perm32(R & 31)) : R;
        voffA[i] = (unsigned)(R * K + C) * 2u;
        voffB[i] = (unsigned)(((Rb >> 4) * (K >> 5) + (C >> 5)) * 1024 + (Rb & 15) * 64 + (C & 31) * 2); }
    constexpr bool GATH = Sched::GATHER; static_assert(!GATH || SP2, "gather mode is written for the SP2 loop");
    unsigned goc[2][2] = {{0u, 0u}, {0u, 0u}}, gon[2][2] = {{0u, 0u}, {0u, 0u}}, go2[2][2] = {{0u, 0u}, {0u, 0u}};
#define PG8_GOFF(dst, U) do { int tg_ = tid; asm volatile("" : "+v"(tg_)); _Pragma("unroll") for (int i_ = 0; i_ < 2; ++i_) { int R_, C_; stage_rc(tg_ * 16 + i_ * 8192, R_, C_); \
        _Pragma("unroll") for (int h_ = 0; h_ < 2; ++h_) dst[h_][i_] = (unsigned)S.src[(U).pm * BM + h_ * HALF + R_] * (unsigned)(K * 2) + (unsigned)C_ * 2u; } } while (0)
    const size_t kstep = (size_t)(BK * 2);
    const size_t kstepB = 2048;
    const size_t hstep = (size_t)HALF * K * 2;
    const size_t tstep = 2 * hstep;
    const unsigned ldsw = (unsigned)wid * 1024u;
    const int aoff = lds_byte(wr * 64 + fr, fq * 8), boff = lds_byte(wc * 32 + fr, fq * 8);
#define PG8_SA(b, h) (((b) * 2 + (h)) * HTB)
#define PG8_SB(b, h) ((4 + (b) * 2 + (h)) * HTB)
#define PG8_STAGE(bufoff, gbase, voff) do { _Pragma("unroll") for (int _i = 0; _i < 2; ++_i) \
        __builtin_amdgcn_global_load_lds((const unsigned*)((const char*)(gbase) + (voff)[_i]), (PG8_LAS unsigned*)(lds + (bufoff) + ldsw + _i * 8192), 16, 0, 0); } while (0)
#define PG8_STAGE_A(b, h, PTR, KPTR, GO) do { if constexpr (GATH) { PG8_STAGE(PG8_SA(b, h), KPTR, GO); } else { PG8_STAGE(PG8_SA(b, h), PTR, voffA); } } while (0)
#define PG8_LDA(dst, b, h) do { _Pragma("unroll") for (int m = 0; m < 4; ++m) _Pragma("unroll") for (int k = 0; k < 2; ++k) dst[m][k] = *(const PG8_LAS bf16x8*)(lds + PG8_SA(b, h) + aoff + m * 2048 + k * 1024); } while (0)
#define PG8_LDB(dst, b, h) do { _Pragma("unroll") for (int n = 0; n < 2; ++n) _Pragma("unroll") for (int k = 0; k < 2; ++k) dst[n][k] = *(const PG8_LAS bf16x8*)(lds + PG8_SB(b, h) + boff + n * 2048 + k * 1024); } while (0)
#define PG8_CAT8(x, y) __builtin_shufflevector(__builtin_bit_cast(i32x4_t, x), __builtin_bit_cast(i32x4_t, y), 0, 1, 2, 3, 4, 5, 6, 7)
#define PG8_MMA(ai, bj, At, Bt) do { __builtin_amdgcn_s_setprio(1); \
        if constexpr (F8) { _Pragma("unroll") for (int m = 0; m < 4; ++m) _Pragma("unroll") for (int n = 0; n < 2; ++n) \
            asm volatile("v_mfma_f32_16x16x128_f8f6f4 %0, %1, %2, %0" : "+v"(acc[ai][bj][m][n]) : "v"(PG8_CAT8(Bt[n][0], Bt[n][1])), "v"(PG8_CAT8(At[m][0], At[m][1]))); } \
        else { _Pragma("unroll") for (int m = 0; m < 4; ++m) _Pragma("unroll") for (int n = 0; n < 2; ++n) _Pragma("unroll") for (int k = 0; k < 2; ++k) \
            acc[ai][bj][m][n] = __builtin_amdgcn_mfma_f32_16x16x32_bf16(Bt[n][k], At[m][k], acc[ai][bj][m][n], 0, 0, 0); } \
        __builtin_amdgcn_s_setprio(0); } while (0)
#define PG8_WAIT_V(n) asm volatile("s_waitcnt vmcnt(" #n ")" ::: "memory")
#define PG8_WAIT_L(n) asm volatile("s_waitcnt lgkmcnt(" #n ")" ::: "memory")
#define PG8_BAR __builtin_amdgcn_s_barrier()
#define PG8_SCHED __builtin_amdgcn_sched_barrier(0)
    Unit cur, nxt; int ui = 0;
    if (!S.next(0, cur)) return;
    f32x4 acc[2][2][4][2];
#pragma unroll
    for (int a = 0; a < 2; ++a)
#pragma unroll
        for (int b = 0; b < 2; ++b)
#pragma unroll
            for (int m = 0; m < 4; ++m)
#pragma unroll
                for (int n = 0; n < 2; ++n) { acc[a][b][m][n] = (f32x4){0.f, 0.f, 0.f, 0.f}; if constexpr (F8) asm volatile("" : "+v"(acc[a][b][m][n])); }
    bf16x8 At[4][2], B0[2][2], B1[2][2];
    const char* cA = (const char*)g.A + (size_t)cur.pm * tstep; const char* cB = (const char*)g.Bt + (size_t)cur.pn * tstep;
    S.a_ready(cur);
    const char* gA = (const char*)g.A;
    if constexpr (GATH) PG8_GOFF(goc, cur);
    if constexpr (SP2) {
        PG8_STAGE(PG8_SB(0, 0), cB, voffB); PG8_STAGE(PG8_SB(0, 1), cB + hstep, voffB); PG8_STAGE_A(0, 0, cA, gA, goc[0]); PG8_STAGE_A(0, 1, cA + hstep, gA, goc[1]);
        if (wr == 1) PG8_BAR;
        PG8_WAIT_V(2); PG8_BAR;
        PG8_STAGE(PG8_SB(1, 0), cB + kstepB, voffB); PG8_STAGE_A(1, 0, cA + kstep, gA + kstep, goc[0]); PG8_STAGE(PG8_SB(1, 1), cB + hstep + kstepB, voffB);
        PG8_WAIT_V(6); PG8_BAR;
    } else {
        PG8_STAGE(PG8_SB(0, 0), cB, voffB); PG8_STAGE(PG8_SA(0, 0), cA, voffA); PG8_STAGE(PG8_SB(0, 1), cB + hstep, voffB); PG8_STAGE(PG8_SA(0, 1), cA + hstep, voffA);
        if (wr == 1) PG8_BAR;
        PG8_WAIT_V(4); PG8_BAR;
        PG8_STAGE(PG8_SB(1, 0), cB + kstepB, voffB); PG8_STAGE(PG8_SA(1, 0), cA + kstep, voffA); PG8_STAGE(PG8_SB(1, 1), cB + hstep + kstepB, voffB);
        PG8_WAIT_V(6); PG8_BAR;
    }
    for (;;) {
        const bool has_next = S.next(ui + 1, nxt);
        if constexpr (GATH) { if (has_next) PG8_GOFF(gon, nxt); else { _Pragma("unroll") for (int h_ = 0; h_ < 2; ++h_) _Pragma("unroll") for (int i_ = 0; i_ < 2; ++i_) gon[h_][i_] = goc[h_][i_]; } }
        const char* nA = has_next ? (const char*)g.A + (size_t)nxt.pm * tstep : cA; const char* nB = has_next ? (const char*)g.Bt + (size_t)nxt.pn * tstep : cB;
        for (int t = 0; t < nt; t += 2) {
            const bool last = (t == nt - 2);
            const char* a1 = cA + (size_t)(t + 1) * kstep;
            const char* a2 = last ? nA : cA + (size_t)(t + 2) * kstep; const char* b2 = last ? nB : cB + (size_t)(t + 2) * kstepB;
            const char* a3 = a2 + kstep; const char* b3 = b2 + kstepB;
            if (last && has_next) S.a_ready(nxt);
            const char* ga1 = gA + (size_t)(t + 1) * kstep; const char* ga2 = last ? gA : gA + (size_t)(t + 2) * kstep; const char* ga3 = ga2 + kstep;
            if constexpr (GATH) { _Pragma("unroll") for (int h_ = 0; h_ < 2; ++h_) _Pragma("unroll") for (int i_ = 0; i_ < 2; ++i_) go2[h_][i_] = last ? gon[h_][i_] : goc[h_][i_]; }
            if constexpr (SP2) {
            PG8_LDB(B0, 0, 0); PG8_LDB(B1, 0, 1); PG8_SCHED; PG8_LDA(At, 0, 0); PG8_STAGE_A(1, 1, a1 + hstep, ga1, goc[1]);
            PG8_WAIT_V(8); PG8_WAIT_L(0); PG8_BAR; PG8_MMA(0, 0, At, B0); PG8_MMA(0, 1, At, B1); PG8_BAR; PG8_SCHED;
            PG8_LDA(At, 0, 1); PG8_STAGE(PG8_SB(0, 0), b2, voffB); PG8_STAGE(PG8_SB(0, 1), b2 + hstep, voffB); PG8_STAGE_A(0, 0, a2, ga2, go2[0]);
            PG8_WAIT_V(8); PG8_WAIT_L(0); PG8_BAR; PG8_MMA(1, 0, At, B0); PG8_MMA(1, 1, At, B1); PG8_BAR; PG8_SCHED;
            PG8_LDB(B0, 1, 0); PG8_LDB(B1, 1, 1); PG8_SCHED; PG8_LDA(At, 1, 0); PG8_STAGE_A(0, 1, a2 + hstep, ga2, go2[1]);
            PG8_WAIT_V(8); PG8_WAIT_L(0); PG8_BAR; PG8_MMA(0, 0, At, B0); PG8_MMA(0, 1, At, B1); PG8_BAR; PG8_SCHED;
            PG8_LDA(At, 1, 1); PG8_STAGE(PG8_SB(1, 0), b3, voffB); PG8_STAGE(PG8_SB(1, 1), b3 + hstep, voffB); PG8_STAGE_A(1, 0, a3, ga3, go2[0]);
            PG8_WAIT_V(8); PG8_WAIT_L(0); PG8_BAR; PG8_MMA(1, 0, At, B0); PG8_MMA(1, 1, At, B1); PG8_BAR; PG8_SCHED;
            } else {
            PG8_LDB(B0, 0, 0); PG8_SCHED; PG8_LDA(At, 0, 0); PG8_STAGE(PG8_SA(1, 1), a1 + hstep, voffA);
            PG8_WAIT_L(8); PG8_BAR; PG8_WAIT_L(0); PG8_MMA(0, 0, At, B0); PG8_BAR; PG8_SCHED;
            PG8_LDB(B1, 0, 1); PG8_STAGE(PG8_SB(0, 0), b2, voffB);
            PG8_BAR; PG8_WAIT_L(0); PG8_MMA(0, 1, At, B1); PG8_BAR;
            PG8_LDA(At, 0, 1); PG8_STAGE(PG8_SA(0, 0), a2, voffA);
            PG8_BAR; PG8_WAIT_L(0); PG8_MMA(1, 0, At, B0); PG8_BAR; PG8_SCHED;
            PG8_STAGE(PG8_SB(0, 1), b2 + hstep, voffB);
            PG8_WAIT_V(6); PG8_BAR; PG8_MMA(1, 1, At, B1); PG8_BAR;
            PG8_LDB(B0, 1, 0); PG8_SCHED; PG8_LDA(At, 1, 0); PG8_STAGE(PG8_SA(0, 1), a2 + hstep, voffA);
            PG8_WAIT_L(8); PG8_BAR; PG8_WAIT_L(0); PG8_MMA(0, 0, At, B0); PG8_BAR; PG8_SCHED;
            PG8_LDB(B1, 1, 1); PG8_STAGE(PG8_SB(1, 0), b3, voffB);
            PG8_BAR; PG8_WAIT_L(0); PG8_MMA(0, 1, At, B1); PG8_BAR;
            PG8_LDA(At, 1, 1); PG8_STAGE(PG8_SA(1, 0), a3, voffA);
            PG8_BAR; PG8_WAIT_L(0); PG8_MMA(1, 0, At, B0); PG8_BAR; PG8_SCHED;
            PG8_STAGE(PG8_SB(1, 1), b3 + hstep, voffB);
            PG8_WAIT_V(6); PG8_BAR; PG8_MMA(1, 1, At, B1); PG8_BAR;
            }
        }
        if constexpr (F8) asm volatile("s_nop 15\n\ts_nop 15" ::: "memory");
        if constexpr (ALIGN_EPI) { if (wr == 0) PG8_BAR; }
        if constexpr (!Epi::AFTER_DRAIN) { E(acc, cur, wr, wc, fr, fq); S.done(cur); }
        if (!has_next) break;
#pragma unroll
        for (int a = 0; a < 2; ++a)
#pragma unroll
            for (int b = 0; b < 2; ++b)
#pragma unroll
                for (int m = 0; m < 4; ++m)
#pragma unroll
                    for (int n = 0; n < 2; ++n) { acc[a][b][m][n] = (f32x4){0.f, 0.f, 0.f, 0.f}; if constexpr (F8) asm volatile("" : "+v"(acc[a][b][m][n])); }
        cur = nxt; cA = nA; cB = nB; ++ui;
        if constexpr (GATH) { _Pragma("unroll") for (int h_ = 0; h_ < 2; ++h_) _Pragma("unroll") for (int i_ = 0; i_ < 2; ++i_) goc[h_][i_] = gon[h_][i_]; }
        if constexpr (ALIGN_EPI) { if (wr == 1) PG8_BAR; }
    }
    PG8_WAIT_V(0);
    if constexpr (!ALIGN_EPI) { if (wr == 0) PG8_BAR; }
    PG8_BAR;
    if constexpr (Epi::AFTER_DRAIN) { E.fused(acc, cur, wr, wc, fr, fq, lds, wid, lane); S.done(cur); }
#undef PG8_SA
#undef PG8_SB
#undef PG8_STAGE
#undef PG8_STAGE_A
#undef PG8_GOFF
#undef PG8_LDA
#undef PG8_LDB
#undef PG8_MMA
#undef PG8_WAIT_V
#undef PG8_WAIT_L
#undef PG8_BAR
#undef PG8_SCHED
}}

namespace mk {
using pg8::bf16_t; using pg8::bf16x8; using pg8::f32x4; using pg8::u32x4; using pg8::u32x2; using pg8::pk2; using pg8::bflo; using pg8::bfhi;
typedef float f32x16 __attribute__((ext_vector_type(16)));
typedef short s16x4 __attribute__((ext_vector_type(4)));
typedef short v4i16_t __attribute__((ext_vector_type(4)));
#define LAS __attribute__((address_space(3)))
#define GAS __attribute__((address_space(1)))
typedef GAS unsigned gu32;
#define RLX_AGENT __ATOMIC_RELAXED, __HIP_MEMORY_SCOPE_AGENT
#define LDS_WAIT() asm volatile("s_waitcnt lgkmcnt(0)" ::: "memory")

constexpr int NB = 8, SEQ = 8192, M = NB * SEQ, D = 1024, NP = 2816, NMEM = 256, MKV = NB * NMEM;
constexpr int PQ = 0, PK = 256, PV = 512, PR = 1024, PG = 1536, PU = 1792, PVS = 2304;
constexpr int DIN = 2576;
constexpr int MOE_ROWS = 135168;
constexpr float ALPHA = 1.4142135623730951f, LN_EPS = 1e-5f, LOG2E = 1.4426950408889634f;
constexpr int NWAVES = 8, NTHR = 512;

constexpr size_t MiB = 1u << 20;
constexpr size_t WS_CTL = 0, CTL_ZERO_BYTES = 1 * MiB;
constexpr size_t WS_WM = 1 * MiB;
constexpr size_t WS_WGCNT = 1 * MiB + 512 * 1024;
constexpr size_t WS_LTOT = 1 * MiB + 768 * 1024;
constexpr size_t WS_TINFO = 2 * MiB;
constexpr size_t WS_TRANK = 3 * MiB;
constexpr size_t WS_TSLOT = 3 * MiB + 512 * 1024;
constexpr size_t WS_SEND = 4 * MiB;
constexpr size_t WS_WKV = 12 * MiB;
constexpr size_t WS_MEMB = 20 * MiB;
constexpr size_t WS_KV = 24 * MiB;
constexpr size_t WS_W = 40 * MiB, W_LAYER = 60 * MiB;
constexpr size_t W_IN = 0, W_OUT = (size_t)NP * D * 2, W_Q = W_OUT + 2 * MiB, W_O = W_Q + 2 * MiB, W_GU = W_O + 2 * MiB, W_D = W_GU + 32 * MiB;
static_assert(W_D + 16 * MiB <= W_LAYER, "weights per layer");
constexpr size_t WS_X = 160 * MiB;
constexpr size_t WS_R = 288 * MiB;
constexpr size_t R_P = 0, R_Y = 352 * MiB, R_Z = 480 * MiB, R_Q = 0, R_O = 128 * MiB, R_XS = 344 * MiB, R_H = 0;
constexpr size_t R_X8 = 256 * MiB;
constexpr size_t WS_SRCROW = WS_R + 616 * MiB;
constexpr size_t WS_PART = WS_SRCROW + 1 * MiB;
constexpr size_t WS_STATS = WS_PART + 8 * MiB;
constexpr size_t WS_CS = WS_STATS + 1 * MiB;
constexpr size_t WS_X8IN = WS_CS + 1 * MiB;
constexpr size_t WS_END = WS_X8IN + 64 * MiB;
static_assert(R_XS + (size_t)MOE_ROWS * D * 2 <= 616 * MiB && R_H + (size_t)MOE_ROWS * 512 * 2 <= R_XS, "moe buffers");
constexpr int CW_BAR = 4096;

constexpr int LDS_BYTES = 159744, LDSCTL_OFF = 155648;
constexpr int MISC_OFF = LDSCTL_OFF;
constexpr int TILEE_OFF = LDSCTL_OFF + 512;
static_assert(TILEE_OFF + 528 * 4 <= LDS_BYTES, "LDS map");

#define XB_TMO      128
#define XB_XCNT(j)  (256  + 64 * (j))
#define XB_XSUB(j)  (1280 + 64 * (j))
#define XB_XGEN(j)  (2304 + 64 * (j))
#define XB_TOP      3328
#define XB_TOPGEN   3392
#define XCD_BAR_WORDS 3456
#define XB_SPIN_CAP (1u << 18)

__device__ __forceinline__ unsigned xb_ld(unsigned* p)              { return __hip_atomic_load(p, __ATOMIC_RELAXED, __HIP_MEMORY_SCOPE_AGENT); }
__device__ __forceinline__ unsigned xb_add(unsigned* p, unsigned v) { return __hip_atomic_fetch_add(p, v, __ATOMIC_RELAXED, __HIP_MEMORY_SCOPE_AGENT); }
__device__ __forceinline__ unsigned xb_xcc_id() { return (unsigned)__builtin_amdgcn_s_getreg((3 << 11) | 20) & 0xFu; }
#define XB_SPIN(cond, bar) do { unsigned _sp = 0; while (cond) { __builtin_amdgcn_s_sleep(1); \
    if ((++_sp & 255u) == 0u) { if (xb_ld(&(bar)[XB_TMO])) break; if (_sp > XB_SPIN_CAP) { atomicAdd(&(bar)[XB_TMO], 1u); break; } } } } while (0)

struct XcdBarrier {
    unsigned* bar; unsigned x;
    volatile LAS unsigned* st;
    int wv;
};

__device__ __forceinline__ XcdBarrier xcd_barrier_post(unsigned* bar, volatile LAS unsigned* st) {
    XcdBarrier b; b.bar = bar; b.x = xb_xcc_id(); b.st = st; b.wv = 0;
    if (threadIdx.x == 0) (void)xb_add(&bar[XB_XCNT(b.x)], 1u);
    return b;
}
__device__ __forceinline__ void xcd_barrier_complete(unsigned* bar, unsigned x, unsigned& nloc, unsigned& nx) {
    const unsigned G = gridDim.x * gridDim.y * gridDim.z;
    unsigned sum, cnt, mine, sp = 0u;
    for (;;) {
        sum = 0u; cnt = 0u; mine = 0u;
#pragma unroll
        for (unsigned j = 0; j < 16; ++j) { const unsigned c = xb_ld(&bar[XB_XCNT(j)]); sum += c; cnt += (c > 0u) ? 1u : 0u; mine = (j == x) ? c : mine; }
        if (sum == G) break;
        __builtin_amdgcn_s_sleep(1);
        if ((++sp & 255u) == 0u) { if (xb_ld(&bar[XB_TMO])) break; if (sp > XB_SPIN_CAP) { atomicAdd(&bar[XB_TMO], 1u); break; } }
    }
    nloc = mine > 0u ? mine : 1u; nx = cnt > 0u ? cnt : 1u;
}

__device__ __forceinline__ void xcd_barrier(const XcdBarrier& b) {
    asm volatile("s_waitcnt vmcnt(0)" ::: "memory");
    __syncthreads();
    if (b.wv == 0 && pg8::lane_id() == 0) {
        unsigned* bar = b.bar;
        __builtin_amdgcn_s_waitcnt(0);
        unsigned nloc = b.st[0], nx = b.st[1];
        if (nloc == 0u) { xcd_barrier_complete(bar, b.x, nloc, nx); b.st[0] = nloc; b.st[1] = nx; }
        const unsigned old = xb_add(&bar[XB_XSUB(b.x)], 1u);
        const unsigned gen = old / nloc;
        if (old + 1u == (gen + 1u) * nloc) {
            __builtin_amdgcn_fence(__ATOMIC_RELEASE, "agent");
            asm volatile("s_waitcnt vmcnt(0)" ::: "memory");
            const unsigned og = xb_add(&bar[XB_TOP], 1u);
            const unsigned tg = og / nx;
            if (og + 1u == (tg + 1u) * nx) xb_add(&bar[XB_TOPGEN], 1u);
            else XB_SPIN(xb_ld(&bar[XB_TOPGEN]) == tg, bar);
            __builtin_amdgcn_fence(__ATOMIC_ACQUIRE, "agent");
            xb_add(&bar[XB_XGEN(b.x)], 1u);
            asm volatile("s_waitcnt vmcnt(0)" ::: "memory");
        } else {
            XB_SPIN(xb_ld(&bar[XB_XGEN(b.x)]) == gen, bar);
            __builtin_amdgcn_fence(__ATOMIC_ACQUIRE, "agent");
            asm volatile("s_waitcnt vmcnt(0)" ::: "memory");
        }
    }
    __syncthreads();
}
__device__ __forceinline__ float shx(float v, int m, int lane) { return __builtin_bit_cast(float, __builtin_amdgcn_ds_bpermute((lane ^ m) << 2, __builtin_bit_cast(int, v))); }
__device__ __forceinline__ int shxi(int v, int m, int lane) { return __builtin_amdgcn_ds_bpermute((lane ^ m) << 2, v); }
__device__ __forceinline__ s16x4 vtr(unsigned lds_addr) { return __builtin_bit_cast(s16x4, __builtin_amdgcn_ds_read_tr16_b64_v4i16((LAS v4i16_t*)(size_t)lds_addr)); }
__device__ __forceinline__ bf16x8 cat8(s16x4 lo, s16x4 hi) { return __builtin_shufflevector(lo, hi, 0, 1, 2, 3, 4, 5, 6, 7); }
__device__ __forceinline__ void unpack8(const u32x4 w, float (&f)[8]) { f[0] = bflo(w.x); f[1] = bfhi(w.x); f[2] = bflo(w.y); f[3] = bfhi(w.y); f[4] = bflo(w.z); f[5] = bfhi(w.z); f[6] = bflo(w.w); f[7] = bfhi(w.w); }
__device__ __forceinline__ void unpack8f8(const u32x2 w, float (&f)[8]) { const auto a0 = __builtin_amdgcn_cvt_pk_f32_fp8((int)w.x, false), a1 = __builtin_amdgcn_cvt_pk_f32_fp8((int)w.x, true), a2 = __builtin_amdgcn_cvt_pk_f32_fp8((int)w.y, false), a3 = __builtin_amdgcn_cvt_pk_f32_fp8((int)w.y, true);
    f[0] = a0[0]; f[1] = a0[1]; f[2] = a1[0]; f[3] = a1[1]; f[4] = a2[0]; f[5] = a2[1]; f[6] = a3[0]; f[7] = a3[1]; }
__device__ __forceinline__ u32x4 pack8(const float (&f)[8]) { u32x4 w; w.x = pk2(f[0], f[1]); w.y = pk2(f[2], f[3]); w.z = pk2(f[4], f[5]); w.w = pk2(f[6], f[7]); return w; }

struct Args {
    const float* in[22]; float* out; unsigned char* ws;
};

__device__ __forceinline__ void transpose_item(const float* p0, const float* p1, int ld, int mode, float scale, int K, int nblk, bf16_t* dst, int row0, LAS float* scr, int item, int lane, const float* kscale = nullptr) {
    const int kb = item / nblk, nb = item % nblk, k0 = 64 * kb, n0 = 32 * nb;
    const int np = n0 + (lane & 31);
    const float* sp; int col;
    if (mode == 0) { sp = p0; col = np; } else { sp = (np & 4) ? p1 : p0; col = (np >> 3) * 4 + (np & 3); }
    sp += (size_t)k0 * ld + col;
#pragma unroll 8
    for (int i = 0; i < 32; ++i) { const int kk = 2 * i + (lane >> 5); scr[kk * 33 + (lane & 31)] = sp[(size_t)kk * ld] * scale * (kscale ? kscale[k0 + kk] : 1.0f); }
    LDS_WAIT(); asm volatile("" ::: "memory");
    const int c = lane & 7;
#pragma unroll
    for (int j = 0; j < 4; ++j) { const int n = (lane >> 3) + 8 * j; const LAS float* s = scr + (8 * c) * 33 + n;
        u32x4 o; o.x = pk2(s[0 * 33], s[1 * 33]); o.y = pk2(s[2 * 33], s[3 * 33]); o.z = pk2(s[4 * 33], s[5 * 33]); o.w = pk2(s[6 * 33], s[7 * 33]);
        const int ng = row0 + n0 + n, kk = k0 + 8 * c;
        *(u32x4*)(dst + ((size_t)(ng >> 4) * (K >> 5) + (kk >> 5)) * 512 + (ng & 15) * 32 + (kk & 31)) = o; }
    LDS_WAIT(); asm volatile("" ::: "memory");
}
__device__ __forceinline__ void transpose_item8(const float* p0, const float* p1, int ld, int mode, float scale, int K, int nblk, unsigned char* dst, int row0, LAS float* scr, int item, int lane) {
    const int kb = item / nblk, nb = item % nblk, k0 = 64 * kb, n0 = 32 * nb;
    const int np = n0 + (lane & 31);
    const float* sp; int col;
    if (mode == 0) { sp = p0; col = np; } else { sp = ((np >> 7) & 1) ? p1 : p0; col = (np >> 8) * 128 + (np & 127); }
    sp += (size_t)k0 * ld + col;
#pragma unroll 8
    for (int i = 0; i < 32; ++i) { const int kk = 2 * i + (lane >> 5); scr[kk * 33 + (lane & 31)] = sp[(size_t)kk * ld] * scale; }
    LDS_WAIT(); asm volatile("" ::: "memory");
    const int c = lane & 7;
#pragma unroll
    for (int j = 0; j < 4; ++j) { const int n = (lane >> 3) + 8 * j; const LAS float* s = scr + (8 * c) * 33 + n;
        u32x2 o; o.x = pg8::pk4f8(s[0 * 33], s[1 * 33], s[2 * 33], s[3 * 33]); o.y = pg8::pk4f8(s[4 * 33], s[5 * 33], s[6 * 33], s[7 * 33]);
        const int ng = row0 + n0 + n;
        *(u32x2*)(dst + ((size_t)(ng >> 4) * (K >> 6) + (k0 >> 6)) * 1024 + (ng & 15) * 64 + 8 * c) = o; }
    LDS_WAIT(); asm volatile("" ::: "memory");
}
__device__ __forceinline__ void p0_convert(const Args& a, LAS unsigned char* lds, int bid, int G, int wave_s) {
    int tid_ = wave_s * 64 + pg8::lane_id(); asm volatile("" : "+v"(tid_)); const int tid = tid_, lane = tid & 63, wave = __builtin_amdgcn_readfirstlane(tid >> 6);
    unsigned char* ws = a.ws;
    LAS float* scr = (LAS float*)(lds + wave * 16384);
    const int gw = bid * NWAVES + wave, NGW = G * NWAVES;
    constexpr int I_INQ = 16 * 8, I_INB = 16 * 40, I_INC = 16 * 32, I_SQ = 16 * 32, I_GU = 16 * 16 * 32, I_DN = 16 * 8 * 32;
    constexpr int I_LAYER = I_INQ + I_INB + I_INC + 5 * I_SQ + I_GU + I_DN;
    for (int it = gw; it < 2 * I_LAYER; it += NGW) {
        const int l = it / I_LAYER; int r = it % I_LAYER;
        unsigned char* wl = ws + WS_W + (size_t)l * W_LAYER;
        const float* w_in = a.in[2] + (size_t)l * D * DIN;
        if (r < I_INQ) { transpose_item8(w_in, nullptr, DIN, 0, 0.125f * pg8::F8_SW, D, 8, wl + W_IN, 0, scr, r, lane); continue; } r -= I_INQ;
        if (r < I_INB) { transpose_item8(w_in + 256, nullptr, DIN, 0, pg8::F8_SW, D, 40, wl + W_IN, 256, scr, r, lane); continue; } r -= I_INB;
        if (r < I_INC) { transpose_item8(w_in + 1552, nullptr, DIN, 0, pg8::F8_SW, D, 32, wl + W_IN, 1792, scr, r, lane); continue; } r -= I_INC;
        if (r < I_SQ) { transpose_item8(a.in[10] + (size_t)l * D * D, nullptr, D, 0, pg8::F8_SW, D, 32, wl + W_OUT, 0, scr, r, lane); continue; } r -= I_SQ;
        if (r < I_SQ) { transpose_item(a.in[11] + (size_t)l * D * D, nullptr, D, 0, 0.0625f, D, 32, (bf16_t*)(wl + W_Q), 0, scr, r, lane, a.in[20] + (size_t)(l * 3 + 0) * D); continue; } r -= I_SQ;
        if (r < I_SQ) { transpose_item8(a.in[14] + (size_t)l * D * D, nullptr, D, 0, pg8::F8_SW, D, 32, wl + W_O, 0, scr, r, lane); continue; } r -= I_SQ;
        if (r < I_SQ) { transpose_item(a.in[12] + (size_t)l * D * D, nullptr, D, 0, 1.0f, D, 32, (bf16_t*)(ws + WS_WKV), l * 2048, scr, r, lane); continue; } r -= I_SQ;
        if (r < I_SQ) { transpose_item(a.in[13] + (size_t)l * D * D, nullptr, D, 0, 1.0f, D, 32, (bf16_t*)(ws + WS_WKV), l * 2048 + 1024, scr, r, lane); continue; } r -= I_SQ;
        if (r < I_GU) { const int e = r / 512, rr = r % 512; const size_t eo = ((size_t)l * 16 + e) * D * 512;
            transpose_item8(a.in[17] + eo, a.in[18] + eo, 512, 2, pg8::F8_SW, D, 32, wl + W_GU, e * 1024, scr, rr, lane); continue; } r -= I_GU;
        { const int e = r / 256, rr = r % 256; const size_t eo = ((size_t)l * 16 + e) * 512 * D;
            transpose_item8(a.in[19] + eo, nullptr, D, 0, pg8::F8_SW, 512, 32, wl + W_D, e * 1024, scr, rr, lane); }
    }
    const size_t gt = (size_t)bid * NTHR + tid, NT = (size_t)G * NTHR;
    for (int it = gw; it < 2 * 16 * 16; it += NGW) { const int l = it >> 8, kc = (it >> 4) & 15, n = (it & 15) * 64 + lane;
        const float* wq = a.in[11] + (size_t)l * D * D; const float* gg = a.in[20] + (size_t)(l * 3) * D; const float* bb = a.in[21] + (size_t)(l * 3) * D; float cs = 0.f, bq = 0.f;
#pragma unroll 8
        for (int k = 64 * kc; k < 64 * kc + 64; ++k) { const float w = wq[(size_t)k * D + n] * 0.0625f; cs += bflo(pk2(w * gg[k], 0.f) & 0xffffu); bq += w * bb[k]; }
        float* tb = (float*)(ws + WS_CS) + (size_t)l * 2 * 16 * 1024; tb[kc * 1024 + n] = cs; tb[16 * 1024 + kc * 1024 + n] = bq; }
    for (size_t i = gt; i < (size_t)2 * 256 * 128; i += NT) {
        const int l = (int)(i / (256 * 128)), r = (int)(i % (256 * 128)), j = r / 128, k8 = r % 128;
        const float* w_in = a.in[2] + (size_t)l * D * DIN; const float* w_a2 = a.in[3] + (size_t)l * 16 * 256;
        float wa[16];
#pragma unroll
        for (int q = 0; q < 16; ++q) wa[q] = w_a2[q * 256 + j];
        float o[8];
#pragma unroll
        for (int kk = 0; kk < 8; ++kk) { const float* wr = w_in + (size_t)(8 * k8 + kk) * DIN + 1536; float s = 0.f;
#pragma unroll
            for (int q = 0; q < 16; q += 4) { const f32x4 v = *(const f32x4*)(wr + q); s += v[0] * wa[q] + v[1] * wa[q + 1] + v[2] * wa[q + 2] + v[3] * wa[q + 3]; }
            o[kk] = s; }
        { const int ng = 1536 + j, kk = 8 * k8; u32x2 o8; o8.x = pg8::pk4f8(o[0] * pg8::F8_SW, o[1] * pg8::F8_SW, o[2] * pg8::F8_SW, o[3] * pg8::F8_SW); o8.y = pg8::pk4f8(o[4] * pg8::F8_SW, o[5] * pg8::F8_SW, o[6] * pg8::F8_SW, o[7] * pg8::F8_SW);
          *(u32x2*)(ws + WS_W + (size_t)l * W_LAYER + W_IN + ((size_t)(ng >> 4) * (D >> 6) + (kk >> 6)) * 1024 + (ng & 15) * 64 + (kk & 63)) = o8; }
    }
    for (size_t i = gt; i < (size_t)2 * 4 * 128 * 16; i += NT) {
        const int s8 = (int)(i & 15), t = (int)((i >> 4) & 127);
        const float* src = a.in[6] + i * 8; float o[8];
#pragma unroll
        for (int q = 0; q < 8; ++q) o[q] = ((8 * s8 + q) / 64 <= t / 64) ? src[q] : 0.f;
        *(u32x4*)((bf16_t*)(ws + WS_WM) + i * 8) = pack8(o);
    }
    for (size_t i = gt; i < (size_t)M * D / 8; i += NT) {
        const f32x4 v0 = *(const f32x4*)(a.in[0] + i * 8), v1 = *(const f32x4*)(a.in[0] + i * 8 + 4);
        u32x4 w; w.x = pk2(v0[0], v0[1]); w.y = pk2(v0[2], v0[3]); w.z = pk2(v1[0], v1[1]); w.w = pk2(v1[2], v1[3]);
        *(u32x4*)((bf16_t*)(ws + WS_X) + i * 8) = w;
        u32x2 q8; q8.x = pg8::pk4f8(v0[0] * pg8::F8_SX, v0[1] * pg8::F8_SX, v0[2] * pg8::F8_SX, v0[3] * pg8::F8_SX); q8.y = pg8::pk4f8(v1[0] * pg8::F8_SX, v1[1] * pg8::F8_SX, v1[2] * pg8::F8_SX, v1[3] * pg8::F8_SX);
        *(u32x2*)(ws + WS_X8IN + i * 8) = q8;
    }
    for (size_t i = gt; i < (size_t)MKV * D / 8; i += NT) {
        const f32x4 v0 = *(const f32x4*)(a.in[1] + i * 8), v1 = *(const f32x4*)(a.in[1] + i * 8 + 4);
        u32x4 w; w.x = pk2(v0[0], v0[1]); w.y = pk2(v0[2], v0[3]); w.z = pk2(v1[0], v1[1]); w.w = pk2(v1[2], v1[3]);
        *(u32x4*)((bf16_t*)(ws + WS_MEMB) + i * 8) = w;
    }
}

constexpr int GL_KD = 0, GL_QS = 9216, GL_VS = 18432, GL_PSUM = 35840, GL_DL = 37888, GL_SSQ = 38144;
template <bool FINAL>
__device__ __forceinline__ void gla_phase(LAS unsigned char* lds, const bf16_t* P, float* Send, float* Ltot, bf16_t* Y, const float* gn_g, int bid, int G, int wave_s) {
    int tid_ = wave_s * 64 + pg8::lane_id(); asm volatile("" : "+v"(tid_)); const int tid = tid_, lane = tid & 63, wave = __builtin_amdgcn_readfirstlane(tid >> 6);
    const unsigned lb = (unsigned)(size_t)lds;
    const int g = lane >> 4, l15 = lane & 15, q4 = l15 >> 2, p4 = lane & 3;
    const int kq = tid & 63, part = wave;
    for (int item = bid; item < 256; item += G) {
        const int b = item >> 5, h = (item >> 3) & 3, run = item & 7, bh = item >> 3;
        f32x4 sacc[4];
#pragma unroll
        for (int kt = 0; kt < 4; ++kt) sacc[kt] = (f32x4){0.f, 0.f, 0.f, 0.f};
        if (FINAL) {
            for (int i = 0; i < run; ++i) {
                const float* se = Send + ((size_t)(bh * 8 + i) * 64) * 128; const float* lt = Ltot + (size_t)(bh * 8 + i) * 64;
#pragma unroll
                for (int kt = 0; kt < 4; ++kt)
#pragma unroll
                    for (int r = 0; r < 4; ++r) { const int k = 16 * kt + 4 * g + r; sacc[kt][r] = __expf(lt[k]) * sacc[kt][r] + se[(size_t)k * 128 + 16 * wave + l15]; }
            }
        }
        float ltot_acc = 0.f;
        unsigned short graw[8], kraw[8]; u32x4 vraw[2], qraw; u32x2 rraw[4];
        const int v_row = tid >> 4, v_c16 = tid & 15, q_row = tid >> 3, q_c16 = tid & 7;
        const int ycol = h * 128 + 16 * wave + 4 * g;
#define GLA_FETCH(CC) do { const size_t tf_ = (size_t)b * SEQ + (size_t)(run * 16 + (CC)) * 64; \
            _Pragma("unroll") for (int i = 0; i < 8; ++i) { const bf16_t* rp = P + (tf_ + 8 * part + i) * NP + h * 64 + kq; graw[i] = rp[PG]; kraw[i] = rp[PK]; } \
            _Pragma("unroll") for (int i = 0; i < 2; ++i) vraw[i] = *(const u32x4*)(P + (tf_ + v_row + 32 * i) * NP + PV + h * 128 + v_c16 * 8); \
            if (FINAL) { qraw = *(const u32x4*)(P + (tf_ + q_row) * NP + PQ + h * 64 + q_c16 * 8); \
                _Pragma("unroll") for (int tt = 0; tt < 4; ++tt) rraw[tt] = *(const u32x2*)(P + (tf_ + 16 * tt + l15) * NP + PR + ycol); } } while (0)
        GLA_FETCH(0);
        for (int c = 0; c < 16; ++c) {
            const size_t t0 = (size_t)b * SEQ + (size_t)(run * 16 + c) * 64;
            __syncthreads();
            float gv[8], kv[8];
#pragma unroll
            for (int i = 0; i < 8; ++i) { gv[i] = __builtin_bit_cast(float, (unsigned)graw[i] << 16); kv[i] = __builtin_bit_cast(float, (unsigned)kraw[i] << 16); }
#pragma unroll
            for (int i = 1; i < 8; ++i) gv[i] += gv[i - 1];
            ((LAS float*)(lds + GL_PSUM))[part * 64 + kq] = gv[7];
#pragma unroll
            for (int i = 0; i < 2; ++i) *(LAS u32x4*)(lds + GL_VS + (v_row + 32 * i) * 272 + v_c16 * 16) = vraw[i];
            u32x2 rcur[4];
            if (FINAL) { *(LAS u32x4*)(lds + GL_QS + q_row * 144 + q_c16 * 16) = qraw;
#pragma unroll
                for (int tt = 0; tt < 4; ++tt) rcur[tt] = rraw[tt]; }
            if (c + 1 < 16) GLA_FETCH(c + 1);
            __syncthreads();
            float offs = 0.f, bl = 0.f;
#pragma unroll
            for (int p = 0; p < 8; ++p) { const float v = ((LAS float*)(lds + GL_PSUM))[p * 64 + kq]; offs += (p < part) ? v : 0.f; bl += v; }
#pragma unroll
            for (int i = 0; i < 8; ++i) { const float kd = kv[i] * __expf(bl - (offs + gv[i]));
                *(LAS unsigned short*)(lds + GL_KD + (8 * part + i) * 144 + kq * 2) = (unsigned short)(pk2(kd, 0.f) & 0xffffu); }
            if (part == 0) ((LAS float*)(lds + GL_DL))[kq] = __expf(bl);
            ltot_acc += bl;
            __syncthreads();
#pragma unroll
            for (int kt = 0; kt < 4; ++kt) { const f32x4 dl = *(LAS f32x4*)(lds + GL_DL + (16 * kt + 4 * g) * 4); sacc[kt] = sacc[kt] * dl; }
#pragma unroll
            for (int ks = 0; ks < 2; ++ks) {
                const unsigned vrow = lb + GL_VS + (unsigned)(32 * ks + 8 * g + q4) * 272u + (unsigned)(16 * wave + 4 * p4) * 2u;
                const bf16x8 vb = cat8(vtr(vrow), vtr(vrow + 4u * 272u));
#pragma unroll
                for (int kt = 0; kt < 4; ++kt) {
                    const unsigned krow = lb + GL_KD + (unsigned)(32 * ks + 8 * g + q4) * 144u + (unsigned)(16 * kt + 4 * p4) * 2u;
                    const bf16x8 ka = cat8(vtr(krow), vtr(krow + 4u * 144u));
                    sacc[kt] = __builtin_amdgcn_mfma_f32_16x16x32_bf16(ka, vb, sacc[kt], 0, 0, 0);
                }
            }
            if (FINAL) {
                f32x4 oacc[4];
#pragma unroll
                for (int tt = 0; tt < 4; ++tt) oacc[tt] = (f32x4){0.f, 0.f, 0.f, 0.f};
#pragma unroll
                for (int ks2 = 0; ks2 < 2; ++ks2) {
                    u32x4 spw; spw.x = pk2(sacc[2 * ks2][0], sacc[2 * ks2][1]); spw.y = pk2(sacc[2 * ks2][2], sacc[2 * ks2][3]);
                    spw.z = pk2(sacc[2 * ks2 + 1][0], sacc[2 * ks2 + 1][1]); spw.w = pk2(sacc[2 * ks2 + 1][2], sacc[2 * ks2 + 1][3]);
                    const bf16x8 sp = __builtin_bit_cast(bf16x8, spw);
#pragma unroll
                    for (int tt = 0; tt < 4; ++tt) {
                        const LAS unsigned char* qp = lds + GL_QS + (16 * tt + l15) * 144 + (32 * ks2 + 4 * g) * 2;
                        const u32x2 qlo = *(const LAS u32x2*)qp, qhi = *(const LAS u32x2*)(qp + 32);
                        u32x4 qw; qw.x = qlo.x; qw.y = qlo.y; qw.z = qhi.x; qw.w = qhi.y;
                        oacc[tt] = __builtin_amdgcn_mfma_f32_16x16x32_bf16(sp, __builtin_bit_cast(bf16x8, qw), oacc[tt], 0, 0, 0);
                    }
                }
#pragma unroll
                for (int tt = 0; tt < 4; ++tt) { float s = oacc[tt][0] * oacc[tt][0] + oacc[tt][1] * oacc[tt][1] + oacc[tt][2] * oacc[tt][2] + oacc[tt][3] * oacc[tt][3];
                    s += shx(s, 16, lane); s += shx(s, 32, lane);
                    if (g == 0) ((LAS float*)(lds + GL_SSQ))[wave * 64 + 16 * tt + l15] = s; }
                __syncthreads();
                const int col = h * 128 + 16 * wave + 4 * g;
                const f32x4 gn = *(const f32x4*)(gn_g + col);
#pragma unroll
                for (int tt = 0; tt < 4; ++tt) { float tot = 0.f;
#pragma unroll
                    for (int w2 = 0; w2 < 8; ++w2) tot += ((LAS float*)(lds + GL_SSQ))[w2 * 64 + 16 * tt + l15];
                    const float rs = __builtin_amdgcn_rsqf(tot * (1.0f / 128.0f) + 1e-6f);
                    const size_t tok = t0 + 16 * tt + l15;
                    const u32x2 rr = rcur[tt];
                    const float rq = rs * pg8::F8_SM;
                    *(unsigned*)((unsigned char*)Y + tok * D + col) = pg8::pk4f8(oacc[tt][0] * rq * gn[0] * bflo(rr.x), oacc[tt][1] * rq * gn[1] * bfhi(rr.x), oacc[tt][2] * rq * gn[2] * bflo(rr.y), oacc[tt][3] * rq * gn[3] * bfhi(rr.y)); }
            }
        }
        if (!FINAL) {
            float* se = Send + ((size_t)(bh * 8 + run) * 64) * 128;
#pragma unroll
            for (int kt = 0; kt < 4; ++kt)
#pragma unroll
                for (int r = 0; r < 4; ++r) se[(size_t)(16 * kt + 4 * g + r) * 128 + 16 * wave + l15] = sacc[kt][r];
            if (part == 0) Ltot[(size_t)(bh * 8 + run) * 64 + kq] = ltot_acc;
        }
    }
}

#undef GLA_FETCH
constexpr int SG_VN = 0;
__device__ __forceinline__ void sgu_phase(LAS unsigned char* lds, const bf16_t* P, const bf16_t* Wm, const float* b_s, const float* lg, const float* lb_, bf16_t* Y, int bid, int G, int wave_s) {
    int tid_ = wave_s * 64 + pg8::lane_id(); asm volatile("" : "+v"(tid_)); const int tid = tid_, lane = tid & 63, wave = __builtin_amdgcn_readfirstlane(tid >> 6);
    const unsigned lb = (unsigned)(size_t)lds;
    const int g = lane >> 4, l15 = lane & 15, q4 = l15 >> 2, p4 = lane & 3;
    const int row = tid >> 2, qu = tid & 3;
    u32x4 vraw[4]; u32x2 uraw[8];
#define SGU_FETCH(IT) do { const int blk_ = (IT) >> 2, gr_ = (IT) & 3; const size_t tf_ = (size_t)blk_ * 128; \
        const bf16_t* src_ = P + (tf_ + row) * NP + PVS + gr_ * 128 + 32 * qu; \
        _Pragma("unroll") for (int i = 0; i < 4; ++i) vraw[i] = *(const u32x4*)(src_ + 8 * i); \
        const bf16_t* us_ = P + (tf_ + 16 * wave + l15) * NP + PU + gr_ * 128 + 4 * g; \
        _Pragma("unroll") for (int ct = 0; ct < 8; ++ct) uraw[ct] = *(const u32x2*)(us_ + 16 * ct); } while (0)
    if (bid < 2048) SGU_FETCH(bid);
    for (int item = bid; item < 2048; item += G) {
        const int blk = item >> 2, gr = item & 3; const size_t t0 = (size_t)blk * 128;
        __syncthreads();
        u32x2 ucur[8];
        { float v[32];
#pragma unroll
          for (int i = 0; i < 4; ++i) { float f[8]; unpack8(vraw[i], f);
#pragma unroll
              for (int j = 0; j < 8; ++j) v[8 * i + j] = f[j]; }
#pragma unroll
          for (int ct = 0; ct < 8; ++ct) ucur[ct] = uraw[ct];
          if (item + G < 2048) SGU_FETCH(item + G);
          float s = 0.f;
#pragma unroll
          for (int i = 0; i < 32; ++i) s += v[i];
          s += shx(s, 1, lane); s += shx(s, 2, lane);
          const float mu = s * (1.0f / 128.0f); float qq = 0.f;
#pragma unroll
          for (int i = 0; i < 32; ++i) { v[i] -= mu; qq += v[i] * v[i]; }
          qq += shx(qq, 1, lane); qq += shx(qq, 2, lane);
          const float rs = __builtin_amdgcn_rsqf(qq * (1.0f / 128.0f) + LN_EPS);
          const float* gp = lg + gr * 128 + 32 * qu; const float* bp = lb_ + gr * 128 + 32 * qu;
#pragma unroll
          for (int i = 0; i < 4; ++i) { float f[8];
#pragma unroll
              for (int j = 0; j < 8; ++j) f[j] = v[8 * i + j] * rs * gp[8 * i + j] + bp[8 * i + j];
              *(LAS u32x4*)(lds + SG_VN + row * 272 + (32 * qu + 8 * i) * 2) = pack8(f); }
        }
        __syncthreads();
        const int nks = (wave < 4) ? 2 : 4;
        bf16x8 wf[4];
#pragma unroll
        for (int ks = 0; ks < 4; ++ks) wf[ks] = *(const bf16x8*)(Wm + ((size_t)(gr * 128 + 16 * wave + l15)) * 128 + 32 * ks + 8 * g);
        const size_t tok = t0 + 16 * wave + l15; const float bs = b_s[gr * 128 + 16 * wave + l15];
        unsigned vb0 = lb + SG_VN + (unsigned)(8 * g + q4) * 272u + (unsigned)(4 * p4) * 2u; asm volatile("" : "+v"(vb0));
#pragma unroll
        for (int ct = 0; ct < 8; ++ct) {
            f32x4 acc = (f32x4){0.f, 0.f, 0.f, 0.f};
#pragma unroll
            for (int ks = 0; ks < 4; ++ks) {
                if (ks < nks) {
                    const unsigned vrow = vb0 + (unsigned)(32 * ks * 272 + 32 * ct);
                    const bf16x8 va = cat8(vtr(vrow), vtr(vrow + 4u * 272u));
                    acc = __builtin_amdgcn_mfma_f32_16x16x32_bf16(va, wf[ks], acc, 0, 0, 0);
                }
            }
            const int col = gr * 128 + 16 * ct + 4 * g;
            const u32x2 uu = ucur[ct];
            *(unsigned*)((unsigned char*)Y + tok * D + 512 + col) = pg8::pk4f8(bflo(uu.x) * (acc[0] + bs) * pg8::F8_SM, bfhi(uu.x) * (acc[1] + bs) * pg8::F8_SM, bflo(uu.y) * (acc[2] + bs) * pg8::F8_SM, bfhi(uu.y) * (acc[3] + bs) * pg8::F8_SM);
        }
    }
}
#undef SGU_FETCH

constexpr int AT_KPS = 1040, AT_VPS = 1088, AT_SLOT = 34816, AT_NSLOT = 3;
static_assert(AT_NSLOT * AT_SLOT <= LDSCTL_OFF, "attention LDS");
__device__ __forceinline__ void glds16(const void* gsrc, unsigned lds_dst) { unsigned keep;
    asm volatile("s_mov_b32 %0, m0\n\ts_mov_b32 m0, %2\n\ts_nop 0\n\tglobal_load_lds_dwordx4 %1, off\n\ts_mov_b32 m0, %0" : "=&s"(keep) : "v"(gsrc), "s"(lds_dst) : "memory"); }
__device__ __forceinline__ void attn_dma(unsigned lb, const char* kvb, int so, unsigned lane_off, int slot, int ps, int wave) {
#pragma unroll
    for (int j = 0; j < 4; ++j) { const int pi = 4 * wave + j, rlo = 32 * (pi >> 4) + (pi & 15);
        glds16(kvb + (size_t)(so + rlo * 8192) + lane_off, (unsigned)__builtin_amdgcn_readfirstlane((int)(lb + (unsigned)(slot * AT_SLOT + pi * ps)))); }
}
#define AT_WAITBAR(N) do { asm volatile("s_waitcnt vmcnt(" #N ") lgkmcnt(0)" ::: "memory"); __builtin_amdgcn_s_barrier(); asm volatile("" ::: "memory"); } while (0)
__device__ __forceinline__ void attn_phase(LAS unsigned char* lds, const bf16_t* Q, const bf16_t* KV, bf16_t* O, int layer, int bid, int G, int wave_s) {
    int tid_ = wave_s * 64 + pg8::lane_id(); asm volatile("" : "+v"(tid_)); const int tid = tid_, lane = tid & 63, wave = __builtin_amdgcn_readfirstlane(tid >> 6);
    const unsigned lb = (unsigned)(size_t)lds;
    const int r32 = lane & 31, hh = lane >> 5, q4 = (lane & 15) >> 2, p4 = lane & 3, blk = (lane >> 4) & 1;
    LAS unsigned char* kbase = lds + (r32 & 15) * AT_KPS + ((r32 >> 4) & 1) * 512 + hh * 16;
    unsigned vbase = lb + (unsigned)(4 * hh + q4) * (unsigned)AT_VPS + (unsigned)(16 * blk + 4 * p4) * 2u;
    unsigned lane_off = (unsigned)((lane >> 5) * 16 * 8192 + (lane & 31) * 16);
    asm volatile("" : "+v"(kbase), "+v"(vbase), "+v"(lane_off));
    const char* kvb = (const char*)KV;
    const int nun = (bid < 256) ? 4 * ((256 - bid + G - 1) / G) : 0;
#define AT_SRC(N, ST) ((int)((((size_t)(((bid + ((N) >> 2) * G) >> 5) * NMEM) * 4096 + layer * 2048 + ((N) & 3) * 256 + (((ST) >> 2) * 1024)) * 2) + ((ST) & 3) * 64 * 8192))
    __syncthreads();
    if (nun > 0) { attn_dma(lb, kvb, AT_SRC(0, 0), lane_off, 0, AT_KPS, wave); attn_dma(lb, kvb, AT_SRC(0, 1), lane_off, 1, AT_KPS, wave); AT_WAITBAR(4); }
    int sl = 0;
    for (int n = 0; n < nun; ++n) {
        const int pan = bid + (n >> 2) * G, h = n & 3, b = pan >> 5, qt = pan & 31;
        int ln_ = pg8::lane_id(); asm volatile("" : "+v"(ln_));
        const unsigned qoff = (unsigned)((wave * 8 * 64 + ln_) * 16);
        const char* qbase = (const char*)Q + (size_t)(pan * 4 + h) * 65536;
        char* obase = (char*)O + ((size_t)b * SEQ + qt * 256) * D + h * 256;
        const bool more = (n + 1 < nun);
        bf16x8 qf[16];
#pragma unroll
        for (int s = 0; s < 8; ++s) { const u32x4 raw = *(const GAS u32x4*)(qbase + qoff + 1024 * s); float f[8]; u32x2 h8;
            h8.x = raw.x; h8.y = raw.y; unpack8f8(h8, f);
#pragma unroll
            for (int i = 0; i < 8; ++i) f[i] *= (1.0f / pg8::F8_SQ);
            qf[s] = __builtin_bit_cast(bf16x8, pack8(f));
            h8.x = raw.z; h8.y = raw.w; unpack8f8(h8, f);
#pragma unroll
            for (int i = 0; i < 8; ++i) f[i] *= (1.0f / pg8::F8_SQ);
            qf[s + 8] = __builtin_bit_cast(bf16x8, pack8(f)); }
        float ml = 0.f, lsum = 0.f;
        bf16x8 pk[8][2];
#pragma unroll
        for (int st = 0; st < 4; ++st) {
            const int sl2 = (sl >= 1) ? sl - 1 : 2;
            if (st > 0) attn_dma(lb, kvb, AT_SRC(n, st + 2), lane_off, sl2, (st + 2 < 4) ? AT_KPS : AT_VPS, wave);
            LAS unsigned char* kb = kbase + sl * AT_SLOT;
            f32x16 sa[2];
#pragma unroll
            for (int kt = 0; kt < 2; ++kt)
#pragma unroll
                for (int r = 0; r < 16; ++r) sa[kt][r] = 0.f;
            bf16x8 kfa[2], kfb[2];
#define AT_KLD(dst, S0) do { _Pragma("unroll") for (int kt = 0; kt < 2; ++kt) dst[kt] = *(const LAS bf16x8*)(kb + kt * 16 * AT_KPS + 32 * (S0)); } while (0)
#define AT_KMM(src, S0) do { _Pragma("unroll") for (int kt = 0; kt < 2; ++kt) sa[kt] = __builtin_amdgcn_mfma_f32_32x32x16_bf16(src[kt], qf[(S0)], sa[kt], 0, 0, 0); } while (0)
            AT_KLD(kfa, 0); __builtin_amdgcn_sched_barrier(0);
#pragma unroll
            for (int bq = 0; bq < 8; ++bq) {
                AT_KLD(kfb, 2 * bq + 1); __builtin_amdgcn_sched_barrier(0);
                AT_KMM(kfa, 2 * bq); __builtin_amdgcn_sched_barrier(0);
                if (bq < 7) { AT_KLD(kfa, 2 * bq + 2); __builtin_amdgcn_sched_barrier(0); }
                AT_KMM(kfb, 2 * bq + 1); __builtin_amdgcn_sched_barrier(0);
            }
#undef AT_KLD
#undef AT_KMM
            if (st == 0) attn_dma(lb, kvb, AT_SRC(n, 2), lane_off, sl2, AT_KPS, wave);
            if (st == 0) { float mx = -3.0e38f;
#pragma unroll
                for (int kt = 0; kt < 2; ++kt)
#pragma unroll
                    for (int r = 0; r < 16; ++r) mx = __builtin_fmaxf(mx, sa[kt][r]);
                mx = __builtin_fmaxf(mx, shx(mx, 32, lane)); ml = mx * LOG2E; }
#pragma unroll
            for (int kt = 0; kt < 2; ++kt) {
                float p[16];
#pragma unroll
                for (int r = 0; r < 16; ++r) { p[r] = __builtin_amdgcn_exp2f(sa[kt][r] * LOG2E - ml); lsum += p[r]; }
#pragma unroll
                for (int s2 = 0; s2 < 2; ++s2) { u32x4 w; w.x = pk2(p[8 * s2 + 0], p[8 * s2 + 1]); w.y = pk2(p[8 * s2 + 2], p[8 * s2 + 3]); w.z = pk2(p[8 * s2 + 4], p[8 * s2 + 5]); w.w = pk2(p[8 * s2 + 6], p[8 * s2 + 7]);
                    pk[2 * st + kt][s2] = __builtin_bit_cast(bf16x8, w); }
            }
            AT_WAITBAR(4);
            sl = (sl == 2) ? 0 : sl + 1;
        }
        lsum += shx(lsum, 32, lane);
        f32x16 oacc[8];
#pragma unroll
        for (int dt = 0; dt < 8; ++dt)
#pragma unroll
            for (int r = 0; r < 16; ++r) oacc[dt][r] = 0.f;
#pragma unroll
        for (int st = 4; st < 8; ++st) {
            const bool issue = (st < 6) || more;
            if (issue) { const int s2 = (sl >= 1) ? sl - 1 : 2;
                if (st < 6) attn_dma(lb, kvb, AT_SRC(n, st + 2), lane_off, s2, AT_VPS, wave); else attn_dma(lb, kvb, AT_SRC(n + 1, st - 6), lane_off, s2, AT_KPS, wave); }
            const unsigned vb = vbase + (unsigned)(sl * AT_SLOT);
            bf16x8 vfa[2], vfb[2];
#define AT_VLD(dst, BT) do { const unsigned va_ = vb + (unsigned)((((BT) >> 3) & 1) * 16 * AT_VPS + (((BT) >> 2) & 1) * 512 + ((BT) & 3) * 128); \
                _Pragma("unroll") for (int d_ = 0; d_ < 2; ++d_) dst[d_] = cat8(vtr(va_ + 64u * d_), vtr(va_ + 64u * d_ + 8u * AT_VPS)); } while (0)
#define AT_VMM(src, BT) do { _Pragma("unroll") for (int d_ = 0; d_ < 2; ++d_) oacc[2 * ((BT) & 3) + d_] = __builtin_amdgcn_mfma_f32_32x32x16_bf16(src[d_], pk[2 * (st - 4) + (((BT) >> 3) & 1)][((BT) >> 2) & 1], oacc[2 * ((BT) & 3) + d_], 0, 0, 0); } while (0)
            AT_VLD(vfa, 0); __builtin_amdgcn_sched_barrier(0);
#pragma unroll
            for (int bq = 0; bq < 8; ++bq) {
                AT_VLD(vfb, 2 * bq + 1); __builtin_amdgcn_sched_barrier(0);
                AT_VMM(vfa, 2 * bq); __builtin_amdgcn_sched_barrier(0);
                if (bq < 7) { AT_VLD(vfa, 2 * bq + 2); __builtin_amdgcn_sched_barrier(0); }
                AT_VMM(vfb, 2 * bq + 1); __builtin_amdgcn_sched_barrier(0);
            }
#undef AT_VLD
#undef AT_VMM
            if (issue) AT_WAITBAR(4); else AT_WAITBAR(0);
            sl = (sl == 2) ? 0 : sl + 1;
        }
        const float inv = 1.0f / lsum;
        int ln2 = pg8::lane_id(); asm volatile("" : "+v"(ln2));
        GAS char* op = (GAS char*)obase + (unsigned)((wave * 32 + (ln2 & 31)) * D) + ((ln2 >> 5) ? 16 : 0);
        const float sc = inv * pg8::F8_SO;
#pragma unroll
        for (int dt = 0; dt < 8; ++dt) {
            unsigned dw[4];
#pragma unroll
            for (int g4 = 0; g4 < 4; ++g4) dw[g4] = pg8::pk4f8(oacc[dt][4 * g4 + 0] * sc, oacc[dt][4 * g4 + 1] * sc, oacc[dt][4 * g4 + 2] * sc, oacc[dt][4 * g4 + 3] * sc);
            { const auto r = __builtin_amdgcn_permlane32_swap(dw[0], dw[2], false, false); dw[0] = r[0]; dw[2] = r[1]; }
            { const auto r = __builtin_amdgcn_permlane32_swap(dw[1], dw[3], false, false); dw[1] = r[0]; dw[3] = r[1]; }
            u32x4 w; w.x = dw[0]; w.y = dw[2]; w.z = dw[1]; w.w = dw[3];
            *(GAS u32x4*)(op + 32 * dt) = w; }
    }
    asm volatile("s_waitcnt vmcnt(0)" ::: "memory");
    __syncthreads();
}
#undef AT_SRC
#undef AT_WAITBAR

constexpr int RT_WH = 0, RT_WL = 32768, RT_SEL = 65536, RT_RK = 66048, RT_CNTW = 67072, RT_WBASE = 67584, RT_CS = 68608, RT_BB = 68672, RT_PART = 68736;
template <int MODE>
__device__ __forceinline__ void ln_phase(LAS unsigned char* lds, const Args& a, int l, int lnidx, bool last, bf16_t* Xout, int bid, int G, int wave_s) {
    int tid_ = wave_s * 64 + pg8::lane_id(); asm volatile("" : "+v"(tid_)); const int tid = tid_, lane = tid & 63, wave = __builtin_amdgcn_readfirstlane(tid >> 6);
    constexpr int R = (MODE == 2) ? 2 : 4;
    unsigned char* ws = a.ws;
    const bf16_t* Z = (const bf16_t*)(ws + WS_R + R_Z); const unsigned char* Ys8 = ws + WS_R + R_XS;
    pg8::f32x2_t* stats1 = (pg8::f32x2_t*)(ws + WS_STATS);
    const float* gp = a.in[20] + (size_t)(l * 3 + lnidx) * D; const float* bp = a.in[21] + (size_t)(l * 3 + lnidx) * D;
    float gg[16], bb[16];
#pragma unroll
    for (int j = 0; j < 2; ++j)
#pragma unroll
        for (int i = 0; i < 8; ++i) { gg[8 * j + i] = gp[8 * lane + 512 * j + i]; bb[8 * j + i] = bp[8 * lane + 512 * j + i]; }
    float g1v[16], b1v[16];
    if (MODE == 2) { const float* gq = a.in[20] + (size_t)(l * 3 + 1) * D; const float* bq_ = a.in[21] + (size_t)(l * 3 + 1) * D;
#pragma unroll
        for (int j = 0; j < 2; ++j)
#pragma unroll
            for (int i = 0; i < 8; ++i) { g1v[8 * j + i] = gq[8 * lane + 512 * j + i]; b1v[8 * j + i] = bq_[8 * lane + 512 * j + i]; } }
    if (MODE == 1) {
        __syncthreads();
        for (int idx = tid; idx < 2048; idx += NTHR) { const int s = idx >> 6, ln = idx & 63, e = ln & 15, g = ln >> 4; float hi[8], lo[8];
#pragma unroll
            for (int j = 0; j < 8; ++j) { const float w = a.in[15][(32 * s + 8 * g + j) * 16 + e] * gp[32 * s + 8 * g + j]; const float h = bflo(pk2(w, 0.f) & 0xffffu); hi[j] = h; lo[j] = w - h; }
            *(LAS u32x4*)(lds + RT_WH + idx * 16) = pack8(hi); *(LAS u32x4*)(lds + RT_WL + idx * 16) = pack8(lo); }
        { const int e = tid & 15, kp = tid >> 4; float cs = 0.f, bs = 0.f;
          for (int k = 32 * kp; k < 32 * kp + 32; ++k) { const float wr = a.in[15][k * 16 + e]; const float w = wr * gp[k]; const float h = bflo(pk2(w, 0.f) & 0xffffu); const float lo2 = bflo(pk2(w - h, 0.f) & 0xffffu); cs += h + lo2; bs += bp[k] * wr; }
          ((LAS float*)(lds + RT_PART))[kp * 32 + e] = cs; ((LAS float*)(lds + RT_PART))[kp * 32 + 16 + e] = bs; }
        __syncthreads();
        if (tid < 32) { float t = 0.f; for (int kp = 0; kp < 32; ++kp) t += ((LAS float*)(lds + RT_PART))[kp * 32 + tid];
            if (tid < 16) ((LAS float*)(lds + RT_CS))[tid] = t; else ((LAS float*)(lds + RT_BB))[tid - 16] = t + a.in[16][tid - 16]; }
        __syncthreads();
    }
    for (int blk = bid; blk < 256; blk += G) {
        int run[16];
#pragma unroll
        for (int e = 0; e < 16; ++e) run[e] = 0;
        u32x4 pa_[R][2]; u32x2 pb_[R][2], pc_[R][2]; float pw0[R], pw1[R]; pg8::f32x2_t pst[R];
#define LN_LOAD(ROW0) do { _Pragma("unroll") for (int r = 0; r < R; ++r) { const size_t row = (ROW0) + r; \
            if (MODE == 2) { const int* ts = (const int*)(ws + WS_TSLOT) + row * 2; const float* ti = (const float*)(ws + WS_TINFO) + row * 4; const int s0 = ts[0], s1 = ts[1]; pw0[r] = ti[2]; pw1[r] = ti[3]; pst[r] = stats1[row]; \
                _Pragma("unroll") for (int j = 0; j < 2; ++j) { pa_[r][j] = *(const u32x4*)(Z + row * D + 8 * lane + 512 * j); pb_[r][j] = *(const u32x2*)(Ys8 + (size_t)s0 * D + 8 * lane + 512 * j); pc_[r][j] = *(const u32x2*)(Ys8 + (size_t)s1 * D + 8 * lane + 512 * j); } } \
            else { _Pragma("unroll") for (int j = 0; j < 2; ++j) pa_[r][j] = *(const u32x4*)(Z + row * D + 8 * lane + 512 * j); } } } while (0)
        float mu_t = 0.f, rs_t = 0.f;
        LN_LOAD((size_t)blk * 256 + wave * 32);
        for (int ri = 0; ri < 32; ri += R) {
            const int rl0 = wave * 32 + ri; const size_t row0 = (size_t)blk * 256 + rl0;
            float v[R][16];
#pragma unroll
            for (int r = 0; r < R; ++r)
#pragma unroll
                for (int j = 0; j < 2; ++j) { float x[8]; unpack8(pa_[r][j], x);
                    if (MODE == 2) { float y0[8], y1[8]; unpack8f8(pb_[r][j], y0); unpack8f8(pc_[r][j], y1); const float mu1 = pst[r][0], rs1 = pst[r][1];
#pragma unroll
                        for (int i = 0; i < 8; ++i) v[r][8 * j + i] = ALPHA * ((x[i] - mu1) * rs1 * g1v[8 * j + i] + b1v[8 * j + i]) + (pw0[r] * (1.0f / pg8::F8_SY)) * y0[i] + (pw1[r] * (1.0f / pg8::F8_SY)) * y1[i]; }
                    else {
#pragma unroll
                        for (int i = 0; i < 8; ++i) v[r][8 * j + i] = x[i]; } }
            if (ri + R < 32) LN_LOAD(row0 + R);
            float s[R];
#pragma unroll
            for (int r = 0; r < R; ++r) { s[r] = 0.f;
#pragma unroll
                for (int i = 0; i < 16; ++i) s[r] += v[r][i]; }
#pragma unroll
            for (int o = 1; o < 64; o <<= 1)
#pragma unroll
                for (int r = 0; r < R; ++r) s[r] += shx(s[r], o, lane);
            float qq[R], mur[R];
#pragma unroll
            for (int r = 0; r < R; ++r) { const float mu = s[r] * (1.0f / D); mur[r] = mu; qq[r] = 0.f;
#pragma unroll
                for (int i = 0; i < 16; ++i) { v[r][i] -= mu; qq[r] += v[r][i] * v[r][i]; } }
#pragma unroll
            for (int o = 1; o < 64; o <<= 1)
#pragma unroll
                for (int r = 0; r < R; ++r) qq[r] += shx(qq[r], o, lane);
#pragma unroll
            for (int r = 0; r < R; ++r) { const float rs = __builtin_amdgcn_rsqf(qq[r] * (1.0f / D) + LN_EPS);
                if (MODE == 1) { if (lane == 0) stats1[row0 + r] = (pg8::f32x2_t){mur[r], rs};
                    if ((lane & 15) == ((ri + r) & 15)) { mu_t = mur[r]; rs_t = rs; } }
#pragma unroll
                for (int i = 0; i < 16; ++i) v[r][i] = v[r][i] * rs * gg[i] + bb[i]; }
#pragma unroll
            for (int r = 0; r < R; ++r) { const size_t row = row0 + r;
                if (MODE == 2 && last) {
#pragma unroll
                    for (int j = 0; j < 2; ++j) { float* op = a.out + row * D + 8 * lane + 512 * j;
                        *(f32x4*)op = (f32x4){v[r][8 * j], v[r][8 * j + 1], v[r][8 * j + 2], v[r][8 * j + 3]}; *(f32x4*)(op + 4) = (f32x4){v[r][8 * j + 4], v[r][8 * j + 5], v[r][8 * j + 6], v[r][8 * j + 7]}; }
                } else {
#pragma unroll
                    for (int j = 0; j < 2; ++j) { float f[8];
#pragma unroll
                        for (int i = 0; i < 8; ++i) f[i] = v[r][8 * j + i];
                        if (MODE != 1) *(u32x4*)(Xout + row * D + 8 * lane + 512 * j) = pack8(f);
                        if (MODE == 1 || MODE == 2) { u32x2 q8; q8.x = pg8::pk4f8(f[0] * pg8::F8_SX, f[1] * pg8::F8_SX, f[2] * pg8::F8_SX, f[3] * pg8::F8_SX); q8.y = pg8::pk4f8(f[4] * pg8::F8_SX, f[5] * pg8::F8_SX, f[6] * pg8::F8_SX, f[7] * pg8::F8_SX);
                            *(u32x2*)(ws + (MODE == 1 ? WS_R + R_X8 : WS_X8IN) + row * D + 8 * lane + 512 * j) = q8; } }
                } }
            if (MODE == 1 && ((ri + R) & 15) == 0) {
                const int tok = lane & 15, g = lane >> 4, tl = rl0 + R - 16 + tok; const size_t token = (size_t)blk * 256 + tl;
                const bf16_t* xr = Z + token * D + 8 * g;
                f32x4 acc = (f32x4){0.f, 0.f, 0.f, 0.f};
#pragma unroll 8
                for (int ks = 0; ks < 32; ++ks) { const bf16x8 xb = *(const bf16x8*)(xr + 32 * ks);
                    const bf16x8 wh = *(const LAS bf16x8*)(lds + RT_WH + (ks * 64 + lane) * 16), wl = *(const LAS bf16x8*)(lds + RT_WL + (ks * 64 + lane) * 16);
                    acc = __builtin_amdgcn_mfma_f32_16x16x32_bf16(wh, xb, acc, 0, 0, 0); acc = __builtin_amdgcn_mfma_f32_16x16x32_bf16(wl, xb, acc, 0, 0, 0); }
                const f32x4 csv = *(const LAS f32x4*)(lds + RT_CS + 16 * g), bbv = *(const LAS f32x4*)(lds + RT_BB + 16 * g);
                float lg[4] = {rs_t * (acc[0] - mu_t * csv[0]) + bbv[0], rs_t * (acc[1] - mu_t * csv[1]) + bbv[1], rs_t * (acc[2] - mu_t * csv[2]) + bbv[2], rs_t * (acc[3] - mu_t * csv[3]) + bbv[3]};
                float m = __builtin_fmaxf(__builtin_fmaxf(lg[0], lg[1]), __builtin_fmaxf(lg[2], lg[3]));
                m = __builtin_fmaxf(m, shx(m, 16, lane)); m = __builtin_fmaxf(m, shx(m, 32, lane));
                float t1 = -1.f, t2 = -1.f; int i1 = 0, i2 = 0;
#pragma unroll
                for (int r = 0; r < 4; ++r) { const float p = __expf(lg[r] - m); if (p > t1) { t2 = t1; i2 = i1; t1 = p; i1 = r; } else if (p > t2) { t2 = p; i2 = r; } }
                const float gs = t1 + t2; float bgs = gs; int bg = g;
                { const float o = shx(bgs, 16, lane); const int og = shxi(bg, 16, lane); if (o > bgs || (o == bgs && og < bg)) { bgs = o; bg = og; } }
                { const float o = shx(bgs, 32, lane); const int og = shxi(bg, 32, lane); if (o > bgs || (o == bgs && og < bg)) { bgs = o; bg = og; } }
                const bool mine = (bg == g); const int e0 = 4 * g + i1, e1 = 4 * g + i2;
                if (mine) { u32x4 info; info.x = (unsigned)e0; info.y = (unsigned)e1; info.z = __builtin_bit_cast(unsigned, t1 / gs); info.w = __builtin_bit_cast(unsigned, t2 / gs);
                    *(u32x4*)(ws + WS_TINFO + token * 16) = info; ((LAS unsigned short*)(lds + RT_SEL))[tl] = (unsigned short)(e0 | (e1 << 8)); }
                const unsigned long long below = (1ull << lane) - 1ull; int r0 = 0, r1 = 0;
#pragma unroll
                for (int e = 0; e < 16; ++e) { const bool hit = mine && (e0 == e || e1 == e); const unsigned long long mb = __ballot(hit); const int cb = __popcll(mb & below);
                    r0 = (e0 == e) ? run[e] + cb : r0; r1 = (e1 == e) ? run[e] + cb : r1; run[e] += __popcll(mb); }
                if (mine) { ((LAS unsigned short*)(lds + RT_RK))[2 * tl] = (unsigned short)r0; ((LAS unsigned short*)(lds + RT_RK))[2 * tl + 1] = (unsigned short)r1; }
            }
        }
        if (MODE == 1) {
            { int vsel = 0;
#pragma unroll
              for (int e = 0; e < 16; ++e) vsel = (lane == e) ? run[e] : vsel;
              if (lane < 16) ((LAS int*)(lds + RT_CNTW))[wave * 16 + lane] = vsel; }
            __syncthreads();
            if (tid < 16) { int base = 0;
#pragma unroll
                for (int w = 0; w < 8; ++w) { const int t = ((LAS int*)(lds + RT_CNTW))[w * 16 + tid]; ((LAS int*)(lds + RT_WBASE))[w * 16 + tid] = base; base += t; }
                ((int*)(ws + WS_WGCNT))[blk * 16 + tid] = base; }
            __syncthreads();
            { const int t = tid >> 1, k = tid & 1; const int e = (((LAS unsigned short*)(lds + RT_SEL))[t] >> (8 * k)) & 255;
              ((int*)(ws + WS_TRANK))[(size_t)blk * 512 + tid] = (int)((LAS unsigned short*)(lds + RT_RK))[tid] + ((LAS int*)(lds + RT_WBASE))[(t >> 5) * 16 + e]; }
            __syncthreads();
        }
    }
}

#undef LN_LOAD
constexpr int MG_TBL = 0, MG_TOT = 16384, MG_PRE = 16448, MG_BASE = 16512;
__device__ __forceinline__ void moe_gather_phase(LAS unsigned char* lds, unsigned char* ws, int bid, int G, int wave_s) {
    int tid_ = wave_s * 64 + pg8::lane_id(); asm volatile("" : "+v"(tid_)); const int tid = tid_, lane = tid & 63, wave = __builtin_amdgcn_readfirstlane(tid >> 6);
    LAS int* tbl = (LAS int*)(lds + MG_TBL); LAS int* tot = (LAS int*)(lds + MG_TOT); LAS int* pre = (LAS int*)(lds + MG_PRE); LAS int* base = (LAS int*)(lds + MG_BASE);
    LAS int* offs = (LAS int*)(lds + MISC_OFF) + 16; LAS int* tile_e = (LAS int*)(lds + TILEE_OFF);
    const bf16_t* X = (const bf16_t*)(ws + WS_X); bf16_t* Xs = (bf16_t*)(ws + WS_R + R_XS);
    for (int blk = bid; blk < 256; blk += G) {
        __syncthreads();
        for (int i = tid; i < 4096; i += NTHR) tbl[i] = ((const int*)(ws + WS_WGCNT))[i];
        __syncthreads();
        if (tid < 16) { int t = 0, p = 0; for (int c = 0; c < 256; ++c) { const int v = tbl[c * 16 + tid]; p += (c < blk) ? v : 0; t += v; } tot[tid] = t; pre[tid] = p; }
        __syncthreads();
        if (tid == 0) { int o = 0; for (int e = 0; e < 16; ++e) { offs[e] = o; base[e] = o + pre[e]; o += (tot[e] + 255) & ~255; } offs[16] = o; offs[17] = o >> 8; }
        __syncthreads();
        for (int rt = tid; rt < 528; rt += NTHR) { int e = 0;
#pragma unroll
            for (int q = 1; q < 16; ++q) e = (rt * 256 >= offs[q]) ? q : e;
            tile_e[rt] = e; }
        { const size_t tok = (size_t)blk * 256 + (tid >> 1); const int k = tid & 1;
          const int e = ((const int*)(ws + WS_TINFO))[tok * 4 + k]; const int rk = ((const int*)(ws + WS_TRANK))[tok * 2 + k];
          const int slot = base[e] + rk;
          ((int*)(ws + WS_TSLOT))[tok * 2 + k] = slot; ((int*)(ws + WS_SRCROW))[slot] = (int)tok; }
        for (int e = wave; e < 16; e += NWAVES) { const int npad = offs[e + 1] - offs[e] - tot[e];
            if (blk < npad && lane == 0) ((int*)(ws + WS_SRCROW))[offs[e] + tot[e] + blk] = 0; }
    }
}

#define GEMM_ALIGN true
#define GEMM_SP2 true
__global__ void __launch_bounds__(NTHR, 2) mk_fwd(Args args) {
    extern __shared__ __attribute__((aligned(16))) unsigned char lds_raw[];
    LAS unsigned char* lds = (LAS unsigned char*)lds_raw;
    const int tid = threadIdx.x; const int wave_s = __builtin_amdgcn_readfirstlane(tid >> 6);
    const int G = gridDim.x, bid = blockIdx.x;
    unsigned char* ws = args.ws;
    volatile LAS unsigned* MISC = (volatile LAS unsigned*)(lds + MISC_OFF);
    for (int u = tid; u < (LDS_BYTES - LDSCTL_OFF) / 4; u += NTHR) ((LAS unsigned*)(lds + LDSCTL_OFF))[u] = 0u;
    __syncthreads();
    XcdBarrier bar = xcd_barrier_post((unsigned*)(ws + WS_CTL) + CW_BAR, MISC + 8);
    bar.wv = wave_s;
#define GRID_BAR() xcd_barrier(bar)
#ifndef REP_MASK
#define REP_MASK 0
#endif
#define LOCAL_SYNC() do { asm volatile("s_waitcnt vmcnt(0)" ::: "memory"); __syncthreads(); } while (0)
#define PHASE(grp, ...) do { __VA_ARGS__; if (REP_MASK & (1 << (grp))) { GRID_BAR(); __VA_ARGS__; } } while (0)

#define WSQ ({ unsigned char* w_ = args.ws; asm volatile("" : "+s"(w_)); w_; })
#define X ((bf16_t*)(WSQ + WS_X))
#define P ((bf16_t*)(WSQ + WS_R + R_P))
#define Y ((bf16_t*)(WSQ + WS_R + R_Y))
#define Z ((bf16_t*)(WSQ + WS_R + R_Z))
#define Qb ((bf16_t*)(WSQ + WS_R + R_Q))
#define Ob ((bf16_t*)(WSQ + WS_R + R_O))
#define Xs ((bf16_t*)(WSQ + WS_R + R_XS))
#define Hb ((bf16_t*)(WSQ + WS_R + R_H))
#define KV ((bf16_t*)(WSQ + WS_KV))
#define wl (WSQ + WS_W + (size_t)l * W_LAYER)

    PHASE(0, p0_convert(args, lds, bid, G, wave_s));
    GRID_BAR();
    { const int tid_r = wave_s * 64 + pg8::lane_id();
      for (int i = bid * NTHR + tid_r; i < 2 * 2 * 1024; i += G * NTHR) { const int l = i >> 11, w = (i >> 10) & 1, n = i & 1023; const float* tb = (const float*)(WSQ + WS_CS) + (size_t)l * 2 * 16 * 1024 + w * 16 * 1024; float s = 0.f;
#pragma unroll
          for (int kc = 0; kc < 16; ++kc) s += tb[kc * 1024 + n];
          ((float*)(WSQ + WS_CS) + 65536)[i] = s; } }
    PHASE(1, { pg8::Gemm g{(const bf16_t*)(WSQ + WS_MEMB), (const bf16_t*)(WSQ + WS_WKV), MKV, 4096, D, wave_s}; pg8::StaticOrder S; S.init(MKV, 4096, G, bid);
      pg8::EpiPlain E{KV, 4096, 0xffff};
      pg8::gemm_phase<pg8::EpiPlain, pg8::StaticOrder, GEMM_ALIGN, GEMM_SP2>(lds, g, S, E); });

#pragma unroll 1
    for (int l = 0; l < 2; ++l) {
        PHASE(1, { pg8::Gemm g{(const bf16_t*)(WSQ + WS_X8IN), (const bf16_t*)(wl + W_IN), M, NP, D / 2, wave_s}; pg8::StaticOrder S; S.init(M, NP, G, bid);
          pg8::EpiInProj8 E{P, args.in[4] + l * 256};
          pg8::gemm_phase<pg8::EpiInProj8, pg8::StaticOrder, GEMM_ALIGN, GEMM_SP2>(lds, g, S, E); });
        GRID_BAR();
        PHASE(3, gla_phase<false>(lds, P, (float*)(WSQ + WS_SEND), (float*)(WSQ + WS_LTOT), Y, args.in[5] + l * 512, bid, G, wave_s));
        PHASE(4, sgu_phase(lds, P, (const bf16_t*)(WSQ + WS_WM) + (size_t)l * 4 * 128 * 128, args.in[7] + l * 512, args.in[8] + l * 512, args.in[9] + l * 512, Y, bid, G, wave_s));
        GRID_BAR();
        PHASE(3, gla_phase<true>(lds, P, (float*)(WSQ + WS_SEND), (float*)(WSQ + WS_LTOT), Y, args.in[5] + l * 512, bid, G, wave_s));
        GRID_BAR();
        PHASE(10, { pg8::Gemm g{Y, (const bf16_t*)(wl + W_OUT), M, D, D / 2, wave_s}; pg8::PanelOrder S{4, M / 256, G, bid};
          pg8::EpiResidStats8 E{X, Z, (pg8::f32x2_t*)(WSQ + WS_PART)};
          pg8::gemm_phase<pg8::EpiResidStats8, pg8::PanelOrder, GEMM_ALIGN, GEMM_SP2>(lds, g, S, E); });
        { const int tid_r = wave_s * 64 + pg8::lane_id();
          for (int pan = bid; pan < 256; pan += G) if (tid_r < 256) { const size_t row = (size_t)pan * 256 + tid_r; const pg8::f32x2_t* pp = (const pg8::f32x2_t*)(WSQ + WS_PART) + row * 16; float s1 = 0.f, s2 = 0.f;
#pragma unroll
              for (int q = 0; q < 16; ++q) { const pg8::f32x2_t v = pp[q]; s1 += v[0]; s2 += v[1]; }
              const float mu = s1 * (1.0f / D), var = s2 * (1.0f / D) - mu * mu; ((pg8::f32x2_t*)(WSQ + WS_STATS))[row] = (pg8::f32x2_t){mu, __builtin_amdgcn_rsqf(var + LN_EPS)}; } }
        LOCAL_SYNC();
        PHASE(10, { pg8::Gemm g{Z, (const bf16_t*)(wl + W_Q), M, D, D, wave_s}; pg8::PanelOrder S{4, M / 256, G, bid};
          pg8::EpiQFragLN E{(unsigned char*)Qb, (const pg8::f32x2_t*)(WSQ + WS_STATS), (const float*)(WSQ + WS_CS) + 65536 + l * 2048, (const float*)(WSQ + WS_CS) + 65536 + l * 2048 + 1024};
          pg8::gemm_phase<pg8::EpiQFragLN, pg8::PanelOrder, GEMM_ALIGN, GEMM_SP2>(lds, g, S, E); });
        PHASE(5, attn_phase(lds, Qb, KV, Ob, l, bid, G, wave_s));
        LOCAL_SYNC();
        PHASE(10, { pg8::Gemm g{Ob, (const bf16_t*)(wl + W_O), M, D, D / 2, wave_s}; pg8::PanelOrder S{4, M / 256, G, bid};
          pg8::EpiResidLN8 E{Z, (const pg8::f32x2_t*)(WSQ + WS_STATS), args.in[20] + (size_t)(l * 3) * D, args.in[21] + (size_t)(l * 3) * D};
          pg8::gemm_phase<pg8::EpiResidLN8, pg8::PanelOrder, GEMM_ALIGN, GEMM_SP2>(lds, g, S, E); });
        PHASE(9, ln_phase<1>(lds, args, l, 1, false, X, bid, G, wave_s));
        GRID_BAR();
        PHASE(7, moe_gather_phase(lds, WSQ, bid, G, wave_s));
        GRID_BAR();
        PHASE(2, { pg8::Gemm g{(const bf16_t*)(WSQ + WS_R + R_X8), (const bf16_t*)(wl + W_GU), MOE_ROWS, 16384, D / 2, wave_s}; pg8::MoeGatherOrder S{(const LAS int*)(lds + TILEE_OFF), (int)MISC[33] * 4, G, bid, (const int*)(WSQ + WS_SRCROW)};
          pg8::EpiGU8 E{(unsigned char*)Hb};
          pg8::gemm_phase<pg8::EpiGU8, pg8::MoeGatherOrder, GEMM_ALIGN, GEMM_SP2>(lds, g, S, E); });
        GRID_BAR();
        PHASE(2, { pg8::Gemm g{Hb, (const bf16_t*)(wl + W_D), MOE_ROWS, 16384, 256, wave_s}; pg8::MoeOrder S{(const LAS int*)(lds + TILEE_OFF), (int)MISC[33] * 4, G, bid};
          pg8::EpiPlain8 E{(unsigned char*)Xs, D, 3};
          pg8::gemm_phase<pg8::EpiPlain8, pg8::MoeOrder, GEMM_ALIGN, GEMM_SP2>(lds, g, S, E); });
        GRID_BAR();
        if (REP_MASK & (1 << 8)) { ln_phase<2>(lds, args, l, 2, l == 1, Z, bid, G, wave_s); GRID_BAR(); }
        ln_phase<2>(lds, args, l, 2, l == 1, X, bid, G, wave_s);
        if (l == 0) GRID_BAR();
    }
}
#undef X
#undef P
#undef Y
#undef Z
#undef Qb
#undef Ob
#undef Xs
#undef Hb
#undef KV
#undef wl
}

extern "C" void kernel_launch(void* const* d_in, const int* in_sizes, int n_in, void* d_out, int out_size, void* d_ws, size_t ws_size, hipStream_t stream) {
    using namespace mk;
    static int grid = 0;
    if (grid == 0) {
        if (n_in != 22 || in_sizes[0] != M * D || out_size != M * D || ws_size < WS_END) { fprintf(stderr, "kernel_launch: unexpected shapes (n_in %d, in0 %d, out %d, ws %zu, need %zu)\n", n_in, n_in > 0 ? in_sizes[0] : -1, out_size, ws_size, (size_t)WS_END); grid = -1; return; }
        int dev = 0, cus = 0;
        if (hipGetDevice(&dev) != hipSuccess || hipDeviceGetAttribute(&cus, hipDeviceAttributeMultiprocessorCount, dev) != hipSuccess) { grid = -1; return; }
        if (hipFuncSetAttribute((const void*)mk_fwd, hipFuncAttributeMaxDynamicSharedMemorySize, LDS_BYTES) != hipSuccess) { fprintf(stderr, "kernel_launch: hipFuncSetAttribute failed\n"); grid = -1; return; }
        int per_cu = 0;
        if (hipOccupancyMaxActiveBlocksPerMultiprocessor(&per_cu, (const void*)mk_fwd, NTHR, LDS_BYTES) != hipSuccess || per_cu < 1) fprintf(stderr, "kernel_launch: occupancy query says %d\n", per_cu);
        (void)hipGetLastError();
        grid = cus;
    }
    if (grid < 0) return;
    if (hipMemsetAsync((char*)d_ws + WS_CTL, 0, CTL_ZERO_BYTES, stream) != hipSuccess) return;
    Args a{};
    for (int i = 0; i < 22; ++i) a.in[i] = (const float*)d_in[i];
    a.out = (float*)d_out; a.ws = (unsigned char*)d_ws;
    hipLaunchKernelGGL(mk_fwd, dim3(grid), dim3(NTHR), LDS_BYTES, stream, a);
}
```

```cpp
#include <hip/hip_runtime.h>
#include <cstdio>
#include <cstdint>

namespace pg8 {
#define PG8_LAS __attribute__((address_space(3)))
typedef unsigned short bf16_t;
typedef short bf16x8 __attribute__((ext_vector_type(8)));
typedef float f32x4 __attribute__((ext_vector_type(4)));
typedef unsigned u32x4 __attribute__((ext_vector_type(4)));
typedef unsigned u32x2 __attribute__((ext_vector_type(2)));
constexpr int BM = 256, BK = 64, HALF = 128, HTB = HALF * BK * 2  , STAGE_BYTES = 8 * HTB, NXCD = 8, WGM = 8;

__host__ __device__ __forceinline__ int lds_byte(int r, int c) { const int st = (r >> 4) * 2 + (c >> 5), rr = r & 15, cc = c & 31, ob = rr * 64 + cc * 2; return st * 1024 + (ob ^ (((ob >> 9) & 1) << 5)); }
__host__ __device__ __forceinline__ void stage_rc(int b, int& R, int& C) { const int st = b / 1024, sb = b % 1024, swz = sb ^ (((sb >> 9) & 1) << 5); R = (st >> 1) * 16 + swz / 64; C = (st & 1) * 32 + (swz % 64) / 2; }
__host__ __device__ __forceinline__ int perm32(int rho) { const int n = rho >> 4, i = rho & 15; return 8 * (i >> 2) + 4 * n + (i & 3); }

struct Unit { int pm, pn; };
struct Gemm { const bf16_t* A; const bf16_t* Bt; int M, N, K; int wv; };
__device__ __forceinline__ int lane_id() { int l; asm volatile("v_mbcnt_lo_u32_b32 %0, -1, 0\n\tv_mbcnt_hi_u32_b32 %0, -1, %0" : "=v"(l)); return l; }

struct StaticOrder {
    static constexpr bool GATHER = false;
    int nM, nN, nwg, G, c; const int* src = nullptr;
    __host__ __device__ void init(int M, int N, int G_, int c_) { nM = M / BM; nN = N / BM; nwg = nM * nN; G = G_; c = c_; }
    __host__ __device__ bool next(int i, Unit& u) const {
        const long L = (long)i * G + c; if (L >= nwg) return false;
        int wgid = (int)L; { const int q = nwg / NXCD, r = nwg % NXCD, xcd = wgid % NXCD, off = wgid / NXCD; wgid = (xcd < r ? xcd * (q + 1) : r * (q + 1) + (xcd - r) * q) + off; }
        const int nig = WGM * nN, gid = wgid / nig, fm = gid * WGM, gsz = (nM - fm) < WGM ? (nM - fm) : WGM;
        u.pm = fm + ((wgid % nig) % gsz); u.pn = (wgid % nig) / gsz; return true;
    }
    __device__ __forceinline__ void a_ready(const Unit&) const {}
    __device__ __forceinline__ void done(const Unit&) const {}
};
struct PanelOrder {
    static constexpr bool GATHER = false;
    int nN, npan, G, c; const int* src = nullptr;
    __device__ __forceinline__ bool next(int i, Unit& u) const { const int p = c + (i / nN) * G; if (p >= npan) return false; u.pm = p; u.pn = i % nN; return true; }
    __device__ __forceinline__ void a_ready(const Unit&) const {}
    __device__ __forceinline__ void done(const Unit&) const {}
};
template <bool GATH_> struct MoeOrderT {
    static constexpr bool GATHER = GATH_;
    const PG8_LAS int* tile_e; int nunits, G, c; const int* src = nullptr;
    __device__ __forceinline__ bool next(int i, Unit& u) const {
        const int cc = ((G & 7) == 0) ? (c & 7) * (G >> 3) + (c >> 3) : c;
        const int L = i * G + cc; if (L >= nunits) return false;
        u.pm = L >> 2; u.pn = tile_e[L >> 2] * 4 + (L & 3); return true;
    }
    __device__ __forceinline__ void a_ready(const Unit&) const {}
    __device__ __forceinline__ void done(const Unit&) const {}
};
typedef MoeOrderT<false> MoeOrder; typedef MoeOrderT<true> MoeGatherOrder;

typedef float f32x2_t __attribute__((ext_vector_type(2))); typedef __bf16 bf16x2_t __attribute__((ext_vector_type(2)));
typedef __amdgpu_buffer_rsrc_t rsrc_t;
__device__ __forceinline__ rsrc_t mk_rsrc(const void* p) { return __builtin_amdgcn_make_buffer_rsrc((void*)p, 0, 0x7fffffff, 0x00020000); }
__device__ __forceinline__ u32x4 bld4(rsrc_t r, unsigned voff, unsigned soff) { return __builtin_bit_cast(u32x4, __builtin_amdgcn_raw_buffer_load_b128(r, voff, soff, 0)); }
__device__ __forceinline__ f32x2_t bld2f(rsrc_t r, unsigned voff, unsigned soff) { return __builtin_bit_cast(f32x2_t, __builtin_amdgcn_raw_buffer_load_b64(r, voff, soff, 0)); }
#define GST4(p) (*(__attribute__((address_space(1))) u32x4*)(p))
__device__ __forceinline__ float f8clamp(float x) { return __builtin_fminf(__builtin_fmaxf(x, -448.0f), 448.0f); }
__device__ __forceinline__ unsigned pk4f8(float a, float b, float c, float d) { int w = 0; w = __builtin_amdgcn_cvt_pk_fp8_f32(f8clamp(a), f8clamp(b), w, false); w = __builtin_amdgcn_cvt_pk_fp8_f32(f8clamp(c), f8clamp(d), w, true); return (unsigned)w; }
__device__ __forceinline__ float f8round(float x) { const int w = __builtin_amdgcn_cvt_pk_fp8_f32(f8clamp(x), 0.0f, 0, false); return __builtin_amdgcn_cvt_pk_f32_fp8(w, false)[0]; }
constexpr float F8_SX = 4.0f, F8_SW = 64.0f, F8_SH = 8.0f, F8_SO = 64.0f, F8_SY = 16.0f, F8_SQ = 64.0f, F8_SM = 4.0f, F8_SZ = 4.0f;
__device__ __forceinline__ unsigned pk2(float lo, float hi) { f32x2_t v = {lo, hi}; bf16x2_t b = __builtin_convertvector(v, bf16x2_t); return __builtin_bit_cast(unsigned, b); }
__device__ __forceinline__ float bflo(unsigned w) { return __builtin_bit_cast(float, w << 16); }
__device__ __forceinline__ float bfhi(unsigned w) { return __builtin_bit_cast(float, w & 0xffff0000u); }
__device__ __forceinline__ float f_silu(float x) { return x * __builtin_amdgcn_rcpf(1.0f + __builtin_amdgcn_exp2f(-1.4426950408889634f * x)); }
__device__ __forceinline__ float f_gelu_tanh(float x) { return x * __builtin_amdgcn_rcpf(1.0f + __builtin_amdgcn_exp2f(x * (-2.3022082f - 0.10294324f * x * x))); }
__device__ __forceinline__ float f_logsig16(float z) { const float t = __builtin_amdgcn_exp2f(-1.4426950408889634f * __builtin_fabsf(z)); return (__builtin_fminf(z, 0.0f) - 0.6931471805599453f * __builtin_amdgcn_logf(1.0f + t)) * 0.0625f; }

struct EpiPlain {
    static constexpr bool PERM = true, AFTER_DRAIN = false;
    bf16_t* O; int ldc; int cmask;
    __device__ __forceinline__ void operator()(const f32x4 (&acc)[2][2][4][2], const Unit& u, int wr, int wc, int fr, int fq) const {
        const int row0 = u.pm * BM + wr * 64 + fr, col0 = (u.pn & cmask) * BM + wc * 32 + 8 * fq;
#pragma unroll
        for (int ai = 0; ai < 2; ++ai)
#pragma unroll
            for (int m = 0; m < 4; ++m) { bf16_t* rowp = O + (size_t)(row0 + ai * HALF + m * 16) * ldc + col0;
#pragma unroll
                for (int bj = 0; bj < 2; ++bj) { const f32x4 v0 = acc[ai][bj][m][0], v1 = acc[ai][bj][m][1];
                    u32x4 w; w.x = pk2(v0[0], v0[1]); w.y = pk2(v0[2], v0[3]); w.z = pk2(v1[0], v1[1]); w.w = pk2(v1[2], v1[3]);
                    *(u32x4*)(rowp + bj * HALF) = w; } }
    }
};
struct EpiQFrag {
    static constexpr bool PERM = true, AFTER_DRAIN = false;
    bf16_t* O;
    __device__ __forceinline__ void operator()(const f32x4 (&acc)[2][2][4][2], const Unit& u, int wr, int wc, int fr, int fq) const {
        unsigned lo = (unsigned)(((fq >> 1) * 64 + fr + 32 * (fq & 1)) * 16); asm volatile("" : "+v"(lo));
        char* tile = (char*)(O + (size_t)(u.pm * 4 + u.pn) * 65536) + (size_t)(wr * 2 * 16 + wc * 2) * 1024 + lo;
#pragma unroll
        for (int ai = 0; ai < 2; ++ai)
#pragma unroll
            for (int m = 0; m < 4; ++m)
#pragma unroll
                for (int bj = 0; bj < 2; ++bj) { const f32x4 v0 = acc[ai][bj][m][0], v1 = acc[ai][bj][m][1];
                    u32x4 w; w.x = pk2(v0[0], v0[1]); w.y = pk2(v0[2], v0[3]); w.z = pk2(v1[0], v1[1]); w.w = pk2(v1[2], v1[3]);
                    *(u32x4*)(tile + ((4 * ai + (m >> 1)) * 16 + 8 * bj) * 1024 + (m & 1) * 256) = w; }
    }
};
struct EpiInProj {
    static constexpr bool PERM = true, AFTER_DRAIN = false;
    bf16_t* O; const float* b_a;
    template <int MODE> __device__ __forceinline__ void tile(const f32x4 (&acc)[2][2][4][2], const Unit& u, int wr, int wc, int fr, int fq) const {
        const int row0 = u.pm * BM + wr * 64 + fr, col0 = u.pn * BM + wc * 32 + 8 * fq;
        f32x4 bv[2][2];
#pragma unroll
        for (int bj = 0; bj < 2; ++bj)
#pragma unroll
            for (int n = 0; n < 2; ++n) bv[bj][n] = (MODE == 2) ? *(const f32x4*)(b_a + (col0 - 1536) + bj * HALF + 4 * n) : (f32x4){0.f, 0.f, 0.f, 0.f};
#pragma unroll
        for (int ai = 0; ai < 2; ++ai)
#pragma unroll
            for (int m = 0; m < 4; ++m) { bf16_t* rowp = O + (size_t)(row0 + ai * HALF + m * 16) * 2816 + col0;
#pragma unroll
                for (int bj = 0; bj < 2; ++bj) { f32x4 v0 = acc[ai][bj][m][0], v1 = acc[ai][bj][m][1];
#pragma unroll
                    for (int j = 0; j < 4; ++j) {
                        if (MODE == 1) { v0[j] = f_silu(v0[j]); v1[j] = f_silu(v1[j]); }
                        if (MODE == 2) { v0[j] = f_logsig16(v0[j] + bv[bj][0][j]); v1[j] = f_logsig16(v1[j] + bv[bj][1][j]); }
                        if (MODE == 3) { v0[j] = f_gelu_tanh(v0[j]); v1[j] = f_gelu_tanh(v1[j]); } }
                    u32x4 w; w.x = pk2(v0[0], v0[1]); w.y = pk2(v0[2], v0[3]); w.z = pk2(v1[0], v1[1]); w.w = pk2(v1[2], v1[3]);
                    *(u32x4*)(rowp + bj * HALF) = w; } }
    }
    __device__ __forceinline__ void operator()(const f32x4 (&acc)[2][2][4][2], const Unit& u, int wr, int wc, int fr, int fq) const {
        const int pn = u.pn;
        if (pn < 4) tile<0>(acc, u, wr, wc, fr, fq); else if (pn < 6) tile<1>(acc, u, wr, wc, fr, fq); else if (pn == 6) tile<2>(acc, u, wr, wc, fr, fq); else tile<3>(acc, u, wr, wc, fr, fq);
    }
};
struct EpiInProj8 {
    static constexpr bool PERM = true, AFTER_DRAIN = false, F8 = true; static constexpr float dq = 1.0f / (F8_SX * F8_SW);
    bf16_t* O; const float* b_a;
    template <int MODE> __device__ __forceinline__ void tile(const f32x4 (&acc)[2][2][4][2], const Unit& u, int wr, int wc, int fr, int fq) const {
        const int row0 = u.pm * BM + wr * 64 + fr, col0 = u.pn * BM + wc * 32 + 8 * fq;
        f32x4 bv[2][2];
#pragma unroll
        for (int bj = 0; bj < 2; ++bj)
#pragma unroll
            for (int n = 0; n < 2; ++n) bv[bj][n] = (MODE == 2) ? *(const f32x4*)(b_a + (col0 - 1536) + bj * HALF + 4 * n) : (f32x4){0.f, 0.f, 0.f, 0.f};
#pragma unroll
        for (int ai = 0; ai < 2; ++ai)
#pragma unroll
            for (int m = 0; m < 4; ++m) { bf16_t* rowp = O + (size_t)(row0 + ai * HALF + m * 16) * 2816 + col0;
#pragma unroll
                for (int bj = 0; bj < 2; ++bj) { f32x4 v0 = acc[ai][bj][m][0] * dq, v1 = acc[ai][bj][m][1] * dq;
#pragma unroll
                    for (int j = 0; j < 4; ++j) {
                        if (MODE == 1) { v0[j] = f_silu(v0[j]); v1[j] = f_silu(v1[j]); }
                        if (MODE == 2) { v0[j] = f_logsig16(v0[j] + bv[bj][0][j]); v1[j] = f_logsig16(v1[j] + bv[bj][1][j]); }
                        if (MODE == 3) { v0[j] = f_gelu_tanh(v0[j]); v1[j] = f_gelu_tanh(v1[j]); } }
                    u32x4 w; w.x = pk2(v0[0], v0[1]); w.y = pk2(v0[2], v0[3]); w.z = pk2(v1[0], v1[1]); w.w = pk2(v1[2], v1[3]);
                    *(u32x4*)(rowp + bj * HALF) = w; } }
    }
    __device__ __forceinline__ void operator()(const f32x4 (&acc)[2][2][4][2], const Unit& u, int wr, int wc, int fr, int fq) const {
        const int pn = u.pn;
        if (pn < 4) tile<0>(acc, u, wr, wc, fr, fq); else if (pn < 6) tile<1>(acc, u, wr, wc, fr, fq); else if (pn == 6) tile<2>(acc, u, wr, wc, fr, fq); else tile<3>(acc, u, wr, wc, fr, fq);
    }
};
struct EpiResid {
    static constexpr bool PERM = true, AFTER_DRAIN = false;
    const bf16_t* X; bf16_t* Z; float alpha;
    __device__ __forceinline__ void operator()(const f32x4 (&acc)[2][2][4][2], const Unit& u, int wr, int wc, int fr, int fq) const {
        const int row0 = u.pm * BM + wr * 64 + fr, col0 = u.pn * BM + wc * 32 + 8 * fq;
#pragma unroll
        for (int ai = 0; ai < 2; ++ai)
#pragma unroll
            for (int m = 0; m < 4; ++m) { const size_t off = (size_t)(row0 + ai * HALF + m * 16) * 1024 + col0;
#pragma unroll
                for (int bj = 0; bj < 2; ++bj) { const f32x4 v0 = acc[ai][bj][m][0], v1 = acc[ai][bj][m][1];
                    const u32x4 xr = *(const u32x4*)(X + off + bj * HALF);
                    u32x4 w; w.x = pk2(alpha * bflo(xr.x) + v0[0], alpha * bfhi(xr.x) + v0[1]); w.y = pk2(alpha * bflo(xr.y) + v0[2], alpha * bfhi(xr.y) + v0[3]);
                    w.z = pk2(alpha * bflo(xr.z) + v1[0], alpha * bfhi(xr.z) + v1[1]); w.w = pk2(alpha * bflo(xr.w) + v1[2], alpha * bfhi(xr.w) + v1[3]);
                    *(u32x4*)(Z + off + bj * HALF) = w; } }
    }
};
struct EpiResidStats {
    static constexpr bool PERM = true, AFTER_DRAIN = false;
    const bf16_t* X; bf16_t* Z; f32x2_t* part; static constexpr float alpha = 1.4142135623730951f;
    __device__ __forceinline__ void operator()(const f32x4 (&acc)[2][2][4][2], const Unit& u, int wr, int wc, int fr, int fq) const {
        const int row0 = u.pm * BM + wr * 64 + fr, col0 = u.pn * BM + wc * 32 + 8 * fq;
        int ln = 16 * fq + fr; asm volatile("" : "+v"(ln));
        float s1[8], s2[8];
        const rsrc_t rx = mk_rsrc(X); const unsigned voff = ((unsigned)row0 * 1024u + (unsigned)col0) * 2u;
        u32x4 xres[2][4][2];
#pragma unroll
        for (int ai = 0; ai < 2; ++ai)
#pragma unroll
            for (int m = 0; m < 4; ++m)
#pragma unroll
                for (int bj = 0; bj < 2; ++bj) xres[ai][m][bj] = bld4(rx, voff, (unsigned)(((ai * HALF + m * 16) * 1024 + bj * HALF) * 2));
        __builtin_amdgcn_sched_barrier(0);
#pragma unroll
        for (int ai = 0; ai < 2; ++ai)
#pragma unroll
            for (int m = 0; m < 4; ++m) { const size_t off = (size_t)(row0 + ai * HALF + m * 16) * 1024 + col0; float a1 = 0.f, a2 = 0.f;
#pragma unroll
                for (int bj = 0; bj < 2; ++bj) { const f32x4 v0 = acc[ai][bj][m][0], v1 = acc[ai][bj][m][1];
                    const u32x4 xr = xres[ai][m][bj];
                    u32x4 w; w.x = pk2(alpha * bflo(xr.x) + v0[0], alpha * bfhi(xr.x) + v0[1]); w.y = pk2(alpha * bflo(xr.y) + v0[2], alpha * bfhi(xr.y) + v0[3]);
                    w.z = pk2(alpha * bflo(xr.z) + v1[0], alpha * bfhi(xr.z) + v1[1]); w.w = pk2(alpha * bflo(xr.w) + v1[2], alpha * bfhi(xr.w) + v1[3]);
                    GST4(Z + off + bj * HALF) = w;
                    const float z0 = bflo(w.x), z1 = bfhi(w.x), z2 = bflo(w.y), z3 = bfhi(w.y), z4 = bflo(w.z), z5 = bfhi(w.z), z6 = bflo(w.w), z7 = bfhi(w.w);
                    a1 += ((z0 + z1) + (z2 + z3)) + ((z4 + z5) + (z6 + z7)); a2 += ((z0 * z0 + z1 * z1) + (z2 * z2 + z3 * z3)) + ((z4 * z4 + z5 * z5) + (z6 * z6 + z7 * z7)); }
                s1[ai * 4 + m] = a1; s2[ai * 4 + m] = a2; }
        const bool h5 = (ln & 32) != 0, h4 = (ln & 16) != 0;
        float t1[4], t2[4];
#pragma unroll
        for (int i = 0; i < 4; ++i) { const float m1 = h5 ? s1[4 + i] : s1[i], g1 = h5 ? s1[i] : s1[4 + i], m2 = h5 ? s2[4 + i] : s2[i], g2 = h5 ? s2[i] : s2[4 + i];
            t1[i] = m1 + __builtin_bit_cast(float, __builtin_amdgcn_ds_bpermute((ln ^ 32) << 2, __builtin_bit_cast(int, g1)));
            t2[i] = m2 + __builtin_bit_cast(float, __builtin_amdgcn_ds_bpermute((ln ^ 32) << 2, __builtin_bit_cast(int, g2))); }
        float r1[2], r2[2];
#pragma unroll
        for (int i = 0; i < 2; ++i) { const float m1 = h4 ? t1[2 + i] : t1[i], g1 = h4 ? t1[i] : t1[2 + i], m2 = h4 ? t2[2 + i] : t2[i], g2 = h4 ? t2[i] : t2[2 + i];
            r1[i] = m1 + __builtin_bit_cast(float, __builtin_amdgcn_ds_bpermute((ln ^ 16) << 2, __builtin_bit_cast(int, g1)));
            r2[i] = m2 + __builtin_bit_cast(float, __builtin_amdgcn_ds_bpermute((ln ^ 16) << 2, __builtin_bit_cast(int, g2))); }
#pragma unroll
        for (int i = 0; i < 2; ++i) { const int gi = (h5 ? 4 : 0) + (h4 ? 2 : 0) + i, row = row0 + (gi >> 2) * HALF + (gi & 3) * 16;
            part[(size_t)row * 16 + u.pn * 4 + wc] = (f32x2_t){r1[i], r2[i]}; }
    }
};
struct EpiResidStats8 {
    static constexpr bool PERM = true, AFTER_DRAIN = false, F8 = true; static constexpr float dq = 1.0f / (F8_SM * F8_SW);
    const bf16_t* X; bf16_t* Z; f32x2_t* part; unsigned char* Z8; static constexpr float alpha = 1.4142135623730951f;
    __device__ __forceinline__ void operator()(const f32x4 (&acc)[2][2][4][2], const Unit& u, int wr, int wc, int fr, int fq) const {
        const int row0 = u.pm * BM + wr * 64 + fr, col0 = u.pn * BM + wc * 32 + 8 * fq;
        int ln = 16 * fq + fr; asm volatile("" : "+v"(ln));
        float s1[8], s2[8];
        const rsrc_t rx = mk_rsrc(X); const unsigned voff = ((unsigned)row0 * 1024u + (unsigned)col0) * 2u;
#pragma unroll
        for (int ai = 0; ai < 2; ++ai) {
            u32x4 xres[4][2];
#pragma unroll
            for (int m = 0; m < 4; ++m)
#pragma unroll
                for (int bj = 0; bj < 2; ++bj) xres[m][bj] = bld4(rx, voff, (unsigned)(((ai * HALF + m * 16) * 1024 + bj * HALF) * 2));
            __builtin_amdgcn_sched_barrier(0);
#pragma unroll
            for (int m = 0; m < 4; ++m) { const size_t off = (size_t)(row0 + ai * HALF + m * 16) * 1024 + col0; float a1 = 0.f, a2 = 0.f;
#pragma unroll
                for (int bj = 0; bj < 2; ++bj) { const f32x4 v0 = acc[ai][bj][m][0] * dq, v1 = acc[ai][bj][m][1] * dq;
                    const u32x4 xr = xres[m][bj];
                    u32x4 w; w.x = pk2(alpha * bflo(xr.x) + v0[0], alpha * bfhi(xr.x) + v0[1]); w.y = pk2(alpha * bflo(xr.y) + v0[2], alpha * bfhi(xr.y) + v0[3]);
                    w.z = pk2(alpha * bflo(xr.z) + v1[0], alpha * bfhi(xr.z) + v1[1]); w.w = pk2(alpha * bflo(xr.w) + v1[2], alpha * bfhi(xr.w) + v1[3]);
                    GST4(Z + off + bj * HALF) = w;
                    { u32x2 w8; w8.x = pk4f8(bflo(w.x) * F8_SZ, bfhi(w.x) * F8_SZ, bflo(w.y) * F8_SZ, bfhi(w.y) * F8_SZ); w8.y = pk4f8(bflo(w.z) * F8_SZ, bfhi(w.z) * F8_SZ, bflo(w.w) * F8_SZ, bfhi(w.w) * F8_SZ);
                      *(__attribute__((address_space(1))) u32x2*)(Z8 + off + bj * HALF) = w8; }
                    const float z0 = bflo(w.x), z1 = bfhi(w.x), z2 = bflo(w.y), z3 = bfhi(w.y), z4 = bflo(w.z), z5 = bfhi(w.z), z6 = bflo(w.w), z7 = bfhi(w.w);
                    a1 += ((z0 + z1) + (z2 + z3)) + ((z4 + z5) + (z6 + z7)); a2 += ((z0 * z0 + z1 * z1) + (z2 * z2 + z3 * z3)) + ((z4 * z4 + z5 * z5) + (z6 * z6 + z7 * z7)); }
                s1[ai * 4 + m] = a1; s2[ai * 4 + m] = a2; } }
        const bool h5 = (ln & 32) != 0, h4 = (ln & 16) != 0;
        float t1[4], t2[4];
#pragma unroll
        for (int i = 0; i < 4; ++i) { const float m1 = h5 ? s1[4 + i] : s1[i], g1 = h5 ? s1[i] : s1[4 + i], m2 = h5 ? s2[4 + i] : s2[i], g2 = h5 ? s2[i] : s2[4 + i];
            t1[i] = m1 + __builtin_bit_cast(float, __builtin_amdgcn_ds_bpermute((ln ^ 32) << 2, __builtin_bit_cast(int, g1)));
            t2[i] = m2 + __builtin_bit_cast(float, __builtin_amdgcn_ds_bpermute((ln ^ 32) << 2, __builtin_bit_cast(int, g2))); }
        float r1[2], r2[2];
#pragma unroll
        for (int i = 0; i < 2; ++i) { const float m1 = h4 ? t1[2 + i] : t1[i], g1 = h4 ? t1[i] : t1[2 + i], m2 = h4 ? t2[2 + i] : t2[i], g2 = h4 ? t2[i] : t2[2 + i];
            r1[i] = m1 + __builtin_bit_cast(float, __builtin_amdgcn_ds_bpermute((ln ^ 16) << 2, __builtin_bit_cast(int, g1)));
            r2[i] = m2 + __builtin_bit_cast(float, __builtin_amdgcn_ds_bpermute((ln ^ 16) << 2, __builtin_bit_cast(int, g2))); }
#pragma unroll
        for (int i = 0; i < 2; ++i) { const int gi = (h5 ? 4 : 0) + (h4 ? 2 : 0) + i, row = row0 + (gi >> 2) * HALF + (gi & 3) * 16;
            part[(size_t)row * 16 + u.pn * 4 + wc] = (f32x2_t){r1[i], r2[i]}; }
    }
};
struct EpiQFragLN {
    static constexpr bool PERM = true, AFTER_DRAIN = false;
    unsigned char* O; const f32x2_t* stats; const float* csum; const float* bq;
    __device__ __forceinline__ void operator()(const f32x4 (&acc)[2][2][4][2], const Unit& u, int wr, int wc, int fr, int fq) const {
        unsigned lo = (unsigned)(((fq >> 1) * 64 + fr + 32 * (fq & 1)) * 16); asm volatile("" : "+v"(lo));
        unsigned char* tile = O + (size_t)(u.pm * 4 + u.pn) * 65536 + (size_t)(wr * 2 * 8 + wc * 2) * 1024 + lo;
        const int row0 = u.pm * BM + wr * 64 + fr, col0 = u.pn * BM + wc * 32 + 8 * fq;
        f32x4 cc[2][2], bb[2][2];
#pragma unroll
        for (int bj = 0; bj < 2; ++bj)
#pragma unroll
            for (int n = 0; n < 2; ++n) { cc[bj][n] = *(const f32x4*)(csum + col0 + bj * HALF + 4 * n); bb[bj][n] = *(const f32x4*)(bq + col0 + bj * HALF + 4 * n); }
#pragma unroll
        for (int ai = 0; ai < 2; ++ai)
#pragma unroll
            for (int m = 0; m < 4; ++m) { const f32x2_t st = stats[row0 + ai * HALF + m * 16]; const float mu = st[0], rs = st[1] * F8_SQ; u32x4 w;
#pragma unroll
                for (int bj = 0; bj < 2; ++bj) { const f32x4 v0 = (acc[ai][bj][m][0] - mu * cc[bj][0]) * rs + bb[bj][0] * F8_SQ, v1 = (acc[ai][bj][m][1] - mu * cc[bj][1]) * rs + bb[bj][1] * F8_SQ;
                    const unsigned lo4 = pk4f8(v0[0], v0[1], v0[2], v0[3]), hi4 = pk4f8(v1[0], v1[1], v1[2], v1[3]);
                    if (bj == 0) { w.x = lo4; w.y = hi4; } else { w.z = lo4; w.w = hi4; } }
                *(u32x4*)(tile + (4 * ai + (m >> 1)) * 8192 + (m & 1) * 256) = w; }
    }
};
struct EpiQFragLN8 {
    static constexpr bool PERM = true, AFTER_DRAIN = false, F8 = true; static constexpr float dq = 1.0f / (F8_SZ * F8_SW);
    unsigned char* O; const f32x2_t* stats; const float* csum; const float* bq;
    __device__ __forceinline__ void operator()(const f32x4 (&acc)[2][2][4][2], const Unit& u, int wr, int wc, int fr, int fq) const {
        unsigned lo = (unsigned)(((fq >> 1) * 64 + fr + 32 * (fq & 1)) * 16); asm volatile("" : "+v"(lo));
        unsigned char* tile = O + (size_t)(u.pm * 4 + u.pn) * 65536 + (size_t)(wr * 2 * 8 + wc * 2) * 1024 + lo;
        const int row0 = u.pm * BM + wr * 64 + fr, col0 = u.pn * BM + wc * 32 + 8 * fq;
        f32x4 cc[2][2], bb[2][2];
#pragma unroll
        for (int bj = 0; bj < 2; ++bj)
#pragma unroll
            for (int n = 0; n < 2; ++n) { cc[bj][n] = *(const f32x4*)(csum + col0 + bj * HALF + 4 * n); bb[bj][n] = *(const f32x4*)(bq + col0 + bj * HALF + 4 * n); }
#pragma unroll
        for (int ai = 0; ai < 2; ++ai)
#pragma unroll
            for (int m = 0; m < 4; ++m) { const f32x2_t st = stats[row0 + ai * HALF + m * 16]; const float mu = st[0], rs = st[1] * F8_SQ; u32x4 w;
#pragma unroll
                for (int bj = 0; bj < 2; ++bj) { const f32x4 v0 = (acc[ai][bj][m][0] * dq - mu * cc[bj][0]) * rs + bb[bj][0] * F8_SQ, v1 = (acc[ai][bj][m][1] * dq - mu * cc[bj][1]) * rs + bb[bj][1] * F8_SQ;
                    const unsigned lo4 = pk4f8(v0[0], v0[1], v0[2], v0[3]), hi4 = pk4f8(v1[0], v1[1], v1[2], v1[3]);
                    if (bj == 0) { w.x = lo4; w.y = hi4; } else { w.z = lo4; w.w = hi4; } }
                *(u32x4*)(tile + (4 * ai + (m >> 1)) * 8192 + (m & 1) * 256) = w; }
    }
};
struct EpiResidLN {
    static constexpr bool PERM = true, AFTER_DRAIN = false;
    bf16_t* Z; const f32x2_t* stats; const float* gain; const float* bias; static constexpr float alpha = 1.4142135623730951f;
    __device__ __forceinline__ void operator()(const f32x4 (&acc)[2][2][4][2], const Unit& u, int wr, int wc, int fr, int fq) const {
        const int row0 = u.pm * BM + wr * 64 + fr, col0 = u.pn * BM + wc * 32 + 8 * fq;
        const rsrc_t rz = mk_rsrc(Z), rs = mk_rsrc(stats); const unsigned voff = ((unsigned)row0 * 1024u + (unsigned)col0) * 2u;
        f32x2_t st[2][4];
#pragma unroll
        for (int ai = 0; ai < 2; ++ai)
#pragma unroll
            for (int m = 0; m < 4; ++m) st[ai][m] = bld2f(rs, (unsigned)row0 * 8u, (unsigned)((ai * HALF + m * 16) * 8));
#pragma unroll
        for (int bj = 0; bj < 2; ++bj) {
            u32x4 zres[2][4];
#pragma unroll
            for (int ai = 0; ai < 2; ++ai)
#pragma unroll
                for (int m = 0; m < 4; ++m) zres[ai][m] = bld4(rz, voff, (unsigned)(((ai * HALF + m * 16) * 1024 + bj * HALF) * 2));
            const f32x4 g0 = *(const f32x4*)(gain + col0 + bj * HALF) * alpha, g1 = *(const f32x4*)(gain + col0 + bj * HALF + 4) * alpha, b0 = *(const f32x4*)(bias + col0 + bj * HALF) * alpha, b1 = *(const f32x4*)(bias + col0 + bj * HALF + 4) * alpha;
            __builtin_amdgcn_sched_barrier(0);
#pragma unroll
            for (int ai = 0; ai < 2; ++ai)
#pragma unroll
                for (int m = 0; m < 4; ++m) { const int row = row0 + ai * HALF + m * 16; const float mu = st[ai][m][0], rsd = st[ai][m][1];
                    const u32x4 zr = zres[ai][m];
                    const f32x4 z0 = (f32x4){bflo(zr.x), bfhi(zr.x), bflo(zr.y), bfhi(zr.y)}, z1 = (f32x4){bflo(zr.z), bfhi(zr.z), bflo(zr.w), bfhi(zr.w)};
                    const f32x4 v0 = (z0 - mu) * rsd * g0 + b0 + acc[ai][bj][m][0], v1 = (z1 - mu) * rsd * g1 + b1 + acc[ai][bj][m][1];
                    u32x4 w; w.x = pk2(v0[0], v0[1]); w.y = pk2(v0[2], v0[3]); w.z = pk2(v1[0], v1[1]); w.w = pk2(v1[2], v1[3]);
                    GST4(Z + (size_t)row * 1024 + col0 + bj * HALF) = w; } }
    }
};
struct EpiResidLN8 {
    static constexpr bool PERM = true, AFTER_DRAIN = false, F8 = true; static constexpr float dq = 1.0f / (F8_SO * F8_SW);
    bf16_t* Z; const f32x2_t* stats; const float* gain; const float* bias; static constexpr float alpha = 1.4142135623730951f;
    __device__ __forceinline__ void operator()(const f32x4 (&acc)[2][2][4][2], const Unit& u, int wr, int wc, int fr, int fq) const {
        const int row0 = u.pm * BM + wr * 64 + fr, col0 = u.pn * BM + wc * 32 + 8 * fq;
        const rsrc_t rz = mk_rsrc(Z), rs = mk_rsrc(stats); const unsigned voff = ((unsigned)row0 * 1024u + (unsigned)col0) * 2u;
        f32x2_t st[2][4];
#pragma unroll
        for (int ai = 0; ai < 2; ++ai)
#pragma unroll
            for (int m = 0; m < 4; ++m) st[ai][m] = bld2f(rs, (unsigned)row0 * 8u, (unsigned)((ai * HALF + m * 16) * 8));
#pragma unroll
        for (int bj = 0; bj < 2; ++bj) {
            u32x4 zres[2][4];
#pragma unroll
            for (int ai = 0; ai < 2; ++ai)
#pragma unroll
                for (int m = 0; m < 4; ++m) zres[ai][m] = bld4(rz, voff, (unsigned)(((ai * HALF + m * 16) * 1024 + bj * HALF) * 2));
            const f32x4 g0 = *(const f32x4*)(gain + col0 + bj * HALF) * alpha, g1 = *(const f32x4*)(gain + col0 + bj * HALF + 4) * alpha, b0 = *(const f32x4*)(bias + col0 + bj * HALF) * alpha, b1 = *(const f32x4*)(bias + col0 + bj * HALF + 4) * alpha;
            __builtin_amdgcn_sched_barrier(0);
#pragma unroll
            for (int ai = 0; ai < 2; ++ai)
#pragma unroll
                for (int m = 0; m < 4; ++m) { const int row = row0 + ai * HALF + m * 16; const float mu = st[ai][m][0], rsd = st[ai][m][1];
                    const u32x4 zr = zres[ai][m];
                    const f32x4 z0 = (f32x4){bflo(zr.x), bfhi(zr.x), bflo(zr.y), bfhi(zr.y)}, z1 = (f32x4){bflo(zr.z), bfhi(zr.z), bflo(zr.w), bfhi(zr.w)};
                    const f32x4 v0 = (z0 - mu) * rsd * g0 + b0 + acc[ai][bj][m][0] * dq, v1 = (z1 - mu) * rsd * g1 + b1 + acc[ai][bj][m][1] * dq;
                    u32x4 w; w.x = pk2(v0[0], v0[1]); w.y = pk2(v0[2], v0[3]); w.z = pk2(v1[0], v1[1]); w.w = pk2(v1[2], v1[3]);
                    GST4(Z + (size_t)row * 1024 + col0 + bj * HALF) = w; } }
    }
};
struct EpiGU {
    static constexpr bool PERM = true, AFTER_DRAIN = false;
    bf16_t* H;
    __device__ __forceinline__ void operator()(const f32x4 (&acc)[2][2][4][2], const Unit& u, int wr, int wc, int fr, int fq) const {
        const int row0 = u.pm * BM + wr * 64 + fr, col0 = (u.pn & 3) * 128 + wc * 16 + 4 * fq;
#pragma unroll
        for (int ai = 0; ai < 2; ++ai)
#pragma unroll
            for (int m = 0; m < 4; ++m) { bf16_t* rowp = H + (size_t)(row0 + ai * HALF + m * 16) * 512 + col0;
#pragma unroll
                for (int bj = 0; bj < 2; ++bj) { const f32x4 g = acc[ai][bj][m][0], up = acc[ai][bj][m][1];
                    u32x2 w; w.x = pk2(f_silu(g[0]) * up[0], f_silu(g[1]) * up[1]); w.y = pk2(f_silu(g[2]) * up[2], f_silu(g[3]) * up[3]);
                    *(u32x2*)(rowp + bj * 64) = w; } }
    }
};
struct EpiGU8 {
    static constexpr bool PERM = true, AFTER_DRAIN = false, F8 = true;
    unsigned char* H;
    __device__ __forceinline__ void operator()(const f32x4 (&acc)[2][2][4][2], const Unit& u, int wr, int wc, int fr, int fq) const {
        const int row0 = u.pm * BM + wr * 64 + fr, col0 = (u.pn & 3) * 128 + wc * 32 + 8 * fq;
        constexpr float dq = 1.0f / (F8_SX * F8_SW);
#pragma unroll
        for (int ai = 0; ai < 2; ++ai)
#pragma unroll
            for (int m = 0; m < 4; ++m) { float h[8];
#pragma unroll
                for (int n = 0; n < 2; ++n) { const f32x4 g = acc[ai][0][m][n] * dq, up = acc[ai][1][m][n] * (dq * F8_SH);
#pragma unroll
                    for (int i = 0; i < 4; ++i) h[4 * n + i] = f_silu(g[i]) * up[i]; }
                u32x2 w; w.x = pk4f8(h[0], h[1], h[2], h[3]); w.y = pk4f8(h[4], h[5], h[6], h[7]);
                *(u32x2*)(H + (size_t)(row0 + ai * HALF + m * 16) * 512 + col0) = w; }
    }
};
struct EpiPlain8 {
    static constexpr bool PERM = true, AFTER_DRAIN = false, F8 = true;
    unsigned char* O; int ldc; int cmask;
    __device__ __forceinline__ void operator()(const f32x4 (&acc)[2][2][4][2], const Unit& u, int wr, int wc, int fr, int fq) const {
        const int row0 = u.pm * BM + wr * 64 + fr, col0 = (u.pn & cmask) * BM + wc * 32 + 8 * fq;
        constexpr float dq = F8_SY / (F8_SH * F8_SW);
#pragma unroll
        for (int ai = 0; ai < 2; ++ai)
#pragma unroll
            for (int m = 0; m < 4; ++m) { unsigned char* rowp = O + (size_t)(row0 + ai * HALF + m * 16) * ldc + col0;
#pragma unroll
                for (int bj = 0; bj < 2; ++bj) { const f32x4 v0 = acc[ai][bj][m][0] * dq, v1 = acc[ai][bj][m][1] * dq;
                    u32x2 w; w.x = pk4f8(v0[0], v0[1], v0[2], v0[3]); w.y = pk4f8(v1[0], v1[1], v1[2], v1[3]);
                    *(u32x2*)(rowp + bj * HALF) = w; } }
    }
};

typedef int i32x4_t __attribute__((ext_vector_type(4)));
template <class T, class = void> struct epi_f8 { static constexpr bool value = false; };
template <class T> struct epi_f8<T, decltype((void)T::F8)> { static constexpr bool value = true; };
template <class Epi, class Sched, bool ALIGN_EPI = false, bool SP2 = false>
__device__ __forceinline__ void gemm_phase(PG8_LAS unsigned char* lds, const Gemm g, const Sched& S, const Epi& E) {
    int tid_ = g.wv * 64 + lane_id(); asm volatile("" : "+v"(tid_));
    const int tid = tid_, wid = __builtin_amdgcn_readfirstlane(tid >> 6), lane = tid & 63, wr = wid >> 2, wc = wid & 3, fr = lane & 15, fq = lane >> 4;
    const int K = g.K, nt = K / BK; constexpr bool F8 = epi_f8<Epi>::value;
    unsigned voffA[2], voffB[2];
#pragma unroll
    for (int i = 0; i < 2; ++i) { int R, C; stage_rc(tid * 16 + i * 8192, R, C); const int Rb = Epi::PERM ? ((R & ~31) + perm32(R & 31)) : R;
        voffA[i] = (unsigned)(R * K + C) * 2u;
        voffB[i] = (unsigned)(((Rb >> 4) * (K >> 5) + (C >> 5)) * 1024 + (Rb & 15) * 64 + (C & 31) * 2); }
    constexpr bool GATH = Sched::GATHER; static_assert(!GATH || SP2, "gather mode is written for the SP2 loop");
    unsigned goc[2][2] = {{0u, 0u}, {0u, 0u}}, gon[2][2] = {{0u, 0u}, {0u, 0u}}, go2[2][2] = {{0u, 0u}, {0u, 0u}};
#define PG8_GOFF(dst, U) do { int tg_ = tid; asm volatile("" : "+v"(tg_)); _Pragma("unroll") for (int i_ = 0; i_ < 2; ++i_) { int R_, C_; stage_rc(tg_ * 16 + i_ * 8192, R_, C_); \
        _Pragma("unroll") for (int h_ = 0; h_ < 2; ++h_) dst[h_][i_] = (unsigned)S.src[(U).pm * BM + h_ * HALF + R_] * (unsigned)(K * 2) + (unsigned)C_ * 2u; } } while (0)
    const size_t kstep = (size_t)(BK * 2);
    const size_t kstepB = 2048;
    const size_t hstep = (size_t)HALF * K * 2;
    const size_t tstep = 2 * hstep;
    const unsigned ldsw = (unsigned)wid * 1024u;
    const int aoff = lds_byte(wr * 64 + fr, fq * 8), boff = lds_byte(wc * 32 + fr, fq * 8);
#define PG8_SA(b, h) (((b) * 2 + (h)) * HTB)
#define PG8_SB(b, h) ((4 + (b) * 2 + (h)) * HTB)
#define PG8_STAGE(bufoff, gbase, voff) do { _Pragma("unroll") for (int _i = 0; _i < 2; ++_i) \
        __builtin_amdgcn_global_load_lds((const unsigned*)((const char*)(gbase) + (voff)[_i]), (PG8_LAS unsigned*)(lds + (bufoff) + ldsw + _i * 8192), 16, 0, 0); } while (0)
#define PG8_STAGE_A(b, h, PTR, KPTR, GO) do { if constexpr (GATH) { PG8_STAGE(PG8_SA(b, h), KPTR, GO); } else { PG8_STAGE(PG8_SA(b, h), PTR, voffA); } } while (0)
#define PG8_LDA(dst, b, h) do { _Pragma("unroll") for (int m = 0; m < 4; ++m) _Pragma("unroll") for (int k = 0; k < 2; ++k) dst[m][k] = *(const PG8_LAS bf16x8*)(lds + PG8_SA(b, h) + aoff + m * 2048 + k * 1024); } while (0)
#define PG8_LDB(dst, b, h) do { _Pragma("unroll") for (int n = 0; n < 2; ++n) _Pragma("unroll") for (int k = 0; k < 2; ++k) dst[n][k] = *(const PG8_LAS bf16x8*)(lds + PG8_SB(b, h) + boff + n * 2048 + k * 1024); } while (0)
#define PG8_CAT8(x, y) __builtin_shufflevector(__builtin_bit_cast(i32x4_t, x), __builtin_bit_cast(i32x4_t, y), 0, 1, 2, 3, 4, 5, 6, 7)
#define PG8_MMA(ai, bj, At, Bt) do { __builtin_amdgcn_s_setprio(1); \
        if constexpr (F8) { _Pragma("unroll") for (int m = 0; m < 4; ++m) _Pragma("unroll") for (int n = 0; n < 2; ++n) \
            asm volatile("v_mfma_f32_16x16x128_f8f6f4 %0, %1, %2, %0" : "+v"(acc[ai][bj][m][n]) : "v"(PG8_CAT8(Bt[n][0], Bt[n][1])), "v"(PG8_CAT8(At[m][0], At[m][1]))); } \
        else { _Pragma("unroll") for (int m = 0; m < 4; ++m) _Pragma("unroll") for (int n = 0; n < 2; ++n) _Pragma("unroll") for (int k = 0; k < 2; ++k) \
            acc[ai][bj][m][n] = __builtin_amdgcn_mfma_f32_16x16x32_bf16(Bt[n][k], At[m][k], acc[ai][bj][m][n], 0, 0, 0); } \
        __builtin_amdgcn_s_setprio(0); } while (0)
#define PG8_WAIT_V(n) asm volatile("s_waitcnt vmcnt(" #n ")" ::: "memory")
#define PG8_WAIT_L(n) asm volatile("s_waitcnt lgkmcnt(" #n ")" ::: "memory")
#define PG8_BAR __builtin_amdgcn_s_barrier()
#define PG8_SCHED __builtin_amdgcn_sched_barrier(0)
    Unit cur, nxt; int ui = 0;
    if (!S.next(0, cur)) return;
    f32x4 acc[2][2][4][2];
#pragma unroll
    for (int a = 0; a < 2; ++a)
#pragma unroll
        for (int b = 0; b < 2; ++b)
#pragma unroll
            for (int m = 0; m < 4; ++m)
#pragma unroll
                for (int n = 0; n < 2; ++n) { acc[a][b][m][n] = (f32x4){0.f, 0.f, 0.f, 0.f}; if constexpr (F8) asm volatile("" : "+v"(acc[a][b][m][n])); }
    bf16x8 At[4][2], B0[2][2], B1[2][2];
    const char* cA = (const char*)g.A + (size_t)cur.pm * tstep; const char* cB = (const char*)g.Bt + (size_t)cur.pn * tstep;
    S.a_ready(cur);
    const char* gA = (const char*)g.A;
    if constexpr (GATH) PG8_GOFF(goc, cur);
    if constexpr (SP2) {
        PG8_STAGE(PG8_SB(0, 0), cB, voffB); PG8_STAGE(PG8_SB(0, 1), cB + hstep, voffB); PG8_STAGE_A(0, 0, cA, gA, goc[0]); PG8_STAGE_A(0, 1, cA + hstep, gA, goc[1]);
        if (wr == 1) PG8_BAR;
        PG8_WAIT_V(2); PG8_BAR;
        PG8_STAGE(PG8_SB(1, 0), cB + kstepB, voffB); PG8_STAGE_A(1, 0, cA + kstep, gA + kstep, goc[0]); PG8_STAGE(PG8_SB(1, 1), cB + hstep + kstepB, voffB);
        PG8_WAIT_V(6); PG8_BAR;
    } else {
        PG8_STAGE(PG8_SB(0, 0), cB, voffB); PG8_STAGE(PG8_SA(0, 0), cA, voffA); PG8_STAGE(PG8_SB(0, 1), cB + hstep, voffB); PG8_STAGE(PG8_SA(0, 1), cA + hstep, voffA);
        if (wr == 1) PG8_BAR;
        PG8_WAIT_V(4); PG8_BAR;
        PG8_STAGE(PG8_SB(1, 0), cB + kstepB, voffB); PG8_STAGE(PG8_SA(1, 0), cA + kstep, voffA); PG8_STAGE(PG8_SB(1, 1), cB + hstep + kstepB, voffB);
        PG8_WAIT_V(6); PG8_BAR;
    }
    for (;;) {
        const bool has_next = S.next(ui + 1, nxt);
        if constexpr (GATH) { if (has_next) PG8_GOFF(gon, nxt); else { _Pragma("unroll") for (int h_ = 0; h_ < 2; ++h_) _Pragma("unroll") for (int i_ = 0; i_ < 2; ++i_) gon[h_][i_] = goc[h_][i_]; } }
        const char* nA = has_next ? (const char*)g.A + (size_t)nxt.pm * tstep : cA; const char* nB = has_next ? (const char*)g.Bt + (size_t)nxt.pn * tstep : cB;
        for (int t = 0; t < nt; t += 2) {
            const bool last = (t == nt - 2);
            const char* a1 = cA + (size_t)(t + 1) * kstep;
            const char* a2 = last ? nA : cA + (size_t)(t + 2) * kstep; const char* b2 = last ? nB : cB + (size_t)(t + 2) * kstepB;
            const char* a3 = a2 + kstep; const char* b3 = b2 + kstepB;
            if (last && has_next) S.a_ready(nxt);
            const char* ga1 = gA + (size_t)(t + 1) * kstep; const char* ga2 = last ? gA : gA + (size_t)(t + 2) * kstep; const char* ga3 = ga2 + kstep;
            if constexpr (GATH) { _Pragma("unroll") for (int h_ = 0; h_ < 2; ++h_) _Pragma("unroll") for (int i_ = 0; i_ < 2; ++i_) go2[h_][i_] = last ? gon[h_][i_] : goc[h_][i_]; }
            if constexpr (SP2) {
            PG8_LDB(B0, 0, 0); PG8_LDB(B1, 0, 1); PG8_SCHED; PG8_LDA(At, 0, 0); PG8_STAGE_A(1, 1, a1 + hstep, ga1, goc[1]);
            PG8_WAIT_V(8); PG8_WAIT_L(0); PG8_BAR; PG8_MMA(0, 0, At, B0); PG8_MMA(0, 1, At, B1); PG8_BAR; PG8_SCHED;
            PG8_LDA(At, 0, 1); PG8_STAGE(PG8_SB(0, 0), b2, voffB); PG8_STAGE(PG8_SB(0, 1), b2 + hstep, voffB); PG8_STAGE_A(0, 0, a2, ga2, go2[0]);
            PG8_WAIT_V(8); PG8_WAIT_L(0); PG8_BAR; PG8_MMA(1, 0, At, B0); PG8_MMA(1, 1, At, B1); PG8_BAR; PG8_SCHED;
            PG8_LDB(B0, 1, 0); PG8_LDB(B1, 1, 1); PG8_SCHED; PG8_LDA(At, 1, 0); PG8_STAGE_A(0, 1, a2 + hstep, ga2, go2[1]);
            PG8_WAIT_V(8); PG8_WAIT_L(0); PG8_BAR; PG8_MMA(0, 0, At, B0); PG8_MMA(0, 1, At, B1); PG8_BAR; PG8_SCHED;
            PG8_LDA(At, 1, 1); PG8_STAGE(PG8_SB(1, 0), b3, voffB); PG8_STAGE(PG8_SB(1, 1), b3 + hstep, voffB); PG8_STAGE_A(1, 0, a3, ga3, go2[0]);
            PG8_WAIT_V(8); PG8_WAIT_L(0); PG8_BAR; PG8_MMA(1, 0, At, B0); PG8_MMA(1, 1, At, B1); PG8_BAR; PG8_SCHED;
            } else {
            PG8_LDB(B0, 0, 0); PG8_SCHED; PG8_LDA(At, 0, 0); PG8_STAGE(PG8_SA(1, 1), a1 + hstep, voffA);
            PG8_WAIT_L(8); PG8_BAR; PG8_WAIT_L(0); PG8_MMA(0, 0, At, B0); PG8_BAR; PG8_SCHED;
            PG8_LDB(B1, 0, 1); PG8_STAGE(PG8_SB(0, 0), b2, voffB);
            PG8_BAR; PG8_WAIT_L(0); PG8_MMA(0, 1, At, B1); PG8_BAR;
            PG8_LDA(At, 0, 1); PG8_STAGE(PG8_SA(0, 0), a2, voffA);
            PG8_BAR; PG8_WAIT_L(0); PG8_MMA(1, 0, At, B0); PG8_BAR; PG8_SCHED;
            PG8_STAGE(PG8_SB(0, 1), b2 + hstep, voffB);
            PG8_WAIT_V(6); PG8_BAR; PG8_MMA(1, 1, At, B1); PG8_BAR;
            PG8_LDB(B0, 1, 0); PG8_SCHED; PG8_LDA(At, 1, 0); PG8_STAGE(PG8_SA(0, 1), a2 + hstep, voffA);
            PG8_WAIT_L(8); PG8_BAR; PG8_WAIT_L(0); PG8_MMA(0, 0, At, B0); PG8_BAR; PG8_SCHED;
            PG8_LDB(B1, 1, 1); PG8_STAGE(PG8_SB(1, 0), b3, voffB);
            PG8_BAR; PG8_WAIT_L(0); PG8_MMA(0, 1, At, B1); PG8_BAR;
            PG8_LDA(At, 1, 1); PG8_STAGE(PG8_SA(1, 0), a3, voffA);
            PG8_BAR; PG8_WAIT_L(0); PG8_MMA(1, 0, At, B0); PG8_BAR; PG8_SCHED;
            PG8_STAGE(PG8_SB(1, 1), b3 + hstep, voffB);
            PG8_WAIT_V(6); PG8_BAR; PG8_MMA(1, 1, At, B1); PG8_BAR;
            }
        }
        if constexpr (F8) asm volatile("s_nop 15\n\ts_nop 15" ::: "memory");
        if constexpr (ALIGN_EPI) { if (wr == 0) PG8_BAR; }
        if constexpr (!Epi::AFTER_DRAIN) { E(acc, cur, wr, wc, fr, fq); S.done(cur); }
        if (!has_next) break;
#pragma unroll
        for (int a = 0; a < 2; ++a)
#pragma unroll
            for (int b = 0; b < 2; ++b)
#pragma unroll
                for (int m = 0; m < 4; ++m)
#pragma unroll
                    for (int n = 0; n < 2; ++n) { acc[a][b][m][n] = (f32x4){0.f, 0.f, 0.f, 0.f}; if constexpr (F8) asm volatile("" : "+v"(acc[a][b][m][n])); }
        cur = nxt; cA = nA; cB = nB; ++ui;
        if constexpr (GATH) { _Pragma("unroll") for (int h_ = 0; h_ < 2; ++h_) _Pragma("unroll") for (int i_ = 0; i_ < 2; ++i_) goc[h_][i_] = gon[h_][i_]; }
        if constexpr (ALIGN_EPI) { if (wr == 1) PG8_BAR; }
    }
    PG8_WAIT_V(0);
    if constexpr (!ALIGN_EPI) { if (wr == 0) PG8_BAR; }
    PG8_BAR;
    if constexpr (Epi::AFTER_DRAIN) { E.fused(acc, cur, wr, wc, fr, fq, lds, wid, lane); S.done(cur); }
#undef PG8_SA
#undef PG8_SB
#undef PG8_STAGE
#undef PG8_STAGE_A
#undef PG8_GOFF
#undef PG8_LDA
#undef PG8_LDB
#undef PG8_MMA
#undef PG8_WAIT_V
#undef PG8_WAIT_L
#undef PG8_BAR
#undef PG8_SCHED
}}

namespace mk {
using pg8::bf16_t; using pg8::bf16x8; using pg8::f32x4; using pg8::u32x4; using pg8::u32x2; using pg8::pk2; using pg8::bflo; using pg8::bfhi;
typedef float f32x16 __attribute__((ext_vector_type(16)));
typedef short s16x4 __attribute__((ext_vector_type(4)));
typedef short v4i16_t __attribute__((ext_vector_type(4)));
#define LAS __attribute__((address_space(3)))
#define GAS __attribute__((address_space(1)))
typedef GAS unsigned gu32;
#define RLX_AGENT __ATOMIC_RELAXED, __HIP_MEMORY_SCOPE_AGENT
#define LDS_WAIT() asm volatile("s_waitcnt lgkmcnt(0)" ::: "memory")

constexpr int NB = 8, SEQ = 8192, M = NB * SEQ, D = 1024, NP = 2816, NMEM = 256, MKV = NB * NMEM;
constexpr int PQ = 0, PK = 256, PV = 512, PR = 1024, PG = 1536, PU = 1792, PVS = 2304;
constexpr int DIN = 2576;
constexpr int MOE_ROWS = 135168;
constexpr float ALPHA = 1.4142135623730951f, LN_EPS = 1e-5f, LOG2E = 1.4426950408889634f;
constexpr int NWAVES = 8, NTHR = 512;

constexpr size_t MiB = 1u << 20;
constexpr size_t WS_CTL = 0, CTL_ZERO_BYTES = 1 * MiB;
constexpr size_t WS_WM = 1 * MiB;
constexpr size_t WS_WGCNT = 1 * MiB + 512 * 1024;
constexpr size_t WS_LTOT = 1 * MiB + 768 * 1024;
constexpr size_t WS_TINFO = 2 * MiB;
constexpr size_t WS_TRANK = 3 * MiB;
constexpr size_t WS_TSLOT = 3 * MiB + 512 * 1024;
constexpr size_t WS_SEND = 4 * MiB;
constexpr size_t WS_WKV = 12 * MiB;
constexpr size_t WS_MEMB = 20 * MiB;
constexpr size_t WS_KV = 24 * MiB;
constexpr size_t WS_W = 40 * MiB, W_LAYER = 60 * MiB;
constexpr size_t W_IN = 0, W_OUT = (size_t)NP * D * 2, W_Q = W_OUT + 2 * MiB, W_O = W_Q + 2 * MiB, W_GU = W_O + 2 * MiB, W_D = W_GU + 32 * MiB;
static_assert(W_D + 16 * MiB <= W_LAYER, "weights per layer");
constexpr size_t WS_X = 160 * MiB;
constexpr size_t WS_R = 288 * MiB;
constexpr size_t R_P = 0, R_Y = 352 * MiB, R_Z = 480 * MiB, R_Q = 0, R_O = 128 * MiB, R_XS = 344 * MiB, R_H = 0;
constexpr size_t R_X8 = 256 * MiB;
constexpr size_t WS_SRCROW = WS_R + 616 * MiB;
constexpr size_t WS_PART = WS_SRCROW + 1 * MiB;
constexpr size_t WS_STATS = WS_PART + 8 * MiB;
constexpr size_t WS_CS = WS_STATS + 1 * MiB;
constexpr size_t WS_X8IN = WS_CS + 1 * MiB;
constexpr size_t WS_END = WS_X8IN + 64 * MiB;
static_assert(R_XS + (size_t)MOE_ROWS * D * 2 <= 616 * MiB && R_H + (size_t)MOE_ROWS * 512 * 2 <= R_XS, "moe buffers");
constexpr int CW_BAR = 4096;

constexpr int LDS_BYTES = 159744, LDSCTL_OFF = 155648;
constexpr int MISC_OFF = LDSCTL_OFF;
constexpr int TILEE_OFF = LDSCTL_OFF + 512;
static_assert(TILEE_OFF + 528 * 4 <= LDS_BYTES, "LDS map");

#define XB_TMO      128
#define XB_XCNT(j)  (256  + 64 * (j))
#define XB_XSUB(j)  (1280 + 64 * (j))
#define XB_XGEN(j)  (2304 + 64 * (j))
#define XB_TOP      3328
#define XB_TOPGEN   3392
#define XCD_BAR_WORDS 3456
#define XB_SPIN_CAP (1u << 18)

__device__ __forceinline__ unsigned xb_ld(unsigned* p)              { return __hip_atomic_load(p, __ATOMIC_RELAXED, __HIP_MEMORY_SCOPE_AGENT); }
__device__ __forceinline__ unsigned xb_add(unsigned* p, unsigned v) { return __hip_atomic_fetch_add(p, v, __ATOMIC_RELAXED, __HIP_MEMORY_SCOPE_AGENT); }
__device__ __forceinline__ unsigned xb_xcc_id() { return (unsigned)__builtin_amdgcn_s_getreg((3 << 11) | 20) & 0xFu; }
#define XB_SPIN(cond, bar) do { unsigned _sp = 0; while (cond) { __builtin_amdgcn_s_sleep(1); \
    if ((++_sp & 255u) == 0u) { if (xb_ld(&(bar)[XB_TMO])) break; if (_sp > XB_SPIN_CAP) { atomicAdd(&(bar)[XB_TMO], 1u); break; } } } } while (0)

struct XcdBarrier {
    unsigned* bar; unsigned x;
    volatile LAS unsigned* st;
    int wv;
};

__device__ __forceinline__ XcdBarrier xcd_barrier_post(unsigned* bar, volatile LAS unsigned* st) {
    XcdBarrier b; b.bar = bar; b.x = xb_xcc_id(); b.st = st; b.wv = 0;
    if (threadIdx.x == 0) (void)xb_add(&bar[XB_XCNT(b.x)], 1u);
    return b;
}
__device__ __forceinline__ void xcd_barrier_complete(unsigned* bar, unsigned x, unsigned& nloc, unsigned& nx) {
    const unsigned G = gridDim.x * gridDim.y * gridDim.z;
    unsigned sum, cnt, mine, sp = 0u;
    for (;;) {
        sum = 0u; cnt = 0u; mine = 0u;
#pragma unroll
        for (unsigned j = 0; j < 16; ++j) { const unsigned c = xb_ld(&bar[XB_XCNT(j)]); sum += c; cnt += (c > 0u) ? 1u : 0u; mine = (j == x) ? c : mine; }
        if (sum == G) break;
        __builtin_amdgcn_s_sleep(1);
        if ((++sp & 255u) == 0u) { if (xb_ld(&bar[XB_TMO])) break; if (sp > XB_SPIN_CAP) { atomicAdd(&bar[XB_TMO], 1u); break; } }
    }
    nloc = mine > 0u ? mine : 1u; nx = cnt > 0u ? cnt : 1u;
}

__device__ __forceinline__ void xcd_barrier(const XcdBarrier& b) {
    asm volatile("s_waitcnt vmcnt(0)" ::: "memory");
    __syncthreads();
    if (b.wv == 0 && pg8::lane_id() == 0) {
        unsigned* bar = b.bar;
        __builtin_amdgcn_s_waitcnt(0);
        unsigned nloc = b.st[0], nx = b.st[1];
        if (nloc == 0u) { xcd_barrier_complete(bar, b.x, nloc, nx); b.st[0] = nloc; b.st[1] = nx; }
        const unsigned old = xb_add(&bar[XB_XSUB(b.x)], 1u);
        const unsigned gen = old / nloc;
        if (old + 1u == (gen + 1u) * nloc) {
            __builtin_amdgcn_fence(__ATOMIC_RELEASE, "agent");
            asm volatile("s_waitcnt vmcnt(0)" ::: "memory");
            const unsigned og = xb_add(&bar[XB_TOP], 1u);
            const unsigned tg = og / nx;
            if (og + 1u == (tg + 1u) * nx) xb_add(&bar[XB_TOPGEN], 1u);
            else XB_SPIN(xb_ld(&bar[XB_TOPGEN]) == tg, bar);
            __builtin_amdgcn_fence(__ATOMIC_ACQUIRE, "agent");
            xb_add(&bar[XB_XGEN(b.x)], 1u);
            asm volatile("s_waitcnt vmcnt(0)" ::: "memory");
        } else {
            XB_SPIN(xb_ld(&bar[XB_XGEN(b.x)]) == gen, bar);
            __builtin_amdgcn_fence(__ATOMIC_ACQUIRE, "agent");
            asm volatile("s_waitcnt vmcnt(0)" ::: "memory");
        }
    }
    __syncthreads();
}
__device__ __forceinline__ float shx(float v, int m, int lane) { return __builtin_bit_cast(float, __builtin_amdgcn_ds_bpermute((lane ^ m) << 2, __builtin_bit_cast(int, v))); }
__device__ __forceinline__ int shxi(int v, int m, int lane) { return __builtin_amdgcn_ds_bpermute((lane ^ m) << 2, v); }
__device__ __forceinline__ s16x4 vtr(unsigned lds_addr) { return __builtin_bit_cast(s16x4, __builtin_amdgcn_ds_read_tr16_b64_v4i16((LAS v4i16_t*)(size_t)lds_addr)); }
__device__ __forceinline__ bf16x8 cat8(s16x4 lo, s16x4 hi) { return __builtin_shufflevector(lo, hi, 0, 1, 2, 3, 4, 5, 6, 7); }
__device__ __forceinline__ void unpack8(const u32x4 w, float (&f)[8]) { f[0] = bflo(w.x); f[1] = bfhi(w.x); f[2] = bflo(w.y); f[3] = bfhi(w.y); f[4] = bflo(w.z); f[5] = bfhi(w.z); f[6] = bflo(w.w); f[7] = bfhi(w.w); }
__device__ __forceinline__ void unpack8f8(const u32x2 w, float (&f)[8]) { const auto a0 = __builtin_amdgcn_cvt_pk_f32_fp8((int)w.x, false), a1 = __builtin_amdgcn_cvt_pk_f32_fp8((int)w.x, true), a2 = __builtin_amdgcn_cvt_pk_f32_fp8((int)w.y, false), a3 = __builtin_amdgcn_cvt_pk_f32_fp8((int)w.y, true);
    f[0] = a0[0]; f[1] = a0[1]; f[2] = a1[0]; f[3] = a1[1]; f[4] = a2[0]; f[5] = a2[1]; f[6] = a3[0]; f[7] = a3[1]; }
__device__ __forceinline__ u32x4 pack8(const float (&f)[8]) { u32x4 w; w.x = pk2(f[0], f[1]); w.y = pk2(f[2], f[3]); w.z = pk2(f[4], f[5]); w.w = pk2(f[6], f[7]); return w; }

struct Args {
    const float* in[22]; float* out; unsigned char* ws;
};

__device__ __forceinline__ void transpose_item(const float* p0, const float* p1, int ld, int mode, float scale, int K, int nblk, bf16_t* dst, int row0, LAS float* scr, int item, int lane, const float* kscale = nullptr) {
    const int kb = item / nblk, nb = item % nblk, k0 = 64 * kb, n0 = 32 * nb;
    const int np = n0 + (lane & 31);
    const float* sp; int col;
    if (mode == 0) { sp = p0; col = np; } else { sp = (np & 4) ? p1 : p0; col = (np >> 3) * 4 + (np & 3); }
    sp += (size_t)k0 * ld + col;
#pragma unroll 8
    for (int i = 0; i < 32; ++i) { const int kk = 2 * i + (lane >> 5); scr[kk * 33 + (lane & 31)] = sp[(size_t)kk * ld] * scale * (kscale ? kscale[k0 + kk] : 1.0f); }
    LDS_WAIT(); asm volatile("" ::: "memory");
    const int c = lane & 7;
#pragma unroll
    for (int j = 0; j < 4; ++j) { const int n = (lane >> 3) + 8 * j; const LAS float* s = scr + (8 * c) * 33 + n;
        u32x4 o; o.x = pk2(s[0 * 33], s[1 * 33]); o.y = pk2(s[2 * 33], s[3 * 33]); o.z = pk2(s[4 * 33], s[5 * 33]); o.w = pk2(s[6 * 33], s[7 * 33]);
        const int ng = row0 + n0 + n, kk = k0 + 8 * c;
        *(u32x4*)(dst + ((size_t)(ng >> 4) * (K >> 5) + (kk >> 5)) * 512 + (ng & 15) * 32 + (kk & 31)) = o; }
    LDS_WAIT(); asm volatile("" ::: "memory");
}
__device__ __forceinline__ void transpose_item8(const float* p0, const float* p1, int ld, int mode, float scale, int K, int nblk, unsigned char* dst, int row0, LAS float* scr, int item, int lane, const float* kscale = nullptr) {
    const int kb = item / nblk, nb = item % nblk, k0 = 64 * kb, n0 = 32 * nb;
    const int np = n0 + (lane & 31);
    const float* sp; int col;
    if (mode == 0) { sp = p0; col = np; } else { sp = ((np >> 7) & 1) ? p1 : p0; col = (np >> 8) * 128 + (np & 127); }
    sp += (size_t)k0 * ld + col;
#pragma unroll 8
    for (int i = 0; i < 32; ++i) { const int kk = 2 * i + (lane >> 5); scr[kk * 33 + (lane & 31)] = sp[(size_t)kk * ld] * scale * (kscale ? kscale[k0 + kk] : 1.0f); }
    LDS_WAIT(); asm volatile("" ::: "memory");
    const int c = lane & 7;
#pragma unroll
    for (int j = 0; j < 4; ++j) { const int n = (lane >> 3) + 8 * j; const LAS float* s = scr + (8 * c) * 33 + n;
        u32x2 o; o.x = pg8::pk4f8(s[0 * 33], s[1 * 33], s[2 * 33], s[3 * 33]); o.y = pg8::pk4f8(s[4 * 33], s[5 * 33], s[6 * 33], s[7 * 33]);
        const int ng = row0 + n0 + n;
        *(u32x2*)(dst + ((size_t)(ng >> 4) * (K >> 6) + (k0 >> 6)) * 1024 + (ng & 15) * 64 + 8 * c) = o; }
    LDS_WAIT(); asm volatile("" ::: "memory");
}
__device__ __forceinline__ void p0_convert(const Args& a, LAS unsigned char* lds, int bid, int G, int wave_s) {
    int tid_ = wave_s * 64 + pg8::lane_id(); asm volatile("" : "+v"(tid_)); const int tid = tid_, lane = tid & 63, wave = __builtin_amdgcn_readfirstlane(tid >> 6);
    unsigned char* ws = a.ws;
    LAS float* scr = (LAS float*)(lds + wave * 16384);
    const int gw = bid * NWAVES + wave, NGW = G * NWAVES;
    constexpr int I_INQ = 16 * 8, I_INB = 16 * 40, I_INC = 16 * 32, I_SQ = 16 * 32, I_GU = 16 * 16 * 32, I_DN = 16 * 8 * 32;
    constexpr int I_LAYER = I_INQ + I_INB + I_INC + 5 * I_SQ + I_GU + I_DN;
    for (int it = gw; it < 2 * I_LAYER; it += NGW) {
        const int l = it / I_LAYER; int r = it % I_LAYER;
        unsigned char* wl = ws + WS_W + (size_t)l * W_LAYER;
        const float* w_in = a.in[2] + (size_t)l * D * DIN;
        if (r < I_INQ) { transpose_item8(w_in, nullptr, DIN, 0, 0.125f * pg8::F8_SW, D, 8, wl + W_IN, 0, scr, r, lane); continue; } r -= I_INQ;
        if (r < I_INB) { transpose_item8(w_in + 256, nullptr, DIN, 0, pg8::F8_SW, D, 40, wl + W_IN, 256, scr, r, lane); continue; } r -= I_INB;
        if (r < I_INC) { transpose_item8(w_in + 1552, nullptr, DIN, 0, pg8::F8_SW, D, 32, wl + W_IN, 1792, scr, r, lane); continue; } r -= I_INC;
        if (r < I_SQ) { transpose_item8(a.in[10] + (size_t)l * D * D, nullptr, D, 0, pg8::F8_SW, D, 32, wl + W_OUT, 0, scr, r, lane); continue; } r -= I_SQ;
        if (r < I_SQ) { transpose_item8(a.in[11] + (size_t)l * D * D, nullptr, D, 0, 0.0625f * pg8::F8_SW, D, 32, wl + W_Q, 0, scr, r, lane, a.in[20] + (size_t)(l * 3 + 0) * D); continue; } r -= I_SQ;
        if (r < I_SQ) { transpose_item8(a.in[14] + (size_t)l * D * D, nullptr, D, 0, pg8::F8_SW, D, 32, wl + W_O, 0, scr, r, lane); continue; } r -= I_SQ;
        if (r < I_SQ) { transpose_item(a.in[12] + (size_t)l * D * D, nullptr, D, 0, 1.0f, D, 32, (bf16_t*)(ws + WS_WKV), l * 2048, scr, r, lane); continue; } r -= I_SQ;
        if (r < I_SQ) { transpose_item(a.in[13] + (size_t)l * D * D, nullptr, D, 0, 1.0f, D, 32, (bf16_t*)(ws + WS_WKV), l * 2048 + 1024, scr, r, lane); continue; } r -= I_SQ;
        if (r < I_GU) { const int e = r / 512, rr = r % 512; const size_t eo = ((size_t)l * 16 + e) * D * 512;
            transpose_item8(a.in[17] + eo, a.in[18] + eo, 512, 2, pg8::F8_SW, D, 32, wl + W_GU, e * 1024, scr, rr, lane); continue; } r -= I_GU;
        { const int e = r / 256, rr = r % 256; const size_t eo = ((size_t)l * 16 + e) * 512 * D;
            transpose_item8(a.in[19] + eo, nullptr, D, 0, pg8::F8_SW, 512, 32, wl + W_D, e * 1024, scr, rr, lane); }
    }
    const size_t gt = (size_t)bid * NTHR + tid, NT = (size_t)G * NTHR;
    for (int it = gw; it < 2 * 16 * 16; it += NGW) { const int l = it >> 8, kc = (it >> 4) & 15, n = (it & 15) * 64 + lane;
        const float* wq = a.in[11] + (size_t)l * D * D; const float* gg = a.in[20] + (size_t)(l * 3) * D; const float* bb = a.in[21] + (size_t)(l * 3) * D; float cs = 0.f, bq = 0.f;
#pragma unroll 8
        for (int k = 64 * kc; k < 64 * kc + 64; ++k) { const float w = wq[(size_t)k * D + n] * 0.0625f; cs += pg8::f8round(w * gg[k] * pg8::F8_SW) * (1.0f / pg8::F8_SW); bq += w * bb[k]; }
        float* tb = (float*)(ws + WS_CS) + (size_t)l * 2 * 16 * 1024; tb[kc * 1024 + n] = cs; tb[16 * 1024 + kc * 1024 + n] = bq; }
    for (size_t i = gt; i < (size_t)2 * 256 * 128; i += NT) {
        const int l = (int)(i / (256 * 128)), r = (int)(i % (256 * 128)), j = r / 128, k8 = r % 128;
        const float* w_in = a.in[2] + (size_t)l * D * DIN; const float* w_a2 = a.in[3] + (size_t)l * 16 * 256;
        float wa[16];
#pragma unroll
        for (int q = 0; q < 16; ++q) wa[q] = w_a2[q * 256 + j];
        float o[8];
#pragma unroll
        for (int kk = 0; kk < 8; ++kk) { const float* wr = w_in + (size_t)(8 * k8 + kk) * DIN + 1536; float s = 0.f;
#pragma unroll
            for (int q = 0; q < 16; q += 4) { const f32x4 v = *(const f32x4*)(wr + q); s += v[0] * wa[q] + v[1] * wa[q + 1] + v[2] * wa[q + 2] + v[3] * wa[q + 3]; }
            o[kk] = s; }
        { const int ng = 1536 + j, kk = 8 * k8; u32x2 o8; o8.x = pg8::pk4f8(o[0] * pg8::F8_SW, o[1] * pg8::F8_SW, o[2] * pg8::F8_SW, o[3] * pg8::F8_SW); o8.y = pg8::pk4f8(o[4] * pg8::F8_SW, o[5] * pg8::F8_SW, o[6] * pg8::F8_SW, o[7] * pg8::F8_SW);
          *(u32x2*)(ws + WS_W + (size_t)l * W_LAYER + W_IN + ((size_t)(ng >> 4) * (D >> 6) + (kk >> 6)) * 1024 + (ng & 15) * 64 + (kk & 63)) = o8; }
    }
    for (size_t i = gt; i < (size_t)2 * 4 * 128 * 16; i += NT) {
        const int s8 = (int)(i & 15), t = (int)((i >> 4) & 127);
        const float* src = a.in[6] + i * 8; float o[8];
#pragma unroll
        for (int q = 0; q < 8; ++q) o[q] = ((8 * s8 + q) / 64 <= t / 64) ? src[q] : 0.f;
        *(u32x4*)((bf16_t*)(ws + WS_WM) + i * 8) = pack8(o);
    }
    for (size_t i = gt; i < (size_t)M * D / 8; i += NT) {
        const f32x4 v0 = *(const f32x4*)(a.in[0] + i * 8), v1 = *(const f32x4*)(a.in[0] + i * 8 + 4);
        u32x4 w; w.x = pk2(v0[0], v0[1]); w.y = pk2(v0[2], v0[3]); w.z = pk2(v1[0], v1[1]); w.w = pk2(v1[2], v1[3]);
        *(u32x4*)((bf16_t*)(ws + WS_X) + i * 8) = w;
        u32x2 q8; q8.x = pg8::pk4f8(v0[0] * pg8::F8_SX, v0[1] * pg8::F8_SX, v0[2] * pg8::F8_SX, v0[3] * pg8::F8_SX); q8.y = pg8::pk4f8(v1[0] * pg8::F8_SX, v1[1] * pg8::F8_SX, v1[2] * pg8::F8_SX, v1[3] * pg8::F8_SX);
        *(u32x2*)(ws + WS_X8IN + i * 8) = q8;
    }
    for (size_t i = gt; i < (size_t)MKV * D / 8; i += NT) {
        const f32x4 v0 = *(const f32x4*)(a.in[1] + i * 8), v1 = *(const f32x4*)(a.in[1] + i * 8 + 4);
        u32x4 w; w.x = pk2(v0[0], v0[1]); w.y = pk2(v0[2], v0[3]); w.z = pk2(v1[0], v1[1]); w.w = pk2(v1[2], v1[3]);
        *(u32x4*)((bf16_t*)(ws + WS_MEMB) + i * 8) = w;
    }
}

constexpr int GL_KD = 0, GL_QS = 9216, GL_VS = 18432, GL_PSUM = 35840, GL_DL = 37888, GL_SSQ = 38144;
template <bool FINAL>
__device__ __forceinline__ void gla_phase(LAS unsigned char* lds, const bf16_t* P, float* Send, float* Ltot, bf16_t* Y, const float* gn_g, int bid, int G, int wave_s) {
    int tid_ = wave_s * 64 + pg8::lane_id(); asm volatile("" : "+v"(tid_)); const int tid = tid_, lane = tid & 63, wave = __builtin_amdgcn_readfirstlane(tid >> 6);
    const unsigned lb = (unsigned)(size_t)lds;
    const int g = lane >> 4, l15 = lane & 15, q4 = l15 >> 2, p4 = lane & 3;
    const int kq = tid & 63, part = wave;
    for (int item = bid; item < 256; item += G) {
        const int b = item >> 5, h = (item >> 3) & 3, run = item & 7, bh = item >> 3;
        f32x4 sacc[4];
#pragma unroll
        for (int kt = 0; kt < 4; ++kt) sacc[kt] = (f32x4){0.f, 0.f, 0.f, 0.f};
        if (FINAL) {
            for (int i = 0; i < run; ++i) {
                const float* se = Send + ((size_t)(bh * 8 + i) * 64) * 128; const float* lt = Ltot + (size_t)(bh * 8 + i) * 64;
#pragma unroll
                for (int kt = 0; kt < 4; ++kt)
#pragma unroll
                    for (int r = 0; r < 4; ++r) { const int k = 16 * kt + 4 * g + r; sacc[kt][r] = __expf(lt[k]) * sacc[kt][r] + se[(size_t)k * 128 + 16 * wave + l15]; }
            }
        }
        float ltot_acc = 0.f;
        unsigned short graw[8], kraw[8]; u32x4 vraw[2], qraw; u32x2 rraw[4];
        const int v_row = tid >> 4, v_c16 = tid & 15, q_row = tid >> 3, q_c16 = tid & 7;
        const int ycol = h * 128 + 16 * wave + 4 * g;
#define GLA_FETCH(CC) do { const size_t tf_ = (size_t)b * SEQ + (size_t)(run * 16 + (CC)) * 64; \
            _Pragma("unroll") for (int i = 0; i < 8; ++i) { const bf16_t* rp = P + (tf_ + 8 * part + i) * NP + h * 64 + kq; graw[i] = rp[PG]; kraw[i] = rp[PK]; } \
            _Pragma("unroll") for (int i = 0; i < 2; ++i) vraw[i] = *(const u32x4*)(P + (tf_ + v_row + 32 * i) * NP + PV + h * 128 + v_c16 * 8); \
            if (FINAL) { qraw = *(const u32x4*)(P + (tf_ + q_row) * NP + PQ + h * 64 + q_c16 * 8); \
                _Pragma("unroll") for (int tt = 0; tt < 4; ++tt) rraw[tt] = *(const u32x2*)(P + (tf_ + 16 * tt + l15) * NP + PR + ycol); } } while (0)
        GLA_FETCH(0);
        for (int c = 0; c < 16; ++c) {
            const size_t t0 = (size_t)b * SEQ + (size_t)(run * 16 + c) * 64;
            __syncthreads();
            float gv[8], kv[8];
#pragma unroll
            for (int i = 0; i < 8; ++i) { gv[i] = __builtin_bit_cast(float, (unsigned)graw[i] << 16); kv[i] = __builtin_bit_cast(float, (unsigned)kraw[i] << 16); }
#pragma unroll
            for (int i = 1; i < 8; ++i) gv[i] += gv[i - 1];
            ((LAS float*)(lds + GL_PSUM))[part * 64 + kq] = gv[7];
#pragma unroll
            for (int i = 0; i < 2; ++i) *(LAS u32x4*)(lds + GL_VS + (v_row + 32 * i) * 272 + v_c16 * 16) = vraw[i];
            u32x2 rcur[4];
            if (FINAL) { *(LAS u32x4*)(lds + GL_QS + q_row * 144 + q_c16 * 16) = qraw;
#pragma unroll
                for (int tt = 0; tt < 4; ++tt) rcur[tt] = rraw[tt]; }
            if (c + 1 < 16) GLA_FETCH(c + 1);
            __syncthreads();
            float offs = 0.f, bl = 0.f;
#pragma unroll
            for (int p = 0; p < 8; ++p) { const float v = ((LAS float*)(lds + GL_PSUM))[p * 64 + kq]; offs += (p < part) ? v : 0.f; bl += v; }
#pragma unroll
            for (int i = 0; i < 8; ++i) { const float kd = kv[i] * __expf(bl - (offs + gv[i]));
                *(LAS unsigned short*)(lds + GL_KD + (8 * part + i) * 144 + kq * 2) = (unsigned short)(pk2(kd, 0.f) & 0xffffu); }
            if (part == 0) ((LAS float*)(lds + GL_DL))[kq] = __expf(bl);
            ltot_acc += bl;
            __syncthreads();
#pragma unroll
            for (int kt = 0; kt < 4; ++kt) { const f32x4 dl = *(LAS f32x4*)(lds + GL_DL + (16 * kt + 4 * g) * 4); sacc[kt] = sacc[kt] * dl; }
#pragma unroll
            for (int ks = 0; ks < 2; ++ks) {
                const unsigned vrow = lb + GL_VS + (unsigned)(32 * ks + 8 * g + q4) * 272u + (unsigned)(16 * wave + 4 * p4) * 2u;
                const bf16x8 vb = cat8(vtr(vrow), vtr(vrow + 4u * 272u));
#pragma unroll
                for (int kt = 0; kt < 4; ++kt) {
                    const unsigned krow = lb + GL_KD + (unsigned)(32 * ks + 8 * g + q4) * 144u + (unsigned)(16 * kt + 4 * p4) * 2u;
                    const bf16x8 ka = cat8(vtr(krow), vtr(krow + 4u * 144u));
                    sacc[kt] = __builtin_amdgcn_mfma_f32_16x16x32_bf16(ka, vb, sacc[kt], 0, 0, 0);
                }
            }
            if (FINAL) {
                f32x4 oacc[4];
#pragma unroll
                for (int tt = 0; tt < 4; ++tt) oacc[tt] = (f32x4){0.f, 0.f, 0.f, 0.f};
#pragma unroll
                for (int ks2 = 0; ks2 < 2; ++ks2) {
                    u32x4 spw; spw.x = pk2(sacc[2 * ks2][0], sacc[2 * ks2][1]); spw.y = pk2(sacc[2 * ks2][2], sacc[2 * ks2][3]);
                    spw.z = pk2(sacc[2 * ks2 + 1][0], sacc[2 * ks2 + 1][1]); spw.w = pk2(sacc[2 * ks2 + 1][2], sacc[2 * ks2 + 1][3]);
                    const bf16x8 sp = __builtin_bit_cast(bf16x8, spw);
#pragma unroll
                    for (int tt = 0; tt < 4; ++tt) {
                        const LAS unsigned char* qp = lds + GL_QS + (16 * tt + l15) * 144 + (32 * ks2 + 4 * g) * 2;
                        const u32x2 qlo = *(const LAS u32x2*)qp, qhi = *(const LAS u32x2*)(qp + 32);
                        u32x4 qw; qw.x = qlo.x; qw.y = qlo.y; qw.z = qhi.x; qw.w = qhi.y;
                        oacc[tt] = __builtin_amdgcn_mfma_f32_16x16x32_bf16(sp, __builtin_bit_cast(bf16x8, qw), oacc[tt], 0, 0, 0);
                    }
                }
#pragma unroll
                for (int tt = 0; tt < 4; ++tt) { float s = oacc[tt][0] * oacc[tt][0] + oacc[tt][1] * oacc[tt][1] + oacc[tt][2] * oacc[tt][2] + oacc[tt][3] * oacc[tt][3];
                    s += shx(s, 16, lane); s += shx(s, 32, lane);
                    if (g == 0) ((LAS float*)(lds + GL_SSQ))[wave * 64 + 16 * tt + l15] = s; }
                __syncthreads();
                const int col = h * 128 + 16 * wave + 4 * g;
                const f32x4 gn = *(const f32x4*)(gn_g + col);
#pragma unroll
                for (int tt = 0; tt < 4; ++tt) { float tot = 0.f;
#pragma unroll
                    for (int w2 = 0; w2 < 8; ++w2) tot += ((LAS float*)(lds + GL_SSQ))[w2 * 64 + 16 * tt + l15];
                    const float rs = __builtin_amdgcn_rsqf(tot * (1.0f / 128.0f) + 1e-6f);
                    const size_t tok = t0 + 16 * tt + l15;
                    const u32x2 rr = rcur[tt];
                    const float rq = rs * pg8::F8_SM;
                    *(unsigned*)((unsigned char*)Y + tok * D + col) = pg8::pk4f8(oacc[tt][0] * rq * gn[0] * bflo(rr.x), oacc[tt][1] * rq * gn[1] * bfhi(rr.x), oacc[tt][2] * rq * gn[2] * bflo(rr.y), oacc[tt][3] * rq * gn[3] * bfhi(rr.y)); }
            }
        }
        if (!FINAL) {
            float* se = Send + ((size_t)(bh * 8 + run) * 64) * 128;
#pragma unroll
            for (int kt = 0; kt < 4; ++kt)
#pragma unroll
                for (int r = 0; r < 4; ++r) se[(size_t)(16 * kt + 4 * g + r) * 128 + 16 * wave + l15] = sacc[kt][r];
            if (part == 0) Ltot[(size_t)(bh * 8 + run) * 64 + kq] = ltot_acc;
        }
    }
}

#undef GLA_FETCH
constexpr int SG_VN = 0;
__device__ __forceinline__ void sgu_phase(LAS unsigned char* lds, const bf16_t* P, const bf16_t* Wm, const float* b_s, const float* lg, const float* lb_, bf16_t* Y, int bid, int G, int wave_s) {
    int tid_ = wave_s * 64 + pg8::lane_id(); asm volatile("" : "+v"(tid_)); const int tid = tid_, lane = tid & 63, wave = __builtin_amdgcn_readfirstlane(tid >> 6);
    const unsigned lb = (unsigned)(size_t)lds;
    const int g = lane >> 4, l15 = lane & 15, q4 = l15 >> 2, p4 = lane & 3;
    const int row = tid >> 2, qu = tid & 3;
    u32x4 vraw[4]; u32x2 uraw[8];
#define SGU_FETCH(IT) do { const int blk_ = (IT) >> 2, gr_ = (IT) & 3; const size_t tf_ = (size_t)blk_ * 128; \
        const bf16_t* src_ = P + (tf_ + row) * NP + PVS + gr_ * 128 + 32 * qu; \
        _Pragma("unroll") for (int i = 0; i < 4; ++i) vraw[i] = *(const u32x4*)(src_ + 8 * i); \
        const bf16_t* us_ = P + (tf_ + 16 * wave + l15) * NP + PU + gr_ * 128 + 4 * g; \
        _Pragma("unroll") for (int ct = 0; ct < 8; ++ct) uraw[ct] = *(const u32x2*)(us_ + 16 * ct); } while (0)
    if (bid < 2048) SGU_FETCH(bid);
    for (int item = bid; item < 2048; item += G) {
        const int blk = item >> 2, gr = item & 3; const size_t t0 = (size_t)blk * 128;
        __syncthreads();
        u32x2 ucur[8];
        { float v[32];
#pragma unroll
          for (int i = 0; i < 4; ++i) { float f[8]; unpack8(vraw[i], f);
#pragma unroll
              for (int j = 0; j < 8; ++j) v[8 * i + j] = f[j]; }
#pragma unroll
          for (int ct = 0; ct < 8; ++ct) ucur[ct] = uraw[ct];
          if (item + G < 2048) SGU_FETCH(item + G);
          float s = 0.f;
#pragma unroll
          for (int i = 0; i < 32; ++i) s += v[i];
          s += shx(s, 1, lane); s += shx(s, 2, lane);
          const float mu = s * (1.0f / 128.0f); float qq = 0.f;
#pragma unroll
          for (int i = 0; i < 32; ++i) { v[i] -= mu; qq += v[i] * v[i]; }
          qq += shx(qq, 1, lane); qq += shx(qq, 2, lane);
          const float rs = __builtin_amdgcn_rsqf(qq * (1.0f / 128.0f) + LN_EPS);
          const float* gp = lg + gr * 128 + 32 * qu; const float* bp = lb_ + gr * 128 + 32 * qu;
#pragma unroll
          for (int i = 0; i < 4; ++i) { float f[8];
#pragma unroll
              for (int j = 0; j < 8; ++j) f[j] = v[8 * i + j] * rs * gp[8 * i + j] + bp[8 * i + j];
              *(LAS u32x4*)(lds + SG_VN + row * 272 + (32 * qu + 8 * i) * 2) = pack8(f); }
        }
        __syncthreads();
        const int nks = (wave < 4) ? 2 : 4;
        bf16x8 wf[4];
#pragma unroll
        for (int ks = 0; ks < 4; ++ks) wf[ks] = *(const bf16x8*)(Wm + ((size_t)(gr * 128 + 16 * wave + l15)) * 128 + 32 * ks + 8 * g);
        const size_t tok = t0 + 16 * wave + l15; const float bs = b_s[gr * 128 + 16 * wave + l15];
        unsigned vb0 = lb + SG_VN + (unsigned)(8 * g + q4) * 272u + (unsigned)(4 * p4) * 2u; asm volatile("" : "+v"(vb0));
#pragma unroll
        for (int ct = 0; ct < 8; ++ct) {
            f32x4 acc = (f32x4){0.f, 0.f, 0.f, 0.f};
#pragma unroll
            for (int ks = 0; ks < 4; ++ks) {
                if (ks < nks) {
                    const unsigned vrow = vb0 + (unsigned)(32 * ks * 272 + 32 * ct);
                    const bf16x8 va = cat8(vtr(vrow), vtr(vrow + 4u * 272u));
                    acc = __builtin_amdgcn_mfma_f32_16x16x32_bf16(va, wf[ks], acc, 0, 0, 0);
                }
            }
            const int col = gr * 128 + 16 * ct + 4 * g;
            const u32x2 uu = ucur[ct];
            *(unsigned*)((unsigned char*)Y + tok * D + 512 + col) = pg8::pk4f8(bflo(uu.x) * (acc[0] + bs) * pg8::F8_SM, bfhi(uu.x) * (acc[1] + bs) * pg8::F8_SM, bflo(uu.y) * (acc[2] + bs) * pg8::F8_SM, bfhi(uu.y) * (acc[3] + bs) * pg8::F8_SM);
        }
    }
}
#undef SGU_FETCH

constexpr int AT_KPS = 1040, AT_VPS = 1088, AT_SLOT = 34816, AT_NSLOT = 3;
static_assert(AT_NSLOT * AT_SLOT <= LDSCTL_OFF, "attention LDS");
__device__ __forceinline__ void glds16(const void* gsrc, unsigned lds_dst) { unsigned keep;
    asm volatile("s_mov_b32 %0, m0\n\ts_mov_b32 m0, %2\n\ts_nop 0\n\tglobal_load_lds_dwordx4 %1, off\n\ts_mov_b32 m0, %0" : "=&s"(keep) : "v"(gsrc), "s"(lds_dst) : "memory"); }
__device__ __forceinline__ void attn_dma(unsigned lb, const char* kvb, int so, unsigned lane_off, int slot, int ps, int wave) {
#pragma unroll
    for (int j = 0; j < 4; ++j) { const int pi = 4 * wave + j, rlo = 32 * (pi >> 4) + (pi & 15);
        glds16(kvb + (size_t)(so + rlo * 8192) + lane_off, (unsigned)__builtin_amdgcn_readfirstlane((int)(lb + (unsigned)(slot * AT_SLOT + pi * ps)))); }
}
#define AT_WAITBAR(N) do { asm volatile("s_waitcnt vmcnt(" #N ") lgkmcnt(0)" ::: "memory"); __builtin_amdgcn_s_barrier(); asm volatile("" ::: "memory"); } while (0)
__device__ __forceinline__ void attn_phase(LAS unsigned char* lds, const bf16_t* Q, const bf16_t* KV, bf16_t* O, int layer, int bid, int G, int wave_s) {
    int tid_ = wave_s * 64 + pg8::lane_id(); asm volatile("" : "+v"(tid_)); const int tid = tid_, lane = tid & 63, wave = __builtin_amdgcn_readfirstlane(tid >> 6);
    const unsigned lb = (unsigned)(size_t)lds;
    const int r32 = lane & 31, hh = lane >> 5, q4 = (lane & 15) >> 2, p4 = lane & 3, blk = (lane >> 4) & 1;
    LAS unsigned char* kbase = lds + (r32 & 15) * AT_KPS + ((r32 >> 4) & 1) * 512 + hh * 16;
    unsigned vbase = lb + (unsigned)(4 * hh + q4) * (unsigned)AT_VPS + (unsigned)(16 * blk + 4 * p4) * 2u;
    unsigned lane_off = (unsigned)((lane >> 5) * 16 * 8192 + (lane & 31) * 16);
    asm volatile("" : "+v"(kbase), "+v"(vbase), "+v"(lane_off));
    const char* kvb = (const char*)KV;
    const int nun = (bid < 256) ? 4 * ((256 - bid + G - 1) / G) : 0;
#define AT_SRC(N, ST) ((int)((((size_t)(((bid + ((N) >> 2) * G) >> 5) * NMEM) * 4096 + layer * 2048 + ((N) & 3) * 256 + (((ST) >> 2) * 1024)) * 2) + ((ST) & 3) * 64 * 8192))
    __syncthreads();
    if (nun > 0) { attn_dma(lb, kvb, AT_SRC(0, 0), lane_off, 0, AT_KPS, wave); attn_dma(lb, kvb, AT_SRC(0, 1), lane_off, 1, AT_KPS, wave); AT_WAITBAR(4); }
    int sl = 0;
    for (int n = 0; n < nun; ++n) {
        const int pan = bid + (n >> 2) * G, h = n & 3, b = pan >> 5, qt = pan & 31;
        int ln_ = pg8::lane_id(); asm volatile("" : "+v"(ln_));
        const unsigned qoff = (unsigned)((wave * 8 * 64 + ln_) * 16);
        const char* qbase = (const char*)Q + (size_t)(pan * 4 + h) * 65536;
        char* obase = (char*)O + ((size_t)b * SEQ + qt * 256) * D + h * 256;
        const bool more = (n + 1 < nun);
        bf16x8 qf[16];
#pragma unroll
        for (int s = 0; s < 8; ++s) { const u32x4 raw = *(const GAS u32x4*)(qbase + qoff + 1024 * s); float f[8]; u32x2 h8;
            h8.x = raw.x; h8.y = raw.y; unpack8f8(h8, f);
#pragma unroll
            for (int i = 0; i < 8; ++i) f[i] *= (1.0f / pg8::F8_SQ);
            qf[s] = __builtin_bit_cast(bf16x8, pack8(f));
            h8.x = raw.z; h8.y = raw.w; unpack8f8(h8, f);
#pragma unroll
            for (int i = 0; i < 8; ++i) f[i] *= (1.0f / pg8::F8_SQ);
            qf[s + 8] = __builtin_bit_cast(bf16x8, pack8(f)); }
        float ml = 0.f, lsum = 0.f;
        bf16x8 pk[8][2];
#pragma unroll
        for (int st = 0; st < 4; ++st) {
            const int sl2 = (sl >= 1) ? sl - 1 : 2;
            if (st > 0) attn_dma(lb, kvb, AT_SRC(n, st + 2), lane_off, sl2, (st + 2 < 4) ? AT_KPS : AT_VPS, wave);
            LAS unsigned char* kb = kbase + sl * AT_SLOT;
            f32x16 sa[2];
#pragma unroll
            for (int kt = 0; kt < 2; ++kt)
#pragma unroll
                for (int r = 0; r < 16; ++r) sa[kt][r] = 0.f;
            bf16x8 kfa[2], kfb[2];
#define AT_KLD(dst, S0) do { _Pragma("unroll") for (int kt = 0; kt < 2; ++kt) dst[kt] = *(const LAS bf16x8*)(kb + kt * 16 * AT_KPS + 32 * (S0)); } while (0)
#define AT_KMM(src, S0) do { _Pragma("unroll") for (int kt = 0; kt < 2; ++kt) sa[kt] = __builtin_amdgcn_mfma_f32_32x32x16_bf16(src[kt], qf[(S0)], sa[kt], 0, 0, 0); } while (0)
            AT_KLD(kfa, 0); __builtin_amdgcn_sched_barrier(0);
#pragma unroll
            for (int bq = 0; bq < 8; ++bq) {
                AT_KLD(kfb, 2 * bq + 1); __builtin_amdgcn_sched_barrier(0);
                AT_KMM(kfa, 2 * bq); __builtin_amdgcn_sched_barrier(0);
                if (bq < 7) { AT_KLD(kfa, 2 * bq + 2); __builtin_amdgcn_sched_barrier(0); }
                AT_KMM(kfb, 2 * bq + 1); __builtin_amdgcn_sched_barrier(0);
            }
#undef AT_KLD
#undef AT_KMM
            if (st == 0) attn_dma(lb, kvb, AT_SRC(n, 2), lane_off, sl2, AT_KPS, wave);
            if (st == 0) { float mx = -3.0e38f;
#pragma unroll
                for (int kt = 0; kt < 2; ++kt)
#pragma unroll
                    for (int r = 0; r < 16; ++r) mx = __builtin_fmaxf(mx, sa[kt][r]);
                mx = __builtin_fmaxf(mx, shx(mx, 32, lane)); ml = mx * LOG2E; }
#pragma unroll
            for (int kt = 0; kt < 2; ++kt) {
                float p[16];
#pragma unroll
                for (int r = 0; r < 16; ++r) { p[r] = __builtin_amdgcn_exp2f(sa[kt][r] * LOG2E - ml); lsum += p[r]; }
#pragma unroll
                for (int s2 = 0; s2 < 2; ++s2) { u32x4 w; w.x = pk2(p[8 * s2 + 0], p[8 * s2 + 1]); w.y = pk2(p[8 * s2 + 2], p[8 * s2 + 3]); w.z = pk2(p[8 * s2 + 4], p[8 * s2 + 5]); w.w = pk2(p[8 * s2 + 6], p[8 * s2 + 7]);
                    pk[2 * st + kt][s2] = __builtin_bit_cast(bf16x8, w); }
            }
            AT_WAITBAR(4);
            sl = (sl == 2) ? 0 : sl + 1;
        }
        lsum += shx(lsum, 32, lane);
        f32x16 oacc[8];
#pragma unroll
        for (int dt = 0; dt < 8; ++dt)
#pragma unroll
            for (int r = 0; r < 16; ++r) oacc[dt][r] = 0.f;
#pragma unroll
        for (int st = 4; st < 8; ++st) {
            const bool issue = (st < 6) || more;
            if (issue) { const int s2 = (sl >= 1) ? sl - 1 : 2;
                if (st < 6) attn_dma(lb, kvb, AT_SRC(n, st + 2), lane_off, s2, AT_VPS, wave); else attn_dma(lb, kvb, AT_SRC(n + 1, st - 6), lane_off, s2, AT_KPS, wave); }
            const unsigned vb = vbase + (unsigned)(sl * AT_SLOT);
            bf16x8 vfa[2], vfb[2];
#define AT_VLD(dst, BT) do { const unsigned va_ = vb + (unsigned)((((BT) >> 3) & 1) * 16 * AT_VPS + (((BT) >> 2) & 1) * 512 + ((BT) & 3) * 128); \
                _Pragma("unroll") for (int d_ = 0; d_ < 2; ++d_) dst[d_] = cat8(vtr(va_ + 64u * d_), vtr(va_ + 64u * d_ + 8u * AT_VPS)); } while (0)
#define AT_VMM(src, BT) do { _Pragma("unroll") for (int d_ = 0; d_ < 2; ++d_) oacc[2 * ((BT) & 3) + d_] = __builtin_amdgcn_mfma_f32_32x32x16_bf16(src[d_], pk[2 * (st - 4) + (((BT) >> 3) & 1)][((BT) >> 2) & 1], oacc[2 * ((BT) & 3) + d_], 0, 0, 0); } while (0)
            AT_VLD(vfa, 0); __builtin_amdgcn_sched_barrier(0);
#pragma unroll
            for (int bq = 0; bq < 8; ++bq) {
                AT_VLD(vfb, 2 * bq + 1); __builtin_amdgcn_sched_barrier(0);
                AT_VMM(vfa, 2 * bq); __builtin_amdgcn_sched_barrier(0);
                if (bq < 7) { AT_VLD(vfa, 2 * bq + 2); __builtin_amdgcn_sched_barrier(0); }
                AT_VMM(vfb, 2 * bq + 1); __builtin_amdgcn_sched_barrier(0);
            }
#undef AT_VLD
#undef AT_VMM
            if (issue) AT_WAITBAR(4); else AT_WAITBAR(0);
            sl = (sl == 2) ? 0 : sl + 1;
        }
        const float inv = 1.0f / lsum;
        int ln2 = pg8::lane_id(); asm volatile("" : "+v"(ln2));
        GAS char* op = (GAS char*)obase + (unsigned)((wave * 32 + (ln2 & 31)) * D) + ((ln2 >> 5) ? 16 : 0);
        const float sc = inv * pg8::F8_SO;
#pragma unroll
        for (int dt = 0; dt < 8; ++dt) {
            unsigned dw[4];
#pragma unroll
            for (int g4 = 0; g4 < 4; ++g4) dw[g4] = pg8::pk4f8(oacc[dt][4 * g4 + 0] * sc, oacc[dt][4 * g4 + 1] * sc, oacc[dt][4 * g4 + 2] * sc, oacc[dt][4 * g4 + 3] * sc);
            { const auto r = __builtin_amdgcn_permlane32_swap(dw[0], dw[2], false, false); dw[0] = r[0]; dw[2] = r[1]; }
            { const auto r = __builtin_amdgcn_permlane32_swap(dw[1], dw[3], false, false); dw[1] = r[0]; dw[3] = r[1]; }
            u32x4 w; w.x = dw[0]; w.y = dw[2]; w.z = dw[1]; w.w = dw[3];
            *(GAS u32x4*)(op + 32 * dt) = w; }
    }
    asm volatile("s_waitcnt vmcnt(0)" ::: "memory");
    __syncthreads();
}
#undef AT_SRC
#undef AT_WAITBAR

constexpr int RT_WH = 0, RT_WL = 32768, RT_SEL = 65536, RT_RK = 66048, RT_CNTW = 67072, RT_WBASE = 67584, RT_CS = 68608, RT_BB = 68672, RT_PART = 68736;
template <int MODE>
__device__ __forceinline__ void ln_phase(LAS unsigned char* lds, const Args& a, int l, int lnidx, bool last, bf16_t* Xout, int bid, int G, int wave_s) {
    int tid_ = wave_s * 64 + pg8::lane_id(); asm volatile("" : "+v"(tid_)); const int tid = tid_, lane = tid & 63, wave = __builtin_amdgcn_readfirstlane(tid >> 6);
    constexpr int R = (MODE == 2) ? 2 : 4;
    unsigned char* ws = a.ws;
    const bf16_t* Z = (const bf16_t*)(ws + WS_R + R_Z); const unsigned char* Ys8 = ws + WS_R + R_XS;
    pg8::f32x2_t* stats1 = (pg8::f32x2_t*)(ws + WS_STATS);
    const float* gp = a.in[20] + (size_t)(l * 3 + lnidx) * D; const float* bp = a.in[21] + (size_t)(l * 3 + lnidx) * D;
    float gg[16], bb[16];
#pragma unroll
    for (int j = 0; j < 2; ++j)
#pragma unroll
        for (int i = 0; i < 8; ++i) { gg[8 * j + i] = gp[8 * lane + 512 * j + i]; bb[8 * j + i] = bp[8 * lane + 512 * j + i]; }
    float g1v[16], b1v[16];
    if (MODE == 2) { const float* gq = a.in[20] + (size_t)(l * 3 + 1) * D; const float* bq_ = a.in[21] + (size_t)(l * 3 + 1) * D;
#pragma unroll
        for (int j = 0; j < 2; ++j)
#pragma unroll
            for (int i = 0; i < 8; ++i) { g1v[8 * j + i] = gq[8 * lane + 512 * j + i]; b1v[8 * j + i] = bq_[8 * lane + 512 * j + i]; } }
    if (MODE == 1) {
        __syncthreads();
        for (int idx = tid; idx < 2048; idx += NTHR) { const int s = idx >> 6, ln = idx & 63, e = ln & 15, g = ln >> 4; float hi[8], lo[8];
#pragma unroll
            for (int j = 0; j < 8; ++j) { const float w = a.in[15][(32 * s + 8 * g + j) * 16 + e] * gp[32 * s + 8 * g + j]; const float h = bflo(pk2(w, 0.f) & 0xffffu); hi[j] = h; lo[j] = w - h; }
            *(LAS u32x4*)(lds + RT_WH + idx * 16) = pack8(hi); *(LAS u32x4*)(lds + RT_WL + idx * 16) = pack8(lo); }
        { const int e = tid & 15, kp = tid >> 4; float cs = 0.f, bs = 0.f;
          for (int k = 32 * kp; k < 32 * kp + 32; ++k) { const float wr = a.in[15][k * 16 + e]; const float w = wr * gp[k]; const float h = bflo(pk2(w, 0.f) & 0xffffu); const float lo2 = bflo(pk2(w - h, 0.f) & 0xffffu); cs += h + lo2; bs += bp[k] * wr; }
          ((LAS float*)(lds + RT_PART))[kp * 32 + e] = cs; ((LAS float*)(lds + RT_PART))[kp * 32 + 16 + e] = bs; }
        __syncthreads();
        if (tid < 32) { float t = 0.f; for (int kp = 0; kp < 32; ++kp) t += ((LAS float*)(lds + RT_PART))[kp * 32 + tid];
            if (tid < 16) ((LAS float*)(lds + RT_CS))[tid] = t; else ((LAS float*)(lds + RT_BB))[tid - 16] = t + a.in[16][tid - 16]; }
        __syncthreads();
    }
    for (int blk = bid; blk < 256; blk += G) {
        int run[16];
#pragma unroll
        for (int e = 0; e < 16; ++e) run[e] = 0;
        u32x4 pa_[R][2]; u32x2 pb_[R][2], pc_[R][2]; float pw0[R], pw1[R]; pg8::f32x2_t pst[R];
#define LN_LOAD(ROW0) do { _Pragma("unroll") for (int r = 0; r < R; ++r) { const size_t row = (ROW0) + r; \
            if (MODE == 2) { const int* ts = (const int*)(ws + WS_TSLOT) + row * 2; const float* ti = (const float*)(ws + WS_TINFO) + row * 4; const int s0 = ts[0], s1 = ts[1]; pw0[r] = ti[2]; pw1[r] = ti[3]; pst[r] = stats1[row]; \
                _Pragma("unroll") for (int j = 0; j < 2; ++j) { pa_[r][j] = *(const u32x4*)(Z + row * D + 8 * lane + 512 * j); pb_[r][j] = *(const u32x2*)(Ys8 + (size_t)s0 * D + 8 * lane + 512 * j); pc_[r][j] = *(const u32x2*)(Ys8 + (size_t)s1 * D + 8 * lane + 512 * j); } } \
            else { _Pragma("unroll") for (int j = 0; j < 2; ++j) pa_[r][j] = *(const u32x4*)(Z + row * D + 8 * lane + 512 * j); } } } while (0)
        float mu_t = 0.f, rs_t = 0.f;
        LN_LOAD((size_t)blk * 256 + wave * 32);
        for (int ri = 0; ri < 32; ri += R) {
            const int rl0 = wave * 32 + ri; const size_t row0 = (size_t)blk * 256 + rl0;
            float v[R][16];
#pragma unroll
            for (int r = 0; r < R; ++r)
#pragma unroll
                for (int j = 0; j < 2; ++j) { float x[8]; unpack8(pa_[r][j], x);
                    if (MODE == 2) { float y0[8], y1[8]; unpack8f8(pb_[r][j], y0); unpack8f8(pc_[r][j], y1); const float mu1 = pst[r][0], rs1 = pst[r][1];
#pragma unroll
                        for (int i = 0; i < 8; ++i) v[r][8 * j + i] = ALPHA * ((x[i] - mu1) * rs1 * g1v[8 * j + i] + b1v[8 * j + i]) + (pw0[r] * (1.0f / pg8::F8_SY)) * y0[i] + (pw1[r] * (1.0f / pg8::F8_SY)) * y1[i]; }
                    else {
#pragma unroll
                        for (int i = 0; i < 8; ++i) v[r][8 * j + i] = x[i]; } }
            if (ri + R < 32) LN_LOAD(row0 + R);
            float s[R];
#pragma unroll
            for (int r = 0; r < R; ++r) { s[r] = 0.f;
#pragma unroll
                for (int i = 0; i < 16; ++i) s[r] += v[r][i]; }
#pragma unroll
            for (int o = 1; o < 64; o <<= 1)
#pragma unroll
                for (int r = 0; r < R; ++r) s[r] += shx(s[r], o, lane);
            float qq[R], mur[R];
#pragma unroll
            for (int r = 0; r < R; ++r) { const float mu = s[r] * (1.0f / D); mur[r] = mu; qq[r] = 0.f;
#pragma unroll
                for (int i = 0; i < 16; ++i) { v[r][i] -= mu; qq[r] += v[r][i] * v[r][i]; } }
#pragma unroll
            for (int o = 1; o < 64; o <<= 1)
#pragma unroll
                for (int r = 0; r < R; ++r) qq[r] += shx(qq[r], o, lane);
#pragma unroll
            for (int r = 0; r < R; ++r) { const float rs = __builtin_amdgcn_rsqf(qq[r] * (1.0f / D) + LN_EPS);
                if (MODE == 1) { if (lane == 0) stats1[row0 + r] = (pg8::f32x2_t){mur[r], rs};
                    if ((lane & 15) == ((ri + r) & 15)) { mu_t = mur[r]; rs_t = rs; } }
#pragma unroll
                for (int i = 0; i < 16; ++i) v[r][i] = v[r][i] * rs * gg[i] + bb[i]; }
#pragma unroll
            for (int r = 0; r < R; ++r) { const size_t row = row0 + r;
                if (MODE == 2 && last) {
#pragma unroll
                    for (int j = 0; j < 2; ++j) { float* op = a.out + row * D + 8 * lane + 512 * j;
                        *(f32x4*)op = (f32x4){v[r][8 * j], v[r][8 * j + 1], v[r][8 * j + 2], v[r][8 * j + 3]}; *(f32x4*)(op + 4) = (f32x4){v[r][8 * j + 4], v[r][8 * j + 5], v[r][8 * j + 6], v[r][8 * j + 7]}; }
                } else {
#pragma unroll
                    for (int j = 0; j < 2; ++j) { float f[8];
#pragma unroll
                        for (int i = 0; i < 8; ++i) f[i] = v[r][8 * j + i];
                        if (MODE != 1) *(u32x4*)(Xout + row * D + 8 * lane + 512 * j) = pack8(f);
                        if (MODE == 1 || MODE == 2) { u32x2 q8; q8.x = pg8::pk4f8(f[0] * pg8::F8_SX, f[1] * pg8::F8_SX, f[2] * pg8::F8_SX, f[3] * pg8::F8_SX); q8.y = pg8::pk4f8(f[4] * pg8::F8_SX, f[5] * pg8::F8_SX, f[6] * pg8::F8_SX, f[7] * pg8::F8_SX);
                            *(u32x2*)(ws + (MODE == 1 ? WS_R + R_X8 : WS_X8IN) + row * D + 8 * lane + 512 * j) = q8; } }
                } }
            if (MODE == 1 && ((ri + R) & 15) == 0) {
                const int tok = lane & 15, g = lane >> 4, tl = rl0 + R - 16 + tok; const size_t token = (size_t)blk * 256 + tl;
                const bf16_t* xr = Z + token * D + 8 * g;
                f32x4 acc = (f32x4){0.f, 0.f, 0.f, 0.f};
#pragma unroll 8
                for (int ks = 0; ks < 32; ++ks) { const bf16x8 xb = *(const bf16x8*)(xr + 32 * ks);
                    const bf16x8 wh = *(const LAS bf16x8*)(lds + RT_WH + (ks * 64 + lane) * 16), wl = *(const LAS bf16x8*)(lds + RT_WL + (ks * 64 + lane) * 16);
                    acc = __builtin_amdgcn_mfma_f32_16x16x32_bf16(wh, xb, acc, 0, 0, 0); acc = __builtin_amdgcn_mfma_f32_16x16x32_bf16(wl, xb, acc, 0, 0, 0); }
                const f32x4 csv = *(const LAS f32x4*)(lds + RT_CS + 16 * g), bbv = *(const LAS f32x4*)(lds + RT_BB + 16 * g);
                float lg[4] = {rs_t * (acc[0] - mu_t * csv[0]) + bbv[0], rs_t * (acc[1] - mu_t * csv[1]) + bbv[1], rs_t * (acc[2] - mu_t * csv[2]) + bbv[2], rs_t * (acc[3] - mu_t * csv[3]) + bbv[3]};
                float m = __builtin_fmaxf(__builtin_fmaxf(lg[0], lg[1]), __builtin_fmaxf(lg[2], lg[3]));
                m = __builtin_fmaxf(m, shx(m, 16, lane)); m = __builtin_fmaxf(m, shx(m, 32, lane));
                float t1 = -1.f, t2 = -1.f; int i1 = 0, i2 = 0;
#pragma unroll
                for (int r = 0; r < 4; ++r) { const float p = __expf(lg[r] - m); if (p > t1) { t2 = t1; i2 = i1; t1 = p; i1 = r; } else if (p > t2) { t2 = p; i2 = r; } }
                const float gs = t1 + t2; float bgs = gs; int bg = g;
                { const float o = shx(bgs, 16, lane); const int og = shxi(bg, 16, lane); if (o > bgs || (o == bgs && og < bg)) { bgs = o; bg = og; } }
                { const float o = shx(bgs, 32, lane); const int og = shxi(bg, 32, lane); if (o > bgs || (o == bgs && og < bg)) { bgs = o; bg = og; } }
                const bool mine = (bg == g); const int e0 = 4 * g + i1, e1 = 4 * g + i2;
                if (mine) { u32x4 info; info.x = (unsigned)e0; info.y = (unsigned)e1; info.z = __builtin_bit_cast(unsigned, t1 / gs); info.w = __builtin_bit_cast(unsigned, t2 / gs);
                    *(u32x4*)(ws + WS_TINFO + token * 16) = info; ((LAS unsigned short*)(lds + RT_SEL))[tl] = (unsigned short)(e0 | (e1 << 8)); }
                const unsigned long long below = (1ull << lane) - 1ull; int r0 = 0, r1 = 0;
#pragma unroll
                for (int e = 0; e < 16; ++e) { const bool hit = mine && (e0 == e || e1 == e); const unsigned long long mb = __ballot(hit); const int cb = __popcll(mb & below);
                    r0 = (e0 == e) ? run[e] + cb : r0; r1 = (e1 == e) ? run[e] + cb : r1; run[e] += __popcll(mb); }
                if (mine) { ((LAS unsigned short*)(lds + RT_RK))[2 * tl] = (unsigned short)r0; ((LAS unsigned short*)(lds + RT_RK))[2 * tl + 1] = (unsigned short)r1; }
            }
        }
        if (MODE == 1) {
            { int vsel = 0;
#pragma unroll
              for (int e = 0; e < 16; ++e) vsel = (lane == e) ? run[e] : vsel;
              if (lane < 16) ((LAS int*)(lds + RT_CNTW))[wave * 16 + lane] = vsel; }
            __syncthreads();
            if (tid < 16) { int base = 0;
#pragma unroll
                for (int w = 0; w < 8; ++w) { const int t = ((LAS int*)(lds + RT_CNTW))[w * 16 + tid]; ((LAS int*)(lds + RT_WBASE))[w * 16 + tid] = base; base += t; }
                ((int*)(ws + WS_WGCNT))[blk * 16 + tid] = base; }
            __syncthreads();
            { const int t = tid >> 1, k = tid & 1; const int e = (((LAS unsigned short*)(lds + RT_SEL))[t] >> (8 * k)) & 255;
              ((int*)(ws + WS_TRANK))[(size_t)blk * 512 + tid] = (int)((LAS unsigned short*)(lds + RT_RK))[tid] + ((LAS int*)(lds + RT_WBASE))[(t >> 5) * 16 + e]; }
            __syncthreads();
        }
    }
}

#undef LN_LOAD
constexpr int MG_TBL = 0, MG_TOT = 16384, MG_PRE = 16448, MG_BASE = 16512;
__device__ __forceinline__ void moe_gather_phase(LAS unsigned char* lds, unsigned char* ws, int bid, int G, int wave_s) {
    int tid_ = wave_s * 64 + pg8::lane_id(); asm volatile("" : "+v"(tid_)); const int tid = tid_, lane = tid & 63, wave = __builtin_amdgcn_readfirstlane(tid >> 6);
    LAS int* tbl = (LAS int*)(lds + MG_TBL); LAS int* tot = (LAS int*)(lds + MG_TOT); LAS int* pre = (LAS int*)(lds + MG_PRE); LAS int* base = (LAS int*)(lds + MG_BASE);
    LAS int* offs = (LAS int*)(lds + MISC_OFF) + 16; LAS int* tile_e = (LAS int*)(lds + TILEE_OFF);
    const bf16_t* X = (const bf16_t*)(ws + WS_X); bf16_t* Xs = (bf16_t*)(ws + WS_R + R_XS);
    for (int blk = bid; blk < 256; blk += G) {
        __syncthreads();
        for (int i = tid; i < 4096; i += NTHR) tbl[i] = ((const int*)(ws + WS_WGCNT))[i];
        __syncthreads();
        if (tid < 16) { int t = 0, p = 0; for (int c = 0; c < 256; ++c) { const int v = tbl[c * 16 + tid]; p += (c < blk) ? v : 0; t += v; } tot[tid] = t; pre[tid] = p; }
        __syncthreads();
        if (tid == 0) { int o = 0; for (int e = 0; e < 16; ++e) { offs[e] = o; base[e] = o + pre[e]; o += (tot[e] + 255) & ~255; } offs[16] = o; offs[17] = o >> 8; }
        __syncthreads();
        for (int rt = tid; rt < 528; rt += NTHR) { int e = 0;
#pragma unroll
            for (int q = 1; q < 16; ++q) e = (rt * 256 >= offs[q]) ? q : e;
            tile_e[rt] = e; }
        { const size_t tok = (size_t)blk * 256 + (tid >> 1); const int k = tid & 1;
          const int e = ((const int*)(ws + WS_TINFO))[tok * 4 + k]; const int rk = ((const int*)(ws + WS_TRANK))[tok * 2 + k];
          const int slot = base[e] + rk;
          ((int*)(ws + WS_TSLOT))[tok * 2 + k] = slot; ((int*)(ws + WS_SRCROW))[slot] = (int)tok; }
        for (int e = wave; e < 16; e += NWAVES) { const int npad = offs[e + 1] - offs[e] - tot[e];
            if (blk < npad && lane == 0) ((int*)(ws + WS_SRCROW))[offs[e] + tot[e] + blk] = 0; }
    }
}

#define GEMM_ALIGN true
#define GEMM_SP2 true
__global__ void __launch_bounds__(NTHR, 2) mk_fwd(Args args) {
    extern __shared__ __attribute__((aligned(16))) unsigned char lds_raw[];
    LAS unsigned char* lds = (LAS unsigned char*)lds_raw;
    const int tid = threadIdx.x; const int wave_s = __builtin_amdgcn_readfirstlane(tid >> 6);
    const int G = gridDim.x, bid = blockIdx.x;
    unsigned char* ws = args.ws;
    volatile LAS unsigned* MISC = (volatile LAS unsigned*)(lds + MISC_OFF);
    for (int u = tid; u < (LDS_BYTES - LDSCTL_OFF) / 4; u += NTHR) ((LAS unsigned*)(lds + LDSCTL_OFF))[u] = 0u;
    __syncthreads();
    XcdBarrier bar = xcd_barrier_post((unsigned*)(ws + WS_CTL) + CW_BAR, MISC + 8);
    bar.wv = wave_s;
#define GRID_BAR() xcd_barrier(bar)
#ifndef REP_MASK
#define REP_MASK 0
#endif
#define LOCAL_SYNC() do { asm volatile("s_waitcnt vmcnt(0)" ::: "memory"); __syncthreads(); } while (0)
#define PHASE(grp, ...) do { __VA_ARGS__; if (REP_MASK & (1 << (grp))) { GRID_BAR(); __VA_ARGS__; } } while (0)

#define WSQ ({ unsigned char* w_ = args.ws; asm volatile("" : "+s"(w_)); w_; })
#define X ((bf16_t*)(WSQ + WS_X))
#define P ((bf16_t*)(WSQ + WS_R + R_P))
#define Y ((bf16_t*)(WSQ + WS_R + R_Y))
#define Z ((bf16_t*)(WSQ + WS_R + R_Z))
#define Qb ((bf16_t*)(WSQ + WS_R + R_Q))
#define Ob ((bf16_t*)(WSQ + WS_R + R_O))
#define Xs ((bf16_t*)(WSQ + WS_R + R_XS))
#define Hb ((bf16_t*)(WSQ + WS_R + R_H))
#define KV ((bf16_t*)(WSQ + WS_KV))
#define wl (WSQ + WS_W + (size_t)l * W_LAYER)

    PHASE(0, p0_convert(args, lds, bid, G, wave_s));
    GRID_BAR();
    { const int tid_r = wave_s * 64 + pg8::lane_id();
      for (int i = bid * NTHR + tid_r; i < 2 * 2 * 1024; i += G * NTHR) { const int l = i >> 11, w = (i >> 10) & 1, n = i & 1023; const float* tb = (const float*)(WSQ + WS_CS) + (size_t)l * 2 * 16 * 1024 + w * 16 * 1024; float s = 0.f;
#pragma unroll
          for (int kc = 0; kc < 16; ++kc) s += tb[kc * 1024 + n];
          ((float*)(WSQ + WS_CS) + 65536)[i] = s; } }
    PHASE(1, { pg8::Gemm g{(const bf16_t*)(WSQ + WS_MEMB), (const bf16_t*)(WSQ + WS_WKV), MKV, 4096, D, wave_s}; pg8::StaticOrder S; S.init(MKV, 4096, G, bid);
      pg8::EpiPlain E{KV, 4096, 0xffff};
      pg8::gemm_phase<pg8::EpiPlain, pg8::StaticOrder, GEMM_ALIGN, GEMM_SP2>(lds, g, S, E); });

#pragma unroll 1
    for (int l = 0; l < 2; ++l) {
        PHASE(1, { pg8::Gemm g{(const bf16_t*)(WSQ + WS_X8IN), (const bf16_t*)(wl + W_IN), M, NP, D / 2, wave_s}; pg8::StaticOrder S; S.init(M, NP, G, bid);
          pg8::EpiInProj8 E{P, args.in[4] + l * 256};
          pg8::gemm_phase<pg8::EpiInProj8, pg8::StaticOrder, GEMM_ALIGN, GEMM_SP2>(lds, g, S, E); });
        GRID_BAR();
        PHASE(3, gla_phase<false>(lds, P, (float*)(WSQ + WS_SEND), (float*)(WSQ + WS_LTOT), Y, args.in[5] + l * 512, bid, G, wave_s));
        PHASE(4, sgu_phase(lds, P, (const bf16_t*)(WSQ + WS_WM) + (size_t)l * 4 * 128 * 128, args.in[7] + l * 512, args.in[8] + l * 512, args.in[9] + l * 512, Y, bid, G, wave_s));
        GRID_BAR();
        PHASE(3, gla_phase<true>(lds, P, (float*)(WSQ + WS_SEND), (float*)(WSQ + WS_LTOT), Y, args.in[5] + l * 512, bid, G, wave_s));
        GRID_BAR();
        PHASE(10, { pg8::Gemm g{Y, (const bf16_t*)(wl + W_OUT), M, D, D / 2, wave_s}; pg8::PanelOrder S{4, M / 256, G, bid};
          pg8::EpiResidStats8 E{X, Z, (pg8::f32x2_t*)(WSQ + WS_PART), WSQ + WS_R + R_X8};
          pg8::gemm_phase<pg8::EpiResidStats8, pg8::PanelOrder, GEMM_ALIGN, GEMM_SP2>(lds, g, S, E); });
        { const int tid_r = wave_s * 64 + pg8::lane_id();
          for (int pan = bid; pan < 256; pan += G) if (tid_r < 256) { const size_t row = (size_t)pan * 256 + tid_r; const pg8::f32x2_t* pp = (const pg8::f32x2_t*)(WSQ + WS_PART) + row * 16; float s1 = 0.f, s2 = 0.f;
#pragma unroll
              for (int q = 0; q < 16; ++q) { const pg8::f32x2_t v = pp[q]; s1 += v[0]; s2 += v[1]; }
              const float mu = s1 * (1.0f / D), var = s2 * (1.0f / D) - mu * mu; ((pg8::f32x2_t*)(WSQ + WS_STATS))[row] = (pg8::f32x2_t){mu, __builtin_amdgcn_rsqf(var + LN_EPS)}; } }
        LOCAL_SYNC();
        PHASE(10, { pg8::Gemm g{(const bf16_t*)(WSQ + WS_R + R_X8), (const bf16_t*)(wl + W_Q), M, D, D / 2, wave_s}; pg8::PanelOrder S{4, M / 256, G, bid};
          pg8::EpiQFragLN8 E{(unsigned char*)Qb, (const pg8::f32x2_t*)(WSQ + WS_STATS), (const float*)(WSQ + WS_CS) + 65536 + l * 2048, (const float*)(WSQ + WS_CS) + 65536 + l * 2048 + 1024};
          pg8::gemm_phase<pg8::EpiQFragLN8, pg8::PanelOrder, GEMM_ALIGN, GEMM_SP2>(lds, g, S, E); });
        PHASE(5, attn_phase(lds, Qb, KV, Ob, l, bid, G, wave_s));
        LOCAL_SYNC();
        PHASE(10, { pg8::Gemm g{Ob, (const bf16_t*)(wl + W_O), M, D, D / 2, wave_s}; pg8::PanelOrder S{4, M / 256, G, bid};
          pg8::EpiResidLN8 E{Z, (const pg8::f32x2_t*)(WSQ + WS_STATS), args.in[20] + (size_t)(l * 3) * D, args.in[21] + (size_t)(l * 3) * D};
          pg8::gemm_phase<pg8::EpiResidLN8, pg8::PanelOrder, GEMM_ALIGN, GEMM_SP2>(lds, g, S, E); });
        PHASE(9, ln_phase<1>(lds, args, l, 1, false, X, bid, G, wave_s));
        GRID_BAR();
        PHASE(7, moe_gather_phase(lds, WSQ, bid, G, wave_s));
        GRID_BAR();
        PHASE(2, { pg8::Gemm g{(const bf16_t*)(WSQ + WS_R + R_X8), (const bf16_t*)(wl + W_GU), MOE_ROWS, 16384, D / 2, wave_s}; pg8::MoeGatherOrder S{(const LAS int*)(lds + TILEE_OFF), (int)MISC[33] * 4, G, bid, (const int*)(WSQ + WS_SRCROW)};
          pg8::EpiGU8 E{(unsigned char*)Hb};
          pg8::gemm_phase<pg8::EpiGU8, pg8::MoeGatherOrder, GEMM_ALIGN, GEMM_SP2>(lds, g, S, E); });
        GRID_BAR();
        PHASE(2, { pg8::Gemm g{Hb, (const bf16_t*)(wl + W_D), MOE_ROWS, 16384, 256, wave_s}; pg8::MoeOrder S{(const LAS int*)(lds + TILEE_OFF), (int)MISC[33] * 4, G, bid};
          pg8::EpiPlain8 E{(unsigned char*)Xs, D, 3};
          pg8::gemm_phase<pg8::EpiPlain8, pg8::MoeOrder, GEMM_ALIGN, GEMM_SP2>(lds, g, S, E); });
        GRID_BAR();
        if (REP_MASK & (1 << 8)) { ln_phase<2>(lds, args, l, 2, l == 1, Z, bid, G, wave_s); GRID_BAR(); }
        ln_phase<2>(lds, args, l, 2, l == 1, X, bid, G, wave_s);
        if (l == 0) GRID_BAR();
    }
}
#undef X
#undef P
#undef Y
#undef Z
#undef Qb
#undef Ob
#undef Xs
#undef Hb
#undef KV
#undef wl
}

extern "C" void kernel_launch(void* const* d_in, const int* in_sizes, int n_in, void* d_out, int out_size, void* d_ws, size_t ws_size, hipStream_t stream) {
    using namespace mk;
    static int grid = 0;
    if (grid == 0) {
        if (n_in != 22 || in_sizes[0] != M * D || out_size != M * D || ws_size < WS_END) { fprintf(stderr, "kernel_launch: unexpected shapes (n_in %d, in0 %d, out %d, ws %zu, need %zu)\n", n_in, n_in > 0 ? in_sizes[0] : -1, out_size, ws_size, (size_t)WS_END); grid = -1; return; }
        int dev = 0, cus = 0;
        if (hipGetDevice(&dev) != hipSuccess || hipDeviceGetAttribute(&cus, hipDeviceAttributeMultiprocessorCount, dev) != hipSuccess) { grid = -1; return; }
        if (hipFuncSetAttribute((const void*)mk_fwd, hipFuncAttributeMaxDynamicSharedMemorySize, LDS_BYTES) != hipSuccess) { fprintf(stderr, "kernel_launch: hipFuncSetAttribute failed\n"); grid = -1; return; }
        int per_cu = 0;
        if (hipOccupancyMaxActiveBlocksPerMultiprocessor(&per_cu, (const void*)mk_fwd, NTHR, LDS_BYTES) != hipSuccess || per_cu < 1) fprintf(stderr, "kernel_launch: occupancy query says %d\n", per_cu);
        (void)hipGetLastError();
        grid = cus;
    }
    if (grid < 0) return;
    if (hipMemsetAsync((char*)d_ws + WS_CTL, 0, CTL_ZERO_BYTES, stream) != hipSuccess) return;
    Args a{};
    for (int i = 0; i < 22; ++i) a.in[i] = (const float*)d_in[i];
    a.out = (float*)d_out; a.ws = (unsigned char*)d_ws;
    hipLaunchKernelGGL(mk_fwd, dim3(grid), dim3(NTHR), LDS_BYTES, stream, a);
}
```

```cpp
#include <hip/hip_runtime.h>
#include <cstdio>
#include <cstdint>

namespace pg8 {
#define PG8_LAS __attribute__((address_space(3)))
typedef unsigned short bf16_t;
typedef short bf16x8 __attribute__((ext_vector_type(8)));
typedef float f32x4 __attribute__((ext_vector_type(4)));
typedef unsigned u32x4 __attribute__((ext_vector_type(4)));
typedef unsigned u32x2 __attribute__((ext_vector_type(2)));
constexpr int BM = 256, BK = 64, HALF = 128, HTB = HALF * BK * 2  , STAGE_BYTES = 8 * HTB, NXCD = 8, WGM = 8;

__host__ __device__ __forceinline__ int lds_byte(int r, int c) { const int st = (r >> 4) * 2 + (c >> 5), rr = r & 15, cc = c & 31, ob = rr * 64 + cc * 2; return st * 1024 + (ob ^ (((ob >> 9) & 1) << 5)); }
__host__ __device__ __forceinline__ void stage_rc(int b, int& R, int& C) { const int st = b / 1024, sb = b % 1024, swz = sb ^ (((sb >> 9) & 1) << 5); R = (st >> 1) * 16 + swz / 64; C = (st & 1) * 32 + (swz % 64) / 2; }
__host__ __device__ __forceinline__ int perm32(int rho) { const int n = rho >> 4, i = rho & 15; return 8 * (i >> 2) + 4 * n + (i & 3); }

struct Unit { int pm, pn; };
struct Gemm { const bf16_t* A; const bf16_t* Bt; int M, N, K; int wv; };
__device__ __forceinline__ int lane_id() { int l; asm volatile("v_mbcnt_lo_u32_b32 %0, -1, 0\n\tv_mbcnt_hi_u32_b32 %0, -1, %0" : "=v"(l)); return l; }

struct StaticOrder {
    static constexpr bool GATHER = false;
    int nM, nN, nwg, G, c; const int* src = nullptr;
    __host__ __device__ void init(int M, int N, int G_, int c_) { nM = M / BM; nN = N / BM; nwg = nM * nN; G = G_; c = c_; }
    __host__ __device__ bool next(int i, Unit& u) const {
        const long L = (long)i * G + c; if (L >= nwg) return false;
        int wgid = (int)L; { const int q = nwg / NXCD, r = nwg % NXCD, xcd = wgid % NXCD, off = wgid / NXCD; wgid = (xcd < r ? xcd * (q + 1) : r * (q + 1) + (xcd - r) * q) + off; }
        const int nig = WGM * nN, gid = wgid / nig, fm = gid * WGM, gsz = (nM - fm) < WGM ? (nM - fm) : WGM;
        u.pm = fm + ((wgid % nig) % gsz); u.pn = (wgid % nig) / gsz; return true;
    }
    __device__ __forceinline__ void a_ready(const Unit&) const {}
    __device__ __forceinline__ void done(const Unit&) const {}
};
struct PanelOrder {
    static constexpr bool GATHER = false;
    int nN, npan, G, c; const int* src = nullptr;
    __device__ __forceinline__ bool next(int i, Unit& u) const { const int p = c + (i / nN) * G; if (p >= npan) return false; u.pm = p; u.pn = i % nN; return true; }
    __device__ __forceinline__ void a_ready(const Unit&) const {}
    __device__ __forceinline__ void done(const Unit&) const {}
};
template <bool GATH_> struct MoeOrderT {
    static constexpr bool GATHER = GATH_;
    const PG8_LAS int* tile_e; int nunits, G, c; const int* src = nullptr;
    __device__ __forceinline__ bool next(int i, Unit& u) const {
        const int cc = ((G & 7) == 0) ? (c & 7) * (G >> 3) + (c >> 3) : c;
        const int L = i * G + cc; if (L >= nunits) return false;
        u.pm = L >> 2; u.pn = tile_e[L >> 2] * 4 + (L & 3); return true;
    }
    __device__ __forceinline__ void a_ready(const Unit&) const {}
    __device__ __forceinline__ void done(const Unit&) const {}
};
typedef MoeOrderT<false> MoeOrder; typedef MoeOrderT<true> MoeGatherOrder;

typedef float f32x2_t __attribute__((ext_vector_type(2))); typedef __bf16 bf16x2_t __attribute__((ext_vector_type(2)));
typedef __amdgpu_buffer_rsrc_t rsrc_t;
__device__ __forceinline__ rsrc_t mk_rsrc(const void* p) { return __builtin_amdgcn_make_buffer_rsrc((void*)p, 0, 0x7fffffff, 0x00020000); }
__device__ __forceinline__ u32x4 bld4(rsrc_t r, unsigned voff, unsigned soff) { return __builtin_bit_cast(u32x4, __builtin_amdgcn_raw_buffer_load_b128(r, voff, soff, 0)); }
__device__ __forceinline__ f32x2_t bld2f(rsrc_t r, unsigned voff, unsigned soff) { return __builtin_bit_cast(f32x2_t, __builtin_amdgcn_raw_buffer_load_b64(r, voff, soff, 0)); }
#define GST4(p) (*(__attribute__((address_space(1))) u32x4*)(p))
__device__ __forceinline__ float f8clamp(float x) { return __builtin_fminf(__builtin_fmaxf(x, -448.0f), 448.0f); }
__device__ __forceinline__ unsigned pk4f8(float a, float b, float c, float d) { int w = 0; w = __builtin_amdgcn_cvt_pk_fp8_f32(f8clamp(a), f8clamp(b), w, false); w = __builtin_amdgcn_cvt_pk_fp8_f32(f8clamp(c), f8clamp(d), w, true); return (unsigned)w; }
__device__ __forceinline__ float f8round(float x) { const int w = __builtin_amdgcn_cvt_pk_fp8_f32(f8clamp(x), 0.0f, 0, false); return __builtin_amdgcn_cvt_pk_f32_fp8(w, false)[0]; }
constexpr float F8_SX = 4.0f, F8_SW = 64.0f, F8_SH = 8.0f, F8_SO = 64.0f, F8_SY = 16.0f, F8_SQ = 64.0f, F8_SM = 4.0f, F8_SZ = 4.0f;
__device__ __forceinline__ unsigned pk2(float lo, float hi) { f32x2_t v = {lo, hi}; bf16x2_t b = __builtin_convertvector(v, bf16x2_t); return __builtin_bit_cast(unsigned, b); }
__device__ __forceinline__ float bflo(unsigned w) { return __builtin_bit_cast(float, w << 16); }
__device__ __forceinline__ float bfhi(unsigned w) { return __builtin_bit_cast(float, w & 0xffff0000u); }
__device__ __forceinline__ float f_silu(float x) { return x * __builtin_amdgcn_rcpf(1.0f + __builtin_amdgcn_exp2f(-1.4426950408889634f * x)); }
__device__ __forceinline__ float f_gelu_tanh(float x) { return x * __builtin_amdgcn_rcpf(1.0f + __builtin_amdgcn_exp2f(x * (-2.3022082f - 0.10294324f * x * x))); }
__device__ __forceinline__ float f_logsig16(float z) { const float t = __builtin_amdgcn_exp2f(-1.4426950408889634f * __builtin_fabsf(z)); return (__builtin_fminf(z, 0.0f) - 0.6931471805599453f * __builtin_amdgcn_logf(1.0f + t)) * 0.0625f; }

struct EpiPlain {
    static constexpr bool PERM = true, AFTER_DRAIN = false;
    bf16_t* O; int ldc; int cmask;
    __device__ __forceinline__ void operator()(const f32x4 (&acc)[2][2][4][2], const Unit& u, int wr, int wc, int fr, int fq) const {
        const int row0 = u.pm * BM + wr * 64 + fr, col0 = (u.pn & cmask) * BM + wc * 32 + 8 * fq;
#pragma unroll
        for (int ai = 0; ai < 2; ++ai)
#pragma unroll
            for (int m = 0; m < 4; ++m) { bf16_t* rowp = O + (size_t)(row0 + ai * HALF + m * 16) * ldc + col0;
#pragma unroll
                for (int bj = 0; bj < 2; ++bj) { const f32x4 v0 = acc[ai][bj][m][0], v1 = acc[ai][bj][m][1];
                    u32x4 w; w.x = pk2(v0[0], v0[1]); w.y = pk2(v0[2], v0[3]); w.z = pk2(v1[0], v1[1]); w.w = pk2(v1[2], v1[3]);
                    *(u32x4*)(rowp + bj * HALF) = w; } }
    }
};
struct EpiQFrag {
    static constexpr bool PERM = true, AFTER_DRAIN = false;
    bf16_t* O;
    __device__ __forceinline__ void operator()(const f32x4 (&acc)[2][2][4][2], const Unit& u, int wr, int wc, int fr, int fq) const {
        unsigned lo = (unsigned)(((fq >> 1) * 64 + fr + 32 * (fq & 1)) * 16); asm volatile("" : "+v"(lo));
        char* tile = (char*)(O + (size_t)(u.pm * 4 + u.pn) * 65536) + (size_t)(wr * 2 * 16 + wc * 2) * 1024 + lo;
#pragma unroll
        for (int ai = 0; ai < 2; ++ai)
#pragma unroll
            for (int m = 0; m < 4; ++m)
#pragma unroll
                for (int bj = 0; bj < 2; ++bj) { const f32x4 v0 = acc[ai][bj][m][0], v1 = acc[ai][bj][m][1];
                    u32x4 w; w.x = pk2(v0[0], v0[1]); w.y = pk2(v0[2], v0[3]); w.z = pk2(v1[0], v1[1]); w.w = pk2(v1[2], v1[3]);
                    *(u32x4*)(tile + ((4 * ai + (m >> 1)) * 16 + 8 * bj) * 1024 + (m & 1) * 256) = w; }
    }
};
struct EpiInProj {
    static constexpr bool PERM = true, AFTER_DRAIN = false;
    bf16_t* O; const float* b_a;
    template <int MODE> __device__ __forceinline__ void tile(const f32x4 (&acc)[2][2][4][2], const Unit& u, int wr, int wc, int fr, int fq) const {
        const int row0 = u.pm * BM + wr * 64 + fr, col0 = u.pn * BM + wc * 32 + 8 * fq;
        f32x4 bv[2][2];
#pragma unroll
        for (int bj = 0; bj < 2; ++bj)
#pragma unroll
            for (int n = 0; n < 2; ++n) bv[bj][n] = (MODE == 2) ? *(const f32x4*)(b_a + (col0 - 1536) + bj * HALF + 4 * n) : (f32x4){0.f, 0.f, 0.f, 0.f};
#pragma unroll
        for (int ai = 0; ai < 2; ++ai)
#pragma unroll
            for (int m = 0; m < 4; ++m) { bf16_t* rowp = O + (size_t)(row0 + ai * HALF + m * 16) * 2816 + col0;
#pragma unroll
                for (int bj = 0; bj < 2; ++bj) { f32x4 v0 = acc[ai][bj][m][0], v1 = acc[ai][bj][m][1];
#pragma unroll
                    for (int j = 0; j < 4; ++j) {
                        if (MODE == 1) { v0[j] = f_silu(v0[j]); v1[j] = f_silu(v1[j]); }
                        if (MODE == 2) { v0[j] = f_logsig16(v0[j] + bv[bj][0][j]); v1[j] = f_logsig16(v1[j] + bv[bj][1][j]); }
                        if (MODE == 3) { v0[j] = f_gelu_tanh(v0[j]); v1[j] = f_gelu_tanh(v1[j]); } }
                    u32x4 w; w.x = pk2(v0[0], v0[1]); w.y = pk2(v0[2], v0[3]); w.z = pk2(v1[0], v1[1]); w.w = pk2(v1[2], v1[3]);
                    *(u32x4*)(rowp + bj * HALF) = w; } }
    }
    __device__ __forceinline__ void operator()(const f32x4 (&acc)[2][2][4][2], const Unit& u, int wr, int wc, int fr, int fq) const {
        const int pn = u.pn;
        if (pn < 4) tile<0>(acc, u, wr, wc, fr, fq); else if (pn < 6) tile<1>(acc, u, wr, wc, fr, fq); else if (pn == 6) tile<2>(acc, u, wr, wc, fr, fq); else tile<3>(acc, u, wr, wc, fr, fq);
    }
};
struct EpiInProj8 {
    static constexpr bool PERM = true, AFTER_DRAIN = false, F8 = true; static constexpr float dq = 1.0f / (F8_SX * F8_SW);
    bf16_t* O; const float* b_a;
    template <int MODE> __device__ __forceinline__ void tile(const f32x4 (&acc)[2][2][4][2], const Unit& u, int wr, int wc, int fr, int fq) const {
        const int row0 = u.pm * BM + wr * 64 + fr, col0 = u.pn * BM + wc * 32 + 8 * fq;
        f32x4 bv[2][2];
#pragma unroll
        for (int bj = 0; bj < 2; ++bj)
#pragma unroll
            for (int n = 0; n < 2; ++n) bv[bj][n] = (MODE == 2) ? *(const f32x4*)(b_a + (col0 - 1536) + bj * HALF + 4 * n) : (f32x4){0.f, 0.f, 0.f, 0.f};
#pragma unroll
        for (int ai = 0; ai < 2; ++ai)
#pragma unroll
            for (int m = 0; m < 4; ++m) { bf16_t* rowp = O + (size_t)(row0 + ai * HALF + m * 16) * 2816 + col0;
#pragma unroll
                for (int bj = 0; bj < 2; ++bj) { f32x4 v0 = acc[ai][bj][m][0] * dq, v1 = acc[ai][bj][m][1] * dq;
#pragma unroll
                    for (int j = 0; j < 4; ++j) {
                        if (MODE == 1) { v0[j] = f_silu(v0[j]); v1[j] = f_silu(v1[j]); }
                        if (MODE == 2) { v0[j] = f_logsig16(v0[j] + bv[bj][0][j]); v1[j] = f_logsig16(v1[j] + bv[bj][1][j]); }
                        if (MODE == 3) { v0[j] = f_gelu_tanh(v0[j]); v1[j] = f_gelu_tanh(v1[j]); } }
                    u32x4 w; w.x = pk2(v0[0], v0[1]); w.y = pk2(v0[2], v0[3]); w.z = pk2(v1[0], v1[1]); w.w = pk2(v1[2], v1[3]);
                    *(u32x4*)(rowp + bj * HALF) = w; } }
    }
    __device__ __forceinline__ void operator()(const f32x4 (&acc)[2][2][4][2], const Unit& u, int wr, int wc, int fr, int fq) const {
        const int pn = u.pn;
        if (pn < 4) tile<0>(acc, u, wr, wc, fr, fq); else if (pn < 6) tile<1>(acc, u, wr, wc, fr, fq); else if (pn == 6) tile<2>(acc, u, wr, wc, fr, fq); else tile<3>(acc, u, wr, wc, fr, fq);
    }
};
struct EpiResid {
    static constexpr bool PERM = true, AFTER_DRAIN = false;
    const bf16_t* X; bf16_t* Z; float alpha;
    __device__ __forceinline__ void operator()(const f32x4 (&acc)[2][2][4][2], const Unit& u, int wr, int wc, int fr, int fq) const {
        const int row0 = u.pm * BM + wr * 64 + fr, col0 = u.pn * BM + wc * 32 + 8 * fq;
#pragma unroll
        for (int ai = 0; ai < 2; ++ai)
#pragma unroll
            for (int m = 0; m < 4; ++m) { const size_t off = (size_t)(row0 + ai * HALF + m * 16) * 1024 + col0;
#pragma unroll
                for (int bj = 0; bj < 2; ++bj) { const f32x4 v0 = acc[ai][bj][m][0], v1 = acc[ai][bj][m][1];
                    const u32x4 xr = *(const u32x4*)(X + off + bj * HALF);
                    u32x4 w; w.x = pk2(alpha * bflo(xr.x) + v0[0], alpha * bfhi(xr.x) + v0[1]); w.y = pk2(alpha * bflo(xr.y) + v0[2], alpha * bfhi(xr.y) + v0[3]);
                    w.z = pk2(alpha * bflo(xr.z) + v1[0], alpha * bfhi(xr.z) + v1[1]); w.w = pk2(alpha * bflo(xr.w) + v1[2], alpha * bfhi(xr.w) + v1[3]);
                    *(u32x4*)(Z + off + bj * HALF) = w; } }
    }
};
struct EpiResidStats {
    static constexpr bool PERM = true, AFTER_DRAIN = false;
    const bf16_t* X; bf16_t* Z; f32x2_t* part; static constexpr float alpha = 1.4142135623730951f;
    __device__ __forceinline__ void operator()(const f32x4 (&acc)[2][2][4][2], const Unit& u, int wr, int wc, int fr, int fq) const {
        const int row0 = u.pm * BM + wr * 64 + fr, col0 = u.pn * BM + wc * 32 + 8 * fq;
        int ln = 16 * fq + fr; asm volatile("" : "+v"(ln));
        float s1[8], s2[8];
        const rsrc_t rx = mk_rsrc(X); const unsigned voff = ((unsigned)row0 * 1024u + (unsigned)col0) * 2u;
        u32x4 xres[2][4][2];
#pragma unroll
        for (int ai = 0; ai < 2; ++ai)
#pragma unroll
            for (int m = 0; m < 4; ++m)
#pragma unroll
                for (int bj = 0; bj < 2; ++bj) xres[ai][m][bj] = bld4(rx, voff, (unsigned)(((ai * HALF + m * 16) * 1024 + bj * HALF) * 2));
        __builtin_amdgcn_sched_barrier(0);
#pragma unroll
        for (int ai = 0; ai < 2; ++ai)
#pragma unroll
            for (int m = 0; m < 4; ++m) { const size_t off = (size_t)(row0 + ai * HALF + m * 16) * 1024 + col0; float a1 = 0.f, a2 = 0.f;
#pragma unroll
                for (int bj = 0; bj < 2; ++bj) { const f32x4 v0 = acc[ai][bj][m][0], v1 = acc[ai][bj][m][1];
                    const u32x4 xr = xres[ai][m][bj];
                    u32x4 w; w.x = pk2(alpha * bflo(xr.x) + v0[0], alpha * bfhi(xr.x) + v0[1]); w.y = pk2(alpha * bflo(xr.y) + v0[2], alpha * bfhi(xr.y) + v0[3]);
                    w.z = pk2(alpha * bflo(xr.z) + v1[0], alpha * bfhi(xr.z) + v1[1]); w.w = pk2(alpha * bflo(xr.w) + v1[2], alpha * bfhi(xr.w) + v1[3]);
                    GST4(Z + off + bj * HALF) = w;
                    const float z0 = bflo(w.x), z1 = bfhi(w.x), z2 = bflo(w.y), z3 = bfhi(w.y), z4 = bflo(w.z), z5 = bfhi(w.z), z6 = bflo(w.w), z7 = bfhi(w.w);
                    a1 += ((z0 + z1) + (z2 + z3)) + ((z4 + z5) + (z6 + z7)); a2 += ((z0 * z0 + z1 * z1) + (z2 * z2 + z3 * z3)) + ((z4 * z4 + z5 * z5) + (z6 * z6 + z7 * z7)); }
                s1[ai * 4 + m] = a1; s2[ai * 4 + m] = a2; }
        const bool h5 = (ln & 32) != 0, h4 = (ln & 16) != 0;
        float t1[4], t2[4];
#pragma unroll
        for (int i = 0; i < 4; ++i) { const float m1 = h5 ? s1[4 + i] : s1[i], g1 = h5 ? s1[i] : s1[4 + i], m2 = h5 ? s2[4 + i] : s2[i], g2 = h5 ? s2[i] : s2[4 + i];
            t1[i] = m1 + __builtin_bit_cast(float, __builtin_amdgcn_ds_bpermute((ln ^ 32) << 2, __builtin_bit_cast(int, g1)));
            t2[i] = m2 + __builtin_bit_cast(float, __builtin_amdgcn_ds_bpermute((ln ^ 32) << 2, __builtin_bit_cast(int, g2))); }
        float r1[2], r2[2];
#pragma unroll
        for (int i = 0; i < 2; ++i) { const float m1 = h4 ? t1[2 + i] : t1[i], g1 = h4 ? t1[i] : t1[2 + i], m2 = h4 ? t2[2 + i] : t2[i], g2 = h4 ? t2[i] : t2[2 + i];
            r1[i] = m1 + __builtin_bit_cast(float, __builtin_amdgcn_ds_bpermute((ln ^ 16) << 2, __builtin_bit_cast(int, g1)));
            r2[i] = m2 + __builtin_bit_cast(float, __builtin_amdgcn_ds_bpermute((ln ^ 16) << 2, __builtin_bit_cast(int, g2))); }
#pragma unroll
        for (int i = 0; i < 2; ++i) { const int gi = (h5 ? 4 : 0) + (h4 ? 2 : 0) + i, row = row0 + (gi >> 2) * HALF + (gi & 3) * 16;
            part[(size_t)row * 16 + u.pn * 4 + wc] = (f32x2_t){r1[i], r2[i]}; }
    }
};
struct EpiResidStats8 {
    static constexpr bool PERM = true, AFTER_DRAIN = false, F8 = true; static constexpr float dq = 1.0f / (F8_SM * F8_SW);
    const bf16_t* X; bf16_t* Z; f32x2_t* part; unsigned char* Z8; static constexpr float alpha = 1.4142135623730951f;
    __device__ __forceinline__ void operator()(const f32x4 (&acc)[2][2][4][2], const Unit& u, int wr, int wc, int fr, int fq) const {
        const int row0 = u.pm * BM + wr * 64 + fr, col0 = u.pn * BM + wc * 32 + 8 * fq;
        int ln = 16 * fq + fr; asm volatile("" : "+v"(ln));
        float s1[8], s2[8];
        const rsrc_t rx = mk_rsrc(X); const unsigned voff = ((unsigned)row0 * 1024u + (unsigned)col0) * 2u;
#pragma unroll
        for (int ai = 0; ai < 2; ++ai) {
            u32x4 xres[4][2];
#pragma unroll
            for (int m = 0; m < 4; ++m)
#pragma unroll
                for (int bj = 0; bj < 2; ++bj) xres[m][bj] = bld4(rx, voff, (unsigned)(((ai * HALF + m * 16) * 1024 + bj * HALF) * 2));
            __builtin_amdgcn_sched_barrier(0);
#pragma unroll
            for (int m = 0; m < 4; ++m) { const size_t off = (size_t)(row0 + ai * HALF + m * 16) * 1024 + col0; float a1 = 0.f, a2 = 0.f;
#pragma unroll
                for (int bj = 0; bj < 2; ++bj) { const f32x4 v0 = acc[ai][bj][m][0] * dq, v1 = acc[ai][bj][m][1] * dq;
                    const u32x4 xr = xres[m][bj];
                    u32x4 w; w.x = pk2(alpha * bflo(xr.x) + v0[0], alpha * bfhi(xr.x) + v0[1]); w.y = pk2(alpha * bflo(xr.y) + v0[2], alpha * bfhi(xr.y) + v0[3]);
                    w.z = pk2(alpha * bflo(xr.z) + v1[0], alpha * bfhi(xr.z) + v1[1]); w.w = pk2(alpha * bflo(xr.w) + v1[2], alpha * bfhi(xr.w) + v1[3]);
                    GST4(Z + off + bj * HALF) = w;
                    { u32x2 w8; w8.x = pk4f8(bflo(w.x) * F8_SZ, bfhi(w.x) * F8_SZ, bflo(w.y) * F8_SZ, bfhi(w.y) * F8_SZ); w8.y = pk4f8(bflo(w.z) * F8_SZ, bfhi(w.z) * F8_SZ, bflo(w.w) * F8_SZ, bfhi(w.w) * F8_SZ);
                      *(__attribute__((address_space(1))) u32x2*)(Z8 + off + bj * HALF) = w8; }
                    const float z0 = bflo(w.x), z1 = bfhi(w.x), z2 = bflo(w.y), z3 = bfhi(w.y), z4 = bflo(w.z), z5 = bfhi(w.z), z6 = bflo(w.w), z7 = bfhi(w.w);
                    a1 += ((z0 + z1) + (z2 + z3)) + ((z4 + z5) + (z6 + z7)); a2 += ((z0 * z0 + z1 * z1) + (z2 * z2 + z3 * z3)) + ((z4 * z4 + z5 * z5) + (z6 * z6 + z7 * z7)); }
                s1[ai * 4 + m] = a1; s2[ai * 4 + m] = a2; } }
        const bool h5 = (ln & 32) != 0, h4 = (ln & 16) != 0;
        float t1[4], t2[4];
#pragma unroll
        for (int i = 0; i < 4; ++i) { const float m1 = h5 ? s1[4 + i] : s1[i], g1 = h5 ? s1[i] : s1[4 + i], m2 = h5 ? s2[4 + i] : s2[i], g2 = h5 ? s2[i] : s2[4 + i];
            t1[i] = m1 + __builtin_bit_cast(float, __builtin_amdgcn_ds_bpermute((ln ^ 32) << 2, __builtin_bit_cast(int, g1)));
            t2[i] = m2 + __builtin_bit_cast(float, __builtin_amdgcn_ds_bpermute((ln ^ 32) << 2, __builtin_bit_cast(int, g2))); }
        float r1[2], r2[2];
#pragma unroll
        for (int i = 0; i < 2; ++i) { const float m1 = h4 ? t1[2 + i] : t1[i], g1 = h4 ? t1[i] : t1[2 + i], m2 = h4 ? t2[2 + i] : t2[i], g2 = h4 ? t2[i] : t2[2 + i];
            r1[i] = m1 + __builtin_bit_cast(float, __builtin_amdgcn_ds_bpermute((ln ^ 16) << 2, __builtin_bit_cast(int, g1)));
            r2[i] = m2 + __builtin_bit_cast(float, __builtin_amdgcn_ds_bpermute((ln ^ 16) << 2, __builtin_bit_cast(int, g2))); }
#pragma unroll
        for (int i = 0; i < 2; ++i) { const int gi = (h5 ? 4 : 0) + (h4 ? 2 : 0) + i, row = row0 + (gi >> 2) * HALF + (gi & 3) * 16;
            part[(size_t)row * 16 + u.pn * 4 + wc] = (f32x2_t){r1[i], r2[i]}; }
    }
};
struct EpiQFragLN {
    static constexpr bool PERM = true, AFTER_DRAIN = false;
    unsigned char* O; const f32x2_t* stats; const float* csum; const float* bq;
    __device__ __forceinline__ void operator()(const f32x4 (&acc)[2][2][4][2], const Unit& u, int wr, int wc, int fr, int fq) const {
        unsigned lo = (unsigned)(((fq >> 1) * 64 + fr + 32 * (fq & 1)) * 16); asm volatile("" : "+v"(lo));
        unsigned char* tile = O + (size_t)(u.pm * 4 + u.pn) * 65536 + (size_t)(wr * 2 * 8 + wc * 2) * 1024 + lo;
        const int row0 = u.pm * BM + wr * 64 + fr, col0 = u.pn * BM + wc * 32 + 8 * fq;
        f32x4 cc[2][2], bb[2][2];
#pragma unroll
        for (int bj = 0; bj < 2; ++bj)
#pragma unroll
            for (int n = 0; n < 2; ++n) { cc[bj][n] = *(const f32x4*)(csum + col0 + bj * HALF + 4 * n); bb[bj][n] = *(const f32x4*)(bq + col0 + bj * HALF + 4 * n); }
#pragma unroll
        for (int ai = 0; ai < 2; ++ai)
#pragma unroll
            for (int m = 0; m < 4; ++m) { const f32x2_t st = stats[row0 + ai * HALF + m * 16]; const float mu = st[0], rs = st[1] * F8_SQ; u32x4 w;
#pragma unroll
                for (int bj = 0; bj < 2; ++bj) { const f32x4 v0 = (acc[ai][bj][m][0] - mu * cc[bj][0]) * rs + bb[bj][0] * F8_SQ, v1 = (acc[ai][bj][m][1] - mu * cc[bj][1]) * rs + bb[bj][1] * F8_SQ;
                    const unsigned lo4 = pk4f8(v0[0], v0[1], v0[2], v0[3]), hi4 = pk4f8(v1[0], v1[1], v1[2], v1[3]);
                    if (bj == 0) { w.x = lo4; w.y = hi4; } else { w.z = lo4; w.w = hi4; } }
                *(u32x4*)(tile + (4 * ai + (m >> 1)) * 8192 + (m & 1) * 256) = w; }
    }
};
struct EpiQFragLN8 {
    static constexpr bool PERM = true, AFTER_DRAIN = false, F8 = true; static constexpr float dq = 1.0f / (F8_SZ * F8_SW);
    unsigned char* O; const f32x2_t* stats; const float* csum; const float* bq;
    __device__ __forceinline__ void operator()(const f32x4 (&acc)[2][2][4][2], const Unit& u, int wr, int wc, int fr, int fq) const {
        unsigned lo = (unsigned)(((fq >> 1) * 64 + fr + 32 * (fq & 1)) * 16); asm volatile("" : "+v"(lo));
        unsigned char* tile = O + (size_t)(u.pm * 4 + u.pn) * 65536 + (size_t)(wr * 2 * 8 + wc * 2) * 1024 + lo;
        const int row0 = u.pm * BM + wr * 64 + fr, col0 = u.pn * BM + wc * 32 + 8 * fq;
        f32x4 cc[2][2], bb[2][2];
#pragma unroll
        for (int bj = 0; bj < 2; ++bj)
#pragma unroll
            for (int n = 0; n < 2; ++n) { cc[bj][n] = *(const f32x4*)(csum + col0 + bj * HALF + 4 * n); bb[bj][n] = *(const f32x4*)(bq + col0 + bj * HALF + 4 * n); }
#pragma unroll
        for (int ai = 0; ai < 2; ++ai)
#pragma unroll
            for (int m = 0; m < 4; ++m) { const f32x2_t st = stats[row0 + ai * HALF + m * 16]; const float mu = st[0], rs = st[1] * F8_SQ; u32x4 w;
#pragma unroll
                for (int bj = 0; bj < 2; ++bj) { const f32x4 v0 = (acc[ai][bj][m][0] * dq - mu * cc[bj][0]) * rs + bb[bj][0] * F8_SQ, v1 = (acc[ai][bj][m][1] * dq - mu * cc[bj][1]) * rs + bb[bj][1] * F8_SQ;
                    const unsigned lo4 = pk4f8(v0[0], v0[1], v0[2], v0[3]), hi4 = pk4f8(v1[0], v1[1], v1[2], v1[3]);
                    if (bj == 0) { w.x = lo4; w.y = hi4; } else { w.z = lo4; w.w = hi4; } }
                *(u32x4*)(tile + (4 * ai + (m >> 1)) * 8192 + (m & 1) * 256) = w; }
    }
};
struct EpiResidLN {
    static constexpr bool PERM = true, AFTER_DRAIN = false;
    bf16_t* Z; const f32x2_t* stats; const float* gain; const float* bias; static constexpr float alpha = 1.4142135623730951f;
    __device__ __forceinline__ void operator()(const f32x4 (&acc)[2][2][4][2], const Unit& u, int wr, int wc, int fr, int fq) const {
        const int row0 = u.pm * BM + wr * 64 + fr, col0 = u.pn * BM + wc * 32 + 8 * fq;
        const rsrc_t rz = mk_rsrc(Z), rs = mk_rsrc(stats); const unsigned voff = ((unsigned)row0 * 1024u + (unsigned)col0) * 2u;
        f32x2_t st[2][4];
#pragma unroll
        for (int ai = 0; ai < 2; ++ai)
#pragma unroll
            for (int m = 0; m < 4; ++m) st[ai][m] = bld2f(rs, (unsigned)row0 * 8u, (unsigned)((ai * HALF + m * 16) * 8));
#pragma unroll
        for (int bj = 0; bj < 2; ++bj) {
            u32x4 zres[2][4];
#pragma unroll
            for (int ai = 0; ai < 2; ++ai)
#pragma unroll
                for (int m = 0; m < 4; ++m) zres[ai][m] = bld4(rz, voff, (unsigned)(((ai * HALF + m * 16) * 1024 + bj * HALF) * 2));
            const f32x4 g0 = *(const f32x4*)(gain + col0 + bj * HALF) * alpha, g1 = *(const f32x4*)(gain + col0 + bj * HALF + 4) * alpha, b0 = *(const f32x4*)(bias + col0 + bj * HALF) * alpha, b1 = *(const f32x4*)(bias + col0 + bj * HALF + 4) * alpha;
            __builtin_amdgcn_sched_barrier(0);
#pragma unroll
            for (int ai = 0; ai < 2; ++ai)
#pragma unroll
                for (int m = 0; m < 4; ++m) { const int row = row0 + ai * HALF + m * 16; const float mu = st[ai][m][0], rsd = st[ai][m][1];
                    const u32x4 zr = zres[ai][m];
                    const f32x4 z0 = (f32x4){bflo(zr.x), bfhi(zr.x), bflo(zr.y), bfhi(zr.y)}, z1 = (f32x4){bflo(zr.z), bfhi(zr.z), bflo(zr.w), bfhi(zr.w)};
                    const f32x4 v0 = (z0 - mu) * rsd * g0 + b0 + acc[ai][bj][m][0], v1 = (z1 - mu) * rsd * g1 + b1 + acc[ai][bj][m][1];
                    u32x4 w; w.x = pk2(v0[0], v0[1]); w.y = pk2(v0[2], v0[3]); w.z = pk2(v1[0], v1[1]); w.w = pk2(v1[2], v1[3]);
                    GST4(Z + (size_t)row * 1024 + col0 + bj * HALF) = w; } }
    }
};
struct EpiResidLN8 {
    static constexpr bool PERM = true, AFTER_DRAIN = false, F8 = true; static constexpr float dq = 1.0f / (F8_SO * F8_SW);
    bf16_t* Z; const f32x2_t* stats; const float* gain; const float* bias; static constexpr float alpha = 1.4142135623730951f;
    __device__ __forceinline__ void operator()(const f32x4 (&acc)[2][2][4][2], const Unit& u, int wr, int wc, int fr, int fq) const {
        const int row0 = u.pm * BM + wr * 64 + fr, col0 = u.pn * BM + wc * 32 + 8 * fq;
        const rsrc_t rz = mk_rsrc(Z), rs = mk_rsrc(stats); const unsigned voff = ((unsigned)row0 * 1024u + (unsigned)col0) * 2u;
        f32x2_t st[2][4];
#pragma unroll
        for (int ai = 0; ai < 2; ++ai)
#pragma unroll
            for (int m = 0; m < 4; ++m) st[ai][m] = bld2f(rs, (unsigned)row0 * 8u, (unsigned)((ai * HALF + m * 16) * 8));
#pragma unroll
        for (int bj = 0; bj < 2; ++bj) {
            u32x4 zres[2][4];
#pragma unroll
            for (int ai = 0; ai < 2; ++ai)
#pragma unroll
                for (int m = 0; m < 4; ++m) zres[ai][m] = bld4(rz, voff, (unsigned)(((ai * HALF + m * 16) * 1024 + bj * HALF) * 2));
            const f32x4 g0 = *(const f32x4*)(gain + col0 + bj * HALF) * alpha, g1 = *(const f32x4*)(gain + col0 + bj * HALF + 4) * alpha, b0 = *(const f32x4*)(bias + col0 + bj * HALF) * alpha, b1 = *(const f32x4*)(bias + col0 + bj * HALF + 4) * alpha;
            __builtin_amdgcn_sched_barrier(0);
#pragma unroll
            for (int ai = 0; ai < 2; ++ai)
#pragma unroll
                for (int m = 0; m < 4; ++m) { const int row = row0 + ai * HALF + m * 16; const float mu = st[ai][m][0], rsd = st[ai][m][1];
                    const u32x4 zr = zres[ai][m];
                    const f32x4 z0 = (f32x4){bflo(zr.x), bfhi(zr.x), bflo(zr.y), bfhi(zr.y)}, z1 = (f32x4){bflo(zr.z), bfhi(zr.z), bflo(zr.w), bfhi(zr.w)};
                    const f32x4 v0 = (z0 - mu) * rsd * g0 + b0 + acc[ai][bj][m][0] * dq, v1 = (z1 - mu) * rsd * g1 + b1 + acc[ai][bj][m][1] * dq;
                    u32x4 w; w.x = pk2(v0[0], v0[1]); w.y = pk2(v0[2], v0[3]); w.z = pk2(v1[0], v1[1]); w.w = pk2(v1[2], v1[3]);
                    GST4(Z + (size_t)row * 1024 + col0 + bj * HALF) = w; } }
    }
};
struct EpiGU {
    static constexpr bool PERM = true, AFTER_DRAIN = false;
    bf16_t* H;
    __device__ __forceinline__ void operator()(const f32x4 (&acc)[2][2][4][2], const Unit& u, int wr, int wc, int fr, int fq) const {
        const int row0 = u.pm * BM + wr * 64 + fr, col0 = (u.pn & 3) * 128 + wc * 16 + 4 * fq;
#pragma unroll
        for (int ai = 0; ai < 2; ++ai)
#pragma unroll
            for (int m = 0; m < 4; ++m) { bf16_t* rowp = H + (size_t)(row0 + ai * HALF + m * 16) * 512 + col0;
#pragma unroll
                for (int bj = 0; bj < 2; ++bj) { const f32x4 g = acc[ai][bj][m][0], up = acc[ai][bj][m][1];
                    u32x2 w; w.x = pk2(f_silu(g[0]) * up[0], f_silu(g[1]) * up[1]); w.y = pk2(f_silu(g[2]) * up[2], f_silu(g[3]) * up[3]);
                    *(u32x2*)(rowp + bj * 64) = w; } }
    }
};
struct EpiGU8 {
    static constexpr bool PERM = true, AFTER_DRAIN = false, F8 = true;
    unsigned char* H;
    __device__ __forceinline__ void operator()(const f32x4 (&acc)[2][2][4][2], const Unit& u, int wr, int wc, int fr, int fq) const {
        const int row0 = u.pm * BM + wr * 64 + fr, col0 = (u.pn & 3) * 128 + wc * 32 + 8 * fq;
        constexpr float dq = 1.0f / (F8_SX * F8_SW);
#pragma unroll
        for (int ai = 0; ai < 2; ++ai)
#pragma unroll
            for (int m = 0; m < 4; ++m) { float h[8];
#pragma unroll
                for (int n = 0; n < 2; ++n) { const f32x4 g = acc[ai][0][m][n] * dq, up = acc[ai][1][m][n] * (dq * F8_SH);
#pragma unroll
                    for (int i = 0; i < 4; ++i) h[4 * n + i] = f_silu(g[i]) * up[i]; }
                u32x2 w; w.x = pk4f8(h[0], h[1], h[2], h[3]); w.y = pk4f8(h[4], h[5], h[6], h[7]);
                *(u32x2*)(H + (size_t)(row0 + ai * HALF + m * 16) * 512 + col0) = w; }
    }
};
struct EpiPlain8 {
    static constexpr bool PERM = true, AFTER_DRAIN = false, F8 = true;
    unsigned char* O; int ldc; int cmask;
    __device__ __forceinline__ void operator()(const f32x4 (&acc)[2][2][4][2], const Unit& u, int wr, int wc, int fr, int fq) const {
        const int row0 = u.pm * BM + wr * 64 + fr, col0 = (u.pn & cmask) * BM + wc * 32 + 8 * fq;
        constexpr float dq = F8_SY / (F8_SH * F8_SW);
#pragma unroll
        for (int ai = 0; ai < 2; ++ai)
#pragma unroll
            for (int m = 0; m < 4; ++m) { unsigned char* rowp = O + (size_t)(row0 + ai * HALF + m * 16) * ldc + col0;
#pragma unroll
                for (int bj = 0; bj < 2; ++bj) { const f32x4 v0 = acc[ai][bj][m][0] * dq, v1 = acc[ai][bj][m][1] * dq;
                    u32x2 w; w.x = pk4f8(v0[0], v0[1], v0[2], v0[3]); w.y = pk4f8(v1[0], v1[1], v1[2], v1[3]);
                    *(u32x2*)(rowp + bj * HALF) = w; } }
    }
};

typedef int i32x4_t __attribute__((ext_vector_type(4)));
template <class T, class = void> struct epi_f8 { static constexpr bool value = false; };
template <class T> struct epi_f8<T, decltype((void)T::F8)> { static constexpr bool value = true; };
template <class Epi, class Sched, bool ALIGN_EPI = false, bool SP2 = false>
__device__ __forceinline__ void gemm_phase(PG8_LAS unsigned char* lds, const Gemm g, const Sched& S, const Epi& E) {
    int tid_ = g.wv * 64 + lane_id(); asm volatile("" : "+v"(tid_));
    const int tid = tid_, wid = __builtin_amdgcn_readfirstlane(tid >> 6), lane = tid & 63, wr = wid >> 2, wc = wid & 3, fr = lane & 15, fq = lane >> 4;
    const int K = g.K, nt = K / BK; constexpr bool F8 = epi_f8<Epi>::value;
    unsigned voffA[2], voffB[2];
#pragma unroll
    for (int i = 0; i < 2; ++i) { int R, C; stage_rc(tid * 16 + i * 8192, R, C); const int Rb = Epi::PERM ? ((R & ~31) + perm32(R & 31)) : R;
        voffA[i] = (unsigned)(R * K + C) * 2u;
        voffB[i] = (unsigned)(((Rb >> 4) * (K >> 5) + (C >> 5)) * 1024 + (Rb & 15) * 64 + (C & 31) * 2); }
    constexpr bool GATH = Sched::GATHER; static_assert(!GATH || SP2, "gather mode is written for the SP2 loop");
    unsigned goc[2][2] = {{0u, 0u}, {0u, 0u}}, gon[2][2] = {{0u, 0u}, {0u, 0u}}, go2[2][2] = {{0u, 0u}, {0u, 0u}};
#define PG8_GOFF(dst, U) do { int tg_ = tid; asm volatile("" : "+v"(tg_)); _Pragma("unroll") for (int i_ = 0; i_ < 2; ++i_) { int R_, C_; stage_rc(tg_ * 16 + i_ * 8192, R_, C_); \
        _Pragma("unroll") for (int h_ = 0; h_ < 2; ++h_) dst[h_][i_] = (unsigned)S.src[(U).pm * BM + h_ * HALF + R_] * (unsigned)(K * 2) + (unsigned)C_ * 2u; } } while (0)
    const size_t kstep = (size_t)(BK * 2);
    const size_t kstepB = 2048;
    const size_t hstep = (size_t)HALF * K * 2;
    const size_t tstep = 2 * hstep;
    const unsigned ldsw = (unsigned)wid * 1024u;
    const int aoff = lds_byte(wr * 64 + fr, fq * 8), boff = lds_byte(wc * 32 + fr, fq * 8);
#define PG8_SA(b, h) (((b) * 2 + (h)) * HTB)
#define PG8_SB(b, h) ((4 + (b) * 2 + (h)) * HTB)
#define PG8_STAGE(bufoff, gbase, voff) do { _Pragma("unroll") for (int _i = 0; _i < 2; ++_i) \
        __builtin_amdgcn_global_load_lds((const unsigned*)((const char*)(gbase) + (voff)[_i]), (PG8_LAS unsigned*)(lds + (bufoff) + ldsw + _i * 8192), 16, 0, 0); } while (0)
#define PG8_STAGE_A(b, h, PTR, KPTR, GO) do { if constexpr (GATH) { PG8_STAGE(PG8_SA(b, h), KPTR, GO); } else { PG8_STAGE(PG8_SA(b, h), PTR, voffA); } } while (0)
#define PG8_LDA(dst, b, h) do { _Pragma("unroll") for (int m = 0; m < 4; ++m) _Pragma("unroll") for (int k = 0; k < 2; ++k) dst[m][k] = *(const PG8_LAS bf16x8*)(lds + PG8_SA(b, h) + aoff + m * 2048 + k * 1024); } while (0)
#define PG8_LDB(dst, b, h) do { _Pragma("unroll") for (int n = 0; n < 2; ++n) _Pragma("unroll") for (int k = 0; k < 2; ++k) dst[n][k] = *(const PG8_LAS bf16x8*)(lds + PG8_SB(b, h) + boff + n * 2048 + k * 1024); } while (0)
#define PG8_CAT8(x, y) __builtin_shufflevector(__builtin_bit_cast(i32x4_t, x), __builtin_bit_cast(i32x4_t, y), 0, 1, 2, 3, 4, 5, 6, 7)
#define PG8_MMA(ai, bj, At, Bt) do { __builtin_amdgcn_s_setprio(1); \
        if constexpr (F8) { _Pragma("unroll") for (int m = 0; m < 4; ++m) _Pragma("unroll") for (int n = 0; n < 2; ++n) \
            asm volatile("v_mfma_f32_16x16x128_f8f6f4 %0, %1, %2, %0" : "+v"(acc[ai][bj][m][n]) : "v"(PG8_CAT8(Bt[n][0], Bt[n][1])), "v"(PG8_CAT8(At[m][0], At[m][1]))); } \
        else { _Pragma("unroll") for (int m = 0; m < 4; ++m) _Pragma("unroll") for (int n = 0; n < 2; ++n) _Pragma("unroll") for (int k = 0; k < 2; ++k) \
            acc[ai][bj][m][n] = __builtin_amdgcn_mfma_f32_16x16x32_bf16(Bt[n][k], At[m][k], acc[ai][bj][m][n], 0, 0, 0); } \
        __builtin_amdgcn_s_setprio(0); } while (0)
#define PG8_WAIT_V(n) asm volatile("s_waitcnt vmcnt(" #n ")" ::: "memory")
#define PG8_WAIT_L(n) asm volatile("s_waitcnt lgkmcnt(" #n ")" ::: "memory")
#define PG8_BAR __builtin_amdgcn_s_barrier()
#define PG8_SCHED __builtin_amdgcn_sched_barrier(0)
    Unit cur, nxt; int ui = 0;
    if (!S.next(0, cur)) return;
    f32x4 acc[2][2][4][2];
#pragma unroll
    for (int a = 0; a < 2; ++a)
#pragma unroll
        for (int b = 0; b < 2; ++b)
#pragma unroll
            for (int m = 0; m < 4; ++m)
#pragma unroll
                for (int n = 0; n < 2; ++n) { acc[a][b][m][n] = (f32x4){0.f, 0.f, 0.f, 0.f}; if constexpr (F8) asm volatile("" : "+v"(acc[a][b][m][n])); }
    bf16x8 At[4][2], B0[2][2], B1[2][2];
    const char* cA = (const char*)g.A + (size_t)cur.pm * tstep; const char* cB = (const char*)g.Bt + (size_t)cur.pn * tstep;
    S.a_ready(cur);
    const char* gA = (const char*)g.A;
    if constexpr (GATH) PG8_GOFF(goc, cur);
    if constexpr (SP2) {
        PG8_STAGE(PG8_SB(0, 0), cB, voffB); PG8_STAGE(PG8_SB(0, 1), cB + hstep, voffB); PG8_STAGE_A(0, 0, cA, gA, goc[0]); PG8_STAGE_A(0, 1, cA + hstep, gA, goc[1]);
        if (wr == 1) PG8_BAR;
        PG8_WAIT_V(2); PG8_BAR;
        PG8_STAGE(PG8_SB(1, 0), cB + kstepB, voffB); PG8_STAGE_A(1, 0, cA + kstep, gA + kstep, goc[0]); PG8_STAGE(PG8_SB(1, 1), cB + hstep + kstepB, voffB);
        PG8_WAIT_V(6); PG8_BAR;
    } else {
        PG8_STAGE(PG8_SB(0, 0), cB, voffB); PG8_STAGE(PG8_SA(0, 0), cA, voffA); PG8_STAGE(PG8_SB(0, 1), cB + hstep, voffB); PG8_STAGE(PG8_SA(0, 1), cA + hstep, voffA);
        if (wr == 1) PG8_BAR;
        PG8_WAIT_V(4); PG8_BAR;
        PG8_STAGE(PG8_SB(1, 0), cB + kstepB, voffB); PG8_STAGE(PG8_SA(1, 0), cA + kstep, voffA); PG8_STAGE(PG8_SB(1, 1), cB + hstep + kstepB, voffB);
        PG8_WAIT_V(6); PG8_BAR;
    }
    for (;;) {
        const bool has_next = S.next(ui + 1, nxt);
        if constexpr (GATH) { if (has_next) PG8_GOFF(gon, nxt); else { _Pragma("unroll") for (int h_ = 0; h_ < 2; ++h_) _Pragma("unroll") for (int i_ = 0; i_ < 2; ++i_) gon[h_][i_] = goc[h_][i_]; } }
        const char* nA = has_next ? (const char*)g.A + (size_t)nxt.pm * tstep : cA; const char* nB = has_next ? (const char*)g.Bt + (size_t)nxt.pn * tstep : cB;
        for (int t = 0; t < nt; t += 2) {
            const bool last = (t == nt - 2);
            const char* a1 = cA + (size_t)(t + 1) * kstep;
            const char* a2 = last ? nA : cA + (size_t)(t + 2) * kstep; const char* b2 = last ? nB : cB + (size_t)(t + 2) * kstepB;
            const char* a3 = a2 + kstep; const char* b3 = b2 + kstepB;
            if (last && has_next) S.a_ready(nxt);
            const char* ga1 = gA + (size_t)(t + 1) * kstep; const char* ga2 = last ? gA : gA + (size_t)(t + 2) * kstep; const char* ga3 = ga2 + kstep;
            if constexpr (GATH) { _Pragma("unroll") for (int h_ = 0; h_ < 2; ++h_) _Pragma("unroll") for (int i_ = 0; i_ < 2; ++i_) go2[h_][i_] = last ? gon[h_][i_] : goc[h_][i_]; }
            if constexpr (SP2) {
            PG8_LDB(B0, 0, 0); PG8_LDB(B1, 0, 1); PG8_SCHED; PG8_LDA(At, 0, 0); PG8_STAGE_A(1, 1, a1 + hstep, ga1, goc[1]);
            PG8_WAIT_V(8); PG8_WAIT_L(0); PG8_BAR; PG8_MMA(0, 0, At, B0); PG8_MMA(0, 1, At, B1); PG8_BAR; PG8_SCHED;
            PG8_LDA(At, 0, 1); PG8_STAGE(PG8_SB(0, 0), b2, voffB); PG8_STAGE(PG8_SB(0, 1), b2 + hstep, voffB); PG8_STAGE_A(0, 0, a2, ga2, go2[0]);
            PG8_WAIT_V(8); PG8_WAIT_L(0); PG8_BAR; PG8_MMA(1, 0, At, B0); PG8_MMA(1, 1, At, B1); PG8_BAR; PG8_SCHED;
            PG8_LDB(B0, 1, 0); PG8_LDB(B1, 1, 1); PG8_SCHED; PG8_LDA(At, 1, 0); PG8_STAGE_A(0, 1, a2 + hstep, ga2, go2[1]);
            PG8_WAIT_V(8); PG8_WAIT_L(0); PG8_BAR; PG8_MMA(0, 0, At, B0); PG8_MMA(0, 1, At, B1); PG8_BAR; PG8_SCHED;
            PG8_LDA(At, 1, 1); PG8_STAGE(PG8_SB(1, 0), b3, voffB); PG8_STAGE(PG8_SB(1, 1), b3 + hstep, voffB); PG8_STAGE_A(1, 0, a3, ga3, go2[0]);
            PG8_WAIT_V(8); PG8_WAIT_L(0); PG8_BAR; PG8_MMA(1, 0, At, B0); PG8_MMA(1, 1, At, B1); PG8_BAR; PG8_SCHED;
            } else {
            PG8_LDB(B0, 0, 0); PG8_SCHED; PG8_LDA(At, 0, 0); PG8_STAGE(PG8_SA(1, 1), a1 + hstep, voffA);
            PG8_WAIT_L(8); PG8_BAR; PG8_WAIT_L(0); PG8_MMA(0, 0, At, B0); PG8_BAR; PG8_SCHED;
            PG8_LDB(B1, 0, 1); PG8_STAGE(PG8_SB(0, 0), b2, voffB);
            PG8_BAR; PG8_WAIT_L(0); PG8_MMA(0, 1, At, B1); PG8_BAR;
            PG8_LDA(At, 0, 1); PG8_STAGE(PG8_SA(0, 0), a2, voffA);
            PG8_BAR; PG8_WAIT_L(0); PG8_MMA(1, 0, At, B0); PG8_BAR; PG8_SCHED;
            PG8_STAGE(PG8_SB(0, 1), b2 + hstep, voffB);
            PG8_WAIT_V(6); PG8_BAR; PG8_MMA(1, 1, At, B1); PG8_BAR;
            PG8_LDB(B0, 1, 0); PG8_SCHED; PG8_LDA(At, 1, 0); PG8_STAGE(PG8_SA(0, 1), a2 + hstep, voffA);
            PG8_WAIT_L(8); PG8_BAR; PG8_WAIT_L(0); PG8_MMA(0, 0, At, B0); PG8_BAR; PG8_SCHED;
            PG8_LDB(B1, 1, 1); PG8_STAGE(PG8_SB(1, 0), b3, voffB);
            PG8_BAR; PG8_WAIT_L(0); PG8_MMA(0, 1, At, B1); PG8_BAR;
            PG8_LDA(At, 1, 1); PG8_STAGE(PG8_SA(1, 0), a3, voffA);
            PG8_BAR; PG8_WAIT_L(0); PG8_MMA(1, 0, At, B0); PG8_BAR; PG8_SCHED;
            PG8_STAGE(PG8_SB(1, 1), b3 + hstep, voffB);
            PG8_WAIT_V(6); PG8_BAR; PG8_MMA(1, 1, At, B1); PG8_BAR;
            }
        }
        if constexpr (F8) asm volatile("s_nop 15\n\ts_nop 15" ::: "memory");
        if constexpr (ALIGN_EPI) { if (wr == 0) PG8_BAR; }
        if constexpr (!Epi::AFTER_DRAIN) { E(acc, cur, wr, wc, fr, fq); S.done(cur); }
        if (!has_next) break;
#pragma unroll
        for (int a = 0; a < 2; ++a)
#pragma unroll
            for (int b = 0; b < 2; ++b)
#pragma unroll
                for (int m = 0; m < 4; ++m)
#pragma unroll
                    for (int n = 0; n < 2; ++n) { acc[a][b][m][n] = (f32x4){0.f, 0.f, 0.f, 0.f}; if constexpr (F8) asm volatile("" : "+v"(acc[a][b][m][n])); }
        cur = nxt; cA = nA; cB = nB; ++ui;
        if constexpr (GATH) { _Pragma("unroll") for (int h_ = 0; h_ < 2; ++h_) _Pragma("unroll") for (int i_ = 0; i_ < 2; ++i_) goc[h_][i_] = gon[h_][i_]; }
        if constexpr (ALIGN_EPI) { if (wr == 1) PG8_BAR; }
    }
    PG8_WAIT_V(0);
    if constexpr (!ALIGN_EPI) { if (wr == 0) PG8_BAR; }
    PG8_BAR;
    if constexpr (Epi::AFTER_DRAIN) { E.fused(acc, cur, wr, wc, fr, fq, lds, wid, lane); S.done(cur); }
#undef PG8_SA
#undef PG8_SB
#undef PG8_STAGE
#undef PG8_STAGE_A
#undef PG8_GOFF
#undef PG8_LDA
#undef PG8_LDB
#undef PG8_MMA
#undef PG8_WAIT_V
#undef PG8_WAIT_L
#undef PG8_BAR
#undef PG8_SCHED
}}

namespace mk {
using pg8::bf16_t; using pg8::bf16x8; using pg8::f32x4; using pg8::u32x4; using pg8::u32x2; using pg8::pk2; using pg8::bflo; using pg8::bfhi;
typedef float f32x16 __attribute__((ext_vector_type(16)));
typedef short s16x4 __attribute__((ext_vector_type(4)));
typedef short v4i16_t __attribute__((ext_vector_type(4)));
#define LAS __attribute__((address_space(3)))
#define GAS __attribute__((address_space(1)))
typedef GAS unsigned gu32;
#define RLX_AGENT __ATOMIC_RELAXED, __HIP_MEMORY_SCOPE_AGENT
#define LDS_WAIT() asm volatile("s_waitcnt lgkmcnt(0)" ::: "memory")

constexpr int NB = 8, SEQ = 8192, M = NB * SEQ, D = 1024, NP = 2816, NMEM = 256, MKV = NB * NMEM;
constexpr int PQ = 0, PK = 256, PV = 512, PR = 1024, PG = 1536, PU = 1792, PVS = 2304;
constexpr int DIN = 2576;
constexpr int MOE_ROWS = 135168;
constexpr float ALPHA = 1.4142135623730951f, LN_EPS = 1e-5f, LOG2E = 1.4426950408889634f;
constexpr int NWAVES = 8, NTHR = 512;

constexpr size_t MiB = 1u << 20;
constexpr size_t WS_CTL = 0, CTL_ZERO_BYTES = 1 * MiB;
constexpr size_t WS_WM = 1 * MiB;
constexpr size_t WS_WGCNT = 1 * MiB + 512 * 1024;
constexpr size_t WS_LTOT = 1 * MiB + 768 * 1024;
constexpr size_t WS_TINFO = 2 * MiB;
constexpr size_t WS_TRANK = 3 * MiB;
constexpr size_t WS_TSLOT = 3 * MiB + 512 * 1024;
constexpr size_t WS_SEND = 4 * MiB;
constexpr size_t WS_WKV = 12 * MiB;
constexpr size_t WS_MEMB = 20 * MiB;
constexpr size_t WS_KV = 24 * MiB;
constexpr size_t WS_W = 40 * MiB, W_LAYER = 60 * MiB;
constexpr size_t W_IN = 0, W_OUT = (size_t)NP * D * 2, W_Q = W_OUT + 2 * MiB, W_O = W_Q + 2 * MiB, W_GU = W_O + 2 * MiB, W_D = W_GU + 32 * MiB;
static_assert(W_D + 16 * MiB <= W_LAYER, "weights per layer");
constexpr size_t WS_X = 160 * MiB;
constexpr size_t WS_R = 288 * MiB;
constexpr size_t R_P = 0, R_Y = 352 * MiB, R_Z = 480 * MiB, R_Q = 0, R_O = 128 * MiB, R_XS = 344 * MiB, R_H = 0;
constexpr size_t R_X8 = 256 * MiB;
constexpr size_t WS_SRCROW = WS_R + 616 * MiB;
constexpr size_t WS_PART = WS_SRCROW + 1 * MiB;
constexpr size_t WS_STATS = WS_PART + 8 * MiB;
constexpr size_t WS_CS = WS_STATS + 1 * MiB;
constexpr size_t WS_X8IN = WS_CS + 1 * MiB;
constexpr size_t WS_END = WS_X8IN + 64 * MiB;
static_assert(R_XS + (size_t)MOE_ROWS * D * 2 <= 616 * MiB && R_H + (size_t)MOE_ROWS * 512 * 2 <= R_XS, "moe buffers");
constexpr int CW_BAR = 4096;

constexpr int LDS_BYTES = 159744, LDSCTL_OFF = 155648;
constexpr int MISC_OFF = LDSCTL_OFF;
constexpr int TILEE_OFF = LDSCTL_OFF + 512;
static_assert(TILEE_OFF + 528 * 4 <= LDS_BYTES, "LDS map");

#define XB_TMO      128
#define XB_XCNT(j)  (256  + 64 * (j))
#define XB_XSUB(j)  (1280 + 64 * (j))
#define XB_XGEN(j)  (2304 + 64 * (j))
#define XB_TOP      3328
#define XB_TOPGEN   3392
#define XCD_BAR_WORDS 3456
#define XB_SPIN_CAP (1u << 18)

__device__ __forceinline__ unsigned xb_ld(unsigned* p)              { return __hip_atomic_load(p, __ATOMIC_RELAXED, __HIP_MEMORY_SCOPE_AGENT); }
__device__ __forceinline__ unsigned xb_add(unsigned* p, unsigned v) { return __hip_atomic_fetch_add(p, v, __ATOMIC_RELAXED, __HIP_MEMORY_SCOPE_AGENT); }
__device__ __forceinline__ unsigned xb_xcc_id() { return (unsigned)__builtin_amdgcn_s_getreg((3 << 11) | 20) & 0xFu; }
#define XB_SPIN(cond, bar) do { unsigned _sp = 0; while (cond) { __builtin_amdgcn_s_sleep(1); \
    if ((++_sp & 255u) == 0u) { if (xb_ld(&(bar)[XB_TMO])) break; if (_sp > XB_SPIN_CAP) { atomicAdd(&(bar)[XB_TMO], 1u); break; } } } } while (0)

struct XcdBarrier {
    unsigned* bar; unsigned x;
    volatile LAS unsigned* st;
    int wv;
};

__device__ __forceinline__ XcdBarrier xcd_barrier_post(unsigned* bar, volatile LAS unsigned* st) {
    XcdBarrier b; b.bar = bar; b.x = xb_xcc_id(); b.st = st; b.wv = 0;
    if (threadIdx.x == 0) (void)xb_add(&bar[XB_XCNT(b.x)], 1u);
    return b;
}
__device__ __forceinline__ void xcd_barrier_complete(unsigned* bar, unsigned x, unsigned& nloc, unsigned& nx) {
    const unsigned G = gridDim.x * gridDim.y * gridDim.z;
    unsigned sum, cnt, mine, sp = 0u;
    for (;;) {
        sum = 0u; cnt = 0u; mine = 0u;
#pragma unroll
        for (unsigned j = 0; j < 16; ++j) { const unsigned c = xb_ld(&bar[XB_XCNT(j)]); sum += c; cnt += (c > 0u) ? 1u : 0u; mine = (j == x) ? c : mine; }
        if (sum == G) break;
        __builtin_amdgcn_s_sleep(1);
        if ((++sp & 255u) == 0u) { if (xb_ld(&bar[XB_TMO])) break; if (sp > XB_SPIN_CAP) { atomicAdd(&bar[XB_TMO], 1u); break; } }
    }
    nloc = mine > 0u ? mine : 1u; nx = cnt > 0u ? cnt : 1u;
}

__device__ __forceinline__ void xcd_barrier(const XcdBarrier& b) {
    asm volatile("s_waitcnt vmcnt(0)" ::: "memory");
    __syncthreads();
    if (b.wv == 0 && pg8::lane_id() == 0) {
        unsigned* bar = b.bar;
        __builtin_amdgcn_s_waitcnt(0);
        unsigned nloc = b.st[0], nx = b.st[1];
        if (nloc == 0u) { xcd_barrier_complete(bar, b.x, nloc, nx); b.st[0] = nloc; b.st[1] = nx; }
        const unsigned old = xb_add(&bar[XB_XSUB(b.x)], 1u);
        const unsigned gen = old / nloc;
        if (old + 1u == (gen + 1u) * nloc) {
            __builtin_amdgcn_fence(__ATOMIC_RELEASE, "agent");
            asm volatile("s_waitcnt vmcnt(0)" ::: "memory");
            const unsigned og = xb_add(&bar[XB_TOP], 1u);
            const unsigned tg = og / nx;
            if (og + 1u == (tg + 1u) * nx) xb_add(&bar[XB_TOPGEN], 1u);
            else XB_SPIN(xb_ld(&bar[XB_TOPGEN]) == tg, bar);
            __builtin_amdgcn_fence(__ATOMIC_ACQUIRE, "agent");
            xb_add(&bar[XB_XGEN(b.x)], 1u);
            asm volatile("s_waitcnt vmcnt(0)" ::: "memory");
        } else {
            XB_SPIN(xb_ld(&bar[XB_XGEN(b.x)]) == gen, bar);
            __builtin_amdgcn_fence(__ATOMIC_ACQUIRE, "agent");
            asm volatile("s_waitcnt vmcnt(0)" ::: "memory");
        }
    }
    __syncthreads();
}
__device__ __forceinline__ float shx(float v, int m, int lane) { return __builtin_bit_cast(float, __builtin_amdgcn_ds_bpermute((lane ^ m) << 2, __builtin_bit_cast(int, v))); }
__device__ __forceinline__ int shxi(int v, int m, int lane) { return __builtin_amdgcn_ds_bpermute((lane ^ m) << 2, v); }
__device__ __forceinline__ s16x4 vtr(unsigned lds_addr) { return __builtin_bit_cast(s16x4, __builtin_amdgcn_ds_read_tr16_b64_v4i16((LAS v4i16_t*)(size_t)lds_addr)); }
__device__ __forceinline__ bf16x8 cat8(s16x4 lo, s16x4 hi) { return __builtin_shufflevector(lo, hi, 0, 1, 2, 3, 4, 5, 6, 7); }
__device__ __forceinline__ void unpack8(const u32x4 w, float (&f)[8]) { f[0] = bflo(w.x); f[1] = bfhi(w.x); f[2] = bflo(w.y); f[3] = bfhi(w.y); f[4] = bflo(w.z); f[5] = bfhi(w.z); f[6] = bflo(w.w); f[7] = bfhi(w.w); }
__device__ __forceinline__ void unpack8f8(const u32x2 w, float (&f)[8]) { const auto a0 = __builtin_amdgcn_cvt_pk_f32_fp8((int)w.x, false), a1 = __builtin_amdgcn_cvt_pk_f32_fp8((int)w.x, true), a2 = __builtin_amdgcn_cvt_pk_f32_fp8((int)w.y, false), a3 = __builtin_amdgcn_cvt_pk_f32_fp8((int)w.y, true);
    f[0] = a0[0]; f[1] = a0[1]; f[2] = a1[0]; f[3] = a1[1]; f[4] = a2[0]; f[5] = a2[1]; f[6] = a3[0]; f[7] = a3[1]; }
__device__ __forceinline__ u32x4 pack8(const float (&f)[8]) { u32x4 w; w.x = pk2(f[0], f[1]); w.y = pk2(f[2], f[3]); w.z = pk2(f[4], f[5]); w.w = pk2(f[6], f[7]); return w; }

struct Args {
    const float* in[22]; float* out; unsigned char* ws;
};

__device__ __forceinline__ void transpose_item(const float* p0, const float* p1, int ld, int mode, float scale, int K, int nblk, bf16_t* dst, int row0, LAS float* scr, int item, int lane, const float* kscale = nullptr) {
    const int kb = item / nblk, nb = item % nblk, k0 = 64 * kb, n0 = 32 * nb;
    const int np = n0 + (lane & 31);
    const float* sp; int col;
    if (mode == 0) { sp = p0; col = np; } else { sp = (np & 4) ? p1 : p0; col = (np >> 3) * 4 + (np & 3); }
    sp += (size_t)k0 * ld + col;
#pragma unroll 8
    for (int i = 0; i < 32; ++i) { const int kk = 2 * i + (lane >> 5); scr[kk * 33 + (lane & 31)] = sp[(size_t)kk * ld] * scale * (kscale ? kscale[k0 + kk] : 1.0f); }
    LDS_WAIT(); asm volatile("" ::: "memory");
    const int c = lane & 7;
#pragma unroll
    for (int j = 0; j < 4; ++j) { const int n = (lane >> 3) + 8 * j; const LAS float* s = scr + (8 * c) * 33 + n;
        u32x4 o; o.x = pk2(s[0 * 33], s[1 * 33]); o.y = pk2(s[2 * 33], s[3 * 33]); o.z = pk2(s[4 * 33], s[5 * 33]); o.w = pk2(s[6 * 33], s[7 * 33]);
        const int ng = row0 + n0 + n, kk = k0 + 8 * c;
        *(u32x4*)(dst + ((size_t)(ng >> 4) * (K >> 5) + (kk >> 5)) * 512 + (ng & 15) * 32 + (kk & 31)) = o; }
    LDS_WAIT(); asm volatile("" ::: "memory");
}
__device__ __forceinline__ void transpose_item8(const float* p0, const float* p1, int ld, int mode, float scale, int K, int nblk, unsigned char* dst, int row0, LAS float* scr, int item, int lane, const float* kscale = nullptr) {
    const int kb = item / nblk, nb = item % nblk, k0 = 64 * kb, n0 = 32 * nb;
    const int nq = lane & 7, kr = lane >> 3, np = n0 + 4 * nq;
    const float* sp; int col;
    if (mode == 0) { sp = p0; col = np; } else { sp = ((np >> 7) & 1) ? p1 : p0; col = (np >> 8) * 128 + (np & 127); }
    sp += (size_t)k0 * ld + col;
    f32x4 ld4[8];
#pragma unroll
    for (int i = 0; i < 8; ++i) ld4[i] = *(const f32x4*)(sp + (size_t)(8 * i + kr) * ld);
#pragma unroll
    for (int i = 0; i < 8; ++i) { const int kk = 8 * i + kr; const float ks = scale * (kscale ? kscale[k0 + kk] : 1.0f);
#pragma unroll
        for (int q = 0; q < 4; ++q) scr[kk * 33 + 4 * nq + q] = ld4[i][q] * ks; }
    LDS_WAIT(); asm volatile("" ::: "memory");
    const int c = lane & 7;
#pragma unroll
    for (int j = 0; j < 4; ++j) { const int n = (lane >> 3) + 8 * j; const LAS float* s = scr + (8 * c) * 33 + n;
        u32x2 o; o.x = pg8::pk4f8(s[0 * 33], s[1 * 33], s[2 * 33], s[3 * 33]); o.y = pg8::pk4f8(s[4 * 33], s[5 * 33], s[6 * 33], s[7 * 33]);
        const int ng = row0 + n0 + n;
        *(u32x2*)(dst + ((size_t)(ng >> 4) * (K >> 6) + (k0 >> 6)) * 1024 + (ng & 15) * 64 + 8 * c) = o; }
    LDS_WAIT(); asm volatile("" ::: "memory");
}
__device__ __forceinline__ void p0_convert(const Args& a, LAS unsigned char* lds, int bid, int G, int wave_s) {
    int tid_ = wave_s * 64 + pg8::lane_id(); asm volatile("" : "+v"(tid_)); const int tid = tid_, lane = tid & 63, wave = __builtin_amdgcn_readfirstlane(tid >> 6);
    unsigned char* ws = a.ws;
    LAS float* scr = (LAS float*)(lds + wave * 16384);
    const int gw = bid * NWAVES + wave, NGW = G * NWAVES;
    constexpr int I_INQ = 16 * 8, I_INB = 16 * 40, I_INC = 16 * 32, I_SQ = 16 * 32, I_GU = 16 * 16 * 32, I_DN = 16 * 8 * 32;
    constexpr int I_LAYER = I_INQ + I_INB + I_INC + 5 * I_SQ + I_GU + I_DN;
    for (int it = gw; it < 2 * I_LAYER; it += NGW) {
        const int l = it / I_LAYER; int r = it % I_LAYER;
        unsigned char* wl = ws + WS_W + (size_t)l * W_LAYER;
        const float* w_in = a.in[2] + (size_t)l * D * DIN;
        if (r < I_INQ) { transpose_item8(w_in, nullptr, DIN, 0, 0.125f * pg8::F8_SW, D, 8, wl + W_IN, 0, scr, r, lane); continue; } r -= I_INQ;
        if (r < I_INB) { transpose_item8(w_in + 256, nullptr, DIN, 0, pg8::F8_SW, D, 40, wl + W_IN, 256, scr, r, lane); continue; } r -= I_INB;
        if (r < I_INC) { transpose_item8(w_in + 1552, nullptr, DIN, 0, pg8::F8_SW, D, 32, wl + W_IN, 1792, scr, r, lane); continue; } r -= I_INC;
        if (r < I_SQ) { transpose_item8(a.in[10] + (size_t)l * D * D, nullptr, D, 0, pg8::F8_SW, D, 32, wl + W_OUT, 0, scr, r, lane); continue; } r -= I_SQ;
        if (r < I_SQ) { transpose_item8(a.in[11] + (size_t)l * D * D, nullptr, D, 0, 0.0625f * pg8::F8_SW, D, 32, wl + W_Q, 0, scr, r, lane, a.in[20] + (size_t)(l * 3 + 0) * D); continue; } r -= I_SQ;
        if (r < I_SQ) { transpose_item8(a.in[14] + (size_t)l * D * D, nullptr, D, 0, pg8::F8_SW, D, 32, wl + W_O, 0, scr, r, lane); continue; } r -= I_SQ;
        if (r < I_SQ) { transpose_item(a.in[12] + (size_t)l * D * D, nullptr, D, 0, 1.0f, D, 32, (bf16_t*)(ws + WS_WKV), l * 2048, scr, r, lane); continue; } r -= I_SQ;
        if (r < I_SQ) { transpose_item(a.in[13] + (size_t)l * D * D, nullptr, D, 0, 1.0f, D, 32, (bf16_t*)(ws + WS_WKV), l * 2048 + 1024, scr, r, lane); continue; } r -= I_SQ;
        if (r < I_GU) { const int e = r / 512, rr = r % 512; const size_t eo = ((size_t)l * 16 + e) * D * 512;
            transpose_item8(a.in[17] + eo, a.in[18] + eo, 512, 2, pg8::F8_SW, D, 32, wl + W_GU, e * 1024, scr, rr, lane); continue; } r -= I_GU;
        { const int e = r / 256, rr = r % 256; const size_t eo = ((size_t)l * 16 + e) * 512 * D;
            transpose_item8(a.in[19] + eo, nullptr, D, 0, pg8::F8_SW, 512, 32, wl + W_D, e * 1024, scr, rr, lane); }
    }
    const size_t gt = (size_t)bid * NTHR + tid, NT = (size_t)G * NTHR;
    for (int it = gw; it < 2 * 16 * 16; it += NGW) { const int l = it >> 8, kc = (it >> 4) & 15, n = (it & 15) * 64 + lane;
        const float* wq = a.in[11] + (size_t)l * D * D; const float* gg = a.in[20] + (size_t)(l * 3) * D; const float* bb = a.in[21] + (size_t)(l * 3) * D; float cs = 0.f, bq = 0.f;
#pragma unroll 8
        for (int k = 64 * kc; k < 64 * kc + 64; ++k) { const float w = wq[(size_t)k * D + n] * 0.0625f; cs += pg8::f8round(w * gg[k] * pg8::F8_SW) * (1.0f / pg8::F8_SW); bq += w * bb[k]; }
        float* tb = (float*)(ws + WS_CS) + (size_t)l * 2 * 16 * 1024; tb[kc * 1024 + n] = cs; tb[16 * 1024 + kc * 1024 + n] = bq; }
    for (size_t i = gt; i < (size_t)2 * 256 * 128; i += NT) {
        const int l = (int)(i / (256 * 128)), r = (int)(i % (256 * 128)), j = r / 128, k8 = r % 128;
        const float* w_in = a.in[2] + (size_t)l * D * DIN; const float* w_a2 = a.in[3] + (size_t)l * 16 * 256;
        float wa[16];
#pragma unroll
        for (int q = 0; q < 16; ++q) wa[q] = w_a2[q * 256 + j];
        float o[8];
#pragma unroll
        for (int kk = 0; kk < 8; ++kk) { const float* wr = w_in + (size_t)(8 * k8 + kk) * DIN + 1536; float s = 0.f;
#pragma unroll
            for (int q = 0; q < 16; q += 4) { const f32x4 v = *(const f32x4*)(wr + q); s += v[0] * wa[q] + v[1] * wa[q + 1] + v[2] * wa[q + 2] + v[3] * wa[q + 3]; }
            o[kk] = s; }
        { const int ng = 1536 + j, kk = 8 * k8; u32x2 o8; o8.x = pg8::pk4f8(o[0] * pg8::F8_SW, o[1] * pg8::F8_SW, o[2] * pg8::F8_SW, o[3] * pg8::F8_SW); o8.y = pg8::pk4f8(o[4] * pg8::F8_SW, o[5] * pg8::F8_SW, o[6] * pg8::F8_SW, o[7] * pg8::F8_SW);
          *(u32x2*)(ws + WS_W + (size_t)l * W_LAYER + W_IN + ((size_t)(ng >> 4) * (D >> 6) + (kk >> 6)) * 1024 + (ng & 15) * 64 + (kk & 63)) = o8; }
    }
    for (size_t i = gt; i < (size_t)2 * 4 * 128 * 16; i += NT) {
        const int s8 = (int)(i & 15), t = (int)((i >> 4) & 127);
        const float* src = a.in[6] + i * 8; float o[8];
#pragma unroll
        for (int q = 0; q < 8; ++q) o[q] = ((8 * s8 + q) / 64 <= t / 64) ? src[q] : 0.f;
        *(u32x4*)((bf16_t*)(ws + WS_WM) + i * 8) = pack8(o);
    }
    for (size_t i = gt; i < (size_t)M * D / 8; i += NT) {
        const f32x4 v0 = *(const f32x4*)(a.in[0] + i * 8), v1 = *(const f32x4*)(a.in[0] + i * 8 + 4);
        u32x4 w; w.x = pk2(v0[0], v0[1]); w.y = pk2(v0[2], v0[3]); w.z = pk2(v1[0], v1[1]); w.w = pk2(v1[2], v1[3]);
        *(u32x4*)((bf16_t*)(ws + WS_X) + i * 8) = w;
        u32x2 q8; q8.x = pg8::pk4f8(v0[0] * pg8::F8_SX, v0[1] * pg8::F8_SX, v0[2] * pg8::F8_SX, v0[3] * pg8::F8_SX); q8.y = pg8::pk4f8(v1[0] * pg8::F8_SX, v1[1] * pg8::F8_SX, v1[2] * pg8::F8_SX, v1[3] * pg8::F8_SX);
        *(u32x2*)(ws + WS_X8IN + i * 8) = q8;
    }
    for (size_t i = gt; i < (size_t)MKV * D / 8; i += NT) {
        const f32x4 v0 = *(const f32x4*)(a.in[1] + i * 8), v1 = *(const f32x4*)(a.in[1] + i * 8 + 4);
        u32x4 w; w.x = pk2(v0[0], v0[1]); w.y = pk2(v0[2], v0[3]); w.z = pk2(v1[0], v1[1]); w.w = pk2(v1[2], v1[3]);
        *(u32x4*)((bf16_t*)(ws + WS_MEMB) + i * 8) = w;
    }
}

constexpr int GL_KD = 0, GL_QS = 9216, GL_VS = 18432, GL_PSUM = 35840, GL_DL = 37888, GL_SSQ = 38144;
template <bool FINAL>
__device__ __forceinline__ void gla_phase(LAS unsigned char* lds, const bf16_t* P, float* Send, float* Ltot, bf16_t* Y, const float* gn_g, int bid, int G, int wave_s) {
    int tid_ = wave_s * 64 + pg8::lane_id(); asm volatile("" : "+v"(tid_)); const int tid = tid_, lane = tid & 63, wave = __builtin_amdgcn_readfirstlane(tid >> 6);
    const unsigned lb = (unsigned)(size_t)lds;
    const int g = lane >> 4, l15 = lane & 15, q4 = l15 >> 2, p4 = lane & 3;
    const int kq = tid & 63, part = wave;
    for (int item = bid; item < 256; item += G) {
        const int b = item >> 5, h = (item >> 3) & 3, run = item & 7, bh = item >> 3;
        f32x4 sacc[4];
#pragma unroll
        for (int kt = 0; kt < 4; ++kt) sacc[kt] = (f32x4){0.f, 0.f, 0.f, 0.f};
        if (FINAL) {
            for (int i = 0; i < run; ++i) {
                const float* se = Send + ((size_t)(bh * 8 + i) * 64) * 128; const float* lt = Ltot + (size_t)(bh * 8 + i) * 64;
#pragma unroll
                for (int kt = 0; kt < 4; ++kt)
#pragma unroll
                    for (int r = 0; r < 4; ++r) { const int k = 16 * kt + 4 * g + r; sacc[kt][r] = __expf(lt[k]) * sacc[kt][r] + se[(size_t)k * 128 + 16 * wave + l15]; }
            }
        }
        float ltot_acc = 0.f;
        unsigned short graw[8], kraw[8]; u32x4 vraw[2], qraw; u32x2 rraw[4];
        const int v_row = tid >> 4, v_c16 = tid & 15, q_row = tid >> 3, q_c16 = tid & 7;
        const int ycol = h * 128 + 16 * wave + 4 * g;
#define GLA_FETCH(CC) do { const size_t tf_ = (size_t)b * SEQ + (size_t)(run * 16 + (CC)) * 64; \
            _Pragma("unroll") for (int i = 0; i < 8; ++i) { const bf16_t* rp = P + (tf_ + 8 * part + i) * NP + h * 64 + kq; graw[i] = rp[PG]; kraw[i] = rp[PK]; } \
            _Pragma("unroll") for (int i = 0; i < 2; ++i) vraw[i] = *(const u32x4*)(P + (tf_ + v_row + 32 * i) * NP + PV + h * 128 + v_c16 * 8); \
            if (FINAL) { qraw = *(const u32x4*)(P + (tf_ + q_row) * NP + PQ + h * 64 + q_c16 * 8); \
                _Pragma("unroll") for (int tt = 0; tt < 4; ++tt) rraw[tt] = *(const u32x2*)(P + (tf_ + 16 * tt + l15) * NP + PR + ycol); } } while (0)
        GLA_FETCH(0);
        for (int c = 0; c < 16; ++c) {
            const size_t t0 = (size_t)b * SEQ + (size_t)(run * 16 + c) * 64;
            __syncthreads();
            float gv[8], kv[8];
#pragma unroll
            for (int i = 0; i < 8; ++i) { gv[i] = __builtin_bit_cast(float, (unsigned)graw[i] << 16); kv[i] = __builtin_bit_cast(float, (unsigned)kraw[i] << 16); }
#pragma unroll
            for (int i = 1; i < 8; ++i) gv[i] += gv[i - 1];
            ((LAS float*)(lds + GL_PSUM))[part * 64 + kq] = gv[7];
#pragma unroll
            for (int i = 0; i < 2; ++i) *(LAS u32x4*)(lds + GL_VS + (v_row + 32 * i) * 272 + v_c16 * 16) = vraw[i];
            u32x2 rcur[4];
            if (FINAL) { *(LAS u32x4*)(lds + GL_QS + q_row * 144 + q_c16 * 16) = qraw;
#pragma unroll
                for (int tt = 0; tt < 4; ++tt) rcur[tt] = rraw[tt]; }
            if (c + 1 < 16) GLA_FETCH(c + 1);
            __syncthreads();
            float offs = 0.f, bl = 0.f;
#pragma unroll
            for (int p = 0; p < 8; ++p) { const float v = ((LAS float*)(lds + GL_PSUM))[p * 64 + kq]; offs += (p < part) ? v : 0.f; bl += v; }
#pragma unroll
            for (int i = 0; i < 8; ++i) { const float kd = kv[i] * __expf(bl - (offs + gv[i]));
                *(LAS unsigned short*)(lds + GL_KD + (8 * part + i) * 144 + kq * 2) = (unsigned short)(pk2(kd, 0.f) & 0xffffu); }
            if (part == 0) ((LAS float*)(lds + GL_DL))[kq] = __expf(bl);
            ltot_acc += bl;
            __syncthreads();
#pragma unroll
            for (int kt = 0; kt < 4; ++kt) { const f32x4 dl = *(LAS f32x4*)(lds + GL_DL + (16 * kt + 4 * g) * 4); sacc[kt] = sacc[kt] * dl; }
#pragma unroll
            for (int ks = 0; ks < 2; ++ks) {
                const unsigned vrow = lb + GL_VS + (unsigned)(32 * ks + 8 * g + q4) * 272u + (unsigned)(16 * wave + 4 * p4) * 2u;
                const bf16x8 vb = cat8(vtr(vrow), vtr(vrow + 4u * 272u));
#pragma unroll
                for (int kt = 0; kt < 4; ++kt) {
                    const unsigned krow = lb + GL_KD + (unsigned)(32 * ks + 8 * g + q4) * 144u + (unsigned)(16 * kt + 4 * p4) * 2u;
                    const bf16x8 ka = cat8(vtr(krow), vtr(krow + 4u * 144u));
                    sacc[kt] = __builtin_amdgcn_mfma_f32_16x16x32_bf16(ka, vb, sacc[kt], 0, 0, 0);
                }
            }
            if (FINAL) {
                f32x4 oacc[4];
#pragma unroll
                for (int tt = 0; tt < 4; ++tt) oacc[tt] = (f32x4){0.f, 0.f, 0.f, 0.f};
#pragma unroll
                for (int ks2 = 0; ks2 < 2; ++ks2) {
                    u32x4 spw; spw.x = pk2(sacc[2 * ks2][0], sacc[2 * ks2][1]); spw.y = pk2(sacc[2 * ks2][2], sacc[2 * ks2][3]);
                    spw.z = pk2(sacc[2 * ks2 + 1][0], sacc[2 * ks2 + 1][1]); spw.w = pk2(sacc[2 * ks2 + 1][2], sacc[2 * ks2 + 1][3]);
                    const bf16x8 sp = __builtin_bit_cast(bf16x8, spw);
#pragma unroll
                    for (int tt = 0; tt < 4; ++tt) {
                        const LAS unsigned char* qp = lds + GL_QS + (16 * tt + l15) * 144 + (32 * ks2 + 4 * g) * 2;
                        const u32x2 qlo = *(const LAS u32x2*)qp, qhi = *(const LAS u32x2*)(qp + 32);
                        u32x4 qw; qw.x = qlo.x; qw.y = qlo.y; qw.z = qhi.x; qw.w = qhi.y;
                        oacc[tt] = __builtin_amdgcn_mfma_f32_16x16x32_bf16(sp, __builtin_bit_cast(bf16x8, qw), oacc[tt], 0, 0, 0);
                    }
                }
#pragma unroll
                for (int tt = 0; tt < 4; ++tt) { float s = oacc[tt][0] * oacc[tt][0] + oacc[tt][1] * oacc[tt][1] + oacc[tt][2] * oacc[tt][2] + oacc[tt][3] * oacc[tt][3];
                    s += shx(s, 16, lane); s += shx(s, 32, lane);
                    if (g == 0) ((LAS float*)(lds + GL_SSQ))[wave * 64 + 16 * tt + l15] = s; }
                __syncthreads();
                const int col = h * 128 + 16 * wave + 4 * g;
                const f32x4 gn = *(const f32x4*)(gn_g + col);
#pragma unroll
                for (int tt = 0; tt < 4; ++tt) { float tot = 0.f;
#pragma unroll
                    for (int w2 = 0; w2 < 8; ++w2) tot += ((LAS float*)(lds + GL_SSQ))[w2 * 64 + 16 * tt + l15];
                    const float rs = __builtin_amdgcn_rsqf(tot * (1.0f / 128.0f) + 1e-6f);
                    const size_t tok = t0 + 16 * tt + l15;
                    const u32x2 rr = rcur[tt];
                    const float rq = rs * pg8::F8_SM;
                    *(unsigned*)((unsigned char*)Y + tok * D + col) = pg8::pk4f8(oacc[tt][0] * rq * gn[0] * bflo(rr.x), oacc[tt][1] * rq * gn[1] * bfhi(rr.x), oacc[tt][2] * rq * gn[2] * bflo(rr.y), oacc[tt][3] * rq * gn[3] * bfhi(rr.y)); }
            }
        }
        if (!FINAL) {
            float* se = Send + ((size_t)(bh * 8 + run) * 64) * 128;
#pragma unroll
            for (int kt = 0; kt < 4; ++kt)
#pragma unroll
                for (int r = 0; r < 4; ++r) se[(size_t)(16 * kt + 4 * g + r) * 128 + 16 * wave + l15] = sacc[kt][r];
            if (part == 0) Ltot[(size_t)(bh * 8 + run) * 64 + kq] = ltot_acc;
        }
    }
}

#undef GLA_FETCH
constexpr int SG_VN = 0;
__device__ __forceinline__ void sgu_phase(LAS unsigned char* lds, const bf16_t* P, const bf16_t* Wm, const float* b_s, const float* lg, const float* lb_, bf16_t* Y, int bid, int G, int wave_s) {
    int tid_ = wave_s * 64 + pg8::lane_id(); asm volatile("" : "+v"(tid_)); const int tid = tid_, lane = tid & 63, wave = __builtin_amdgcn_readfirstlane(tid >> 6);
    const unsigned lb = (unsigned)(size_t)lds;
    const int g = lane >> 4, l15 = lane & 15, q4 = l15 >> 2, p4 = lane & 3;
    const int row = tid >> 2, qu = tid & 3;
    u32x4 vraw[4]; u32x2 uraw[8];
#define SGU_FETCH(IT) do { const int blk_ = (IT) >> 2, gr_ = (IT) & 3; const size_t tf_ = (size_t)blk_ * 128; \
        const bf16_t* src_ = P + (tf_ + row) * NP + PVS + gr_ * 128 + 32 * qu; \
        _Pragma("unroll") for (int i = 0; i < 4; ++i) vraw[i] = *(const u32x4*)(src_ + 8 * i); \
        const bf16_t* us_ = P + (tf_ + 16 * wave + l15) * NP + PU + gr_ * 128 + 4 * g; \
        _Pragma("unroll") for (int ct = 0; ct < 8; ++ct) uraw[ct] = *(const u32x2*)(us_ + 16 * ct); } while (0)
    if (bid < 2048) SGU_FETCH(bid);
    for (int item = bid; item < 2048; item += G) {
        const int blk = item >> 2, gr = item & 3; const size_t t0 = (size_t)blk * 128;
        __syncthreads();
        u32x2 ucur[8];
        { float v[32];
#pragma unroll
          for (int i = 0; i < 4; ++i) { float f[8]; unpack8(vraw[i], f);
#pragma unroll
              for (int j = 0; j < 8; ++j) v[8 * i + j] = f[j]; }
#pragma unroll
          for (int ct = 0; ct < 8; ++ct) ucur[ct] = uraw[ct];
          if (item + G < 2048) SGU_FETCH(item + G);
          float s = 0.f;
#pragma unroll
          for (int i = 0; i < 32; ++i) s += v[i];
          s += shx(s, 1, lane); s += shx(s, 2, lane);
          const float mu = s * (1.0f / 128.0f); float qq = 0.f;
#pragma unroll
          for (int i = 0; i < 32; ++i) { v[i] -= mu; qq += v[i] * v[i]; }
          qq += shx(qq, 1, lane); qq += shx(qq, 2, lane);
          const float rs = __builtin_amdgcn_rsqf(qq * (1.0f / 128.0f) + LN_EPS);
          const float* gp = lg + gr * 128 + 32 * qu; const float* bp = lb_ + gr * 128 + 32 * qu;
#pragma unroll
          for (int i = 0; i < 4; ++i) { float f[8];
#pragma unroll
              for (int j = 0; j < 8; ++j) f[j] = v[8 * i + j] * rs * gp[8 * i + j] + bp[8 * i + j];
              *(LAS u32x4*)(lds + SG_VN + row * 272 + (32 * qu + 8 * i) * 2) = pack8(f); }
        }
        __syncthreads();
        const int nks = (wave < 4) ? 2 : 4;
        bf16x8 wf[4];
#pragma unroll
        for (int ks = 0; ks < 4; ++ks) wf[ks] = *(const bf16x8*)(Wm + ((size_t)(gr * 128 + 16 * wave + l15)) * 128 + 32 * ks + 8 * g);
        const size_t tok = t0 + 16 * wave + l15; const float bs = b_s[gr * 128 + 16 * wave + l15];
        unsigned vb0 = lb + SG_VN + (unsigned)(8 * g + q4) * 272u + (unsigned)(4 * p4) * 2u; asm volatile("" : "+v"(vb0));
#pragma unroll
        for (int ct = 0; ct < 8; ++ct) {
            f32x4 acc = (f32x4){0.f, 0.f, 0.f, 0.f};
#pragma unroll
            for (int ks = 0; ks < 4; ++ks) {
                if (ks < nks) {
                    const unsigned vrow = vb0 + (unsigned)(32 * ks * 272 + 32 * ct);
                    const bf16x8 va = cat8(vtr(vrow), vtr(vrow + 4u * 272u));
                    acc = __builtin_amdgcn_mfma_f32_16x16x32_bf16(va, wf[ks], acc, 0, 0, 0);
                }
            }
            const int col = gr * 128 + 16 * ct + 4 * g;
            const u32x2 uu = ucur[ct];
            *(unsigned*)((unsigned char*)Y + tok * D + 512 + col) = pg8::pk4f8(bflo(uu.x) * (acc[0] + bs) * pg8::F8_SM, bfhi(uu.x) * (acc[1] + bs) * pg8::F8_SM, bflo(uu.y) * (acc[2] + bs) * pg8::F8_SM, bfhi(uu.y) * (acc[3] + bs) * pg8::F8_SM);
        }
    }
}
#undef SGU_FETCH

constexpr int AT_KPS = 1040, AT_VPS = 1088, AT_SLOT = 34816, AT_NSLOT = 3;
static_assert(AT_NSLOT * AT_SLOT <= LDSCTL_OFF, "attention LDS");
__device__ __forceinline__ void glds16(const void* gsrc, unsigned lds_dst) { unsigned keep;
    asm volatile("s_mov_b32 %0, m0\n\ts_mov_b32 m0, %2\n\ts_nop 0\n\tglobal_load_lds_dwordx4 %1, off\n\ts_mov_b32 m0, %0" : "=&s"(keep) : "v"(gsrc), "s"(lds_dst) : "memory"); }
__device__ __forceinline__ void attn_dma(unsigned lb, const char* kvb, int so, unsigned lane_off, int slot, int ps, int wave) {
#pragma unroll
    for (int j = 0; j < 4; ++j) { const int pi = 4 * wave + j, rlo = 32 * (pi >> 4) + (pi & 15);
        glds16(kvb + (size_t)(so + rlo * 8192) + lane_off, (unsigned)__builtin_amdgcn_readfirstlane((int)(lb + (unsigned)(slot * AT_SLOT + pi * ps)))); }
}
#define AT_WAITBAR(N) do { asm volatile("s_waitcnt vmcnt(" #N ") lgkmcnt(0)" ::: "memory"); __builtin_amdgcn_s_barrier(); asm volatile("" ::: "memory"); } while (0)
__device__ __forceinline__ void attn_phase(LAS unsigned char* lds, const bf16_t* Q, const bf16_t* KV, bf16_t* O, int layer, int bid, int G, int wave_s) {
    int tid_ = wave_s * 64 + pg8::lane_id(); asm volatile("" : "+v"(tid_)); const int tid = tid_, lane = tid & 63, wave = __builtin_amdgcn_readfirstlane(tid >> 6);
    const unsigned lb = (unsigned)(size_t)lds;
    const int r32 = lane & 31, hh = lane >> 5, q4 = (lane & 15) >> 2, p4 = lane & 3, blk = (lane >> 4) & 1;
    LAS unsigned char* kbase = lds + (r32 & 15) * AT_KPS + ((r32 >> 4) & 1) * 512 + hh * 16;
    unsigned vbase = lb + (unsigned)(4 * hh + q4) * (unsigned)AT_VPS + (unsigned)(16 * blk + 4 * p4) * 2u;
    unsigned lane_off = (unsigned)((lane >> 5) * 16 * 8192 + (lane & 31) * 16);
    asm volatile("" : "+v"(kbase), "+v"(vbase), "+v"(lane_off));
    const char* kvb = (const char*)KV;
    const int nun = (bid < 256) ? 4 * ((256 - bid + G - 1) / G) : 0;
#define AT_SRC(N, ST) ((int)((((size_t)(((bid + ((N) >> 2) * G) >> 5) * NMEM) * 4096 + layer * 2048 + ((N) & 3) * 256 + (((ST) >> 2) * 1024)) * 2) + ((ST) & 3) * 64 * 8192))
    __syncthreads();
    if (nun > 0) { attn_dma(lb, kvb, AT_SRC(0, 0), lane_off, 0, AT_KPS, wave); attn_dma(lb, kvb, AT_SRC(0, 1), lane_off, 1, AT_KPS, wave); AT_WAITBAR(4); }
    int sl = 0;
    for (int n = 0; n < nun; ++n) {
        const int pan = bid + (n >> 2) * G, h = n & 3, b = pan >> 5, qt = pan & 31;
        int ln_ = pg8::lane_id(); asm volatile("" : "+v"(ln_));
        const unsigned qoff = (unsigned)((wave * 8 * 64 + ln_) * 16);
        const char* qbase = (const char*)Q + (size_t)(pan * 4 + h) * 65536;
        char* obase = (char*)O + ((size_t)b * SEQ + qt * 256) * D + h * 256;
        const bool more = (n + 1 < nun);
        bf16x8 qf[16];
#pragma unroll
        for (int s = 0; s < 8; ++s) { const u32x4 raw = *(const GAS u32x4*)(qbase + qoff + 1024 * s); float f[8]; u32x2 h8;
            h8.x = raw.x; h8.y = raw.y; unpack8f8(h8, f);
#pragma unroll
            for (int i = 0; i < 8; ++i) f[i] *= (1.0f / pg8::F8_SQ);
            qf[s] = __builtin_bit_cast(bf16x8, pack8(f));
            h8.x = raw.z; h8.y = raw.w; unpack8f8(h8, f);
#pragma unroll
            for (int i = 0; i < 8; ++i) f[i] *= (1.0f / pg8::F8_SQ);
            qf[s + 8] = __builtin_bit_cast(bf16x8, pack8(f)); }
        float ml = 0.f, lsum = 0.f;
        bf16x8 pk[8][2];
#pragma unroll
        for (int st = 0; st < 4; ++st) {
            const int sl2 = (sl >= 1) ? sl - 1 : 2;
            if (st > 0) attn_dma(lb, kvb, AT_SRC(n, st + 2), lane_off, sl2, (st + 2 < 4) ? AT_KPS : AT_VPS, wave);
            LAS unsigned char* kb = kbase + sl * AT_SLOT;
            f32x16 sa[2];
#pragma unroll
            for (int kt = 0; kt < 2; ++kt)
#pragma unroll
                for (int r = 0; r < 16; ++r) sa[kt][r] = 0.f;
            bf16x8 kfa[2], kfb[2];
#define AT_KLD(dst, S0) do { _Pragma("unroll") for (int kt = 0; kt < 2; ++kt) dst[kt] = *(const LAS bf16x8*)(kb + kt * 16 * AT_KPS + 32 * (S0)); } while (0)
#define AT_KMM(src, S0) do { _Pragma("unroll") for (int kt = 0; kt < 2; ++kt) sa[kt] = __builtin_amdgcn_mfma_f32_32x32x16_bf16(src[kt], qf[(S0)], sa[kt], 0, 0, 0); } while (0)
            AT_KLD(kfa, 0); __builtin_amdgcn_sched_barrier(0);
#pragma unroll
            for (int bq = 0; bq < 8; ++bq) {
                AT_KLD(kfb, 2 * bq + 1); __builtin_amdgcn_sched_barrier(0);
                AT_KMM(kfa, 2 * bq); __builtin_amdgcn_sched_barrier(0);
                if (bq < 7) { AT_KLD(kfa, 2 * bq + 2); __builtin_amdgcn_sched_barrier(0); }
                AT_KMM(kfb, 2 * bq + 1); __builtin_amdgcn_sched_barrier(0);
            }
#undef AT_KLD
#undef AT_KMM
            if (st == 0) attn_dma(lb, kvb, AT_SRC(n, 2), lane_off, sl2, AT_KPS, wave);
            if (st == 0) { float mx = -3.0e38f;
#pragma unroll
                for (int kt = 0; kt < 2; ++kt)
#pragma unroll
                    for (int r = 0; r < 16; ++r) mx = __builtin_fmaxf(mx, sa[kt][r]);
                mx = __builtin_fmaxf(mx, shx(mx, 32, lane)); ml = mx * LOG2E; }
#pragma unroll
            for (int kt = 0; kt < 2; ++kt) {
                float p[16];
#pragma unroll
                for (int r = 0; r < 16; ++r) { p[r] = __builtin_amdgcn_exp2f(sa[kt][r] * LOG2E - ml); lsum += p[r]; }
#pragma unroll
                for (int s2 = 0; s2 < 2; ++s2) { u32x4 w; w.x = pk2(p[8 * s2 + 0], p[8 * s2 + 1]); w.y = pk2(p[8 * s2 + 2], p[8 * s2 + 3]); w.z = pk2(p[8 * s2 + 4], p[8 * s2 + 5]); w.w = pk2(p[8 * s2 + 6], p[8 * s2 + 7]);
                    pk[2 * st + kt][s2] = __builtin_bit_cast(bf16x8, w); }
            }
            AT_WAITBAR(4);
            sl = (sl == 2) ? 0 : sl + 1;
        }
        lsum += shx(lsum, 32, lane);
        f32x16 oacc[8];
#pragma unroll
        for (int dt = 0; dt < 8; ++dt)
#pragma unroll
            for (int r = 0; r < 16; ++r) oacc[dt][r] = 0.f;
#pragma unroll
        for (int st = 4; st < 8; ++st) {
            const bool issue = (st < 6) || more;
            if (issue) { const int s2 = (sl >= 1) ? sl - 1 : 2;
                if (st < 6) attn_dma(lb, kvb, AT_SRC(n, st + 2), lane_off, s2, AT_VPS, wave); else attn_dma(lb, kvb, AT_SRC(n + 1, st - 6), lane_off, s2, AT_KPS, wave); }
            const unsigned vb = vbase + (unsigned)(sl * AT_SLOT);
            bf16x8 vfa[2], vfb[2];
#define AT_VLD(dst, BT) do { const unsigned va_ = vb + (unsigned)((((BT) >> 3) & 1) * 16 * AT_VPS + (((BT) >> 2) & 1) * 512 + ((BT) & 3) * 128); \
                _Pragma("unroll") for (int d_ = 0; d_ < 2; ++d_) dst[d_] = cat8(vtr(va_ + 64u * d_), vtr(va_ + 64u * d_ + 8u * AT_VPS)); } while (0)
#define AT_VMM(src, BT) do { _Pragma("unroll") for (int d_ = 0; d_ < 2; ++d_) oacc[2 * ((BT) & 3) + d_] = __builtin_amdgcn_mfma_f32_32x32x16_bf16(src[d_], pk[2 * (st - 4) + (((BT) >> 3) & 1)][((BT) >> 2) & 1], oacc[2 * ((BT) & 3) + d_], 0, 0, 0); } while (0)
            AT_VLD(vfa, 0); __builtin_amdgcn_sched_barrier(0);
#pragma unroll
            for (int bq = 0; bq < 8; ++bq) {
                AT_VLD(vfb, 2 * bq + 1); __builtin_amdgcn_sched_barrier(0);
                AT_VMM(vfa, 2 * bq); __builtin_amdgcn_sched_barrier(0);
                if (bq < 7) { AT_VLD(vfa, 2 * bq + 2); __builtin_amdgcn_sched_barrier(0); }
                AT_VMM(vfb, 2 * bq + 1); __builtin_amdgcn_sched_barrier(0);
            }
#undef AT_VLD
#undef AT_VMM
            if (issue) AT_WAITBAR(4); else AT_WAITBAR(0);
            sl = (sl == 2) ? 0 : sl + 1;
        }
        const float inv = 1.0f / lsum;
        int ln2 = pg8::lane_id(); asm volatile("" : "+v"(ln2));
        GAS char* op = (GAS char*)obase + (unsigned)((wave * 32 + (ln2 & 31)) * D) + ((ln2 >> 5) ? 16 : 0);
        const float sc = inv * pg8::F8_SO;
#pragma unroll
        for (int dt = 0; dt < 8; ++dt) {
            unsigned dw[4];
#pragma unroll
            for (int g4 = 0; g4 < 4; ++g4) dw[g4] = pg8::pk4f8(oacc[dt][4 * g4 + 0] * sc, oacc[dt][4 * g4 + 1] * sc, oacc[dt][4 * g4 + 2] * sc, oacc[dt][4 * g4 + 3] * sc);
            { const auto r = __builtin_amdgcn_permlane32_swap(dw[0], dw[2], false, false); dw[0] = r[0]; dw[2] = r[1]; }
            { const auto r = __builtin_amdgcn_permlane32_swap(dw[1], dw[3], false, false); dw[1] = r[0]; dw[3] = r[1]; }
            u32x4 w; w.x = dw[0]; w.y = dw[2]; w.z = dw[1]; w.w = dw[3];
            *(GAS u32x4*)(op + 32 * dt) = w; }
    }
    asm volatile("s_waitcnt vmcnt(0)" ::: "memory");
    __syncthreads();
}
#undef AT_SRC
#undef AT_WAITBAR

constexpr int RT_WH = 0, RT_WL = 32768, RT_SEL = 65536, RT_RK = 66048, RT_CNTW = 67072, RT_WBASE = 67584, RT_CS = 68608, RT_BB = 68672, RT_PART = 68736;
template <int MODE>
__device__ __forceinline__ void ln_phase(LAS unsigned char* lds, const Args& a, int l, int lnidx, bool last, bf16_t* Xout, int bid, int G, int wave_s) {
    int tid_ = wave_s * 64 + pg8::lane_id(); asm volatile("" : "+v"(tid_)); const int tid = tid_, lane = tid & 63, wave = __builtin_amdgcn_readfirstlane(tid >> 6);
    constexpr int R = (MODE == 2) ? 2 : 4;
    unsigned char* ws = a.ws;
    const bf16_t* Z = (const bf16_t*)(ws + WS_R + R_Z); const unsigned char* Ys8 = ws + WS_R + R_XS;
    pg8::f32x2_t* stats1 = (pg8::f32x2_t*)(ws + WS_STATS);
    const float* gp = a.in[20] + (size_t)(l * 3 + lnidx) * D; const float* bp = a.in[21] + (size_t)(l * 3 + lnidx) * D;
    float gg[16], bb[16];
#pragma unroll
    for (int j = 0; j < 2; ++j)
#pragma unroll
        for (int i = 0; i < 8; ++i) { gg[8 * j + i] = gp[8 * lane + 512 * j + i]; bb[8 * j + i] = bp[8 * lane + 512 * j + i]; }
    float g1v[16], b1v[16];
    if (MODE == 2) { const float* gq = a.in[20] + (size_t)(l * 3 + 1) * D; const float* bq_ = a.in[21] + (size_t)(l * 3 + 1) * D;
#pragma unroll
        for (int j = 0; j < 2; ++j)
#pragma unroll
            for (int i = 0; i < 8; ++i) { g1v[8 * j + i] = gq[8 * lane + 512 * j + i]; b1v[8 * j + i] = bq_[8 * lane + 512 * j + i]; } }
    if (MODE == 1) {
        __syncthreads();
        for (int idx = tid; idx < 2048; idx += NTHR) { const int s = idx >> 6, ln = idx & 63, e = ln & 15, g = ln >> 4; float hi[8], lo[8];
#pragma unroll
            for (int j = 0; j < 8; ++j) { const float w = a.in[15][(32 * s + 8 * g + j) * 16 + e] * gp[32 * s + 8 * g + j]; const float h = bflo(pk2(w, 0.f) & 0xffffu); hi[j] = h; lo[j] = w - h; }
            *(LAS u32x4*)(lds + RT_WH + idx * 16) = pack8(hi); *(LAS u32x4*)(lds + RT_WL + idx * 16) = pack8(lo); }
        { const int e = tid & 15, kp = tid >> 4; float cs = 0.f, bs = 0.f;
          for (int k = 32 * kp; k < 32 * kp + 32; ++k) { const float wr = a.in[15][k * 16 + e]; const float w = wr * gp[k]; const float h = bflo(pk2(w, 0.f) & 0xffffu); const float lo2 = bflo(pk2(w - h, 0.f) & 0xffffu); cs += h + lo2; bs += bp[k] * wr; }
          ((LAS float*)(lds + RT_PART))[kp * 32 + e] = cs; ((LAS float*)(lds + RT_PART))[kp * 32 + 16 + e] = bs; }
        __syncthreads();
        if (tid < 32) { float t = 0.f; for (int kp = 0; kp < 32; ++kp) t += ((LAS float*)(lds + RT_PART))[kp * 32 + tid];
            if (tid < 16) ((LAS float*)(lds + RT_CS))[tid] = t; else ((LAS float*)(lds + RT_BB))[tid - 16] = t + a.in[16][tid - 16]; }
        __syncthreads();
    }
    for (int blk = bid; blk < 256; blk += G) {
        int run[16];
#pragma unroll
        for (int e = 0; e < 16; ++e) run[e] = 0;
        u32x4 pa_[R][2]; u32x2 pb_[R][2], pc_[R][2]; float pw0[R], pw1[R]; pg8::f32x2_t pst[R];
#define LN_LOAD(ROW0) do { _Pragma("unroll") for (int r = 0; r < R; ++r) { const size_t row = (ROW0) + r; \
            if (MODE == 2) { const int* ts = (const int*)(ws + WS_TSLOT) + row * 2; const float* ti = (const float*)(ws + WS_TINFO) + row * 4; const int s0 = ts[0], s1 = ts[1]; pw0[r] = ti[2]; pw1[r] = ti[3]; pst[r] = stats1[row]; \
                _Pragma("unroll") for (int j = 0; j < 2; ++j) { pa_[r][j] = *(const u32x4*)(Z + row * D + 8 * lane + 512 * j); pb_[r][j] = *(const u32x2*)(Ys8 + (size_t)s0 * D + 8 * lane + 512 * j); pc_[r][j] = *(const u32x2*)(Ys8 + (size_t)s1 * D + 8 * lane + 512 * j); } } \
            else { _Pragma("unroll") for (int j = 0; j < 2; ++j) pa_[r][j] = *(const u32x4*)(Z + row * D + 8 * lane + 512 * j); } } } while (0)
        float mu_t = 0.f, rs_t = 0.f;
        LN_LOAD((size_t)blk * 256 + wave * 32);
        for (int ri = 0; ri < 32; ri += R) {
            const int rl0 = wave * 32 + ri; const size_t row0 = (size_t)blk * 256 + rl0;
            float v[R][16];
#pragma unroll
            for (int r = 0; r < R; ++r)
#pragma unroll
                for (int j = 0; j < 2; ++j) { float x[8]; unpack8(pa_[r][j], x);
                    if (MODE == 2) { float y0[8], y1[8]; unpack8f8(pb_[r][j], y0); unpack8f8(pc_[r][j], y1); const float mu1 = pst[r][0], rs1 = pst[r][1];
#pragma unroll
                        for (int i = 0; i < 8; ++i) v[r][8 * j + i] = ALPHA * ((x[i] - mu1) * rs1 * g1v[8 * j + i] + b1v[8 * j + i]) + (pw0[r] * (1.0f / pg8::F8_SY)) * y0[i] + (pw1[r] * (1.0f / pg8::F8_SY)) * y1[i]; }
                    else {
#pragma unroll
                        for (int i = 0; i < 8; ++i) v[r][8 * j + i] = x[i]; } }
            if (ri + R < 32) LN_LOAD(row0 + R);
            float s[R];
#pragma unroll
            for (int r = 0; r < R; ++r) { s[r] = 0.f;
#pragma unroll
                for (int i = 0; i < 16; ++i) s[r] += v[r][i]; }
#pragma unroll
            for (int o = 1; o < 64; o <<= 1)
#pragma unroll
                for (int r = 0; r < R; ++r) s[r] += shx(s[r], o, lane);
            float qq[R], mur[R];
#pragma unroll
            for (int r = 0; r < R; ++r) { const float mu = s[r] * (1.0f / D); mur[r] = mu; qq[r] = 0.f;
#pragma unroll
                for (int i = 0; i < 16; ++i) { v[r][i] -= mu; qq[r] += v[r][i] * v[r][i]; } }
#pragma unroll
            for (int o = 1; o < 64; o <<= 1)
#pragma unroll
                for (int r = 0; r < R; ++r) qq[r] += shx(qq[r], o, lane);
#pragma unroll
            for (int r = 0; r < R; ++r) { const float rs = __builtin_amdgcn_rsqf(qq[r] * (1.0f / D) + LN_EPS);
                if (MODE == 1) { if (lane == 0) stats1[row0 + r] = (pg8::f32x2_t){mur[r], rs};
                    if ((lane & 15) == ((ri + r) & 15)) { mu_t = mur[r]; rs_t = rs; } }
#pragma unroll
                for (int i = 0; i < 16; ++i) v[r][i] = v[r][i] * rs * gg[i] + bb[i]; }
#pragma unroll
            for (int r = 0; r < R; ++r) { const size_t row = row0 + r;
                if (MODE == 2 && last) {
#pragma unroll
                    for (int j = 0; j < 2; ++j) { float* op = a.out + row * D + 8 * lane + 512 * j;
                        *(f32x4*)op = (f32x4){v[r][8 * j], v[r][8 * j + 1], v[r][8 * j + 2], v[r][8 * j + 3]}; *(f32x4*)(op + 4) = (f32x4){v[r][8 * j + 4], v[r][8 * j + 5], v[r][8 * j + 6], v[r][8 * j + 7]}; }
                } else {
#pragma unroll
                    for (int j = 0; j < 2; ++j) { float f[8];
#pragma unroll
                        for (int i = 0; i < 8; ++i) f[i] = v[r][8 * j + i];
                        if (MODE != 1) *(u32x4*)(Xout + row * D + 8 * lane + 512 * j) = pack8(f);
                        if (MODE == 1 || MODE == 2) { u32x2 q8; q8.x = pg8::pk4f8(f[0] * pg8::F8_SX, f[1] * pg8::F8_SX, f[2] * pg8::F8_SX, f[3] * pg8::F8_SX); q8.y = pg8::pk4f8(f[4] * pg8::F8_SX, f[5] * pg8::F8_SX, f[6] * pg8::F8_SX, f[7] * pg8::F8_SX);
                            *(u32x2*)(ws + (MODE == 1 ? WS_R + R_X8 : WS_X8IN) + row * D + 8 * lane + 512 * j) = q8; } }
                } }
            if (MODE == 1 && ((ri + R) & 15) == 0) {
                const int tok = lane & 15, g = lane >> 4, tl = rl0 + R - 16 + tok; const size_t token = (size_t)blk * 256 + tl;
                const bf16_t* xr = Z + token * D + 8 * g;
                f32x4 acc = (f32x4){0.f, 0.f, 0.f, 0.f};
#pragma unroll 8
                for (int ks = 0; ks < 32; ++ks) { const bf16x8 xb = *(const bf16x8*)(xr + 32 * ks);
                    const bf16x8 wh = *(const LAS bf16x8*)(lds + RT_WH + (ks * 64 + lane) * 16), wl = *(const LAS bf16x8*)(lds + RT_WL + (ks * 64 + lane) * 16);
                    acc = __builtin_amdgcn_mfma_f32_16x16x32_bf16(wh, xb, acc, 0, 0, 0); acc = __builtin_amdgcn_mfma_f32_16x16x32_bf16(wl, xb, acc, 0, 0, 0); }
                const f32x4 csv = *(const LAS f32x4*)(lds + RT_CS + 16 * g), bbv = *(const LAS f32x4*)(lds + RT_BB + 16 * g);
                float lg[4] = {rs_t * (acc[0] - mu_t * csv[0]) + bbv[0], rs_t * (acc[1] - mu_t * csv[1]) + bbv[1], rs_t * (acc[2] - mu_t * csv[2]) + bbv[2], rs_t * (acc[3] - mu_t * csv[3]) + bbv[3]};
                float m = __builtin_fmaxf(__builtin_fmaxf(lg[0], lg[1]), __builtin_fmaxf(lg[2], lg[3]));
                m = __builtin_fmaxf(m, shx(m, 16, lane)); m = __builtin_fmaxf(m, shx(m, 32, lane));
                float t1 = -1.f, t2 = -1.f; int i1 = 0, i2 = 0;
#pragma unroll
                for (int r = 0; r < 4; ++r) { const float p = __expf(lg[r] - m); if (p > t1) { t2 = t1; i2 = i1; t1 = p; i1 = r; } else if (p > t2) { t2 = p; i2 = r; } }
                const float gs = t1 + t2; float bgs = gs; int bg = g;
                { const float o = shx(bgs, 16, lane); const int og = shxi(bg, 16, lane); if (o > bgs || (o == bgs && og < bg)) { bgs = o; bg = og; } }
                { const float o = shx(bgs, 32, lane); const int og = shxi(bg, 32, lane); if (o > bgs || (o == bgs && og < bg)) { bgs = o; bg = og; } }
                const bool mine = (bg == g); const int e0 = 4 * g + i1, e1 = 4 * g + i2;
                if (mine) { u32x4 info; info.x = (unsigned)e0; info.y = (unsigned)e1; info.z = __builtin_bit_cast(unsigned, t1 / gs); info.w = __builtin_bit_cast(unsigned, t2 / gs);
                    *(u32x4*)(ws + WS_TINFO + token * 16) = info; ((LAS unsigned short*)(lds + RT_SEL))[tl] = (unsigned short)(e0 | (e1 << 8)); }
                const unsigned long long below = (1ull << lane) - 1ull; int r0 = 0, r1 = 0;
#pragma unroll
                for (int e = 0; e < 16; ++e) { const bool hit = mine && (e0 == e || e1 == e); const unsigned long long mb = __ballot(hit); const int cb = __popcll(mb & below);
                    r0 = (e0 == e) ? run[e] + cb : r0; r1 = (e1 == e) ? run[e] + cb : r1; run[e] += __popcll(mb); }
                if (mine) { ((LAS unsigned short*)(lds + RT_RK))[2 * tl] = (unsigned short)r0; ((LAS unsigned short*)(lds + RT_RK))[2 * tl + 1] = (unsigned short)r1; }
            }
        }
        if (MODE == 1) {
            { int vsel = 0;
#pragma unroll
              for (int e = 0; e < 16; ++e) vsel = (lane == e) ? run[e] : vsel;
              if (lane < 16) ((LAS int*)(lds + RT_CNTW))[wave * 16 + lane] = vsel; }
            __syncthreads();
            if (tid < 16) { int base = 0;
#pragma unroll
                for (int w = 0; w < 8; ++w) { const int t = ((LAS int*)(lds + RT_CNTW))[w * 16 + tid]; ((LAS int*)(lds + RT_WBASE))[w * 16 + tid] = base; base += t; }
                ((int*)(ws + WS_WGCNT))[blk * 16 + tid] = base; }
            __syncthreads();
            { const int t = tid >> 1, k = tid & 1; const int e = (((LAS unsigned short*)(lds + RT_SEL))[t] >> (8 * k)) & 255;
              ((int*)(ws + WS_TRANK))[(size_t)blk * 512 + tid] = (int)((LAS unsigned short*)(lds + RT_RK))[tid] + ((LAS int*)(lds + RT_WBASE))[(t >> 5) * 16 + e]; }
            __syncthreads();
        }
    }
}

#undef LN_LOAD
constexpr int MG_TBL = 0, MG_TOT = 16384, MG_PRE = 16448, MG_BASE = 16512;
__device__ __forceinline__ void moe_gather_phase(LAS unsigned char* lds, unsigned char* ws, int bid, int G, int wave_s) {
    int tid_ = wave_s * 64 + pg8::lane_id(); asm volatile("" : "+v"(tid_)); const int tid = tid_, lane = tid & 63, wave = __builtin_amdgcn_readfirstlane(tid >> 6);
    LAS int* tbl = (LAS int*)(lds + MG_TBL); LAS int* tot = (LAS int*)(lds + MG_TOT); LAS int* pre = (LAS int*)(lds + MG_PRE); LAS int* base = (LAS int*)(lds + MG_BASE);
    LAS int* offs = (LAS int*)(lds + MISC_OFF) + 16; LAS int* tile_e = (LAS int*)(lds + TILEE_OFF);
    const bf16_t* X = (const bf16_t*)(ws + WS_X); bf16_t* Xs = (bf16_t*)(ws + WS_R + R_XS);
    for (int blk = bid; blk < 256; blk += G) {
        __syncthreads();
        for (int i = tid; i < 4096; i += NTHR) tbl[i] = ((const int*)(ws + WS_WGCNT))[i];
        __syncthreads();
        if (tid < 16) { int t = 0, p = 0; for (int c = 0; c < 256; ++c) { const int v = tbl[c * 16 + tid]; p += (c < blk) ? v : 0; t += v; } tot[tid] = t; pre[tid] = p; }
        __syncthreads();
        if (tid == 0) { int o = 0; for (int e = 0; e < 16; ++e) { offs[e] = o; base[e] = o + pre[e]; o += (tot[e] + 255) & ~255; } offs[16] = o; offs[17] = o >> 8; }
        __syncthreads();
        for (int rt = tid; rt < 528; rt += NTHR) { int e = 0;
#pragma unroll
            for (int q = 1; q < 16; ++q) e = (rt * 256 >= offs[q]) ? q : e;
            tile_e[rt] = e; }
        { const size_t tok = (size_t)blk * 256 + (tid >> 1); const int k = tid & 1;
          const int e = ((const int*)(ws + WS_TINFO))[tok * 4 + k]; const int rk = ((const int*)(ws + WS_TRANK))[tok * 2 + k];
          const int slot = base[e] + rk;
          ((int*)(ws + WS_TSLOT))[tok * 2 + k] = slot; ((int*)(ws + WS_SRCROW))[slot] = (int)tok; }
        for (int e = wave; e < 16; e += NWAVES) { const int npad = offs[e + 1] - offs[e] - tot[e];
            if (blk < npad && lane == 0) ((int*)(ws + WS_SRCROW))[offs[e] + tot[e] + blk] = 0; }
    }
}

#define GEMM_ALIGN true
#define GEMM_SP2 true
__global__ void __launch_bounds__(NTHR, 2) mk_fwd(Args args) {
    extern __shared__ __attribute__((aligned(16))) unsigned char lds_raw[];
    LAS unsigned char* lds = (LAS unsigned char*)lds_raw;
    const int tid = threadIdx.x; const int wave_s = __builtin_amdgcn_readfirstlane(tid >> 6);
    const int G = gridDim.x, bid = blockIdx.x;
    unsigned char* ws = args.ws;
    volatile LAS unsigned* MISC = (volatile LAS unsigned*)(lds + MISC_OFF);
    for (int u = tid; u < (LDS_BYTES - LDSCTL_OFF) / 4; u += NTHR) ((LAS unsigned*)(lds + LDSCTL_OFF))[u] = 0u;
    __syncthreads();
    XcdBarrier bar = xcd_barrier_post((unsigned*)(ws + WS_CTL) + CW_BAR, MISC + 8);
    bar.wv = wave_s;
#define GRID_BAR() xcd_barrier(bar)
#ifndef REP_MASK
#define REP_MASK 0
#endif
#define LOCAL_SYNC() do { asm volatile("s_waitcnt vmcnt(0)" ::: "memory"); __syncthreads(); } while (0)
#define PHASE(grp, ...) do { __VA_ARGS__; if (REP_MASK & (1 << (grp))) { GRID_BAR(); __VA_ARGS__; } } while (0)

#define WSQ ({ unsigned char* w_ = args.ws; asm volatile("" : "+s"(w_)); w_; })
#define X ((bf16_t*)(WSQ + WS_X))
#define P ((bf16_t*)(WSQ + WS_R + R_P))
#define Y ((bf16_t*)(WSQ + WS_R + R_Y))
#define Z ((bf16_t*)(WSQ + WS_R + R_Z))
#define Qb ((bf16_t*)(WSQ + WS_R + R_Q))
#define Ob ((bf16_t*)(WSQ + WS_R + R_O))
#define Xs ((bf16_t*)(WSQ + WS_R + R_XS))
#define Hb ((bf16_t*)(WSQ + WS_R + R_H))
#define KV ((bf16_t*)(WSQ + WS_KV))
#define wl (WSQ + WS_W + (size_t)l * W_LAYER)

    PHASE(0, p0_convert(args, lds, bid, G, wave_s));
    GRID_BAR();
    { const int tid_r = wave_s * 64 + pg8::lane_id();
      for (int i = bid * NTHR + tid_r; i < 2 * 2 * 1024; i += G * NTHR) { const int l = i >> 11, w = (i >> 10) & 1, n = i & 1023; const float* tb = (const float*)(WSQ + WS_CS) + (size_t)l * 2 * 16 * 1024 + w * 16 * 1024; float s = 0.f;
#pragma unroll
          for (int kc = 0; kc < 16; ++kc) s += tb[kc * 1024 + n];
          ((float*)(WSQ + WS_CS) + 65536)[i] = s; } }
    PHASE(1, { pg8::Gemm g{(const bf16_t*)(WSQ + WS_MEMB), (const bf16_t*)(WSQ + WS_WKV), MKV, 4096, D, wave_s}; pg8::StaticOrder S; S.init(MKV, 4096, G, bid);
      pg8::EpiPlain E{KV, 4096, 0xffff};
      pg8::gemm_phase<pg8::EpiPlain, pg8::StaticOrder, GEMM_ALIGN, GEMM_SP2>(lds, g, S, E); });

#pragma unroll 1
    for (int l = 0; l < 2; ++l) {
        PHASE(1, { pg8::Gemm g{(const bf16_t*)(WSQ + WS_X8IN), (const bf16_t*)(wl + W_IN), M, NP, D / 2, wave_s}; pg8::StaticOrder S; S.init(M, NP, G, bid);
          pg8::EpiInProj8 E{P, args.in[4] + l * 256};
          pg8::gemm_phase<pg8::EpiInProj8, pg8::StaticOrder, GEMM_ALIGN, GEMM_SP2>(lds, g, S, E); });
        GRID_BAR();
        PHASE(3, gla_phase<false>(lds, P, (float*)(WSQ + WS_SEND), (float*)(WSQ + WS_LTOT), Y, args.in[5] + l * 512, bid, G, wave_s));
        PHASE(4, sgu_phase(lds, P, (const bf16_t*)(WSQ + WS_WM) + (size_t)l * 4 * 128 * 128, args.in[7] + l * 512, args.in[8] + l * 512, args.in[9] + l * 512, Y, bid, G, wave_s));
        GRID_BAR();
        PHASE(3, gla_phase<true>(lds, P, (float*)(WSQ + WS_SEND), (float*)(WSQ + WS_LTOT), Y, args.in[5] + l * 512, bid, G, wave_s));
        GRID_BAR();
        PHASE(10, { pg8::Gemm g{Y, (const bf16_t*)(wl + W_OUT), M, D, D / 2, wave_s}; pg8::PanelOrder S{4, M / 256, G, bid};
          pg8::EpiResidStats8 E{X, Z, (pg8::f32x2_t*)(WSQ + WS_PART), WSQ + WS_R + R_X8};
          pg8::gemm_phase<pg8::EpiResidStats8, pg8::PanelOrder, GEMM_ALIGN, GEMM_SP2>(lds, g, S, E); });
        { const int tid_r = wave_s * 64 + pg8::lane_id();
          for (int pan = bid; pan < 256; pan += G) if (tid_r < 256) { const size_t row = (size_t)pan * 256 + tid_r; const pg8::f32x2_t* pp = (const pg8::f32x2_t*)(WSQ + WS_PART) + row * 16; float s1 = 0.f, s2 = 0.f;
#pragma unroll
              for (int q = 0; q < 16; ++q) { const pg8::f32x2_t v = pp[q]; s1 += v[0]; s2 += v[1]; }
              const float mu = s1 * (1.0f / D), var = s2 * (1.0f / D) - mu * mu; ((pg8::f32x2_t*)(WSQ + WS_STATS))[row] = (pg8::f32x2_t){mu, __builtin_amdgcn_rsqf(var + LN_EPS)}; } }
        LOCAL_SYNC();
        PHASE(10, { pg8::Gemm g{(const bf16_t*)(WSQ + WS_R + R_X8), (const bf16_t*)(wl + W_Q), M, D, D / 2, wave_s}; pg8::PanelOrder S{4, M / 256, G, bid};
          pg8::EpiQFragLN8 E{(unsigned char*)Qb, (const pg8::f32x2_t*)(WSQ + WS_STATS), (const float*)(WSQ + WS_CS) + 65536 + l * 2048, (const float*)(WSQ + WS_CS) + 65536 + l * 2048 + 1024};
          pg8::gemm_phase<pg8::EpiQFragLN8, pg8::PanelOrder, GEMM_ALIGN, GEMM_SP2>(lds, g, S, E); });
        PHASE(5, attn_phase(lds, Qb, KV, Ob, l, bid, G, wave_s));
        LOCAL_SYNC();
        PHASE(10, { pg8::Gemm g{Ob, (const bf16_t*)(wl + W_O), M, D, D / 2, wave_s}; pg8::PanelOrder S{4, M / 256, G, bid};
          pg8::EpiResidLN8 E{Z, (const pg8::f32x2_t*)(WSQ + WS_STATS), args.in[20] + (size_t)(l * 3) * D, args.in[21] + (size_t)(l * 3) * D};
          pg8::gemm_phase<pg8::EpiResidLN8, pg8::PanelOrder, GEMM_ALIGN, GEMM_SP2>(lds, g, S, E); });
        PHASE(9, ln_phase<1>(lds, args, l, 1, false, X, bid, G, wave_s));
        GRID_BAR();
        PHASE(7, moe_gather_phase(lds, WSQ, bid, G, wave_s));
        GRID_BAR();
        PHASE(2, { pg8::Gemm g{(const bf16_t*)(WSQ + WS_R + R_X8), (const bf16_t*)(wl + W_GU), MOE_ROWS, 16384, D / 2, wave_s}; pg8::MoeGatherOrder S{(const LAS int*)(lds + TILEE_OFF), (int)MISC[33] * 4, G, bid, (const int*)(WSQ + WS_SRCROW)};
          pg8::EpiGU8 E{(unsigned char*)Hb};
          pg8::gemm_phase<pg8::EpiGU8, pg8::MoeGatherOrder, GEMM_ALIGN, GEMM_SP2>(lds, g, S, E); });
        GRID_BAR();
        PHASE(2, { pg8::Gemm g{Hb, (const bf16_t*)(wl + W_D), MOE_ROWS, 16384, 256, wave_s}; pg8::MoeOrder S{(const LAS int*)(lds + TILEE_OFF), (int)MISC[33] * 4, G, bid};
          pg8::EpiPlain8 E{(unsigned char*)Xs, D, 3};
          pg8::gemm_phase<pg8::EpiPlain8, pg8::MoeOrder, GEMM_ALIGN, GEMM_SP2>(lds, g, S, E); });
        GRID_BAR();
        if (REP_MASK & (1 << 8)) { ln_phase<2>(lds, args, l, 2, l == 1, Z, bid, G, wave_s); GRID_BAR(); }
        ln_phase<2>(lds, args, l, 2, l == 1, X, bid, G, wave_s);
        if (l == 0) GRID_BAR();
    }
}
#undef X
#undef P
#undef Y
#undef Z
#undef Qb
#undef Ob
#undef Xs
#undef Hb
#undef KV
#undef wl
}

extern "C" void kernel_launch(void* const* d_in, const int* in_sizes, int n_in, void* d_out, int out_size, void* d_ws, size_t ws_size, hipStream_t stream) {
    using namespace mk;
    static int grid = 0;
    if (grid == 0) {
        if (n_in != 22 || in_sizes[0] != M * D || out_size != M * D || ws_size < WS_END) { fprintf(stderr, "kernel_launch: unexpected shapes (n_in %d, in0 %d, out %d, ws %zu, need %zu)\n", n_in, n_in > 0 ? in_sizes[0] : -1, out_size, ws_size, (size_t)WS_END); grid = -1; return; }
        int dev = 0, cus = 0;
        if (hipGetDevice(&dev) != hipSuccess || hipDeviceGetAttribute(&cus, hipDeviceAttributeMultiprocessorCount, dev) != hipSuccess) { grid = -1; return; }
        if (hipFuncSetAttribute((const void*)mk_fwd, hipFuncAttributeMaxDynamicSharedMemorySize, LDS_BYTES) != hipSuccess) { fprintf(stderr, "kernel_launch: hipFuncSetAttribute failed\n"); grid = -1; return; }
        int per_cu = 0;
        if (hipOccupancyMaxActiveBlocksPerMultiprocessor(&per_cu, (const void*)mk_fwd, NTHR, LDS_BYTES) != hipSuccess || per_cu < 1) fprintf(stderr, "kernel_launch: occupancy query says %d\n", per_cu);
        (void)hipGetLastError();
        grid = cus;
    }
    if (grid < 0) return;
    if (hipMemsetAsync((char*)d_ws + WS_CTL, 0, CTL_ZERO_BYTES, stream) != hipSuccess) return;
    Args a{};
    for (int i = 0; i < 22; ++i) a.in[i] = (const float*)d_in[i];
    a.out = (float*)d_out; a.ws = (unsigned char*)d_ws;
    hipLaunchKernelGGL(mk_fwd, dim3(grid), dim3(NTHR), LDS_BYTES, stream, a);
}
```

```cpp
#include <hip/hip_runtime.h>
#include <cstdio>
#include <cstdint>

namespace pg8 {
#define PG8_LAS __attribute__((address_space(3)))
typedef unsigned short bf16_t;
typedef short bf16x8 __attribute__((ext_vector_type(8)));
typedef float f32x4 __attribute__((ext_vector_type(4)));
typedef unsigned u32x4 __attribute__((ext_vector_type(4)));
typedef unsigned u32x2 __attribute__((ext_vector_type(2)));
constexpr int BM = 256, BK = 64, HALF = 128, HTB = HALF * BK * 2  , STAGE_BYTES = 8 * HTB, NXCD = 8, WGM = 8;

__host__ __device__ __forceinline__ int lds_byte(int r, int c) { const int st = (r >> 4) * 2 + (c >> 5), rr = r & 15, cc = c & 31, ob = rr * 64 + cc * 2; return st * 1024 + (ob ^ (((ob >> 9) & 1) << 5)); }
__host__ __device__ __forceinline__ void stage_rc(int b, int& R, int& C) { const int st = b / 1024, sb = b % 1024, swz = sb ^ (((sb >> 9) & 1) << 5); R = (st >> 1) * 16 + swz / 64; C = (st & 1) * 32 + (swz % 64) / 2; }
__host__ __device__ __forceinline__ int perm32(int rho) { const int n = rho >> 4, i = rho & 15; return 8 * (i >> 2) + 4 * n + (i & 3); }

struct Unit { int pm, pn; };
struct Gemm { const bf16_t* A; const bf16_t* Bt; int M, N, K; int wv; };
__device__ __forceinline__ int lane_id() { int l; asm volatile("v_mbcnt_lo_u32_b32 %0, -1, 0\n\tv_mbcnt_hi_u32_b32 %0, -1, %0" : "=v"(l)); return l; }

struct StaticOrder {
    static constexpr bool GATHER = false;
    int nM, nN, nwg, G, c; const int* src = nullptr;
    __host__ __device__ void init(int M, int N, int G_, int c_) { nM = M / BM; nN = N / BM; nwg = nM * nN; G = G_; c = c_; }
    __host__ __device__ bool next(int i, Unit& u) const {
        const long L = (long)i * G + c; if (L >= nwg) return false;
        int wgid = (int)L; { const int q = nwg / NXCD, r = nwg % NXCD, xcd = wgid % NXCD, off = wgid / NXCD; wgid = (xcd < r ? xcd * (q + 1) : r * (q + 1) + (xcd - r) * q) + off; }
        const int nig = WGM * nN, gid = wgid / nig, fm = gid * WGM, gsz = (nM - fm) < WGM ? (nM - fm) : WGM;
        u.pm = fm + ((wgid % nig) % gsz); u.pn = (wgid % nig) / gsz; return true;
    }
    __device__ __forceinline__ void a_ready(const Unit&) const {}
    __device__ __forceinline__ void done(const Unit&) const {}
};
struct PanelOrder {
    static constexpr bool GATHER = false;
    int nN, npan, G, c; const int* src = nullptr;
    __device__ __forceinline__ bool next(int i, Unit& u) const { const int p = c + (i / nN) * G; if (p >= npan) return false; u.pm = p; u.pn = i % nN; return true; }
    __device__ __forceinline__ void a_ready(const Unit&) const {}
    __device__ __forceinline__ void done(const Unit&) const {}
};
template <bool GATH_> struct MoeOrderT {
    static constexpr bool GATHER = GATH_;
    const PG8_LAS int* tile_e; int nunits, G, c; const int* src = nullptr;
    __device__ __forceinline__ bool next(int i, Unit& u) const {
        const int cc = ((G & 7) == 0) ? (c & 7) * (G >> 3) + (c >> 3) : c;
        const int L = i * G + cc; if (L >= nunits) return false;
        u.pm = L >> 2; u.pn = tile_e[L >> 2] * 4 + (L & 3); return true;
    }
    __device__ __forceinline__ void a_ready(const Unit&) const {}
    __device__ __forceinline__ void done(const Unit&) const {}
};
typedef MoeOrderT<false> MoeOrder; typedef MoeOrderT<true> MoeGatherOrder;

typedef float f32x2_t __attribute__((ext_vector_type(2))); typedef __bf16 bf16x2_t __attribute__((ext_vector_type(2)));
typedef __amdgpu_buffer_rsrc_t rsrc_t;
__device__ __forceinline__ rsrc_t mk_rsrc(const void* p) { return __builtin_amdgcn_make_buffer_rsrc((void*)p, 0, 0x7fffffff, 0x00020000); }
__device__ __forceinline__ u32x4 bld4(rsrc_t r, unsigned voff, unsigned soff) { return __builtin_bit_cast(u32x4, __builtin_amdgcn_raw_buffer_load_b128(r, voff, soff, 0)); }
__device__ __forceinline__ f32x2_t bld2f(rsrc_t r, unsigned voff, unsigned soff) { return __builtin_bit_cast(f32x2_t, __builtin_amdgcn_raw_buffer_load_b64(r, voff, soff, 0)); }
#define GST4(p) (*(__attribute__((address_space(1))) u32x4*)(p))
__device__ __forceinline__ float f8clamp(float x) { return __builtin_fminf(__builtin_fmaxf(x, -448.0f), 448.0f); }
__device__ __forceinline__ unsigned pk4f8(float a, float b, float c, float d) { int w = 0; w = __builtin_amdgcn_cvt_pk_fp8_f32(f8clamp(a), f8clamp(b), w, false); w = __builtin_amdgcn_cvt_pk_fp8_f32(f8clamp(c), f8clamp(d), w, true); return (unsigned)w; }
__device__ __forceinline__ float f8round(float x) { const int w = __builtin_amdgcn_cvt_pk_fp8_f32(f8clamp(x), 0.0f, 0, false); return __builtin_amdgcn_cvt_pk_f32_fp8(w, false)[0]; }
constexpr float F8_SX = 4.0f, F8_SW = 64.0f, F8_SH = 8.0f, F8_SO = 64.0f, F8_SY = 16.0f, F8_SQ = 64.0f, F8_SM = 4.0f, F8_SZ = 4.0f;
__device__ __forceinline__ unsigned pk2(float lo, float hi) { f32x2_t v = {lo, hi}; bf16x2_t b = __builtin_convertvector(v, bf16x2_t); return __builtin_bit_cast(unsigned, b); }
__device__ __forceinline__ float bflo(unsigned w) { return __builtin_bit_cast(float, w << 16); }
__device__ __forceinline__ float bfhi(unsigned w) { return __builtin_bit_cast(float, w & 0xffff0000u); }
__device__ __forceinline__ float f_silu(float x) { return x * __builtin_amdgcn_rcpf(1.0f + __builtin_amdgcn_exp2f(-1.4426950408889634f * x)); }
__device__ __forceinline__ float f_gelu_tanh(float x) { return x * __builtin_amdgcn_rcpf(1.0f + __builtin_amdgcn_exp2f(x * (-2.3022082f - 0.10294324f * x * x))); }
__device__ __forceinline__ float f_logsig16(float z) { const float t = __builtin_amdgcn_exp2f(-1.4426950408889634f * __builtin_fabsf(z)); return (__builtin_fminf(z, 0.0f) - 0.6931471805599453f * __builtin_amdgcn_logf(1.0f + t)) * 0.0625f; }

struct EpiPlain {
    static constexpr bool PERM = true, AFTER_DRAIN = false;
    bf16_t* O; int ldc; int cmask;
    __device__ __forceinline__ void operator()(const f32x4 (&acc)[2][2][4][2], const Unit& u, int wr, int wc, int fr, int fq) const {
        const int row0 = u.pm * BM + wr * 64 + fr, col0 = (u.pn & cmask) * BM + wc * 32 + 8 * fq;
#pragma unroll
        for (int ai = 0; ai < 2; ++ai)
#pragma unroll
            for (int m = 0; m < 4; ++m) { bf16_t* rowp = O + (size_t)(row0 + ai * HALF + m * 16) * ldc + col0;
#pragma unroll
                for (int bj = 0; bj < 2; ++bj) { const f32x4 v0 = acc[ai][bj][m][0], v1 = acc[ai][bj][m][1];
                    u32x4 w; w.x = pk2(v0[0], v0[1]); w.y = pk2(v0[2], v0[3]); w.z = pk2(v1[0], v1[1]); w.w = pk2(v1[2], v1[3]);
                    *(u32x4*)(rowp + bj * HALF) = w; } }
    }
};
struct EpiQFrag {
    static constexpr bool PERM = true, AFTER_DRAIN = false;
    bf16_t* O;
    __device__ __forceinline__ void operator()(const f32x4 (&acc)[2][2][4][2], const Unit& u, int wr, int wc, int fr, int fq) const {
        unsigned lo = (unsigned)(((fq >> 1) * 64 + fr + 32 * (fq & 1)) * 16); asm volatile("" : "+v"(lo));
        char* tile = (char*)(O + (size_t)(u.pm * 4 + u.pn) * 65536) + (size_t)(wr * 2 * 16 + wc * 2) * 1024 + lo;
#pragma unroll
        for (int ai = 0; ai < 2; ++ai)
#pragma unroll
            for (int m = 0; m < 4; ++m)
#pragma unroll
                for (int bj = 0; bj < 2; ++bj) { const f32x4 v0 = acc[ai][bj][m][0], v1 = acc[ai][bj][m][1];
                    u32x4 w; w.x = pk2(v0[0], v0[1]); w.y = pk2(v0[2], v0[3]); w.z = pk2(v1[0], v1[1]); w.w = pk2(v1[2], v1[3]);
                    *(u32x4*)(tile + ((4 * ai + (m >> 1)) * 16 + 8 * bj) * 1024 + (m & 1) * 256) = w; }
    }
};
struct EpiInProj {
    static constexpr bool PERM = true, AFTER_DRAIN = false;
    bf16_t* O; const float* b_a;
    template <int MODE> __device__ __forceinline__ void tile(const f32x4 (&acc)[2][2][4][2], const Unit& u, int wr, int wc, int fr, int fq) const {
        const int row0 = u.pm * BM + wr * 64 + fr, col0 = u.pn * BM + wc * 32 + 8 * fq;
        f32x4 bv[2][2];
#pragma unroll
        for (int bj = 0; bj < 2; ++bj)
#pragma unroll
            for (int n = 0; n < 2; ++n) bv[bj][n] = (MODE == 2) ? *(const f32x4*)(b_a + (col0 - 1536) + bj * HALF + 4 * n) : (f32x4){0.f, 0.f, 0.f, 0.f};
#pragma unroll
        for (int ai = 0; ai < 2; ++ai)
#pragma unroll
            for (int m = 0; m < 4; ++m) { bf16_t* rowp = O + (size_t)(row0 + ai * HALF + m * 16) * 2816 + col0;
#pragma unroll
                for (int bj = 0; bj < 2; ++bj) { f32x4 v0 = acc[ai][bj][m][0], v1 = acc[ai][bj][m][1];
#pragma unroll
                    for (int j = 0; j < 4; ++j) {
                        if (MODE == 1) { v0[j] = f_silu(v0[j]); v1[j] = f_silu(v1[j]); }
                        if (MODE == 2) { v0[j] = f_logsig16(v0[j] + bv[bj][0][j]); v1[j] = f_logsig16(v1[j] + bv[bj][1][j]); }
                        if (MODE == 3) { v0[j] = f_gelu_tanh(v0[j]); v1[j] = f_gelu_tanh(v1[j]); } }
                    u32x4 w; w.x = pk2(v0[0], v0[1]); w.y = pk2(v0[2], v0[3]); w.z = pk2(v1[0], v1[1]); w.w = pk2(v1[2], v1[3]);
                    *(u32x4*)(rowp + bj * HALF) = w; } }
    }
    __device__ __forceinline__ void operator()(const f32x4 (&acc)[2][2][4][2], const Unit& u, int wr, int wc, int fr, int fq) const {
        const int pn = u.pn;
        if (pn < 4) tile<0>(acc, u, wr, wc, fr, fq); else if (pn < 6) tile<1>(acc, u, wr, wc, fr, fq); else if (pn == 6) tile<2>(acc, u, wr, wc, fr, fq); else tile<3>(acc, u, wr, wc, fr, fq);
    }
};
struct EpiInProj8 {
    static constexpr bool PERM = true, AFTER_DRAIN = false, F8 = true; static constexpr float dq = 1.0f / (F8_SX * F8_SW);
    bf16_t* O; const float* b_a;
    template <int MODE> __device__ __forceinline__ void tile(const f32x4 (&acc)[2][2][4][2], const Unit& u, int wr, int wc, int fr, int fq) const {
        const int row0 = u.pm * BM + wr * 64 + fr, col0 = u.pn * BM + wc * 32 + 8 * fq;
        f32x4 bv[2][2];
#pragma unroll
        for (int bj = 0; bj < 2; ++bj)
#pragma unroll
            for (int n = 0; n < 2; ++n) bv[bj][n] = (MODE == 2) ? *(const f32x4*)(b_a + (col0 - 1536) + bj * HALF + 4 * n) : (f32x4){0.f, 0.f, 0.f, 0.f};
#pragma unroll
        for (int ai = 0; ai < 2; ++ai)
#pragma unroll
            for (int m = 0; m < 4; ++m) { bf16_t* rowp = O + (size_t)(row0 + ai * HALF + m * 16) * 2816 + col0;
#pragma unroll
                for (int bj = 0; bj < 2; ++bj) { f32x4 v0 = acc[ai][bj][m][0] * dq, v1 = acc[ai][bj][m][1] * dq;
#pragma unroll
                    for (int j = 0; j < 4; ++j) {
                        if (MODE == 1) { v0[j] = f_silu(v0[j]); v1[j] = f_silu(v1[j]); }
                        if (MODE == 2) { v0[j] = f_logsig16(v0[j] + bv[bj][0][j]); v1[j] = f_logsig16(v1[j] + bv[bj][1][j]); }
                        if (MODE == 3) { v0[j] = f_gelu_tanh(v0[j]); v1[j] = f_gelu_tanh(v1[j]); } }
                    u32x4 w; w.x = pk2(v0[0], v0[1]); w.y = pk2(v0[2], v0[3]); w.z = pk2(v1[0], v1[1]); w.w = pk2(v1[2], v1[3]);
                    *(u32x4*)(rowp + bj * HALF) = w; } }
    }
    __device__ __forceinline__ void operator()(const f32x4 (&acc)[2][2][4][2], const Unit& u, int wr, int wc, int fr, int fq) const {
        const int pn = u.pn;
        if (pn < 4) tile<0>(acc, u, wr, wc, fr, fq); else if (pn < 6) tile<1>(acc, u, wr, wc, fr, fq); else if (pn == 6) tile<2>(acc, u, wr, wc, fr, fq); else tile<3>(acc, u, wr, wc, fr, fq);
    }
};
struct EpiResid {
    static constexpr bool PERM = true, AFTER_DRAIN = false;
    const bf16_t* X; bf16_t* Z; float alpha;
    __device__ __forceinline__ void operator()(const f32x4 (&acc)[2][2][4][2], const Unit& u, int wr, int wc, int fr, int fq) const {
        const int row0 = u.pm * BM + wr * 64 + fr, col0 = u.pn * BM + wc * 32 + 8 * fq;
#pragma unroll
        for (int ai = 0; ai < 2; ++ai)
#pragma unroll
            for (int m = 0; m < 4; ++m) { const size_t off = (size_t)(row0 + ai * HALF + m * 16) * 1024 + col0;
#pragma unroll
                for (int bj = 0; bj < 2; ++bj) { const f32x4 v0 = acc[ai][bj][m][0], v1 = acc[ai][bj][m][1];
                    const u32x4 xr = *(const u32x4*)(X + off + bj * HALF);
                    u32x4 w; w.x = pk2(alpha * bflo(xr.x) + v0[0], alpha * bfhi(xr.x) + v0[1]); w.y = pk2(alpha * bflo(xr.y) + v0[2], alpha * bfhi(xr.y) + v0[3]);
                    w.z = pk2(alpha * bflo(xr.z) + v1[0], alpha * bfhi(xr.z) + v1[1]); w.w = pk2(alpha * bflo(xr.w) + v1[2], alpha * bfhi(xr.w) + v1[3]);
                    *(u32x4*)(Z + off + bj * HALF) = w; } }
    }
};
struct EpiResidStats {
    static constexpr bool PERM = true, AFTER_DRAIN = false;
    const bf16_t* X; bf16_t* Z; f32x2_t* part; static constexpr float alpha = 1.4142135623730951f;
    __device__ __forceinline__ void operator()(const f32x4 (&acc)[2][2][4][2], const Unit& u, int wr, int wc, int fr, int fq) const {
        const int row0 = u.pm * BM + wr * 64 + fr, col0 = u.pn * BM + wc * 32 + 8 * fq;
        int ln = 16 * fq + fr; asm volatile("" : "+v"(ln));
        float s1[8], s2[8];
        const rsrc_t rx = mk_rsrc(X); const unsigned voff = ((unsigned)row0 * 1024u + (unsigned)col0) * 2u;
        u32x4 xres[2][4][2];
#pragma unroll
        for (int ai = 0; ai < 2; ++ai)
#pragma unroll
            for (int m = 0; m < 4; ++m)
#pragma unroll
                for (int bj = 0; bj < 2; ++bj) xres[ai][m][bj] = bld4(rx, voff, (unsigned)(((ai * HALF + m * 16) * 1024 + bj * HALF) * 2));
        __builtin_amdgcn_sched_barrier(0);
#pragma unroll
        for (int ai = 0; ai < 2; ++ai)
#pragma unroll
            for (int m = 0; m < 4; ++m) { const size_t off = (size_t)(row0 + ai * HALF + m * 16) * 1024 + col0; float a1 = 0.f, a2 = 0.f;
#pragma unroll
                for (int bj = 0; bj < 2; ++bj) { const f32x4 v0 = acc[ai][bj][m][0], v1 = acc[ai][bj][m][1];
                    const u32x4 xr = xres[ai][m][bj];
                    u32x4 w; w.x = pk2(alpha * bflo(xr.x) + v0[0], alpha * bfhi(xr.x) + v0[1]); w.y = pk2(alpha * bflo(xr.y) + v0[2], alpha * bfhi(xr.y) + v0[3]);
                    w.z = pk2(alpha * bflo(xr.z) + v1[0], alpha * bfhi(xr.z) + v1[1]); w.w = pk2(alpha * bflo(xr.w) + v1[2], alpha * bfhi(xr.w) + v1[3]);
                    GST4(Z + off + bj * HALF) = w;
                    const float z0 = bflo(w.x), z1 = bfhi(w.x), z2 = bflo(w.y), z3 = bfhi(w.y), z4 = bflo(w.z), z5 = bfhi(w.z), z6 = bflo(w.w), z7 = bfhi(w.w);
                    a1 += ((z0 + z1) + (z2 + z3)) + ((z4 + z5) + (z6 + z7)); a2 += ((z0 * z0 + z1 * z1) + (z2 * z2 + z3 * z3)) + ((z4 * z4 + z5 * z5) + (z6 * z6 + z7 * z7)); }
                s1[ai * 4 + m] = a1; s2[ai * 4 + m] = a2; }
        const bool h5 = (ln & 32) != 0, h4 = (ln & 16) != 0;
        float t1[4], t2[4];
#pragma unroll
        for (int i = 0; i < 4; ++i) { const float m1 = h5 ? s1[4 + i] : s1[i], g1 = h5 ? s1[i] : s1[4 + i], m2 = h5 ? s2[4 + i] : s2[i], g2 = h5 ? s2[i] : s2[4 + i];
            t1[i] = m1 + __builtin_bit_cast(float, __builtin_amdgcn_ds_bpermute((ln ^ 32) << 2, __builtin_bit_cast(int, g1)));
            t2[i] = m2 + __builtin_bit_cast(float, __builtin_amdgcn_ds_bpermute((ln ^ 32) << 2, __builtin_bit_cast(int, g2))); }
        float r1[2], r2[2];
#pragma unroll
        for (int i = 0; i < 2; ++i) { const float m1 = h4 ? t1[2 + i] : t1[i], g1 = h4 ? t1[i] : t1[2 + i], m2 = h4 ? t2[2 + i] : t2[i], g2 = h4 ? t2[i] : t2[2 + i];
            r1[i] = m1 + __builtin_bit_cast(float, __builtin_amdgcn_ds_bpermute((ln ^ 16) << 2, __builtin_bit_cast(int, g1)));
            r2[i] = m2 + __builtin_bit_cast(float, __builtin_amdgcn_ds_bpermute((ln ^ 16) << 2, __builtin_bit_cast(int, g2))); }
#pragma unroll
        for (int i = 0; i < 2; ++i) { const int gi = (h5 ? 4 : 0) + (h4 ? 2 : 0) + i, row = row0 + (gi >> 2) * HALF + (gi & 3) * 16;
            part[(size_t)row * 16 + u.pn * 4 + wc] = (f32x2_t){r1[i], r2[i]}; }
    }
};
struct EpiResidStats8 {
    static constexpr bool PERM = true, AFTER_DRAIN = false, F8 = true; static constexpr float dq = 1.0f / (F8_SM * F8_SW);
    const bf16_t* X; bf16_t* Z; f32x2_t* part; unsigned char* Z8; static constexpr float alpha = 1.4142135623730951f;
    __device__ __forceinline__ void operator()(const f32x4 (&acc)[2][2][4][2], const Unit& u, int wr, int wc, int fr, int fq) const {
        const int row0 = u.pm * BM + wr * 64 + fr, col0 = u.pn * BM + wc * 32 + 8 * fq;
        int ln = 16 * fq + fr; asm volatile("" : "+v"(ln));
        float s1[8], s2[8];
        const rsrc_t rx = mk_rsrc(X); const unsigned voff = ((unsigned)row0 * 1024u + (unsigned)col0) * 2u;
#pragma unroll
        for (int ai = 0; ai < 2; ++ai) {
            u32x4 xres[4][2];
#pragma unroll
            for (int m = 0; m < 4; ++m)
#pragma unroll
                for (int bj = 0; bj < 2; ++bj) xres[m][bj] = bld4(rx, voff, (unsigned)(((ai * HALF + m * 16) * 1024 + bj * HALF) * 2));
            __builtin_amdgcn_sched_barrier(0);
#pragma unroll
            for (int m = 0; m < 4; ++m) { const size_t off = (size_t)(row0 + ai * HALF + m * 16) * 1024 + col0; float a1 = 0.f, a2 = 0.f;
#pragma unroll
                for (int bj = 0; bj < 2; ++bj) { const f32x4 v0 = acc[ai][bj][m][0] * dq, v1 = acc[ai][bj][m][1] * dq;
                    const u32x4 xr = xres[m][bj];
                    u32x4 w; w.x = pk2(alpha * bflo(xr.x) + v0[0], alpha * bfhi(xr.x) + v0[1]); w.y = pk2(alpha * bflo(xr.y) + v0[2], alpha * bfhi(xr.y) + v0[3]);
                    w.z = pk2(alpha * bflo(xr.z) + v1[0], alpha * bfhi(xr.z) + v1[1]); w.w = pk2(alpha * bflo(xr.w) + v1[2], alpha * bfhi(xr.w) + v1[3]);
                    GST4(Z + off + bj * HALF) = w;
                    { u32x2 w8; w8.x = pk4f8(bflo(w.x) * F8_SZ, bfhi(w.x) * F8_SZ, bflo(w.y) * F8_SZ, bfhi(w.y) * F8_SZ); w8.y = pk4f8(bflo(w.z) * F8_SZ, bfhi(w.z) * F8_SZ, bflo(w.w) * F8_SZ, bfhi(w.w) * F8_SZ);
                      *(__attribute__((address_space(1))) u32x2*)(Z8 + off + bj * HALF) = w8; }
                    const float z0 = bflo(w.x), z1 = bfhi(w.x), z2 = bflo(w.y), z3 = bfhi(w.y), z4 = bflo(w.z), z5 = bfhi(w.z), z6 = bflo(w.w), z7 = bfhi(w.w);
                    a1 += ((z0 + z1) + (z2 + z3)) + ((z4 + z5) + (z6 + z7)); a2 += ((z0 * z0 + z1 * z1) + (z2 * z2 + z3 * z3)) + ((z4 * z4 + z5 * z5) + (z6 * z6 + z7 * z7)); }
                s1[ai * 4 + m] = a1; s2[ai * 4 + m] = a2; } }
        const bool h5 = (ln & 32) != 0, h4 = (ln & 16) != 0;
        float t1[4], t2[4];
#pragma unroll
        for (int i = 0; i < 4; ++i) { const float m1 = h5 ? s1[4 + i] : s1[i], g1 = h5 ? s1[i] : s1[4 + i], m2 = h5 ? s2[4 + i] : s2[i], g2 = h5 ? s2[i] : s2[4 + i];
            t1[i] = m1 + __builtin_bit_cast(float, __builtin_amdgcn_ds_bpermute((ln ^ 32) << 2, __builtin_bit_cast(int, g1)));
            t2[i] = m2 + __builtin_bit_cast(float, __builtin_amdgcn_ds_bpermute((ln ^ 32) << 2, __builtin_bit_cast(int, g2))); }
        float r1[2], r2[2];
#pragma unroll
        for (int i = 0; i < 2; ++i) { const float m1 = h4 ? t1[2 + i] : t1[i], g1 = h4 ? t1[i] : t1[2 + i], m2 = h4 ? t2[2 + i] : t2[i], g2 = h4 ? t2[i] : t2[2 + i];
            r1[i] = m1 + __builtin_bit_cast(float, __builtin_amdgcn_ds_bpermute((ln ^ 16) << 2, __builtin_bit_cast(int, g1)));
            r2[i] = m2 + __builtin_bit_cast(float, __builtin_amdgcn_ds_bpermute((ln ^ 16) << 2, __builtin_bit_cast(int, g2))); }
#pragma unroll
        for (int i = 0; i < 2; ++i) { const int gi = (h5 ? 4 : 0) + (h4 ? 2 : 0) + i, row = row0 + (gi >> 2) * HALF + (gi & 3) * 16;
            part[(size_t)row * 16 + u.pn * 4 + wc] = (f32x2_t){r1[i], r2[i]}; }
    }
};
struct EpiQFragLN {
    static constexpr bool PERM = true, AFTER_DRAIN = false;
    unsigned char* O; const f32x2_t* stats; const float* csum; const float* bq;
    __device__ __forceinline__ void operator()(const f32x4 (&acc)[2][2][4][2], const Unit& u, int wr, int wc, int fr, int fq) const {
        unsigned lo = (unsigned)(((fq >> 1) * 64 + fr + 32 * (fq & 1)) * 16); asm volatile("" : "+v"(lo));
        unsigned char* tile = O + (size_t)(u.pm * 4 + u.pn) * 65536 + (size_t)(wr * 2 * 8 + wc * 2) * 1024 + lo;
        const int row0 = u.pm * BM + wr * 64 + fr, col0 = u.pn * BM + wc * 32 + 8 * fq;
        f32x4 cc[2][2], bb[2][2];
#pragma unroll
        for (int bj = 0; bj < 2; ++bj)
#pragma unroll
            for (int n = 0; n < 2; ++n) { cc[bj][n] = *(const f32x4*)(csum + col0 + bj * HALF + 4 * n); bb[bj][n] = *(const f32x4*)(bq + col0 + bj * HALF + 4 * n); }
#pragma unroll
        for (int ai = 0; ai < 2; ++ai)
#pragma unroll
            for (int m = 0; m < 4; ++m) { const f32x2_t st = stats[row0 + ai * HALF + m * 16]; const float mu = st[0], rs = st[1] * F8_SQ; u32x4 w;
#pragma unroll
                for (int bj = 0; bj < 2; ++bj) { const f32x4 v0 = (acc[ai][bj][m][0] - mu * cc[bj][0]) * rs + bb[bj][0] * F8_SQ, v1 = (acc[ai][bj][m][1] - mu * cc[bj][1]) * rs + bb[bj][1] * F8_SQ;
                    const unsigned lo4 = pk4f8(v0[0], v0[1], v0[2], v0[3]), hi4 = pk4f8(v1[0], v1[1], v1[2], v1[3]);
                    if (bj == 0) { w.x = lo4; w.y = hi4; } else { w.z = lo4; w.w = hi4; } }
                *(u32x4*)(tile + (4 * ai + (m >> 1)) * 8192 + (m & 1) * 256) = w; }
    }
};
struct EpiQFragLN8 {
    static constexpr bool PERM = true, AFTER_DRAIN = false, F8 = true; static constexpr float dq = 1.0f / (F8_SZ * F8_SW);
    unsigned char* O; const f32x2_t* stats; const float* csum; const float* bq;
    __device__ __forceinline__ void operator()(const f32x4 (&acc)[2][2][4][2], const Unit& u, int wr, int wc, int fr, int fq) const {
        unsigned lo = (unsigned)(((fq >> 1) * 64 + fr + 32 * (fq & 1)) * 16); asm volatile("" : "+v"(lo));
        unsigned char* tile = O + (size_t)(u.pm * 4 + u.pn) * 65536 + (size_t)(wr * 2 * 8 + wc * 2) * 1024 + lo;
        const int row0 = u.pm * BM + wr * 64 + fr, col0 = u.pn * BM + wc * 32 + 8 * fq;
        f32x4 cc[2][2], bb[2][2];
#pragma unroll
        for (int bj = 0; bj < 2; ++bj)
#pragma unroll
            for (int n = 0; n < 2; ++n) { cc[bj][n] = *(const f32x4*)(csum + col0 + bj * HALF + 4 * n); bb[bj][n] = *(const f32x4*)(bq + col0 + bj * HALF + 4 * n); }
#pragma unroll
        for (int ai = 0; ai < 2; ++ai)
#pragma unroll
            for (int m = 0; m < 4; ++m) { const f32x2_t st = stats[row0 + ai * HALF + m * 16]; const float mu = st[0], rs = st[1] * F8_SQ; u32x4 w;
#pragma unroll
                for (int bj = 0; bj < 2; ++bj) { const f32x4 v0 = (acc[ai][bj][m][0] * dq - mu * cc[bj][0]) * rs + bb[bj][0] * F8_SQ, v1 = (acc[ai][bj][m][1] * dq - mu * cc[bj][1]) * rs + bb[bj][1] * F8_SQ;
                    const unsigned lo4 = pk4f8(v0[0], v0[1], v0[2], v0[3]), hi4 = pk4f8(v1[0], v1[1], v1[2], v1[3]);
                    if (bj == 0) { w.x = lo4; w.y = hi4; } else { w.z = lo4; w.w = hi4; } }
                *(u32x4*)(tile + (4 * ai + (m >> 1)) * 8192 + (m & 1) * 256) = w; }
    }
};
struct EpiResidLN {
    static constexpr bool PERM = true, AFTER_DRAIN = false;
    bf16_t* Z; const f32x2_t* stats; const float* gain; const float* bias; static constexpr float alpha = 1.4142135623730951f;
    __device__ __forceinline__ void operator()(const f32x4 (&acc)[2][2][4][2], const Unit& u, int wr, int wc, int fr, int fq) const {
        const int row0 = u.pm * BM + wr * 64 + fr, col0 = u.pn * BM + wc * 32 + 8 * fq;
        const rsrc_t rz = mk_rsrc(Z), rs = mk_rsrc(stats); const unsigned voff = ((unsigned)row0 * 1024u + (unsigned)col0) * 2u;
        f32x2_t st[2][4];
#pragma unroll
        for (int ai = 0; ai < 2; ++ai)
#pragma unroll
            for (int m = 0; m < 4; ++m) st[ai][m] = bld2f(rs, (unsigned)row0 * 8u, (unsigned)((ai * HALF + m * 16) * 8));
#pragma unroll
        for (int bj = 0; bj < 2; ++bj) {
            u32x4 zres[2][4];
#pragma unroll
            for (int ai = 0; ai < 2; ++ai)
#pragma unroll
                for (int m = 0; m < 4; ++m) zres[ai][m] = bld4(rz, voff, (unsigned)(((ai * HALF + m * 16) * 1024 + bj * HALF) * 2));
            const f32x4 g0 = *(const f32x4*)(gain + col0 + bj * HALF) * alpha, g1 = *(const f32x4*)(gain + col0 + bj * HALF + 4) * alpha, b0 = *(const f32x4*)(bias + col0 + bj * HALF) * alpha, b1 = *(const f32x4*)(bias + col0 + bj * HALF + 4) * alpha;
            __builtin_amdgcn_sched_barrier(0);
#pragma unroll
            for (int ai = 0; ai < 2; ++ai)
#pragma unroll
                for (int m = 0; m < 4; ++m) { const int row = row0 + ai * HALF + m * 16; const float mu = st[ai][m][0], rsd = st[ai][m][1];
                    const u32x4 zr = zres[ai][m];
                    const f32x4 z0 = (f32x4){bflo(zr.x), bfhi(zr.x), bflo(zr.y), bfhi(zr.y)}, z1 = (f32x4){bflo(zr.z), bfhi(zr.z), bflo(zr.w), bfhi(zr.w)};
                    const f32x4 v0 = (z0 - mu) * rsd * g0 + b0 + acc[ai][bj][m][0], v1 = (z1 - mu) * rsd * g1 + b1 + acc[ai][bj][m][1];
                    u32x4 w; w.x = pk2(v0[0], v0[1]); w.y = pk2(v0[2], v0[3]); w.z = pk2(v1[0], v1[1]); w.w = pk2(v1[2], v1[3]);
                    GST4(Z + (size_t)row * 1024 + col0 + bj * HALF) = w; } }
    }
};
struct EpiResidLN8 {
    static constexpr bool PERM = true, AFTER_DRAIN = false, F8 = true; static constexpr float dq = 1.0f / (F8_SO * F8_SW);
    bf16_t* Z; const f32x2_t* stats; const float* gain; const float* bias; static constexpr float alpha = 1.4142135623730951f;
    __device__ __forceinline__ void operator()(const f32x4 (&acc)[2][2][4][2], const Unit& u, int wr, int wc, int fr, int fq) const {
        const int row0 = u.pm * BM + wr * 64 + fr, col0 = u.pn * BM + wc * 32 + 8 * fq;
        const rsrc_t rz = mk_rsrc(Z), rs = mk_rsrc(stats); const unsigned voff = ((unsigned)row0 * 1024u + (unsigned)col0) * 2u;
        f32x2_t st[2][4];
#pragma unroll
        for (int ai = 0; ai < 2; ++ai)
#pragma unroll
            for (int m = 0; m < 4; ++m) st[ai][m] = bld2f(rs, (unsigned)row0 * 8u, (unsigned)((ai * HALF + m * 16) * 8));
#pragma unroll
        for (int bj = 0; bj < 2; ++bj) {
            u32x4 zres[2][4];
#pragma unroll
            for (int ai = 0; ai < 2; ++ai)
#pragma unroll
                for (int m = 0; m < 4; ++m) zres[ai][m] = bld4(rz, voff, (unsigned)(((ai * HALF + m * 16) * 1024 + bj * HALF) * 2));
            const f32x4 g0 = *(const f32x4*)(gain + col0 + bj * HALF) * alpha, g1 = *(const f32x4*)(gain + col0 + bj * HALF + 4) * alpha, b0 = *(const f32x4*)(bias + col0 + bj * HALF) * alpha, b1 = *(const f32x4*)(bias + col0 + bj * HALF + 4) * alpha;
            __builtin_amdgcn_sched_barrier(0);
#pragma unroll
            for (int ai = 0; ai < 2; ++ai)
#pragma unroll
                for (int m = 0; m < 4; ++m) { const int row = row0 + ai * HALF + m * 16; const float mu = st[ai][m][0], rsd = st[ai][m][1];
                    const u32x4 zr = zres[ai][m];
                    const f32x4 z0 = (f32x4){bflo(zr.x), bfhi(zr.x), bflo(zr.y), bfhi(zr.y)}, z1 = (f32x4){bflo(zr.z), bfhi(zr.z), bflo(zr.w), bfhi(zr.w)};
                    const f32x4 v0 = (z0 - mu) * rsd * g0 + b0 + acc[ai][bj][m][0] * dq, v1 = (z1 - mu) * rsd * g1 + b1 + acc[ai][bj][m][1] * dq;
                    u32x4 w; w.x = pk2(v0[0], v0[1]); w.y = pk2(v0[2], v0[3]); w.z = pk2(v1[0], v1[1]); w.w = pk2(v1[2], v1[3]);
                    GST4(Z + (size_t)row * 1024 + col0 + bj * HALF) = w; } }
    }
};
struct EpiGU {
    static constexpr bool PERM = true, AFTER_DRAIN = false;
    bf16_t* H;
    __device__ __forceinline__ void operator()(const f32x4 (&acc)[2][2][4][2], const Unit& u, int wr, int wc, int fr, int fq) const {
        const int row0 = u.pm * BM + wr * 64 + fr, col0 = (u.pn & 3) * 128 + wc * 16 + 4 * fq;
#pragma unroll
        for (int ai = 0; ai < 2; ++ai)
#pragma unroll
            for (int m = 0; m < 4; ++m) { bf16_t* rowp = H + (size_t)(row0 + ai * HALF + m * 16) * 512 + col0;
#pragma unroll
                for (int bj = 0; bj < 2; ++bj) { const f32x4 g = acc[ai][bj][m][0], up = acc[ai][bj][m][1];
                    u32x2 w; w.x = pk2(f_silu(g[0]) * up[0], f_silu(g[1]) * up[1]); w.y = pk2(f_silu(g[2]) * up[2], f_silu(g[3]) * up[3]);
                    *(u32x2*)(rowp + bj * 64) = w; } }
    }
};
struct EpiGU8 {
    static constexpr bool PERM = true, AFTER_DRAIN = false, F8 = true;
    unsigned char* H;
    __device__ __forceinline__ void operator()(const f32x4 (&acc)[2][2][4][2], const Unit& u, int wr, int wc, int fr, int fq) const {
        const int row0 = u.pm * BM + wr * 64 + fr, col0 = (u.pn & 3) * 128 + wc * 32 + 8 * fq;
        constexpr float dq = 1.0f / (F8_SX * F8_SW);
#pragma unroll
        for (int ai = 0; ai < 2; ++ai)
#pragma unroll
            for (int m = 0; m < 4; ++m) { float h[8];
#pragma unroll
                for (int n = 0; n < 2; ++n) { const f32x4 g = acc[ai][0][m][n] * dq, up = acc[ai][1][m][n] * (dq * F8_SH);
#pragma unroll
                    for (int i = 0; i < 4; ++i) h[4 * n + i] = f_silu(g[i]) * up[i]; }
                u32x2 w; w.x = pk4f8(h[0], h[1], h[2], h[3]); w.y = pk4f8(h[4], h[5], h[6], h[7]);
                *(u32x2*)(H + (size_t)(row0 + ai * HALF + m * 16) * 512 + col0) = w; }
    }
};
struct EpiPlain8 {
    static constexpr bool PERM = true, AFTER_DRAIN = false, F8 = true;
    unsigned char* O; int ldc; int cmask;
    __device__ __forceinline__ void operator()(const f32x4 (&acc)[2][2][4][2], const Unit& u, int wr, int wc, int fr, int fq) const {
        const int row0 = u.pm * BM + wr * 64 + fr, col0 = (u.pn & cmask) * BM + wc * 32 + 8 * fq;
        constexpr float dq = F8_SY / (F8_SH * F8_SW);
#pragma unroll
        for (int ai = 0; ai < 2; ++ai)
#pragma unroll
            for (int m = 0; m < 4; ++m) { unsigned char* rowp = O + (size_t)(row0 + ai * HALF + m * 16) * ldc + col0;
#pragma unroll
                for (int bj = 0; bj < 2; ++bj) { const f32x4 v0 = acc[ai][bj][m][0] * dq, v1 = acc[ai][bj][m][1] * dq;
                    u32x2 w; w.x = pk4f8(v0[0], v0[1], v0[2], v0[3]); w.y = pk4f8(v1[0], v1[1], v1[2], v1[3]);
                    *(u32x2*)(rowp + bj * HALF) = w; } }
    }
};

typedef int i32x4_t __attribute__((ext_vector_type(4)));
template <class T, class = void> struct epi_f8 { static constexpr bool value = false; };
template <class T> struct epi_f8<T, decltype((void)T::F8)> { static constexpr bool value = true; };
template <class Epi, class Sched, bool ALIGN_EPI = false, bool SP2 = false>
__device__ __forceinline__ void gemm_phase(PG8_LAS unsigned char* lds, const Gemm g, const Sched& S, const Epi& E) {
    int tid_ = g.wv * 64 + lane_id(); asm volatile("" : "+v"(tid_));
    const int tid = tid_, wid = __builtin_amdgcn_readfirstlane(tid >> 6), lane = tid & 63, wr = wid >> 2, wc = wid & 3, fr = lane & 15, fq = lane >> 4;
    const int K = g.K, nt = K / BK; constexpr bool F8 = epi_f8<Epi>::value;
    unsigned voffA[2], voffB[2];
#pragma unroll
    for (int i = 0; i < 2; ++i) { int R, C; stage_rc(tid * 16 + i * 8192, R, C); const int Rb = Epi::PERM ? ((R & ~31) + perm32(R & 31)) : R;
        voffA[i] = (unsigned)(R * K + C) * 2u;
        voffB[i] = (unsigned)(((Rb >> 4) * (K >> 5) + (C >> 5)) * 1024 + (Rb & 15) * 64 + (C & 31) * 2); }
    constexpr bool GATH = Sched::GATHER; static_assert(!GATH || SP2, "gather mode is written for the SP2 loop");
    unsigned goc[2][2] = {{0u, 0u}, {0u, 0u}}, gon[2][2] = {{0u, 0u}, {0u, 0u}}, go2[2][2] = {{0u, 0u}, {0u, 0u}};
#define PG8_GOFF(dst, U) do { int tg_ = tid; asm volatile("" : "+v"(tg_)); _Pragma("unroll") for (int i_ = 0; i_ < 2; ++i_) { int R_, C_; stage_rc(tg_ * 16 + i_ * 8192, R_, C_); \
        _Pragma("unroll") for (int h_ = 0; h_ < 2; ++h_) dst[h_][i_] = (unsigned)S.src[(U).pm * BM + h_ * HALF + R_] * (unsigned)(K * 2) + (unsigned)C_ * 2u; } } while (0)
    const size_t kstep = (size_t)(BK * 2);
    const size_t kstepB = 2048;
    const size_t hstep = (size_t)HALF * K * 2;
    const size_t tstep = 2 * hstep;
    const unsigned ldsw = (unsigned)wid * 1024u;
    const int aoff = lds_byte(wr * 64 + fr, fq * 8), boff = lds_byte(wc * 32 + fr, fq * 8);
#define PG8_SA(b, h) (((b) * 2 + (h)) * HTB)
#define PG8_SB(b, h) ((4 + (b) * 2 + (h)) * HTB)
#define PG8_STAGE(bufoff, gbase, voff) do { _Pragma("unroll") for (int _i = 0; _i < 2; ++_i) \
        __builtin_amdgcn_global_load_lds((const unsigned*)((const char*)(gbase) + (voff)[_i]), (PG8_LAS unsigned*)(lds + (bufoff) + ldsw + _i * 8192), 16, 0, 0); } while (0)
#define PG8_STAGE_A(b, h, PTR, KPTR, GO) do { if constexpr (GATH) { PG8_STAGE(PG8_SA(b, h), KPTR, GO); } else { PG8_STAGE(PG8_SA(b, h), PTR, voffA); } } while (0)
#define PG8_LDA(dst, b, h) do { _Pragma("unroll") for (int m = 0; m < 4; ++m) _Pragma("unroll") for (int k = 0; k < 2; ++k) dst[m][k] = *(const PG8_LAS bf16x8*)(lds + PG8_SA(b, h) + aoff + m * 2048 + k * 1024); } while (0)
#define PG8_LDB(dst, b, h) do { _Pragma("unroll") for (int n = 0; n < 2; ++n) _Pragma("unroll") for (int k = 0; k < 2; ++k) dst[n][k] = *(const PG8_LAS bf16x8*)(lds + PG8_SB(b, h) + boff + n * 2048 + k * 1024); } while (0)
#define PG8_CAT8(x, y) __builtin_shufflevector(__builtin_bit_cast(i32x4_t, x), __builtin_bit_cast(i32x4_t, y), 0, 1, 2, 3, 4, 5, 6, 7)
#define PG8_MMA(ai, bj, At, Bt) do { __builtin_amdgcn_s_setprio(1); \
        if constexpr (F8) { _Pragma("unroll") for (int m = 0; m < 4; ++m) _Pragma("unroll") for (int n = 0; n < 2; ++n) \
            asm volatile("v_mfma_f32_16x16x128_f8f6f4 %0, %1, %2, %0" : "+v"(acc[ai][bj][m][n]) : "v"(PG8_CAT8(Bt[n][0], Bt[n][1])), "v"(PG8_CAT8(At[m][0], At[m][1]))); } \
        else { _Pragma("unroll") for (int m = 0; m < 4; ++m) _Pragma("unroll") for (int n = 0; n < 2; ++n) _Pragma("unroll") for (int k = 0; k < 2; ++k) \
            acc[ai][bj][m][n] = __builtin_amdgcn_mfma_f32_16x16x32_bf16(Bt[n][k], At[m][k], acc[ai][bj][m][n], 0, 0, 0); } \
        __builtin_amdgcn_s_setprio(0); } while (0)
#define PG8_WAIT_V(n) asm volatile("s_waitcnt vmcnt(" #n ")" ::: "memory")
#define PG8_WAIT_L(n) asm volatile("s_waitcnt lgkmcnt(" #n ")" ::: "memory")
#define PG8_BAR __builtin_amdgcn_s_barrier()
#define PG8_SCHED __builtin_amdgcn_sched_barrier(0)
    Unit cur, nxt; int ui = 0;
    if (!S.next(0, cur)) return;
    f32x4 acc[2][2][4][2];
#pragma unroll
    for (int a = 0; a < 2; ++a)
#pragma unroll
        for (int b = 0; b < 2; ++b)
#pragma unroll
            for (int m = 0; m < 4; ++m)
#pragma unroll
                for (int n = 0; n < 2; ++n) { acc[a][b][m][n] = (f32x4){0.f, 0.f, 0.f, 0.f}; if constexpr (F8) asm volatile("" : "+v"(acc[a][b][m][n])); }
    bf16x8 At[4][2], B0[2][2], B1[2][2];
    const char* cA = (const char*)g.A + (size_t)cur.pm * tstep; const char* cB = (const char*)g.Bt + (size_t)cur.pn * tstep;
    S.a_ready(cur);
    const char* gA = (const char*)g.A;
    if constexpr (GATH) PG8_GOFF(goc, cur);
    if constexpr (SP2) {
        PG8_STAGE(PG8_SB(0, 0), cB, voffB); PG8_STAGE(PG8_SB(0, 1), cB + hstep, voffB); PG8_STAGE_A(0, 0, cA, gA, goc[0]); PG8_STAGE_A(0, 1, cA + hstep, gA, goc[1]);
        if (wr == 1) PG8_BAR;
        PG8_WAIT_V(2); PG8_BAR;
        PG8_STAGE(PG8_SB(1, 0), cB + kstepB, voffB); PG8_STAGE_A(1, 0, cA + kstep, gA + kstep, goc[0]); PG8_STAGE(PG8_SB(1, 1), cB + hstep + kstepB, voffB);
        PG8_WAIT_V(6); PG8_BAR;
    } else {
        PG8_STAGE(PG8_SB(0, 0), cB, voffB); PG8_STAGE(PG8_SA(0, 0), cA, voffA); PG8_STAGE(PG8_SB(0, 1), cB + hstep, voffB); PG8_STAGE(PG8_SA(0, 1), cA + hstep, voffA);
        if (wr == 1) PG8_BAR;
        PG8_WAIT_V(4); PG8_BAR;
        PG8_STAGE(PG8_SB(1, 0), cB + kstepB, voffB); PG8_STAGE(PG8_SA(1, 0), cA + kstep, voffA); PG8_STAGE(PG8_SB(1, 1), cB + hstep + kstepB, voffB);
        PG8_WAIT_V(6); PG8_BAR;
    }
    for (;;) {
        const bool has_next = S.next(ui + 1, nxt);
        if constexpr (GATH) { if (has_next) PG8_GOFF(gon, nxt); else { _Pragma("unroll") for (int h_ = 0; h_ < 2; ++h_) _Pragma("unroll") for (int i_ = 0; i_ < 2; ++i_) gon[h_][i_] = goc[h_][i_]; } }
        const char* nA = has_next ? (const char*)g.A + (size_t)nxt.pm * tstep : cA; const char* nB = has_next ? (const char*)g.Bt + (size_t)nxt.pn * tstep : cB;
        for (int t = 0; t < nt; t += 2) {
            const bool last = (t == nt - 2);
            const char* a1 = cA + (size_t)(t + 1) * kstep;
            const char* a2 = last ? nA : cA + (size_t)(t + 2) * kstep; const char* b2 = last ? nB : cB + (size_t)(t + 2) * kstepB;
            const char* a3 = a2 + kstep; const char* b3 = b2 + kstepB;
            if (last && has_next) S.a_ready(nxt);
            const char* ga1 = gA + (size_t)(t + 1) * kstep; const char* ga2 = last ? gA : gA + (size_t)(t + 2) * kstep; const char* ga3 = ga2 + kstep;
            if constexpr (GATH) { _Pragma("unroll") for (int h_ = 0; h_ < 2; ++h_) _Pragma("unroll") for (int i_ = 0; i_ < 2; ++i_) go2[h_][i_] = last ? gon[h_][i_] : goc[h_][i_]; }
            if constexpr (SP2) {
            PG8_LDB(B0, 0, 0); PG8_LDB(B1, 0, 1); PG8_SCHED; PG8_LDA(At, 0, 0); PG8_STAGE_A(1, 1, a1 + hstep, ga1, goc[1]);
            PG8_WAIT_V(8); PG8_WAIT_L(0); PG8_BAR; PG8_MMA(0, 0, At, B0); PG8_MMA(0, 1, At, B1); PG8_BAR; PG8_SCHED;
            PG8_LDA(At, 0, 1); PG8_STAGE(PG8_SB(0, 0), b2, voffB); PG8_STAGE(PG8_SB(0, 1), b2 + hstep, voffB); PG8_STAGE_A(0, 0, a2, ga2, go2[0]);
            PG8_WAIT_V(8); PG8_WAIT_L(0); PG8_BAR; PG8_MMA(1, 0, At, B0); PG8_MMA(1, 1, At, B1); PG8_BAR; PG8_SCHED;
            PG8_LDB(B0, 1, 0); PG8_LDB(B1, 1, 1); PG8_SCHED; PG8_LDA(At, 1, 0); PG8_STAGE_A(0, 1, a2 + hstep, ga2, go2[1]);
            PG8_WAIT_V(8); PG8_WAIT_L(0); PG8_BAR; PG8_MMA(0, 0, At, B0); PG8_MMA(0, 1, At, B1); PG8_BAR; PG8_SCHED;
            PG8_LDA(At, 1, 1); PG8_STAGE(PG8_SB(1, 0), b3, voffB); PG8_STAGE(PG8_SB(1, 1), b3 + hstep, voffB); PG8_STAGE_A(1, 0, a3, ga3, go2[0]);
            PG8_WAIT_V(8); PG8_WAIT_L(0); PG8_BAR; PG8_MMA(1, 0, At, B0); PG8_MMA(1, 1, At, B1); PG8_BAR; PG8_SCHED;
            } else {
            PG8_LDB(B0, 0, 0); PG8_SCHED; PG8_LDA(At, 0, 0); PG8_STAGE(PG8_SA(1, 1), a1 + hstep, voffA);
            PG8_WAIT_L(8); PG8_BAR; PG8_WAIT_L(0); PG8_MMA(0, 0, At, B0); PG8_BAR; PG8_SCHED;
            PG8_LDB(B1, 0, 1); PG8_STAGE(PG8_SB(0, 0), b2, voffB);
            PG8_BAR; PG8_WAIT_L(0); PG8_MMA(0, 1, At, B1); PG8_BAR;
            PG8_LDA(At, 0, 1); PG8_STAGE(PG8_SA(0, 0), a2, voffA);
            PG8_BAR; PG8_WAIT_L(0); PG8_MMA(1, 0, At, B0); PG8_BAR; PG8_SCHED;
            PG8_STAGE(PG8_SB(0, 1), b2 + hstep, voffB);
            PG8_WAIT_V(6); PG8_BAR; PG8_MMA(1, 1, At, B1); PG8_BAR;
            PG8_LDB(B0, 1, 0); PG8_SCHED; PG8_LDA(At, 1, 0); PG8_STAGE(PG8_SA(0, 1), a2 + hstep, voffA);
            PG8_WAIT_L(8); PG8_BAR; PG8_WAIT_L(0); PG8_MMA(0, 0, At, B0); PG8_BAR; PG8_SCHED;
            PG8_LDB(B1, 1, 1); PG8_STAGE(PG8_SB(1, 0), b3, voffB);
            PG8_BAR; PG8_WAIT_L(0); PG8_MMA(0, 1, At, B1); PG8_BAR;
            PG8_LDA(At, 1, 1); PG8_STAGE(PG8_SA(1, 0), a3, voffA);
            PG8_BAR; PG8_WAIT_L(0); PG8_MMA(1, 0, At, B0); PG8_BAR; PG8_SCHED;
            PG8_STAGE(PG8_SB(1, 1), b3 + hstep, voffB);
            PG8_WAIT_V(6); PG8_BAR; PG8_MMA(1, 1, At, B1); PG8_BAR;
            }
        }
        if constexpr (F8) asm volatile("s_nop 15\n\ts_nop 15" ::: "memory");
        if constexpr (ALIGN_EPI) { if (wr == 0) PG8_BAR; }
        if constexpr (!Epi::AFTER_DRAIN) { E(acc, cur, wr, wc, fr, fq); S.done(cur); }
        if (!has_next) break;
#pragma unroll
        for (int a = 0; a < 2; ++a)
#pragma unroll
            for (int b = 0; b < 2; ++b)
#pragma unroll
                for (int m = 0; m < 4; ++m)
#pragma unroll
                    for (int n = 0; n < 2; ++n) { acc[a][b][m][n] = (f32x4){0.f, 0.f, 0.f, 0.f}; if constexpr (F8) asm volatile("" : "+v"(acc[a][b][m][n])); }
        cur = nxt; cA = nA; cB = nB; ++ui;
        if constexpr (GATH) { _Pragma("unroll") for (int h_ = 0; h_ < 2; ++h_) _Pragma("unroll") for (int i_ = 0; i_ < 2; ++i_) goc[h_][i_] = gon[h_][i_]; }
        if constexpr (ALIGN_EPI) { if (wr == 1) PG8_BAR; }
    }
    PG8_WAIT_V(0);
    if constexpr (!ALIGN_EPI) { if (wr == 0) PG8_BAR; }
    PG8_BAR;
    if constexpr (Epi::AFTER_DRAIN) { E.fused(acc, cur, wr, wc, fr, fq, lds, wid, lane); S.done(cur); }
#undef PG8_SA
#undef PG8_SB
#undef PG8_STAGE
#undef PG8_STAGE_A
#undef PG8_GOFF
#undef PG8_LDA
#undef PG8_LDB
#undef PG8_MMA
#undef PG8_WAIT_V
#undef PG8_WAIT_L
#undef PG8_BAR
#undef PG8_SCHED
}}

namespace mk {
using pg8::bf16_t; using pg8::bf16x8; using pg8::f32x4; using pg8::u32x4; using pg8::u32x2; using pg8::pk2; using pg8::bflo; using pg8::bfhi;
typedef float f32x16 __attribute__((ext_vector_type(16)));
typedef short s16x4 __attribute__((ext_vector_type(4)));
typedef short v4i16_t __attribute__((ext_vector_type(4)));
#define LAS __attribute__((address_space(3)))
#define GAS __attribute__((address_space(1)))
typedef GAS unsigned gu32;
#define RLX_AGENT __ATOMIC_RELAXED, __HIP_MEMORY_SCOPE_AGENT
#define LDS_WAIT() asm volatile("s_waitcnt lgkmcnt(0)" ::: "memory")

constexpr int NB = 8, SEQ = 8192, M = NB * SEQ, D = 1024, NP = 2816, NMEM = 256, MKV = NB * NMEM;
constexpr int PQ = 0, PK = 256, PV = 512, PR = 1024, PG = 1536, PU = 1792, PVS = 2304;
constexpr int DIN = 2576;
constexpr int MOE_ROWS = 135168;
constexpr float ALPHA = 1.4142135623730951f, LN_EPS = 1e-5f, LOG2E = 1.4426950408889634f;
constexpr int NWAVES = 8, NTHR = 512;

constexpr size_t MiB = 1u << 20;
constexpr size_t WS_CTL = 0, CTL_ZERO_BYTES = 1 * MiB;
constexpr size_t WS_WM = 1 * MiB;
constexpr size_t WS_WGCNT = 1 * MiB + 512 * 1024;
constexpr size_t WS_LTOT = 1 * MiB + 768 * 1024;
constexpr size_t WS_TINFO = 2 * MiB;
constexpr size_t WS_TRANK = 3 * MiB;
constexpr size_t WS_TSLOT = 3 * MiB + 512 * 1024;
constexpr size_t WS_SEND = 4 * MiB;
constexpr size_t WS_WKV = 12 * MiB;
constexpr size_t WS_MEMB = 20 * MiB;
constexpr size_t WS_KV = 24 * MiB;
constexpr size_t WS_W = 40 * MiB, W_LAYER = 60 * MiB;
constexpr size_t W_IN = 0, W_OUT = (size_t)NP * D * 2, W_Q = W_OUT + 2 * MiB, W_O = W_Q + 2 * MiB, W_GU = W_O + 2 * MiB, W_D = W_GU + 32 * MiB;
static_assert(W_D + 16 * MiB <= W_LAYER, "weights per layer");
constexpr size_t WS_X = 160 * MiB;
constexpr size_t WS_R = 288 * MiB;
constexpr size_t R_P = 0, R_Y = 352 * MiB, R_Z = 480 * MiB, R_Q = 0, R_O = 128 * MiB, R_XS = 344 * MiB, R_H = 0;
constexpr size_t R_X8 = 256 * MiB;
constexpr size_t WS_SRCROW = WS_R + 616 * MiB;
constexpr size_t WS_PART = WS_SRCROW + 1 * MiB;
constexpr size_t WS_STATS = WS_PART + 8 * MiB;
constexpr size_t WS_CS = WS_STATS + 1 * MiB;
constexpr size_t WS_X8IN = WS_CS + 1 * MiB;
constexpr size_t WS_END = WS_X8IN + 64 * MiB;
static_assert(R_XS + (size_t)MOE_ROWS * D * 2 <= 616 * MiB && R_H + (size_t)MOE_ROWS * 512 * 2 <= R_XS, "moe buffers");
constexpr int CW_BAR = 4096;

constexpr int LDS_BYTES = 159744, LDSCTL_OFF = 155648;
constexpr int MISC_OFF = LDSCTL_OFF;
constexpr int TILEE_OFF = LDSCTL_OFF + 512;
static_assert(TILEE_OFF + 528 * 4 <= LDS_BYTES, "LDS map");

#define XB_TMO      128
#define XB_XCNT(j)  (256  + 64 * (j))
#define XB_XSUB(j)  (1280 + 64 * (j))
#define XB_XGEN(j)  (2304 + 64 * (j))
#define XB_TOP      3328
#define XB_TOPGEN   3392
#define XCD_BAR_WORDS 3456
#define XB_SPIN_CAP (1u << 18)

__device__ __forceinline__ unsigned xb_ld(unsigned* p)              { return __hip_atomic_load(p, __ATOMIC_RELAXED, __HIP_MEMORY_SCOPE_AGENT); }
__device__ __forceinline__ unsigned xb_add(unsigned* p, unsigned v) { return __hip_atomic_fetch_add(p, v, __ATOMIC_RELAXED, __HIP_MEMORY_SCOPE_AGENT); }
__device__ __forceinline__ unsigned xb_xcc_id() { return (unsigned)__builtin_amdgcn_s_getreg((3 << 11) | 20) & 0xFu; }
#define XB_SPIN(cond, bar) do { unsigned _sp = 0; while (cond) { __builtin_amdgcn_s_sleep(1); \
    if ((++_sp & 255u) == 0u) { if (xb_ld(&(bar)[XB_TMO])) break; if (_sp > XB_SPIN_CAP) { atomicAdd(&(bar)[XB_TMO], 1u); break; } } } } while (0)

struct XcdBarrier {
    unsigned* bar; unsigned x;
    volatile LAS unsigned* st;
    int wv;
};

__device__ __forceinline__ XcdBarrier xcd_barrier_post(unsigned* bar, volatile LAS unsigned* st) {
    XcdBarrier b; b.bar = bar; b.x = xb_xcc_id(); b.st = st; b.wv = 0;
    if (threadIdx.x == 0) (void)xb_add(&bar[XB_XCNT(b.x)], 1u);
    return b;
}
__device__ __forceinline__ void xcd_barrier_complete(unsigned* bar, unsigned x, unsigned& nloc, unsigned& nx) {
    const unsigned G = gridDim.x * gridDim.y * gridDim.z;
    unsigned sum, cnt, mine, sp = 0u;
    for (;;) {
        sum = 0u; cnt = 0u; mine = 0u;
#pragma unroll
        for (unsigned j = 0; j < 16; ++j) { const unsigned c = xb_ld(&bar[XB_XCNT(j)]); sum += c; cnt += (c > 0u) ? 1u : 0u; mine = (j == x) ? c : mine; }
        if (sum == G) break;
        __builtin_amdgcn_s_sleep(1);
        if ((++sp & 255u) == 0u) { if (xb_ld(&bar[XB_TMO])) break; if (sp > XB_SPIN_CAP) { atomicAdd(&bar[XB_TMO], 1u); break; } }
    }
    nloc = mine > 0u ? mine : 1u; nx = cnt > 0u ? cnt : 1u;
}

__device__ __forceinline__ void xcd_barrier(const XcdBarrier& b) {
    asm volatile("s_waitcnt vmcnt(0)" ::: "memory");
    __syncthreads();
    if (b.wv == 0 && pg8::lane_id() == 0) {
        unsigned* bar = b.bar;
        __builtin_amdgcn_s_waitcnt(0);
        unsigned nloc = b.st[0], nx = b.st[1];
        if (nloc == 0u) { xcd_barrier_complete(bar, b.x, nloc, nx); b.st[0] = nloc; b.st[1] = nx; }
        const unsigned old = xb_add(&bar[XB_XSUB(b.x)], 1u);
        const unsigned gen = old / nloc;
        if (old + 1u == (gen + 1u) * nloc) {
            __builtin_amdgcn_fence(__ATOMIC_RELEASE, "agent");
            asm volatile("s_waitcnt vmcnt(0)" ::: "memory");
            const unsigned og = xb_add(&bar[XB_TOP], 1u);
            const unsigned tg = og / nx;
            if (og + 1u == (tg + 1u) * nx) xb_add(&bar[XB_TOPGEN], 1u);
            else XB_SPIN(xb_ld(&bar[XB_TOPGEN]) == tg, bar);
            __builtin_amdgcn_fence(__ATOMIC_ACQUIRE, "agent");
            xb_add(&bar[XB_XGEN(b.x)], 1u);
            asm volatile("s_waitcnt vmcnt(0)" ::: "memory");
        } else {
            XB_SPIN(xb_ld(&bar[XB_XGEN(b.x)]) == gen, bar);
            __builtin_amdgcn_fence(__ATOMIC_ACQUIRE, "agent");
            asm volatile("s_waitcnt vmcnt(0)" ::: "memory");
        }
    }
    __syncthreads();
}
__device__ __forceinline__ float shx(float v, int m, int lane) { return __builtin_bit_cast(float, __builtin_amdgcn_ds_bpermute((lane ^ m) << 2, __builtin_bit_cast(int, v))); }
__device__ __forceinline__ int shxi(int v, int m, int lane) { return __builtin_amdgcn_ds_bpermute((lane ^ m) << 2, v); }
__device__ __forceinline__ s16x4 vtr(unsigned lds_addr) { return __builtin_bit_cast(s16x4, __builtin_amdgcn_ds_read_tr16_b64_v4i16((LAS v4i16_t*)(size_t)lds_addr)); }
__device__ __forceinline__ bf16x8 cat8(s16x4 lo, s16x4 hi) { return __builtin_shufflevector(lo, hi, 0, 1, 2, 3, 4, 5, 6, 7); }
__device__ __forceinline__ void unpack8(const u32x4 w, float (&f)[8]) { f[0] = bflo(w.x); f[1] = bfhi(w.x); f[2] = bflo(w.y); f[3] = bfhi(w.y); f[4] = bflo(w.z); f[5] = bfhi(w.z); f[6] = bflo(w.w); f[7] = bfhi(w.w); }
__device__ __forceinline__ void unpack8f8(const u32x2 w, float (&f)[8]) { const auto a0 = __builtin_amdgcn_cvt_pk_f32_fp8((int)w.x, false), a1 = __builtin_amdgcn_cvt_pk_f32_fp8((int)w.x, true), a2 = __builtin_amdgcn_cvt_pk_f32_fp8((int)w.y, false), a3 = __builtin_amdgcn_cvt_pk_f32_fp8((int)w.y, true);
    f[0] = a0[0]; f[1] = a0[1]; f[2] = a1[0]; f[3] = a1[1]; f[4] = a2[0]; f[5] = a2[1]; f[6] = a3[0]; f[7] = a3[1]; }
__device__ __forceinline__ u32x4 pack8(const float (&f)[8]) { u32x4 w; w.x = pk2(f[0], f[1]); w.y = pk2(f[2], f[3]); w.z = pk2(f[4], f[5]); w.w = pk2(f[6], f[7]); return w; }

struct Args {
    const float* in[22]; float* out; unsigned char* ws;
};

__device__ __forceinline__ void transpose_item(const float* p0, const float* p1, int ld, int mode, float scale, int K, int nblk, bf16_t* dst, int row0, LAS float* scr, int item, int lane, const float* kscale = nullptr) {
    const int kb = item / nblk, nb = item % nblk, k0 = 64 * kb, n0 = 32 * nb;
    const int np = n0 + (lane & 31);
    const float* sp; int col;
    if (mode == 0) { sp = p0; col = np; } else { sp = (np & 4) ? p1 : p0; col = (np >> 3) * 4 + (np & 3); }
    sp += (size_t)k0 * ld + col;
#pragma unroll 8
    for (int i = 0; i < 32; ++i) { const int kk = 2 * i + (lane >> 5); scr[kk * 33 + (lane & 31)] = sp[(size_t)kk * ld] * scale * (kscale ? kscale[k0 + kk] : 1.0f); }
    LDS_WAIT(); asm volatile("" ::: "memory");
    const int c = lane & 7;
#pragma unroll
    for (int j = 0; j < 4; ++j) { const int n = (lane >> 3) + 8 * j; const LAS float* s = scr + (8 * c) * 33 + n;
        u32x4 o; o.x = pk2(s[0 * 33], s[1 * 33]); o.y = pk2(s[2 * 33], s[3 * 33]); o.z = pk2(s[4 * 33], s[5 * 33]); o.w = pk2(s[6 * 33], s[7 * 33]);
        const int ng = row0 + n0 + n, kk = k0 + 8 * c;
        *(u32x4*)(dst + ((size_t)(ng >> 4) * (K >> 5) + (kk >> 5)) * 512 + (ng & 15) * 32 + (kk & 31)) = o; }
    LDS_WAIT(); asm volatile("" ::: "memory");
}
__device__ __forceinline__ void transpose_item8(const float* p0, const float* p1, int ld, int mode, float scale, int K, int nblk, unsigned char* dst, int row0, LAS float* scr, int item, int lane, const float* kscale = nullptr) {
    const int kb = item / nblk, nb = item % nblk, k0 = 64 * kb, n0 = 32 * nb;
    const int nq = lane & 7, kr = lane >> 3, np = n0 + 4 * nq;
    const float* sp; int col;
    if (mode == 0) { sp = p0; col = np; } else { sp = ((np >> 7) & 1) ? p1 : p0; col = (np >> 8) * 128 + (np & 127); }
    sp += (size_t)k0 * ld + col;
    f32x4 ld4[8];
#pragma unroll
    for (int i = 0; i < 8; ++i) ld4[i] = *(const f32x4*)(sp + (size_t)(8 * i + kr) * ld);
#pragma unroll
    for (int i = 0; i < 8; ++i) { const int kk = 8 * i + kr; const float ks = scale * (kscale ? kscale[k0 + kk] : 1.0f);
#pragma unroll
        for (int q = 0; q < 4; ++q) scr[kk * 33 + 4 * nq + q] = ld4[i][q] * ks; }
    LDS_WAIT(); asm volatile("" ::: "memory");
    const int c = lane & 7;
#pragma unroll
    for (int j = 0; j < 4; ++j) { const int n = (lane >> 3) + 8 * j; const LAS float* s = scr + (8 * c) * 33 + n;
        u32x2 o; o.x = pg8::pk4f8(s[0 * 33], s[1 * 33], s[2 * 33], s[3 * 33]); o.y = pg8::pk4f8(s[4 * 33], s[5 * 33], s[6 * 33], s[7 * 33]);
        const int ng = row0 + n0 + n;
        *(u32x2*)(dst + ((size_t)(ng >> 4) * (K >> 6) + (k0 >> 6)) * 1024 + (ng & 15) * 64 + 8 * c) = o; }
    LDS_WAIT(); asm volatile("" ::: "memory");
}
__device__ __forceinline__ void p0_convert(const Args& a, LAS unsigned char* lds, int bid, int G, int wave_s) {
    int tid_ = wave_s * 64 + pg8::lane_id(); asm volatile("" : "+v"(tid_)); const int tid = tid_, lane = tid & 63, wave = __builtin_amdgcn_readfirstlane(tid >> 6);
    unsigned char* ws = a.ws;
    LAS float* scr = (LAS float*)(lds + wave * 16384);
    const int gw = bid * NWAVES + wave, NGW = G * NWAVES;
    constexpr int I_INQ = 16 * 8, I_INB = 16 * 40, I_INC = 16 * 32, I_SQ = 16 * 32, I_GU = 16 * 16 * 32, I_DN = 16 * 8 * 32;
    constexpr int I_LAYER = I_INQ + I_INB + I_INC + 5 * I_SQ + I_GU + I_DN;
    for (int it = gw; it < 2 * I_LAYER; it += NGW) {
        const int l = it / I_LAYER; int r = it % I_LAYER;
        unsigned char* wl = ws + WS_W + (size_t)l * W_LAYER;
        const float* w_in = a.in[2] + (size_t)l * D * DIN;
        if (r < I_INQ) { transpose_item8(w_in, nullptr, DIN, 0, 0.125f * pg8::F8_SW, D, 8, wl + W_IN, 0, scr, r, lane); continue; } r -= I_INQ;
        if (r < I_INB) { transpose_item8(w_in + 256, nullptr, DIN, 0, pg8::F8_SW, D, 40, wl + W_IN, 256, scr, r, lane); continue; } r -= I_INB;
        if (r < I_INC) { transpose_item8(w_in + 1552, nullptr, DIN, 0, pg8::F8_SW, D, 32, wl + W_IN, 1792, scr, r, lane); continue; } r -= I_INC;
        if (r < I_SQ) { transpose_item8(a.in[10] + (size_t)l * D * D, nullptr, D, 0, pg8::F8_SW, D, 32, wl + W_OUT, 0, scr, r, lane); continue; } r -= I_SQ;
        if (r < I_SQ) { transpose_item8(a.in[11] + (size_t)l * D * D, nullptr, D, 0, 0.0625f * pg8::F8_SW, D, 32, wl + W_Q, 0, scr, r, lane, a.in[20] + (size_t)(l * 3 + 0) * D); continue; } r -= I_SQ;
        if (r < I_SQ) { transpose_item8(a.in[14] + (size_t)l * D * D, nullptr, D, 0, pg8::F8_SW, D, 32, wl + W_O, 0, scr, r, lane); continue; } r -= I_SQ;
        if (r < I_SQ) { transpose_item(a.in[12] + (size_t)l * D * D, nullptr, D, 0, 1.0f, D, 32, (bf16_t*)(ws + WS_WKV), l * 2048, scr, r, lane); continue; } r -= I_SQ;
        if (r < I_SQ) { transpose_item(a.in[13] + (size_t)l * D * D, nullptr, D, 0, 1.0f, D, 32, (bf16_t*)(ws + WS_WKV), l * 2048 + 1024, scr, r, lane); continue; } r -= I_SQ;
        if (r < I_GU) { const int e = r / 512, rr = r % 512; const size_t eo = ((size_t)l * 16 + e) * D * 512;
            transpose_item8(a.in[17] + eo, a.in[18] + eo, 512, 2, pg8::F8_SW, D, 32, wl + W_GU, e * 1024, scr, rr, lane); continue; } r -= I_GU;
        { const int e = r / 256, rr = r % 256; const size_t eo = ((size_t)l * 16 + e) * 512 * D;
            transpose_item8(a.in[19] + eo, nullptr, D, 0, pg8::F8_SW, 512, 32, wl + W_D, e * 1024, scr, rr, lane); }
    }
    const size_t gt = (size_t)bid * NTHR + tid, NT = (size_t)G * NTHR;
    for (int it = gw; it < 2 * 16 * 16; it += NGW) { const int l = it >> 8, kc = (it >> 4) & 15, n = (it & 15) * 64 + lane;
        const float* wq = a.in[11] + (size_t)l * D * D; const float* gg = a.in[20] + (size_t)(l * 3) * D; const float* bb = a.in[21] + (size_t)(l * 3) * D; float cs = 0.f, bq = 0.f;
#pragma unroll 8
        for (int k = 64 * kc; k < 64 * kc + 64; ++k) { const float w = wq[(size_t)k * D + n] * 0.0625f; cs += pg8::f8round(w * gg[k] * pg8::F8_SW) * (1.0f / pg8::F8_SW); bq += w * bb[k]; }
        float* tb = (float*)(ws + WS_CS) + (size_t)l * 2 * 16 * 1024; tb[kc * 1024 + n] = cs; tb[16 * 1024 + kc * 1024 + n] = bq; }
    for (size_t i = gt; i < (size_t)2 * 256 * 128; i += NT) {
        const int l = (int)(i / (256 * 128)), r = (int)(i % (256 * 128)), j = r / 128, k8 = r % 128;
        const float* w_in = a.in[2] + (size_t)l * D * DIN; const float* w_a2 = a.in[3] + (size_t)l * 16 * 256;
        float wa[16];
#pragma unroll
        for (int q = 0; q < 16; ++q) wa[q] = w_a2[q * 256 + j];
        float o[8];
#pragma unroll
        for (int kk = 0; kk < 8; ++kk) { const float* wr = w_in + (size_t)(8 * k8 + kk) * DIN + 1536; float s = 0.f;
#pragma unroll
            for (int q = 0; q < 16; q += 4) { const f32x4 v = *(const f32x4*)(wr + q); s += v[0] * wa[q] + v[1] * wa[q + 1] + v[2] * wa[q + 2] + v[3] * wa[q + 3]; }
            o[kk] = s; }
        { const int ng = 1536 + j, kk = 8 * k8; u32x2 o8; o8.x = pg8::pk4f8(o[0] * pg8::F8_SW, o[1] * pg8::F8_SW, o[2] * pg8::F8_SW, o[3] * pg8::F8_SW); o8.y = pg8::pk4f8(o[4] * pg8::F8_SW, o[5] * pg8::F8_SW, o[6] * pg8::F8_SW, o[7] * pg8::F8_SW);
          *(u32x2*)(ws + WS_W + (size_t)l * W_LAYER + W_IN + ((size_t)(ng >> 4) * (D >> 6) + (kk >> 6)) * 1024 + (ng & 15) * 64 + (kk & 63)) = o8; }
    }
    for (size_t i = gt; i < (size_t)2 * 4 * 128 * 16; i += NT) {
        const int s8 = (int)(i & 15), t = (int)((i >> 4) & 127);
        const float* src = a.in[6] + i * 8; float o[8];
#pragma unroll
        for (int q = 0; q < 8; ++q) o[q] = ((8 * s8 + q) / 64 <= t / 64) ? src[q] : 0.f;
        *(u32x4*)((bf16_t*)(ws + WS_WM) + i * 8) = pack8(o);
    }
    for (size_t i = gt; i < (size_t)M * D / 8; i += NT) {
        const f32x4 v0 = *(const f32x4*)(a.in[0] + i * 8), v1 = *(const f32x4*)(a.in[0] + i * 8 + 4);
        u32x4 w; w.x = pk2(v0[0], v0[1]); w.y = pk2(v0[2], v0[3]); w.z = pk2(v1[0], v1[1]); w.w = pk2(v1[2], v1[3]);
        *(u32x4*)((bf16_t*)(ws + WS_X) + i * 8) = w;
        u32x2 q8; q8.x = pg8::pk4f8(v0[0] * pg8::F8_SX, v0[1] * pg8::F8_SX, v0[2] * pg8::F8_SX, v0[3] * pg8::F8_SX); q8.y = pg8::pk4f8(v1[0] * pg8::F8_SX, v1[1] * pg8::F8_SX, v1[2] * pg8::F8_SX, v1[3] * pg8::F8_SX);
        *(u32x2*)(ws + WS_X8IN + i * 8) = q8;
    }
    for (size_t i = gt; i < (size_t)MKV * D / 8; i += NT) {
        const f32x4 v0 = *(const f32x4*)(a.in[1] + i * 8), v1 = *(const f32x4*)(a.in[1] + i * 8 + 4);
        u32x4 w; w.x = pk2(v0[0], v0[1]); w.y = pk2(v0[2], v0[3]); w.z = pk2(v1[0], v1[1]); w.w = pk2(v1[2], v1[3]);
        *(u32x4*)((bf16_t*)(ws + WS_MEMB) + i * 8) = w;
    }
}

constexpr int GL_KD = 0, GL_QS = 9216, GL_VS = 18432, GL_PSUM = 35840, GL_DL = 37888, GL_SSQ = 38144;
template <bool FINAL>
__device__ __forceinline__ void gla_phase(LAS unsigned char* lds, const bf16_t* P, float* Send, float* Ltot, bf16_t* Y, const float* gn_g, int bid, int G, int wave_s) {
    int tid_ = wave_s * 64 + pg8::lane_id(); asm volatile("" : "+v"(tid_)); const int tid = tid_, lane = tid & 63, wave = __builtin_amdgcn_readfirstlane(tid >> 6);
    const unsigned lb = (unsigned)(size_t)lds;
    const int g = lane >> 4, l15 = lane & 15, q4 = l15 >> 2, p4 = lane & 3;
    const int kq = tid & 63, part = wave;
    for (int item = bid; item < 256; item += G) {
        const int b = item >> 5, h = (item >> 3) & 3, run = item & 7, bh = item >> 3;
        f32x4 sacc[4];
#pragma unroll
        for (int kt = 0; kt < 4; ++kt) sacc[kt] = (f32x4){0.f, 0.f, 0.f, 0.f};
        if (FINAL) {
#pragma unroll
            for (int i = 0; i < 7; ++i) if (i < run) {
                const float* se = Send + ((size_t)(bh * 8 + i) * 64) * 128; const float* lt = Ltot + (size_t)(bh * 8 + i) * 64;
#pragma unroll
                for (int kt = 0; kt < 4; ++kt)
#pragma unroll
                    for (int r = 0; r < 4; ++r) { const int k = 16 * kt + 4 * g + r; sacc[kt][r] = __expf(lt[k]) * sacc[kt][r] + se[(size_t)k * 128 + 16 * wave + l15]; }
            }
        }
        float ltot_acc = 0.f;
        unsigned short graw[8], kraw[8]; u32x4 vraw[2], qraw; u32x2 rraw[4];
        const int v_row = tid >> 4, v_c16 = tid & 15, q_row = tid >> 3, q_c16 = tid & 7;
        const int ycol = h * 128 + 16 * wave + 4 * g;
        f32x4 gn = {1.f, 1.f, 1.f, 1.f}; if (FINAL) gn = *(const f32x4*)(gn_g + ycol);
#define GLA_FETCH(CC) do { const size_t tf_ = (size_t)b * SEQ + (size_t)(run * 16 + (CC)) * 64; \
            _Pragma("unroll") for (int i = 0; i < 8; ++i) { const bf16_t* rp = P + (tf_ + 8 * part + i) * NP + h * 64 + kq; graw[i] = rp[PG]; kraw[i] = rp[PK]; } \
            _Pragma("unroll") for (int i = 0; i < 2; ++i) vraw[i] = *(const u32x4*)(P + (tf_ + v_row + 32 * i) * NP + PV + h * 128 + v_c16 * 8); \
            if (FINAL) { qraw = *(const u32x4*)(P + (tf_ + q_row) * NP + PQ + h * 64 + q_c16 * 8); \
                _Pragma("unroll") for (int tt = 0; tt < 4; ++tt) rraw[tt] = *(const u32x2*)(P + (tf_ + 16 * tt + l15) * NP + PR + ycol); } } while (0)
        GLA_FETCH(0);
        for (int c = 0; c < 16; ++c) {
            const size_t t0 = (size_t)b * SEQ + (size_t)(run * 16 + c) * 64;
            __syncthreads();
            float gv[8], kv[8];
#pragma unroll
            for (int i = 0; i < 8; ++i) { gv[i] = __builtin_bit_cast(float, (unsigned)graw[i] << 16); kv[i] = __builtin_bit_cast(float, (unsigned)kraw[i] << 16); }
#pragma unroll
            for (int i = 1; i < 8; ++i) gv[i] += gv[i - 1];
            ((LAS float*)(lds + GL_PSUM))[part * 64 + kq] = gv[7];
#pragma unroll
            for (int i = 0; i < 2; ++i) *(LAS u32x4*)(lds + GL_VS + (v_row + 32 * i) * 272 + v_c16 * 16) = vraw[i];
            u32x2 rcur[4];
            if (FINAL) { *(LAS u32x4*)(lds + GL_QS + q_row * 144 + q_c16 * 16) = qraw;
#pragma unroll
                for (int tt = 0; tt < 4; ++tt) rcur[tt] = rraw[tt]; }
            if (c + 1 < 16) GLA_FETCH(c + 1);
            __syncthreads();
            float offs = 0.f, bl = 0.f;
#pragma unroll
            for (int p = 0; p < 8; ++p) { const float v = ((LAS float*)(lds + GL_PSUM))[p * 64 + kq]; offs += (p < part) ? v : 0.f; bl += v; }
#pragma unroll
            for (int i = 0; i < 8; ++i) { const float kd = kv[i] * __expf(bl - (offs + gv[i]));
                *(LAS unsigned short*)(lds + GL_KD + (8 * part + i) * 144 + kq * 2) = (unsigned short)(pk2(kd, 0.f) & 0xffffu); }
            if (part == 0) ((LAS float*)(lds + GL_DL))[kq] = __expf(bl);
            ltot_acc += bl;
            __syncthreads();
#pragma unroll
            for (int kt = 0; kt < 4; ++kt) { const f32x4 dl = *(LAS f32x4*)(lds + GL_DL + (16 * kt + 4 * g) * 4); sacc[kt] = sacc[kt] * dl; }
#pragma unroll
            for (int ks = 0; ks < 2; ++ks) {
                const unsigned vrow = lb + GL_VS + (unsigned)(32 * ks + 8 * g + q4) * 272u + (unsigned)(16 * wave + 4 * p4) * 2u;
                const bf16x8 vb = cat8(vtr(vrow), vtr(vrow + 4u * 272u));
#pragma unroll
                for (int kt = 0; kt < 4; ++kt) {
                    const unsigned krow = lb + GL_KD + (unsigned)(32 * ks + 8 * g + q4) * 144u + (unsigned)(16 * kt + 4 * p4) * 2u;
                    const bf16x8 ka = cat8(vtr(krow), vtr(krow + 4u * 144u));
                    sacc[kt] = __builtin_amdgcn_mfma_f32_16x16x32_bf16(ka, vb, sacc[kt], 0, 0, 0);
                }
            }
            if (FINAL) {
                f32x4 oacc[4];
#pragma unroll
                for (int tt = 0; tt < 4; ++tt) oacc[tt] = (f32x4){0.f, 0.f, 0.f, 0.f};
#pragma unroll
                for (int ks2 = 0; ks2 < 2; ++ks2) {
                    u32x4 spw; spw.x = pk2(sacc[2 * ks2][0], sacc[2 * ks2][1]); spw.y = pk2(sacc[2 * ks2][2], sacc[2 * ks2][3]);
                    spw.z = pk2(sacc[2 * ks2 + 1][0], sacc[2 * ks2 + 1][1]); spw.w = pk2(sacc[2 * ks2 + 1][2], sacc[2 * ks2 + 1][3]);
                    const bf16x8 sp = __builtin_bit_cast(bf16x8, spw);
#pragma unroll
                    for (int tt = 0; tt < 4; ++tt) {
                        const LAS unsigned char* qp = lds + GL_QS + (16 * tt + l15) * 144 + (32 * ks2 + 4 * g) * 2;
                        const u32x2 qlo = *(const LAS u32x2*)qp, qhi = *(const LAS u32x2*)(qp + 32);
                        u32x4 qw; qw.x = qlo.x; qw.y = qlo.y; qw.z = qhi.x; qw.w = qhi.y;
                        oacc[tt] = __builtin_amdgcn_mfma_f32_16x16x32_bf16(sp, __builtin_bit_cast(bf16x8, qw), oacc[tt], 0, 0, 0);
                    }
                }
#pragma unroll
                for (int tt = 0; tt < 4; ++tt) { float s = oacc[tt][0] * oacc[tt][0] + oacc[tt][1] * oacc[tt][1] + oacc[tt][2] * oacc[tt][2] + oacc[tt][3] * oacc[tt][3];
                    s += shx(s, 16, lane); s += shx(s, 32, lane);
                    if (g == 0) ((LAS float*)(lds + GL_SSQ))[wave * 64 + 16 * tt + l15] = s; }
                __syncthreads();
                const int col = ycol;
#pragma unroll
                for (int tt = 0; tt < 4; ++tt) { float tot = 0.f;
#pragma unroll
                    for (int w2 = 0; w2 < 8; ++w2) tot += ((LAS float*)(lds + GL_SSQ))[w2 * 64 + 16 * tt + l15];
                    const float rs = __builtin_amdgcn_rsqf(tot * (1.0f / 128.0f) + 1e-6f);
                    const size_t tok = t0 + 16 * tt + l15;
                    const u32x2 rr = rcur[tt];
                    const float rq = rs * pg8::F8_SM;
                    *(unsigned*)((unsigned char*)Y + tok * D + col) = pg8::pk4f8(oacc[tt][0] * rq * gn[0] * bflo(rr.x), oacc[tt][1] * rq * gn[1] * bfhi(rr.x), oacc[tt][2] * rq * gn[2] * bflo(rr.y), oacc[tt][3] * rq * gn[3] * bfhi(rr.y)); }
            }
        }
        if (!FINAL) {
            float* se = Send + ((size_t)(bh * 8 + run) * 64) * 128;
#pragma unroll
            for (int kt = 0; kt < 4; ++kt)
#pragma unroll
                for (int r = 0; r < 4; ++r) se[(size_t)(16 * kt + 4 * g + r) * 128 + 16 * wave + l15] = sacc[kt][r];
            if (part == 0) Ltot[(size_t)(bh * 8 + run) * 64 + kq] = ltot_acc;
        }
    }
}

#undef GLA_FETCH
constexpr int SG_VN = 0;
__device__ __forceinline__ void sgu_phase(LAS unsigned char* lds, const bf16_t* P, const bf16_t* Wm, const float* b_s, const float* lg, const float* lb_, bf16_t* Y, int bid, int G, int wave_s) {
    int tid_ = wave_s * 64 + pg8::lane_id(); asm volatile("" : "+v"(tid_)); const int tid = tid_, lane = tid & 63, wave = __builtin_amdgcn_readfirstlane(tid >> 6);
    const unsigned lb = (unsigned)(size_t)lds;
    const int g = lane >> 4, l15 = lane & 15, q4 = l15 >> 2, p4 = lane & 3;
    const int row = tid >> 2, qu = tid & 3;
    u32x4 vraw[4]; u32x2 uraw[8];
#define SGU_FETCH(IT) do { const int blk_ = (IT) >> 2, gr_ = (IT) & 3; const size_t tf_ = (size_t)blk_ * 128; \
        const bf16_t* src_ = P + (tf_ + row) * NP + PVS + gr_ * 128 + 32 * qu; \
        _Pragma("unroll") for (int i = 0; i < 4; ++i) vraw[i] = *(const u32x4*)(src_ + 8 * i); \
        const bf16_t* us_ = P + (tf_ + 16 * wave + l15) * NP + PU + gr_ * 128 + 4 * g; \
        _Pragma("unroll") for (int ct = 0; ct < 8; ++ct) uraw[ct] = *(const u32x2*)(us_ + 16 * ct); } while (0)
    if (bid < 2048) SGU_FETCH(bid);
    const int gr = bid & 3;
    bf16x8 wf[4]; float gph[32], bph[32];
#pragma unroll
    for (int ks = 0; ks < 4; ++ks) wf[ks] = *(const bf16x8*)(Wm + ((size_t)(gr * 128 + 16 * wave + l15)) * 128 + 32 * ks + 8 * g);
    const float bs = b_s[gr * 128 + 16 * wave + l15];
#pragma unroll
    for (int i = 0; i < 32; ++i) { gph[i] = lg[gr * 128 + 32 * qu + i]; bph[i] = lb_[gr * 128 + 32 * qu + i]; }
    for (int item = bid; item < 2048; item += G) {
        const int blk = item >> 2; const size_t t0 = (size_t)blk * 128;
        __syncthreads();
        u32x2 ucur[8];
        { float v[32];
#pragma unroll
          for (int i = 0; i < 4; ++i) { float f[8]; unpack8(vraw[i], f);
#pragma unroll
              for (int j = 0; j < 8; ++j) v[8 * i + j] = f[j]; }
#pragma unroll
          for (int ct = 0; ct < 8; ++ct) ucur[ct] = uraw[ct];
          if (item + G < 2048) SGU_FETCH(item + G);
          float s = 0.f;
#pragma unroll
          for (int i = 0; i < 32; ++i) s += v[i];
          s += shx(s, 1, lane); s += shx(s, 2, lane);
          const float mu = s * (1.0f / 128.0f); float qq = 0.f;
#pragma unroll
          for (int i = 0; i < 32; ++i) { v[i] -= mu; qq += v[i] * v[i]; }
          qq += shx(qq, 1, lane); qq += shx(qq, 2, lane);
          const float rs = __builtin_amdgcn_rsqf(qq * (1.0f / 128.0f) + LN_EPS);
#pragma unroll
          for (int i = 0; i < 4; ++i) { float f[8];
#pragma unroll
              for (int j = 0; j < 8; ++j) f[j] = v[8 * i + j] * rs * gph[8 * i + j] + bph[8 * i + j];
              *(LAS u32x4*)(lds + SG_VN + row * 272 + (32 * qu + 8 * i) * 2) = pack8(f); }
        }
        __syncthreads();
        const int nks = (wave < 4) ? 2 : 4;
        const size_t tok = t0 + 16 * wave + l15;
        unsigned vb0 = lb + SG_VN + (unsigned)(8 * g + q4) * 272u + (unsigned)(4 * p4) * 2u; asm volatile("" : "+v"(vb0));
#pragma unroll
        for (int ct = 0; ct < 8; ++ct) {
            f32x4 acc = (f32x4){0.f, 0.f, 0.f, 0.f};
#pragma unroll
            for (int ks = 0; ks < 4; ++ks) {
                if (ks < nks) {
                    const unsigned vrow = vb0 + (unsigned)(32 * ks * 272 + 32 * ct);
                    const bf16x8 va = cat8(vtr(vrow), vtr(vrow + 4u * 272u));
                    acc = __builtin_amdgcn_mfma_f32_16x16x32_bf16(va, wf[ks], acc, 0, 0, 0);
                }
            }
            const int col = gr * 128 + 16 * ct + 4 * g;
            const u32x2 uu = ucur[ct];
            *(unsigned*)((unsigned char*)Y + tok * D + 512 + col) = pg8::pk4f8(bflo(uu.x) * (acc[0] + bs) * pg8::F8_SM, bfhi(uu.x) * (acc[1] + bs) * pg8::F8_SM, bflo(uu.y) * (acc[2] + bs) * pg8::F8_SM, bfhi(uu.y) * (acc[3] + bs) * pg8::F8_SM);
        }
    }
}
#undef SGU_FETCH

constexpr int AT_KPS = 1040, AT_VPS = 1088, AT_SLOT = 34816, AT_NSLOT = 3;
static_assert(AT_NSLOT * AT_SLOT <= LDSCTL_OFF, "attention LDS");
__device__ __forceinline__ void glds16(const void* gsrc, unsigned lds_dst) { unsigned keep;
    asm volatile("s_mov_b32 %0, m0\n\ts_mov_b32 m0, %2\n\ts_nop 0\n\tglobal_load_lds_dwordx4 %1, off\n\ts_mov_b32 m0, %0" : "=&s"(keep) : "v"(gsrc), "s"(lds_dst) : "memory"); }
__device__ __forceinline__ void attn_dma(unsigned lb, const char* kvb, int so, unsigned lane_off, int slot, int ps, int wave) {
#pragma unroll
    for (int j = 0; j < 4; ++j) { const int pi = 4 * wave + j, rlo = 32 * (pi >> 4) + (pi & 15);
        glds16(kvb + (size_t)(so + rlo * 8192) + lane_off, (unsigned)__builtin_amdgcn_readfirstlane((int)(lb + (unsigned)(slot * AT_SLOT + pi * ps)))); }
}
#define AT_WAITBAR(N) do { asm volatile("s_waitcnt vmcnt(" #N ") lgkmcnt(0)" ::: "memory"); __builtin_amdgcn_s_barrier(); asm volatile("" ::: "memory"); } while (0)
__device__ __forceinline__ void attn_phase(LAS unsigned char* lds, const bf16_t* Q, const bf16_t* KV, bf16_t* O, int layer, int bid, int G, int wave_s) {
    int tid_ = wave_s * 64 + pg8::lane_id(); asm volatile("" : "+v"(tid_)); const int tid = tid_, lane = tid & 63, wave = __builtin_amdgcn_readfirstlane(tid >> 6);
    const unsigned lb = (unsigned)(size_t)lds;
    const int r32 = lane & 31, hh = lane >> 5, q4 = (lane & 15) >> 2, p4 = lane & 3, blk = (lane >> 4) & 1;
    LAS unsigned char* kbase = lds + (r32 & 15) * AT_KPS + ((r32 >> 4) & 1) * 512 + hh * 16;
    unsigned vbase = lb + (unsigned)(4 * hh + q4) * (unsigned)AT_VPS + (unsigned)(16 * blk + 4 * p4) * 2u;
    unsigned lane_off = (unsigned)((lane >> 5) * 16 * 8192 + (lane & 31) * 16);
    asm volatile("" : "+v"(kbase), "+v"(vbase), "+v"(lane_off));
    const char* kvb = (const char*)KV;
    const int nun = (bid < 256) ? 4 * ((256 - bid + G - 1) / G) : 0;
#define AT_SRC(N, ST) ((int)((((size_t)(((bid + ((N) >> 2) * G) >> 5) * NMEM) * 4096 + layer * 2048 + ((N) & 3) * 256 + (((ST) >> 2) * 1024)) * 2) + ((ST) & 3) * 64 * 8192))
    __syncthreads();
    if (nun > 0) { attn_dma(lb, kvb, AT_SRC(0, 0), lane_off, 0, AT_KPS, wave); attn_dma(lb, kvb, AT_SRC(0, 1), lane_off, 1, AT_KPS, wave); AT_WAITBAR(4); }
    int sl = 0;
    for (int n = 0; n < nun; ++n) {
        const int pan = bid + (n >> 2) * G, h = n & 3, b = pan >> 5, qt = pan & 31;
        int ln_ = pg8::lane_id(); asm volatile("" : "+v"(ln_));
        const unsigned qoff = (unsigned)((wave * 8 * 64 + ln_) * 16);
        const char* qbase = (const char*)Q + (size_t)(pan * 4 + h) * 65536;
        char* obase = (char*)O + ((size_t)b * SEQ + qt * 256) * D + h * 256;
        const bool more = (n + 1 < nun);
        bf16x8 qf[16];
#pragma unroll
        for (int s = 0; s < 8; ++s) { const u32x4 raw = *(const GAS u32x4*)(qbase + qoff + 1024 * s); float f[8]; u32x2 h8;
            h8.x = raw.x; h8.y = raw.y; unpack8f8(h8, f);
#pragma unroll
            for (int i = 0; i < 8; ++i) f[i] *= (1.0f / pg8::F8_SQ);
            qf[s] = __builtin_bit_cast(bf16x8, pack8(f));
            h8.x = raw.z; h8.y = raw.w; unpack8f8(h8, f);
#pragma unroll
            for (int i = 0; i < 8; ++i) f[i] *= (1.0f / pg8::F8_SQ);
            qf[s + 8] = __builtin_bit_cast(bf16x8, pack8(f)); }
        float ml = 0.f, lsum = 0.f;
        bf16x8 pk[8][2];
#pragma unroll
        for (int st = 0; st < 4; ++st) {
            const int sl2 = (sl >= 1) ? sl - 1 : 2;
            if (st > 0) attn_dma(lb, kvb, AT_SRC(n, st + 2), lane_off, sl2, (st + 2 < 4) ? AT_KPS : AT_VPS, wave);
            LAS unsigned char* kb = kbase + sl * AT_SLOT;
            f32x16 sa[2];
#pragma unroll
            for (int kt = 0; kt < 2; ++kt)
#pragma unroll
                for (int r = 0; r < 16; ++r) sa[kt][r] = 0.f;
            bf16x8 kfa[2], kfb[2];
#define AT_KLD(dst, S0) do { _Pragma("unroll") for (int kt = 0; kt < 2; ++kt) dst[kt] = *(const LAS bf16x8*)(kb + kt * 16 * AT_KPS + 32 * (S0)); } while (0)
#define AT_KMM(src, S0) do { _Pragma("unroll") for (int kt = 0; kt < 2; ++kt) sa[kt] = __builtin_amdgcn_mfma_f32_32x32x16_bf16(src[kt], qf[(S0)], sa[kt], 0, 0, 0); } while (0)
            AT_KLD(kfa, 0); __builtin_amdgcn_sched_barrier(0);
#pragma unroll
            for (int bq = 0; bq < 8; ++bq) {
                AT_KLD(kfb, 2 * bq + 1); __builtin_amdgcn_sched_barrier(0);
                AT_KMM(kfa, 2 * bq); __builtin_amdgcn_sched_barrier(0);
                if (bq < 7) { AT_KLD(kfa, 2 * bq + 2); __builtin_amdgcn_sched_barrier(0); }
                AT_KMM(kfb, 2 * bq + 1); __builtin_amdgcn_sched_barrier(0);
            }
#undef AT_KLD
#undef AT_KMM
            if (st == 0) attn_dma(lb, kvb, AT_SRC(n, 2), lane_off, sl2, AT_KPS, wave);
            if (st == 0) { float mx = -3.0e38f;
#pragma unroll
                for (int kt = 0; kt < 2; ++kt)
#pragma unroll
                    for (int r = 0; r < 16; ++r) mx = __builtin_fmaxf(mx, sa[kt][r]);
                mx = __builtin_fmaxf(mx, shx(mx, 32, lane)); ml = mx * LOG2E; }
#pragma unroll
            for (int kt = 0; kt < 2; ++kt) {
                float p[16];
#pragma unroll
                for (int r = 0; r < 16; ++r) { p[r] = __builtin_amdgcn_exp2f(sa[kt][r] * LOG2E - ml); lsum += p[r]; }
#pragma unroll
                for (int s2 = 0; s2 < 2; ++s2) { u32x4 w; w.x = pk2(p[8 * s2 + 0], p[8 * s2 + 1]); w.y = pk2(p[8 * s2 + 2], p[8 * s2 + 3]); w.z = pk2(p[8 * s2 + 4], p[8 * s2 + 5]); w.w = pk2(p[8 * s2 + 6], p[8 * s2 + 7]);
                    pk[2 * st + kt][s2] = __builtin_bit_cast(bf16x8, w); }
            }
            AT_WAITBAR(4);
            sl = (sl == 2) ? 0 : sl + 1;
        }
        lsum += shx(lsum, 32, lane);
        f32x16 oacc[8];
#pragma unroll
        for (int dt = 0; dt < 8; ++dt)
#pragma unroll
            for (int r = 0; r < 16; ++r) oacc[dt][r] = 0.f;
#pragma unroll
        for (int st = 4; st < 8; ++st) {
            const bool issue = (st < 6) || more;
            if (issue) { const int s2 = (sl >= 1) ? sl - 1 : 2;
                if (st < 6) attn_dma(lb, kvb, AT_SRC(n, st + 2), lane_off, s2, AT_VPS, wave); else attn_dma(lb, kvb, AT_SRC(n + 1, st - 6), lane_off, s2, AT_KPS, wave); }
            const unsigned vb = vbase + (unsigned)(sl * AT_SLOT);
            bf16x8 vfa[2], vfb[2];
#define AT_VLD(dst, BT) do { const unsigned va_ = vb + (unsigned)((((BT) >> 3) & 1) * 16 * AT_VPS + (((BT) >> 2) & 1) * 512 + ((BT) & 3) * 128); \
                _Pragma("unroll") for (int d_ = 0; d_ < 2; ++d_) dst[d_] = cat8(vtr(va_ + 64u * d_), vtr(va_ + 64u * d_ + 8u * AT_VPS)); } while (0)
#define AT_VMM(src, BT) do { _Pragma("unroll") for (int d_ = 0; d_ < 2; ++d_) oacc[2 * ((BT) & 3) + d_] = __builtin_amdgcn_mfma_f32_32x32x16_bf16(src[d_], pk[2 * (st - 4) + (((BT) >> 3) & 1)][((BT) >> 2) & 1], oacc[2 * ((BT) & 3) + d_], 0, 0, 0); } while (0)
            AT_VLD(vfa, 0); __builtin_amdgcn_sched_barrier(0);
#pragma unroll
            for (int bq = 0; bq < 8; ++bq) {
                AT_VLD(vfb, 2 * bq + 1); __builtin_amdgcn_sched_barrier(0);
                AT_VMM(vfa, 2 * bq); __builtin_amdgcn_sched_barrier(0);
                if (bq < 7) { AT_VLD(vfa, 2 * bq + 2); __builtin_amdgcn_sched_barrier(0); }
                AT_VMM(vfb, 2 * bq + 1); __builtin_amdgcn_sched_barrier(0);
            }
#undef AT_VLD
#undef AT_VMM
            if (issue) AT_WAITBAR(4); else AT_WAITBAR(0);
            sl = (sl == 2) ? 0 : sl + 1;
        }
        const float inv = 1.0f / lsum;
        int ln2 = pg8::lane_id(); asm volatile("" : "+v"(ln2));
        GAS char* op = (GAS char*)obase + (unsigned)((wave * 32 + (ln2 & 31)) * D) + ((ln2 >> 5) ? 16 : 0);
        const float sc = inv * pg8::F8_SO;
#pragma unroll
        for (int dt = 0; dt < 8; ++dt) {
            unsigned dw[4];
#pragma unroll
            for (int g4 = 0; g4 < 4; ++g4) dw[g4] = pg8::pk4f8(oacc[dt][4 * g4 + 0] * sc, oacc[dt][4 * g4 + 1] * sc, oacc[dt][4 * g4 + 2] * sc, oacc[dt][4 * g4 + 3] * sc);
            { const auto r = __builtin_amdgcn_permlane32_swap(dw[0], dw[2], false, false); dw[0] = r[0]; dw[2] = r[1]; }
            { const auto r = __builtin_amdgcn_permlane32_swap(dw[1], dw[3], false, false); dw[1] = r[0]; dw[3] = r[1]; }
            u32x4 w; w.x = dw[0]; w.y = dw[2]; w.z = dw[1]; w.w = dw[3];
            *(GAS u32x4*)(op + 32 * dt) = w; }
    }
    asm volatile("s_waitcnt vmcnt(0)" ::: "memory");
    __syncthreads();
}
#undef AT_SRC
#undef AT_WAITBAR

constexpr int RT_WH = 0, RT_WL = 32768, RT_SEL = 65536, RT_RK = 66048, RT_CNTW = 67072, RT_WBASE = 67584, RT_CS = 68608, RT_BB = 68672, RT_PART = 68736;
template <int MODE>
__device__ __forceinline__ void ln_phase(LAS unsigned char* lds, const Args& a, int l, int lnidx, bool last, bf16_t* Xout, int bid, int G, int wave_s) {
    int tid_ = wave_s * 64 + pg8::lane_id(); asm volatile("" : "+v"(tid_)); const int tid = tid_, lane = tid & 63, wave = __builtin_amdgcn_readfirstlane(tid >> 6);
    constexpr int R = (MODE == 2) ? 2 : 4;
    unsigned char* ws = a.ws;
    const bf16_t* Z = (const bf16_t*)(ws + WS_R + R_Z); const unsigned char* Ys8 = ws + WS_R + R_XS;
    pg8::f32x2_t* stats1 = (pg8::f32x2_t*)(ws + WS_STATS);
    const float* gp = a.in[20] + (size_t)(l * 3 + lnidx) * D; const float* bp = a.in[21] + (size_t)(l * 3 + lnidx) * D;
    float gg[16], bb[16];
#pragma unroll
    for (int j = 0; j < 2; ++j)
#pragma unroll
        for (int i = 0; i < 8; ++i) { gg[8 * j + i] = gp[8 * lane + 512 * j + i]; bb[8 * j + i] = bp[8 * lane + 512 * j + i]; }
    float g1v[16], b1v[16];
    if (MODE == 2) { const float* gq = a.in[20] + (size_t)(l * 3 + 1) * D; const float* bq_ = a.in[21] + (size_t)(l * 3 + 1) * D;
#pragma unroll
        for (int j = 0; j < 2; ++j)
#pragma unroll
            for (int i = 0; i < 8; ++i) { g1v[8 * j + i] = gq[8 * lane + 512 * j + i]; b1v[8 * j + i] = bq_[8 * lane + 512 * j + i]; } }
    if (MODE == 1) {
        __syncthreads();
        for (int idx = tid; idx < 2048; idx += NTHR) { const int s = idx >> 6, ln = idx & 63, e = ln & 15, g = ln >> 4; float hi[8], lo[8];
#pragma unroll
            for (int j = 0; j < 8; ++j) { const float w = a.in[15][(32 * s + 8 * g + j) * 16 + e] * gp[32 * s + 8 * g + j]; const float h = bflo(pk2(w, 0.f) & 0xffffu); hi[j] = h; lo[j] = w - h; }
            *(LAS u32x4*)(lds + RT_WH + idx * 16) = pack8(hi); *(LAS u32x4*)(lds + RT_WL + idx * 16) = pack8(lo); }
        { const int e = tid & 15, kp = tid >> 4; float cs = 0.f, bs = 0.f;
          for (int k = 32 * kp; k < 32 * kp + 32; ++k) { const float wr = a.in[15][k * 16 + e]; const float w = wr * gp[k]; const float h = bflo(pk2(w, 0.f) & 0xffffu); const float lo2 = bflo(pk2(w - h, 0.f) & 0xffffu); cs += h + lo2; bs += bp[k] * wr; }
          ((LAS float*)(lds + RT_PART))[kp * 32 + e] = cs; ((LAS float*)(lds + RT_PART))[kp * 32 + 16 + e] = bs; }
        __syncthreads();
        if (tid < 32) { float t = 0.f; for (int kp = 0; kp < 32; ++kp) t += ((LAS float*)(lds + RT_PART))[kp * 32 + tid];
            if (tid < 16) ((LAS float*)(lds + RT_CS))[tid] = t; else ((LAS float*)(lds + RT_BB))[tid - 16] = t + a.in[16][tid - 16]; }
        __syncthreads();
    }
    for (int blk = bid; blk < 256; blk += G) {
        int run[16];
#pragma unroll
        for (int e = 0; e < 16; ++e) run[e] = 0;
        u32x4 pa_[R][2]; u32x2 pb_[R][2], pc_[R][2]; float pw0[R], pw1[R]; pg8::f32x2_t pst[R];
#define LN_LOAD(ROW0) do { _Pragma("unroll") for (int r = 0; r < R; ++r) { const size_t row = (ROW0) + r; \
            if (MODE == 2) { const int* ts = (const int*)(ws + WS_TSLOT) + row * 2; const float* ti = (const float*)(ws + WS_TINFO) + row * 4; const int s0 = ts[0], s1 = ts[1]; pw0[r] = ti[2]; pw1[r] = ti[3]; pst[r] = stats1[row]; \
                _Pragma("unroll") for (int j = 0; j < 2; ++j) { pa_[r][j] = *(const u32x4*)(Z + row * D + 8 * lane + 512 * j); pb_[r][j] = *(const u32x2*)(Ys8 + (size_t)s0 * D + 8 * lane + 512 * j); pc_[r][j] = *(const u32x2*)(Ys8 + (size_t)s1 * D + 8 * lane + 512 * j); } } \
            else { _Pragma("unroll") for (int j = 0; j < 2; ++j) pa_[r][j] = *(const u32x4*)(Z + row * D + 8 * lane + 512 * j); } } } while (0)
        float mu_t = 0.f, rs_t = 0.f;
        LN_LOAD((size_t)blk * 256 + wave * 32);
        for (int ri = 0; ri < 32; ri += R) {
            const int rl0 = wave * 32 + ri; const size_t row0 = (size_t)blk * 256 + rl0;
            float v[R][16];
#pragma unroll
            for (int r = 0; r < R; ++r)
#pragma unroll
                for (int j = 0; j < 2; ++j) { float x[8]; unpack8(pa_[r][j], x);
                    if (MODE == 2) { float y0[8], y1[8]; unpack8f8(pb_[r][j], y0); unpack8f8(pc_[r][j], y1); const float mu1 = pst[r][0], rs1 = pst[r][1];
#pragma unroll
                        for (int i = 0; i < 8; ++i) v[r][8 * j + i] = ALPHA * ((x[i] - mu1) * rs1 * g1v[8 * j + i] + b1v[8 * j + i]) + (pw0[r] * (1.0f / pg8::F8_SY)) * y0[i] + (pw1[r] * (1.0f / pg8::F8_SY)) * y1[i]; }
                    else {
#pragma unroll
                        for (int i = 0; i < 8; ++i) v[r][8 * j + i] = x[i]; } }
            if (ri + R < 32) LN_LOAD(row0 + R);
            float s[R];
#pragma unroll
            for (int r = 0; r < R; ++r) { s[r] = 0.f;
#pragma unroll
                for (int i = 0; i < 16; ++i) s[r] += v[r][i]; }
#pragma unroll
            for (int o = 1; o < 64; o <<= 1)
#pragma unroll
                for (int r = 0; r < R; ++r) s[r] += shx(s[r], o, lane);
            float qq[R], mur[R];
#pragma unroll
            for (int r = 0; r < R; ++r) { const float mu = s[r] * (1.0f / D); mur[r] = mu; qq[r] = 0.f;
#pragma unroll
                for (int i = 0; i < 16; ++i) { v[r][i] -= mu; qq[r] += v[r][i] * v[r][i]; } }
#pragma unroll
            for (int o = 1; o < 64; o <<= 1)
#pragma unroll
                for (int r = 0; r < R; ++r) qq[r] += shx(qq[r], o, lane);
#pragma unroll
            for (int r = 0; r < R; ++r) { const float rs = __builtin_amdgcn_rsqf(qq[r] * (1.0f / D) + LN_EPS);
                if (MODE == 1) { if (lane == 0) stats1[row0 + r] = (pg8::f32x2_t){mur[r], rs};
                    if ((lane & 15) == ((ri + r) & 15)) { mu_t = mur[r]; rs_t = rs; } }
#pragma unroll
                for (int i = 0; i < 16; ++i) v[r][i] = v[r][i] * rs * gg[i] + bb[i]; }
#pragma unroll
            for (int r = 0; r < R; ++r) { const size_t row = row0 + r;
                if (MODE == 2 && last) {
#pragma unroll
                    for (int j = 0; j < 2; ++j) { float* op = a.out + row * D + 8 * lane + 512 * j;
                        *(f32x4*)op = (f32x4){v[r][8 * j], v[r][8 * j + 1], v[r][8 * j + 2], v[r][8 * j + 3]}; *(f32x4*)(op + 4) = (f32x4){v[r][8 * j + 4], v[r][8 * j + 5], v[r][8 * j + 6], v[r][8 * j + 7]}; }
                } else {
#pragma unroll
                    for (int j = 0; j < 2; ++j) { float f[8];
#pragma unroll
                        for (int i = 0; i < 8; ++i) f[i] = v[r][8 * j + i];
                        if (MODE != 1) *(u32x4*)(Xout + row * D + 8 * lane + 512 * j) = pack8(f);
                        if (MODE == 1 || MODE == 2) { u32x2 q8; q8.x = pg8::pk4f8(f[0] * pg8::F8_SX, f[1] * pg8::F8_SX, f[2] * pg8::F8_SX, f[3] * pg8::F8_SX); q8.y = pg8::pk4f8(f[4] * pg8::F8_SX, f[5] * pg8::F8_SX, f[6] * pg8::F8_SX, f[7] * pg8::F8_SX);
                            *(u32x2*)(ws + (MODE == 1 ? WS_R + R_X8 : WS_X8IN) + row * D + 8 * lane + 512 * j) = q8; } }
                } }
            if (MODE == 1 && ((ri + R) & 15) == 0) {
                const int tok = lane & 15, g = lane >> 4, tl = rl0 + R - 16 + tok; const size_t token = (size_t)blk * 256 + tl;
                const bf16_t* xr = Z + token * D + 8 * g;
                f32x4 acc = (f32x4){0.f, 0.f, 0.f, 0.f};
#pragma unroll 8
                for (int ks = 0; ks < 32; ++ks) { const bf16x8 xb = *(const bf16x8*)(xr + 32 * ks);
                    const bf16x8 wh = *(const LAS bf16x8*)(lds + RT_WH + (ks * 64 + lane) * 16), wl = *(const LAS bf16x8*)(lds + RT_WL + (ks * 64 + lane) * 16);
                    acc = __builtin_amdgcn_mfma_f32_16x16x32_bf16(wh, xb, acc, 0, 0, 0); acc = __builtin_amdgcn_mfma_f32_16x16x32_bf16(wl, xb, acc, 0, 0, 0); }
                const f32x4 csv = *(const LAS f32x4*)(lds + RT_CS + 16 * g), bbv = *(const LAS f32x4*)(lds + RT_BB + 16 * g);
                float lg[4] = {rs_t * (acc[0] - mu_t * csv[0]) + bbv[0], rs_t * (acc[1] - mu_t * csv[1]) + bbv[1], rs_t * (acc[2] - mu_t * csv[2]) + bbv[2], rs_t * (acc[3] - mu_t * csv[3]) + bbv[3]};
                float m = __builtin_fmaxf(__builtin_fmaxf(lg[0], lg[1]), __builtin_fmaxf(lg[2], lg[3]));
                m = __builtin_fmaxf(m, shx(m, 16, lane)); m = __builtin_fmaxf(m, shx(m, 32, lane));
                float t1 = -1.f, t2 = -1.f; int i1 = 0, i2 = 0;
#pragma unroll
                for (int r = 0; r < 4; ++r) { const float p = __expf(lg[r] - m); if (p > t1) { t2 = t1; i2 = i1; t1 = p; i1 = r; } else if (p > t2) { t2 = p; i2 = r; } }
                const float gs = t1 + t2; float bgs = gs; int bg = g;
                { const float o = shx(bgs, 16, lane); const int og = shxi(bg, 16, lane); if (o > bgs || (o == bgs && og < bg)) { bgs = o; bg = og; } }
                { const float o = shx(bgs, 32, lane); const int og = shxi(bg, 32, lane); if (o > bgs || (o == bgs && og < bg)) { bgs = o; bg = og; } }
                const bool mine = (bg == g); const int e0 = 4 * g + i1, e1 = 4 * g + i2;
                if (mine) { u32x4 info; info.x = (unsigned)e0; info.y = (unsigned)e1; info.z = __builtin_bit_cast(unsigned, t1 / gs); info.w = __builtin_bit_cast(unsigned, t2 / gs);
                    *(u32x4*)(ws + WS_TINFO + token * 16) = info; ((LAS unsigned short*)(lds + RT_SEL))[tl] = (unsigned short)(e0 | (e1 << 8)); }
                const unsigned long long below = (1ull << lane) - 1ull; int r0 = 0, r1 = 0;
#pragma unroll
                for (int e = 0; e < 16; ++e) { const bool hit = mine && (e0 == e || e1 == e); const unsigned long long mb = __ballot(hit); const int cb = __popcll(mb & below);
                    r0 = (e0 == e) ? run[e] + cb : r0; r1 = (e1 == e) ? run[e] + cb : r1; run[e] += __popcll(mb); }
                if (mine) { ((LAS unsigned short*)(lds + RT_RK))[2 * tl] = (unsigned short)r0; ((LAS unsigned short*)(lds + RT_RK))[2 * tl + 1] = (unsigned short)r1; }
            }
        }
        if (MODE == 1) {
            { int vsel = 0;
#pragma unroll
              for (int e = 0; e < 16; ++e) vsel = (lane == e) ? run[e] : vsel;
              if (lane < 16) ((LAS int*)(lds + RT_CNTW))[wave * 16 + lane] = vsel; }
            __syncthreads();
            if (tid < 16) { int base = 0;
#pragma unroll
                for (int w = 0; w < 8; ++w) { const int t = ((LAS int*)(lds + RT_CNTW))[w * 16 + tid]; ((LAS int*)(lds + RT_WBASE))[w * 16 + tid] = base; base += t; }
                ((int*)(ws + WS_WGCNT))[blk * 16 + tid] = base; }
            __syncthreads();
            { const int t = tid >> 1, k = tid & 1; const int e = (((LAS unsigned short*)(lds + RT_SEL))[t] >> (8 * k)) & 255;
              ((int*)(ws + WS_TRANK))[(size_t)blk * 512 + tid] = (int)((LAS unsigned short*)(lds + RT_RK))[tid] + ((LAS int*)(lds + RT_WBASE))[(t >> 5) * 16 + e]; }
            __syncthreads();
        }
    }
}

#undef LN_LOAD
constexpr int MG_TBL = 0, MG_TOT = 16384, MG_PRE = 16448, MG_BASE = 16512;
__device__ __forceinline__ void moe_gather_phase(LAS unsigned char* lds, unsigned char* ws, int bid, int G, int wave_s) {
    int tid_ = wave_s * 64 + pg8::lane_id(); asm volatile("" : "+v"(tid_)); const int tid = tid_, lane = tid & 63, wave = __builtin_amdgcn_readfirstlane(tid >> 6);
    LAS int* tbl = (LAS int*)(lds + MG_TBL); LAS int* tot = (LAS int*)(lds + MG_TOT); LAS int* pre = (LAS int*)(lds + MG_PRE); LAS int* base = (LAS int*)(lds + MG_BASE);
    LAS int* offs = (LAS int*)(lds + MISC_OFF) + 16; LAS int* tile_e = (LAS int*)(lds + TILEE_OFF);
    const bf16_t* X = (const bf16_t*)(ws + WS_X); bf16_t* Xs = (bf16_t*)(ws + WS_R + R_XS);
    for (int blk = bid; blk < 256; blk += G) {
        __syncthreads();
        for (int i = tid; i < 4096; i += NTHR) tbl[i] = ((const int*)(ws + WS_WGCNT))[i];
        __syncthreads();
        if (tid < 16) { int t = 0, p = 0; for (int c = 0; c < 256; ++c) { const int v = tbl[c * 16 + tid]; p += (c < blk) ? v : 0; t += v; } tot[tid] = t; pre[tid] = p; }
        __syncthreads();
        if (tid == 0) { int o = 0; for (int e = 0; e < 16; ++e) { offs[e] = o; base[e] = o + pre[e]; o += (tot[e] + 255) & ~255; } offs[16] = o; offs[17] = o >> 8; }
        __syncthreads();
        for (int rt = tid; rt < 528; rt += NTHR) { int e = 0;
#pragma unroll
            for (int q = 1; q < 16; ++q) e = (rt * 256 >= offs[q]) ? q : e;
            tile_e[rt] = e; }
        { const size_t tok = (size_t)blk * 256 + (tid >> 1); const int k = tid & 1;
          const int e = ((const int*)(ws + WS_TINFO))[tok * 4 + k]; const int rk = ((const int*)(ws + WS_TRANK))[tok * 2 + k];
          const int slot = base[e] + rk;
          ((int*)(ws + WS_TSLOT))[tok * 2 + k] = slot; ((int*)(ws + WS_SRCROW))[slot] = (int)tok; }
        for (int e = wave; e < 16; e += NWAVES) { const int npad = offs[e + 1] - offs[e] - tot[e];
            if (blk < npad && lane == 0) ((int*)(ws + WS_SRCROW))[offs[e] + tot[e] + blk] = 0; }
    }
}

#define GEMM_ALIGN true
#define GEMM_SP2 true
__global__ void __launch_bounds__(NTHR, 2) mk_fwd(Args args) {
    extern __shared__ __attribute__((aligned(16))) unsigned char lds_raw[];
    LAS unsigned char* lds = (LAS unsigned char*)lds_raw;
    const int tid = threadIdx.x; const int wave_s = __builtin_amdgcn_readfirstlane(tid >> 6);
    const int G = gridDim.x, bid = blockIdx.x;
    unsigned char* ws = args.ws;
    volatile LAS unsigned* MISC = (volatile LAS unsigned*)(lds + MISC_OFF);
    for (int u = tid; u < (LDS_BYTES - LDSCTL_OFF) / 4; u += NTHR) ((LAS unsigned*)(lds + LDSCTL_OFF))[u] = 0u;
    __syncthreads();
    XcdBarrier bar = xcd_barrier_post((unsigned*)(ws + WS_CTL) + CW_BAR, MISC + 8);
    bar.wv = wave_s;
#define GRID_BAR() xcd_barrier(bar)
#ifndef REP_MASK
#define REP_MASK 0
#endif
#define LOCAL_SYNC() do { asm volatile("s_waitcnt vmcnt(0)" ::: "memory"); __syncthreads(); } while (0)
#define PHASE(grp, ...) do { __VA_ARGS__; if (REP_MASK & (1 << (grp))) { GRID_BAR(); __VA_ARGS__; } } while (0)

#define WSQ ({ unsigned char* w_ = args.ws; asm volatile("" : "+s"(w_)); w_; })
#define X ((bf16_t*)(WSQ + WS_X))
#define P ((bf16_t*)(WSQ + WS_R + R_P))
#define Y ((bf16_t*)(WSQ + WS_R + R_Y))
#define Z ((bf16_t*)(WSQ + WS_R + R_Z))
#define Qb ((bf16_t*)(WSQ + WS_R + R_Q))
#define Ob ((bf16_t*)(WSQ + WS_R + R_O))
#define Xs ((bf16_t*)(WSQ + WS_R + R_XS))
#define Hb ((bf16_t*)(WSQ + WS_R + R_H))
#define KV ((bf16_t*)(WSQ + WS_KV))
#define wl (WSQ + WS_W + (size_t)l * W_LAYER)

    PHASE(0, p0_convert(args, lds, bid, G, wave_s));
    GRID_BAR();
    { const int tid_r = wave_s * 64 + pg8::lane_id();
      for (int i = bid * NTHR + tid_r; i < 2 * 2 * 1024; i += G * NTHR) { const int l = i >> 11, w = (i >> 10) & 1, n = i & 1023; const float* tb = (const float*)(WSQ + WS_CS) + (size_t)l * 2 * 16 * 1024 + w * 16 * 1024; float s = 0.f;
#pragma unroll
          for (int kc = 0; kc < 16; ++kc) s += tb[kc * 1024 + n];
          ((float*)(WSQ + WS_CS) + 65536)[i] = s; } }
    PHASE(1, { pg8::Gemm g{(const bf16_t*)(WSQ + WS_MEMB), (const bf16_t*)(WSQ + WS_WKV), MKV, 4096, D, wave_s}; pg8::StaticOrder S; S.init(MKV, 4096, G, bid);
      pg8::EpiPlain E{KV, 4096, 0xffff};
      pg8::gemm_phase<pg8::EpiPlain, pg8::StaticOrder, GEMM_ALIGN, GEMM_SP2>(lds, g, S, E); });

#pragma unroll 1
    for (int l = 0; l < 2; ++l) {
        PHASE(1, { pg8::Gemm g{(const bf16_t*)(WSQ + WS_X8IN), (const bf16_t*)(wl + W_IN), M, NP, D / 2, wave_s}; pg8::StaticOrder S; S.init(M, NP, G, bid);
          pg8::EpiInProj8 E{P, args.in[4] + l * 256};
          pg8::gemm_phase<pg8::EpiInProj8, pg8::StaticOrder, GEMM_ALIGN, GEMM_SP2>(lds, g, S, E); });
        GRID_BAR();
        PHASE(3, gla_phase<false>(lds, P, (float*)(WSQ + WS_SEND), (float*)(WSQ + WS_LTOT), Y, args.in[5] + l * 512, bid, G, wave_s));
        PHASE(4, sgu_phase(lds, P, (const bf16_t*)(WSQ + WS_WM) + (size_t)l * 4 * 128 * 128, args.in[7] + l * 512, args.in[8] + l * 512, args.in[9] + l * 512, Y, bid, G, wave_s));
        GRID_BAR();
        PHASE(3, gla_phase<true>(lds, P, (float*)(WSQ + WS_SEND), (float*)(WSQ + WS_LTOT), Y, args.in[5] + l * 512, bid, G, wave_s));
        GRID_BAR();
        PHASE(10, { pg8::Gemm g{Y, (const bf16_t*)(wl + W_OUT), M, D, D / 2, wave_s}; pg8::PanelOrder S{4, M / 256, G, bid};
          pg8::EpiResidStats8 E{X, Z, (pg8::f32x2_t*)(WSQ + WS_PART), WSQ + WS_R + R_X8};
          pg8::gemm_phase<pg8::EpiResidStats8, pg8::PanelOrder, GEMM_ALIGN, GEMM_SP2>(lds, g, S, E); });
        { const int tid_r = wave_s * 64 + pg8::lane_id();
          for (int pan = bid; pan < 256; pan += G) if (tid_r < 256) { const size_t row = (size_t)pan * 256 + tid_r; const pg8::f32x2_t* pp = (const pg8::f32x2_t*)(WSQ + WS_PART) + row * 16; float s1 = 0.f, s2 = 0.f;
#pragma unroll
              for (int q = 0; q < 16; ++q) { const pg8::f32x2_t v = pp[q]; s1 += v[0]; s2 += v[1]; }
              const float mu = s1 * (1.0f / D), var = s2 * (1.0f / D) - mu * mu; ((pg8::f32x2_t*)(WSQ + WS_STATS))[row] = (pg8::f32x2_t){mu, __builtin_amdgcn_rsqf(var + LN_EPS)}; } }
        LOCAL_SYNC();
        PHASE(10, { pg8::Gemm g{(const bf16_t*)(WSQ + WS_R + R_X8), (const bf16_t*)(wl + W_Q), M, D, D / 2, wave_s}; pg8::PanelOrder S{4, M / 256, G, bid};
          pg8::EpiQFragLN8 E{(unsigned char*)Qb, (const pg8::f32x2_t*)(WSQ + WS_STATS), (const float*)(WSQ + WS_CS) + 65536 + l * 2048, (const float*)(WSQ + WS_CS) + 65536 + l * 2048 + 1024};
          pg8::gemm_phase<pg8::EpiQFragLN8, pg8::PanelOrder, GEMM_ALIGN, GEMM_SP2>(lds, g, S, E); });
        PHASE(5, attn_phase(lds, Qb, KV, Ob, l, bid, G, wave_s));
        LOCAL_SYNC();
        PHASE(10, { pg8::Gemm g{Ob, (const bf16_t*)(wl + W_O), M, D, D / 2, wave_s}; pg8::PanelOrder S{4, M / 256, G, bid};
          pg8::EpiResidLN8 E{Z, (const pg8::f32x2_t*)(WSQ + WS_STATS), args.in[20] + (size_t)(l * 3) * D, args.in[21] + (size_t)(l * 3) * D};
          pg8::gemm_phase<pg8::EpiResidLN8, pg8::PanelOrder, GEMM_ALIGN, GEMM_SP2>(lds, g, S, E); });
        PHASE(9, ln_phase<1>(lds, args, l, 1, false, X, bid, G, wave_s));
        GRID_BAR();
        PHASE(7, moe_gather_phase(lds, WSQ, bid, G, wave_s));
        GRID_BAR();
        PHASE(2, { pg8::Gemm g{(const bf16_t*)(WSQ + WS_R + R_X8), (const bf16_t*)(wl + W_GU), MOE_ROWS, 16384, D / 2, wave_s}; pg8::MoeGatherOrder S{(const LAS int*)(lds + TILEE_OFF), (int)MISC[33] * 4, G, bid, (const int*)(WSQ + WS_SRCROW)};
          pg8::EpiGU8 E{(unsigned char*)Hb};
          pg8::gemm_phase<pg8::EpiGU8, pg8::MoeGatherOrder, GEMM_ALIGN, GEMM_SP2>(lds, g, S, E); });
        GRID_BAR();
        PHASE(2, { pg8::Gemm g{Hb, (const bf16_t*)(wl + W_D), MOE_ROWS, 16384, 256, wave_s}; pg8::MoeOrder S{(const LAS int*)(lds + TILEE_OFF), (int)MISC[33] * 4, G, bid};
          pg8::EpiPlain8 E{(unsigned char*)Xs, D, 3};
          pg8::gemm_phase<pg8::EpiPlain8, pg8::MoeOrder, GEMM_ALIGN, GEMM_SP2>(lds, g, S, E); });
        GRID_BAR();
        if (REP_MASK & (1 << 8)) { ln_phase<2>(lds, args, l, 2, l == 1, Z, bid, G, wave_s); GRID_BAR(); }
        ln_phase<2>(lds, args, l, 2, l == 1, X, bid, G, wave_s);
        if (l == 0) GRID_BAR();
    }
}
#undef X
#undef P
#undef Y
#undef Z
#undef Qb
#undef Ob
#undef Xs
#undef Hb
#undef KV
#undef wl
}

extern "C" void kernel_launch(void* const* d_in, const int* in_sizes, int n_in, void* d_out, int out_size, void* d_ws, size_t ws_size, hipStream_t stream) {
    using namespace mk;
    static int grid = 0;
    if (grid == 0) {
        if (n_in != 22 || in_sizes[0] != M * D || out_size != M * D || ws_size < WS_END) { fprintf(stderr, "kernel_launch: unexpected shapes (n_in %d, in0 %d, out %d, ws %zu, need %zu)\n", n_in, n_in > 0 ? in_sizes[0] : -1, out_size, ws_size, (size_t)WS_END); grid = -1; return; }
        int dev = 0, cus = 0;
        if (hipGetDevice(&dev) != hipSuccess || hipDeviceGetAttribute(&cus, hipDeviceAttributeMultiprocessorCount, dev) != hipSuccess) { grid = -1; return; }
        if (hipFuncSetAttribute((const void*)mk_fwd, hipFuncAttributeMaxDynamicSharedMemorySize, LDS_BYTES) != hipSuccess) { fprintf(stderr, "kernel_launch: hipFuncSetAttribute failed\n"); grid = -1; return; }
        int per_cu = 0;
        if (hipOccupancyMaxActiveBlocksPerMultiprocessor(&per_cu, (const void*)mk_fwd, NTHR, LDS_BYTES) != hipSuccess || per_cu < 1) fprintf(stderr, "kernel_launch: occupancy query says %d\n", per_cu);
        (void)hipGetLastError();
        grid = cus;
        if (grid & 3) { fprintf(stderr, "kernel_launch: the spatial-gating phase needs a grid that is a multiple of 4 (found %d CUs); nothing launched\n", grid); grid = -1; return; }
    }
    if (grid < 0) return;
    if (hipMemsetAsync((char*)d_ws + WS_CTL, 0, CTL_ZERO_BYTES, stream) != hipSuccess) return;
    Args a{};
    for (int i = 0; i < 22; ++i) a.in[i] = (const float*)d_in[i];
    a.out = (float*)d_out; a.ws = (unsigned char*)d_ws;
    hipLaunchKernelGGL(mk_fwd, dim3(grid), dim3(NTHR), LDS_BYTES, stream, a);
}
```

```cpp
#include <hip/hip_runtime.h>
#include <cstdio>
#include <cstdint>

namespace pg8 {
#define PG8_LAS __attribute__((address_space(3)))
typedef unsigned short bf16_t;
typedef short bf16x8 __attribute__((ext_vector_type(8)));
typedef float f32x4 __attribute__((ext_vector_type(4)));
typedef unsigned u32x4 __attribute__((ext_vector_type(4)));
typedef unsigned u32x2 __attribute__((ext_vector_type(2)));
constexpr int BM = 256, BK = 64, HALF = 128, HTB = HALF * BK * 2  , STAGE_BYTES = 8 * HTB, NXCD = 8, WGM = 8;

__host__ __device__ __forceinline__ int lds_byte(int r, int c) { const int st = (r >> 4) * 2 + (c >> 5), rr = r & 15, cc = c & 31, ob = rr * 64 + cc * 2; return st * 1024 + (ob ^ (((ob >> 9) & 1) << 5)); }
__host__ __device__ __forceinline__ void stage_rc(int b, int& R, int& C) { const int st = b / 1024, sb = b % 1024, swz = sb ^ (((sb >> 9) & 1) << 5); R = (st >> 1) * 16 + swz / 64; C = (st & 1) * 32 + (swz % 64) / 2; }
__host__ __device__ __forceinline__ int perm32(int rho) { const int n = rho >> 4, i = rho & 15; return 8 * (i >> 2) + 4 * n + (i & 3); }

struct Unit { int pm, pn; };
struct Gemm { const bf16_t* A; const bf16_t* Bt; int M, N, K; int wv; };
__device__ __forceinline__ int lane_id() { int l; asm volatile("v_mbcnt_lo_u32_b32 %0, -1, 0\n\tv_mbcnt_hi_u32_b32 %0, -1, %0" : "=v"(l)); return l; }

struct StaticOrder {
    static constexpr bool GATHER = false;
    int nM, nN, nwg, G, c; const int* src = nullptr;
    __host__ __device__ void init(int M, int N, int G_, int c_) { nM = M / BM; nN = N / BM; nwg = nM * nN; G = G_; c = c_; }
    __host__ __device__ bool next(int i, Unit& u) const {
        const long L = (long)i * G + c; if (L >= nwg) return false;
        int wgid = (int)L; { const int q = nwg / NXCD, r = nwg % NXCD, xcd = wgid % NXCD, off = wgid / NXCD; wgid = (xcd < r ? xcd * (q + 1) : r * (q + 1) + (xcd - r) * q) + off; }
        const int nig = WGM * nN, gid = wgid / nig, fm = gid * WGM, gsz = (nM - fm) < WGM ? (nM - fm) : WGM;
        u.pm = fm + ((wgid % nig) % gsz); u.pn = (wgid % nig) / gsz; return true;
    }
    __device__ __forceinline__ void a_ready(const Unit&) const {}
    __device__ __forceinline__ void done(const Unit&) const {}
};
struct PanelOrder {
    static constexpr bool GATHER = false;
    int nN, npan, G, c; const int* src = nullptr;
    __device__ __forceinline__ bool next(int i, Unit& u) const { const int p = c + (i / nN) * G; if (p >= npan) return false; u.pm = p; u.pn = i % nN; return true; }
    __device__ __forceinline__ void a_ready(const Unit&) const {}
    __device__ __forceinline__ void done(const Unit&) const {}
};
template <bool GATH_> struct MoeOrderT {
    static constexpr bool GATHER = GATH_;
    const PG8_LAS int* tile_e; int nunits, G, c; const int* src = nullptr;
    __device__ __forceinline__ bool next(int i, Unit& u) const {
        const int cc = ((G & 7) == 0) ? (c & 7) * (G >> 3) + (c >> 3) : c;
        const int L = i * G + cc; if (L >= nunits) return false;
        u.pm = L >> 2; u.pn = tile_e[L >> 2] * 4 + (L & 3); return true;
    }
    __device__ __forceinline__ void a_ready(const Unit&) const {}
    __device__ __forceinline__ void done(const Unit&) const {}
};
typedef MoeOrderT<false> MoeOrder; typedef MoeOrderT<true> MoeGatherOrder;

typedef float f32x2_t __attribute__((ext_vector_type(2))); typedef __bf16 bf16x2_t __attribute__((ext_vector_type(2)));
typedef __amdgpu_buffer_rsrc_t rsrc_t;
__device__ __forceinline__ rsrc_t mk_rsrc(const void* p) { return __builtin_amdgcn_make_buffer_rsrc((void*)p, 0, 0x7fffffff, 0x00020000); }
__device__ __forceinline__ u32x4 bld4(rsrc_t r, unsigned voff, unsigned soff) { return __builtin_bit_cast(u32x4, __builtin_amdgcn_raw_buffer_load_b128(r, voff, soff, 0)); }
__device__ __forceinline__ f32x2_t bld2f(rsrc_t r, unsigned voff, unsigned soff) { return __builtin_bit_cast(f32x2_t, __builtin_amdgcn_raw_buffer_load_b64(r, voff, soff, 0)); }
#define GST4(p) (*(__attribute__((address_space(1))) u32x4*)(p))
__device__ __forceinline__ float f8clamp(float x) { return __builtin_fminf(__builtin_fmaxf(x, -448.0f), 448.0f); }
__device__ __forceinline__ unsigned pk4f8(float a, float b, float c, float d) { int w = 0; w = __builtin_amdgcn_cvt_pk_fp8_f32(f8clamp(a), f8clamp(b), w, false); w = __builtin_amdgcn_cvt_pk_fp8_f32(f8clamp(c), f8clamp(d), w, true); return (unsigned)w; }
__device__ __forceinline__ float f8round(float x) { const int w = __builtin_amdgcn_cvt_pk_fp8_f32(f8clamp(x), 0.0f, 0, false); return __builtin_amdgcn_cvt_pk_f32_fp8(w, false)[0]; }
constexpr float F8_SX = 4.0f, F8_SW = 64.0f, F8_SH = 8.0f, F8_SO = 64.0f, F8_SY = 16.0f, F8_SQ = 64.0f, F8_SM = 4.0f, F8_SZ = 4.0f;
__device__ __forceinline__ unsigned pk2(float lo, float hi) { f32x2_t v = {lo, hi}; bf16x2_t b = __builtin_convertvector(v, bf16x2_t); return __builtin_bit_cast(unsigned, b); }
__device__ __forceinline__ float bflo(unsigned w) { return __builtin_bit_cast(float, w << 16); }
__device__ __forceinline__ float bfhi(unsigned w) { return __builtin_bit_cast(float, w & 0xffff0000u); }
__device__ __forceinline__ float f_silu(float x) { return x * __builtin_amdgcn_rcpf(1.0f + __builtin_amdgcn_exp2f(-1.4426950408889634f * x)); }
__device__ __forceinline__ float f_gelu_tanh(float x) { return x * __builtin_amdgcn_rcpf(1.0f + __builtin_amdgcn_exp2f(x * (-2.3022082f - 0.10294324f * x * x))); }
__device__ __forceinline__ float f_logsig16(float z) { const float t = __builtin_amdgcn_exp2f(-1.4426950408889634f * __builtin_fabsf(z)); return (__builtin_fminf(z, 0.0f) - 0.6931471805599453f * __builtin_amdgcn_logf(1.0f + t)) * 0.0625f; }

struct EpiPlain {
    static constexpr bool PERM = true, AFTER_DRAIN = false;
    bf16_t* O; int ldc; int cmask;
    __device__ __forceinline__ void operator()(const f32x4 (&acc)[2][2][4][2], const Unit& u, int wr, int wc, int fr, int fq) const {
        const int row0 = u.pm * BM + wr * 64 + fr, col0 = (u.pn & cmask) * BM + wc * 32 + 8 * fq;
#pragma unroll
        for (int ai = 0; ai < 2; ++ai)
#pragma unroll
            for (int m = 0; m < 4; ++m) { bf16_t* rowp = O + (size_t)(row0 + ai * HALF + m * 16) * ldc + col0;
#pragma unroll
                for (int bj = 0; bj < 2; ++bj) { const f32x4 v0 = acc[ai][bj][m][0], v1 = acc[ai][bj][m][1];
                    u32x4 w; w.x = pk2(v0[0], v0[1]); w.y = pk2(v0[2], v0[3]); w.z = pk2(v1[0], v1[1]); w.w = pk2(v1[2], v1[3]);
                    *(u32x4*)(rowp + bj * HALF) = w; } }
    }
};
struct EpiQFrag {
    static constexpr bool PERM = true, AFTER_DRAIN = false;
    bf16_t* O;
    __device__ __forceinline__ void operator()(const f32x4 (&acc)[2][2][4][2], const Unit& u, int wr, int wc, int fr, int fq) const {
        unsigned lo = (unsigned)(((fq >> 1) * 64 + fr + 32 * (fq & 1)) * 16); asm volatile("" : "+v"(lo));
        char* tile = (char*)(O + (size_t)(u.pm * 4 + u.pn) * 65536) + (size_t)(wr * 2 * 16 + wc * 2) * 1024 + lo;
#pragma unroll
        for (int ai = 0; ai < 2; ++ai)
#pragma unroll
            for (int m = 0; m < 4; ++m)
#pragma unroll
                for (int bj = 0; bj < 2; ++bj) { const f32x4 v0 = acc[ai][bj][m][0], v1 = acc[ai][bj][m][1];
                    u32x4 w; w.x = pk2(v0[0], v0[1]); w.y = pk2(v0[2], v0[3]); w.z = pk2(v1[0], v1[1]); w.w = pk2(v1[2], v1[3]);
                    *(u32x4*)(tile + ((4 * ai + (m >> 1)) * 16 + 8 * bj) * 1024 + (m & 1) * 256) = w; }
    }
};
struct EpiInProj {
    static constexpr bool PERM = true, AFTER_DRAIN = false;
    bf16_t* O; const float* b_a;
    template <int MODE> __device__ __forceinline__ void tile(const f32x4 (&acc)[2][2][4][2], const Unit& u, int wr, int wc, int fr, int fq) const {
        const int row0 = u.pm * BM + wr * 64 + fr, col0 = u.pn * BM + wc * 32 + 8 * fq;
        f32x4 bv[2][2];
#pragma unroll
        for (int bj = 0; bj < 2; ++bj)
#pragma unroll
            for (int n = 0; n < 2; ++n) bv[bj][n] = (MODE == 2) ? *(const f32x4*)(b_a + (col0 - 1536) + bj * HALF + 4 * n) : (f32x4){0.f, 0.f, 0.f, 0.f};
#pragma unroll
        for (int ai = 0; ai < 2; ++ai)
#pragma unroll
            for (int m = 0; m < 4; ++m) { bf16_t* rowp = O + (size_t)(row0 + ai * HALF + m * 16) * 2816 + col0;
#pragma unroll
                for (int bj = 0; bj < 2; ++bj) { f32x4 v0 = acc[ai][bj][m][0], v1 = acc[ai][bj][m][1];
#pragma unroll
                    for (int j = 0; j < 4; ++j) {
                        if (MODE == 1) { v0[j] = f_silu(v0[j]); v1[j] = f_silu(v1[j]); }
                        if (MODE == 2) { v0[j] = f_logsig16(v0[j] + bv[bj][0][j]); v1[j] = f_logsig16(v1[j] + bv[bj][1][j]); }
                        if (MODE == 3) { v0[j] = f_gelu_tanh(v0[j]); v1[j] = f_gelu_tanh(v1[j]); } }
                    u32x4 w; w.x = pk2(v0[0], v0[1]); w.y = pk2(v0[2], v0[3]); w.z = pk2(v1[0], v1[1]); w.w = pk2(v1[2], v1[3]);
                    *(u32x4*)(rowp + bj * HALF) = w; } }
    }
    __device__ __forceinline__ void operator()(const f32x4 (&acc)[2][2][4][2], const Unit& u, int wr, int wc, int fr, int fq) const {
        const int pn = u.pn;
        if (pn < 4) tile<0>(acc, u, wr, wc, fr, fq); else if (pn < 6) tile<1>(acc, u, wr, wc, fr, fq); else if (pn == 6) tile<2>(acc, u, wr, wc, fr, fq); else tile<3>(acc, u, wr, wc, fr, fq);
    }
};
struct EpiInProj8 {
    static constexpr bool PERM = true, AFTER_DRAIN = false, F8 = true; static constexpr float dq = 1.0f / (F8_SX * F8_SW);
    bf16_t* O; const float* b_a;
    template <int MODE> __device__ __forceinline__ void tile(const f32x4 (&acc)[2][2][4][2], const Unit& u, int wr, int wc, int fr, int fq) const {
        const int row0 = u.pm * BM + wr * 64 + fr, col0 = u.pn * BM + wc * 32 + 8 * fq;
        f32x4 bv[2][2];
#pragma unroll
        for (int bj = 0; bj < 2; ++bj)
#pragma unroll
            for (int n = 0; n < 2; ++n) bv[bj][n] = (MODE == 2) ? *(const f32x4*)(b_a + (col0 - 1536) + bj * HALF + 4 * n) : (f32x4){0.f, 0.f, 0.f, 0.f};
#pragma unroll
        for (int ai = 0; ai < 2; ++ai)
#pragma unroll
            for (int m = 0; m < 4; ++m) { bf16_t* rowp = O + (size_t)(row0 + ai * HALF + m * 16) * 2816 + col0;
#pragma unroll
                for (int bj = 0; bj < 2; ++bj) { f32x4 v0 = acc[ai][bj][m][0] * dq, v1 = acc[ai][bj][m][1] * dq;
#pragma unroll
                    for (int j = 0; j < 4; ++j) {
                        if (MODE == 1) { v0[j] = f_silu(v0[j]); v1[j] = f_silu(v1[j]); }
                        if (MODE == 2) { v0[j] = f_logsig16(v0[j] + bv[bj][0][j]); v1[j] = f_logsig16(v1[j] + bv[bj][1][j]); }
                        if (MODE == 3) { v0[j] = f_gelu_tanh(v0[j]); v1[j] = f_gelu_tanh(v1[j]); } }
                    u32x4 w; w.x = pk2(v0[0], v0[1]); w.y = pk2(v0[2], v0[3]); w.z = pk2(v1[0], v1[1]); w.w = pk2(v1[2], v1[3]);
                    *(u32x4*)(rowp + bj * HALF) = w; } }
    }
    __device__ __forceinline__ void operator()(const f32x4 (&acc)[2][2][4][2], const Unit& u, int wr, int wc, int fr, int fq) const {
        const int pn = u.pn;
        if (pn < 4) tile<0>(acc, u, wr, wc, fr, fq); else if (pn < 6) tile<1>(acc, u, wr, wc, fr, fq); else if (pn == 6) tile<2>(acc, u, wr, wc, fr, fq); else tile<3>(acc, u, wr, wc, fr, fq);
    }
};
struct EpiResid {
    static constexpr bool PERM = true, AFTER_DRAIN = false;
    const bf16_t* X; bf16_t* Z; float alpha;
    __device__ __forceinline__ void operator()(const f32x4 (&acc)[2][2][4][2], const Unit& u, int wr, int wc, int fr, int fq) const {
        const int row0 = u.pm * BM + wr * 64 + fr, col0 = u.pn * BM + wc * 32 + 8 * fq;
#pragma unroll
        for (int ai = 0; ai < 2; ++ai)
#pragma unroll
            for (int m = 0; m < 4; ++m) { const size_t off = (size_t)(row0 + ai * HALF + m * 16) * 1024 + col0;
#pragma unroll
                for (int bj = 0; bj < 2; ++bj) { const f32x4 v0 = acc[ai][bj][m][0], v1 = acc[ai][bj][m][1];
                    const u32x4 xr = *(const u32x4*)(X + off + bj * HALF);
                    u32x4 w; w.x = pk2(alpha * bflo(xr.x) + v0[0], alpha * bfhi(xr.x) + v0[1]); w.y = pk2(alpha * bflo(xr.y) + v0[2], alpha * bfhi(xr.y) + v0[3]);
                    w.z = pk2(alpha * bflo(xr.z) + v1[0], alpha * bfhi(xr.z) + v1[1]); w.w = pk2(alpha * bflo(xr.w) + v1[2], alpha * bfhi(xr.w) + v1[3]);
                    *(u32x4*)(Z + off + bj * HALF) = w; } }
    }
};
struct EpiResidStats {
    static constexpr bool PERM = true, AFTER_DRAIN = false;
    const bf16_t* X; bf16_t* Z; f32x2_t* part; static constexpr float alpha = 1.4142135623730951f;
    __device__ __forceinline__ void operator()(const f32x4 (&acc)[2][2][4][2], const Unit& u, int wr, int wc, int fr, int fq) const {
        const int row0 = u.pm * BM + wr * 64 + fr, col0 = u.pn * BM + wc * 32 + 8 * fq;
        int ln = 16 * fq + fr; asm volatile("" : "+v"(ln));
        float s1[8], s2[8];
        const rsrc_t rx = mk_rsrc(X); const unsigned voff = ((unsigned)row0 * 1024u + (unsigned)col0) * 2u;
        u32x4 xres[2][4][2];
#pragma unroll
        for (int ai = 0; ai < 2; ++ai)
#pragma unroll
            for (int m = 0; m < 4; ++m)
#pragma unroll
                for (int bj = 0; bj < 2; ++bj) xres[ai][m][bj] = bld4(rx, voff, (unsigned)(((ai * HALF + m * 16) * 1024 + bj * HALF) * 2));
        __builtin_amdgcn_sched_barrier(0);
#pragma unroll
        for (int ai = 0; ai < 2; ++ai)
#pragma unroll
            for (int m = 0; m < 4; ++m) { const size_t off = (size_t)(row0 + ai * HALF + m * 16) * 1024 + col0; float a1 = 0.f, a2 = 0.f;
#pragma unroll
                for (int bj = 0; bj < 2; ++bj) { const f32x4 v0 = acc[ai][bj][m][0], v1 = acc[ai][bj][m][1];
                    const u32x4 xr = xres[ai][m][bj];
                    u32x4 w; w.x = pk2(alpha * bflo(xr.x) + v0[0], alpha * bfhi(xr.x) + v0[1]); w.y = pk2(alpha * bflo(xr.y) + v0[2], alpha * bfhi(xr.y) + v0[3]);
                    w.z = pk2(alpha * bflo(xr.z) + v1[0], alpha * bfhi(xr.z) + v1[1]); w.w = pk2(alpha * bflo(xr.w) + v1[2], alpha * bfhi(xr.w) + v1[3]);
                    GST4(Z + off + bj * HALF) = w;
                    const float z0 = bflo(w.x), z1 = bfhi(w.x), z2 = bflo(w.y), z3 = bfhi(w.y), z4 = bflo(w.z), z5 = bfhi(w.z), z6 = bflo(w.w), z7 = bfhi(w.w);
                    a1 += ((z0 + z1) + (z2 + z3)) + ((z4 + z5) + (z6 + z7)); a2 += ((z0 * z0 + z1 * z1) + (z2 * z2 + z3 * z3)) + ((z4 * z4 + z5 * z5) + (z6 * z6 + z7 * z7)); }
                s1[ai * 4 + m] = a1; s2[ai * 4 + m] = a2; }
        const bool h5 = (ln & 32) != 0, h4 = (ln & 16) != 0;
        float t1[4], t2[4];
#pragma unroll
        for (int i = 0; i < 4; ++i) { const float m1 = h5 ? s1[4 + i] : s1[i], g1 = h5 ? s1[i] : s1[4 + i], m2 = h5 ? s2[4 + i] : s2[i], g2 = h5 ? s2[i] : s2[4 + i];
            t1[i] = m1 + __builtin_bit_cast(float, __builtin_amdgcn_ds_bpermute((ln ^ 32) << 2, __builtin_bit_cast(int, g1)));
            t2[i] = m2 + __builtin_bit_cast(float, __builtin_amdgcn_ds_bpermute((ln ^ 32) << 2, __builtin_bit_cast(int, g2))); }
        float r1[2], r2[2];
#pragma unroll
        for (int i = 0; i < 2; ++i) { const float m1 = h4 ? t1[2 + i] : t1[i], g1 = h4 ? t1[i] : t1[2 + i], m2 = h4 ? t2[2 + i] : t2[i], g2 = h4 ? t2[i] : t2[2 + i];
            r1[i] = m1 + __builtin_bit_cast(float, __builtin_amdgcn_ds_bpermute((ln ^ 16) << 2, __builtin_bit_cast(int, g1)));
            r2[i] = m2 + __builtin_bit_cast(float, __builtin_amdgcn_ds_bpermute((ln ^ 16) << 2, __builtin_bit_cast(int, g2))); }
#pragma unroll
        for (int i = 0; i < 2; ++i) { const int gi = (h5 ? 4 : 0) + (h4 ? 2 : 0) + i, row = row0 + (gi >> 2) * HALF + (gi & 3) * 16;
            part[(size_t)row * 16 + u.pn * 4 + wc] = (f32x2_t){r1[i], r2[i]}; }
    }
};
struct EpiResidStats8 {
    static constexpr bool PERM = true, AFTER_DRAIN = false, F8 = true; static constexpr float dq = 1.0f / (F8_SM * F8_SW);
    const bf16_t* X; bf16_t* Z; f32x2_t* part; unsigned char* Z8; static constexpr float alpha = 1.4142135623730951f;
    __device__ __forceinline__ void operator()(const f32x4 (&acc)[2][2][4][2], const Unit& u, int wr, int wc, int fr, int fq) const {
        const int row0 = u.pm * BM + wr * 64 + fr, col0 = u.pn * BM + wc * 32 + 8 * fq;
        int ln = 16 * fq + fr; asm volatile("" : "+v"(ln));
        float s1[8], s2[8];
        const rsrc_t rx = mk_rsrc(X); const unsigned voff = ((unsigned)row0 * 1024u + (unsigned)col0) * 2u;
#pragma unroll
        for (int ai = 0; ai < 2; ++ai) {
            u32x4 xres[4][2];
#pragma unroll
            for (int m = 0; m < 4; ++m)
#pragma unroll
                for (int bj = 0; bj < 2; ++bj) xres[m][bj] = bld4(rx, voff, (unsigned)(((ai * HALF + m * 16) * 1024 + bj * HALF) * 2));
            __builtin_amdgcn_sched_barrier(0);
#pragma unroll
            for (int m = 0; m < 4; ++m) { const size_t off = (size_t)(row0 + ai * HALF + m * 16) * 1024 + col0; float a1 = 0.f, a2 = 0.f;
#pragma unroll
                for (int bj = 0; bj < 2; ++bj) { const f32x4 v0 = acc[ai][bj][m][0] * dq, v1 = acc[ai][bj][m][1] * dq;
                    const u32x4 xr = xres[m][bj];
                    u32x4 w; w.x = pk2(alpha * bflo(xr.x) + v0[0], alpha * bfhi(xr.x) + v0[1]); w.y = pk2(alpha * bflo(xr.y) + v0[2], alpha * bfhi(xr.y) + v0[3]);
                    w.z = pk2(alpha * bflo(xr.z) + v1[0], alpha * bfhi(xr.z) + v1[1]); w.w = pk2(alpha * bflo(xr.w) + v1[2], alpha * bfhi(xr.w) + v1[3]);
                    GST4(Z + off + bj * HALF) = w;
                    { u32x2 w8; w8.x = pk4f8(bflo(w.x) * F8_SZ, bfhi(w.x) * F8_SZ, bflo(w.y) * F8_SZ, bfhi(w.y) * F8_SZ); w8.y = pk4f8(bflo(w.z) * F8_SZ, bfhi(w.z) * F8_SZ, bflo(w.w) * F8_SZ, bfhi(w.w) * F8_SZ);
                      *(__attribute__((address_space(1))) u32x2*)(Z8 + off + bj * HALF) = w8; }
                    const float z0 = bflo(w.x), z1 = bfhi(w.x), z2 = bflo(w.y), z3 = bfhi(w.y), z4 = bflo(w.z), z5 = bfhi(w.z), z6 = bflo(w.w), z7 = bfhi(w.w);
                    a1 += ((z0 + z1) + (z2 + z3)) + ((z4 + z5) + (z6 + z7)); a2 += ((z0 * z0 + z1 * z1) + (z2 * z2 + z3 * z3)) + ((z4 * z4 + z5 * z5) + (z6 * z6 + z7 * z7)); }
                s1[ai * 4 + m] = a1; s2[ai * 4 + m] = a2; } }
        const bool h5 = (ln & 32) != 0, h4 = (ln & 16) != 0;
        float t1[4], t2[4];
#pragma unroll
        for (int i = 0; i < 4; ++i) { const float m1 = h5 ? s1[4 + i] : s1[i], g1 = h5 ? s1[i] : s1[4 + i], m2 = h5 ? s2[4 + i] : s2[i], g2 = h5 ? s2[i] : s2[4 + i];
            t1[i] = m1 + __builtin_bit_cast(float, __builtin_amdgcn_ds_bpermute((ln ^ 32) << 2, __builtin_bit_cast(int, g1)));
            t2[i] = m2 + __builtin_bit_cast(float, __builtin_amdgcn_ds_bpermute((ln ^ 32) << 2, __builtin_bit_cast(int, g2))); }
        float r1[2], r2[2];
#pragma unroll
        for (int i = 0; i < 2; ++i) { const float m1 = h4 ? t1[2 + i] : t1[i], g1 = h4 ? t1[i] : t1[2 + i], m2 = h4 ? t2[2 + i] : t2[i], g2 = h4 ? t2[i] : t2[2 + i];
            r1[i] = m1 + __builtin_bit_cast(float, __builtin_amdgcn_ds_bpermute((ln ^ 16) << 2, __builtin_bit_cast(int, g1)));
            r2[i] = m2 + __builtin_bit_cast(float, __builtin_amdgcn_ds_bpermute((ln ^ 16) << 2, __builtin_bit_cast(int, g2))); }
#pragma unroll
        for (int i = 0; i < 2; ++i) { const int gi = (h5 ? 4 : 0) + (h4 ? 2 : 0) + i, row = row0 + (gi >> 2) * HALF + (gi & 3) * 16;
            part[(size_t)row * 16 + u.pn * 4 + wc] = (f32x2_t){r1[i], r2[i]}; }
    }
};
struct EpiQFragLN {
    static constexpr bool PERM = true, AFTER_DRAIN = false;
    unsigned char* O; const f32x2_t* stats; const float* csum; const float* bq;
    __device__ __forceinline__ void operator()(const f32x4 (&acc)[2][2][4][2], const Unit& u, int wr, int wc, int fr, int fq) const {
        unsigned lo = (unsigned)(((fq >> 1) * 64 + fr + 32 * (fq & 1)) * 16); asm volatile("" : "+v"(lo));
        unsigned char* tile = O + (size_t)(u.pm * 4 + u.pn) * 65536 + (size_t)(wr * 2 * 8 + wc * 2) * 1024 + lo;
        const int row0 = u.pm * BM + wr * 64 + fr, col0 = u.pn * BM + wc * 32 + 8 * fq;
        f32x4 cc[2][2], bb[2][2];
#pragma unroll
        for (int bj = 0; bj < 2; ++bj)
#pragma unroll
            for (int n = 0; n < 2; ++n) { cc[bj][n] = *(const f32x4*)(csum + col0 + bj * HALF + 4 * n); bb[bj][n] = *(const f32x4*)(bq + col0 + bj * HALF + 4 * n); }
#pragma unroll
        for (int ai = 0; ai < 2; ++ai)
#pragma unroll
            for (int m = 0; m < 4; ++m) { const f32x2_t st = stats[row0 + ai * HALF + m * 16]; const float mu = st[0], rs = st[1] * F8_SQ; u32x4 w;
#pragma unroll
                for (int bj = 0; bj < 2; ++bj) { const f32x4 v0 = (acc[ai][bj][m][0] - mu * cc[bj][0]) * rs + bb[bj][0] * F8_SQ, v1 = (acc[ai][bj][m][1] - mu * cc[bj][1]) * rs + bb[bj][1] * F8_SQ;
                    const unsigned lo4 = pk4f8(v0[0], v0[1], v0[2], v0[3]), hi4 = pk4f8(v1[0], v1[1], v1[2], v1[3]);
                    if (bj == 0) { w.x = lo4; w.y = hi4; } else { w.z = lo4; w.w = hi4; } }
                *(u32x4*)(tile + (4 * ai + (m >> 1)) * 8192 + (m & 1) * 256) = w; }
    }
};
struct EpiQFragLN8 {
    static constexpr bool PERM = true, AFTER_DRAIN = false, F8 = true; static constexpr float dq = 1.0f / (F8_SZ * F8_SW);
    unsigned char* O; const f32x2_t* stats; const float* csum; const float* bq;
    __device__ __forceinline__ void operator()(const f32x4 (&acc)[2][2][4][2], const Unit& u, int wr, int wc, int fr, int fq) const {
        unsigned lo = (unsigned)(((fq >> 1) * 64 + fr + 32 * (fq & 1)) * 16); asm volatile("" : "+v"(lo));
        unsigned char* tile = O + (size_t)(u.pm * 4 + u.pn) * 65536 + (size_t)(wr * 2 * 8 + wc * 2) * 1024 + lo;
        const int row0 = u.pm * BM + wr * 64 + fr, col0 = u.pn * BM + wc * 32 + 8 * fq;
        f32x4 cc[2][2], bb[2][2];
#pragma unroll
        for (int bj = 0; bj < 2; ++bj)
#pragma unroll
            for (int n = 0; n < 2; ++n) { cc[bj][n] = *(const f32x4*)(csum + col0 + bj * HALF + 4 * n); bb[bj][n] = *(const f32x4*)(bq + col0 + bj * HALF + 4 * n); }
#pragma unroll
        for (int ai = 0; ai < 2; ++ai)
#pragma unroll
            for (int m = 0; m < 4; ++m) { const f32x2_t st = stats[row0 + ai * HALF + m * 16]; const float mu = st[0], rs = st[1] * F8_SQ; u32x4 w;
#pragma unroll
                for (int bj = 0; bj < 2; ++bj) { const f32x4 v0 = (acc[ai][bj][m][0] * dq - mu * cc[bj][0]) * rs + bb[bj][0] * F8_SQ, v1 = (acc[ai][bj][m][1] * dq - mu * cc[bj][1]) * rs + bb[bj][1] * F8_SQ;
                    const unsigned lo4 = pk4f8(v0[0], v0[1], v0[2], v0[3]), hi4 = pk4f8(v1[0], v1[1], v1[2], v1[3]);
                    if (bj == 0) { w.x = lo4; w.y = hi4; } else { w.z = lo4; w.w = hi4; } }
                *(u32x4*)(tile + (4 * ai + (m >> 1)) * 8192 + (m & 1) * 256) = w; }
    }
};
struct EpiResidLN {
    static constexpr bool PERM = true, AFTER_DRAIN = false;
    bf16_t* Z; const f32x2_t* stats; const float* gain; const float* bias; static constexpr float alpha = 1.4142135623730951f;
    __device__ __forceinline__ void operator()(const f32x4 (&acc)[2][2][4][2], const Unit& u, int wr, int wc, int fr, int fq) const {
        const int row0 = u.pm * BM + wr * 64 + fr, col0 = u.pn * BM + wc * 32 + 8 * fq;
        const rsrc_t rz = mk_rsrc(Z), rs = mk_rsrc(stats); const unsigned voff = ((unsigned)row0 * 1024u + (unsigned)col0) * 2u;
        f32x2_t st[2][4];
#pragma unroll
        for (int ai = 0; ai < 2; ++ai)
#pragma unroll
            for (int m = 0; m < 4; ++m) st[ai][m] = bld2f(rs, (unsigned)row0 * 8u, (unsigned)((ai * HALF + m * 16) * 8));
#pragma unroll
        for (int bj = 0; bj < 2; ++bj) {
            u32x4 zres[2][4];
#pragma unroll
            for (int ai = 0; ai < 2; ++ai)
#pragma unroll
                for (int m = 0; m < 4; ++m) zres[ai][m] = bld4(rz, voff, (unsigned)(((ai * HALF + m * 16) * 1024 + bj * HALF) * 2));
            const f32x4 g0 = *(const f32x4*)(gain + col0 + bj * HALF) * alpha, g1 = *(const f32x4*)(gain + col0 + bj * HALF + 4) * alpha, b0 = *(const f32x4*)(bias + col0 + bj * HALF) * alpha, b1 = *(const f32x4*)(bias + col0 + bj * HALF + 4) * alpha;
            __builtin_amdgcn_sched_barrier(0);
#pragma unroll
            for (int ai = 0; ai < 2; ++ai)
#pragma unroll
                for (int m = 0; m < 4; ++m) { const int row = row0 + ai * HALF + m * 16; const float mu = st[ai][m][0], rsd = st[ai][m][1];
                    const u32x4 zr = zres[ai][m];
                    const f32x4 z0 = (f32x4){bflo(zr.x), bfhi(zr.x), bflo(zr.y), bfhi(zr.y)}, z1 = (f32x4){bflo(zr.z), bfhi(zr.z), bflo(zr.w), bfhi(zr.w)};
                    const f32x4 v0 = (z0 - mu) * rsd * g0 + b0 + acc[ai][bj][m][0], v1 = (z1 - mu) * rsd * g1 + b1 + acc[ai][bj][m][1];
                    u32x4 w; w.x = pk2(v0[0], v0[1]); w.y = pk2(v0[2], v0[3]); w.z = pk2(v1[0], v1[1]); w.w = pk2(v1[2], v1[3]);
                    GST4(Z + (size_t)row * 1024 + col0 + bj * HALF) = w; } }
    }
};
struct EpiResidLN8 {
    static constexpr bool PERM = true, AFTER_DRAIN = false, F8 = true; static constexpr float dq = 1.0f / (F8_SO * F8_SW);
    bf16_t* Z; const f32x2_t* stats; const float* gain; const float* bias; static constexpr float alpha = 1.4142135623730951f;
    __device__ __forceinline__ void operator()(const f32x4 (&acc)[2][2][4][2], const Unit& u, int wr, int wc, int fr, int fq) const {
        const int row0 = u.pm * BM + wr * 64 + fr, col0 = u.pn * BM + wc * 32 + 8 * fq;
        const rsrc_t rz = mk_rsrc(Z), rs = mk_rsrc(stats); const unsigned voff = ((unsigned)row0 * 1024u + (unsigned)col0) * 2u;
        f32x2_t st[2][4];
#pragma unroll
        for (int ai = 0; ai < 2; ++ai)
#pragma unroll
            for (int m = 0; m < 4; ++m) st[ai][m] = bld2f(rs, (unsigned)row0 * 8u, (unsigned)((ai * HALF + m * 16) * 8));
#pragma unroll
        for (int bj = 0; bj < 2; ++bj) {
            u32x4 zres[2][4];
#pragma unroll
            for (int ai = 0; ai < 2; ++ai)
#pragma unroll
                for (int m = 0; m < 4; ++m) zres[ai][m] = bld4(rz, voff, (unsigned)(((ai * HALF + m * 16) * 1024 + bj * HALF) * 2));
            const f32x4 g0 = *(const f32x4*)(gain + col0 + bj * HALF) * alpha, g1 = *(const f32x4*)(gain + col0 + bj * HALF + 4) * alpha, b0 = *(const f32x4*)(bias + col0 + bj * HALF) * alpha, b1 = *(const f32x4*)(bias + col0 + bj * HALF + 4) * alpha;
            __builtin_amdgcn_sched_barrier(0);
#pragma unroll
            for (int ai = 0; ai < 2; ++ai)
#pragma unroll
                for (int m = 0; m < 4; ++m) { const int row = row0 + ai * HALF + m * 16; const float mu = st[ai][m][0], rsd = st[ai][m][1];
                    const u32x4 zr = zres[ai][m];
                    const f32x4 z0 = (f32x4){bflo(zr.x), bfhi(zr.x), bflo(zr.y), bfhi(zr.y)}, z1 = (f32x4){bflo(zr.z), bfhi(zr.z), bflo(zr.w), bfhi(zr.w)};
                    const f32x4 v0 = (z0 - mu) * rsd * g0 + b0 + acc[ai][bj][m][0] * dq, v1 = (z1 - mu) * rsd * g1 + b1 + acc[ai][bj][m][1] * dq;
                    u32x4 w; w.x = pk2(v0[0], v0[1]); w.y = pk2(v0[2], v0[3]); w.z = pk2(v1[0], v1[1]); w.w = pk2(v1[2], v1[3]);
                    GST4(Z + (size_t)row * 1024 + col0 + bj * HALF) = w; } }
    }
};
struct EpiGU {
    static constexpr bool PERM = true, AFTER_DRAIN = false;
    bf16_t* H;
    __device__ __forceinline__ void operator()(const f32x4 (&acc)[2][2][4][2], const Unit& u, int wr, int wc, int fr, int fq) const {
        const int row0 = u.pm * BM + wr * 64 + fr, col0 = (u.pn & 3) * 128 + wc * 16 + 4 * fq;
#pragma unroll
        for (int ai = 0; ai < 2; ++ai)
#pragma unroll
            for (int m = 0; m < 4; ++m) { bf16_t* rowp = H + (size_t)(row0 + ai * HALF + m * 16) * 512 + col0;
#pragma unroll
                for (int bj = 0; bj < 2; ++bj) { const f32x4 g = acc[ai][bj][m][0], up = acc[ai][bj][m][1];
                    u32x2 w; w.x = pk2(f_silu(g[0]) * up[0], f_silu(g[1]) * up[1]); w.y = pk2(f_silu(g[2]) * up[2], f_silu(g[3]) * up[3]);
                    *(u32x2*)(rowp + bj * 64) = w; } }
    }
};
struct EpiGU8 {
    static constexpr bool PERM = true, AFTER_DRAIN = false, F8 = true;
    unsigned char* H;
    __device__ __forceinline__ void operator()(const f32x4 (&acc)[2][2][4][2], const Unit& u, int wr, int wc, int fr, int fq) const {
        const int row0 = u.pm * BM + wr * 64 + fr, col0 = (u.pn & 3) * 128 + wc * 32 + 8 * fq;
        constexpr float dq = 1.0f / (F8_SX * F8_SW);
#pragma unroll
        for (int ai = 0; ai < 2; ++ai)
#pragma unroll
            for (int m = 0; m < 4; ++m) { float h[8];
#pragma unroll
                for (int n = 0; n < 2; ++n) { const f32x4 g = acc[ai][0][m][n] * dq, up = acc[ai][1][m][n] * (dq * F8_SH);
#pragma unroll
                    for (int i = 0; i < 4; ++i) h[4 * n + i] = f_silu(g[i]) * up[i]; }
                u32x2 w; w.x = pk4f8(h[0], h[1], h[2], h[3]); w.y = pk4f8(h[4], h[5], h[6], h[7]);
                *(u32x2*)(H + (size_t)(row0 + ai * HALF + m * 16) * 512 + col0) = w; }
    }
};
struct EpiPlain8 {
    static constexpr bool PERM = true, AFTER_DRAIN = false, F8 = true;
    unsigned char* O; int ldc; int cmask;
    __device__ __forceinline__ void operator()(const f32x4 (&acc)[2][2][4][2], const Unit& u, int wr, int wc, int fr, int fq) const {
        const int row0 = u.pm * BM + wr * 64 + fr, col0 = (u.pn & cmask) * BM + wc * 32 + 8 * fq;
        constexpr float dq = F8_SY / (F8_SH * F8_SW);
#pragma unroll
        for (int ai = 0; ai < 2; ++ai)
#pragma unroll
            for (int m = 0; m < 4; ++m) { unsigned char* rowp = O + (size_t)(row0 + ai * HALF + m * 16) * ldc + col0;
#pragma unroll
                for (int bj = 0; bj < 2; ++bj) { const f32x4 v0 = acc[ai][bj][m][0] * dq, v1 = acc[ai][bj][m][1] * dq;
                    u32x2 w; w.x = pk4f8(v0[0], v0[1], v0[2], v0[3]); w.y = pk4f8(v1[0], v1[1], v1[2], v1[3]);
                    *(u32x2*)(rowp + bj * HALF) = w; } }
    }
};

typedef int i32x4_t __attribute__((ext_vector_type(4)));
template <class T, class = void> struct epi_f8 { static constexpr bool value = false; };
template <class T> struct epi_f8<T, decltype((void)T::F8)> { static constexpr bool value = true; };
template <class Epi, class Sched, bool ALIGN_EPI = false, bool SP2 = false>
__device__ __forceinline__ void gemm_phase(PG8_LAS unsigned char* lds, const Gemm g, const Sched& S, const Epi& E) {
    int tid_ = g.wv * 64 + lane_id(); asm volatile("" : "+v"(tid_));
    const int tid = tid_, wid = __builtin_amdgcn_readfirstlane(tid >> 6), lane = tid & 63, wr = wid >> 2, wc = wid & 3, fr = lane & 15, fq = lane >> 4;
    const int K = g.K, nt = K / BK; constexpr bool F8 = epi_f8<Epi>::value;
    unsigned voffA[2], voffB[2];
#pragma unroll
    for (int i = 0; i < 2; ++i) { int R, C; stage_rc(tid * 16 + i * 8192, R, C); const int Rb = Epi::PERM ? ((R & ~31) + perm32(R & 31)) : R;
        voffA[i] = (unsigned)(R * K + C) * 2u;
        voffB[i] = (unsigned)(((Rb >> 4) * (K >> 5) + (C >> 5)) * 1024 + (Rb & 15) * 64 + (C & 31) * 2); }
    constexpr bool GATH = Sched::GATHER; static_assert(!GATH || SP2, "gather mode is written for the SP2 loop");
    unsigned goc[2][2] = {{0u, 0u}, {0u, 0u}}, gon[2][2] = {{0u, 0u}, {0u, 0u}}, go2[2][2] = {{0u, 0u}, {0u, 0u}};
#define PG8_GOFF(dst, U) do { int tg_ = tid; asm volatile("" : "+v"(tg_)); _Pragma("unroll") for (int i_ = 0; i_ < 2; ++i_) { int R_, C_; stage_rc(tg_ * 16 + i_ * 8192, R_, C_); \
        _Pragma("unroll") for (int h_ = 0; h_ < 2; ++h_) dst[h_][i_] = (unsigned)S.src[(U).pm * BM + h_ * HALF + R_] * (unsigned)(K * 2) + (unsigned)C_ * 2u; } } while (0)
    const size_t kstep = (size_t)(BK * 2);
    const size_t kstepB = 2048;
    const size_t hstep = (size_t)HALF * K * 2;
    const size_t tstep = 2 * hstep;
    const unsigned ldsw = (unsigned)wid * 1024u;
    const int aoff = lds_byte(wr * 64 + fr, fq * 8), boff = lds_byte(wc * 32 + fr, fq * 8);
#define PG8_SA(b, h) (((b) * 2 + (h)) * HTB)
#define PG8_SB(b, h) ((4 + (b) * 2 + (h)) * HTB)
#define PG8_STAGE(bufoff, gbase, voff) do { _Pragma("unroll") for (int _i = 0; _i < 2; ++_i) \
        __builtin_amdgcn_global_load_lds((const unsigned*)((const char*)(gbase) + (voff)[_i]), (PG8_LAS unsigned*)(lds + (bufoff) + ldsw + _i * 8192), 16, 0, 0); } while (0)
#define PG8_STAGE_A(b, h, PTR, KPTR, GO) do { if constexpr (GATH) { PG8_STAGE(PG8_SA(b, h), KPTR, GO); } else { PG8_STAGE(PG8_SA(b, h), PTR, voffA); } } while (0)
#define PG8_LDA(dst, b, h) do { _Pragma("unroll") for (int m = 0; m < 4; ++m) _Pragma("unroll") for (int k = 0; k < 2; ++k) dst[m][k] = *(const PG8_LAS bf16x8*)(lds + PG8_SA(b, h) + aoff + m * 2048 + k * 1024); } while (0)
#define PG8_LDB(dst, b, h) do { _Pragma("unroll") for (int n = 0; n < 2; ++n) _Pragma("unroll") for (int k = 0; k < 2; ++k) dst[n][k] = *(const PG8_LAS bf16x8*)(lds + PG8_SB(b, h) + boff + n * 2048 + k * 1024); } while (0)
#define PG8_CAT8(x, y) __builtin_shufflevector(__builtin_bit_cast(i32x4_t, x), __builtin_bit_cast(i32x4_t, y), 0, 1, 2, 3, 4, 5, 6, 7)
#define PG8_MMA(ai, bj, At, Bt) do { __builtin_amdgcn_s_setprio(1); \
        if constexpr (F8) { _Pragma("unroll") for (int m = 0; m < 4; ++m) _Pragma("unroll") for (int n = 0; n < 2; ++n) \
            asm volatile("v_mfma_f32_16x16x128_f8f6f4 %0, %1, %2, %0" : "+v"(acc[ai][bj][m][n]) : "v"(PG8_CAT8(Bt[n][0], Bt[n][1])), "v"(PG8_CAT8(At[m][0], At[m][1]))); } \
        else { _Pragma("unroll") for (int m = 0; m < 4; ++m) _Pragma("unroll") for (int n = 0; n < 2; ++n) _Pragma("unroll") for (int k = 0; k < 2; ++k) \
            acc[ai][bj][m][n] = __builtin_amdgcn_mfma_f32_16x16x32_bf16(Bt[n][k], At[m][k], acc[ai][bj][m][n], 0, 0, 0); } \
        __builtin_amdgcn_s_setprio(0); } while (0)
#define PG8_WAIT_V(n) asm volatile("s_waitcnt vmcnt(" #n ")" ::: "memory")
#define PG8_WAIT_L(n) asm volatile("s_waitcnt lgkmcnt(" #n ")" ::: "memory")
#define PG8_BAR __builtin_amdgcn_s_barrier()
#define PG8_SCHED __builtin_amdgcn_sched_barrier(0)
    Unit cur, nxt; int ui = 0;
    if (!S.next(0, cur)) return;
    f32x4 acc[2][2][4][2];
#pragma unroll
    for (int a = 0; a < 2; ++a)
#pragma unroll
        for (int b = 0; b < 2; ++b)
#pragma unroll
            for (int m = 0; m < 4; ++m)
#pragma unroll
                for (int n = 0; n < 2; ++n) { acc[a][b][m][n] = (f32x4){0.f, 0.f, 0.f, 0.f}; if constexpr (F8) asm volatile("" : "+v"(acc[a][b][m][n])); }
    bf16x8 At[4][2], B0[2][2], B1[2][2];
    const char* cA = (const char*)g.A + (size_t)cur.pm * tstep; const char* cB = (const char*)g.Bt + (size_t)cur.pn * tstep;
    S.a_ready(cur);
    const char* gA = (const char*)g.A;
    if constexpr (GATH) PG8_GOFF(goc, cur);
    if constexpr (SP2) {
        PG8_STAGE(PG8_SB(0, 0), cB, voffB); PG8_STAGE(PG8_SB(0, 1), cB + hstep, voffB); PG8_STAGE_A(0, 0, cA, gA, goc[0]); PG8_STAGE_A(0, 1, cA + hstep, gA, goc[1]);
        if (wr == 1) PG8_BAR;
        PG8_WAIT_V(2); PG8_BAR;
        PG8_STAGE(PG8_SB(1, 0), cB + kstepB, voffB); PG8_STAGE_A(1, 0, cA + kstep, gA + kstep, goc[0]); PG8_STAGE(PG8_SB(1, 1), cB + hstep + kstepB, voffB);
        PG8_WAIT_V(6); PG8_BAR;
    } else {
        PG8_STAGE(PG8_SB(0, 0), cB, voffB); PG8_STAGE(PG8_SA(0, 0), cA, voffA); PG8_STAGE(PG8_SB(0, 1), cB + hstep, voffB); PG8_STAGE(PG8_SA(0, 1), cA + hstep, voffA);
        if (wr == 1) PG8_BAR;
        PG8_WAIT_V(4); PG8_BAR;
        PG8_STAGE(PG8_SB(1, 0), cB + kstepB, voffB); PG8_STAGE(PG8_SA(1, 0), cA + kstep, voffA); PG8_STAGE(PG8_SB(1, 1), cB + hstep + kstepB, voffB);
        PG8_WAIT_V(6); PG8_BAR;
    }
    for (;;) {
        const bool has_next = S.next(ui + 1, nxt);
        if constexpr (GATH) { if (has_next) PG8_GOFF(gon, nxt); else { _Pragma("unroll") for (int h_ = 0; h_ < 2; ++h_) _Pragma("unroll") for (int i_ = 0; i_ < 2; ++i_) gon[h_][i_] = goc[h_][i_]; } }
        const char* nA = has_next ? (const char*)g.A + (size_t)nxt.pm * tstep : cA; const char* nB = has_next ? (const char*)g.Bt + (size_t)nxt.pn * tstep : cB;
        for (int t = 0; t < nt; t += 2) {
            const bool last = (t == nt - 2);
            const char* a1 = cA + (size_t)(t + 1) * kstep;
            const char* a2 = last ? nA : cA + (size_t)(t + 2) * kstep; const char* b2 = last ? nB : cB + (size_t)(t + 2) * kstepB;
            const char* a3 = a2 + kstep; const char* b3 = b2 + kstepB;
            if (last && has_next) S.a_ready(nxt);
            const char* ga1 = gA + (size_t)(t + 1) * kstep; const char* ga2 = last ? gA : gA + (size_t)(t + 2) * kstep; const char* ga3 = ga2 + kstep;
            if constexpr (GATH) { _Pragma("unroll") for (int h_ = 0; h_ < 2; ++h_) _Pragma("unroll") for (int i_ = 0; i_ < 2; ++i_) go2[h_][i_] = last ? gon[h_][i_] : goc[h_][i_]; }
            if constexpr (SP2) {
            PG8_LDB(B0, 0, 0); PG8_LDB(B1, 0, 1); PG8_SCHED; PG8_LDA(At, 0, 0); PG8_STAGE_A(1, 1, a1 + hstep, ga1, goc[1]);
            PG8_WAIT_V(8); PG8_WAIT_L(0); PG8_BAR; PG8_MMA(0, 0, At, B0); PG8_MMA(0, 1, At, B1); PG8_BAR; PG8_SCHED;
            PG8_LDA(At, 0, 1); PG8_STAGE(PG8_SB(0, 0), b2, voffB); PG8_STAGE(PG8_SB(0, 1), b2 + hstep, voffB); PG8_STAGE_A(0, 0, a2, ga2, go2[0]);
            PG8_WAIT_V(8); PG8_WAIT_L(0); PG8_BAR; PG8_MMA(1, 0, At, B0); PG8_MMA(1, 1, At, B1); PG8_BAR; PG8_SCHED;
            PG8_LDB(B0, 1, 0); PG8_LDB(B1, 1, 1); PG8_SCHED; PG8_LDA(At, 1, 0); PG8_STAGE_A(0, 1, a2 + hstep, ga2, go2[1]);
            PG8_WAIT_V(8); PG8_WAIT_L(0); PG8_BAR; PG8_MMA(0, 0, At, B0); PG8_MMA(0, 1, At, B1); PG8_BAR; PG8_SCHED;
            PG8_LDA(At, 1, 1); PG8_STAGE(PG8_SB(1, 0), b3, voffB); PG8_STAGE(PG8_SB(1, 1), b3 + hstep, voffB); PG8_STAGE_A(1, 0, a3, ga3, go2[0]);
            PG8_WAIT_V(8); PG8_WAIT_L(0); PG8_BAR; PG8_MMA(1, 0, At, B0); PG8_MMA(1, 1, At, B1); PG8_BAR; PG8_SCHED;
            } else {
            PG8_LDB(B0, 0, 0); PG8_SCHED; PG8_LDA(At, 0, 0); PG8_STAGE(PG8_SA(1, 1), a1 + hstep, voffA);
            PG8_WAIT_L(8); PG8_BAR; PG8_WAIT_L(0); PG8_MMA(0, 0, At, B0); PG8_BAR; PG8_SCHED;
            PG8_LDB(B1, 0, 1); PG8_STAGE(PG8_SB(0, 0), b2, voffB);
            PG8_BAR; PG8_WAIT_L(0); PG8_MMA(0, 1, At, B1); PG8_BAR;
            PG8_LDA(At, 0, 1); PG8_STAGE(PG8_SA(0, 0), a2, voffA);
            PG8_BAR; PG8_WAIT_L(0); PG8_MMA(1, 0, At, B0); PG8_BAR; PG8_SCHED;
            PG8_STAGE(PG8_SB(0, 1), b2 + hstep, voffB);
            PG8_WAIT_V(6); PG8_BAR; PG8_MMA(1, 1, At, B1); PG8_BAR;
            PG8_LDB(B0, 1, 0); PG8_SCHED; PG8_LDA(At, 1, 0); PG8_STAGE(PG8_SA(0, 1), a2 + hstep, voffA);
            PG8_WAIT_L(8); PG8_BAR; PG8_WAIT_L(0); PG8_MMA(0, 0, At, B0); PG8_BAR; PG8_SCHED;
            PG8_LDB(B1, 1, 1); PG8_STAGE(PG8_SB(1, 0), b3, voffB);
            PG8_BAR; PG8_WAIT_L(0); PG8_MMA(0, 1, At, B1); PG8_BAR;
            PG8_LDA(At, 1, 1); PG8_STAGE(PG8_SA(1, 0), a3, voffA);
            PG8_BAR; PG8_WAIT_L(0); PG8_MMA(1, 0, At, B0); PG8_BAR; PG8_SCHED;
            PG8_STAGE(PG8_SB(1, 1), b3 + hstep, voffB);
            PG8_WAIT_V(6); PG8_BAR; PG8_MMA(1, 1, At, B1); PG8_BAR;
            }
        }
        if constexpr (F8) asm volatile("s_nop 15\n\ts_nop 15" ::: "memory");
        if constexpr (ALIGN_EPI) { if (wr == 0) PG8_BAR; }
        if constexpr (!Epi::AFTER_DRAIN) { E(acc, cur, wr, wc, fr, fq); S.done(cur); }
        if (!has_next) break;
#pragma unroll
        for (int a = 0; a < 2; ++a)
#pragma unroll
            for (int b = 0; b < 2; ++b)
#pragma unroll
                for (int m = 0; m < 4; ++m)
#pragma unroll
                    for (int n = 0; n < 2; ++n) { acc[a][b][m][n] = (f32x4){0.f, 0.f, 0.f, 0.f}; if constexpr (F8) asm volatile("" : "+v"(acc[a][b][m][n])); }
        cur = nxt; cA = nA; cB = nB; ++ui;
        if constexpr (GATH) { _Pragma("unroll") for (int h_ = 0; h_ < 2; ++h_) _Pragma("unroll") for (int i_ = 0; i_ < 2; ++i_) goc[h_][i_] = gon[h_][i_]; }
        if constexpr (ALIGN_EPI) { if (wr == 1) PG8_BAR; }
    }
    PG8_WAIT_V(0);
    if constexpr (!ALIGN_EPI) { if (wr == 0) PG8_BAR; }
    PG8_BAR;
    if constexpr (Epi::AFTER_DRAIN) { E.fused(acc, cur, wr, wc, fr, fq, lds, wid, lane); S.done(cur); }
#undef PG8_SA
#undef PG8_SB
#undef PG8_STAGE
#undef PG8_STAGE_A
#undef PG8_GOFF
#undef PG8_LDA
#undef PG8_LDB
#undef PG8_MMA
#undef PG8_WAIT_V
#undef PG8_WAIT_L
#undef PG8_BAR
#undef PG8_SCHED
}}

namespace mk {
using pg8::bf16_t; using pg8::bf16x8; using pg8::f32x4; using pg8::u32x4; using pg8::u32x2; using pg8::pk2; using pg8::bflo; using pg8::bfhi;
typedef float f32x16 __attribute__((ext_vector_type(16)));
typedef short s16x4 __attribute__((ext_vector_type(4)));
typedef short v4i16_t __attribute__((ext_vector_type(4)));
#define LAS __attribute__((address_space(3)))
#define GAS __attribute__((address_space(1)))
typedef GAS unsigned gu32;
#define RLX_AGENT __ATOMIC_RELAXED, __HIP_MEMORY_SCOPE_AGENT
#define LDS_WAIT() asm volatile("s_waitcnt lgkmcnt(0)" ::: "memory")

constexpr int NB = 8, SEQ = 8192, M = NB * SEQ, D = 1024, NP = 2816, NMEM = 256, MKV = NB * NMEM;
constexpr int PQ = 0, PK = 256, PV = 512, PR = 1024, PG = 1536, PU = 1792, PVS = 2304;
constexpr int DIN = 2576;
constexpr int MOE_ROWS = 135168;
constexpr float ALPHA = 1.4142135623730951f, LN_EPS = 1e-5f, LOG2E = 1.4426950408889634f;
constexpr int NWAVES = 8, NTHR = 512;

constexpr size_t MiB = 1u << 20;
constexpr size_t WS_CTL = 0, CTL_ZERO_BYTES = 1 * MiB;
constexpr size_t WS_WM = 1 * MiB;
constexpr size_t WS_WGCNT = 1 * MiB + 512 * 1024;
constexpr size_t WS_LTOT = 1 * MiB + 768 * 1024;
constexpr size_t WS_TINFO = 2 * MiB;
constexpr size_t WS_TRANK = 3 * MiB;
constexpr size_t WS_TSLOT = 3 * MiB + 512 * 1024;
constexpr size_t WS_SEND = 4 * MiB;
constexpr size_t WS_WKV = 12 * MiB;
constexpr size_t WS_MEMB = 20 * MiB;
constexpr size_t WS_KV = 24 * MiB;
constexpr size_t WS_W = 40 * MiB, W_LAYER = 60 * MiB;
constexpr size_t W_IN = 0, W_OUT = (size_t)NP * D * 2, W_Q = W_OUT + 2 * MiB, W_O = W_Q + 2 * MiB, W_GU = W_O + 2 * MiB, W_D = W_GU + 32 * MiB;
static_assert(W_D + 16 * MiB <= W_LAYER, "weights per layer");
constexpr size_t WS_X = 160 * MiB;
constexpr size_t WS_R = 288 * MiB;
constexpr size_t R_P = 0, R_Y = 352 * MiB, R_Z = 480 * MiB, R_Q = 0, R_O = 128 * MiB, R_XS = 344 * MiB, R_H = 0;
constexpr size_t R_X8 = 256 * MiB;
constexpr size_t WS_SRCROW = WS_R + 616 * MiB;
constexpr size_t WS_PART = WS_SRCROW + 1 * MiB;
constexpr size_t WS_STATS = WS_PART + 8 * MiB;
constexpr size_t WS_CS = WS_STATS + 1 * MiB;
constexpr size_t WS_X8IN = WS_CS + 1 * MiB;
constexpr size_t WS_END = WS_X8IN + 64 * MiB;
static_assert(R_XS + (size_t)MOE_ROWS * D * 2 <= 616 * MiB && R_H + (size_t)MOE_ROWS * 512 * 2 <= R_XS, "moe buffers");
constexpr int CW_BAR = 4096;

constexpr int LDS_BYTES = 159744, LDSCTL_OFF = 155648;
constexpr int MISC_OFF = LDSCTL_OFF;
constexpr int TILEE_OFF = LDSCTL_OFF + 512;
static_assert(TILEE_OFF + 528 * 4 <= LDS_BYTES, "LDS map");

#define XB_TMO      128
#define XB_XCNT(j)  (256  + 64 * (j))
#define XB_XSUB(j)  (1280 + 64 * (j))
#define XB_XGEN(j)  (2304 + 64 * (j))
#define XB_TOP      3328
#define XB_TOPGEN   3392
#define XCD_BAR_WORDS 3456
#define XB_SPIN_CAP (1u << 18)

__device__ __forceinline__ unsigned xb_ld(unsigned* p)              { return __hip_atomic_load(p, __ATOMIC_RELAXED, __HIP_MEMORY_SCOPE_AGENT); }
__device__ __forceinline__ unsigned xb_add(unsigned* p, unsigned v) { return __hip_atomic_fetch_add(p, v, __ATOMIC_RELAXED, __HIP_MEMORY_SCOPE_AGENT); }
__device__ __forceinline__ unsigned xb_xcc_id() { return (unsigned)__builtin_amdgcn_s_getreg((3 << 11) | 20) & 0xFu; }
#define XB_SPIN(cond, bar) do { unsigned _sp = 0; while (cond) { __builtin_amdgcn_s_sleep(1); \
    if ((++_sp & 255u) == 0u) { if (xb_ld(&(bar)[XB_TMO])) break; if (_sp > XB_SPIN_CAP) { atomicAdd(&(bar)[XB_TMO], 1u); break; } } } } while (0)

struct XcdBarrier {
    unsigned* bar; unsigned x;
    volatile LAS unsigned* st;
    int wv;
};

__device__ __forceinline__ XcdBarrier xcd_barrier_post(unsigned* bar, volatile LAS unsigned* st) {
    XcdBarrier b; b.bar = bar; b.x = xb_xcc_id(); b.st = st; b.wv = 0;
    if (threadIdx.x == 0) (void)xb_add(&bar[XB_XCNT(b.x)], 1u);
    return b;
}
__device__ __forceinline__ void xcd_barrier_complete(unsigned* bar, unsigned x, unsigned& nloc, unsigned& nx) {
    const unsigned G = gridDim.x * gridDim.y * gridDim.z;
    unsigned sum, cnt, mine, sp = 0u;
    for (;;) {
        sum = 0u; cnt = 0u; mine = 0u;
#pragma unroll
        for (unsigned j = 0; j < 16; ++j) { const unsigned c = xb_ld(&bar[XB_XCNT(j)]); sum += c; cnt += (c > 0u) ? 1u : 0u; mine = (j == x) ? c : mine; }
        if (sum == G) break;
        __builtin_amdgcn_s_sleep(1);
        if ((++sp & 255u) == 0u) { if (xb_ld(&bar[XB_TMO])) break; if (sp > XB_SPIN_CAP) { atomicAdd(&bar[XB_TMO], 1u); break; } }
    }
    nloc = mine > 0u ? mine : 1u; nx = cnt > 0u ? cnt : 1u;
}

__device__ __forceinline__ void xcd_barrier(const XcdBarrier& b) {
    asm volatile("s_waitcnt vmcnt(0)" ::: "memory");
    __syncthreads();
    if (b.wv == 0 && pg8::lane_id() == 0) {
        unsigned* bar = b.bar;
        __builtin_amdgcn_s_waitcnt(0);
        unsigned nloc = b.st[0], nx = b.st[1];
        if (nloc == 0u) { xcd_barrier_complete(bar, b.x, nloc, nx); b.st[0] = nloc; b.st[1] = nx; }
        const unsigned old = xb_add(&bar[XB_XSUB(b.x)], 1u);
        const unsigned gen = old / nloc;
        if (old + 1u == (gen + 1u) * nloc) {
            __builtin_amdgcn_fence(__ATOMIC_RELEASE, "agent");
            asm volatile("s_waitcnt vmcnt(0)" ::: "memory");
            const unsigned og = xb_add(&bar[XB_TOP], 1u);
            const unsigned tg = og / nx;
            if (og + 1u == (tg + 1u) * nx) xb_add(&bar[XB_TOPGEN], 1u);
            else XB_SPIN(xb_ld(&bar[XB_TOPGEN]) == tg, bar);
            __builtin_amdgcn_fence(__ATOMIC_ACQUIRE, "agent");
            xb_add(&bar[XB_XGEN(b.x)], 1u);
            asm volatile("s_waitcnt vmcnt(0)" ::: "memory");
        } else {
            XB_SPIN(xb_ld(&bar[XB_XGEN(b.x)]) == gen, bar);
            __builtin_amdgcn_fence(__ATOMIC_ACQUIRE, "agent");
            asm volatile("s_waitcnt vmcnt(0)" ::: "memory");
        }
    }
    __syncthreads();
}
__device__ __forceinline__ float shx(float v, int m, int lane) { return __builtin_bit_cast(float, __builtin_amdgcn_ds_bpermute((lane ^ m) << 2, __builtin_bit_cast(int, v))); }
__device__ __forceinline__ int shxi(int v, int m, int lane) { return __builtin_amdgcn_ds_bpermute((lane ^ m) << 2, v); }
__device__ __forceinline__ s16x4 vtr(unsigned lds_addr) { return __builtin_bit_cast(s16x4, __builtin_amdgcn_ds_read_tr16_b64_v4i16((LAS v4i16_t*)(size_t)lds_addr)); }
__device__ __forceinline__ bf16x8 cat8(s16x4 lo, s16x4 hi) { return __builtin_shufflevector(lo, hi, 0, 1, 2, 3, 4, 5, 6, 7); }
__device__ __forceinline__ void unpack8(const u32x4 w, float (&f)[8]) { f[0] = bflo(w.x); f[1] = bfhi(w.x); f[2] = bflo(w.y); f[3] = bfhi(w.y); f[4] = bflo(w.z); f[5] = bfhi(w.z); f[6] = bflo(w.w); f[7] = bfhi(w.w); }
__device__ __forceinline__ void unpack8f8(const u32x2 w, float (&f)[8]) { const auto a0 = __builtin_amdgcn_cvt_pk_f32_fp8((int)w.x, false), a1 = __builtin_amdgcn_cvt_pk_f32_fp8((int)w.x, true), a2 = __builtin_amdgcn_cvt_pk_f32_fp8((int)w.y, false), a3 = __builtin_amdgcn_cvt_pk_f32_fp8((int)w.y, true);
    f[0] = a0[0]; f[1] = a0[1]; f[2] = a1[0]; f[3] = a1[1]; f[4] = a2[0]; f[5] = a2[1]; f[6] = a3[0]; f[7] = a3[1]; }
__device__ __forceinline__ u32x4 pack8(const float (&f)[8]) { u32x4 w; w.x = pk2(f[0], f[1]); w.y = pk2(f[2], f[3]); w.z = pk2(f[4], f[5]); w.w = pk2(f[6], f[7]); return w; }

struct Args {
    const float* in[22]; float* out; unsigned char* ws;
};

__device__ __forceinline__ void transpose_item(const float* p0, const float* p1, int ld, int mode, float scale, int K, int nblk, bf16_t* dst, int row0, LAS float* scr, int item, int lane, const float* kscale = nullptr) {
    const int kb = item / nblk, nb = item % nblk, k0 = 64 * kb, n0 = 32 * nb;
    const int np = n0 + (lane & 31);
    const float* sp; int col;
    if (mode == 0) { sp = p0; col = np; } else { sp = (np & 4) ? p1 : p0; col = (np >> 3) * 4 + (np & 3); }
    sp += (size_t)k0 * ld + col;
#pragma unroll 8
    for (int i = 0; i < 32; ++i) { const int kk = 2 * i + (lane >> 5); scr[kk * 33 + (lane & 31)] = sp[(size_t)kk * ld] * scale * (kscale ? kscale[k0 + kk] : 1.0f); }
    LDS_WAIT(); asm volatile("" ::: "memory");
    const int c = lane & 7;
#pragma unroll
    for (int j = 0; j < 4; ++j) { const int n = (lane >> 3) + 8 * j; const LAS float* s = scr + (8 * c) * 33 + n;
        u32x4 o; o.x = pk2(s[0 * 33], s[1 * 33]); o.y = pk2(s[2 * 33], s[3 * 33]); o.z = pk2(s[4 * 33], s[5 * 33]); o.w = pk2(s[6 * 33], s[7 * 33]);
        const int ng = row0 + n0 + n, kk = k0 + 8 * c;
        *(u32x4*)(dst + ((size_t)(ng >> 4) * (K >> 5) + (kk >> 5)) * 512 + (ng & 15) * 32 + (kk & 31)) = o; }
    LDS_WAIT(); asm volatile("" ::: "memory");
}
__device__ __forceinline__ void transpose_item8(const float* p0, const float* p1, int ld, int mode, float scale, int K, int nblk, unsigned char* dst, int row0, LAS float* scr, int item, int lane, const float* kscale = nullptr) {
    const int kb = item / nblk, nb = item % nblk, k0 = 64 * kb, n0 = 32 * nb;
    const int nq = lane & 7, kr = lane >> 3, np = n0 + 4 * nq;
    const float* sp; int col;
    if (mode == 0) { sp = p0; col = np; } else { sp = ((np >> 7) & 1) ? p1 : p0; col = (np >> 8) * 128 + (np & 127); }
    sp += (size_t)k0 * ld + col;
    f32x4 ld4[8];
#pragma unroll
    for (int i = 0; i < 8; ++i) ld4[i] = *(const f32x4*)(sp + (size_t)(8 * i + kr) * ld);
#pragma unroll
    for (int i = 0; i < 8; ++i) { const int kk = 8 * i + kr; const float ks = scale * (kscale ? kscale[k0 + kk] : 1.0f);
#pragma unroll
        for (int q = 0; q < 4; ++q) scr[kk * 33 + 4 * nq + q] = ld4[i][q] * ks; }
    LDS_WAIT(); asm volatile("" ::: "memory");
    const int c = lane & 7;
#pragma unroll
    for (int j = 0; j < 4; ++j) { const int n = (lane >> 3) + 8 * j; const LAS float* s = scr + (8 * c) * 33 + n;
        u32x2 o; o.x = pg8::pk4f8(s[0 * 33], s[1 * 33], s[2 * 33], s[3 * 33]); o.y = pg8::pk4f8(s[4 * 33], s[5 * 33], s[6 * 33], s[7 * 33]);
        const int ng = row0 + n0 + n;
        *(u32x2*)(dst + ((size_t)(ng >> 4) * (K >> 6) + (k0 >> 6)) * 1024 + (ng & 15) * 64 + 8 * c) = o; }
    LDS_WAIT(); asm volatile("" ::: "memory");
}
__device__ __forceinline__ void p0_convert(const Args& a, LAS unsigned char* lds, int bid, int G, int wave_s) {
    int tid_ = wave_s * 64 + pg8::lane_id(); asm volatile("" : "+v"(tid_)); const int tid = tid_, lane = tid & 63, wave = __builtin_amdgcn_readfirstlane(tid >> 6);
    unsigned char* ws = a.ws;
    LAS float* scr = (LAS float*)(lds + wave * 16384);
    const int gw = bid * NWAVES + wave, NGW = G * NWAVES;
    constexpr int I_INQ = 16 * 8, I_INB = 16 * 40, I_INC = 16 * 32, I_SQ = 16 * 32, I_GU = 16 * 16 * 32, I_DN = 16 * 8 * 32;
    constexpr int I_LAYER = I_INQ + I_INB + I_INC + 5 * I_SQ + I_GU + I_DN;
    for (int it = gw; it < 2 * I_LAYER; it += NGW) {
        const int l = it / I_LAYER; int r = it % I_LAYER;
        unsigned char* wl = ws + WS_W + (size_t)l * W_LAYER;
        const float* w_in = a.in[2] + (size_t)l * D * DIN;
        if (r < I_INQ) { transpose_item8(w_in, nullptr, DIN, 0, 0.125f * pg8::F8_SW, D, 8, wl + W_IN, 0, scr, r, lane); continue; } r -= I_INQ;
        if (r < I_INB) { transpose_item8(w_in + 256, nullptr, DIN, 0, pg8::F8_SW, D, 40, wl + W_IN, 256, scr, r, lane); continue; } r -= I_INB;
        if (r < I_INC) { transpose_item8(w_in + 1552, nullptr, DIN, 0, pg8::F8_SW, D, 32, wl + W_IN, 1792, scr, r, lane); continue; } r -= I_INC;
        if (r < I_SQ) { transpose_item8(a.in[10] + (size_t)l * D * D, nullptr, D, 0, pg8::F8_SW, D, 32, wl + W_OUT, 0, scr, r, lane); continue; } r -= I_SQ;
        if (r < I_SQ) { transpose_item8(a.in[11] + (size_t)l * D * D, nullptr, D, 0, 0.0625f * pg8::F8_SW, D, 32, wl + W_Q, 0, scr, r, lane, a.in[20] + (size_t)(l * 3 + 0) * D); continue; } r -= I_SQ;
        if (r < I_SQ) { transpose_item8(a.in[14] + (size_t)l * D * D, nullptr, D, 0, pg8::F8_SW, D, 32, wl + W_O, 0, scr, r, lane); continue; } r -= I_SQ;
        if (r < I_SQ) { transpose_item(a.in[12] + (size_t)l * D * D, nullptr, D, 0, 1.0f, D, 32, (bf16_t*)(ws + WS_WKV), l * 2048, scr, r, lane); continue; } r -= I_SQ;
        if (r < I_SQ) { transpose_item(a.in[13] + (size_t)l * D * D, nullptr, D, 0, 1.0f, D, 32, (bf16_t*)(ws + WS_WKV), l * 2048 + 1024, scr, r, lane); continue; } r -= I_SQ;
        if (r < I_GU) { const int e = r / 512, rr = r % 512; const size_t eo = ((size_t)l * 16 + e) * D * 512;
            transpose_item8(a.in[17] + eo, a.in[18] + eo, 512, 2, pg8::F8_SW, D, 32, wl + W_GU, e * 1024, scr, rr, lane); continue; } r -= I_GU;
        { const int e = r / 256, rr = r % 256; const size_t eo = ((size_t)l * 16 + e) * 512 * D;
            transpose_item8(a.in[19] + eo, nullptr, D, 0, pg8::F8_SW, 512, 32, wl + W_D, e * 1024, scr, rr, lane); }
    }
    const size_t gt = (size_t)bid * NTHR + tid, NT = (size_t)G * NTHR;
    for (int it = gw; it < 2 * 16 * 16; it += NGW) { const int l = it >> 8, kc = (it >> 4) & 15, n = (it & 15) * 64 + lane;
        const float* wq = a.in[11] + (size_t)l * D * D; const float* gg = a.in[20] + (size_t)(l * 3) * D; const float* bb = a.in[21] + (size_t)(l * 3) * D; float cs = 0.f, bq = 0.f;
#pragma unroll 8
        for (int k = 64 * kc; k < 64 * kc + 64; ++k) { const float w = wq[(size_t)k * D + n] * 0.0625f; cs += pg8::f8round(w * gg[k] * pg8::F8_SW) * (1.0f / pg8::F8_SW); bq += w * bb[k]; }
        float* tb = (float*)(ws + WS_CS) + (size_t)l * 2 * 16 * 1024; tb[kc * 1024 + n] = cs; tb[16 * 1024 + kc * 1024 + n] = bq; }
    for (size_t i = gt; i < (size_t)2 * 256 * 128; i += NT) {
        const int l = (int)(i / (256 * 128)), r = (int)(i % (256 * 128)), j = r / 128, k8 = r % 128;
        const float* w_in = a.in[2] + (size_t)l * D * DIN; const float* w_a2 = a.in[3] + (size_t)l * 16 * 256;
        float wa[16];
#pragma unroll
        for (int q = 0; q < 16; ++q) wa[q] = w_a2[q * 256 + j];
        float o[8];
#pragma unroll
        for (int kk = 0; kk < 8; ++kk) { const float* wr = w_in + (size_t)(8 * k8 + kk) * DIN + 1536; float s = 0.f;
#pragma unroll
            for (int q = 0; q < 16; q += 4) { const f32x4 v = *(const f32x4*)(wr + q); s += v[0] * wa[q] + v[1] * wa[q + 1] + v[2] * wa[q + 2] + v[3] * wa[q + 3]; }
            o[kk] = s; }
        { const int ng = 1536 + j, kk = 8 * k8; u32x2 o8; o8.x = pg8::pk4f8(o[0] * pg8::F8_SW, o[1] * pg8::F8_SW, o[2] * pg8::F8_SW, o[3] * pg8::F8_SW); o8.y = pg8::pk4f8(o[4] * pg8::F8_SW, o[5] * pg8::F8_SW, o[6] * pg8::F8_SW, o[7] * pg8::F8_SW);
          *(u32x2*)(ws + WS_W + (size_t)l * W_LAYER + W_IN + ((size_t)(ng >> 4) * (D >> 6) + (kk >> 6)) * 1024 + (ng & 15) * 64 + (kk & 63)) = o8; }
    }
    for (size_t i = gt; i < (size_t)2 * 4 * 128 * 16; i += NT) {
        const int s8 = (int)(i & 15), t = (int)((i >> 4) & 127);
        const float* src = a.in[6] + i * 8; float o[8];
#pragma unroll
        for (int q = 0; q < 8; ++q) o[q] = ((8 * s8 + q) / 64 <= t / 64) ? src[q] : 0.f;
        *(u32x4*)((bf16_t*)(ws + WS_WM) + i * 8) = pack8(o);
    }
    for (size_t i = gt; i < (size_t)M * D / 8; i += NT) {
        const f32x4 v0 = *(const f32x4*)(a.in[0] + i * 8), v1 = *(const f32x4*)(a.in[0] + i * 8 + 4);
        u32x4 w; w.x = pk2(v0[0], v0[1]); w.y = pk2(v0[2], v0[3]); w.z = pk2(v1[0], v1[1]); w.w = pk2(v1[2], v1[3]);
        *(u32x4*)((bf16_t*)(ws + WS_X) + i * 8) = w;
        u32x2 q8; q8.x = pg8::pk4f8(v0[0] * pg8::F8_SX, v0[1] * pg8::F8_SX, v0[2] * pg8::F8_SX, v0[3] * pg8::F8_SX); q8.y = pg8::pk4f8(v1[0] * pg8::F8_SX, v1[1] * pg8::F8_SX, v1[2] * pg8::F8_SX, v1[3] * pg8::F8_SX);
        *(u32x2*)(ws + WS_X8IN + i * 8) = q8;
    }
    for (size_t i = gt; i < (size_t)MKV * D / 8; i += NT) {
        const f32x4 v0 = *(const f32x4*)(a.in[1] + i * 8), v1 = *(const f32x4*)(a.in[1] + i * 8 + 4);
        u32x4 w; w.x = pk2(v0[0], v0[1]); w.y = pk2(v0[2], v0[3]); w.z = pk2(v1[0], v1[1]); w.w = pk2(v1[2], v1[3]);
        *(u32x4*)((bf16_t*)(ws + WS_MEMB) + i * 8) = w;
    }
}

constexpr int GL_KD = 0, GL_QS = 9216, GL_VS = 18432, GL_PSUM = 35840, GL_DL = 37888, GL_SSQ = 38144;
template <bool FINAL>
__device__ __forceinline__ void gla_phase(LAS unsigned char* lds, const bf16_t* P, float* Send, float* Ltot, bf16_t* Y, const float* gn_g, int bid, int G, int wave_s) {
    int tid_ = wave_s * 64 + pg8::lane_id(); asm volatile("" : "+v"(tid_)); const int tid = tid_, lane = tid & 63, wave = __builtin_amdgcn_readfirstlane(tid >> 6);
    const unsigned lb = (unsigned)(size_t)lds;
    const int g = lane >> 4, l15 = lane & 15, q4 = l15 >> 2, p4 = lane & 3;
    const int kq = tid & 63, part = wave;
    for (int item = bid; item < 256; item += G) {
        const int b = item >> 5, h = (item >> 3) & 3, run = item & 7, bh = item >> 3;
        f32x4 sacc[4];
#pragma unroll
        for (int kt = 0; kt < 4; ++kt) sacc[kt] = (f32x4){0.f, 0.f, 0.f, 0.f};
        if (FINAL) {
#pragma unroll
            for (int i = 0; i < 7; ++i) if (i < run) {
                const float* se = Send + ((size_t)(bh * 8 + i) * 64) * 128; const float* lt = Ltot + (size_t)(bh * 8 + i) * 64;
#pragma unroll
                for (int kt = 0; kt < 4; ++kt)
#pragma unroll
                    for (int r = 0; r < 4; ++r) { const int k = 16 * kt + 4 * g + r; sacc[kt][r] = __expf(lt[k]) * sacc[kt][r] + se[(size_t)k * 128 + 16 * wave + l15]; }
            }
        }
        float ltot_acc = 0.f;
        unsigned short graw[8], kraw[8]; u32x4 vraw[2], qraw; u32x2 rraw[4];
        const int v_row = tid >> 4, v_c16 = tid & 15, q_row = tid >> 3, q_c16 = tid & 7;
        const int ycol = h * 128 + 16 * wave + 4 * g;
        f32x4 gn = {1.f, 1.f, 1.f, 1.f}; if (FINAL) gn = *(const f32x4*)(gn_g + ycol);
#define GLA_FETCH(CC) do { const size_t tf_ = (size_t)b * SEQ + (size_t)(run * 16 + (CC)) * 64; \
            _Pragma("unroll") for (int i = 0; i < 8; ++i) { const bf16_t* rp = P + (tf_ + 8 * part + i) * NP + h * 64 + kq; graw[i] = rp[PG]; kraw[i] = rp[PK]; } \
            _Pragma("unroll") for (int i = 0; i < 2; ++i) vraw[i] = *(const u32x4*)(P + (tf_ + v_row + 32 * i) * NP + PV + h * 128 + v_c16 * 8); \
            if (FINAL) { qraw = *(const u32x4*)(P + (tf_ + q_row) * NP + PQ + h * 64 + q_c16 * 8); \
                _Pragma("unroll") for (int tt = 0; tt < 4; ++tt) rraw[tt] = *(const u32x2*)(P + (tf_ + 16 * tt + l15) * NP + PR + ycol); } } while (0)
        GLA_FETCH(0);
        for (int c = 0; c < 16; ++c) {
            const size_t t0 = (size_t)b * SEQ + (size_t)(run * 16 + c) * 64;
            __syncthreads();
            float gv[8], kv[8];
#pragma unroll
            for (int i = 0; i < 8; ++i) { gv[i] = __builtin_bit_cast(float, (unsigned)graw[i] << 16); kv[i] = __builtin_bit_cast(float, (unsigned)kraw[i] << 16); }
#pragma unroll
            for (int i = 1; i < 8; ++i) gv[i] += gv[i - 1];
            ((LAS float*)(lds + GL_PSUM))[part * 64 + kq] = gv[7];
#pragma unroll
            for (int i = 0; i < 2; ++i) *(LAS u32x4*)(lds + GL_VS + (v_row + 32 * i) * 272 + v_c16 * 16) = vraw[i];
            u32x2 rcur[4];
            if (FINAL) { *(LAS u32x4*)(lds + GL_QS + q_row * 144 + q_c16 * 16) = qraw;
#pragma unroll
                for (int tt = 0; tt < 4; ++tt) rcur[tt] = rraw[tt]; }
            if (c + 1 < 16) GLA_FETCH(c + 1);
            __syncthreads();
            float offs = 0.f, bl = 0.f;
#pragma unroll
            for (int p = 0; p < 8; ++p) { const float v = ((LAS float*)(lds + GL_PSUM))[p * 64 + kq]; offs += (p < part) ? v : 0.f; bl += v; }
#pragma unroll
            for (int i = 0; i < 8; ++i) { const float kd = kv[i] * __expf(bl - (offs + gv[i]));
                *(LAS unsigned short*)(lds + GL_KD + (8 * part + i) * 144 + kq * 2) = (unsigned short)(pk2(kd, 0.f) & 0xffffu); }
            if (part == 0) ((LAS float*)(lds + GL_DL))[kq] = __expf(bl);
            ltot_acc += bl;
            __syncthreads();
#pragma unroll
            for (int kt = 0; kt < 4; ++kt) { const f32x4 dl = *(LAS f32x4*)(lds + GL_DL + (16 * kt + 4 * g) * 4); sacc[kt] = sacc[kt] * dl; }
#pragma unroll
            for (int ks = 0; ks < 2; ++ks) {
                const unsigned vrow = lb + GL_VS + (unsigned)(32 * ks + 8 * g + q4) * 272u + (unsigned)(16 * wave + 4 * p4) * 2u;
                const bf16x8 vb = cat8(vtr(vrow), vtr(vrow + 4u * 272u));
#pragma unroll
                for (int kt = 0; kt < 4; ++kt) {
                    const unsigned krow = lb + GL_KD + (unsigned)(32 * ks + 8 * g + q4) * 144u + (unsigned)(16 * kt + 4 * p4) * 2u;
                    const bf16x8 ka = cat8(vtr(krow), vtr(krow + 4u * 144u));
                    sacc[kt] = __builtin_amdgcn_mfma_f32_16x16x32_bf16(ka, vb, sacc[kt], 0, 0, 0);
                }
            }
            if (FINAL) {
                f32x4 oacc[4];
#pragma unroll
                for (int tt = 0; tt < 4; ++tt) oacc[tt] = (f32x4){0.f, 0.f, 0.f, 0.f};
#pragma unroll
                for (int ks2 = 0; ks2 < 2; ++ks2) {
                    u32x4 spw; spw.x = pk2(sacc[2 * ks2][0], sacc[2 * ks2][1]); spw.y = pk2(sacc[2 * ks2][2], sacc[2 * ks2][3]);
                    spw.z = pk2(sacc[2 * ks2 + 1][0], sacc[2 * ks2 + 1][1]); spw.w = pk2(sacc[2 * ks2 + 1][2], sacc[2 * ks2 + 1][3]);
                    const bf16x8 sp = __builtin_bit_cast(bf16x8, spw);
#pragma unroll
                    for (int tt = 0; tt < 4; ++tt) {
                        const LAS unsigned char* qp = lds + GL_QS + (16 * tt + l15) * 144 + (32 * ks2 + 4 * g) * 2;
                        const u32x2 qlo = *(const LAS u32x2*)qp, qhi = *(const LAS u32x2*)(qp + 32);
                        u32x4 qw; qw.x = qlo.x; qw.y = qlo.y; qw.z = qhi.x; qw.w = qhi.y;
                        oacc[tt] = __builtin_amdgcn_mfma_f32_16x16x32_bf16(sp, __builtin_bit_cast(bf16x8, qw), oacc[tt], 0, 0, 0);
                    }
                }
#pragma unroll
                for (int tt = 0; tt < 4; ++tt) { float s = oacc[tt][0] * oacc[tt][0] + oacc[tt][1] * oacc[tt][1] + oacc[tt][2] * oacc[tt][2] + oacc[tt][3] * oacc[tt][3];
                    s += shx(s, 16, lane); s += shx(s, 32, lane);
                    if (g == 0) ((LAS float*)(lds + GL_SSQ))[wave * 64 + 16 * tt + l15] = s; }
                __syncthreads();
                const int col = ycol;
#pragma unroll
                for (int tt = 0; tt < 4; ++tt) { float tot = 0.f;
#pragma unroll
                    for (int w2 = 0; w2 < 8; ++w2) tot += ((LAS float*)(lds + GL_SSQ))[w2 * 64 + 16 * tt + l15];
                    const float rs = __builtin_amdgcn_rsqf(tot * (1.0f / 128.0f) + 1e-6f);
                    const size_t tok = t0 + 16 * tt + l15;
                    const u32x2 rr = rcur[tt];
                    const float rq = rs * pg8::F8_SM;
                    *(unsigned*)((unsigned char*)Y + tok * D + col) = pg8::pk4f8(oacc[tt][0] * rq * gn[0] * bflo(rr.x), oacc[tt][1] * rq * gn[1] * bfhi(rr.x), oacc[tt][2] * rq * gn[2] * bflo(rr.y), oacc[tt][3] * rq * gn[3] * bfhi(rr.y)); }
            }
        }
        if (!FINAL) {
            float* se = Send + ((size_t)(bh * 8 + run) * 64) * 128;
#pragma unroll
            for (int kt = 0; kt < 4; ++kt)
#pragma unroll
                for (int r = 0; r < 4; ++r) se[(size_t)(16 * kt + 4 * g + r) * 128 + 16 * wave + l15] = sacc[kt][r];
            if (part == 0) Ltot[(size_t)(bh * 8 + run) * 64 + kq] = ltot_acc;
        }
    }
}

#undef GLA_FETCH
constexpr int SG_VN = 0;
__device__ __forceinline__ void sgu_phase(LAS unsigned char* lds, const bf16_t* P, const bf16_t* Wm, const float* b_s, const float* lg, const float* lb_, bf16_t* Y, int bid, int G, int wave_s) {
    int tid_ = wave_s * 64 + pg8::lane_id(); asm volatile("" : "+v"(tid_)); const int tid = tid_, lane = tid & 63, wave = __builtin_amdgcn_readfirstlane(tid >> 6);
    const unsigned lb = (unsigned)(size_t)lds;
    const int g = lane >> 4, l15 = lane & 15, q4 = l15 >> 2, p4 = lane & 3;
    const int row = tid >> 2, qu = tid & 3;
    u32x4 vraw[4]; u32x2 uraw[8];
#define SGU_FETCH(IT) do { const int blk_ = (IT) >> 2, gr_ = (IT) & 3; const size_t tf_ = (size_t)blk_ * 128; \
        const bf16_t* src_ = P + (tf_ + row) * NP + PVS + gr_ * 128 + 32 * qu; \
        _Pragma("unroll") for (int i = 0; i < 4; ++i) vraw[i] = *(const u32x4*)(src_ + 8 * i); \
        const bf16_t* us_ = P + (tf_ + 16 * wave + l15) * NP + PU + gr_ * 128 + 4 * g; \
        _Pragma("unroll") for (int ct = 0; ct < 8; ++ct) uraw[ct] = *(const u32x2*)(us_ + 16 * ct); } while (0)
    if (bid < 2048) SGU_FETCH(bid);
    const int gr = bid & 3;
    bf16x8 wf[4]; float gph[32], bph[32];
#pragma unroll
    for (int ks = 0; ks < 4; ++ks) wf[ks] = *(const bf16x8*)(Wm + ((size_t)(gr * 128 + 16 * wave + l15)) * 128 + 32 * ks + 8 * g);
    const float bs = b_s[gr * 128 + 16 * wave + l15];
#pragma unroll
    for (int i = 0; i < 32; ++i) { gph[i] = lg[gr * 128 + 32 * qu + i]; bph[i] = lb_[gr * 128 + 32 * qu + i]; }
    for (int item = bid; item < 2048; item += G) {
        const int blk = item >> 2; const size_t t0 = (size_t)blk * 128;
        __syncthreads();
        u32x2 ucur[8];
        { float v[32];
#pragma unroll
          for (int i = 0; i < 4; ++i) { float f[8]; unpack8(vraw[i], f);
#pragma unroll
              for (int j = 0; j < 8; ++j) v[8 * i + j] = f[j]; }
#pragma unroll
          for (int ct = 0; ct < 8; ++ct) ucur[ct] = uraw[ct];
          if (item + G < 2048) SGU_FETCH(item + G);
          float s = 0.f;
#pragma unroll
          for (int i = 0; i < 32; ++i) s += v[i];
          s += shx(s, 1, lane); s += shx(s, 2, lane);
          const float mu = s * (1.0f / 128.0f); float qq = 0.f;
#pragma unroll
          for (int i = 0; i < 32; ++i) { v[i] -= mu; qq += v[i] * v[i]; }
          qq += shx(qq, 1, lane); qq += shx(qq, 2, lane);
          const float rs = __builtin_amdgcn_rsqf(qq * (1.0f / 128.0f) + LN_EPS);
#pragma unroll
          for (int i = 0; i < 4; ++i) { float f[8];
#pragma unroll
              for (int j = 0; j < 8; ++j) f[j] = v[8 * i + j] * rs * gph[8 * i + j] + bph[8 * i + j];
              *(LAS u32x4*)(lds + SG_VN + row * 272 + (32 * qu + 8 * i) * 2) = pack8(f); }
        }
        __syncthreads();
        const int nks = (wave < 4) ? 2 : 4;
        const size_t tok = t0 + 16 * wave + l15;
        unsigned vb0 = lb + SG_VN + (unsigned)(8 * g + q4) * 272u + (unsigned)(4 * p4) * 2u; asm volatile("" : "+v"(vb0));
#pragma unroll
        for (int ct = 0; ct < 8; ++ct) {
            f32x4 acc = (f32x4){0.f, 0.f, 0.f, 0.f};
#pragma unroll
            for (int ks = 0; ks < 4; ++ks) {
                if (ks < nks) {
                    const unsigned vrow = vb0 + (unsigned)(32 * ks * 272 + 32 * ct);
                    const bf16x8 va = cat8(vtr(vrow), vtr(vrow + 4u * 272u));
                    acc = __builtin_amdgcn_mfma_f32_16x16x32_bf16(va, wf[ks], acc, 0, 0, 0);
                }
            }
            const int col = gr * 128 + 16 * ct + 4 * g;
            const u32x2 uu = ucur[ct];
            *(unsigned*)((unsigned char*)Y + tok * D + 512 + col) = pg8::pk4f8(bflo(uu.x) * (acc[0] + bs) * pg8::F8_SM, bfhi(uu.x) * (acc[1] + bs) * pg8::F8_SM, bflo(uu.y) * (acc[2] + bs) * pg8::F8_SM, bfhi(uu.y) * (acc[3] + bs) * pg8::F8_SM);
        }
    }
}
#undef SGU_FETCH

constexpr int AT_KPS = 1040, AT_VPS = 1088, AT_SLOT = 34816, AT_NSLOT = 3;
static_assert(AT_NSLOT * AT_SLOT <= LDSCTL_OFF, "attention LDS");
__device__ __forceinline__ void glds16(const void* gsrc, unsigned lds_dst) { unsigned keep;
    asm volatile("s_mov_b32 %0, m0\n\ts_mov_b32 m0, %2\n\ts_nop 0\n\tglobal_load_lds_dwordx4 %1, off\n\ts_mov_b32 m0, %0" : "=&s"(keep) : "v"(gsrc), "s"(lds_dst) : "memory"); }
__device__ __forceinline__ void attn_dma(unsigned lb, const char* kvb, int so, unsigned lane_off, int slot, int ps, int wave) {
#pragma unroll
    for (int j = 0; j < 4; ++j) { const int pi = 4 * wave + j, rlo = 32 * (pi >> 4) + (pi & 15);
        glds16(kvb + (size_t)(so + rlo * 8192) + lane_off, (unsigned)__builtin_amdgcn_readfirstlane((int)(lb + (unsigned)(slot * AT_SLOT + pi * ps)))); }
}
#define AT_WAITBAR(N) do { asm volatile("s_waitcnt vmcnt(" #N ") lgkmcnt(0)" ::: "memory"); __builtin_amdgcn_s_barrier(); asm volatile("" ::: "memory"); } while (0)
__device__ __forceinline__ void attn_phase(LAS unsigned char* lds, const bf16_t* Q, const bf16_t* KV, bf16_t* O, int layer, int bid, int G, int wave_s) {
    int tid_ = wave_s * 64 + pg8::lane_id(); asm volatile("" : "+v"(tid_)); const int tid = tid_, lane = tid & 63, wave = __builtin_amdgcn_readfirstlane(tid >> 6);
    const unsigned lb = (unsigned)(size_t)lds;
    const int r32 = lane & 31, hh = lane >> 5, q4 = (lane & 15) >> 2, p4 = lane & 3, blk = (lane >> 4) & 1;
    LAS unsigned char* kbase = lds + (r32 & 15) * AT_KPS + ((r32 >> 4) & 1) * 512 + hh * 16;
    unsigned vbase = lb + (unsigned)(4 * hh + q4) * (unsigned)AT_VPS + (unsigned)(16 * blk + 4 * p4) * 2u;
    unsigned lane_off = (unsigned)((lane >> 5) * 16 * 8192 + (lane & 31) * 16);
    asm volatile("" : "+v"(kbase), "+v"(vbase), "+v"(lane_off));
    const char* kvb = (const char*)KV;
    const int nun = (bid < 256) ? 4 * ((256 - bid + G - 1) / G) : 0;
#define AT_SRC(N, ST) ((int)((((size_t)(((bid + ((N) >> 2) * G) >> 5) * NMEM) * 4096 + layer * 2048 + ((N) & 3) * 256 + (((ST) >> 2) * 1024)) * 2) + ((ST) & 3) * 64 * 8192))
    __syncthreads();
    if (nun > 0) { attn_dma(lb, kvb, AT_SRC(0, 0), lane_off, 0, AT_KPS, wave); attn_dma(lb, kvb, AT_SRC(0, 1), lane_off, 1, AT_KPS, wave); AT_WAITBAR(4); }
    int sl = 0;
    for (int n = 0; n < nun; ++n) {
        const int pan = bid + (n >> 2) * G, h = n & 3, b = pan >> 5, qt = pan & 31;
        int ln_ = pg8::lane_id(); asm volatile("" : "+v"(ln_));
        const unsigned qoff = (unsigned)((wave * 8 * 64 + ln_) * 16);
        const char* qbase = (const char*)Q + (size_t)(pan * 4 + h) * 65536;
        char* obase = (char*)O + ((size_t)b * SEQ + qt * 256) * D + h * 256;
        const bool more = (n + 1 < nun);
        bf16x8 qf[16];
#pragma unroll
        for (int s = 0; s < 8; ++s) { const u32x4 raw = *(const GAS u32x4*)(qbase + qoff + 1024 * s); float f[8]; u32x2 h8;
            h8.x = raw.x; h8.y = raw.y; unpack8f8(h8, f);
#pragma unroll
            for (int i = 0; i < 8; ++i) f[i] *= (1.0f / pg8::F8_SQ);
            qf[s] = __builtin_bit_cast(bf16x8, pack8(f));
            h8.x = raw.z; h8.y = raw.w; unpack8f8(h8, f);
#pragma unroll
            for (int i = 0; i < 8; ++i) f[i] *= (1.0f / pg8::F8_SQ);
            qf[s + 8] = __builtin_bit_cast(bf16x8, pack8(f)); }
        float ml = 0.f, lsum = 0.f;
        bf16x8 pk[8][2];
#pragma unroll
        for (int st = 0; st < 4; ++st) {
            const int sl2 = (sl >= 1) ? sl - 1 : 2;
            if (st > 0) attn_dma(lb, kvb, AT_SRC(n, st + 2), lane_off, sl2, (st + 2 < 4) ? AT_KPS : AT_VPS, wave);
            LAS unsigned char* kb = kbase + sl * AT_SLOT;
            f32x16 sa[2];
#pragma unroll
            for (int kt = 0; kt < 2; ++kt)
#pragma unroll
                for (int r = 0; r < 16; ++r) sa[kt][r] = 0.f;
            bf16x8 kfa[2], kfb[2];
#define AT_KLD(dst, S0) do { _Pragma("unroll") for (int kt = 0; kt < 2; ++kt) dst[kt] = *(const LAS bf16x8*)(kb + kt * 16 * AT_KPS + 32 * (S0)); } while (0)
#define AT_KMM(src, S0) do { _Pragma("unroll") for (int kt = 0; kt < 2; ++kt) sa[kt] = __builtin_amdgcn_mfma_f32_32x32x16_bf16(src[kt], qf[(S0)], sa[kt], 0, 0, 0); } while (0)
            AT_KLD(kfa, 0); __builtin_amdgcn_sched_barrier(0);
#pragma unroll
            for (int bq = 0; bq < 8; ++bq) {
                AT_KLD(kfb, 2 * bq + 1); __builtin_amdgcn_sched_barrier(0);
                AT_KMM(kfa, 2 * bq); __builtin_amdgcn_sched_barrier(0);
                if (bq < 7) { AT_KLD(kfa, 2 * bq + 2); __builtin_amdgcn_sched_barrier(0); }
                AT_KMM(kfb, 2 * bq + 1); __builtin_amdgcn_sched_barrier(0);
            }
#undef AT_KLD
#undef AT_KMM
            if (st == 0) attn_dma(lb, kvb, AT_SRC(n, 2), lane_off, sl2, AT_KPS, wave);
            if (st == 0) { float mx = -3.0e38f;
#pragma unroll
                for (int kt = 0; kt < 2; ++kt)
#pragma unroll
                    for (int r = 0; r < 16; ++r) mx = __builtin_fmaxf(mx, sa[kt][r]);
                mx = __builtin_fmaxf(mx, shx(mx, 32, lane)); ml = mx * LOG2E; }
#pragma unroll
            for (int kt = 0; kt < 2; ++kt) {
                float p[16];
#pragma unroll
                for (int r = 0; r < 16; ++r) { p[r] = __builtin_amdgcn_exp2f(sa[kt][r] * LOG2E - ml); lsum += p[r]; }
#pragma unroll
                for (int s2 = 0; s2 < 2; ++s2) { u32x4 w; w.x = pk2(p[8 * s2 + 0], p[8 * s2 + 1]); w.y = pk2(p[8 * s2 + 2], p[8 * s2 + 3]); w.z = pk2(p[8 * s2 + 4], p[8 * s2 + 5]); w.w = pk2(p[8 * s2 + 6], p[8 * s2 + 7]);
                    pk[2 * st + kt][s2] = __builtin_bit_cast(bf16x8, w); }
            }
            AT_WAITBAR(4);
            sl = (sl == 2) ? 0 : sl + 1;
        }
        lsum += shx(lsum, 32, lane);
        f32x16 oacc[8];
#pragma unroll
        for (int dt = 0; dt < 8; ++dt)
#pragma unroll
            for (int r = 0; r < 16; ++r) oacc[dt][r] = 0.f;
#pragma unroll
        for (int st = 4; st < 8; ++st) {
            const bool issue = (st < 6) || more;
            if (issue) { const int s2 = (sl >= 1) ? sl - 1 : 2;
                if (st < 6) attn_dma(lb, kvb, AT_SRC(n, st + 2), lane_off, s2, AT_VPS, wave); else attn_dma(lb, kvb, AT_SRC(n + 1, st - 6), lane_off, s2, AT_KPS, wave); }
            const unsigned vb = vbase + (unsigned)(sl * AT_SLOT);
            bf16x8 vfa[2], vfb[2];
#define AT_VLD(dst, BT) do { const unsigned va_ = vb + (unsigned)((((BT) >> 3) & 1) * 16 * AT_VPS + (((BT) >> 2) & 1) * 512 + ((BT) & 3) * 128); \
                _Pragma("unroll") for (int d_ = 0; d_ < 2; ++d_) dst[d_] = cat8(vtr(va_ + 64u * d_), vtr(va_ + 64u * d_ + 8u * AT_VPS)); } while (0)
#define AT_VMM(src, BT) do { _Pragma("unroll") for (int d_ = 0; d_ < 2; ++d_) oacc[2 * ((BT) & 3) + d_] = __builtin_amdgcn_mfma_f32_32x32x16_bf16(src[d_], pk[2 * (st - 4) + (((BT) >> 3) & 1)][((BT) >> 2) & 1], oacc[2 * ((BT) & 3) + d_], 0, 0, 0); } while (0)
            AT_VLD(vfa, 0); __builtin_amdgcn_sched_barrier(0);
#pragma unroll
            for (int bq = 0; bq < 8; ++bq) {
                AT_VLD(vfb, 2 * bq + 1); __builtin_amdgcn_sched_barrier(0);
                AT_VMM(vfa, 2 * bq); __builtin_amdgcn_sched_barrier(0);
                if (bq < 7) { AT_VLD(vfa, 2 * bq + 2); __builtin_amdgcn_sched_barrier(0); }
                AT_VMM(vfb, 2 * bq + 1); __builtin_amdgcn_sched_barrier(0);
            }
#undef AT_VLD
#undef AT_VMM
            if (issue) AT_WAITBAR(4); else AT_WAITBAR(0);
            sl = (sl == 2) ? 0 : sl + 1;
        }
        const float inv = 1.0f / lsum;
        int ln2 = pg8::lane_id(); asm volatile("" : "+v"(ln2));
        GAS char* op = (GAS char*)obase + (unsigned)((wave * 32 + (ln2 & 31)) * D) + ((ln2 >> 5) ? 16 : 0);
        const float sc = inv * pg8::F8_SO;
#pragma unroll
        for (int dt = 0; dt < 8; ++dt) {
            unsigned dw[4];
#pragma unroll
            for (int g4 = 0; g4 < 4; ++g4) dw[g4] = pg8::pk4f8(oacc[dt][4 * g4 + 0] * sc, oacc[dt][4 * g4 + 1] * sc, oacc[dt][4 * g4 + 2] * sc, oacc[dt][4 * g4 + 3] * sc);
            { const auto r = __builtin_amdgcn_permlane32_swap(dw[0], dw[2], false, false); dw[0] = r[0]; dw[2] = r[1]; }
            { const auto r = __builtin_amdgcn_permlane32_swap(dw[1], dw[3], false, false); dw[1] = r[0]; dw[3] = r[1]; }
            u32x4 w; w.x = dw[0]; w.y = dw[2]; w.z = dw[1]; w.w = dw[3];
            *(GAS u32x4*)(op + 32 * dt) = w; }
    }
    asm volatile("s_waitcnt vmcnt(0)" ::: "memory");
    __syncthreads();
}
#undef AT_SRC
#undef AT_WAITBAR

constexpr int RT_WH = 0, RT_WL = 32768, RT_SEL = 65536, RT_RK = 66048, RT_CNTW = 67072, RT_WBASE = 67584, RT_CS = 68608, RT_BB = 68672, RT_PART = 68736;
template <int MODE>
__device__ __forceinline__ void ln_phase(LAS unsigned char* lds, const Args& a, int l, int lnidx, bool last, bf16_t* Xout, int bid, int G, int wave_s) {
    int tid_ = wave_s * 64 + pg8::lane_id(); asm volatile("" : "+v"(tid_)); const int tid = tid_, lane = tid & 63, wave = __builtin_amdgcn_readfirstlane(tid >> 6);
    constexpr int R = (MODE == 2) ? 2 : 4;
    unsigned char* ws = a.ws;
    const bf16_t* Z = (const bf16_t*)(ws + WS_R + R_Z); const unsigned char* Ys8 = ws + WS_R + R_XS;
    pg8::f32x2_t* stats1 = (pg8::f32x2_t*)(ws + WS_STATS);
    const float* gp = a.in[20] + (size_t)(l * 3 + lnidx) * D; const float* bp = a.in[21] + (size_t)(l * 3 + lnidx) * D;
    float gg[16], bb[16];
#pragma unroll
    for (int j = 0; j < 2; ++j)
#pragma unroll
        for (int i = 0; i < 8; ++i) { gg[8 * j + i] = gp[8 * lane + 512 * j + i]; bb[8 * j + i] = bp[8 * lane + 512 * j + i]; }
    float g1v[16], b1v[16];
    if (MODE == 2) { const float* gq = a.in[20] + (size_t)(l * 3 + 1) * D; const float* bq_ = a.in[21] + (size_t)(l * 3 + 1) * D;
#pragma unroll
        for (int j = 0; j < 2; ++j)
#pragma unroll
            for (int i = 0; i < 8; ++i) { g1v[8 * j + i] = gq[8 * lane + 512 * j + i]; b1v[8 * j + i] = bq_[8 * lane + 512 * j + i]; } }
    if (MODE == 1) {
        __syncthreads();
        for (int idx = tid; idx < 2048; idx += NTHR) { const int s = idx >> 6, ln = idx & 63, e = ln & 15, g = ln >> 4; float hi[8], lo[8];
#pragma unroll
            for (int j = 0; j < 8; ++j) { const float w = a.in[15][(32 * s + 8 * g + j) * 16 + e] * gp[32 * s + 8 * g + j]; const float h = bflo(pk2(w, 0.f) & 0xffffu); hi[j] = h; lo[j] = w - h; }
            *(LAS u32x4*)(lds + RT_WH + idx * 16) = pack8(hi); *(LAS u32x4*)(lds + RT_WL + idx * 16) = pack8(lo); }
        { const int e = tid & 15, kp = tid >> 4; float cs = 0.f, bs = 0.f;
          for (int k = 32 * kp; k < 32 * kp + 32; ++k) { const float wr = a.in[15][k * 16 + e]; const float w = wr * gp[k]; const float h = bflo(pk2(w, 0.f) & 0xffffu); const float lo2 = bflo(pk2(w - h, 0.f) & 0xffffu); cs += h + lo2; bs += bp[k] * wr; }
          ((LAS float*)(lds + RT_PART))[kp * 32 + e] = cs; ((LAS float*)(lds + RT_PART))[kp * 32 + 16 + e] = bs; }
        __syncthreads();
        if (tid < 32) { float t = 0.f; for (int kp = 0; kp < 32; ++kp) t += ((LAS float*)(lds + RT_PART))[kp * 32 + tid];
            if (tid < 16) ((LAS float*)(lds + RT_CS))[tid] = t; else ((LAS float*)(lds + RT_BB))[tid - 16] = t + a.in[16][tid - 16]; }
        __syncthreads();
    }
    for (int blk = bid; blk < 256; blk += G) {
        int run[16];
#pragma unroll
        for (int e = 0; e < 16; ++e) run[e] = 0;
#define LN_DECL(P) u32x4 P##pa_[R][2]; u32x2 P##pb_[R][2], P##pc_[R][2]; float P##pw0[R], P##pw1[R]; pg8::f32x2_t P##pst[R]
        LN_DECL(c); LN_DECL(n); LN_DECL(f);
#define LN_LOAD(P, ROW0) do { _Pragma("unroll") for (int r = 0; r < R; ++r) { const size_t row = (ROW0) + r; \
            if (MODE == 2) { const int* ts = (const int*)(ws + WS_TSLOT) + row * 2; const float* ti = (const float*)(ws + WS_TINFO) + row * 4; const int s0 = ts[0], s1 = ts[1]; P##pw0[r] = ti[2]; P##pw1[r] = ti[3]; P##pst[r] = stats1[row]; \
                _Pragma("unroll") for (int j = 0; j < 2; ++j) { P##pa_[r][j] = *(const u32x4*)(Z + row * D + 8 * lane + 512 * j); P##pb_[r][j] = *(const u32x2*)(Ys8 + (size_t)s0 * D + 8 * lane + 512 * j); P##pc_[r][j] = *(const u32x2*)(Ys8 + (size_t)s1 * D + 8 * lane + 512 * j); } } \
            else { _Pragma("unroll") for (int j = 0; j < 2; ++j) P##pa_[r][j] = *(const u32x4*)(Z + row * D + 8 * lane + 512 * j); } } } while (0)
#define LN_COPY(DST, SRC) do { _Pragma("unroll") for (int r = 0; r < R; ++r) { DST##pw0[r] = SRC##pw0[r]; DST##pw1[r] = SRC##pw1[r]; DST##pst[r] = SRC##pst[r]; \
            _Pragma("unroll") for (int j = 0; j < 2; ++j) { DST##pa_[r][j] = SRC##pa_[r][j]; DST##pb_[r][j] = SRC##pb_[r][j]; DST##pc_[r][j] = SRC##pc_[r][j]; } } } while (0)
        float mu_t = 0.f, rs_t = 0.f;
#pragma unroll
        for (int r = 0; r < R; ++r) { cpw0[r] = cpw1[r] = npw0[r] = npw1[r] = fpw0[r] = fpw1[r] = 0.f; cpst[r] = npst[r] = fpst[r] = (pg8::f32x2_t){0.f, 0.f};
#pragma unroll
            for (int j = 0; j < 2; ++j) { cpb_[r][j] = cpc_[r][j] = npb_[r][j] = npc_[r][j] = fpb_[r][j] = fpc_[r][j] = (u32x2){0u, 0u}; fpa_[r][j] = (u32x4){0u, 0u, 0u, 0u}; } }
        LN_LOAD(c, (size_t)blk * 256 + wave * 32);
        LN_LOAD(n, (size_t)blk * 256 + wave * 32 + R);
        for (int ri = 0; ri < 32; ri += R) {
            const int rl0 = wave * 32 + ri; const size_t row0 = (size_t)blk * 256 + rl0;
            float v[R][16];
#pragma unroll
            for (int r = 0; r < R; ++r)
#pragma unroll
                for (int j = 0; j < 2; ++j) { float x[8]; unpack8(cpa_[r][j], x);
                    if (MODE == 2) { float y0[8], y1[8]; unpack8f8(cpb_[r][j], y0); unpack8f8(cpc_[r][j], y1); const float mu1 = cpst[r][0], rs1 = cpst[r][1];
#pragma unroll
                        for (int i = 0; i < 8; ++i) v[r][8 * j + i] = ALPHA * ((x[i] - mu1) * rs1 * g1v[8 * j + i] + b1v[8 * j + i]) + (cpw0[r] * (1.0f / pg8::F8_SY)) * y0[i] + (cpw1[r] * (1.0f / pg8::F8_SY)) * y1[i]; }
                    else {
#pragma unroll
                        for (int i = 0; i < 8; ++i) v[r][8 * j + i] = x[i]; } }
            if (ri + 2 * R < 32) LN_LOAD(f, row0 + 2 * R);
            float s[R];
#pragma unroll
            for (int r = 0; r < R; ++r) { s[r] = 0.f;
#pragma unroll
                for (int i = 0; i < 16; ++i) s[r] += v[r][i]; }
#pragma unroll
            for (int o = 1; o < 64; o <<= 1)
#pragma unroll
                for (int r = 0; r < R; ++r) s[r] += shx(s[r], o, lane);
            float qq[R], mur[R];
#pragma unroll
            for (int r = 0; r < R; ++r) { const float mu = s[r] * (1.0f / D); mur[r] = mu; qq[r] = 0.f;
#pragma unroll
                for (int i = 0; i < 16; ++i) { v[r][i] -= mu; qq[r] += v[r][i] * v[r][i]; } }
#pragma unroll
            for (int o = 1; o < 64; o <<= 1)
#pragma unroll
                for (int r = 0; r < R; ++r) qq[r] += shx(qq[r], o, lane);
#pragma unroll
            for (int r = 0; r < R; ++r) { const float rs = __builtin_amdgcn_rsqf(qq[r] * (1.0f / D) + LN_EPS);
                if (MODE == 1) { if (lane == 0) stats1[row0 + r] = (pg8::f32x2_t){mur[r], rs};
                    if ((lane & 15) == ((ri + r) & 15)) { mu_t = mur[r]; rs_t = rs; } }
#pragma unroll
                for (int i = 0; i < 16; ++i) v[r][i] = v[r][i] * rs * gg[i] + bb[i]; }
#pragma unroll
            for (int r = 0; r < R; ++r) { const size_t row = row0 + r;
                if (MODE == 2 && last) {
#pragma unroll
                    for (int j = 0; j < 2; ++j) { float* op = a.out + row * D + 8 * lane + 512 * j;
                        *(f32x4*)op = (f32x4){v[r][8 * j], v[r][8 * j + 1], v[r][8 * j + 2], v[r][8 * j + 3]}; *(f32x4*)(op + 4) = (f32x4){v[r][8 * j + 4], v[r][8 * j + 5], v[r][8 * j + 6], v[r][8 * j + 7]}; }
                } else {
#pragma unroll
                    for (int j = 0; j < 2; ++j) { float f[8];
#pragma unroll
                        for (int i = 0; i < 8; ++i) f[i] = v[r][8 * j + i];
                        if (MODE != 1) *(u32x4*)(Xout + row * D + 8 * lane + 512 * j) = pack8(f);
                        if (MODE == 1 || MODE == 2) { u32x2 q8; q8.x = pg8::pk4f8(f[0] * pg8::F8_SX, f[1] * pg8::F8_SX, f[2] * pg8::F8_SX, f[3] * pg8::F8_SX); q8.y = pg8::pk4f8(f[4] * pg8::F8_SX, f[5] * pg8::F8_SX, f[6] * pg8::F8_SX, f[7] * pg8::F8_SX);
                            *(u32x2*)(ws + (MODE == 1 ? WS_R + R_X8 : WS_X8IN) + row * D + 8 * lane + 512 * j) = q8; } }
                } }
            if (MODE == 1 && ((ri + R) & 15) == 0) {
                const int tok = lane & 15, g = lane >> 4, tl = rl0 + R - 16 + tok; const size_t token = (size_t)blk * 256 + tl;
                const bf16_t* xr = Z + token * D + 8 * g;
                f32x4 acc = (f32x4){0.f, 0.f, 0.f, 0.f};
#pragma unroll 8
                for (int ks = 0; ks < 32; ++ks) { const bf16x8 xb = *(const bf16x8*)(xr + 32 * ks);
                    const bf16x8 wh = *(const LAS bf16x8*)(lds + RT_WH + (ks * 64 + lane) * 16), wl = *(const LAS bf16x8*)(lds + RT_WL + (ks * 64 + lane) * 16);
                    acc = __builtin_amdgcn_mfma_f32_16x16x32_bf16(wh, xb, acc, 0, 0, 0); acc = __builtin_amdgcn_mfma_f32_16x16x32_bf16(wl, xb, acc, 0, 0, 0); }
                const f32x4 csv = *(const LAS f32x4*)(lds + RT_CS + 16 * g), bbv = *(const LAS f32x4*)(lds + RT_BB + 16 * g);
                float lg[4] = {rs_t * (acc[0] - mu_t * csv[0]) + bbv[0], rs_t * (acc[1] - mu_t * csv[1]) + bbv[1], rs_t * (acc[2] - mu_t * csv[2]) + bbv[2], rs_t * (acc[3] - mu_t * csv[3]) + bbv[3]};
                float m = __builtin_fmaxf(__builtin_fmaxf(lg[0], lg[1]), __builtin_fmaxf(lg[2], lg[3]));
                m = __builtin_fmaxf(m, shx(m, 16, lane)); m = __builtin_fmaxf(m, shx(m, 32, lane));
                float t1 = -1.f, t2 = -1.f; int i1 = 0, i2 = 0;
#pragma unroll
                for (int r = 0; r < 4; ++r) { const float p = __expf(lg[r] - m); if (p > t1) { t2 = t1; i2 = i1; t1 = p; i1 = r; } else if (p > t2) { t2 = p; i2 = r; } }
                const float gs = t1 + t2; float bgs = gs; int bg = g;
                { const float o = shx(bgs, 16, lane); const int og = shxi(bg, 16, lane); if (o > bgs || (o == bgs && og < bg)) { bgs = o; bg = og; } }
                { const float o = shx(bgs, 32, lane); const int og = shxi(bg, 32, lane); if (o > bgs || (o == bgs && og < bg)) { bgs = o; bg = og; } }
                const bool mine = (bg == g); const int e0 = 4 * g + i1, e1 = 4 * g + i2;
                if (mine) { u32x4 info; info.x = (unsigned)e0; info.y = (unsigned)e1; info.z = __builtin_bit_cast(unsigned, t1 / gs); info.w = __builtin_bit_cast(unsigned, t2 / gs);
                    *(u32x4*)(ws + WS_TINFO + token * 16) = info; ((LAS unsigned short*)(lds + RT_SEL))[tl] = (unsigned short)(e0 | (e1 << 8)); }
                const unsigned long long below = (1ull << lane) - 1ull; int r0 = 0, r1 = 0;
#pragma unroll
                for (int e = 0; e < 16; ++e) { const bool hit = mine && (e0 == e || e1 == e); const unsigned long long mb = __ballot(hit); const int cb = __popcll(mb & below);
                    r0 = (e0 == e) ? run[e] + cb : r0; r1 = (e1 == e) ? run[e] + cb : r1; run[e] += __popcll(mb); }
                if (mine) { ((LAS unsigned short*)(lds + RT_RK))[2 * tl] = (unsigned short)r0; ((LAS unsigned short*)(lds + RT_RK))[2 * tl + 1] = (unsigned short)r1; }
            }
            LN_COPY(c, n); LN_COPY(n, f);
        }
        if (MODE == 1) {
            { int vsel = 0;
#pragma unroll
              for (int e = 0; e < 16; ++e) vsel = (lane == e) ? run[e] : vsel;
              if (lane < 16) ((LAS int*)(lds + RT_CNTW))[wave * 16 + lane] = vsel; }
            __syncthreads();
            if (tid < 16) { int base = 0;
#pragma unroll
                for (int w = 0; w < 8; ++w) { const int t = ((LAS int*)(lds + RT_CNTW))[w * 16 + tid]; ((LAS int*)(lds + RT_WBASE))[w * 16 + tid] = base; base += t; }
                ((int*)(ws + WS_WGCNT))[blk * 16 + tid] = base; }
            __syncthreads();
            { const int t = tid >> 1, k = tid & 1; const int e = (((LAS unsigned short*)(lds + RT_SEL))[t] >> (8 * k)) & 255;
              ((int*)(ws + WS_TRANK))[(size_t)blk * 512 + tid] = (int)((LAS unsigned short*)(lds + RT_RK))[tid] + ((LAS int*)(lds + RT_WBASE))[(t >> 5) * 16 + e]; }
            __syncthreads();
        }
    }
}

#undef LN_LOAD
#undef LN_COPY
#undef LN_DECL
constexpr int MG_TBL = 0, MG_TOT = 16384, MG_PRE = 16448, MG_BASE = 16512;
__device__ __forceinline__ void moe_gather_phase(LAS unsigned char* lds, unsigned char* ws, int bid, int G, int wave_s) {
    int tid_ = wave_s * 64 + pg8::lane_id(); asm volatile("" : "+v"(tid_)); const int tid = tid_, lane = tid & 63, wave = __builtin_amdgcn_readfirstlane(tid >> 6);
    LAS int* tbl = (LAS int*)(lds + MG_TBL); LAS int* tot = (LAS int*)(lds + MG_TOT); LAS int* pre = (LAS int*)(lds + MG_PRE); LAS int* base = (LAS int*)(lds + MG_BASE);
    LAS int* offs = (LAS int*)(lds + MISC_OFF) + 16; LAS int* tile_e = (LAS int*)(lds + TILEE_OFF);
    const bf16_t* X = (const bf16_t*)(ws + WS_X); bf16_t* Xs = (bf16_t*)(ws + WS_R + R_XS);
    for (int blk = bid; blk < 256; blk += G) {
        __syncthreads();
        for (int i = tid; i < 4096; i += NTHR) tbl[i] = ((const int*)(ws + WS_WGCNT))[i];
        __syncthreads();
        if (tid < 16) { int t = 0, p = 0; for (int c = 0; c < 256; ++c) { const int v = tbl[c * 16 + tid]; p += (c < blk) ? v : 0; t += v; } tot[tid] = t; pre[tid] = p; }
        __syncthreads();
        if (tid == 0) { int o = 0; for (int e = 0; e < 16; ++e) { offs[e] = o; base[e] = o + pre[e]; o += (tot[e] + 255) & ~255; } offs[16] = o; offs[17] = o >> 8; }
        __syncthreads();
        for (int rt = tid; rt < 528; rt += NTHR) { int e = 0;
#pragma unroll
            for (int q = 1; q < 16; ++q) e = (rt * 256 >= offs[q]) ? q : e;
            tile_e[rt] = e; }
        { const size_t tok = (size_t)blk * 256 + (tid >> 1); const int k = tid & 1;
          const int e = ((const int*)(ws + WS_TINFO))[tok * 4 + k]; const int rk = ((const int*)(ws + WS_TRANK))[tok * 2 + k];
          const int slot = base[e] + rk;
          ((int*)(ws + WS_TSLOT))[tok * 2 + k] = slot; ((int*)(ws + WS_SRCROW))[slot] = (int)tok; }
        for (int e = wave; e < 16; e += NWAVES) { const int npad = offs[e + 1] - offs[e] - tot[e];
            if (blk < npad && lane == 0) ((int*)(ws + WS_SRCROW))[offs[e] + tot[e] + blk] = 0; }
    }
}

#define GEMM_ALIGN true
#define GEMM_SP2 true
__global__ void __launch_bounds__(NTHR, 2) mk_fwd(Args args) {
    extern __shared__ __attribute__((aligned(16))) unsigned char lds_raw[];
    LAS unsigned char* lds = (LAS unsigned char*)lds_raw;
    const int tid = threadIdx.x; const int wave_s = __builtin_amdgcn_readfirstlane(tid >> 6);
    const int G = gridDim.x, bid = blockIdx.x;
    unsigned char* ws = args.ws;
    volatile LAS unsigned* MISC = (volatile LAS unsigned*)(lds + MISC_OFF);
    for (int u = tid; u < (LDS_BYTES - LDSCTL_OFF) / 4; u += NTHR) ((LAS unsigned*)(lds + LDSCTL_OFF))[u] = 0u;
    __syncthreads();
    XcdBarrier bar = xcd_barrier_post((unsigned*)(ws + WS_CTL) + CW_BAR, MISC + 8);
    bar.wv = wave_s;
#define GRID_BAR() xcd_barrier(bar)
#ifndef REP_MASK
#define REP_MASK 0
#endif
#define LOCAL_SYNC() do { asm volatile("s_waitcnt vmcnt(0)" ::: "memory"); __syncthreads(); } while (0)
#define PHASE(grp, ...) do { __VA_ARGS__; if (REP_MASK & (1 << (grp))) { GRID_BAR(); __VA_ARGS__; } } while (0)

#define WSQ ({ unsigned char* w_ = args.ws; asm volatile("" : "+s"(w_)); w_; })
#define X ((bf16_t*)(WSQ + WS_X))
#define P ((bf16_t*)(WSQ + WS_R + R_P))
#define Y ((bf16_t*)(WSQ + WS_R + R_Y))
#define Z ((bf16_t*)(WSQ + WS_R + R_Z))
#define Qb ((bf16_t*)(WSQ + WS_R + R_Q))
#define Ob ((bf16_t*)(WSQ + WS_R + R_O))
#define Xs ((bf16_t*)(WSQ + WS_R + R_XS))
#define Hb ((bf16_t*)(WSQ + WS_R + R_H))
#define KV ((bf16_t*)(WSQ + WS_KV))
#define wl (WSQ + WS_W + (size_t)l * W_LAYER)

    PHASE(0, p0_convert(args, lds, bid, G, wave_s));
    GRID_BAR();
    { const int tid_r = wave_s * 64 + pg8::lane_id();
      for (int i = bid * NTHR + tid_r; i < 2 * 2 * 1024; i += G * NTHR) { const int l = i >> 11, w = (i >> 10) & 1, n = i & 1023; const float* tb = (const float*)(WSQ + WS_CS) + (size_t)l * 2 * 16 * 1024 + w * 16 * 1024; float s = 0.f;
#pragma unroll
          for (int kc = 0; kc < 16; ++kc) s += tb[kc * 1024 + n];
          ((float*)(WSQ + WS_CS) + 65536)[i] = s; } }
    PHASE(1, { pg8::Gemm g{(const bf16_t*)(WSQ + WS_MEMB), (const bf16_t*)(WSQ + WS_WKV), MKV, 4096, D, wave_s}; pg8::StaticOrder S; S.init(MKV, 4096, G, bid);
      pg8::EpiPlain E{KV, 4096, 0xffff};
      pg8::gemm_phase<pg8::EpiPlain, pg8::StaticOrder, GEMM_ALIGN, GEMM_SP2>(lds, g, S, E); });

#pragma unroll 1
    for (int l = 0; l < 2; ++l) {
        PHASE(1, { pg8::Gemm g{(const bf16_t*)(WSQ + WS_X8IN), (const bf16_t*)(wl + W_IN), M, NP, D / 2, wave_s}; pg8::StaticOrder S; S.init(M, NP, G, bid);
          pg8::EpiInProj8 E{P, args.in[4] + l * 256};
          pg8::gemm_phase<pg8::EpiInProj8, pg8::StaticOrder, GEMM_ALIGN, GEMM_SP2>(lds, g, S, E); });
        GRID_BAR();
        PHASE(3, gla_phase<false>(lds, P, (float*)(WSQ + WS_SEND), (float*)(WSQ + WS_LTOT), Y, args.in[5] + l * 512, bid, G, wave_s));
        PHASE(4, sgu_phase(lds, P, (const bf16_t*)(WSQ + WS_WM) + (size_t)l * 4 * 128 * 128, args.in[7] + l * 512, args.in[8] + l * 512, args.in[9] + l * 512, Y, bid, G, wave_s));
        GRID_BAR();
        PHASE(3, gla_phase<true>(lds, P, (float*)(WSQ + WS_SEND), (float*)(WSQ + WS_LTOT), Y, args.in[5] + l * 512, bid, G, wave_s));
        GRID_BAR();
        PHASE(10, { pg8::Gemm g{Y, (const bf16_t*)(wl + W_OUT), M, D, D / 2, wave_s}; pg8::PanelOrder S{4, M / 256, G, bid};
          pg8::EpiResidStats8 E{X, Z, (pg8::f32x2_t*)(WSQ + WS_PART), WSQ + WS_R + R_X8};
          pg8::gemm_phase<pg8::EpiResidStats8, pg8::PanelOrder, GEMM_ALIGN, GEMM_SP2>(lds, g, S, E); });
        { const int tid_r = wave_s * 64 + pg8::lane_id();
          for (int pan = bid; pan < 256; pan += G) if (tid_r < 256) { const size_t row = (size_t)pan * 256 + tid_r; const pg8::f32x2_t* pp = (const pg8::f32x2_t*)(WSQ + WS_PART) + row * 16; float s1 = 0.f, s2 = 0.f;
#pragma unroll
              for (int q = 0; q < 16; ++q) { const pg8::f32x2_t v = pp[q]; s1 += v[0]; s2 += v[1]; }
              const float mu = s1 * (1.0f / D), var = s2 * (1.0f / D) - mu * mu; ((pg8::f32x2_t*)(WSQ + WS_STATS))[row] = (pg8::f32x2_t){mu, __builtin_amdgcn_rsqf(var + LN_EPS)}; } }
        LOCAL_SYNC();
        PHASE(10, { pg8::Gemm g{(const bf16_t*)(WSQ + WS_R + R_X8), (const bf16_t*)(wl + W_Q), M, D, D / 2, wave_s}; pg8::PanelOrder S{4, M / 256, G, bid};
          pg8::EpiQFragLN8 E{(unsigned char*)Qb, (const pg8::f32x2_t*)(WSQ + WS_STATS), (const float*)(WSQ + WS_CS) + 65536 + l * 2048, (const float*)(WSQ + WS_CS) + 65536 + l * 2048 + 1024};
          pg8::gemm_phase<pg8::EpiQFragLN8, pg8::PanelOrder, GEMM_ALIGN, GEMM_SP2>(lds, g, S, E); });
        PHASE(5, attn_phase(lds, Qb, KV, Ob, l, bid, G, wave_s));
        LOCAL_SYNC();
        PHASE(10, { pg8::Gemm g{Ob, (const bf16_t*)(wl + W_O), M, D, D / 2, wave_s}; pg8::PanelOrder S{4, M / 256, G, bid};
          pg8::EpiResidLN8 E{Z, (const pg8::f32x2_t*)(WSQ + WS_STATS), args.in[20] + (size_t)(l * 3) * D, args.in[21] + (size_t)(l * 3) * D};
          pg8::gemm_phase<pg8::EpiResidLN8, pg8::PanelOrder, GEMM_ALIGN, GEMM_SP2>(lds, g, S, E); });
        PHASE(9, ln_phase<1>(lds, args, l, 1, false, X, bid, G, wave_s));
        GRID_BAR();
        PHASE(7, moe_gather_phase(lds, WSQ, bid, G, wave_s));
        GRID_BAR();
        PHASE(2, { pg8::Gemm g{(const bf16_t*)(WSQ + WS_R + R_X8), (const bf16_t*)(wl + W_GU), MOE_ROWS, 16384, D / 2, wave_s}; pg8::MoeGatherOrder S{(const LAS int*)(lds + TILEE_OFF), (int)MISC[33] * 4, G, bid, (const int*)(WSQ + WS_SRCROW)};
          pg8::EpiGU8 E{(unsigned char*)Hb};
          pg8::gemm_phase<pg8::EpiGU8, pg8::MoeGatherOrder, GEMM_ALIGN, GEMM_SP2>(lds, g, S, E); });
        GRID_BAR();
        PHASE(2, { pg8::Gemm g{Hb, (const bf16_t*)(wl + W_D), MOE_ROWS, 16384, 256, wave_s}; pg8::MoeOrder S{(const LAS int*)(lds + TILEE_OFF), (int)MISC[33] * 4, G, bid};
          pg8::EpiPlain8 E{(unsigned char*)Xs, D, 3};
          pg8::gemm_phase<pg8::EpiPlain8, pg8::MoeOrder, GEMM_ALIGN, GEMM_SP2>(lds, g, S, E); });
        GRID_BAR();
        if (REP_MASK & (1 << 8)) { ln_phase<2>(lds, args, l, 2, l == 1, Z, bid, G, wave_s); GRID_BAR(); }
        ln_phase<2>(lds, args, l, 2, l == 1, X, bid, G, wave_s);
        if (l == 0) GRID_BAR();
    }
}
#undef X
#undef P
#undef Y
#undef Z
#undef Qb
#undef Ob
#undef Xs
#undef Hb
#undef KV
#undef wl
}

extern "C" void kernel_launch(void* const* d_in, const int* in_sizes, int n_in, void* d_out, int out_size, void* d_ws, size_t ws_size, hipStream_t stream) {
    using namespace mk;
    static int grid = 0;
    if (grid == 0) {
        if (n_in != 22 || in_sizes[0] != M * D || out_size != M * D || ws_size < WS_END) { fprintf(stderr, "kernel_launch: unexpected shapes (n_in %d, in0 %d, out %d, ws %zu, need %zu)\n", n_in, n_in > 0 ? in_sizes[0] : -1, out_size, ws_size, (size_t)WS_END); grid = -1; return; }
        int dev = 0, cus = 0;
        if (hipGetDevice(&dev) != hipSuccess || hipDeviceGetAttribute(&cus, hipDeviceAttributeMultiprocessorCount, dev) != hipSuccess) { grid = -1; return; }
        if (hipFuncSetAttribute((const void*)mk_fwd, hipFuncAttributeMaxDynamicSharedMemorySize, LDS_BYTES) != hipSuccess) { fprintf(stderr, "kernel_launch: hipFuncSetAttribute failed\n"); grid = -1; return; }
        int per_cu = 0;
        if (hipOccupancyMaxActiveBlocksPerMultiprocessor(&per_cu, (const void*)mk_fwd, NTHR, LDS_BYTES) != hipSuccess || per_cu < 1) fprintf(stderr, "kernel_launch: occupancy query says %d\n", per_cu);
        (void)hipGetLastError();
        grid = cus;
        if (grid & 3) { fprintf(stderr, "kernel_launch: the spatial-gating phase needs a grid that is a multiple of 4 (found %d CUs); nothing launched\n", grid); grid = -1; return; }
    }
    if (grid < 0) return;
    if (hipMemsetAsync((char*)d_ws + WS_CTL, 0, CTL_ZERO_BYTES, stream) != hipSuccess) return;
    Args a{};
    for (int i = 0; i < 22; ++i) a.in[i] = (const float*)d_in[i];
    a.out = (float*)d_out; a.ws = (unsigned char*)d_ws;
    hipLaunchKernelGGL(mk_fwd, dim3(grid), dim3(NTHR), LDS_BYTES, stream, a);
}
```
